# Optimizing an MI355X kernel written in HIP

```python
import jax, jax.numpy as jnp
from jax import lax
import numpy as np

D_MODEL = 1024
BATCH = 8
SEQ = 4096
DEPTH = 1
DEC_BATCH = 8
DEC_SEQ = 32
PAST_LEN = 2048

CHUNK = 64
D_MIX = D_MODEL
ML_HEADS = 4
ML_DIM = 128
ML_WIDTH = ML_HEADS * ML_DIM
SB_HEADS = 8
SB_DIM = 64
SB_WIDTH = SB_HEADS * SB_DIM
Q_BLOCK = 128
D_FF = 2816
CONV_W = 3
EPS = 1e-6
SPLIT_SIZES = (ML_WIDTH, ML_WIDTH, ML_WIDTH, ML_WIDTH, ML_HEADS, ML_HEADS, SB_WIDTH, SB_WIDTH, SB_WIDTH)
D_IN = 4 * ML_WIDTH + 2 * ML_HEADS + 3 * SB_WIDTH

kernel_name = "hymba_mlstm_stickbreaking_convffn_step"


def rmsnorm(x, w):
    xf = x.astype(jnp.float32)
    y = xf * lax.rsqrt(jnp.mean(xf * xf, axis=-1, keepdims=True) + EPS)
    return (y * w.astype(jnp.float32)).astype(x.dtype)


def adaln(c, w_ada, b_ada):
    mod = jax.nn.silu(c) @ w_ada + b_ada
    return jnp.split(mod[:, None, :], 6, axis=-1)


def split_proj(proj):
    idx, acc = [], 0
    for s in SPLIT_SIZES[:-1]:
        acc += s
        idx.append(acc)
    return jnp.split(proj, idx, axis=-1)


def mlstm_chunk(state, inp):
    C, n, m = state
    q, k, v, ig, lf = inp
    L = q.shape[2]
    b = jnp.cumsum(lf, axis=-1)
    causal = jnp.tril(jnp.ones((L, L), dtype=bool))
    d_log = jnp.where(causal, b[..., :, None] - b[..., None, :] + ig[..., None, :], -jnp.inf)
    inter = b + m[..., None]
    m_t = jnp.maximum(inter, jnp.max(d_log, axis=-1))
    w_intra = jnp.exp(d_log - m_t[..., None])
    w_inter = jnp.exp(inter - m_t)
    s = jnp.einsum('bhtd,bhsd->bhts', q, k) * w_intra
    num = w_inter[..., None] * jnp.einsum('bhtd,bhde->bhte', q, C) + jnp.einsum('bhts,bhse->bhte', s, v)
    den = w_inter * jnp.einsum('bhtd,bhd->bht', q, n) + jnp.sum(s, axis=-1)
    h = num / jnp.maximum(jnp.abs(den), jnp.exp(-m_t))[..., None]
    b_last = b[..., -1]
    w_k = b_last[..., None] - b + ig
    m_new = jnp.maximum(b_last + m, jnp.max(w_k, axis=-1))
    decay = jnp.exp(b_last + m - m_new)
    wk = jnp.exp(w_k - m_new[..., None])
    C_new = decay[..., None, None] * C + jnp.einsum('bhs,bhsd,bhse->bhde', wk, k, v)
    n_new = decay[..., None] * n + jnp.einsum('bhs,bhsd->bhd', wk, k)
    return (C_new, n_new, m_new), h


def mlstm_prompt(q, k, v, ig, lf):
    B, H, T, _ = q.shape
    nc = T // CHUNK

    def to_chunks(t):
        return jnp.moveaxis(t.reshape(t.shape[:2] + (nc, CHUNK) + t.shape[3:]), 2, 0)

    init = (jnp.zeros((B, H, ML_DIM, ML_DIM), jnp.float32),
            jnp.zeros((B, H, ML_DIM), jnp.float32),
            jnp.zeros((B, H), jnp.float32))
    state, h = lax.scan(mlstm_chunk, init, (to_chunks(q), to_chunks(k), to_chunks(v), to_chunks(ig), to_chunks(lf)))
    h = jnp.moveaxis(h, 0, 2).reshape(B, H, T, ML_DIM)
    return h, state


def stick_breaking_block(q, k, v, q_pos, k_pos):
    z = jnp.einsum('bhtd,bhsd->bhts', q, k).astype(jnp.float32) * (SB_DIM ** -0.5)
    mask = k_pos[None, :] < q_pos[:, None]
    log_beta = jnp.where(mask, jax.nn.log_sigmoid(z), -jnp.inf)
    log_1m = jnp.where(mask, jax.nn.log_sigmoid(-z), 0.0)
    rest = lax.cumsum(log_1m, axis=3, reverse=True) - log_1m
    a = jnp.exp(log_beta + rest)
    return jnp.einsum('bhts,bhsd->bhtd', a.astype(v.dtype), v)


def sb_prompt(q, k, v):
    B, H, T, d = q.shape
    nb = T // Q_BLOCK
    qb = jnp.moveaxis(q.reshape(B, H, nb, Q_BLOCK, d), 2, 0)
    k_pos = jnp.arange(T)

    def one_block(args):
        q_blk, start = args
        return stick_breaking_block(q_blk, k, v, start + jnp.arange(Q_BLOCK), k_pos)

    o = lax.map(one_block, (qb, jnp.arange(nb) * Q_BLOCK))
    return jnp.moveaxis(o, 0, 2).reshape(B, H, T, d)


def conv_ffn(h, conv_state, w_up, w_conv, b_conv, w_down):
    u = h @ w_up
    T = u.shape[1]
    padded = jnp.concatenate([conv_state.astype(u.dtype), u], axis=1)
    uc = sum(padded[:, j:j + T] * w_conv[j] for j in range(CONV_W)) + b_conv
    a, g = jnp.split(uc, 2, axis=-1)
    out = (jax.nn.silu(a) * g) @ w_down
    return out, padded[:, -(CONV_W - 1):]


def trunk_layer(x, c, p, ml_state=None, k_past=None, v_past=None, conv_state=None):
    B, T, _ = x.shape
    sh1, sc1, g1, sh2, sc2, g2 = adaln(c, p['w_ada'], p['b_ada'])
    h = rmsnorm(x, p['norm1_w']) * (1 + sc1) + sh1
    mq, mk, mv, mo, mi, mf, sq, sk, sv = split_proj(h @ p['w_in'])

    def heads(t, nh):
        return t.reshape(B, T, nh, -1).transpose(0, 2, 1, 3).astype(jnp.float32)
    q_a = heads(mq, ML_HEADS)
    k_a = heads(mk, ML_HEADS) * (ML_DIM ** -0.5)
    v_a = heads(mv, ML_HEADS)
    ig = (mi + p['b_ig']).astype(jnp.float32).transpose(0, 2, 1)
    lf = jax.nn.log_sigmoid((mf + p['b_fg']).astype(jnp.float32)).transpose(0, 2, 1)
    if ml_state is None:
        h_cell, ml_new = mlstm_prompt(q_a, k_a, v_a, ig, lf)
    else:
        st = tuple(s.astype(jnp.float32) for s in ml_state)
        ml_new, h_cell = mlstm_chunk(st, (q_a, k_a, v_a, ig, lf))
    h_cell = rmsnorm(h_cell.transpose(0, 2, 1, 3), p['ml_norm_w']).reshape(B, T, ML_WIDTH).astype(x.dtype)
    y_a = h_cell * jax.nn.sigmoid(mo)

    q_b = rmsnorm(sq.reshape(B, T, SB_HEADS, SB_DIM), p['sb_q_norm_w'])
    k_rows = rmsnorm(sk.reshape(B, T, SB_HEADS, SB_DIM), p['sb_k_norm_w'])
    v_rows = sv.reshape(B, T, SB_HEADS, SB_DIM)
    if k_past is None:
        o_b = sb_prompt(q_b.transpose(0, 2, 1, 3), k_rows.transpose(0, 2, 1, 3), v_rows.transpose(0, 2, 1, 3))
    else:
        P = k_past.shape[1]
        k_all = jnp.concatenate([k_past.astype(k_rows.dtype), k_rows], axis=1).transpose(0, 2, 1, 3)
        v_all = jnp.concatenate([v_past.astype(v_rows.dtype), v_rows], axis=1).transpose(0, 2, 1, 3)
        o_b = stick_breaking_block(q_b.transpose(0, 2, 1, 3), k_all, v_all, P + jnp.arange(T), jnp.arange(P + T))
    y_b = rmsnorm(o_b.transpose(0, 2, 1, 3).reshape(B, T, SB_WIDTH), p['sb_out_norm_w'])

    mix = jnp.concatenate([y_a, y_b], axis=-1) @ p['w_out']
    x = x + g1 * mix

    h2 = rmsnorm(x, p['norm2_w']) * (1 + sc2) + sh2
    if conv_state is None:
        conv_state = jnp.zeros((B, CONV_W - 1, 2 * D_FF), x.dtype)
    f_out, conv_new = conv_ffn(h2, conv_state, p['w_up'], p['w_conv'], p['b_conv'], p['w_down'])
    x = x + g2 * f_out
    return x, ml_new, k_rows, v_rows, conv_new


def setup_inputs(seed: int = 0) -> dict:
    key = jax.random.key(seed)
    ks = jax.random.split(key, 32)
    nrm = lambda k, shape: jax.random.normal(k, shape, jnp.float32)
    return {
        "x_prompt": nrm(ks[0], (BATCH, SEQ, D_MODEL)),
        "x_sample": nrm(ks[1], (DEC_BATCH, DEC_SEQ, D_MODEL)),
        "c_prompt": nrm(ks[2], (BATCH, D_MODEL)),
        "c_sample": nrm(ks[3], (DEC_BATCH, D_MODEL)),
        "state_mlstm_c": 0.1 * nrm(ks[4], (DEPTH, DEC_BATCH, ML_HEADS, ML_DIM, ML_DIM)),
        "state_mlstm_n": 0.5 * nrm(ks[5], (DEPTH, DEC_BATCH, ML_HEADS, ML_DIM)),
        "state_mlstm_m": 0.5 * nrm(ks[6], (DEPTH, DEC_BATCH, ML_HEADS)),
        "cache_sb_k": nrm(ks[7], (DEPTH, DEC_BATCH, PAST_LEN, SB_HEADS, SB_DIM)),
        "cache_sb_v": nrm(ks[8], (DEPTH, DEC_BATCH, PAST_LEN, SB_HEADS, SB_DIM)),
        "state_ffn_conv": nrm(ks[9], (DEPTH, DEC_BATCH, CONV_W - 1, 2 * D_FF)),
        "w_ada": 0.5 * D_MODEL ** -0.5 * nrm(ks[10], (DEPTH, D_MODEL, 6 * D_MODEL)),
        "b_ada": 0.01 * nrm(ks[11], (DEPTH, 6 * D_MODEL)),
        "norm1_w": 1.0 + 0.02 * nrm(ks[12], (DEPTH, D_MODEL)),
        "w_in": D_MODEL ** -0.5 * nrm(ks[13], (DEPTH, D_MODEL, D_IN)),
        "b_ig": 0.1 * nrm(ks[14], (DEPTH, ML_HEADS)),
        "b_fg": 3.0 + 0.5 * nrm(ks[15], (DEPTH, ML_HEADS)),
        "ml_norm_w": 1.0 + 0.02 * nrm(ks[16], (DEPTH, ML_HEADS, ML_DIM)),
        "sb_q_norm_w": 1.0 + 0.02 * nrm(ks[17], (DEPTH, SB_DIM)),
        "sb_k_norm_w": 1.0 + 0.02 * nrm(ks[18], (DEPTH, SB_DIM)),
        "sb_out_norm_w": 1.0 + 0.02 * nrm(ks[19], (DEPTH, SB_WIDTH)),
        "w_out": D_MIX ** -0.5 * nrm(ks[20], (DEPTH, D_MIX, D_MODEL)),
        "norm2_w": 1.0 + 0.02 * nrm(ks[21], (DEPTH, D_MODEL)),
        "w_up": D_MODEL ** -0.5 * nrm(ks[22], (DEPTH, D_MODEL, 2 * D_FF)),
        "w_conv": CONV_W ** -0.5 * nrm(ks[23], (DEPTH, CONV_W, 2 * D_FF)),
        "b_conv": 0.01 * nrm(ks[24], (DEPTH, 2 * D_FF)),
        "w_down": D_FF ** -0.5 * nrm(ks[25], (DEPTH, D_FF, D_MODEL)),
    }


def reference(x_prompt, x_sample, c_prompt, c_sample, state_mlstm_c, state_mlstm_n, state_mlstm_m,
              cache_sb_k, cache_sb_v, state_ffn_conv, w_ada, b_ada, norm1_w, w_in, b_ig, b_fg,
              ml_norm_w, sb_q_norm_w, sb_k_norm_w, sb_out_norm_w, w_out, norm2_w, w_up, w_conv,
              b_conv, w_down):
    weights = {"w_ada": w_ada, "b_ada": b_ada, "norm1_w": norm1_w, "w_in": w_in, "b_ig": b_ig,
               "b_fg": b_fg, "ml_norm_w": ml_norm_w, "sb_q_norm_w": sb_q_norm_w,
               "sb_k_norm_w": sb_k_norm_w, "sb_out_norm_w": sb_out_norm_w, "w_out": w_out,
               "norm2_w": norm2_w, "w_up": w_up, "w_conv": w_conv, "b_conv": b_conv, "w_down": w_down}
    y_p, y_s = x_prompt, x_sample
    pc, pn, pm, pk, pv, pf = [], [], [], [], [], []
    sc, sn, sm, sk, sv, sf = [], [], [], [], [], []
    for l in range(DEPTH):
        p = {name: w[l] for name, w in weights.items()}
        y_p, (c_new, n_new, m_new), k_new, v_new, f_new = trunk_layer(y_p, c_prompt, p)
        pc.append(c_new); pn.append(n_new); pm.append(m_new); pk.append(k_new); pv.append(v_new); pf.append(f_new)
        y_s, (c_new, n_new, m_new), k_new, v_new, f_new = trunk_layer(
            y_s, c_sample, p, (state_mlstm_c[l], state_mlstm_n[l], state_mlstm_m[l]),
            cache_sb_k[l], cache_sb_v[l], state_ffn_conv[l])
        sc.append(c_new); sn.append(n_new); sm.append(m_new); sk.append(k_new); sv.append(v_new); sf.append(f_new)
    return (y_p, y_s,
            jnp.stack(pc), jnp.stack(pn), jnp.stack(pm), jnp.stack(pk), jnp.stack(pv), jnp.stack(pf),
            jnp.stack(sc), jnp.stack(sn), jnp.stack(sm), jnp.stack(sk), jnp.stack(sv), jnp.stack(sf))
```

```cpp
#include <hip/hip_runtime.h>
#include <hip/hip_cooperative_groups.h>
#include <cstdio>
#include <cstdint>
namespace cg = cooperative_groups;

#define LAS __attribute__((address_space(3)))
typedef unsigned short bf16_t;
typedef short bf16x8 __attribute__((ext_vector_type(8)));
typedef short s16x4 __attribute__((ext_vector_type(4)));
typedef float f32x2 __attribute__((ext_vector_type(2)));
typedef float f32x4 __attribute__((ext_vector_type(4)));
typedef float f32x16 __attribute__((ext_vector_type(16)));
typedef unsigned u32x2 __attribute__((ext_vector_type(2)));
typedef unsigned u32x4 __attribute__((ext_vector_type(4)));
typedef __bf16 bf16x2_t __attribute__((ext_vector_type(2)));
typedef LAS unsigned char* lptr;
typedef const LAS unsigned char* clptr;

constexpr int DM = 1024, SEQ = 4096, NB = 8, MP = NB * SEQ, DEC = 32, MS = NB * DEC, MT = MP + MS, PAST = 2048;
constexpr int DIN = 3592, NPROJ = 3584, FF = 2816, FF2 = 5632;
constexpr float EPS = 1e-6f;
constexpr float LOG2E = 1.4426950408889634f;
constexpr size_t O_YP = 0, O_YS = 33554432, O_PC = 33816576, O_PN = 34340864, O_PM = 34344960, O_PK = 34344992, O_PV = 51122208,
                 O_PF = 67899424, O_SC = 67989536, O_SN = 68513824, O_SM = 68517920, O_SK = 68517952, O_SV = 68649024, O_SF = 68780096, O_END = 68870208;
constexpr size_t MiB = 1u << 20;
constexpr size_t WS_CTL = 0, WS_MODP = 1 * MiB, WS_MOD = 7 * MiB, WS_GATES = 8 * MiB, WS_SSQ = 10 * MiB, WS_UEDGE = 12 * MiB,
                 WS_W1T = 24 * MiB, WS_W2T = 31 * MiB, WS_W3T = 33 * MiB, WS_W4T = 44 * MiB, WS_H = 52 * MiB, WS_PROJ = 120 * MiB,
                 PROJ_STRIDE = 33 * MiB, WS_YCAT = 352 * MiB, WS_ACT = 120 * MiB, WS_END = 420 * MiB;
constexpr size_t WS_X1B = 424 * MiB;
constexpr int LDS_BYTES = 147456;
constexpr int QOFF = LDS_BYTES - 64;

struct Params { const float* in[26]; float* out; unsigned char* ws; };
enum { I_XP = 0, I_XS, I_CP, I_CS, I_STC, I_STN, I_STM, I_CK, I_CV, I_SFC, I_WADA, I_BADA, I_N1W, I_WIN, I_BIG, I_BFG, I_MLW, I_SQW, I_SKW, I_SOW,
       I_WOUT, I_N2W, I_WUP, I_WCONV, I_BCONV, I_WDOWN };

__device__ __forceinline__ unsigned cvtpk(float lo, float hi) { f32x2 v = {lo, hi}; bf16x2_t b = __builtin_convertvector(v, bf16x2_t); return __builtin_bit_cast(unsigned, b); }
__device__ __forceinline__ float bf2f(unsigned short x) { return __uint_as_float((unsigned)x << 16); }
__device__ __forceinline__ float bflo(unsigned w) { return __uint_as_float(w << 16); }
__device__ __forceinline__ float bfhi(unsigned w) { return __uint_as_float(w & 0xffff0000u); }
__device__ __forceinline__ unsigned short f2bf(float f) { return (unsigned short)(cvtpk(f, 0.f) & 0xffffu); }
__device__ __forceinline__ float wave_sum(float v) {
#pragma unroll
    for (int o = 1; o < 64; o <<= 1) v += __shfl_xor(v, o);
    return v;
}
__device__ __forceinline__ float fast_exp2(float x) { return __builtin_amdgcn_exp2f(x); }
__device__ __forceinline__ float fast_rcp(float x) { return __builtin_amdgcn_rcpf(x); }
__device__ __forceinline__ float sigmoidf_(float x) { return fast_rcp(1.f + fast_exp2(-x * LOG2E)); }
__device__ __forceinline__ int crow(int r, int hi) { return (r & 3) + 8 * (r >> 2) + 4 * hi; }
typedef short v4i16_t __attribute__((ext_vector_type(4)));
__device__ __forceinline__ s16x4 tr_read(clptr p) { return __builtin_bit_cast(s16x4, __builtin_amdgcn_ds_read_tr16_b64_v4i16((LAS v4i16_t*)p)); }
__device__ __forceinline__ bf16x8 tr_frag(clptr base, int P, int R0, int C0, int lane) {
    const int h = lane >> 5, blk = (lane >> 4) & 1, q = (lane & 15) >> 2, p = lane & 3;
    clptr a = base + (R0 + 8 * h + q) * P + (C0 + 16 * blk + 4 * p) * 2;
    const s16x4 lo = tr_read(a), hi = tr_read(a + 4 * P);
    return (bf16x8){lo[0], lo[1], lo[2], lo[3], hi[0], hi[1], hi[2], hi[3]};
}
__device__ __forceinline__ bf16x8 row_frag(clptr base, int P, int R0, int K0, int lane) {
    return *(const LAS bf16x8*)(base + (R0 + (lane & 31)) * P + (K0 + 8 * (lane >> 5)) * 2);
}
#define MFMA32(a, b, c) __builtin_amdgcn_mfma_f32_32x32x16_bf16((a), (b), (c), 0, 0, 0)
#define MFMA16(a, b, c) __builtin_amdgcn_mfma_f32_16x16x32_bf16((a), (b), (c), 0, 0, 0)

namespace pg8 {
#define PG8_LAS __attribute__((address_space(3)))
typedef unsigned short bf16_t;
typedef short bf16x8 __attribute__((ext_vector_type(8)));
typedef float f32x4 __attribute__((ext_vector_type(4)));
typedef unsigned u32x4 __attribute__((ext_vector_type(4)));
constexpr int BM = 256, BK = 64, HALF = 128, HTB = HALF * BK * 2  , STAGE_BYTES = 8 * HTB, NXCD = 8, WGM = 8;

__host__ __device__ __forceinline__ int lds_byte(int r, int c) { const int st = (r >> 4) * 2 + (c >> 5), rr = r & 15, cc = c & 31, ob = rr * 64 + cc * 2; return st * 1024 + (ob ^ (((ob >> 9) & 1) << 5)); }
__host__ __device__ __forceinline__ void stage_rc(int b, int& R, int& C) { const int st = b / 1024, sb = b % 1024, swz = sb ^ (((sb >> 9) & 1) << 5); R = (st >> 1) * 16 + swz / 64; C = (st & 1) * 32 + (swz % 64) / 2; }
__host__ __device__ __forceinline__ int perm32(int rho) { const int n = rho >> 4, i = rho & 15; return 8 * (i >> 2) + 4 * n + (i & 3); }

struct Unit { int pm, pn; };
struct Gemm { const bf16_t* A; const bf16_t* Bt; int M, N, K; };

struct StaticOrder {
    int nM, nN, nwg, G, c;
    __host__ __device__ void init(int M, int N, int G_, int c_) { nM = M / BM; nN = N / BM; nwg = nM * nN; G = G_; c = c_; }
    __host__ __device__ bool next(int i, Unit& u) const {
        const long L = (long)i * G + c; if (L >= nwg) return false;
        int wgid = (int)L; { const int q = nwg / NXCD, r = nwg % NXCD, xcd = wgid % NXCD, off = wgid / NXCD; wgid = (xcd < r ? xcd * (q + 1) : r * (q + 1) + (xcd - r) * q) + off; }
        const int nig = WGM * nN, gid = wgid / nig, fm = gid * WGM, gsz = (nM - fm) < WGM ? (nM - fm) : WGM;
        u.pm = fm + ((wgid % nig) % gsz); u.pn = (wgid % nig) / gsz; return true;
    }
    __device__ __forceinline__ void a_ready(const Unit&) const {}
    __device__ __forceinline__ void done(const Unit&) const {}
};

template <class Epi, class Sched, bool ALIGN_EPI = false, bool SP2 = false>
__device__ __forceinline__ void gemm_phase(PG8_LAS unsigned char* lds, const Gemm g, const Sched& S, const Epi& E) {
    int tid_o = threadIdx.x; asm volatile("" : "+v"(tid_o));
    const int tid = tid_o, wid = __builtin_amdgcn_readfirstlane(tid >> 6), lane = tid & 63, wr = wid >> 2, wc = wid & 3, fr = lane & 15, fq = lane >> 4;
    const int K = g.K, nt = K / BK;
    unsigned voffA[2], voffB[2];
#pragma unroll
    for (int i = 0; i < 2; ++i) { int R, C; stage_rc(tid * 16 + i * 8192, R, C); const int Rb = Epi::PERM ? ((R & ~31) + perm32(R & 31)) : R;
        voffA[i] = (unsigned)(R * K + C) * 2u; voffB[i] = (unsigned)(Rb * K + C) * 2u; }
    const size_t kstep = (size_t)(BK * 2);
    const size_t hstep = (size_t)HALF * K * 2;
    const size_t tstep = 2 * hstep;
    const unsigned ldsw = (unsigned)wid * 1024u;
    const int aoff = lds_byte(wr * 64 + fr, fq * 8), boff = lds_byte(wc * 32 + fr, fq * 8);
#define PG8_SA(b, h) (((b) * 2 + (h)) * HTB)
#define PG8_SB(b, h) ((4 + (b) * 2 + (h)) * HTB)
#define PG8_STAGE(bufoff, gbase, voff) do { _Pragma("unroll") for (int _i = 0; _i < 2; ++_i) \
        __builtin_amdgcn_global_load_lds((const unsigned*)((const char*)(gbase) + (voff)[_i]), (PG8_LAS unsigned*)(lds + (bufoff) + ldsw + _i * 8192), 16, 0, 0); } while (0)
#define PG8_LDA(dst, b, h) do { _Pragma("unroll") for (int m = 0; m < 4; ++m) _Pragma("unroll") for (int k = 0; k < 2; ++k) dst[m][k] = *(const PG8_LAS bf16x8*)(lds + PG8_SA(b, h) + aoff + m * 2048 + k * 1024); } while (0)
#define PG8_LDB(dst, b, h) do { _Pragma("unroll") for (int n = 0; n < 2; ++n) _Pragma("unroll") for (int k = 0; k < 2; ++k) dst[n][k] = *(const PG8_LAS bf16x8*)(lds + PG8_SB(b, h) + boff + n * 2048 + k * 1024); } while (0)
#define PG8_MMA(ai, bj, At, Bt) do { __builtin_amdgcn_s_setprio(1); _Pragma("unroll") for (int m = 0; m < 4; ++m) _Pragma("unroll") for (int n = 0; n < 2; ++n) _Pragma("unroll") for (int k = 0; k < 2; ++k) \
        acc[ai][bj][m][n] = __builtin_amdgcn_mfma_f32_16x16x32_bf16(Bt[n][k], At[m][k], acc[ai][bj][m][n], 0, 0, 0); __builtin_amdgcn_s_setprio(0); } while (0)
#define PG8_WAIT_V(n) asm volatile("s_waitcnt vmcnt(" #n ")" ::: "memory")
#define PG8_WAIT_L(n) asm volatile("s_waitcnt lgkmcnt(" #n ")" ::: "memory")
#define PG8_BAR __builtin_amdgcn_s_barrier()
#define PG8_SCHED __builtin_amdgcn_sched_barrier(0)
    Unit cur, nxt; int ui = 0;
    if (!S.next(0, cur)) return;
    f32x4 acc[2][2][4][2];
#pragma unroll
    for (int a = 0; a < 2; ++a)
#pragma unroll
        for (int b = 0; b < 2; ++b)
#pragma unroll
            for (int m = 0; m < 4; ++m)
#pragma unroll
                for (int n = 0; n < 2; ++n) acc[a][b][m][n] = (f32x4){0.f, 0.f, 0.f, 0.f};
    bf16x8 At[4][2], B0[2][2], B1[2][2];
    const char* cA = (const char*)g.A + (size_t)cur.pm * tstep; const char* cB = (const char*)g.Bt + (size_t)cur.pn * tstep;
    S.a_ready(cur);
    if constexpr (SP2) {
        PG8_STAGE(PG8_SB(0, 0), cB, voffB); PG8_STAGE(PG8_SB(0, 1), cB + hstep, voffB); PG8_STAGE(PG8_SA(0, 0), cA, voffA); PG8_STAGE(PG8_SA(0, 1), cA + hstep, voffA);
        if (wr == 1) PG8_BAR;
        PG8_WAIT_V(2); PG8_BAR;
        PG8_STAGE(PG8_SB(1, 0), cB + kstep, voffB); PG8_STAGE(PG8_SA(1, 0), cA + kstep, voffA); PG8_STAGE(PG8_SB(1, 1), cB + hstep + kstep, voffB);
        PG8_WAIT_V(6); PG8_BAR;
    } else {
        PG8_STAGE(PG8_SB(0, 0), cB, voffB); PG8_STAGE(PG8_SA(0, 0), cA, voffA); PG8_STAGE(PG8_SB(0, 1), cB + hstep, voffB); PG8_STAGE(PG8_SA(0, 1), cA + hstep, voffA);
        if (wr == 1) PG8_BAR;
        PG8_WAIT_V(4); PG8_BAR;
        PG8_STAGE(PG8_SB(1, 0), cB + kstep, voffB); PG8_STAGE(PG8_SA(1, 0), cA + kstep, voffA); PG8_STAGE(PG8_SB(1, 1), cB + hstep + kstep, voffB);
        PG8_WAIT_V(6); PG8_BAR;
    }
    for (;;) {
        const bool has_next = S.next(ui + 1, nxt);
        const char* nA = has_next ? (const char*)g.A + (size_t)nxt.pm * tstep : cA; const char* nB = has_next ? (const char*)g.Bt + (size_t)nxt.pn * tstep : cB;
        for (int t = 0; t < nt; t += 2) {
            const bool last = (t == nt - 2);
            const char* a1 = cA + (size_t)(t + 1) * kstep;
            const char* a2 = last ? nA : cA + (size_t)(t + 2) * kstep; const char* b2 = last ? nB : cB + (size_t)(t + 2) * kstep;
            const char* a3 = a2 + kstep; const char* b3 = b2 + kstep;
            if (last && has_next) S.a_ready(nxt);
            if constexpr (SP2) {
            PG8_LDB(B0, 0, 0); PG8_LDB(B1, 0, 1); PG8_SCHED; PG8_LDA(At, 0, 0); PG8_STAGE(PG8_SA(1, 1), a1 + hstep, voffA);
            PG8_WAIT_V(8); PG8_WAIT_L(0); PG8_BAR; PG8_MMA(0, 0, At, B0); PG8_MMA(0, 1, At, B1); PG8_BAR; PG8_SCHED;
            PG8_LDA(At, 0, 1); PG8_STAGE(PG8_SB(0, 0), b2, voffB); PG8_STAGE(PG8_SB(0, 1), b2 + hstep, voffB); PG8_STAGE(PG8_SA(0, 0), a2, voffA);
            PG8_WAIT_V(8); PG8_WAIT_L(0); PG8_BAR; PG8_MMA(1, 0, At, B0); PG8_MMA(1, 1, At, B1); PG8_BAR; PG8_SCHED;
            PG8_LDB(B0, 1, 0); PG8_LDB(B1, 1, 1); PG8_SCHED; PG8_LDA(At, 1, 0); PG8_STAGE(PG8_SA(0, 1), a2 + hstep, voffA);
            PG8_WAIT_V(8); PG8_WAIT_L(0); PG8_BAR; PG8_MMA(0, 0, At, B0); PG8_MMA(0, 1, At, B1); PG8_BAR; PG8_SCHED;
            PG8_LDA(At, 1, 1); PG8_STAGE(PG8_SB(1, 0), b3, voffB); PG8_STAGE(PG8_SB(1, 1), b3 + hstep, voffB); PG8_STAGE(PG8_SA(1, 0), a3, voffA);
            PG8_WAIT_V(8); PG8_WAIT_L(0); PG8_BAR; PG8_MMA(1, 0, At, B0); PG8_MMA(1, 1, At, B1); PG8_BAR; PG8_SCHED;
            } else {
            PG8_LDB(B0, 0, 0); PG8_SCHED; PG8_LDA(At, 0, 0); PG8_STAGE(PG8_SA(1, 1), a1 + hstep, voffA);
            PG8_WAIT_L(8); PG8_BAR; PG8_WAIT_L(0); PG8_MMA(0, 0, At, B0); PG8_BAR; PG8_SCHED;
            PG8_LDB(B1, 0, 1); PG8_STAGE(PG8_SB(0, 0), b2, voffB);
            PG8_BAR; PG8_WAIT_L(0); PG8_MMA(0, 1, At, B1); PG8_BAR;
            PG8_LDA(At, 0, 1); PG8_STAGE(PG8_SA(0, 0), a2, voffA);
            PG8_BAR; PG8_WAIT_L(0); PG8_MMA(1, 0, At, B0); PG8_BAR; PG8_SCHED;
            PG8_STAGE(PG8_SB(0, 1), b2 + hstep, voffB);
            PG8_WAIT_V(6); PG8_BAR; PG8_MMA(1, 1, At, B1); PG8_BAR;
            PG8_LDB(B0, 1, 0); PG8_SCHED; PG8_LDA(At, 1, 0); PG8_STAGE(PG8_SA(0, 1), a2 + hstep, voffA);
            PG8_WAIT_L(8); PG8_BAR; PG8_WAIT_L(0); PG8_MMA(0, 0, At, B0); PG8_BAR; PG8_SCHED;
            PG8_LDB(B1, 1, 1); PG8_STAGE(PG8_SB(1, 0), b3, voffB);
            PG8_BAR; PG8_WAIT_L(0); PG8_MMA(0, 1, At, B1); PG8_BAR;
            PG8_LDA(At, 1, 1); PG8_STAGE(PG8_SA(1, 0), a3, voffA);
            PG8_BAR; PG8_WAIT_L(0); PG8_MMA(1, 0, At, B0); PG8_BAR; PG8_SCHED;
            PG8_STAGE(PG8_SB(1, 1), b3 + hstep, voffB);
            PG8_WAIT_V(6); PG8_BAR; PG8_MMA(1, 1, At, B1); PG8_BAR;
            }
        }
        if constexpr (ALIGN_EPI) { if (wr == 0) PG8_BAR; }
        if constexpr (!Epi::AFTER_DRAIN) { E(acc, cur, wr, wc, fr, fq, lds); S.done(cur); }
        if (!has_next) break;
#pragma unroll
        for (int a = 0; a < 2; ++a)
#pragma unroll
            for (int b = 0; b < 2; ++b)
#pragma unroll
                for (int m = 0; m < 4; ++m)
#pragma unroll
                    for (int n = 0; n < 2; ++n) acc[a][b][m][n] = (f32x4){0.f, 0.f, 0.f, 0.f};
        cur = nxt; cA = nA; cB = nB; ++ui;
        if constexpr (ALIGN_EPI) { if (wr == 1) PG8_BAR; }
    }
    PG8_WAIT_V(0);
    if constexpr (!ALIGN_EPI) { if (wr == 0) PG8_BAR; }
    PG8_BAR;
    if constexpr (Epi::AFTER_DRAIN) { E.fused(acc, cur, wr, wc, fr, fq, lds, wid, lane); S.done(cur); }
#undef PG8_SA
#undef PG8_SB
#undef PG8_STAGE
#undef PG8_LDA
#undef PG8_LDB
#undef PG8_MMA
#undef PG8_WAIT_V
#undef PG8_WAIT_L
#undef PG8_BAR
#undef PG8_SCHED
}
}

__device__ __forceinline__ u32x4 pack8(const f32x4& v0, const f32x4& v1) { u32x4 w; w.x = cvtpk(v0[0], v0[1]); w.y = cvtpk(v0[2], v0[3]); w.z = cvtpk(v1[0], v1[1]); w.w = cvtpk(v1[2], v1[3]); return w; }

struct EpiProj {
    static constexpr bool PERM = true, AFTER_DRAIN = false;
    bf16_t* proj; float* outK; float* outV; const float* qw; const float* kw; int rowoff;
    __device__ __forceinline__ void sub(const f32x4 (&a)[2][4][2], int pn, int rloc0, int wc, int fr, int fq) const {
        const int kind = pn >> 1, half = pn & 1;
        const int c8 = 256 * half + 64 * wc + 8 * fq;
        bf16_t* ob = proj + (size_t)kind * (PROJ_STRIDE / 2);
        if (kind < 4) {
#pragma unroll
            for (int m = 0; m < 4; ++m) { const size_t row = (size_t)(rowoff + rloc0 + 16 * m + fr);
#pragma unroll
                for (int bj = 0; bj < 2; ++bj) { f32x4 v0 = a[bj][m][0], v1 = a[bj][m][1];
                    if (kind == 1) { v0 = v0 * 0.08838834764831845f; v1 = v1 * 0.08838834764831845f; }
                    if (kind == 3) {
#pragma unroll
                        for (int e = 0; e < 4; ++e) { v0[e] = sigmoidf_(v0[e]); v1[e] = sigmoidf_(v1[e]); } }
                    *(u32x4*)(ob + row * 512 + c8 + 32 * bj) = pack8(v0, v1); } }
        } else if (kind < 6) {
            const float* w = kind == 4 ? qw : kw; const float osc = kind == 4 ? 0.125f * LOG2E : 1.f;
            f32x4 wv[2][2];
#pragma unroll
            for (int bj = 0; bj < 2; ++bj)
#pragma unroll
                for (int n = 0; n < 2; ++n) wv[bj][n] = *(const f32x4*)(w + 32 * bj + 8 * fq + 4 * n);
#pragma unroll
            for (int m = 0; m < 4; ++m) { const int rl = rloc0 + 16 * m + fr; float ss = 0.f;
#pragma unroll
                for (int bj = 0; bj < 2; ++bj)
#pragma unroll
                    for (int n = 0; n < 2; ++n) { const f32x4 x = a[bj][m][n]; ss += (x[0] * x[0] + x[1] * x[1]) + (x[2] * x[2] + x[3] * x[3]); }
                ss += __shfl_xor(ss, 16); ss += __shfl_xor(ss, 32);
                const float rstd = rsqrtf(ss * (1.f / 64.f) + EPS);
#pragma unroll
                for (int bj = 0; bj < 2; ++bj) { f32x4 v0 = a[bj][m][0] * rstd * wv[bj][0], v1 = a[bj][m][1] * rstd * wv[bj][1];
                    if (kind == 5) { float* o = outK + (size_t)rl * 512 + c8 + 32 * bj; __builtin_nontemporal_store(v0, (f32x4*)o); __builtin_nontemporal_store(v1, (f32x4*)(o + 4)); }
                    v0 = v0 * osc; v1 = v1 * osc;
                    *(u32x4*)(ob + (size_t)(rowoff + rl) * 512 + c8 + 32 * bj) = pack8(v0, v1); } }
        } else {
#pragma unroll
            for (int m = 0; m < 4; ++m) { const int rl = rloc0 + 16 * m + fr;
#pragma unroll
                for (int bj = 0; bj < 2; ++bj) { const f32x4 v0 = a[bj][m][0], v1 = a[bj][m][1];
                    float* o = outV + (size_t)rl * 512 + c8 + 32 * bj; __builtin_nontemporal_store(v0, (f32x4*)o); __builtin_nontemporal_store(v1, (f32x4*)(o + 4));
                    *(u32x4*)(ob + (size_t)(rowoff + rl) * 512 + c8 + 32 * bj) = pack8(v0, v1); } }
        }
    }
    __device__ __forceinline__ void operator()(const f32x4 (&acc)[2][2][4][2], const pg8::Unit& u, int wr, int wc, int fr, int fq, lptr) const {
#pragma unroll
        for (int ai = 0; ai < 2; ++ai) sub(acc[ai], u.pn, u.pm * 256 + ai * 128 + wr * 64, wc, fr, fq);
    }
};

template <int MODE>
struct EpiRes {
    static constexpr bool PERM = true, AFTER_DRAIN = false;
    const void* xin; void* xout; const float* gate; int tlog;
    __device__ __forceinline__ void sub(const f32x4 (&a)[2][4][2], int pn, int rloc0, int wc, int fr, int fq) const {
#pragma unroll
        for (int m = 0; m < 4; ++m) { const int rl = rloc0 + 16 * m + fr; const float* g = gate + (size_t)(rl >> tlog) * 6144;
#pragma unroll
            for (int bj = 0; bj < 2; ++bj) { const int c = 256 * pn + 128 * bj + 32 * wc + 8 * fq;
                const f32x4 g0 = *(const f32x4*)(g + c), g1 = *(const f32x4*)(g + c + 4);
                if (MODE == 0) {
                    const float* xp = (const float*)xin + (size_t)rl * 1024 + c;
                    const f32x4 o0 = *(const f32x4*)xp + g0 * a[bj][m][0], o1 = *(const f32x4*)(xp + 4) + g1 * a[bj][m][1];
                    *(u32x4*)((bf16_t*)xout + (size_t)rl * 1024 + c) = pack8(o0, o1);
                } else {
                    const u32x4 xv = *(const u32x4*)((const bf16_t*)xin + (size_t)rl * 1024 + c);
                    const f32x4 x0 = {bflo(xv.x), bfhi(xv.x), bflo(xv.y), bfhi(xv.y)}, x1 = {bflo(xv.z), bfhi(xv.z), bflo(xv.w), bfhi(xv.w)};
                    float* op = (float*)xout + (size_t)rl * 1024 + c;
                    __builtin_nontemporal_store(x0 + g0 * a[bj][m][0], (f32x4*)op); __builtin_nontemporal_store(x1 + g1 * a[bj][m][1], (f32x4*)(op + 4));
                } } }
    }
    __device__ __forceinline__ void operator()(const f32x4 (&acc)[2][2][4][2], const pg8::Unit& u, int wr, int wc, int fr, int fq, lptr) const {
#pragma unroll
        for (int ai = 0; ai < 2; ++ai) sub(acc[ai], u.pn, u.pm * 256 + ai * 128 + wr * 64, wc, fr, fq);
    }
};

__device__ __forceinline__ float dpp_ror1(float x) { return __int_as_float(__builtin_amdgcn_update_dpp(0, __float_as_int(x), 0x121, 0xf, 0xf, false)); }
__device__ __forceinline__ float dpp_ror2(float x) { return __int_as_float(__builtin_amdgcn_update_dpp(0, __float_as_int(x), 0x122, 0xf, 0xf, false)); }
struct ConvW { f32x4 w0a, w1a, w2a, ba, w0g, w1g, w2g, bg; };
__device__ __forceinline__ ConvW load_convw(const float* wconv, const float* bconv, int c) {
    ConvW w; w.w0a = *(const f32x4*)(wconv + c); w.w1a = *(const f32x4*)(wconv + FF2 + c); w.w2a = *(const f32x4*)(wconv + 2 * FF2 + c); w.ba = *(const f32x4*)(bconv + c);
    w.w0g = *(const f32x4*)(wconv + FF + c); w.w1g = *(const f32x4*)(wconv + FF2 + FF + c); w.w2g = *(const f32x4*)(wconv + 2 * FF2 + FF + c); w.bg = *(const f32x4*)(bconv + FF + c); return w;
}
template <int CTRL> __device__ __forceinline__ float dppz(float x) { return __int_as_float(__builtin_amdgcn_update_dpp(0, __float_as_int(x), CTRL, 0xf, 0xf, true)); }
__device__ __forceinline__ u32x2 conv_gate4(const f32x4& ca, const f32x4& cg, const f32x4& pa, const f32x4& pg, const ConvW& w, int) {
    float o[4];
#pragma unroll
    for (int e = 0; e < 4; ++e) {
        float ua = fmaf(w.w2a[e], ca[e], w.ba[e]);
        ua = fmaf(dppz<0x111>(ca[e]), w.w1a[e], ua); ua = fmaf(dppz<0x10F>(pa[e]), w.w1a[e], ua);
        ua = fmaf(dppz<0x112>(ca[e]), w.w0a[e], ua); ua = fmaf(dppz<0x10E>(pa[e]), w.w0a[e], ua);
        float ug = fmaf(w.w2g[e], cg[e], w.bg[e]);
        ug = fmaf(dppz<0x111>(cg[e]), w.w1g[e], ug); ug = fmaf(dppz<0x10F>(pg[e]), w.w1g[e], ug);
        ug = fmaf(dppz<0x112>(cg[e]), w.w0g[e], ug); ug = fmaf(dppz<0x10E>(pg[e]), w.w0g[e], ug);
        o[e] = ua * sigmoidf_(ua) * ug;
    }
    u32x2 r; r.x = cvtpk(o[0], o[1]); r.y = cvtpk(o[2], o[3]); return r;
}
struct EpiFFN {
    static constexpr bool PERM = true, AFTER_DRAIN = false;
    bf16_t* act; float* uedge; float* outF; const float* wconv; const float* bconv;
    __device__ __forceinline__ void operator()(const f32x4 (&acc)[2][2][4][2], const pg8::Unit& u, int wr, int wc, int fr, int fq, lptr lds) const {
        lptr halo = lds + pg8::STAGE_BYTES;
        const int q8 = 32 * wc + 8 * fq;
        if (fr >= 14) {
#pragma unroll
            for (int ai = 0; ai < 2; ++ai)
#pragma unroll
                for (int bj = 0; bj < 2; ++bj)
#pragma unroll
                    for (int n = 0; n < 2; ++n) *(LAS f32x4*)(halo + ((((2 * ai + wr) * 2 + (fr - 14)) * 256 + 128 * bj + q8 + 4 * n) * 4)) = acc[ai][bj][3][n];
        }
        asm volatile("s_waitcnt lgkmcnt(0)" ::: "memory"); __builtin_amdgcn_s_barrier(); asm volatile("" ::: "memory");
#pragma unroll
        for (int n = 0; n < 2; ++n) {
            const int c = 128 * u.pn + q8 + 4 * n;
            const ConvW w = load_convw(wconv, bconv, c);
#pragma unroll
            for (int ai = 0; ai < 2; ++ai) {
                const int G = 2 * ai + wr;
                f32x4 pa = {0.f, 0.f, 0.f, 0.f}, pg = {0.f, 0.f, 0.f, 0.f};
                if (G > 0 && fr >= 14) { pa = *(const LAS f32x4*)(halo + ((((G - 1) * 2 + (fr - 14)) * 256 + q8 + 4 * n) * 4)); pg = *(const LAS f32x4*)(halo + ((((G - 1) * 2 + (fr - 14)) * 256 + 128 + q8 + 4 * n) * 4)); }
#pragma unroll
                for (int m = 0; m < 4; ++m) {
                    const f32x4 ca = acc[ai][0][m][n], cg = acc[ai][1][m][n];
                    const f32x4 qa = m ? acc[ai][0][m ? m - 1 : 0][n] : pa, qg = m ? acc[ai][1][m ? m - 1 : 0][n] : pg;
                    const u32x2 o = conv_gate4(ca, cg, qa, qg, w, fr);
                    const size_t row = (size_t)u.pm * 256 + 64 * G + 16 * m + fr;
                    *(u32x2*)(act + row * FF + c) = o;
                    if (m == 0 && G == 0 && fr < 2) { float* e = uedge + ((size_t)u.pm * 4 + fr) * FF2 + c; *(f32x4*)e = ca; *(f32x4*)(e + FF) = cg; }
                    if (m == 3 && G == 3 && fr >= 14) { float* e = uedge + ((size_t)u.pm * 4 + 2 + (fr - 14)) * FF2 + c; *(f32x4*)e = ca; *(f32x4*)(e + FF) = cg;
                        if ((u.pm & 15) == 15) { float* f = outF + ((size_t)(u.pm >> 4) * 2 + (fr - 14)) * FF2 + c; *(f32x4*)f = ca; *(f32x4*)(f + FF) = cg; } }
                }
            }
        }
    }
};
struct EpiFFNs {
    bf16_t* act; float* outF; const float* state; const float* wconv; const float* bconv;
    __device__ __forceinline__ void sub(const f32x4 (&a)[2][4][2], int pn, int rloc0, int wc, int fr, int fq) const {
        const int q8 = 32 * wc + 8 * fq;
#pragma unroll
        for (int n = 0; n < 2; ++n) {
            const int c = 128 * pn + q8 + 4 * n;
            const ConvW w = load_convw(wconv, bconv, c);
#pragma unroll
            for (int m = 0; m < 4; ++m) {
                const int b = (rloc0 + 16 * m) >> 5;
                const f32x4 ca = a[0][m][n], cg = a[1][m][n];
                f32x4 qa = {0.f, 0.f, 0.f, 0.f}, qg = {0.f, 0.f, 0.f, 0.f};
                if (m & 1) { qa = a[0][m ? m - 1 : 0][n]; qg = a[1][m ? m - 1 : 0][n]; }
                else if (fr >= 14) { const float* s = state + ((size_t)b * 2 + (fr - 14)) * FF2 + c; qa = *(const f32x4*)s; qg = *(const f32x4*)(s + FF); }
                const u32x2 o = conv_gate4(ca, cg, qa, qg, w, fr);
                const size_t row = (size_t)MP + rloc0 + 16 * m + fr;
                *(u32x2*)(act + row * FF + c) = o;
                if ((m & 1) && fr >= 14) { float* f = outF + ((size_t)b * 2 + (fr - 14)) * FF2 + c; *(f32x4*)f = ca; *(f32x4*)(f + FF) = cg; }
            }
        }
    }
};

template <int K, bool HISCALE, class Epi>
__device__ __forceinline__ void small_tile(const bf16_t* __restrict__ A, const bf16_t* __restrict__ Bt, const Epi& E, const float* ssq, lptr lds, int t, int tid, int lane, int wave) {
    constexpr int KW = K / 8;
    const int fr = lane & 15, fq = lane >> 4;
    const int wc = t & 3, G = (t >> 2) & 3, pn = t >> 4;
    f32x4 acc[2][4][2];
#pragma unroll
    for (int bj = 0; bj < 2; ++bj)
#pragma unroll
        for (int m = 0; m < 4; ++m)
#pragma unroll
            for (int n = 0; n < 2; ++n) acc[bj][m][n] = (f32x4){0.f, 0.f, 0.f, 0.f};
    const bf16_t* ap = A + (size_t)(G * 64 + fr) * K + fq * 8 + wave * KW;
    const bf16_t* bp = Bt + (size_t)(256 * pn + 32 * wc + 8 * (fr >> 2) + (fr & 3)) * K + fq * 8 + wave * KW;
#ifdef DBLK
    for (int rep = 0; rep < 2; ++rep) {
    if (rep == 1) {
_Pragma("unroll") for (int bj = 0; bj < 2; ++bj) _Pragma("unroll") for (int m = 0; m < 4; ++m) _Pragma("unroll") for (int n = 0; n < 2; ++n) acc[bj][m][n] = acc[bj][m][n] * 0.f; asm volatile("" ::: "memory"); }
#endif
#pragma unroll 4
    for (int k0 = 0; k0 < KW; k0 += 32) {
        bf16x8 af[4], bf[2][2];
#pragma unroll
        for (int m = 0; m < 4; ++m) af[m] = *(const bf16x8*)(ap + (size_t)(16 * m) * K + k0);
#pragma unroll
        for (int bj = 0; bj < 2; ++bj)
#pragma unroll
            for (int n = 0; n < 2; ++n) bf[bj][n] = *(const bf16x8*)(bp + (size_t)(128 * bj + 4 * n) * K + k0);
#pragma unroll
        for (int bj = 0; bj < 2; ++bj)
#pragma unroll
            for (int m = 0; m < 4; ++m)
#pragma unroll
                for (int n = 0; n < 2; ++n) acc[bj][m][n] = MFMA16(bf[bj][n], af[m], acc[bj][m][n]);
    }
#ifdef DBLK
    }
#endif
    if (HISCALE) { if (wave >= 4) {
#pragma unroll
        for (int m = 0; m < 4; ++m) { const float* sp = ssq + (size_t)(MP + G * 64 + 16 * m + fr) * 8; const f32x4 s0 = *(const f32x4*)sp, s1 = *(const f32x4*)(sp + 4);
            const float rstd = rsqrtf(((s0.x + s0.y) + (s0.z + s0.w) + (s1.x + s1.y) + (s1.z + s1.w)) * (1.f / 512.f) + EPS);
#pragma unroll
            for (int bj = 0; bj < 2; ++bj)
#pragma unroll
                for (int n = 0; n < 2; ++n) acc[bj][m][n] = acc[bj][m][n] * rstd; } } }
    __syncthreads();
    if (wave != 0) {
#pragma unroll
        for (int bj = 0; bj < 2; ++bj)
#pragma unroll
            for (int m = 0; m < 4; ++m)
#pragma unroll
                for (int n = 0; n < 2; ++n) *(LAS f32x4*)(lds + ((((wave - 1) * 16 + (bj * 4 + m) * 2 + n) * 64 + lane) * 16)) = acc[bj][m][n];
    }
    __syncthreads();
    if (wave == 0) {
#pragma unroll 1
        for (int w2 = 0; w2 < 7; ++w2)
#pragma unroll
            for (int bj = 0; bj < 2; ++bj)
#pragma unroll
                for (int m = 0; m < 4; ++m)
#pragma unroll
                    for (int n = 0; n < 2; ++n) acc[bj][m][n] = acc[bj][m][n] + *(const LAS f32x4*)(lds + (((w2 * 16 + (bj * 4 + m) * 2 + n) * 64 + lane) * 16));
        E.sub(acc, pn, G * 64, wc, fr, fq);
#ifdef DBLE
        asm volatile("" ::: "memory"); E.sub(acc, pn, G * 64, wc, fr, fq);
#endif
    }
    __syncthreads();
}

typedef unsigned v4u __attribute__((ext_vector_type(4)));
#define XB_TMO      128
#define XB_XCNT(j)  (256  + 64 * (j))
#define XB_XSUB(j)  (1280 + 64 * (j))
#define XB_XGEN(j)  (2304 + 64 * (j))
#define XB_TOP      3328
#define XB_TOPGEN   3392
#define XCD_BAR_WORDS 3456
#define XB_SPIN_CAP (1u << 18)

__device__ __forceinline__ unsigned xb_ld(unsigned* p)              { return __hip_atomic_load(p, __ATOMIC_RELAXED, __HIP_MEMORY_SCOPE_AGENT); }
__device__ __forceinline__ unsigned xb_add(unsigned* p, unsigned v) { return __hip_atomic_fetch_add(p, v, __ATOMIC_RELAXED, __HIP_MEMORY_SCOPE_AGENT); }
__device__ __forceinline__ unsigned xb_xcc_id() { return (unsigned)__builtin_amdgcn_s_getreg((3 << 11) | 20) & 0xFu; }
#define XB_SPIN(cond, bar) do { unsigned _sp = 0; while (cond) { __builtin_amdgcn_s_sleep(1); \
    if ((++_sp & 255u) == 0u) { if (xb_ld(&(bar)[XB_TMO])) break; if (_sp > XB_SPIN_CAP) { atomicAdd(&(bar)[XB_TMO], 1u); break; } } } } while (0)

struct XcdBarrier {
    unsigned* bar; unsigned x;
    volatile LAS unsigned* st;
};

__device__ __forceinline__ XcdBarrier xcd_barrier_post(unsigned* bar, volatile LAS unsigned* st) {
    XcdBarrier b; b.bar = bar; b.x = xb_xcc_id(); b.st = st;
    if (threadIdx.x == 0) st[2] = xb_add(&bar[XB_XCNT(b.x)], 1u);
    return b;
}
__device__ __forceinline__ void xcd_barrier_complete(unsigned* bar, unsigned x, unsigned& nloc, unsigned& nx) {
    const unsigned G = gridDim.x * gridDim.y * gridDim.z;
    unsigned sum, cnt, mine, sp = 0u;
    for (;;) {
        sum = 0u; cnt = 0u; mine = 0u;
#pragma unroll
        for (unsigned j = 0; j < 16; ++j) { const unsigned c = xb_ld(&bar[XB_XCNT(j)]); sum += c; cnt += (c > 0u) ? 1u : 0u; mine = (j == x) ? c : mine; }
        if (sum == G) break;
        __builtin_amdgcn_s_sleep(1);
        if ((++sp & 255u) == 0u) { if (xb_ld(&bar[XB_TMO])) break; if (sp > XB_SPIN_CAP) { atomicAdd(&bar[XB_TMO], 1u); break; } }
    }
    nloc = mine > 0u ? mine : 1u; nx = cnt > 0u ? cnt : 1u;
}

__device__ __forceinline__ void xcd_barrier(const XcdBarrier& b) {
    asm volatile("s_waitcnt vmcnt(0)" ::: "memory");
    __syncthreads();
    if (threadIdx.x == 0) {
        unsigned* bar = b.bar;
        __builtin_amdgcn_s_waitcnt(0);
        unsigned nloc = b.st[0], nx = b.st[1];
        if (nloc == 0u) { xcd_barrier_complete(bar, b.x, nloc, nx); b.st[0] = nloc; b.st[1] = nx; }
        const unsigned old = xb_add(&bar[XB_XSUB(b.x)], 1u);
        const unsigned gen = old / nloc;
        if (old + 1u == (gen + 1u) * nloc) {
            __builtin_amdgcn_fence(__ATOMIC_RELEASE, "agent");
            asm volatile("s_waitcnt vmcnt(0)" ::: "memory");
            const unsigned og = xb_add(&bar[XB_TOP], 1u);
            const unsigned tg = og / nx;
            if (og + 1u == (tg + 1u) * nx) xb_add(&bar[XB_TOPGEN], 1u);
            else XB_SPIN(xb_ld(&bar[XB_TOPGEN]) == tg, bar);
            __builtin_amdgcn_fence(__ATOMIC_ACQUIRE, "agent");
            xb_add(&bar[XB_XGEN(b.x)], 1u);
            asm volatile("s_waitcnt vmcnt(0)" ::: "memory");
        } else {
            XB_SPIN(xb_ld(&bar[XB_XGEN(b.x)]) == gen, bar);
            __builtin_amdgcn_fence(__ATOMIC_ACQUIRE, "agent");
            asm volatile("s_waitcnt vmcnt(0)" ::: "memory");
        }
    }
    __syncthreads();
}


__device__ __forceinline__ void transpose_item(const float* __restrict__ W, int ldw, int srccol0, bf16_t* __restrict__ WT, int K, int destrow0, int k0, LAS float* scr, int lane, const float* kscale = nullptr) {
#pragma unroll 16
    for (int i = 0; i < 32; ++i) { const int kk = 2 * i + (lane >> 5); scr[kk * 33 + (lane & 31)] = W[(size_t)(k0 + kk) * ldw + srccol0 + (lane & 31)] * (kscale ? kscale[k0 + kk] : 1.f); }
    asm volatile("s_waitcnt lgkmcnt(0)" ::: "memory");
    const int c = lane & 7;
#pragma unroll
    for (int j = 0; j < 4; ++j) { const int n = (lane >> 3) + 8 * j; const LAS float* s = scr + (8 * c) * 33 + n;
        u32x4 o; o.x = cvtpk(s[0 * 33], s[1 * 33]); o.y = cvtpk(s[2 * 33], s[3 * 33]); o.z = cvtpk(s[4 * 33], s[5 * 33]); o.w = cvtpk(s[6 * 33], s[7 * 33]);
        *(u32x4*)(WT + (size_t)(destrow0 + n) * K + k0 + 8 * c) = o; }
    asm volatile("s_waitcnt lgkmcnt(0)" ::: "memory");
}

__device__ __forceinline__ void phase_weights(const Params& P, lptr lds, int lane, int wave) {
    unsigned char* ws = P.ws;
    LAS float* scr = (LAS float*)(lds + wave * 16384);
    const int gw = blockIdx.x * 8 + wave, NGW = gridDim.x * 8;
    constexpr int I1 = 16 * 112, I2 = 16 * 32, I3 = 16 * 176, I4 = 44 * 32;
    for (int it = gw; it < I1 + I2 + I3 + I4; it += NGW) {
        int r = it;
        if (r < I1) { const int kb = r / 112, n0 = (r % 112) * 32, tile = n0 >> 8, p = n0 & 255, wc = (p >> 5) & 3, bj = p >> 7, L = tile * 256 + 64 * wc + 32 * bj;
            transpose_item(P.in[I_WIN], DIN, L < 2048 ? L : L + 8, (bf16_t*)(ws + WS_W1T), 1024, n0, kb * 64, scr, lane); continue; }
        r -= I1;
        if (r < I2) { const int kb = r / 32, n0 = (r % 32) * 32; transpose_item(P.in[I_WOUT], 1024, n0, (bf16_t*)(ws + WS_W2T), 1024, n0, kb * 64, scr, lane, kb >= 8 ? P.in[I_SOW] - 512 : nullptr); continue; }
        r -= I2;
        if (r < I3) { const int kb = r / 176, n0 = (r % 176) * 32, pn = n0 >> 8, p = n0 & 255, bj = p >> 7, q0 = p & 127;
            transpose_item(P.in[I_WUP], FF2, 128 * pn + q0 + FF * bj, (bf16_t*)(ws + WS_W3T), 1024, n0, kb * 64, scr, lane); continue; }
        r -= I3;
        { const int kb = r / 32, n0 = (r % 32) * 32; transpose_item(P.in[I_WDOWN], 1024, n0, (bf16_t*)(ws + WS_W4T), FF, n0, kb * 64, scr, lane); }
    }
}

__device__ __forceinline__ void phase0(const Params& P, lptr lds, int tid, int lane, int wave) {
    unsigned char* ws = P.ws;
    LAS float* sc = (LAS float*)lds;
    for (int i = tid; i < 16384; i += 512) { const int r = i >> 10, k = i & 1023; const float c = r < 8 ? P.in[I_CP][r * 1024 + k] : P.in[I_CS][(r - 8) * 1024 + k]; sc[i] = c / (1.f + __expf(-c)); }
    __syncthreads();
    const int job = blockIdx.x * 512 + tid;
    if (job < 16 * 6144) {
        const int ks = job / 6144, n = job % 6144;
        float acc[16];
#pragma unroll
        for (int r = 0; r < 16; ++r) acc[r] = 0.f;
        const float* wp = P.in[I_WADA] + (size_t)(ks * 64) * 6144 + n;
#pragma unroll 16
        for (int k = 0; k < 64; ++k) { const float w = wp[(size_t)k * 6144];
#pragma unroll
            for (int r = 0; r < 16; ++r) acc[r] += sc[r * 1024 + ks * 64 + k] * w; }
        float* mp = (float*)(ws + WS_MODP);
#pragma unroll
        for (int r = 0; r < 16; ++r) mp[(size_t)(ks * 16 + r) * 6144 + n] = acc[r];
    }
}

__device__ __forceinline__ void load_mod_vectors(const Params& P, LAS float* A, LAS float* S, const float* normw, int r, int shofs, int tid) {
    const float* mp = (const float*)(P.ws + WS_MODP); const float* ba = P.in[I_BADA];
    for (int k = tid; k < 1024; k += 512) {
        float sh = ba[shofs + k], scv = ba[shofs + 1024 + k];
#pragma unroll
        for (int ks = 0; ks < 16; ++ks) { sh += mp[(size_t)(ks * 16 + r) * 6144 + shofs + k]; scv += mp[(size_t)(ks * 16 + r) * 6144 + shofs + 1024 + k]; }
        A[k] = normw[k] * (1.f + scv); S[k] = sh;
    }
}
__device__ __forceinline__ void load_row_bf(const bf16_t* xrow, int lane, f32x4 (&v)[4]) {
#pragma unroll
    for (int j = 0; j < 4; ++j) { const u32x2 w = ((const u32x2*)xrow)[lane + 64 * j]; v[j] = (f32x4){bflo(w.x), bfhi(w.x), bflo(w.y), bfhi(w.y)}; }
}
__device__ __forceinline__ void load_row(const float* xrow, int lane, f32x4 (&v)[4]) {
#pragma unroll
    for (int j = 0; j < 4; ++j) v[j] = ((const f32x4*)xrow)[lane + 64 * j];
}
template <bool GATES>
__device__ __forceinline__ void norm_row(const Params& P, const f32x4 (&v)[4], bf16_t* orow, float* grow, const LAS float* A, const LAS float* S, const LAS float* Wg, int lane) {
    float s = 0.f;
#pragma unroll
    for (int j = 0; j < 4; ++j) s += (v[j].x * v[j].x + v[j].y * v[j].y) + (v[j].z * v[j].z + v[j].w * v[j].w);
    const float rstd = rsqrtf(wave_sum(s) * (1.f / 1024.f) + EPS);
    float g[8];
#pragma unroll
    for (int i = 0; i < 8; ++i) g[i] = 0.f;
#pragma unroll
    for (int j = 0; j < 4; ++j) { const int k0 = 4 * lane + 256 * j;
        const f32x4 a = *(const LAS f32x4*)(A + k0), sh = *(const LAS f32x4*)(S + k0);
        const f32x4 hv = v[j] * rstd * a + sh;
        u32x2 o; o.x = cvtpk(hv.x, hv.y); o.y = cvtpk(hv.z, hv.w);
        *(u32x2*)(orow + k0) = o;
        if (GATES) {
#pragma unroll
            for (int i = 0; i < 8; ++i) { const f32x4 w = *(const LAS f32x4*)(Wg + i * 1024 + k0); g[i] += (hv.x * w.x + hv.y * w.y) + (hv.z * w.z + hv.w * w.w); } }
    }
    if (GATES) {
        { const bool hi = (lane & 32) != 0;
#pragma unroll
          for (int i = 0; i < 4; ++i) { const float send = hi ? g[i] : g[i + 4], keep = hi ? g[i + 4] : g[i]; g[i] = keep + __shfl_xor(send, 32); } }
        { const bool hi = (lane & 16) != 0;
#pragma unroll
          for (int i = 0; i < 2; ++i) { const float send = hi ? g[i] : g[i + 2], keep = hi ? g[i + 2] : g[i]; g[i] = keep + __shfl_xor(send, 16); } }
        { const bool hi = (lane & 8) != 0; const float send = hi ? g[0] : g[1], keep = hi ? g[1] : g[0]; g[0] = keep + __shfl_xor(send, 8); }
        g[0] += __shfl_xor(g[0], 4); g[0] += __shfl_xor(g[0], 2); g[0] += __shfl_xor(g[0], 1);
        const int gt = lane >> 3;
        if ((lane & 7) == 0) {
            float o;
            if (gt < 4) o = g[0] + P.in[I_BIG][gt];
            else { const float x = g[0] + P.in[I_BFG][gt - 4]; o = fminf(x, 0.f) - log1pf(expf(-fabsf(x))); }
            grow[gt] = o;
        }
    }
}
__device__ __forceinline__ void phase1(const Params& P, lptr lds, int tid, int lane, int wave) {
    LAS float* A1 = (LAS float*)lds; LAS float* S1 = A1 + 1024; LAS float* Wg = S1 + 1024;
    for (int k = tid; k < 1024; k += 512) { const f32x4 w0 = *(const f32x4*)(P.in[I_WIN] + (size_t)k * DIN + 2048), w1 = *(const f32x4*)(P.in[I_WIN] + (size_t)k * DIN + 2052);
        Wg[k] = w0.x; Wg[1024 + k] = w0.y; Wg[2048 + k] = w0.z; Wg[3072 + k] = w0.w; Wg[4096 + k] = w1.x; Wg[5120 + k] = w1.y; Wg[6144 + k] = w1.z; Wg[7168 + k] = w1.w; }
    if (tid < 384) { const int e = blockIdx.x * 384 + tid, r = e / 6144, n = e % 6144; const float* mp = (const float*)(P.ws + WS_MODP); float s = P.in[I_BADA][n];
#pragma unroll
        for (int ks = 0; ks < 16; ++ks) s += mp[(size_t)(ks * 16 + r) * 6144 + n];
        ((float*)(P.ws + WS_MOD))[e] = s; }
    load_mod_vectors(P, A1, S1, P.in[I_N1W], blockIdx.x >> 5, 0, tid);
    LAS float* A1s = Wg + 8192; LAS float* S1s = A1s + 1024;
    load_mod_vectors(P, A1s, S1s, P.in[I_N1W], 8 + (blockIdx.x >> 5), 0, tid);
    __syncthreads();
    bf16_t* H = (bf16_t*)(P.ws + WS_H); float* GT = (float*)(P.ws + WS_GATES);
    { const size_t row0 = (size_t)blockIdx.x * 128 + wave * 16; f32x4 v[4], vn[4]; load_row(P.in[I_XP] + row0 * 1024, lane, v);
#pragma unroll 1
      for (int j = 0; j < 16; ++j) { const size_t row = row0 + j;
          if (j + 1 < 16) load_row(P.in[I_XP] + (row + 1) * 1024, lane, vn);
          else if (wave == 0) load_row(P.in[I_XS] + (size_t)blockIdx.x * 1024, lane, vn);
          norm_row<true>(P, v, H + row * 1024, GT + row * 8, A1, S1, Wg, lane);
#pragma unroll
          for (int q = 0; q < 4; ++q) v[q] = vn[q]; }
      if (wave == 0) norm_row<true>(P, v, H + ((size_t)MP + blockIdx.x) * 1024, GT + ((size_t)MP + blockIdx.x) * 8, A1s, S1s, Wg, lane); }
}
__device__ __forceinline__ void phase5(const Params& P, lptr lds, int tid, int lane, int wave) {
    LAS float* A1 = (LAS float*)lds; LAS float* S1 = A1 + 1024;
    load_mod_vectors(P, A1, S1, P.in[I_N2W], blockIdx.x >> 5, 3072, tid);
    __syncthreads();
    bf16_t* H = (bf16_t*)(P.ws + WS_H);
    { const size_t row0 = (size_t)blockIdx.x * 128 + wave * 16; const bf16_t* X1 = (const bf16_t*)(P.ws + WS_X1B); f32x4 v[4], vn[4]; load_row_bf(X1 + row0 * 1024, lane, v);
#pragma unroll 1
      for (int j = 0; j < 16; ++j) { const size_t row = row0 + j;
          if (j + 1 < 16) load_row_bf(X1 + (row + 1) * 1024, lane, vn);
          norm_row<false>(P, v, H + row * 1024, nullptr, A1, S1, nullptr, lane);
#pragma unroll
          for (int q = 0; q < 4; ++q) v[q] = vn[q]; } }
    __syncthreads();
}
__device__ __forceinline__ void sample_h2_row(const Params& P, lptr lds, int tid, int lane, int wave) {
    LAS float* A1 = (LAS float*)lds; LAS float* S1 = A1 + 1024;
    load_mod_vectors(P, A1, S1, P.in[I_N2W], 8 + (blockIdx.x >> 5), 3072, tid);
    __syncthreads();
    if (wave == 0) { f32x4 v[4]; load_row_bf((const bf16_t*)(P.ws + WS_X1B) + ((size_t)MP + blockIdx.x) * 1024, lane, v); norm_row<false>(P, v, (bf16_t*)(P.ws + WS_H) + ((size_t)MP + blockIdx.x) * 1024, nullptr, A1, S1, nullptr, lane); }
    __syncthreads();
}
__device__ __forceinline__ void phase3b(const Params& P, int lane, int gw, int NGW) {
    bf16_t* Y = (bf16_t*)(P.ws + WS_YCAT); const float* SSQ = (const float*)(P.ws + WS_SSQ);
    for (int row = gw; row < MP; row += NGW) {
        const f32x4 s0 = *(const f32x4*)(SSQ + (size_t)row * 8), s1 = *(const f32x4*)(SSQ + (size_t)row * 8 + 4);
        const float rstd = rsqrtf(((s0.x + s0.y) + (s0.z + s0.w) + (s1.x + s1.y) + (s1.z + s1.w)) * (1.f / 512.f) + EPS);
        u32x4* p = (u32x4*)(Y + (size_t)row * 1024 + 512 + 8 * lane); const u32x4 o = *p;
        f32x4 a = {bflo(o.x), bfhi(o.x), bflo(o.y), bfhi(o.y)}, b = {bflo(o.z), bfhi(o.z), bflo(o.w), bfhi(o.w)};
        a = a * rstd; b = b * rstd;
        *p = pack8(a, b);
    }
}
__device__ __forceinline__ void phase_fix(const Params& P, int tid) {
    const float* UE = (const float*)(P.ws + WS_UEDGE); bf16_t* act = (bf16_t*)(P.ws + WS_ACT);
    const float* wc = P.in[I_WCONV]; const float* bc = P.in[I_BCONV];
    const int total = 128 * 2 * FF;
    for (int i = blockIdx.x * 512 + tid; i < total; i += gridDim.x * 512) {
        const int j = i % FF, rr = (i / FF) & 1, pm = i / (2 * FF);
        if ((pm & 15) == 0) continue;
        float uc[2];
#pragma unroll
        for (int hf = 0; hf < 2; ++hf) { const int c = j + hf * FF;
            const float um2 = rr == 0 ? UE[((size_t)(pm - 1) * 4 + 2) * FF2 + c] : UE[((size_t)(pm - 1) * 4 + 3) * FF2 + c];
            const float um1 = rr == 0 ? UE[((size_t)(pm - 1) * 4 + 3) * FF2 + c] : UE[((size_t)pm * 4 + 0) * FF2 + c];
            const float u0 = UE[((size_t)pm * 4 + rr) * FF2 + c];
            uc[hf] = bc[c] + wc[2 * FF2 + c] * u0 + wc[FF2 + c] * um1 + wc[c] * um2; }
        act[((size_t)pm * 256 + rr) * FF + j] = f2bf(uc[0] * sigmoidf_(uc[0]) * uc[1]);
    }
}

constexpr int ML_P = 272;
constexpr int ML_QS = 0, ML_KS = 17408, ML_VS = 34816, ML_VW = 52224, ML_CS = 69632, ML_SS = 104448, ML_SC = 113664;
__device__ __forceinline__ void mlstm_item(const Params& P, lptr lds, int bh, bool sample, int tid, int lane, int wave) {
    const int b = bh >> 2, h = bh & 3, hh = lane >> 5, n31 = lane & 31;
    const size_t rowbase = sample ? (size_t)MP + b * 32 : (size_t)b * SEQ;
    const int nch = sample ? 1 : 64, L = sample ? 32 : 64;
    const bf16_t* MQ = (const bf16_t*)(P.ws + WS_PROJ); const bf16_t* MK = (const bf16_t*)(P.ws + WS_PROJ + PROJ_STRIDE); const bf16_t* MV = (const bf16_t*)(P.ws + WS_PROJ + 2 * PROJ_STRIDE);
    const bf16_t* MO = (const bf16_t*)(P.ws + WS_PROJ + 3 * PROJ_STRIDE); const float* GT = (const float*)(P.ws + WS_GATES); bf16_t* YC = (bf16_t*)(P.ws + WS_YCAT);
    LAS float* sc = (LAS float*)(lds + ML_SC);
    LAS float* bt = sc, *as_ = sc + 64, *mt = sc + 128, *winter = sc + 192, *emt = sc + 256, *wk = sc + 320, *rsum = sc + 384, *qn = sc + 512, *nvec = sc + 576, *misc = sc + 704;
    const int ti = wave >> 2, ej = wave & 3;
    f32x16 Cacc[2];
    {
        LAS float* cst = (LAS float*)lds;
        if (sample) { const float* src = P.in[I_STC] + ((size_t)b * 4 + h) * 16384;
            for (int i = tid; i < 4096; i += 512) { const f32x4 v = *(const f32x4*)(src + 4 * i); *(LAS f32x4*)(cst + (i >> 5) * 132 + (i & 31) * 4) = v; } }
        else { for (int i = tid; i < 4096; i += 512) *(LAS f32x4*)(cst + (i >> 5) * 132 + (i & 31) * 4) = (f32x4){0.f, 0.f, 0.f, 0.f}; }
        __syncthreads();
        const LAS float* cb = cst + (64 * (wave >> 2) + 4 * hh) * 132 + 32 * ej + n31;
#pragma unroll
        for (int i = 0; i < 2; ++i)
#pragma unroll
            for (int r = 0; r < 16; ++r) Cacc[i][r] = cb[(32 * i + (r & 3) + 8 * (r >> 2)) * 132];
        __syncthreads();
        lptr cs = lds + ML_CS + (64 * (wave >> 2) + 4 * hh) * ML_P + (32 * ej + n31) * 2;
#pragma unroll
        for (int i = 0; i < 2; ++i)
#pragma unroll
            for (int r = 0; r < 16; ++r) *(LAS unsigned short*)(cs + (32 * i + (r & 3) + 8 * (r >> 2)) * ML_P) = f2bf(Cacc[i][r]);
    }
    if (tid < 128) nvec[tid] = sample ? P.in[I_STN][((size_t)b * 4 + h) * 128 + tid] : 0.f;
    if (tid == 0) misc[0] = sample ? P.in[I_STM][b * 4 + h] : 0.f;
    u32x4 rq[2], rk[2], rv[2]; float g_ig = -INFINITY, g_lf = 0.f;
    const int prow[2] = {tid >> 4, (tid + 512) >> 4}, pch = tid & 15;
#define ML_LOAD(c) do { _Pragma("unroll") for (int i = 0; i < 2; ++i) { if (prow[i] < L) { const size_t go = (rowbase + (size_t)(c) * 64 + prow[i]) * 512 + h * 128 + pch * 8; \
            rq[i] = *(const u32x4*)(MQ + go); rk[i] = *(const u32x4*)(MK + go); rv[i] = *(const u32x4*)(MV + go); } else { rq[i] = (u32x4){0u, 0u, 0u, 0u}; rk[i] = rq[i]; rv[i] = rq[i]; } } \
        if (wave == 0) { if (lane < L) { const float* g = GT + (rowbase + (size_t)(c) * 64 + lane) * 8; g_ig = g[h]; g_lf = g[4 + h]; } else { g_ig = -INFINITY; g_lf = 0.f; } } } while (0)
    ML_LOAD(0);
    for (int c = 0; c < nch; ++c) {
        __syncthreads();
        if (wave == 0) {
            float bcum = g_lf;
#pragma unroll
            for (int o = 1; o < 64; o <<= 1) { const float v = __shfl_up(bcum, o); if (lane >= o) bcum += v; }
            const float a = g_ig - bcum; float amax = a;
#pragma unroll
            for (int o = 1; o < 64; o <<= 1) { const float v = __shfl_up(amax, o); if (lane >= o) amax = fmaxf(amax, v); }
            const float mprev = misc[0];
            const float m_t = fmaxf(bcum + mprev, bcum + amax);
            const float bL = __shfl(bcum, 63), aM = __shfl(amax, 63);
            const float m_new = fmaxf(bL + mprev, bL + aM);
            bt[lane] = bcum; as_[lane] = a; mt[lane] = m_t; winter[lane] = expf(bcum + mprev - m_t); emt[lane] = expf(-m_t); wk[lane] = expf(bL + a - m_new);
            if (lane == 0) { misc[1] = expf(bL + mprev - m_new); misc[2] = m_new; }
        }
#pragma unroll
        for (int i = 0; i < 2; ++i) { const int o = prow[i] * ML_P + pch * 16;
            *(LAS u32x4*)(lds + ML_QS + o) = rq[i]; *(LAS u32x4*)(lds + ML_KS + o) = rk[i]; *(LAS u32x4*)(lds + ML_VS + o) = rv[i]; }
        __syncthreads();
#pragma unroll
        for (int i = 0; i < 2; ++i) { const float w = wk[prow[i]]; const u32x4 v = rv[i]; u32x4 o;
            o.x = cvtpk(bflo(v.x) * w, bfhi(v.x) * w); o.y = cvtpk(bflo(v.y) * w, bfhi(v.y) * w); o.z = cvtpk(bflo(v.z) * w, bfhi(v.z) * w); o.w = cvtpk(bflo(v.w) * w, bfhi(v.w) * w);
            *(LAS u32x4*)(lds + ML_VW + prow[i] * ML_P + pch * 16) = o; }
        if (c + 1 < nch) ML_LOAD(c + 1);
        f32x16 num;
#pragma unroll
        for (int r = 0; r < 16; ++r) num[r] = 0.f;
#pragma unroll
        for (int ks = 0; ks < 8; ++ks) num = MFMA32(row_frag(lds + ML_QS, ML_P, 32 * ti, 16 * ks, lane), tr_frag(lds + ML_CS, ML_P, 16 * ks, 32 * ej, lane), num);
        if (wave < 3) {
            const int sti = wave == 0 ? 0 : 1, sj = wave == 2 ? 1 : 0;
            const int krow = (n31 & ~12) | ((n31 & 4) << 1) | ((n31 & 8) >> 1);
            f32x16 p;
#pragma unroll
            for (int r = 0; r < 16; ++r) p[r] = 0.f;
#pragma unroll
            for (int ks = 0; ks < 8; ++ks) p = MFMA32(*(const LAS bf16x8*)(lds + ML_KS + (32 * sj + krow) * ML_P + (16 * ks + 8 * hh) * 2), row_frag(lds + ML_QS, ML_P, 32 * sti, 16 * ks, lane), p);
            const int t = 32 * sti + n31; const float bt_t = bt[t], mt_t = mt[t]; float rs = 0.f;
            const LAS float* asb = as_ + 32 * sj + 8 * hh; const int tb = t - (32 * sj + 8 * hh);
#pragma unroll
            for (int r = 0; r < 16; ++r) { const int so = 16 * (r >> 3) + (r & 7);
                const float w = so <= tb ? __expf(bt_t + asb[so] - mt_t) : 0.f; p[r] *= w; rs += p[r]; }
#pragma unroll
            for (int a2 = 0; a2 < 2; ++a2) { u32x4 o; o.x = cvtpk(p[8 * a2 + 0], p[8 * a2 + 1]); o.y = cvtpk(p[8 * a2 + 2], p[8 * a2 + 3]); o.z = cvtpk(p[8 * a2 + 4], p[8 * a2 + 5]); o.w = cvtpk(p[8 * a2 + 6], p[8 * a2 + 7]);
                *(LAS u32x4*)(lds + ML_SS + t * 144 + (32 * sj + 16 * a2 + 8 * hh) * 2) = o; }
            rs += __shfl_xor(rs, 32);
            if (hh == 0) rsum[sj * 64 + t] = rs;
        }
        if (wave >= 4) {
            const int t = (tid - 256) >> 2, part = tid & 3; float s = 0.f;
#pragma unroll 8
            for (int d = 0; d < 32; ++d) s += bf2f(*(const LAS unsigned short*)(lds + ML_QS + t * ML_P + (32 * part + d) * 2)) * nvec[32 * part + d];
            s += __shfl_xor(s, 1); s += __shfl_xor(s, 2);
            if (part == 0) qn[t] = s;
        }
        __syncthreads();
        const LAS float* tb2 = sc + 32 * ti + 4 * hh;
#pragma unroll
        for (int r = 0; r < 16; ++r) num[r] *= tb2[192 + (r & 3) + 8 * (r >> 2)];
#pragma unroll
        for (int ks = 0; ks < 4; ++ks) if (ks < 2 || ti == 1) num = MFMA32(*(const LAS bf16x8*)(lds + ML_SS + (32 * ti + n31) * 144 + (16 * ks + 8 * hh) * 2), tr_frag(lds + ML_VS, ML_P, 16 * ks, 32 * ej, lane), num);
#pragma unroll
        for (int r = 0; r < 16; ++r) { const int o = (r & 3) + 8 * (r >> 2);
            const float den = tb2[192 + o] * tb2[512 + o] + tb2[384 + o] + (ti ? tb2[448 + o] : 0.f);
            const float hv = num[r] / fmaxf(fabsf(den), tb2[256 + o]);
            *(LAS unsigned short*)(lds + ML_QS + (32 * ti + 4 * hh) * ML_P + (32 * ej + n31) * 2 + o * ML_P) = f2bf(hv); }
        const float decay = misc[1];
#pragma unroll
        for (int i = 0; i < 2; ++i) { const int di = 2 * (wave >> 2) + i;
#pragma unroll
            for (int r = 0; r < 16; ++r) Cacc[i][r] *= decay;
#pragma unroll
            for (int ks = 0; ks < 4; ++ks) Cacc[i] = MFMA32(tr_frag(lds + ML_KS, ML_P, 16 * ks, 32 * di, lane), tr_frag(lds + ML_VW, ML_P, 16 * ks, 32 * ej, lane), Cacc[i]);
#pragma unroll
            for (int r = 0; r < 16; ++r) *(LAS unsigned short*)(lds + ML_CS + (64 * (wave >> 2) + 4 * hh) * ML_P + (32 * ej + n31) * 2 + (32 * i + (r & 3) + 8 * (r >> 2)) * ML_P) = f2bf(Cacc[i][r]); }
        if (tid < 128) { float s = decay * nvec[tid];
#pragma unroll 8
            for (int t = 0; t < 64; ++t) s += wk[t] * bf2f(*(const LAS unsigned short*)(lds + ML_KS + t * ML_P + tid * 2));
            nvec[tid] = s; }
        if (tid == 0) misc[0] = misc[2];
        __syncthreads();
        { const int t = tid >> 3, part = tid & 7;
          const u32x4 h0 = *(const LAS u32x4*)(lds + ML_QS + t * ML_P + part * 32), h1 = *(const LAS u32x4*)(lds + ML_QS + t * ML_P + part * 32 + 16);
          float hv[16] = {bflo(h0.x), bfhi(h0.x), bflo(h0.y), bfhi(h0.y), bflo(h0.z), bfhi(h0.z), bflo(h0.w), bfhi(h0.w), bflo(h1.x), bfhi(h1.x), bflo(h1.y), bfhi(h1.y), bflo(h1.z), bfhi(h1.z), bflo(h1.w), bfhi(h1.w)};
          float ss = 0.f;
#pragma unroll
          for (int e = 0; e < 16; ++e) ss += hv[e] * hv[e];
          ss += __shfl_xor(ss, 1); ss += __shfl_xor(ss, 2); ss += __shfl_xor(ss, 4);
          const float rstd = rsqrtf(ss * (1.f / 128.f) + EPS);
          if (t < L) {
              const size_t row = rowbase + (size_t)c * 64 + t; const int col = h * 128 + part * 16;
              const u32x4 g0 = *(const u32x4*)(MO + row * 512 + col), g1 = *(const u32x4*)(MO + row * 512 + col + 8);
              const float gv[16] = {bflo(g0.x), bfhi(g0.x), bflo(g0.y), bfhi(g0.y), bflo(g0.z), bfhi(g0.z), bflo(g0.w), bfhi(g0.w), bflo(g1.x), bfhi(g1.x), bflo(g1.y), bfhi(g1.y), bflo(g1.z), bfhi(g1.z), bflo(g1.w), bfhi(g1.w)};
              const float* mw = P.in[I_MLW] + col;
              float y[16];
#pragma unroll
              for (int e = 0; e < 16; ++e) y[e] = hv[e] * rstd * mw[e] * gv[e];
              u32x4 o0, o1; o0.x = cvtpk(y[0], y[1]); o0.y = cvtpk(y[2], y[3]); o0.z = cvtpk(y[4], y[5]); o0.w = cvtpk(y[6], y[7]); o1.x = cvtpk(y[8], y[9]); o1.y = cvtpk(y[10], y[11]); o1.z = cvtpk(y[12], y[13]); o1.w = cvtpk(y[14], y[15]);
              *(u32x4*)(YC + row * 1024 + col) = o0; *(u32x4*)(YC + row * 1024 + col + 8) = o1;
          } }
    }
#undef ML_LOAD
    __syncthreads();
    {
        LAS float* cst = (LAS float*)lds;
        int l3 = lane; asm volatile("" : "+v"(l3));
        LAS float* cb = cst + (64 * (wave >> 2) + 4 * (l3 >> 5)) * 132 + 32 * ej + (l3 & 31);
#pragma unroll
        for (int i = 0; i < 2; ++i)
#pragma unroll
            for (int r = 0; r < 16; ++r) cb[(32 * i + (r & 3) + 8 * (r >> 2)) * 132] = Cacc[i][r];
        __syncthreads();
        float* oc = P.out + (sample ? O_SC : O_PC) + ((size_t)b * 4 + h) * 16384;
        for (int i = tid; i < 4096; i += 512) *(f32x4*)(oc + 4 * i) = *(const LAS f32x4*)(cst + (i >> 5) * 132 + (i & 31) * 4);
    }
    if (tid < 128) P.out[(sample ? O_SN : O_PN) + ((size_t)b * 4 + h) * 128 + tid] = nvec[tid];
    if (tid == 0) P.out[(sample ? O_SM : O_PM) + b * 4 + h] = misc[0];
}


constexpr size_t WS_KVL = WS_H, WS_KNL = 420 * MiB, WS_CHS = 421 * MiB, WS_NST = 422 * MiB, WS_MST = 423 * MiB, WS_CST = 424 * MiB, WS_END2 = 489 * MiB;
template <int NC>
__device__ __forceinline__ void ml1_pair(const Params& P, lptr lds, int pair, int tid, int lane, int wave) {
    const int item0 = NC * pair; const int bh = item0 >> 6, c = item0 & 63, b = bh >> 2, h = bh & 3, hh = lane >> 5, n31 = lane & 31, ej = wave & 3;
    const size_t row0 = (size_t)b * SEQ + 64 * c;
    const bf16_t* MK = (const bf16_t*)(P.ws + WS_PROJ + PROJ_STRIDE); const bf16_t* MV = (const bf16_t*)(P.ws + WS_PROJ + 2 * PROJ_STRIDE); const float* GT = (const float*)(P.ws + WS_GATES);
    LAS float* wk = (LAS float*)(lds + ML_SC) + 320;
    const int prow[2] = {tid >> 4, (tid + 512) >> 4}, pch = tid & 15;
    u32x4 rk2[NC][2], rv2[NC][2]; float g_ig2[NC], g_lf2[NC];
#pragma unroll
    for (int s2 = 0; s2 < NC; ++s2) { g_ig2[s2] = 0.f; g_lf2[s2] = 0.f;
#pragma unroll
        for (int i = 0; i < 2; ++i) { const size_t go = (row0 + 64 * s2 + prow[i]) * 512 + h * 128 + pch * 8; rk2[s2][i] = *(const u32x4*)(MK + go); rv2[s2][i] = *(const u32x4*)(MV + go); }
        if (wave == 0) { const float* g = GT + (row0 + 64 * s2 + lane) * 8; g_ig2[s2] = g[h]; g_lf2[s2] = g[4 + h]; } }
#pragma unroll
    for (int s2 = 0; s2 < NC; ++s2) {
    const int item = item0 + s2; const float g_ig = g_ig2[s2], g_lf = g_lf2[s2];
    u32x4 rk[2] = {rk2[s2][0], rk2[s2][1]}, rv[2] = {rv2[s2][0], rv2[s2][1]};
    __syncthreads();
    if (wave == 0) {
        float bcum = g_lf;
#pragma unroll
        for (int o = 1; o < 64; o <<= 1) { const float v = __shfl_up(bcum, o); if (lane >= o) bcum += v; }
        const float a = g_ig - bcum; float amax = a;
#pragma unroll
        for (int o = 1; o < 64; o <<= 1) amax = fmaxf(amax, __shfl_xor(amax, o));
        const float bL = __shfl(bcum, 63);
        wk[lane] = expf(a - amax);
        if (lane == 0) { float* ch = (float*)(P.ws + WS_CHS) + (size_t)item * 4; ch[0] = bL; ch[1] = bL + amax; }
    }
#pragma unroll
    for (int i = 0; i < 2; ++i) *(LAS u32x4*)(lds + ML_KS + prow[i] * ML_P + pch * 16) = rk[i];
    __syncthreads();
#pragma unroll
    for (int i = 0; i < 2; ++i) { const float w = wk[prow[i]]; const u32x4 v = rv[i]; u32x4 o;
        o.x = cvtpk(bflo(v.x) * w, bfhi(v.x) * w); o.y = cvtpk(bflo(v.y) * w, bfhi(v.y) * w); o.z = cvtpk(bflo(v.z) * w, bfhi(v.z) * w); o.w = cvtpk(bflo(v.w) * w, bfhi(v.w) * w);
        *(LAS u32x4*)(lds + ML_VW + prow[i] * ML_P + pch * 16) = o; }
    if (tid < 128) { float s = 0.f;
#pragma unroll 8
        for (int t = 0; t < 64; ++t) s += wk[t] * bf2f(*(const LAS unsigned short*)(lds + ML_KS + t * ML_P + tid * 2));
        ((float*)(P.ws + WS_KNL))[(size_t)item * 128 + tid] = s; }
    __syncthreads();
#pragma unroll
    for (int i = 0; i < 2; ++i) { const int di = 2 * (wave >> 2) + i;
        f32x16 acc;
#pragma unroll
        for (int r = 0; r < 16; ++r) acc[r] = 0.f;
#pragma unroll
        for (int ks = 0; ks < 4; ++ks) acc = MFMA32(tr_frag(lds + ML_KS, ML_P, 16 * ks, 32 * di, lane), tr_frag(lds + ML_VW, ML_P, 16 * ks, 32 * ej, lane), acc);
#pragma unroll
        for (int r = 0; r < 16; ++r) *(LAS unsigned short*)(lds + ML_CS + (64 * (wave >> 2) + 4 * hh) * ML_P + (32 * ej + n31) * 2 + (32 * i + (r & 3) + 8 * (r >> 2)) * ML_P) = f2bf(acc[r]); }
    __syncthreads();
    bf16_t* kvl = (bf16_t*)(P.ws + WS_KVL) + (size_t)item * 16384;
#pragma unroll
    for (int i = 0; i < 4; ++i) { const int p = tid + 512 * i, row = p >> 4, ch = p & 15; *(u32x4*)(kvl + row * 128 + ch * 8) = *(const LAS u32x4*)(lds + ML_CS + row * ML_P + ch * 16); }
    }
}
__device__ __forceinline__ void ml2_scan(const Params& P, lptr lds, int tid, int job) {
    const int bh = job >> 3, part = job & 7;
    LAS float* dec = (LAS float*)lds; LAS float* scl = dec + 64; LAS float* mst = scl + 64;
    if (tid == 0) { const float* ch = (const float*)(P.ws + WS_CHS) + (size_t)bh * 64 * 4; float m = 0.f;
        for (int c = 0; c < 64; ++c) { const float bL = ch[4 * c], ml = ch[4 * c + 1], mn = fmaxf(bL + m, ml); dec[c] = expf(bL + m - mn); scl[c] = expf(ml - mn); mst[c] = m; m = mn; }
        mst[64] = m; }
    __syncthreads();
    const size_t e0 = (size_t)part * 2048 + tid * 4;
    const bf16_t* kv = (const bf16_t*)(P.ws + WS_KVL) + (size_t)bh * 64 * 16384 + e0; bf16_t* cs = (bf16_t*)(P.ws + WS_CST) + (size_t)bh * 64 * 16384 + e0;
    f32x4 C = {0.f, 0.f, 0.f, 0.f};
#pragma unroll 16
    for (int c = 0; c < 64; ++c) { const u32x2 v = *(const u32x2*)(kv + (size_t)c * 16384);
        *(u32x2*)(cs + (size_t)c * 16384) = (u32x2){cvtpk(C.x, C.y), cvtpk(C.z, C.w)};
        const f32x4 kvf = {bflo(v.x), bfhi(v.x), bflo(v.y), bfhi(v.y)};
        C = C * dec[c] + kvf * scl[c]; }
    *(f32x4*)(P.out + O_PC + (size_t)bh * 16384 + e0) = C;
    if (part == 0 && tid < 128) { float n = 0.f; const float* kn = (const float*)(P.ws + WS_KNL) + (size_t)bh * 64 * 128 + tid; float* ns = (float*)(P.ws + WS_NST) + (size_t)bh * 64 * 128 + tid;
#pragma unroll 16
        for (int c = 0; c < 64; ++c) { ns[c * 128] = n; n = n * dec[c] + kn[c * 128] * scl[c]; }
        P.out[O_PN + (size_t)bh * 128 + tid] = n; }
    if (part == 0 && tid >= 128 && tid < 192) ((float*)(P.ws + WS_MST))[bh * 64 + tid - 128] = mst[tid - 128];
    if (part == 0 && tid == 192) P.out[O_PM + bh] = mst[64];
}
struct Ml3In { u32x4 rq[2], rk[2], rv[2], rc[4], g0, g1; float g_ig, g_lf, mprev, nin; };
__device__ __forceinline__ void ml3_load(const Params& P, int item, int tid, int lane, int wave, Ml3In& L) {
    const int bh = item >> 6, c = item & 63, b = bh >> 2, h = bh & 3;
    const size_t row0 = (size_t)b * SEQ + 64 * c;
    const bf16_t* MQ = (const bf16_t*)(P.ws + WS_PROJ); const bf16_t* MK = (const bf16_t*)(P.ws + WS_PROJ + PROJ_STRIDE); const bf16_t* MV = (const bf16_t*)(P.ws + WS_PROJ + 2 * PROJ_STRIDE);
    const bf16_t* MO = (const bf16_t*)(P.ws + WS_PROJ + 3 * PROJ_STRIDE); const float* GT = (const float*)(P.ws + WS_GATES);
    const int prow[2] = {tid >> 4, (tid + 512) >> 4}, pch = tid & 15;
#pragma unroll
    for (int i = 0; i < 2; ++i) { const size_t go = (row0 + prow[i]) * 512 + h * 128 + pch * 8; L.rq[i] = *(const u32x4*)(MQ + go); L.rk[i] = *(const u32x4*)(MK + go); L.rv[i] = *(const u32x4*)(MV + go); }
    const bf16_t* cst = (const bf16_t*)(P.ws + WS_CST) + (size_t)item * 16384;
#pragma unroll
    for (int i = 0; i < 4; ++i) { const int p = tid + 512 * i; L.rc[i] = *(const u32x4*)(cst + (p >> 4) * 128 + (p & 15) * 8); }
    { const size_t row = row0 + (tid >> 3); const int col = h * 128 + (tid & 7) * 16; L.g0 = *(const u32x4*)(MO + row * 512 + col); L.g1 = *(const u32x4*)(MO + row * 512 + col + 8); }
    L.g_ig = 0.f; L.g_lf = 0.f; L.mprev = 0.f; L.nin = 0.f;
    if (wave == 0) { const float* g = GT + (row0 + lane) * 8; L.g_ig = g[h]; L.g_lf = g[4 + h]; L.mprev = ((const float*)(P.ws + WS_MST))[item]; }
    if (tid < 128) L.nin = ((const float*)(P.ws + WS_NST))[(size_t)item * 128 + tid];
}
__device__ __forceinline__ void ml3_item(const Params& P, lptr lds, int item, const Ml3In& L, int tid, int lane, int wave) {
    const int bh = item >> 6, c = item & 63, b = bh >> 2, h = bh & 3, hh = lane >> 5, n31 = lane & 31;
    const size_t row0 = (size_t)b * SEQ + 64 * c;
    bf16_t* YC = (bf16_t*)(P.ws + WS_YCAT);
    LAS float* sc = (LAS float*)(lds + ML_SC);
    LAS float* bt = sc, *as_ = sc + 64, *mt = sc + 128, *winter = sc + 192, *emt = sc + 256, *rsum = sc + 384, *qn = sc + 512, *nvec = sc + 576;
    const int ti = wave >> 2, ej = wave & 3;
    const int prow[2] = {tid >> 4, (tid + 512) >> 4}, pch = tid & 15;
    const float g_ig = L.g_ig, g_lf = L.g_lf, mprev = L.mprev, nin = L.nin;
    __syncthreads();
    if (wave == 0) {
        float bcum = g_lf;
#pragma unroll
        for (int o = 1; o < 64; o <<= 1) { const float v = __shfl_up(bcum, o); if (lane >= o) bcum += v; }
        const float a = g_ig - bcum; float amax = a;
#pragma unroll
        for (int o = 1; o < 64; o <<= 1) { const float v = __shfl_up(amax, o); if (lane >= o) amax = fmaxf(amax, v); }
        const float m_t = fmaxf(bcum + mprev, bcum + amax);
        bt[lane] = bcum; as_[lane] = a; mt[lane] = m_t; winter[lane] = expf(bcum + mprev - m_t); emt[lane] = expf(-m_t);
    }
    if (tid < 128) nvec[tid] = nin;
#pragma unroll
    for (int i = 0; i < 2; ++i) { const int o = prow[i] * ML_P + pch * 16;
        *(LAS u32x4*)(lds + ML_QS + o) = L.rq[i]; *(LAS u32x4*)(lds + ML_KS + o) = L.rk[i]; *(LAS u32x4*)(lds + ML_VS + o) = L.rv[i]; }
#pragma unroll
    for (int i = 0; i < 4; ++i) { const int p = tid + 512 * i; *(LAS u32x4*)(lds + ML_CS + (p >> 4) * ML_P + (p & 15) * 16) = L.rc[i]; }
    __syncthreads();
    f32x16 num;
#pragma unroll
    for (int r = 0; r < 16; ++r) num[r] = 0.f;
#pragma unroll
    for (int ks = 0; ks < 8; ++ks) num = MFMA32(row_frag(lds + ML_QS, ML_P, 32 * ti, 16 * ks, lane), tr_frag(lds + ML_CS, ML_P, 16 * ks, 32 * ej, lane), num);
    if (wave < 3) {
        const int sti = wave == 0 ? 0 : 1, sj = wave == 2 ? 1 : 0;
        const int krow = (n31 & ~12) | ((n31 & 4) << 1) | ((n31 & 8) >> 1);
        f32x16 p;
#pragma unroll
        for (int r = 0; r < 16; ++r) p[r] = 0.f;
#pragma unroll
        for (int ks = 0; ks < 8; ++ks) p = MFMA32(*(const LAS bf16x8*)(lds + ML_KS + (32 * sj + krow) * ML_P + (16 * ks + 8 * hh) * 2), row_frag(lds + ML_QS, ML_P, 32 * sti, 16 * ks, lane), p);
        const int t = 32 * sti + n31; const float bt_t = bt[t], mt_t = mt[t]; float rs = 0.f;
        const LAS float* asb = as_ + 32 * sj + 8 * hh; const int tb = t - (32 * sj + 8 * hh);
#pragma unroll
        for (int r = 0; r < 16; ++r) { const int so = 16 * (r >> 3) + (r & 7);
            const float w = so <= tb ? __expf(bt_t + asb[so] - mt_t) : 0.f; p[r] *= w; rs += p[r]; }
#pragma unroll
        for (int a2 = 0; a2 < 2; ++a2) { u32x4 o; o.x = cvtpk(p[8 * a2 + 0], p[8 * a2 + 1]); o.y = cvtpk(p[8 * a2 + 2], p[8 * a2 + 3]); o.z = cvtpk(p[8 * a2 + 4], p[8 * a2 + 5]); o.w = cvtpk(p[8 * a2 + 6], p[8 * a2 + 7]);
            *(LAS u32x4*)(lds + ML_SS + t * 144 + (32 * sj + 16 * a2 + 8 * hh) * 2) = o; }
        rs += __shfl_xor(rs, 32);
        if (hh == 0) rsum[sj * 64 + t] = rs;
    }
    if (wave >= 4) {
        const int t = (tid - 256) >> 2, part = tid & 3; float s = 0.f;
#pragma unroll 8
        for (int d = 0; d < 32; ++d) s += bf2f(*(const LAS unsigned short*)(lds + ML_QS + t * ML_P + (32 * part + d) * 2)) * nvec[32 * part + d];
        s += __shfl_xor(s, 1); s += __shfl_xor(s, 2);
        if (part == 0) qn[t] = s;
    }
    __syncthreads();
    const LAS float* tb2 = sc + 32 * ti + 4 * hh;
#pragma unroll
    for (int r = 0; r < 16; ++r) num[r] *= tb2[192 + (r & 3) + 8 * (r >> 2)];
#pragma unroll
    for (int ks = 0; ks < 4; ++ks) if (ks < 2 || ti == 1) num = MFMA32(*(const LAS bf16x8*)(lds + ML_SS + (32 * ti + n31) * 144 + (16 * ks + 8 * hh) * 2), tr_frag(lds + ML_VS, ML_P, 16 * ks, 32 * ej, lane), num);
#pragma unroll
    for (int r = 0; r < 16; ++r) { const int o = (r & 3) + 8 * (r >> 2);
        const float den = tb2[192 + o] * tb2[512 + o] + tb2[384 + o] + (ti ? tb2[448 + o] : 0.f);
        const float hv = num[r] / fmaxf(fabsf(den), tb2[256 + o]);
        *(LAS unsigned short*)(lds + ML_QS + (32 * ti + 4 * hh) * ML_P + (32 * ej + n31) * 2 + o * ML_P) = f2bf(hv); }
    __syncthreads();
    { const int t = tid >> 3, part = tid & 7;
      const size_t row = row0 + t; const int col = h * 128 + part * 16;
      const u32x4 g0 = L.g0, g1 = L.g1;
      const u32x4 h0 = *(const LAS u32x4*)(lds + ML_QS + t * ML_P + part * 32), h1 = *(const LAS u32x4*)(lds + ML_QS + t * ML_P + part * 32 + 16);
      float hv[16] = {bflo(h0.x), bfhi(h0.x), bflo(h0.y), bfhi(h0.y), bflo(h0.z), bfhi(h0.z), bflo(h0.w), bfhi(h0.w), bflo(h1.x), bfhi(h1.x), bflo(h1.y), bfhi(h1.y), bflo(h1.z), bfhi(h1.z), bflo(h1.w), bfhi(h1.w)};
      float ss = 0.f;
#pragma unroll
      for (int e = 0; e < 16; ++e) ss += hv[e] * hv[e];
      ss += __shfl_xor(ss, 1); ss += __shfl_xor(ss, 2); ss += __shfl_xor(ss, 4);
      const float rstd = rsqrtf(ss * (1.f / 128.f) + EPS);
      const float gv[16] = {bflo(g0.x), bfhi(g0.x), bflo(g0.y), bfhi(g0.y), bflo(g0.z), bfhi(g0.z), bflo(g0.w), bfhi(g0.w), bflo(g1.x), bfhi(g1.x), bflo(g1.y), bfhi(g1.y), bflo(g1.z), bfhi(g1.z), bflo(g1.w), bfhi(g1.w)};
      const float* mw = P.in[I_MLW] + col;
      float y[16];
#pragma unroll
      for (int e = 0; e < 16; ++e) y[e] = hv[e] * rstd * mw[e] * gv[e];
      u32x4 o0, o1; o0.x = cvtpk(y[0], y[1]); o0.y = cvtpk(y[2], y[3]); o0.z = cvtpk(y[4], y[5]); o0.w = cvtpk(y[6], y[7]); o1.x = cvtpk(y[8], y[9]); o1.y = cvtpk(y[10], y[11]); o1.z = cvtpk(y[12], y[13]); o1.w = cvtpk(y[14], y[15]);
      *(u32x4*)(YC + row * 1024 + col) = o0; *(u32x4*)(YC + row * 1024 + col + 8) = o1; }
}

constexpr int AT_KP = 144, AT_VP = 136, AT_WAVE = 64 * AT_KP + 64 * AT_VP;
__device__ __forceinline__ void sb_step(clptr Kt, clptr Vt, const bf16x8 (&qf)[4], f32x16& o0, f32x16& o1, float& carry, int lane, bool domask, int kq) {
    const int n31 = lane & 31, hh = lane >> 5;
    const int krow = (n31 & ~12) | ((n31 & 4) << 1) | ((n31 & 8) >> 1);
    f32x16 p[2];
#pragma unroll
    for (int r = 0; r < 16; ++r) { p[0][r] = 0.f; p[1][r] = 0.f; }
#pragma unroll
    for (int ks = 0; ks < 4; ++ks) {
        p[0] = MFMA32(*(const LAS bf16x8*)(Kt + krow * AT_KP + (16 * ks + 8 * hh) * 2), qf[ks], p[0]);
        p[1] = MFMA32(*(const LAS bf16x8*)(Kt + (32 + krow) * AT_KP + (16 * ks + 8 * hh) * 2), qf[ks], p[1]);
    }
    f32x16 om[2];
    float town[4], tpar[4];
#pragma unroll
    for (int u = 0; u < 2; ++u)
#pragma unroll
        for (int a = 0; a < 2; ++a) { float tp = 1.f;
#pragma unroll
            for (int j = 0; j < 8; ++j) { const int r = 8 * a + j;
                const float z = fminf(fmaxf(p[u][r], -60.f), 60.f);
                const float e = fast_exp2(-z); float sg = fast_rcp(1.f + e); float o = e * sg;
                if (domask) { const int kl = 32 * u + 16 * a + 8 * hh + j; if (kl >= kq) { sg = 0.f; o = 1.f; } }
                p[u][r] = sg; om[u][r] = o; tp *= o; }
            town[2 * u + a] = tp; }
#pragma unroll
    for (int i = 0; i < 4; ++i) tpar[i] = __shfl_xor(town[i], 32);
    float suf[5]; suf[4] = 1.f;
#pragma unroll
    for (int i = 3; i >= 0; --i) suf[i] = suf[i + 1] * (town[i] * tpar[i]);
    bf16x8 pf[4];
#pragma unroll
    for (int u = 0; u < 2; ++u)
#pragma unroll
        for (int a = 0; a < 2; ++a) { const int pr = 2 * u + a;
            float R = carry * suf[pr + 1] * (hh == 0 ? tpar[pr] : 1.f);
            float av[8];
#pragma unroll
            for (int j = 7; j >= 0; --j) { av[j] = p[u][8 * a + j] * R; R *= om[u][8 * a + j]; }
            u32x4 w; w.x = cvtpk(av[0], av[1]); w.y = cvtpk(av[2], av[3]); w.z = cvtpk(av[4], av[5]); w.w = cvtpk(av[6], av[7]);
            pf[pr] = __builtin_bit_cast(bf16x8, w); }
    carry *= suf[0];
#pragma unroll
    for (int pr = 0; pr < 4; ++pr) {
        o0 = MFMA32(tr_frag(Vt, AT_VP, 16 * pr, 0, lane), pf[pr], o0);
        o1 = MFMA32(tr_frag(Vt, AT_VP, 16 * pr, 32, lane), pf[pr], o1);
    }
}
__device__ __forceinline__ void attn_prompt_item(const Params& P, lptr lds, int bh, int qb, int lane, int wave) {
    const int b = bh >> 3, h = bh & 7, n31 = lane & 31, hh = lane >> 5;
    const bf16_t* SQ = (const bf16_t*)(P.ws + WS_PROJ + 4 * PROJ_STRIDE); const bf16_t* SK = (const bf16_t*)(P.ws + WS_PROJ + 5 * PROJ_STRIDE); const bf16_t* SV = (const bf16_t*)(P.ws + WS_PROJ + 6 * PROJ_STRIDE);
    const size_t rowb = (size_t)b * SEQ; const int q0 = 256 * qb + 32 * wave;
    lptr Kt = lds + wave * AT_WAVE; lptr Vt = Kt + 64 * AT_KP;
    bf16x8 qf[4];
#pragma unroll
    for (int ks = 0; ks < 4; ++ks) qf[ks] = *(const bf16x8*)(SQ + (rowb + q0 + n31) * 512 + h * 64 + 16 * ks + 8 * hh);
    f32x16 o0, o1;
#pragma unroll
    for (int r = 0; r < 16; ++r) { o0[r] = 0.f; o1[r] = 0.f; }
    float carry = 1.f;
    const int trow = lane >> 3, tch = lane & 7;
    u32x4 kv[8], vv[8];
    const int jt0 = (q0 + 30) >> 6;
#pragma unroll
    for (int i = 0; i < 8; ++i) { const size_t go = (rowb + 64 * jt0 + 8 * i + trow) * 512 + h * 64 + tch * 8; kv[i] = *(const u32x4*)(SK + go); vv[i] = *(const u32x4*)(SV + go); }
    for (int jt = jt0; jt >= 0; --jt) {
#pragma unroll
        for (int i = 0; i < 8; ++i) { const int row = 8 * i + trow;
            *(LAS u32x4*)(Kt + row * AT_KP + tch * 16) = kv[i];
            *(LAS u32x2*)(Vt + row * AT_VP + tch * 16) = (u32x2){vv[i].x, vv[i].y}; *(LAS u32x2*)(Vt + row * AT_VP + tch * 16 + 8) = (u32x2){vv[i].z, vv[i].w}; }
        if (jt > 0) {
#pragma unroll
            for (int i = 0; i < 8; ++i) { const size_t go = (rowb + 64 * (jt - 1) + 8 * i + trow) * 512 + h * 64 + tch * 8; kv[i] = *(const u32x4*)(SK + go); vv[i] = *(const u32x4*)(SV + go); } }
        sb_step(Kt, Vt, qf, o0, o1, carry, lane, 64 * jt + 63 >= q0, q0 + n31 - 64 * jt);
        if (__all(carry < 1e-30f)) break;
    }
    float ss = 0.f;
#pragma unroll
    for (int r = 0; r < 16; ++r) ss += o0[r] * o0[r] + o1[r] * o1[r];
    ss += __shfl_xor(ss, 32);
    const size_t row = rowb + q0 + n31;
    if (hh == 0) ((float*)(P.ws + WS_SSQ))[row * 8 + h] = ss;
    bf16_t* yo = (bf16_t*)(P.ws + WS_YCAT) + row * 1024 + 512 + h * 64 + 4 * hh;
#pragma unroll
    for (int g = 0; g < 4; ++g) {
        *(u32x2*)(yo + 8 * g) = (u32x2){cvtpk(o0[4 * g], o0[4 * g + 1]), cvtpk(o0[4 * g + 2], o0[4 * g + 3])};
        *(u32x2*)(yo + 32 + 8 * g) = (u32x2){cvtpk(o1[4 * g], o1[4 * g + 1]), cvtpk(o1[4 * g + 2], o1[4 * g + 3])};
    }
}
__device__ __forceinline__ void attn_sample_item(const Params& P, lptr lds, int bh, int tid, int lane, int wave) {
    const int b = bh >> 3, h = bh & 7, n31 = lane & 31, hh = lane >> 5;
    const bf16_t* SQ = (const bf16_t*)(P.ws + WS_PROJ + 4 * PROJ_STRIDE); const bf16_t* SK = (const bf16_t*)(P.ws + WS_PROJ + 5 * PROJ_STRIDE); const bf16_t* SV = (const bf16_t*)(P.ws + WS_PROJ + 6 * PROJ_STRIDE);
    const size_t rows = (size_t)MP + b * 32;
    lptr Kt = lds + wave * AT_WAVE; lptr Vt = Kt + 64 * AT_KP;
    bf16x8 qf[4];
#pragma unroll
    for (int ks = 0; ks < 4; ++ks) qf[ks] = *(const bf16x8*)(SQ + (rows + n31) * 512 + h * 64 + 16 * ks + 8 * hh);
    f32x16 o0, o1;
#pragma unroll
    for (int r = 0; r < 16; ++r) { o0[r] = 0.f; o1[r] = 0.f; }
    float carry = 1.f;
    if (wave == 7) {
        const int trow = lane >> 3, tch = lane & 7;
#pragma unroll
        for (int i = 0; i < 8; ++i) { const int row = 8 * i + trow; u32x4 kv = {0u, 0u, 0u, 0u}, vv = {0u, 0u, 0u, 0u};
            if (row < 32) { const size_t go = (rows + row) * 512 + h * 64 + tch * 8; kv = *(const u32x4*)(SK + go); vv = *(const u32x4*)(SV + go); }
            *(LAS u32x4*)(Kt + row * AT_KP + tch * 16) = kv;
            *(LAS u32x2*)(Vt + row * AT_VP + tch * 16) = (u32x2){vv.x, vv.y}; *(LAS u32x2*)(Vt + row * AT_VP + tch * 16 + 8) = (u32x2){vv.z, vv.w}; }
        sb_step(Kt, Vt, qf, o0, o1, carry, lane, true, n31);
    }
    const float* CK = P.in[I_CK] + (size_t)b * PAST * 512 + h * 64; const float* CV = P.in[I_CV] + (size_t)b * PAST * 512 + h * 64;
    for (int jt = 4 * wave + 3; jt >= 4 * wave; --jt) {
        const int trow = lane >> 4, c4 = lane & 15;
#pragma unroll
        for (int i = 0; i < 16; ++i) { const int row = 4 * i + trow; const size_t go = (size_t)(64 * jt + row) * 512 + c4 * 4;
            const f32x4 kx = *(const f32x4*)(CK + go), vx = *(const f32x4*)(CV + go);
            *(LAS u32x2*)(Kt + row * AT_KP + c4 * 8) = (u32x2){cvtpk(kx.x, kx.y), cvtpk(kx.z, kx.w)};
            *(LAS u32x2*)(Vt + row * AT_VP + c4 * 8) = (u32x2){cvtpk(vx.x, vx.y), cvtpk(vx.z, vx.w)}; }
        sb_step(Kt, Vt, qf, o0, o1, carry, lane, false, 0);
    }
    __syncthreads();
    LAS float* carr = (LAS float*)(lds + 65536);
    if (hh == 0) carr[wave * 32 + n31] = carry;
    __syncthreads();
    float mult = 1.f;
    for (int w2 = wave + 1; w2 < 8; ++w2) mult *= carr[w2 * 32 + n31];
#pragma unroll
    for (int g = 0; g < 4; ++g) {
        *(LAS f32x4*)(lds + (((wave * 8 + g) * 64 + lane) * 16)) = (f32x4){o0[4 * g] * mult, o0[4 * g + 1] * mult, o0[4 * g + 2] * mult, o0[4 * g + 3] * mult};
        *(LAS f32x4*)(lds + (((wave * 8 + 4 + g) * 64 + lane) * 16)) = (f32x4){o1[4 * g] * mult, o1[4 * g + 1] * mult, o1[4 * g + 2] * mult, o1[4 * g + 3] * mult};
    }
    __syncthreads();
    { const int q = tid >> 4, part = tid & 15; const int slot = (part >> 3) * 4 + ((part & 7) >> 1), ln = q + 32 * (part & 1);
      f32x4 v = {0.f, 0.f, 0.f, 0.f};
#pragma unroll
      for (int w2 = 0; w2 < 8; ++w2) v = v + *(const LAS f32x4*)(lds + (((w2 * 8 + slot) * 64 + ln) * 16));
      float ss = (v.x * v.x + v.y * v.y) + (v.z * v.z + v.w * v.w);
      ss += __shfl_xor(ss, 1); ss += __shfl_xor(ss, 2); ss += __shfl_xor(ss, 4); ss += __shfl_xor(ss, 8);
      const size_t row = rows + q;
      if (part == 0) ((float*)(P.ws + WS_SSQ))[row * 8 + h] = ss;
      *(u32x2*)((bf16_t*)(P.ws + WS_YCAT) + row * 1024 + 512 + h * 64 + part * 4) = (u32x2){cvtpk(v.x, v.y), cvtpk(v.z, v.w)}; }
    __syncthreads();
}
#ifndef M1NC
#define M1NC 2
#endif
constexpr int NQ_G1S = 224, NQ_AT = 1024, NQ_M1 = 2048 / M1NC, NQ_TOTAL = NQ_G1S + NQ_AT + NQ_M1;
template <class EpiS>
__device__ __forceinline__ void phase_mixers(const Params& P, lptr lds, int tid_in, int wave, const EpiS& Es) {
    unsigned* ctr = (unsigned*)(P.ws + WS_CTL);
    for (;;) {
        __syncthreads();
        if (tid_in == 0) *(LAS int*)(lds + QOFF) = (int)atomicAdd(ctr, 1u);
        __syncthreads();
        int item = *(const LAS int*)(lds + QOFF);
        int tid = tid_in; asm volatile("" : "+v"(tid));
        const int lane = tid & 63;
        if (item >= NQ_TOTAL) break;
        if (item < NQ_G1S) { small_tile<1024, false>((const bf16_t*)(P.ws + WS_H) + (size_t)MP * 1024, (const bf16_t*)(P.ws + WS_W1T), Es, nullptr, lds, item, tid, lane, wave); continue; }
        item -= NQ_G1S;
        if (item < NQ_AT) { attn_prompt_item(P, lds, item & 63, 15 - (item >> 6), lane, wave); continue; }
        item -= NQ_AT;
        ml1_pair<M1NC>(P, lds, item, tid, lane, wave);
    }
}
__device__ __forceinline__ void phase_ml2(const Params& P, lptr lds, int tid_in, int wave) {
    int tid = tid_in; asm volatile("" : "+v"(tid));
    if (blockIdx.x < 160) { for (int job = blockIdx.x; job < 256; job += 160) { __syncthreads(); ml2_scan(P, lds, tid, job); } }
    else if (blockIdx.x < 192) mlstm_item(P, lds, blockIdx.x - 160, true, tid, tid & 63, wave);
    else attn_sample_item(P, lds, blockIdx.x - 192, tid, tid & 63, wave);
}
template <class EpiS>
__device__ __forceinline__ void phase_ml3(const Params& P, lptr lds, int tid_in, int wave, const EpiS& Es) {
    if (blockIdx.x >= 192) { int tid = tid_in; asm volatile("" : "+v"(tid));
        small_tile<1024, true>((const bf16_t*)(P.ws + WS_YCAT) + (size_t)MP * 1024, (const bf16_t*)(P.ws + WS_W2T), Es, (const float*)(P.ws + WS_SSQ), lds, blockIdx.x - 192, tid, tid & 63, wave); }
#ifdef DBL_M3
    for (int rep = 0; rep < 2; ++rep)
#endif
    { int tid = tid_in; asm volatile("" : "+v"(tid));
      Ml3In cur, nxt; ml3_load(P, blockIdx.x, tid, tid & 63, wave, cur);
#pragma unroll 1
      for (int item = blockIdx.x; item < 2048; item += gridDim.x) {
          const int nitem = item + gridDim.x;
          if (nitem < 2048) ml3_load(P, nitem, tid, tid & 63, wave, nxt);
          ml3_item(P, lds, item, cur, tid, tid & 63, wave);
          cur = nxt;
      } }
    { int tid = tid_in; asm volatile("" : "+v"(tid)); phase3b(P, tid & 63, blockIdx.x * 8 + wave, gridDim.x * 8); }
}

__global__ void __launch_bounds__(512, 2) fwd(Params P) {
    extern __shared__ __attribute__((aligned(16))) unsigned char lds_raw[];
    lptr lds = (lptr)lds_raw;
    cg::grid_group grid = cg::this_grid();
    int tid = threadIdx.x, lane = tid & 63; const int wave = __builtin_amdgcn_readfirstlane(tid >> 6);
#define FRESH_TID() do { asm volatile("" : "+v"(tid)); lane = tid & 63; } while (0)
    const int gw = blockIdx.x * 8 + wave, NGW = gridDim.x * 8;
    unsigned char* ws = P.ws;
    const float* MOD = (const float*)(ws + WS_MOD);
    bf16_t* H = (bf16_t*)(ws + WS_H); bf16_t* PROJ = (bf16_t*)(ws + WS_PROJ); bf16_t* YC = (bf16_t*)(ws + WS_YCAT); bf16_t* ACT = (bf16_t*)(ws + WS_ACT);

#ifndef G_ALIGN
#define G_ALIGN true
#endif
#ifndef G_SP2
#define G_SP2 true
#endif
#ifndef PH
#define PH 0xFFFF
#endif
    if (tid == 0) { *(LAS unsigned*)(lds + LDS_BYTES - 32) = 0u; *(LAS unsigned*)(lds + LDS_BYTES - 28) = 0u; }
    __syncthreads();
    const XcdBarrier bar = xcd_barrier_post((unsigned*)(ws + WS_CTL) + 1024, (volatile LAS unsigned*)(lds + LDS_BYTES - 32));
    __syncthreads();
    const unsigned xrank = *(volatile LAS unsigned*)(lds + LDS_BYTES - 24);
    const int vcu = (xrank < 32u && bar.x < 8u) ? (int)(xrank * 8u + bar.x) : (int)blockIdx.x;
    if (P.out == nullptr) grid.sync();
    phase0(P, lds, tid, lane, wave);
#ifdef DBL_P0
    __syncthreads(); phase0(P, lds, tid, lane, wave);
#endif
    xcd_barrier(bar);
    FRESH_TID();
    phase1(P, lds, tid, lane, wave);
    __syncthreads();
    phase_weights(P, lds, lane, wave);
#ifdef DBL_P1
    __syncthreads(); phase1(P, lds, tid, lane, wave);
#endif
#ifdef DBL_P1NG
    __syncthreads(); phase1_nogates(P, lds, tid, lane, wave);
#endif
#ifdef DBL_W
    __syncthreads(); phase_weights(P, lds, lane, wave);
#endif
    xcd_barrier(bar);
    FRESH_TID();
    {
        EpiProj E{PROJ, P.out + O_PK, P.out + O_PV, P.in[I_SQW], P.in[I_SKW], 0};
        pg8::Gemm g{H, (const bf16_t*)(ws + WS_W1T), MP, NPROJ, 1024}; pg8::StaticOrder S; S.init(MP, NPROJ, gridDim.x, vcu);
        pg8::gemm_phase<EpiProj, pg8::StaticOrder, G_ALIGN, G_SP2>(lds, g, S, E);
#ifdef DBL_G
        pg8::gemm_phase<EpiProj, pg8::StaticOrder, G_ALIGN, G_SP2>(lds, g, S, E);
#endif
    }
    xcd_barrier(bar);
    FRESH_TID();
    {
        EpiProj Es{PROJ, P.out + O_SK, P.out + O_SV, P.in[I_SQW], P.in[I_SKW], MP};
        phase_mixers(P, lds, tid, wave, Es);
    }
    xcd_barrier(bar);
    FRESH_TID();
    phase_ml2(P, lds, tid, wave);
#ifdef DBL_M2
    __syncthreads(); phase_ml2(P, lds, tid, wave);
#endif
    xcd_barrier(bar);
    FRESH_TID();
    {
        EpiRes<0> Es{P.in[I_XS], (bf16_t*)(ws + WS_X1B) + (size_t)MP * 1024, MOD + 8 * 6144 + 2048, 5};
        phase_ml3(P, lds, tid, wave, Es);
    }
#ifdef XSYNC
    for (int i = 0; i < XSYNC; ++i) xcd_barrier(bar);
#endif
    xcd_barrier(bar);
    FRESH_TID();
    {
        sample_h2_row(P, lds, tid, lane, wave);
        EpiRes<0> E{P.in[I_XP], ws + WS_X1B, MOD + 2048, 12};
        pg8::Gemm g{YC, (const bf16_t*)(ws + WS_W2T), MP, 1024, 1024}; pg8::StaticOrder S; S.init(MP, 1024, gridDim.x, vcu);
        pg8::gemm_phase<EpiRes<0>, pg8::StaticOrder, G_ALIGN, G_SP2>(lds, g, S, E);
    }
    xcd_barrier(bar);
    FRESH_TID();
    {
        phase5(P, lds, tid, lane, wave);
#ifdef DBL_P5
        phase5(P, lds, tid, lane, wave);
#endif
        EpiFFNs Es{ACT, P.out + O_SF, P.in[I_SFC], P.in[I_WCONV], P.in[I_BCONV]};
        for (int t = blockIdx.x; t < 352; t += gridDim.x) small_tile<1024, false>(H + (size_t)MP * 1024, (const bf16_t*)(ws + WS_W3T), Es, nullptr, lds, t, tid, lane, wave);
    }
    xcd_barrier(bar);
    FRESH_TID();
    {
        EpiFFN E{ACT, (float*)(ws + WS_UEDGE), P.out + O_PF, P.in[I_WCONV], P.in[I_BCONV]};
        pg8::Gemm g{H, (const bf16_t*)(ws + WS_W3T), MP, FF2, 1024}; pg8::StaticOrder S; S.init(MP, FF2, gridDim.x, vcu);
        pg8::gemm_phase<EpiFFN, pg8::StaticOrder, true, G_SP2>(lds, g, S, E);
#ifdef DBL_G
        pg8::gemm_phase<EpiFFN, pg8::StaticOrder, true, G_SP2>(lds, g, S, E);
#endif
    }
    xcd_barrier(bar);
    FRESH_TID();
    {
        phase_fix(P, tid);
        EpiRes<1> Es{(const bf16_t*)(ws + WS_X1B) + (size_t)MP * 1024, P.out + O_YS, MOD + 8 * 6144 + 5120, 5};
        if (blockIdx.x < 64) small_tile<FF, false>(ACT + (size_t)MP * FF, (const bf16_t*)(ws + WS_W4T), Es, nullptr, lds, blockIdx.x, tid, lane, wave);
    }
    xcd_barrier(bar);
    FRESH_TID();
    {
        EpiRes<1> E{ws + WS_X1B, P.out + O_YP, MOD + 5120, 12};
        pg8::Gemm g{ACT, (const bf16_t*)(ws + WS_W4T), MP, 1024, FF}; pg8::StaticOrder S; S.init(MP, 1024, gridDim.x, vcu);
        pg8::gemm_phase<EpiRes<1>, pg8::StaticOrder, G_ALIGN, G_SP2>(lds, g, S, E);
    }

#ifdef DIAG
    xcd_barrier(bar);
    {
        const size_t offs[15] = {O_YP, O_YS, O_PC, O_PN, O_PM, O_PK, O_PV, O_PF, O_SC, O_SN, O_SM, O_SK, O_SV, O_SF, O_END};
        for (int o = 0; o < 14; ++o) if ((DIAG >> o) & 1) for (size_t i = offs[o] + (size_t)blockIdx.x * 512 + tid; i < offs[o + 1]; i += (size_t)gridDim.x * 512) P.out[i] *= 1.2f;
    }
#endif
}

extern "C" void kernel_launch(void* const* d_in, const int* in_sizes, int n_in, void* d_out, int out_size, void* d_ws, size_t ws_size, hipStream_t stream) {
    static int grid_blocks = 0;
    if (!grid_blocks) {
        int dev = 0, cus = 0, per_cu = 0;
        (void)hipGetDevice(&dev);
        (void)hipDeviceGetAttribute(&cus, hipDeviceAttributeMultiprocessorCount, dev);
        (void)hipFuncSetAttribute((const void*)fwd, hipFuncAttributeMaxDynamicSharedMemorySize, LDS_BYTES);
        (void)hipOccupancyMaxActiveBlocksPerMultiprocessor(&per_cu, (const void*)fwd, 512, LDS_BYTES);
        grid_blocks = cus;
        if (n_in != 26 || out_size != (int)O_END || ws_size < WS_END2 || cus != 256 || per_cu < 1) {
            fprintf(stderr, "kernel_launch: unexpected geometry: n_in %d out %d ws %zu cus %d per_cu %d\n", n_in, out_size, ws_size, cus, per_cu);
            if (n_in != 26 || out_size != (int)O_END || ws_size < WS_END2 || cus != 256) grid_blocks = -1;
        }
    }
    if (grid_blocks < 0) return;
    if (hipMemsetAsync((char*)d_ws + WS_CTL, 0, (1024 + XCD_BAR_WORDS) * 4, stream) != hipSuccess) { fprintf(stderr, "kernel_launch: memset of the control words failed\n"); return; }
    Params p{};
    for (int i = 0; i < 26; ++i) p.in[i] = (const float*)d_in[i];
    p.out = (float*)d_out; p.ws = (unsigned char*)d_ws;
    void* args[] = {&p};
    hipError_t e = hipLaunchCooperativeKernel((const void*)fwd, dim3(grid_blocks), dim3(512), args, LDS_BYTES, stream);
    if (e != hipSuccess) fprintf(stderr, "cooperative launch failed: %s (grid %d)\n", hipGetErrorString(e), grid_blocks);
}
```

```cpp
#include <hip/hip_runtime.h>
#include <hip/hip_cooperative_groups.h>
#include <cstdio>
#include <cstdint>
namespace cg = cooperative_groups;

#define LAS __attribute__((address_space(3)))
typedef unsigned short bf16_t;
typedef short bf16x8 __attribute__((ext_vector_type(8)));
typedef short s16x4 __attribute__((ext_vector_type(4)));
typedef float f32x2 __attribute__((ext_vector_type(2)));
typedef float f32x4 __attribute__((ext_vector_type(4)));
typedef float f32x16 __attribute__((ext_vector_type(16)));
typedef unsigned u32x2 __attribute__((ext_vector_type(2)));
typedef unsigned u32x4 __attribute__((ext_vector_type(4)));
typedef __bf16 bf16x2_t __attribute__((ext_vector_type(2)));
typedef LAS unsigned char* lptr;
typedef const LAS unsigned char* clptr;

constexpr int DM = 1024, SEQ = 4096, NB = 8, MP = NB * SEQ, DEC = 32, MS = NB * DEC, MT = MP + MS, PAST = 2048;
constexpr int DIN = 3592, NPROJ = 3584, FF = 2816, FF2 = 5632;
constexpr float EPS = 1e-6f;
constexpr float LOG2E = 1.4426950408889634f;
constexpr size_t O_YP = 0, O_YS = 33554432, O_PC = 33816576, O_PN = 34340864, O_PM = 34344960, O_PK = 34344992, O_PV = 51122208,
                 O_PF = 67899424, O_SC = 67989536, O_SN = 68513824, O_SM = 68517920, O_SK = 68517952, O_SV = 68649024, O_SF = 68780096, O_END = 68870208;
constexpr size_t MiB = 1u << 20;
constexpr size_t WS_CTL = 0, WS_MODP = 1 * MiB, WS_MOD = 7 * MiB, WS_GATES = 8 * MiB, WS_SSQ = 10 * MiB, WS_UEDGE = 12 * MiB,
                 WS_W1T = 24 * MiB, WS_W2T = 31 * MiB, WS_W3T = 33 * MiB, WS_W4T = 44 * MiB, WS_H = 52 * MiB, WS_PROJ = 120 * MiB,
                 PROJ_STRIDE = 33 * MiB, WS_YCAT = 352 * MiB, WS_ACT = 120 * MiB, WS_END = 420 * MiB;
constexpr size_t WS_X1B = 424 * MiB;
constexpr int LDS_BYTES = 147456;
constexpr int QOFF = LDS_BYTES - 64;

struct Params { const float* in[26]; float* out; unsigned char* ws; };
enum { I_XP = 0, I_XS, I_CP, I_CS, I_STC, I_STN, I_STM, I_CK, I_CV, I_SFC, I_WADA, I_BADA, I_N1W, I_WIN, I_BIG, I_BFG, I_MLW, I_SQW, I_SKW, I_SOW,
       I_WOUT, I_N2W, I_WUP, I_WCONV, I_BCONV, I_WDOWN };

__device__ __forceinline__ unsigned cvtpk(float lo, float hi) { f32x2 v = {lo, hi}; bf16x2_t b = __builtin_convertvector(v, bf16x2_t); return __builtin_bit_cast(unsigned, b); }
__device__ __forceinline__ float bf2f(unsigned short x) { return __uint_as_float((unsigned)x << 16); }
__device__ __forceinline__ float bflo(unsigned w) { return __uint_as_float(w << 16); }
__device__ __forceinline__ float bfhi(unsigned w) { return __uint_as_float(w & 0xffff0000u); }
__device__ __forceinline__ unsigned short f2bf(float f) { return (unsigned short)(cvtpk(f, 0.f) & 0xffffu); }
__device__ __forceinline__ float wave_sum(float v) {
#pragma unroll
    for (int o = 1; o < 64; o <<= 1) v += __shfl_xor(v, o);
    return v;
}
__device__ __forceinline__ float fast_exp2(float x) { return __builtin_amdgcn_exp2f(x); }
__device__ __forceinline__ float fast_rcp(float x) { return __builtin_amdgcn_rcpf(x); }
__device__ __forceinline__ float sigmoidf_(float x) { return fast_rcp(1.f + fast_exp2(-x * LOG2E)); }
__device__ __forceinline__ int crow(int r, int hi) { return (r & 3) + 8 * (r >> 2) + 4 * hi; }
typedef short v4i16_t __attribute__((ext_vector_type(4)));
__device__ __forceinline__ s16x4 tr_read(clptr p) { return __builtin_bit_cast(s16x4, __builtin_amdgcn_ds_read_tr16_b64_v4i16((LAS v4i16_t*)p)); }
__device__ __forceinline__ bf16x8 tr_frag(clptr base, int P, int R0, int C0, int lane) {
    const int h = lane >> 5, blk = (lane >> 4) & 1, q = (lane & 15) >> 2, p = lane & 3;
    clptr a = base + (R0 + 8 * h + q) * P + (C0 + 16 * blk + 4 * p) * 2;
    const s16x4 lo = tr_read(a), hi = tr_read(a + 4 * P);
    return (bf16x8){lo[0], lo[1], lo[2], lo[3], hi[0], hi[1], hi[2], hi[3]};
}
__device__ __forceinline__ bf16x8 row_frag(clptr base, int P, int R0, int K0, int lane) {
    return *(const LAS bf16x8*)(base + (R0 + (lane & 31)) * P + (K0 + 8 * (lane >> 5)) * 2);
}
#define MFMA32(a, b, c) __builtin_amdgcn_mfma_f32_32x32x16_bf16((a), (b), (c), 0, 0, 0)
#define MFMA16(a, b, c) __builtin_amdgcn_mfma_f32_16x16x32_bf16((a), (b), (c), 0, 0, 0)

namespace pg8 {
#define PG8_LAS __attribute__((address_space(3)))
typedef unsigned short bf16_t;
typedef short bf16x8 __attribute__((ext_vector_type(8)));
typedef float f32x4 __attribute__((ext_vector_type(4)));
typedef unsigned u32x4 __attribute__((ext_vector_type(4)));
constexpr int BM = 256, BK = 64, HALF = 128, HTB = HALF * BK * 2  , STAGE_BYTES = 8 * HTB, NXCD = 8, WGM = 8;

__host__ __device__ __forceinline__ int lds_byte(int r, int c) { const int st = (r >> 4) * 2 + (c >> 5), rr = r & 15, cc = c & 31, ob = rr * 64 + cc * 2; return st * 1024 + (ob ^ (((ob >> 9) & 1) << 5)); }
__host__ __device__ __forceinline__ void stage_rc(int b, int& R, int& C) { const int st = b / 1024, sb = b % 1024, swz = sb ^ (((sb >> 9) & 1) << 5); R = (st >> 1) * 16 + swz / 64; C = (st & 1) * 32 + (swz % 64) / 2; }
__host__ __device__ __forceinline__ int perm32(int rho) { const int n = rho >> 4, i = rho & 15; return 8 * (i >> 2) + 4 * n + (i & 3); }

struct Unit { int pm, pn; };
struct Gemm { const bf16_t* A; const bf16_t* Bt; int M, N, K; };

struct StaticOrder {
    int nM, nN, nwg, G, c;
    __host__ __device__ void init(int M, int N, int G_, int c_) { nM = M / BM; nN = N / BM; nwg = nM * nN; G = G_; c = c_; }
    __host__ __device__ bool next(int i, Unit& u) const {
        const long L = (long)i * G + c; if (L >= nwg) return false;
        int wgid = (int)L; { const int q = nwg / NXCD, r = nwg % NXCD, xcd = wgid % NXCD, off = wgid / NXCD; wgid = (xcd < r ? xcd * (q + 1) : r * (q + 1) + (xcd - r) * q) + off; }
        const int nig = WGM * nN, gid = wgid / nig, fm = gid * WGM, gsz = (nM - fm) < WGM ? (nM - fm) : WGM;
        u.pm = fm + ((wgid % nig) % gsz); u.pn = (wgid % nig) / gsz; return true;
    }
    __device__ __forceinline__ void a_ready(const Unit&) const {}
    __device__ __forceinline__ void done(const Unit&) const {}
};

template <class Epi, class Sched, bool ALIGN_EPI = false, bool SP2 = false>
__device__ __forceinline__ void gemm_phase(PG8_LAS unsigned char* lds, const Gemm g, const Sched& S, const Epi& E) {
    int tid_o = threadIdx.x; asm volatile("" : "+v"(tid_o));
    const int tid = tid_o, wid = __builtin_amdgcn_readfirstlane(tid >> 6), lane = tid & 63, wr = wid >> 2, wc = wid & 3, fr = lane & 15, fq = lane >> 4;
    const int K = g.K, nt = K / BK;
    unsigned voffA[2], voffB[2];
#pragma unroll
    for (int i = 0; i < 2; ++i) { int R, C; stage_rc(tid * 16 + i * 8192, R, C); const int Rb = Epi::PERM ? ((R & ~31) + perm32(R & 31)) : R;
        voffA[i] = (unsigned)(R * K + C) * 2u; voffB[i] = (unsigned)(Rb * K + C) * 2u; }
    const size_t kstep = (size_t)(BK * 2);
    const size_t hstep = (size_t)HALF * K * 2;
    const size_t tstep = 2 * hstep;
    const unsigned ldsw = (unsigned)wid * 1024u;
    const int aoff = lds_byte(wr * 64 + fr, fq * 8), boff = lds_byte(wc * 32 + fr, fq * 8);
#define PG8_SA(b, h) (((b) * 2 + (h)) * HTB)
#define PG8_SB(b, h) ((4 + (b) * 2 + (h)) * HTB)
#define PG8_STAGE(bufoff, gbase, voff) do { _Pragma("unroll") for (int _i = 0; _i < 2; ++_i) \
        __builtin_amdgcn_global_load_lds((const unsigned*)((const char*)(gbase) + (voff)[_i]), (PG8_LAS unsigned*)(lds + (bufoff) + ldsw + _i * 8192), 16, 0, 0); } while (0)
#define PG8_LDA(dst, b, h) do { _Pragma("unroll") for (int m = 0; m < 4; ++m) _Pragma("unroll") for (int k = 0; k < 2; ++k) dst[m][k] = *(const PG8_LAS bf16x8*)(lds + PG8_SA(b, h) + aoff + m * 2048 + k * 1024); } while (0)
#define PG8_LDB(dst, b, h) do { _Pragma("unroll") for (int n = 0; n < 2; ++n) _Pragma("unroll") for (int k = 0; k < 2; ++k) dst[n][k] = *(const PG8_LAS bf16x8*)(lds + PG8_SB(b, h) + boff + n * 2048 + k * 1024); } while (0)
#define PG8_MMA(ai, bj, At, Bt) do { __builtin_amdgcn_s_setprio(1); _Pragma("unroll") for (int m = 0; m < 4; ++m) _Pragma("unroll") for (int n = 0; n < 2; ++n) _Pragma("unroll") for (int k = 0; k < 2; ++k) \
        acc[ai][bj][m][n] = __builtin_amdgcn_mfma_f32_16x16x32_bf16(Bt[n][k], At[m][k], acc[ai][bj][m][n], 0, 0, 0); __builtin_amdgcn_s_setprio(0); } while (0)
#define PG8_WAIT_V(n) asm volatile("s_waitcnt vmcnt(" #n ")" ::: "memory")
#define PG8_WAIT_L(n) asm volatile("s_waitcnt lgkmcnt(" #n ")" ::: "memory")
#define PG8_BAR __builtin_amdgcn_s_barrier()
#define PG8_SCHED __builtin_amdgcn_sched_barrier(0)
    Unit cur, nxt; int ui = 0;
    if (!S.next(0, cur)) return;
    f32x4 acc[2][2][4][2];
#pragma unroll
    for (int a = 0; a < 2; ++a)
#pragma unroll
        for (int b = 0; b < 2; ++b)
#pragma unroll
            for (int m = 0; m < 4; ++m)
#pragma unroll
                for (int n = 0; n < 2; ++n) acc[a][b][m][n] = (f32x4){0.f, 0.f, 0.f, 0.f};
    bf16x8 At[4][2], B0[2][2], B1[2][2];
    const char* cA = (const char*)g.A + (size_t)cur.pm * tstep; const char* cB = (const char*)g.Bt + (size_t)cur.pn * tstep;
    S.a_ready(cur);
    if constexpr (SP2) {
        PG8_STAGE(PG8_SB(0, 0), cB, voffB); PG8_STAGE(PG8_SB(0, 1), cB + hstep, voffB); PG8_STAGE(PG8_SA(0, 0), cA, voffA); PG8_STAGE(PG8_SA(0, 1), cA + hstep, voffA);
        if (wr == 1) PG8_BAR;
        PG8_WAIT_V(2); PG8_BAR;
        PG8_STAGE(PG8_SB(1, 0), cB + kstep, voffB); PG8_STAGE(PG8_SA(1, 0), cA + kstep, voffA); PG8_STAGE(PG8_SB(1, 1), cB + hstep + kstep, voffB);
        PG8_WAIT_V(6); PG8_BAR;
    } else {
        PG8_STAGE(PG8_SB(0, 0), cB, voffB); PG8_STAGE(PG8_SA(0, 0), cA, voffA); PG8_STAGE(PG8_SB(0, 1), cB + hstep, voffB); PG8_STAGE(PG8_SA(0, 1), cA + hstep, voffA);
        if (wr == 1) PG8_BAR;
        PG8_WAIT_V(4); PG8_BAR;
        PG8_STAGE(PG8_SB(1, 0), cB + kstep, voffB); PG8_STAGE(PG8_SA(1, 0), cA + kstep, voffA); PG8_STAGE(PG8_SB(1, 1), cB + hstep + kstep, voffB);
        PG8_WAIT_V(6); PG8_BAR;
    }
    for (;;) {
        const bool has_next = S.next(ui + 1, nxt);
        const char* nA = has_next ? (const char*)g.A + (size_t)nxt.pm * tstep : cA; const char* nB = has_next ? (const char*)g.Bt + (size_t)nxt.pn * tstep : cB;
        for (int t = 0; t < nt; t += 2) {
            const bool last = (t == nt - 2);
            const char* a1 = cA + (size_t)(t + 1) * kstep;
            const char* a2 = last ? nA : cA + (size_t)(t + 2) * kstep; const char* b2 = last ? nB : cB + (size_t)(t + 2) * kstep;
            const char* a3 = a2 + kstep; const char* b3 = b2 + kstep;
            if (last && has_next) S.a_ready(nxt);
            if constexpr (SP2) {
            PG8_LDB(B0, 0, 0); PG8_LDB(B1, 0, 1); PG8_SCHED; PG8_LDA(At, 0, 0); PG8_STAGE(PG8_SA(1, 1), a1 + hstep, voffA);
            PG8_WAIT_V(8); PG8_WAIT_L(0); PG8_BAR; PG8_MMA(0, 0, At, B0); PG8_MMA(0, 1, At, B1); PG8_BAR; PG8_SCHED;
            PG8_LDA(At, 0, 1); PG8_STAGE(PG8_SB(0, 0), b2, voffB); PG8_STAGE(PG8_SB(0, 1), b2 + hstep, voffB); PG8_STAGE(PG8_SA(0, 0), a2, voffA);
            PG8_WAIT_V(8); PG8_WAIT_L(0); PG8_BAR; PG8_MMA(1, 0, At, B0); PG8_MMA(1, 1, At, B1); PG8_BAR; PG8_SCHED;
            PG8_LDB(B0, 1, 0); PG8_LDB(B1, 1, 1); PG8_SCHED; PG8_LDA(At, 1, 0); PG8_STAGE(PG8_SA(0, 1), a2 + hstep, voffA);
            PG8_WAIT_V(8); PG8_WAIT_L(0); PG8_BAR; PG8_MMA(0, 0, At, B0); PG8_MMA(0, 1, At, B1); PG8_BAR; PG8_SCHED;
            PG8_LDA(At, 1, 1); PG8_STAGE(PG8_SB(1, 0), b3, voffB); PG8_STAGE(PG8_SB(1, 1), b3 + hstep, voffB); PG8_STAGE(PG8_SA(1, 0), a3, voffA);
            PG8_WAIT_V(8); PG8_WAIT_L(0); PG8_BAR; PG8_MMA(1, 0, At, B0); PG8_MMA(1, 1, At, B1); PG8_BAR; PG8_SCHED;
            } else {
            PG8_LDB(B0, 0, 0); PG8_SCHED; PG8_LDA(At, 0, 0); PG8_STAGE(PG8_SA(1, 1), a1 + hstep, voffA);
            PG8_WAIT_L(8); PG8_BAR; PG8_WAIT_L(0); PG8_MMA(0, 0, At, B0); PG8_BAR; PG8_SCHED;
            PG8_LDB(B1, 0, 1); PG8_STAGE(PG8_SB(0, 0), b2, voffB);
            PG8_BAR; PG8_WAIT_L(0); PG8_MMA(0, 1, At, B1); PG8_BAR;
            PG8_LDA(At, 0, 1); PG8_STAGE(PG8_SA(0, 0), a2, voffA);
            PG8_BAR; PG8_WAIT_L(0); PG8_MMA(1, 0, At, B0); PG8_BAR; PG8_SCHED;
            PG8_STAGE(PG8_SB(0, 1), b2 + hstep, voffB);
            PG8_WAIT_V(6); PG8_BAR; PG8_MMA(1, 1, At, B1); PG8_BAR;
            PG8_LDB(B0, 1, 0); PG8_SCHED; PG8_LDA(At, 1, 0); PG8_STAGE(PG8_SA(0, 1), a2 + hstep, voffA);
            PG8_WAIT_L(8); PG8_BAR; PG8_WAIT_L(0); PG8_MMA(0, 0, At, B0); PG8_BAR; PG8_SCHED;
            PG8_LDB(B1, 1, 1); PG8_STAGE(PG8_SB(1, 0), b3, voffB);
            PG8_BAR; PG8_WAIT_L(0); PG8_MMA(0, 1, At, B1); PG8_BAR;
            PG8_LDA(At, 1, 1); PG8_STAGE(PG8_SA(1, 0), a3, voffA);
            PG8_BAR; PG8_WAIT_L(0); PG8_MMA(1, 0, At, B0); PG8_BAR; PG8_SCHED;
            PG8_STAGE(PG8_SB(1, 1), b3 + hstep, voffB);
            PG8_WAIT_V(6); PG8_BAR; PG8_MMA(1, 1, At, B1); PG8_BAR;
            }
        }
        if constexpr (ALIGN_EPI) { if (wr == 0) PG8_BAR; }
        if constexpr (!Epi::AFTER_DRAIN) { E(acc, cur, wr, wc, fr, fq, lds); S.done(cur); }
        if (!has_next) break;
#pragma unroll
        for (int a = 0; a < 2; ++a)
#pragma unroll
            for (int b = 0; b < 2; ++b)
#pragma unroll
                for (int m = 0; m < 4; ++m)
#pragma unroll
                    for (int n = 0; n < 2; ++n) acc[a][b][m][n] = (f32x4){0.f, 0.f, 0.f, 0.f};
        cur = nxt; cA = nA; cB = nB; ++ui;
        if constexpr (ALIGN_EPI) { if (wr == 1) PG8_BAR; }
    }
    PG8_WAIT_V(0);
    if constexpr (!ALIGN_EPI) { if (wr == 0) PG8_BAR; }
    PG8_BAR;
    if constexpr (Epi::AFTER_DRAIN) { E.fused(acc, cur, wr, wc, fr, fq, lds, wid, lane); S.done(cur); }
#undef PG8_SA
#undef PG8_SB
#undef PG8_STAGE
#undef PG8_LDA
#undef PG8_LDB
#undef PG8_MMA
#undef PG8_WAIT_V
#undef PG8_WAIT_L
#undef PG8_BAR
#undef PG8_SCHED
}
}

__device__ __forceinline__ u32x4 pack8(const f32x4& v0, const f32x4& v1) { u32x4 w; w.x = cvtpk(v0[0], v0[1]); w.y = cvtpk(v0[2], v0[3]); w.z = cvtpk(v1[0], v1[1]); w.w = cvtpk(v1[2], v1[3]); return w; }

struct EpiProj {
    static constexpr bool PERM = true, AFTER_DRAIN = false;
    bf16_t* proj; float* outK; float* outV; const float* qw; const float* kw; int rowoff;
    __device__ __forceinline__ void sub(const f32x4 (&a)[2][4][2], int pn, int rloc0, int wc, int fr, int fq) const {
        const int kind = pn >> 1, half = pn & 1;
        const int c8 = 256 * half + 64 * wc + 8 * fq;
        bf16_t* ob = proj + (size_t)kind * (PROJ_STRIDE / 2);
        if (kind < 4) {
#pragma unroll
            for (int m = 0; m < 4; ++m) { const size_t row = (size_t)(rowoff + rloc0 + 16 * m + fr);
#pragma unroll
                for (int bj = 0; bj < 2; ++bj) { f32x4 v0 = a[bj][m][0], v1 = a[bj][m][1];
                    if (kind == 1) { v0 = v0 * 0.08838834764831845f; v1 = v1 * 0.08838834764831845f; }
                    if (kind == 3) {
#pragma unroll
                        for (int e = 0; e < 4; ++e) { v0[e] = sigmoidf_(v0[e]); v1[e] = sigmoidf_(v1[e]); } }
                    *(u32x4*)(ob + row * 512 + c8 + 32 * bj) = pack8(v0, v1); } }
        } else if (kind < 6) {
            const float* w = kind == 4 ? qw : kw; const float osc = kind == 4 ? 0.125f * LOG2E : 1.f;
            f32x4 wv[2][2];
#pragma unroll
            for (int bj = 0; bj < 2; ++bj)
#pragma unroll
                for (int n = 0; n < 2; ++n) wv[bj][n] = *(const f32x4*)(w + 32 * bj + 8 * fq + 4 * n);
#pragma unroll
            for (int m = 0; m < 4; ++m) { const int rl = rloc0 + 16 * m + fr; float ss = 0.f;
#pragma unroll
                for (int bj = 0; bj < 2; ++bj)
#pragma unroll
                    for (int n = 0; n < 2; ++n) { const f32x4 x = a[bj][m][n]; ss += (x[0] * x[0] + x[1] * x[1]) + (x[2] * x[2] + x[3] * x[3]); }
                ss += __shfl_xor(ss, 16); ss += __shfl_xor(ss, 32);
                const float rstd = rsqrtf(ss * (1.f / 64.f) + EPS);
#pragma unroll
                for (int bj = 0; bj < 2; ++bj) { f32x4 v0 = a[bj][m][0] * rstd * wv[bj][0], v1 = a[bj][m][1] * rstd * wv[bj][1];
                    if (kind == 5) { float* o = outK + (size_t)rl * 512 + c8 + 32 * bj; __builtin_nontemporal_store(v0, (f32x4*)o); __builtin_nontemporal_store(v1, (f32x4*)(o + 4)); }
                    v0 = v0 * osc; v1 = v1 * osc;
                    *(u32x4*)(ob + (size_t)(rowoff + rl) * 512 + c8 + 32 * bj) = pack8(v0, v1); } }
        } else {
#pragma unroll
            for (int m = 0; m < 4; ++m) { const int rl = rloc0 + 16 * m + fr;
#pragma unroll
                for (int bj = 0; bj < 2; ++bj) { const f32x4 v0 = a[bj][m][0], v1 = a[bj][m][1];
                    float* o = outV + (size_t)rl * 512 + c8 + 32 * bj; __builtin_nontemporal_store(v0, (f32x4*)o); __builtin_nontemporal_store(v1, (f32x4*)(o + 4));
                    *(u32x4*)(ob + (size_t)(rowoff + rl) * 512 + c8 + 32 * bj) = pack8(v0, v1); } }
        }
    }
    __device__ __forceinline__ void operator()(const f32x4 (&acc)[2][2][4][2], const pg8::Unit& u, int wr, int wc, int fr, int fq, lptr) const {
#pragma unroll
        for (int ai = 0; ai < 2; ++ai) sub(acc[ai], u.pn, u.pm * 256 + ai * 128 + wr * 64, wc, fr, fq);
    }
};

template <int MODE>
struct EpiRes {
    static constexpr bool PERM = true, AFTER_DRAIN = false;
    const void* xin; void* xout; const float* gate; int tlog;
    __device__ __forceinline__ void sub(const f32x4 (&a)[2][4][2], int pn, int rloc0, int wc, int fr, int fq) const {
#pragma unroll
        for (int m = 0; m < 4; ++m) { const int rl = rloc0 + 16 * m + fr; const float* g = gate + (size_t)(rl >> tlog) * 6144;
#pragma unroll
            for (int bj = 0; bj < 2; ++bj) { const int c = 256 * pn + 128 * bj + 32 * wc + 8 * fq;
                const f32x4 g0 = *(const f32x4*)(g + c), g1 = *(const f32x4*)(g + c + 4);
                if (MODE == 0) {
                    const float* xp = (const float*)xin + (size_t)rl * 1024 + c;
                    const f32x4 o0 = *(const f32x4*)xp + g0 * a[bj][m][0], o1 = *(const f32x4*)(xp + 4) + g1 * a[bj][m][1];
                    *(u32x4*)((bf16_t*)xout + (size_t)rl * 1024 + c) = pack8(o0, o1);
                } else {
                    const u32x4 xv = *(const u32x4*)((const bf16_t*)xin + (size_t)rl * 1024 + c);
                    const f32x4 x0 = {bflo(xv.x), bfhi(xv.x), bflo(xv.y), bfhi(xv.y)}, x1 = {bflo(xv.z), bfhi(xv.z), bflo(xv.w), bfhi(xv.w)};
                    float* op = (float*)xout + (size_t)rl * 1024 + c;
                    __builtin_nontemporal_store(x0 + g0 * a[bj][m][0], (f32x4*)op); __builtin_nontemporal_store(x1 + g1 * a[bj][m][1], (f32x4*)(op + 4));
                } } }
    }
    __device__ __forceinline__ void operator()(const f32x4 (&acc)[2][2][4][2], const pg8::Unit& u, int wr, int wc, int fr, int fq, lptr) const {
#pragma unroll
        for (int ai = 0; ai < 2; ++ai) sub(acc[ai], u.pn, u.pm * 256 + ai * 128 + wr * 64, wc, fr, fq);
    }
};

__device__ __forceinline__ float dpp_ror1(float x) { return __int_as_float(__builtin_amdgcn_update_dpp(0, __float_as_int(x), 0x121, 0xf, 0xf, false)); }
__device__ __forceinline__ float dpp_ror2(float x) { return __int_as_float(__builtin_amdgcn_update_dpp(0, __float_as_int(x), 0x122, 0xf, 0xf, false)); }
struct ConvW { f32x4 w0a, w1a, w2a, ba, w0g, w1g, w2g, bg; };
__device__ __forceinline__ ConvW load_convw(const float* wconv, const float* bconv, int c) {
    ConvW w; w.w0a = *(const f32x4*)(wconv + c); w.w1a = *(const f32x4*)(wconv + FF2 + c); w.w2a = *(const f32x4*)(wconv + 2 * FF2 + c); w.ba = *(const f32x4*)(bconv + c);
    w.w0g = *(const f32x4*)(wconv + FF + c); w.w1g = *(const f32x4*)(wconv + FF2 + FF + c); w.w2g = *(const f32x4*)(wconv + 2 * FF2 + FF + c); w.bg = *(const f32x4*)(bconv + FF + c); return w;
}
template <int CTRL> __device__ __forceinline__ float dppz(float x) { return __int_as_float(__builtin_amdgcn_update_dpp(0, __float_as_int(x), CTRL, 0xf, 0xf, true)); }
__device__ __forceinline__ u32x2 conv_gate4(const f32x4& ca, const f32x4& cg, const f32x4& pa, const f32x4& pg, const ConvW& w, int) {
    float o[4];
#pragma unroll
    for (int e = 0; e < 4; ++e) {
        float ua = fmaf(w.w2a[e], ca[e], w.ba[e]);
        ua = fmaf(dppz<0x111>(ca[e]), w.w1a[e], ua); ua = fmaf(dppz<0x10F>(pa[e]), w.w1a[e], ua);
        ua = fmaf(dppz<0x112>(ca[e]), w.w0a[e], ua); ua = fmaf(dppz<0x10E>(pa[e]), w.w0a[e], ua);
        float ug = fmaf(w.w2g[e], cg[e], w.bg[e]);
        ug = fmaf(dppz<0x111>(cg[e]), w.w1g[e], ug); ug = fmaf(dppz<0x10F>(pg[e]), w.w1g[e], ug);
        ug = fmaf(dppz<0x112>(cg[e]), w.w0g[e], ug); ug = fmaf(dppz<0x10E>(pg[e]), w.w0g[e], ug);
        o[e] = ua * sigmoidf_(ua) * ug;
    }
    u32x2 r; r.x = cvtpk(o[0], o[1]); r.y = cvtpk(o[2], o[3]); return r;
}
struct EpiFFN {
    static constexpr bool PERM = true, AFTER_DRAIN = false;
    bf16_t* act; float* uedge; float* outF; const float* wconv; const float* bconv;
    __device__ __forceinline__ void operator()(const f32x4 (&acc)[2][2][4][2], const pg8::Unit& u, int wr, int wc, int fr, int fq, lptr lds) const {
        lptr halo = lds + pg8::STAGE_BYTES;
        const int q8 = 32 * wc + 8 * fq;
        if (fr >= 14) {
#pragma unroll
            for (int ai = 0; ai < 2; ++ai)
#pragma unroll
                for (int bj = 0; bj < 2; ++bj)
#pragma unroll
                    for (int n = 0; n < 2; ++n) *(LAS f32x4*)(halo + ((((2 * ai + wr) * 2 + (fr - 14)) * 256 + 128 * bj + q8 + 4 * n) * 4)) = acc[ai][bj][3][n];
        }
        asm volatile("s_waitcnt lgkmcnt(0)" ::: "memory"); __builtin_amdgcn_s_barrier(); asm volatile("" ::: "memory");
#pragma unroll
        for (int n = 0; n < 2; ++n) {
            const int c = 128 * u.pn + q8 + 4 * n;
            const ConvW w = load_convw(wconv, bconv, c);
#pragma unroll
            for (int ai = 0; ai < 2; ++ai) {
                const int G = 2 * ai + wr;
                f32x4 pa = {0.f, 0.f, 0.f, 0.f}, pg = {0.f, 0.f, 0.f, 0.f};
                if (G > 0 && fr >= 14) { pa = *(const LAS f32x4*)(halo + ((((G - 1) * 2 + (fr - 14)) * 256 + q8 + 4 * n) * 4)); pg = *(const LAS f32x4*)(halo + ((((G - 1) * 2 + (fr - 14)) * 256 + 128 + q8 + 4 * n) * 4)); }
#pragma unroll
                for (int m = 0; m < 4; ++m) {
                    const f32x4 ca = acc[ai][0][m][n], cg = acc[ai][1][m][n];
                    const f32x4 qa = m ? acc[ai][0][m ? m - 1 : 0][n] : pa, qg = m ? acc[ai][1][m ? m - 1 : 0][n] : pg;
                    const u32x2 o = conv_gate4(ca, cg, qa, qg, w, fr);
                    const size_t row = (size_t)u.pm * 256 + 64 * G + 16 * m + fr;
                    *(u32x2*)(act + row * FF + c) = o;
                    if (m == 0 && G == 0 && fr < 2) { float* e = uedge + ((size_t)u.pm * 4 + fr) * FF2 + c; *(f32x4*)e = ca; *(f32x4*)(e + FF) = cg; }
                    if (m == 3 && G == 3 && fr >= 14) { float* e = uedge + ((size_t)u.pm * 4 + 2 + (fr - 14)) * FF2 + c; *(f32x4*)e = ca; *(f32x4*)(e + FF) = cg;
                        if ((u.pm & 15) == 15) { float* f = outF + ((size_t)(u.pm >> 4) * 2 + (fr - 14)) * FF2 + c; *(f32x4*)f = ca; *(f32x4*)(f + FF) = cg; } }
                }
            }
        }
    }
};
struct EpiFFNs {
    bf16_t* act; float* outF; const float* state; const float* wconv; const float* bconv;
    __device__ __forceinline__ void sub(const f32x4 (&a)[2][4][2], int pn, int rloc0, int wc, int fr, int fq) const {
        const int q8 = 32 * wc + 8 * fq;
#pragma unroll
        for (int n = 0; n < 2; ++n) {
            const int c = 128 * pn + q8 + 4 * n;
            const ConvW w = load_convw(wconv, bconv, c);
#pragma unroll
            for (int m = 0; m < 4; ++m) {
                const int b = (rloc0 + 16 * m) >> 5;
                const f32x4 ca = a[0][m][n], cg = a[1][m][n];
                f32x4 qa = {0.f, 0.f, 0.f, 0.f}, qg = {0.f, 0.f, 0.f, 0.f};
                if (m & 1) { qa = a[0][m ? m - 1 : 0][n]; qg = a[1][m ? m - 1 : 0][n]; }
                else if (fr >= 14) { const float* s = state + ((size_t)b * 2 + (fr - 14)) * FF2 + c; qa = *(const f32x4*)s; qg = *(const f32x4*)(s + FF); }
                const u32x2 o = conv_gate4(ca, cg, qa, qg, w, fr);
                const size_t row = (size_t)MP + rloc0 + 16 * m + fr;
                *(u32x2*)(act + row * FF + c) = o;
                if ((m & 1) && fr >= 14) { float* f = outF + ((size_t)b * 2 + (fr - 14)) * FF2 + c; *(f32x4*)f = ca; *(f32x4*)(f + FF) = cg; }
            }
        }
    }
};

template <int K, bool HISCALE, class Epi>
__device__ __forceinline__ void small_tile(const bf16_t* __restrict__ A, const bf16_t* __restrict__ Bt, const Epi& E, const float* ssq, lptr lds, int t, int tid, int lane, int wave) {
    constexpr int KW = K / 8;
    const int fr = lane & 15, fq = lane >> 4;
    const int wc = t & 3, G = (t >> 2) & 3, pn = t >> 4;
    f32x4 acc[2][4][2];
#pragma unroll
    for (int bj = 0; bj < 2; ++bj)
#pragma unroll
        for (int m = 0; m < 4; ++m)
#pragma unroll
            for (int n = 0; n < 2; ++n) acc[bj][m][n] = (f32x4){0.f, 0.f, 0.f, 0.f};
    const bf16_t* ap = A + (size_t)(G * 64 + fr) * K + fq * 8 + wave * KW;
    const bf16_t* bp = Bt + (size_t)(256 * pn + 32 * wc + 8 * (fr >> 2) + (fr & 3)) * K + fq * 8 + wave * KW;
#ifdef DBLK
    for (int rep = 0; rep < 2; ++rep) {
    if (rep == 1) {
_Pragma("unroll") for (int bj = 0; bj < 2; ++bj) _Pragma("unroll") for (int m = 0; m < 4; ++m) _Pragma("unroll") for (int n = 0; n < 2; ++n) acc[bj][m][n] = acc[bj][m][n] * 0.f; asm volatile("" ::: "memory"); }
#endif
#pragma unroll 4
    for (int k0 = 0; k0 < KW; k0 += 32) {
        bf16x8 af[4], bf[2][2];
#pragma unroll
        for (int m = 0; m < 4; ++m) af[m] = *(const bf16x8*)(ap + (size_t)(16 * m) * K + k0);
#pragma unroll
        for (int bj = 0; bj < 2; ++bj)
#pragma unroll
            for (int n = 0; n < 2; ++n) bf[bj][n] = *(const bf16x8*)(bp + (size_t)(128 * bj + 4 * n) * K + k0);
#pragma unroll
        for (int bj = 0; bj < 2; ++bj)
#pragma unroll
            for (int m = 0; m < 4; ++m)
#pragma unroll
                for (int n = 0; n < 2; ++n) acc[bj][m][n] = MFMA16(bf[bj][n], af[m], acc[bj][m][n]);
    }
#ifdef DBLK
    }
#endif
    if (HISCALE) { if (wave >= 4) {
#pragma unroll
        for (int m = 0; m < 4; ++m) { const float* sp = ssq + (size_t)(MP + G * 64 + 16 * m + fr) * 8; const f32x4 s0 = *(const f32x4*)sp, s1 = *(const f32x4*)(sp + 4);
            const float rstd = rsqrtf(((s0.x + s0.y) + (s0.z + s0.w) + (s1.x + s1.y) + (s1.z + s1.w)) * (1.f / 512.f) + EPS);
#pragma unroll
            for (int bj = 0; bj < 2; ++bj)
#pragma unroll
                for (int n = 0; n < 2; ++n) acc[bj][m][n] = acc[bj][m][n] * rstd; } } }
    __syncthreads();
    if (wave != 0) {
#pragma unroll
        for (int bj = 0; bj < 2; ++bj)
#pragma unroll
            for (int m = 0; m < 4; ++m)
#pragma unroll
                for (int n = 0; n < 2; ++n) *(LAS f32x4*)(lds + ((((wave - 1) * 16 + (bj * 4 + m) * 2 + n) * 64 + lane) * 16)) = acc[bj][m][n];
    }
    __syncthreads();
    if (wave == 0) {
#pragma unroll 1
        for (int w2 = 0; w2 < 7; ++w2)
#pragma unroll
            for (int bj = 0; bj < 2; ++bj)
#pragma unroll
                for (int m = 0; m < 4; ++m)
#pragma unroll
                    for (int n = 0; n < 2; ++n) acc[bj][m][n] = acc[bj][m][n] + *(const LAS f32x4*)(lds + (((w2 * 16 + (bj * 4 + m) * 2 + n) * 64 + lane) * 16));
        E.sub(acc, pn, G * 64, wc, fr, fq);
#ifdef DBLE
        asm volatile("" ::: "memory"); E.sub(acc, pn, G * 64, wc, fr, fq);
#endif
    }
    __syncthreads();
}

typedef unsigned v4u __attribute__((ext_vector_type(4)));
#define XB_TMO      128
#define XB_XCNT(j)  (256  + 64 * (j))
#define XB_XSUB(j)  (1280 + 64 * (j))
#define XB_XGEN(j)  (2304 + 64 * (j))
#define XB_TOP      3328
#define XB_TOPGEN   3392
#define XCD_BAR_WORDS 3456
#define XB_SPIN_CAP (1u << 18)

__device__ __forceinline__ unsigned xb_ld(unsigned* p)              { return __hip_atomic_load(p, __ATOMIC_RELAXED, __HIP_MEMORY_SCOPE_AGENT); }
__device__ __forceinline__ unsigned xb_add(unsigned* p, unsigned v) { return __hip_atomic_fetch_add(p, v, __ATOMIC_RELAXED, __HIP_MEMORY_SCOPE_AGENT); }
__device__ __forceinline__ unsigned xb_xcc_id() { return (unsigned)__builtin_amdgcn_s_getreg((3 << 11) | 20) & 0xFu; }
#define XB_SPIN(cond, bar) do { unsigned _sp = 0; while (cond) { __builtin_amdgcn_s_sleep(1); \
    if ((++_sp & 255u) == 0u) { if (xb_ld(&(bar)[XB_TMO])) break; if (_sp > XB_SPIN_CAP) { atomicAdd(&(bar)[XB_TMO], 1u); break; } } } } while (0)

struct XcdBarrier {
    unsigned* bar; unsigned x;
    volatile LAS unsigned* st;
};

__device__ __forceinline__ XcdBarrier xcd_barrier_post(unsigned* bar, volatile LAS unsigned* st) {
    XcdBarrier b; b.bar = bar; b.x = xb_xcc_id(); b.st = st;
    if (threadIdx.x == 0) st[2] = xb_add(&bar[XB_XCNT(b.x)], 1u);
    return b;
}
__device__ __forceinline__ void xcd_barrier_complete(unsigned* bar, unsigned x, unsigned& nloc, unsigned& nx) {
    const unsigned G = gridDim.x * gridDim.y * gridDim.z;
    unsigned sum, cnt, mine, sp = 0u;
    for (;;) {
        sum = 0u; cnt = 0u; mine = 0u;
#pragma unroll
        for (unsigned j = 0; j < 16; ++j) { const unsigned c = xb_ld(&bar[XB_XCNT(j)]); sum += c; cnt += (c > 0u) ? 1u : 0u; mine = (j == x) ? c : mine; }
        if (sum == G) break;
        __builtin_amdgcn_s_sleep(1);
        if ((++sp & 255u) == 0u) { if (xb_ld(&bar[XB_TMO])) break; if (sp > XB_SPIN_CAP) { atomicAdd(&bar[XB_TMO], 1u); break; } }
    }
    nloc = mine > 0u ? mine : 1u; nx = cnt > 0u ? cnt : 1u;
}

__device__ __forceinline__ void xcd_barrier(const XcdBarrier& b) {
    asm volatile("s_waitcnt vmcnt(0)" ::: "memory");
    __syncthreads();
    if (threadIdx.x == 0) {
        unsigned* bar = b.bar;
        __builtin_amdgcn_s_waitcnt(0);
        unsigned nloc = b.st[0], nx = b.st[1];
        if (nloc == 0u) { xcd_barrier_complete(bar, b.x, nloc, nx); b.st[0] = nloc; b.st[1] = nx; }
        const unsigned old = xb_add(&bar[XB_XSUB(b.x)], 1u);
        const unsigned gen = old / nloc;
        if (old + 1u == (gen + 1u) * nloc) {
            __builtin_amdgcn_fence(__ATOMIC_RELEASE, "agent");
            asm volatile("s_waitcnt vmcnt(0)" ::: "memory");
            const unsigned og = xb_add(&bar[XB_TOP], 1u);
            const unsigned tg = og / nx;
            if (og + 1u == (tg + 1u) * nx) xb_add(&bar[XB_TOPGEN], 1u);
            else XB_SPIN(xb_ld(&bar[XB_TOPGEN]) == tg, bar);
            __builtin_amdgcn_fence(__ATOMIC_ACQUIRE, "agent");
            xb_add(&bar[XB_XGEN(b.x)], 1u);
            asm volatile("s_waitcnt vmcnt(0)" ::: "memory");
        } else {
            XB_SPIN(xb_ld(&bar[XB_XGEN(b.x)]) == gen, bar);
            __builtin_amdgcn_fence(__ATOMIC_ACQUIRE, "agent");
            asm volatile("s_waitcnt vmcnt(0)" ::: "memory");
        }
    }
    __syncthreads();
}


__device__ __forceinline__ void transpose_item(const float* __restrict__ W, int ldw, int srccol0, bf16_t* __restrict__ WT, int K, int destrow0, int k0, LAS float* scr, int lane, const float* kscale = nullptr) {
#pragma unroll 16
    for (int i = 0; i < 32; ++i) { const int kk = 2 * i + (lane >> 5); scr[kk * 33 + (lane & 31)] = W[(size_t)(k0 + kk) * ldw + srccol0 + (lane & 31)] * (kscale ? kscale[k0 + kk] : 1.f); }
    asm volatile("s_waitcnt lgkmcnt(0)" ::: "memory");
    const int c = lane & 7;
#pragma unroll
    for (int j = 0; j < 4; ++j) { const int n = (lane >> 3) + 8 * j; const LAS float* s = scr + (8 * c) * 33 + n;
        u32x4 o; o.x = cvtpk(s[0 * 33], s[1 * 33]); o.y = cvtpk(s[2 * 33], s[3 * 33]); o.z = cvtpk(s[4 * 33], s[5 * 33]); o.w = cvtpk(s[6 * 33], s[7 * 33]);
        *(u32x4*)(WT + (size_t)(destrow0 + n) * K + k0 + 8 * c) = o; }
    asm volatile("s_waitcnt lgkmcnt(0)" ::: "memory");
}

__device__ __forceinline__ void phase_weights(const Params& P, lptr lds, int lane, int wave) {
    unsigned char* ws = P.ws;
    LAS float* scr = (LAS float*)(lds + wave * 16384);
    const int gw = blockIdx.x * 8 + wave, NGW = gridDim.x * 8;
    constexpr int I1 = 16 * 112, I2 = 16 * 32, I3 = 16 * 176, I4 = 44 * 32;
    for (int it = gw; it < I1 + I2 + I3 + I4; it += NGW) {
        int r = it;
        if (r < I1) { const int kb = r / 112, n0 = (r % 112) * 32, tile = n0 >> 8, p = n0 & 255, wc = (p >> 5) & 3, bj = p >> 7, L = tile * 256 + 64 * wc + 32 * bj;
            transpose_item(P.in[I_WIN], DIN, L < 2048 ? L : L + 8, (bf16_t*)(ws + WS_W1T), 1024, n0, kb * 64, scr, lane); continue; }
        r -= I1;
        if (r < I2) { const int kb = r / 32, n0 = (r % 32) * 32; transpose_item(P.in[I_WOUT], 1024, n0, (bf16_t*)(ws + WS_W2T), 1024, n0, kb * 64, scr, lane, kb >= 8 ? P.in[I_SOW] - 512 : nullptr); continue; }
        r -= I2;
        if (r < I3) { const int kb = r / 176, n0 = (r % 176) * 32, pn = n0 >> 8, p = n0 & 255, bj = p >> 7, q0 = p & 127;
            transpose_item(P.in[I_WUP], FF2, 128 * pn + q0 + FF * bj, (bf16_t*)(ws + WS_W3T), 1024, n0, kb * 64, scr, lane); continue; }
        r -= I3;
        { const int kb = r / 32, n0 = (r % 32) * 32; transpose_item(P.in[I_WDOWN], 1024, n0, (bf16_t*)(ws + WS_W4T), FF, n0, kb * 64, scr, lane); }
    }
}

__device__ __forceinline__ void phase0(const Params& P, lptr lds, int tid, int lane, int wave) {
    unsigned char* ws = P.ws;
    LAS float* sc = (LAS float*)lds;
    for (int i = tid; i < 16384; i += 512) { const int r = i >> 10, k = i & 1023; const float c = r < 8 ? P.in[I_CP][r * 1024 + k] : P.in[I_CS][(r - 8) * 1024 + k]; sc[i] = c / (1.f + __expf(-c)); }
    __syncthreads();
    const int job = blockIdx.x * 512 + tid;
    if (job < 16 * 6144) {
        const int ks = job / 6144, n = job % 6144;
        float acc[16];
#pragma unroll
        for (int r = 0; r < 16; ++r) acc[r] = 0.f;
        const float* wp = P.in[I_WADA] + (size_t)(ks * 64) * 6144 + n;
#pragma unroll 16
        for (int k = 0; k < 64; ++k) { const float w = wp[(size_t)k * 6144];
#pragma unroll
            for (int r = 0; r < 16; ++r) acc[r] += sc[r * 1024 + ks * 64 + k] * w; }
        float* mp = (float*)(ws + WS_MODP);
#pragma unroll
        for (int r = 0; r < 16; ++r) mp[(size_t)(ks * 16 + r) * 6144 + n] = acc[r];
    }
}

__device__ __forceinline__ void load_mod_vectors(const Params& P, LAS float* A, LAS float* S, const float* normw, int r, int shofs, int tid) {
    const float* mp = (const float*)(P.ws + WS_MODP); const float* ba = P.in[I_BADA];
    for (int k = tid; k < 1024; k += 512) {
        float sh = ba[shofs + k], scv = ba[shofs + 1024 + k];
#pragma unroll
        for (int ks = 0; ks < 16; ++ks) { sh += mp[(size_t)(ks * 16 + r) * 6144 + shofs + k]; scv += mp[(size_t)(ks * 16 + r) * 6144 + shofs + 1024 + k]; }
        A[k] = normw[k] * (1.f + scv); S[k] = sh;
    }
}
__device__ __forceinline__ void load_row_bf(const bf16_t* xrow, int lane, f32x4 (&v)[4]) {
#pragma unroll
    for (int j = 0; j < 4; ++j) { const u32x2 w = ((const u32x2*)xrow)[lane + 64 * j]; v[j] = (f32x4){bflo(w.x), bfhi(w.x), bflo(w.y), bfhi(w.y)}; }
}
__device__ __forceinline__ void load_row(const float* xrow, int lane, f32x4 (&v)[4]) {
#pragma unroll
    for (int j = 0; j < 4; ++j) v[j] = ((const f32x4*)xrow)[lane + 64 * j];
}
template <bool GATES>
__device__ __forceinline__ void norm_row(const Params& P, const f32x4 (&v)[4], bf16_t* orow, float* grow, const LAS float* A, const LAS float* S, const LAS float* Wg, int lane) {
    float s = 0.f;
#pragma unroll
    for (int j = 0; j < 4; ++j) s += (v[j].x * v[j].x + v[j].y * v[j].y) + (v[j].z * v[j].z + v[j].w * v[j].w);
    const float rstd = rsqrtf(wave_sum(s) * (1.f / 1024.f) + EPS);
    float g[8];
#pragma unroll
    for (int i = 0; i < 8; ++i) g[i] = 0.f;
#pragma unroll
    for (int j = 0; j < 4; ++j) { const int k0 = 4 * lane + 256 * j;
        const f32x4 a = *(const LAS f32x4*)(A + k0), sh = *(const LAS f32x4*)(S + k0);
        const f32x4 hv = v[j] * rstd * a + sh;
        u32x2 o; o.x = cvtpk(hv.x, hv.y); o.y = cvtpk(hv.z, hv.w);
        *(u32x2*)(orow + k0) = o;
        if (GATES) {
#pragma unroll
            for (int i = 0; i < 8; ++i) { const f32x4 w = *(const LAS f32x4*)(Wg + i * 1024 + k0); g[i] += (hv.x * w.x + hv.y * w.y) + (hv.z * w.z + hv.w * w.w); } }
    }
    if (GATES) {
        { const bool hi = (lane & 32) != 0;
#pragma unroll
          for (int i = 0; i < 4; ++i) { const float send = hi ? g[i] : g[i + 4], keep = hi ? g[i + 4] : g[i]; g[i] = keep + __shfl_xor(send, 32); } }
        { const bool hi = (lane & 16) != 0;
#pragma unroll
          for (int i = 0; i < 2; ++i) { const float send = hi ? g[i] : g[i + 2], keep = hi ? g[i + 2] : g[i]; g[i] = keep + __shfl_xor(send, 16); } }
        { const bool hi = (lane & 8) != 0; const float send = hi ? g[0] : g[1], keep = hi ? g[1] : g[0]; g[0] = keep + __shfl_xor(send, 8); }
        g[0] += __shfl_xor(g[0], 4); g[0] += __shfl_xor(g[0], 2); g[0] += __shfl_xor(g[0], 1);
        const int gt = lane >> 3;
        if ((lane & 7) == 0) {
            float o;
            if (gt < 4) o = g[0] + P.in[I_BIG][gt];
            else { const float x = g[0] + P.in[I_BFG][gt - 4]; o = fminf(x, 0.f) - log1pf(expf(-fabsf(x))); }
            grow[gt] = o;
        }
    }
}
__device__ __forceinline__ void phase1(const Params& P, lptr lds, int tid, int lane, int wave) {
    LAS float* A1 = (LAS float*)lds; LAS float* S1 = A1 + 1024; LAS float* Wg = S1 + 1024;
    for (int k = tid; k < 1024; k += 512) { const f32x4 w0 = *(const f32x4*)(P.in[I_WIN] + (size_t)k * DIN + 2048), w1 = *(const f32x4*)(P.in[I_WIN] + (size_t)k * DIN + 2052);
        Wg[k] = w0.x; Wg[1024 + k] = w0.y; Wg[2048 + k] = w0.z; Wg[3072 + k] = w0.w; Wg[4096 + k] = w1.x; Wg[5120 + k] = w1.y; Wg[6144 + k] = w1.z; Wg[7168 + k] = w1.w; }
    if (tid < 384) { const int e = blockIdx.x * 384 + tid, r = e / 6144, n = e % 6144; const float* mp = (const float*)(P.ws + WS_MODP); float s = P.in[I_BADA][n];
#pragma unroll
        for (int ks = 0; ks < 16; ++ks) s += mp[(size_t)(ks * 16 + r) * 6144 + n];
        ((float*)(P.ws + WS_MOD))[e] = s; }
    load_mod_vectors(P, A1, S1, P.in[I_N1W], blockIdx.x >> 5, 0, tid);
    LAS float* A1s = Wg + 8192; LAS float* S1s = A1s + 1024;
    load_mod_vectors(P, A1s, S1s, P.in[I_N1W], 8 + (blockIdx.x >> 5), 0, tid);
    __syncthreads();
    bf16_t* H = (bf16_t*)(P.ws + WS_H); float* GT = (float*)(P.ws + WS_GATES);
    { const size_t row0 = (size_t)blockIdx.x * 128 + wave * 16; f32x4 v[4], vn[4]; load_row(P.in[I_XP] + row0 * 1024, lane, v);
#pragma unroll 1
      for (int j = 0; j < 16; ++j) { const size_t row = row0 + j;
          if (j + 1 < 16) load_row(P.in[I_XP] + (row + 1) * 1024, lane, vn);
          else if (wave == 0) load_row(P.in[I_XS] + (size_t)blockIdx.x * 1024, lane, vn);
          norm_row<true>(P, v, H + row * 1024, GT + row * 8, A1, S1, Wg, lane);
#pragma unroll
          for (int q = 0; q < 4; ++q) v[q] = vn[q]; }
      if (wave == 0) norm_row<true>(P, v, H + ((size_t)MP + blockIdx.x) * 1024, GT + ((size_t)MP + blockIdx.x) * 8, A1s, S1s, Wg, lane); }
}
__device__ __forceinline__ void phase5(const Params& P, lptr lds, int tid, int lane, int wave) {
    LAS float* A1 = (LAS float*)lds; LAS float* S1 = A1 + 1024;
    load_mod_vectors(P, A1, S1, P.in[I_N2W], blockIdx.x >> 5, 3072, tid);
    __syncthreads();
    bf16_t* H = (bf16_t*)(P.ws + WS_H);
    { const size_t row0 = (size_t)blockIdx.x * 128 + wave * 16; const bf16_t* X1 = (const bf16_t*)(P.ws + WS_X1B); f32x4 v[4], vn[4]; load_row_bf(X1 + row0 * 1024, lane, v);
#pragma unroll 1
      for (int j = 0; j < 16; ++j) { const size_t row = row0 + j;
          if (j + 1 < 16) load_row_bf(X1 + (row + 1) * 1024, lane, vn);
          norm_row<false>(P, v, H + row * 1024, nullptr, A1, S1, nullptr, lane);
#pragma unroll
          for (int q = 0; q < 4; ++q) v[q] = vn[q]; } }
    __syncthreads();
}
__device__ __forceinline__ void sample_h2_row(const Params& P, lptr lds, int tid, int lane, int wave) {
    LAS float* A1 = (LAS float*)lds; LAS float* S1 = A1 + 1024;
    load_mod_vectors(P, A1, S1, P.in[I_N2W], 8 + (blockIdx.x >> 5), 3072, tid);
    __syncthreads();
    if (wave == 0) { f32x4 v[4]; load_row_bf((const bf16_t*)(P.ws + WS_X1B) + ((size_t)MP + blockIdx.x) * 1024, lane, v); norm_row<false>(P, v, (bf16_t*)(P.ws + WS_H) + ((size_t)MP + blockIdx.x) * 1024, nullptr, A1, S1, nullptr, lane); }
    __syncthreads();
}
__device__ __forceinline__ void phase3b(const Params& P, int lane, int gw, int NGW) {
    bf16_t* Y = (bf16_t*)(P.ws + WS_YCAT); const float* SSQ = (const float*)(P.ws + WS_SSQ);
    for (int row = gw; row < MP; row += NGW) {
        const f32x4 s0 = *(const f32x4*)(SSQ + (size_t)row * 8), s1 = *(const f32x4*)(SSQ + (size_t)row * 8 + 4);
        const float rstd = rsqrtf(((s0.x + s0.y) + (s0.z + s0.w) + (s1.x + s1.y) + (s1.z + s1.w)) * (1.f / 512.f) + EPS);
        u32x4* p = (u32x4*)(Y + (size_t)row * 1024 + 512 + 8 * lane); const u32x4 o = *p;
        f32x4 a = {bflo(o.x), bfhi(o.x), bflo(o.y), bfhi(o.y)}, b = {bflo(o.z), bfhi(o.z), bflo(o.w), bfhi(o.w)};
        a = a * rstd; b = b * rstd;
        *p = pack8(a, b);
    }
}
__device__ __forceinline__ void phase_fix(const Params& P, int tid) {
    const float* UE = (const float*)(P.ws + WS_UEDGE); bf16_t* act = (bf16_t*)(P.ws + WS_ACT);
    const float* wc = P.in[I_WCONV]; const float* bc = P.in[I_BCONV];
    const int total = 128 * 2 * FF;
    for (int i = blockIdx.x * 512 + tid; i < total; i += gridDim.x * 512) {
        const int j = i % FF, rr = (i / FF) & 1, pm = i / (2 * FF);
        if ((pm & 15) == 0) continue;
        float uc[2];
#pragma unroll
        for (int hf = 0; hf < 2; ++hf) { const int c = j + hf * FF;
            const float um2 = rr == 0 ? UE[((size_t)(pm - 1) * 4 + 2) * FF2 + c] : UE[((size_t)(pm - 1) * 4 + 3) * FF2 + c];
            const float um1 = rr == 0 ? UE[((size_t)(pm - 1) * 4 + 3) * FF2 + c] : UE[((size_t)pm * 4 + 0) * FF2 + c];
            const float u0 = UE[((size_t)pm * 4 + rr) * FF2 + c];
            uc[hf] = bc[c] + wc[2 * FF2 + c] * u0 + wc[FF2 + c] * um1 + wc[c] * um2; }
        act[((size_t)pm * 256 + rr) * FF + j] = f2bf(uc[0] * sigmoidf_(uc[0]) * uc[1]);
    }
}

constexpr int ML_P = 272;
constexpr int ML_QS = 0, ML_KS = 17408, ML_VS = 34816, ML_VW = 52224, ML_CS = 69632, ML_SS = 104448, ML_SC = 113664;
__device__ __forceinline__ void mlstm_item(const Params& P, lptr lds, int bh, bool sample, int tid, int lane, int wave) {
    const int b = bh >> 2, h = bh & 3, hh = lane >> 5, n31 = lane & 31;
    const size_t rowbase = sample ? (size_t)MP + b * 32 : (size_t)b * SEQ;
    const int nch = sample ? 1 : 64, L = sample ? 32 : 64;
    const bf16_t* MQ = (const bf16_t*)(P.ws + WS_PROJ); const bf16_t* MK = (const bf16_t*)(P.ws + WS_PROJ + PROJ_STRIDE); const bf16_t* MV = (const bf16_t*)(P.ws + WS_PROJ + 2 * PROJ_STRIDE);
    const bf16_t* MO = (const bf16_t*)(P.ws + WS_PROJ + 3 * PROJ_STRIDE); const float* GT = (const float*)(P.ws + WS_GATES); bf16_t* YC = (bf16_t*)(P.ws + WS_YCAT);
    LAS float* sc = (LAS float*)(lds + ML_SC);
    LAS float* bt = sc, *as_ = sc + 64, *mt = sc + 128, *winter = sc + 192, *emt = sc + 256, *wk = sc + 320, *rsum = sc + 384, *qn = sc + 512, *nvec = sc + 576, *misc = sc + 704;
    const int ti = wave >> 2, ej = wave & 3;
    f32x16 Cacc[2];
    {
        LAS float* cst = (LAS float*)lds;
        if (sample) { const float* src = P.in[I_STC] + ((size_t)b * 4 + h) * 16384;
            for (int i = tid; i < 4096; i += 512) { const f32x4 v = *(const f32x4*)(src + 4 * i); *(LAS f32x4*)(cst + (i >> 5) * 132 + (i & 31) * 4) = v; } }
        else { for (int i = tid; i < 4096; i += 512) *(LAS f32x4*)(cst + (i >> 5) * 132 + (i & 31) * 4) = (f32x4){0.f, 0.f, 0.f, 0.f}; }
        __syncthreads();
        const LAS float* cb = cst + (64 * (wave >> 2) + 4 * hh) * 132 + 32 * ej + n31;
#pragma unroll
        for (int i = 0; i < 2; ++i)
#pragma unroll
            for (int r = 0; r < 16; ++r) Cacc[i][r] = cb[(32 * i + (r & 3) + 8 * (r >> 2)) * 132];
        __syncthreads();
        lptr cs = lds + ML_CS + (64 * (wave >> 2) + 4 * hh) * ML_P + (32 * ej + n31) * 2;
#pragma unroll
        for (int i = 0; i < 2; ++i)
#pragma unroll
            for (int r = 0; r < 16; ++r) *(LAS unsigned short*)(cs + (32 * i + (r & 3) + 8 * (r >> 2)) * ML_P) = f2bf(Cacc[i][r]);
    }
    if (tid < 128) nvec[tid] = sample ? P.in[I_STN][((size_t)b * 4 + h) * 128 + tid] : 0.f;
    if (tid == 0) misc[0] = sample ? P.in[I_STM][b * 4 + h] : 0.f;
    u32x4 rq[2], rk[2], rv[2]; float g_ig = -INFINITY, g_lf = 0.f;
    const int prow[2] = {tid >> 4, (tid + 512) >> 4}, pch = tid & 15;
#define ML_LOAD(c) do { _Pragma("unroll") for (int i = 0; i < 2; ++i) { if (prow[i] < L) { const size_t go = (rowbase + (size_t)(c) * 64 + prow[i]) * 512 + h * 128 + pch * 8; \
            rq[i] = *(const u32x4*)(MQ + go); rk[i] = *(const u32x4*)(MK + go); rv[i] = *(const u32x4*)(MV + go); } else { rq[i] = (u32x4){0u, 0u, 0u, 0u}; rk[i] = rq[i]; rv[i] = rq[i]; } } \
        if (wave == 0) { if (lane < L) { const float* g = GT + (rowbase + (size_t)(c) * 64 + lane) * 8; g_ig = g[h]; g_lf = g[4 + h]; } else { g_ig = -INFINITY; g_lf = 0.f; } } } while (0)
    ML_LOAD(0);
    for (int c = 0; c < nch; ++c) {
        __syncthreads();
        if (wave == 0) {
            float bcum = g_lf;
#pragma unroll
            for (int o = 1; o < 64; o <<= 1) { const float v = __shfl_up(bcum, o); if (lane >= o) bcum += v; }
            const float a = g_ig - bcum; float amax = a;
#pragma unroll
            for (int o = 1; o < 64; o <<= 1) { const float v = __shfl_up(amax, o); if (lane >= o) amax = fmaxf(amax, v); }
            const float mprev = misc[0];
            const float m_t = fmaxf(bcum + mprev, bcum + amax);
            const float bL = __shfl(bcum, 63), aM = __shfl(amax, 63);
            const float m_new = fmaxf(bL + mprev, bL + aM);
            bt[lane] = bcum; as_[lane] = a; mt[lane] = m_t; winter[lane] = expf(bcum + mprev - m_t); emt[lane] = expf(-m_t); wk[lane] = expf(bL + a - m_new);
            if (lane == 0) { misc[1] = expf(bL + mprev - m_new); misc[2] = m_new; }
        }
#pragma unroll
        for (int i = 0; i < 2; ++i) { const int o = prow[i] * ML_P + pch * 16;
            *(LAS u32x4*)(lds + ML_QS + o) = rq[i]; *(LAS u32x4*)(lds + ML_KS + o) = rk[i]; *(LAS u32x4*)(lds + ML_VS + o) = rv[i]; }
        __syncthreads();
#pragma unroll
        for (int i = 0; i < 2; ++i) { const float w = wk[prow[i]]; const u32x4 v = rv[i]; u32x4 o;
            o.x = cvtpk(bflo(v.x) * w, bfhi(v.x) * w); o.y = cvtpk(bflo(v.y) * w, bfhi(v.y) * w); o.z = cvtpk(bflo(v.z) * w, bfhi(v.z) * w); o.w = cvtpk(bflo(v.w) * w, bfhi(v.w) * w);
            *(LAS u32x4*)(lds + ML_VW + prow[i] * ML_P + pch * 16) = o; }
        if (c + 1 < nch) ML_LOAD(c + 1);
        f32x16 num;
#pragma unroll
        for (int r = 0; r < 16; ++r) num[r] = 0.f;
#pragma unroll
        for (int ks = 0; ks < 8; ++ks) num = MFMA32(row_frag(lds + ML_QS, ML_P, 32 * ti, 16 * ks, lane), tr_frag(lds + ML_CS, ML_P, 16 * ks, 32 * ej, lane), num);
        if (wave < 3) {
            const int sti = wave == 0 ? 0 : 1, sj = wave == 2 ? 1 : 0;
            const int krow = (n31 & ~12) | ((n31 & 4) << 1) | ((n31 & 8) >> 1);
            f32x16 p;
#pragma unroll
            for (int r = 0; r < 16; ++r) p[r] = 0.f;
#pragma unroll
            for (int ks = 0; ks < 8; ++ks) p = MFMA32(*(const LAS bf16x8*)(lds + ML_KS + (32 * sj + krow) * ML_P + (16 * ks + 8 * hh) * 2), row_frag(lds + ML_QS, ML_P, 32 * sti, 16 * ks, lane), p);
            const int t = 32 * sti + n31; const float bt_t = bt[t], mt_t = mt[t]; float rs = 0.f;
            const LAS float* asb = as_ + 32 * sj + 8 * hh; const int tb = t - (32 * sj + 8 * hh);
#pragma unroll
            for (int r = 0; r < 16; ++r) { const int so = 16 * (r >> 3) + (r & 7);
                const float w = so <= tb ? __expf(bt_t + asb[so] - mt_t) : 0.f; p[r] *= w; rs += p[r]; }
#pragma unroll
            for (int a2 = 0; a2 < 2; ++a2) { u32x4 o; o.x = cvtpk(p[8 * a2 + 0], p[8 * a2 + 1]); o.y = cvtpk(p[8 * a2 + 2], p[8 * a2 + 3]); o.z = cvtpk(p[8 * a2 + 4], p[8 * a2 + 5]); o.w = cvtpk(p[8 * a2 + 6], p[8 * a2 + 7]);
                *(LAS u32x4*)(lds + ML_SS + t * 144 + (32 * sj + 16 * a2 + 8 * hh) * 2) = o; }
            rs += __shfl_xor(rs, 32);
            if (hh == 0) rsum[sj * 64 + t] = rs;
        }
        if (wave >= 4) {
            const int t = (tid - 256) >> 2, part = tid & 3; float s = 0.f;
#pragma unroll 8
            for (int d = 0; d < 32; ++d) s += bf2f(*(const LAS unsigned short*)(lds + ML_QS + t * ML_P + (32 * part + d) * 2)) * nvec[32 * part + d];
            s += __shfl_xor(s, 1); s += __shfl_xor(s, 2);
            if (part == 0) qn[t] = s;
        }
        __syncthreads();
        const LAS float* tb2 = sc + 32 * ti + 4 * hh;
#pragma unroll
        for (int r = 0; r < 16; ++r) num[r] *= tb2[192 + (r & 3) + 8 * (r >> 2)];
#pragma unroll
        for (int ks = 0; ks < 4; ++ks) if (ks < 2 || ti == 1) num = MFMA32(*(const LAS bf16x8*)(lds + ML_SS + (32 * ti + n31) * 144 + (16 * ks + 8 * hh) * 2), tr_frag(lds + ML_VS, ML_P, 16 * ks, 32 * ej, lane), num);
#pragma unroll
        for (int r = 0; r < 16; ++r) { const int o = (r & 3) + 8 * (r >> 2);
            const float den = tb2[192 + o] * tb2[512 + o] + tb2[384 + o] + (ti ? tb2[448 + o] : 0.f);
            const float hv = num[r] / fmaxf(fabsf(den), tb2[256 + o]);
            *(LAS unsigned short*)(lds + ML_QS + (32 * ti + 4 * hh) * ML_P + (32 * ej + n31) * 2 + o * ML_P) = f2bf(hv); }
        const float decay = misc[1];
#pragma unroll
        for (int i = 0; i < 2; ++i) { const int di = 2 * (wave >> 2) + i;
#pragma unroll
            for (int r = 0; r < 16; ++r) Cacc[i][r] *= decay;
#pragma unroll
            for (int ks = 0; ks < 4; ++ks) Cacc[i] = MFMA32(tr_frag(lds + ML_KS, ML_P, 16 * ks, 32 * di, lane), tr_frag(lds + ML_VW, ML_P, 16 * ks, 32 * ej, lane), Cacc[i]);
#pragma unroll
            for (int r = 0; r < 16; ++r) *(LAS unsigned short*)(lds + ML_CS + (64 * (wave >> 2) + 4 * hh) * ML_P + (32 * ej + n31) * 2 + (32 * i + (r & 3) + 8 * (r >> 2)) * ML_P) = f2bf(Cacc[i][r]); }
        if (tid < 128) { float s = decay * nvec[tid];
#pragma unroll 8
            for (int t = 0; t < 64; ++t) s += wk[t] * bf2f(*(const LAS unsigned short*)(lds + ML_KS + t * ML_P + tid * 2));
            nvec[tid] = s; }
        if (tid == 0) misc[0] = misc[2];
        __syncthreads();
        { const int t = tid >> 3, part = tid & 7;
          const u32x4 h0 = *(const LAS u32x4*)(lds + ML_QS + t * ML_P + part * 32), h1 = *(const LAS u32x4*)(lds + ML_QS + t * ML_P + part * 32 + 16);
          float hv[16] = {bflo(h0.x), bfhi(h0.x), bflo(h0.y), bfhi(h0.y), bflo(h0.z), bfhi(h0.z), bflo(h0.w), bfhi(h0.w), bflo(h1.x), bfhi(h1.x), bflo(h1.y), bfhi(h1.y), bflo(h1.z), bfhi(h1.z), bflo(h1.w), bfhi(h1.w)};
          float ss = 0.f;
#pragma unroll
          for (int e = 0; e < 16; ++e) ss += hv[e] * hv[e];
          ss += __shfl_xor(ss, 1); ss += __shfl_xor(ss, 2); ss += __shfl_xor(ss, 4);
          const float rstd = rsqrtf(ss * (1.f / 128.f) + EPS);
          if (t < L) {
              const size_t row = rowbase + (size_t)c * 64 + t; const int col = h * 128 + part * 16;
              const u32x4 g0 = *(const u32x4*)(MO + row * 512 + col), g1 = *(const u32x4*)(MO + row * 512 + col + 8);
              const float gv[16] = {bflo(g0.x), bfhi(g0.x), bflo(g0.y), bfhi(g0.y), bflo(g0.z), bfhi(g0.z), bflo(g0.w), bfhi(g0.w), bflo(g1.x), bfhi(g1.x), bflo(g1.y), bfhi(g1.y), bflo(g1.z), bfhi(g1.z), bflo(g1.w), bfhi(g1.w)};
              const float* mw = P.in[I_MLW] + col;
              float y[16];
#pragma unroll
              for (int e = 0; e < 16; ++e) y[e] = hv[e] * rstd * mw[e] * gv[e];
              u32x4 o0, o1; o0.x = cvtpk(y[0], y[1]); o0.y = cvtpk(y[2], y[3]); o0.z = cvtpk(y[4], y[5]); o0.w = cvtpk(y[6], y[7]); o1.x = cvtpk(y[8], y[9]); o1.y = cvtpk(y[10], y[11]); o1.z = cvtpk(y[12], y[13]); o1.w = cvtpk(y[14], y[15]);
              *(u32x4*)(YC + row * 1024 + col) = o0; *(u32x4*)(YC + row * 1024 + col + 8) = o1;
          } }
    }
#undef ML_LOAD
    __syncthreads();
    {
        LAS float* cst = (LAS float*)lds;
        int l3 = lane; asm volatile("" : "+v"(l3));
        LAS float* cb = cst + (64 * (wave >> 2) + 4 * (l3 >> 5)) * 132 + 32 * ej + (l3 & 31);
#pragma unroll
        for (int i = 0; i < 2; ++i)
#pragma unroll
            for (int r = 0; r < 16; ++r) cb[(32 * i + (r & 3) + 8 * (r >> 2)) * 132] = Cacc[i][r];
        __syncthreads();
        float* oc = P.out + (sample ? O_SC : O_PC) + ((size_t)b * 4 + h) * 16384;
        for (int i = tid; i < 4096; i += 512) *(f32x4*)(oc + 4 * i) = *(const LAS f32x4*)(cst + (i >> 5) * 132 + (i & 31) * 4);
    }
    if (tid < 128) P.out[(sample ? O_SN : O_PN) + ((size_t)b * 4 + h) * 128 + tid] = nvec[tid];
    if (tid == 0) P.out[(sample ? O_SM : O_PM) + b * 4 + h] = misc[0];
}


constexpr size_t WS_KVL = WS_H, WS_KNL = 420 * MiB, WS_CHS = 421 * MiB, WS_NST = 422 * MiB, WS_MST = 423 * MiB, WS_CST = 424 * MiB, WS_END2 = 489 * MiB;
template <int NC>
__device__ __forceinline__ void ml1_pair(const Params& P, lptr lds, int pair, int tid, int lane, int wave) {
    const int item0 = NC * pair; const int bh = item0 >> 6, c = item0 & 63, b = bh >> 2, h = bh & 3, hh = lane >> 5, n31 = lane & 31, ej = wave & 3;
    const size_t row0 = (size_t)b * SEQ + 64 * c;
    const bf16_t* MK = (const bf16_t*)(P.ws + WS_PROJ + PROJ_STRIDE); const bf16_t* MV = (const bf16_t*)(P.ws + WS_PROJ + 2 * PROJ_STRIDE); const float* GT = (const float*)(P.ws + WS_GATES);
    LAS float* wk = (LAS float*)(lds + ML_SC) + 320;
    const int prow[2] = {tid >> 4, (tid + 512) >> 4}, pch = tid & 15;
    u32x4 rk2[NC][2], rv2[NC][2]; float g_ig2[NC], g_lf2[NC];
#pragma unroll
    for (int s2 = 0; s2 < NC; ++s2) { g_ig2[s2] = 0.f; g_lf2[s2] = 0.f;
#pragma unroll
        for (int i = 0; i < 2; ++i) { const size_t go = (row0 + 64 * s2 + prow[i]) * 512 + h * 128 + pch * 8; rk2[s2][i] = *(const u32x4*)(MK + go); rv2[s2][i] = *(const u32x4*)(MV + go); }
        if (wave == 0) { const float* g = GT + (row0 + 64 * s2 + lane) * 8; g_ig2[s2] = g[h]; g_lf2[s2] = g[4 + h]; } }
#pragma unroll
    for (int s2 = 0; s2 < NC; ++s2) {
    const int item = item0 + s2; const float g_ig = g_ig2[s2], g_lf = g_lf2[s2];
    u32x4 rk[2] = {rk2[s2][0], rk2[s2][1]}, rv[2] = {rv2[s2][0], rv2[s2][1]};
    __syncthreads();
    if (wave == 0) {
        float bcum = g_lf;
#pragma unroll
        for (int o = 1; o < 64; o <<= 1) { const float v = __shfl_up(bcum, o); if (lane >= o) bcum += v; }
        const float a = g_ig - bcum; float amax = a;
#pragma unroll
        for (int o = 1; o < 64; o <<= 1) amax = fmaxf(amax, __shfl_xor(amax, o));
        const float bL = __shfl(bcum, 63);
        wk[lane] = expf(a - amax);
        if (lane == 0) { float* ch = (float*)(P.ws + WS_CHS) + (size_t)item * 4; ch[0] = bL; ch[1] = bL + amax; }
    }
#pragma unroll
    for (int i = 0; i < 2; ++i) *(LAS u32x4*)(lds + ML_KS + prow[i] * ML_P + pch * 16) = rk[i];
    __syncthreads();
#pragma unroll
    for (int i = 0; i < 2; ++i) { const float w = wk[prow[i]]; const u32x4 v = rv[i]; u32x4 o;
        o.x = cvtpk(bflo(v.x) * w, bfhi(v.x) * w); o.y = cvtpk(bflo(v.y) * w, bfhi(v.y) * w); o.z = cvtpk(bflo(v.z) * w, bfhi(v.z) * w); o.w = cvtpk(bflo(v.w) * w, bfhi(v.w) * w);
        *(LAS u32x4*)(lds + ML_VW + prow[i] * ML_P + pch * 16) = o; }
    if (tid < 128) { float s = 0.f;
#pragma unroll 8
        for (int t = 0; t < 64; ++t) s += wk[t] * bf2f(*(const LAS unsigned short*)(lds + ML_KS + t * ML_P + tid * 2));
        ((float*)(P.ws + WS_KNL))[(size_t)item * 128 + tid] = s; }
    __syncthreads();
#pragma unroll
    for (int i = 0; i < 2; ++i) { const int di = 2 * (wave >> 2) + i;
        f32x16 acc;
#pragma unroll
        for (int r = 0; r < 16; ++r) acc[r] = 0.f;
#pragma unroll
        for (int ks = 0; ks < 4; ++ks) acc = MFMA32(tr_frag(lds + ML_KS, ML_P, 16 * ks, 32 * di, lane), tr_frag(lds + ML_VW, ML_P, 16 * ks, 32 * ej, lane), acc);
#pragma unroll
        for (int r = 0; r < 16; ++r) *(LAS unsigned short*)(lds + ML_CS + (64 * (wave >> 2) + 4 * hh) * ML_P + (32 * ej + n31) * 2 + (32 * i + (r & 3) + 8 * (r >> 2)) * ML_P) = f2bf(acc[r]); }
    __syncthreads();
    bf16_t* kvl = (bf16_t*)(P.ws + WS_KVL) + (size_t)item * 16384;
#pragma unroll
    for (int i = 0; i < 4; ++i) { const int p = tid + 512 * i, row = p >> 4, ch = p & 15; *(u32x4*)(kvl + row * 128 + ch * 8) = *(const LAS u32x4*)(lds + ML_CS + row * ML_P + ch * 16); }
    }
}
__device__ __forceinline__ void ml2_scan(const Params& P, lptr lds, int tid, int job) {
    const int bh = job >> 3, part = job & 7;
    LAS float* dec = (LAS float*)lds; LAS float* scl = dec + 64; LAS float* mst = scl + 64;
    if (tid == 0) { const float* ch = (const float*)(P.ws + WS_CHS) + (size_t)bh * 64 * 4; float m = 0.f;
        for (int c = 0; c < 64; ++c) { const float bL = ch[4 * c], ml = ch[4 * c + 1], mn = fmaxf(bL + m, ml); dec[c] = expf(bL + m - mn); scl[c] = expf(ml - mn); mst[c] = m; m = mn; }
        mst[64] = m; }
    __syncthreads();
    const size_t e0 = (size_t)part * 2048 + tid * 4;
    const bf16_t* kv = (const bf16_t*)(P.ws + WS_KVL) + (size_t)bh * 64 * 16384 + e0; bf16_t* cs = (bf16_t*)(P.ws + WS_CST) + (size_t)bh * 64 * 16384 + e0;
    f32x4 C = {0.f, 0.f, 0.f, 0.f};
#pragma unroll 16
    for (int c = 0; c < 64; ++c) { const u32x2 v = *(const u32x2*)(kv + (size_t)c * 16384);
        *(u32x2*)(cs + (size_t)c * 16384) = (u32x2){cvtpk(C.x, C.y), cvtpk(C.z, C.w)};
        const f32x4 kvf = {bflo(v.x), bfhi(v.x), bflo(v.y), bfhi(v.y)};
        C = C * dec[c] + kvf * scl[c]; }
    *(f32x4*)(P.out + O_PC + (size_t)bh * 16384 + e0) = C;
    if (part == 0 && tid < 128) { float n = 0.f; const float* kn = (const float*)(P.ws + WS_KNL) + (size_t)bh * 64 * 128 + tid; float* ns = (float*)(P.ws + WS_NST) + (size_t)bh * 64 * 128 + tid;
#pragma unroll 16
        for (int c = 0; c < 64; ++c) { ns[c * 128] = n; n = n * dec[c] + kn[c * 128] * scl[c]; }
        P.out[O_PN + (size_t)bh * 128 + tid] = n; }
    if (part == 0 && tid >= 128 && tid < 192) ((float*)(P.ws + WS_MST))[bh * 64 + tid - 128] = mst[tid - 128];
    if (part == 0 && tid == 192) P.out[O_PM + bh] = mst[64];
}
struct Ml3In { u32x4 rq[2], rk[2], rv[2], rc[4], g0, g1; float g_ig, g_lf, mprev, nin; };
__device__ __forceinline__ void ml3_load(const Params& P, int item, int tid, int lane, int wave, Ml3In& L) {
    const int bh = item >> 6, c = item & 63, b = bh >> 2, h = bh & 3;
    const size_t row0 = (size_t)b * SEQ + 64 * c;
    const bf16_t* MQ = (const bf16_t*)(P.ws + WS_PROJ); const bf16_t* MK = (const bf16_t*)(P.ws + WS_PROJ + PROJ_STRIDE); const bf16_t* MV = (const bf16_t*)(P.ws + WS_PROJ + 2 * PROJ_STRIDE);
    const bf16_t* MO = (const bf16_t*)(P.ws + WS_PROJ + 3 * PROJ_STRIDE); const float* GT = (const float*)(P.ws + WS_GATES);
    const int prow[2] = {tid >> 4, (tid + 512) >> 4}, pch = tid & 15;
#pragma unroll
    for (int i = 0; i < 2; ++i) { const size_t go = (row0 + prow[i]) * 512 + h * 128 + pch * 8; L.rq[i] = *(const u32x4*)(MQ + go); L.rk[i] = *(const u32x4*)(MK + go); L.rv[i] = *(const u32x4*)(MV + go); }
    const bf16_t* cst = (const bf16_t*)(P.ws + WS_CST) + (size_t)item * 16384;
#pragma unroll
    for (int i = 0; i < 4; ++i) { const int p = tid + 512 * i; L.rc[i] = *(const u32x4*)(cst + (p >> 4) * 128 + (p & 15) * 8); }
    { const size_t row = row0 + (tid >> 3); const int col = h * 128 + (tid & 7) * 16; L.g0 = *(const u32x4*)(MO + row * 512 + col); L.g1 = *(const u32x4*)(MO + row * 512 + col + 8); }
    L.g_ig = 0.f; L.g_lf = 0.f; L.mprev = 0.f; L.nin = 0.f;
    if (wave == 0) { const float* g = GT + (row0 + lane) * 8; L.g_ig = g[h]; L.g_lf = g[4 + h]; L.mprev = ((const float*)(P.ws + WS_MST))[item]; }
    if (tid < 128) L.nin = ((const float*)(P.ws + WS_NST))[(size_t)item * 128 + tid];
}
__device__ __forceinline__ void ml3_item(const Params& P, lptr lds, int item, const Ml3In& L, int tid, int lane, int wave) {
    const int bh = item >> 6, c = item & 63, b = bh >> 2, h = bh & 3, hh = lane >> 5, n31 = lane & 31;
    const size_t row0 = (size_t)b * SEQ + 64 * c;
    bf16_t* YC = (bf16_t*)(P.ws + WS_YCAT);
    LAS float* sc = (LAS float*)(lds + ML_SC);
    LAS float* bt = sc, *as_ = sc + 64, *mt = sc + 128, *winter = sc + 192, *emt = sc + 256, *rsum = sc + 384, *qn = sc + 512, *nvec = sc + 576;
    const int ti = wave >> 2, ej = wave & 3;
    const int prow[2] = {tid >> 4, (tid + 512) >> 4}, pch = tid & 15;
    const float g_ig = L.g_ig, g_lf = L.g_lf, mprev = L.mprev, nin = L.nin;
    __syncthreads();
    if (wave == 0) {
        float bcum = g_lf;
#pragma unroll
        for (int o = 1; o < 64; o <<= 1) { const float v = __shfl_up(bcum, o); if (lane >= o) bcum += v; }
        const float a = g_ig - bcum; float amax = a;
#pragma unroll
        for (int o = 1; o < 64; o <<= 1) { const float v = __shfl_up(amax, o); if (lane >= o) amax = fmaxf(amax, v); }
        const float m_t = fmaxf(bcum + mprev, bcum + amax);
        bt[lane] = bcum; as_[lane] = a; mt[lane] = m_t; winter[lane] = expf(bcum + mprev - m_t); emt[lane] = expf(-m_t);
    }
    if (tid < 128) nvec[tid] = nin;
#pragma unroll
    for (int i = 0; i < 2; ++i) { const int o = prow[i] * ML_P + pch * 16;
        *(LAS u32x4*)(lds + ML_QS + o) = L.rq[i]; *(LAS u32x4*)(lds + ML_KS + o) = L.rk[i]; *(LAS u32x4*)(lds + ML_VS + o) = L.rv[i]; }
#pragma unroll
    for (int i = 0; i < 4; ++i) { const int p = tid + 512 * i; *(LAS u32x4*)(lds + ML_CS + (p >> 4) * ML_P + (p & 15) * 16) = L.rc[i]; }
    __syncthreads();
    f32x16 num;
#pragma unroll
    for (int r = 0; r < 16; ++r) num[r] = 0.f;
#pragma unroll
    for (int ks = 0; ks < 8; ++ks) num = MFMA32(row_frag(lds + ML_QS, ML_P, 32 * ti, 16 * ks, lane), tr_frag(lds + ML_CS, ML_P, 16 * ks, 32 * ej, lane), num);
    if (wave < 3) {
        const int sti = wave == 0 ? 0 : 1, sj = wave == 2 ? 1 : 0;
        const int krow = (n31 & ~12) | ((n31 & 4) << 1) | ((n31 & 8) >> 1);
        f32x16 p;
#pragma unroll
        for (int r = 0; r < 16; ++r) p[r] = 0.f;
#pragma unroll
        for (int ks = 0; ks < 8; ++ks) p = MFMA32(*(const LAS bf16x8*)(lds + ML_KS + (32 * sj + krow) * ML_P + (16 * ks + 8 * hh) * 2), row_frag(lds + ML_QS, ML_P, 32 * sti, 16 * ks, lane), p);
        const int t = 32 * sti + n31; const float bt_t = bt[t], mt_t = mt[t]; float rs = 0.f;
        const LAS float* asb = as_ + 32 * sj + 8 * hh; const int tb = t - (32 * sj + 8 * hh);
#pragma unroll
        for (int r = 0; r < 16; ++r) { const int so = 16 * (r >> 3) + (r & 7);
            const float w = so <= tb ? __expf(bt_t + asb[so] - mt_t) : 0.f; p[r] *= w; rs += p[r]; }
#pragma unroll
        for (int a2 = 0; a2 < 2; ++a2) { u32x4 o; o.x = cvtpk(p[8 * a2 + 0], p[8 * a2 + 1]); o.y = cvtpk(p[8 * a2 + 2], p[8 * a2 + 3]); o.z = cvtpk(p[8 * a2 + 4], p[8 * a2 + 5]); o.w = cvtpk(p[8 * a2 + 6], p[8 * a2 + 7]);
            *(LAS u32x4*)(lds + ML_SS + t * 144 + (32 * sj + 16 * a2 + 8 * hh) * 2) = o; }
        rs += __shfl_xor(rs, 32);
        if (hh == 0) rsum[sj * 64 + t] = rs;
    }
    if (wave >= 4) {
        const int t = (tid - 256) >> 2, part = tid & 3; float s = 0.f;
#pragma unroll 8
        for (int d = 0; d < 32; ++d) s += bf2f(*(const LAS unsigned short*)(lds + ML_QS + t * ML_P + (32 * part + d) * 2)) * nvec[32 * part + d];
        s += __shfl_xor(s, 1); s += __shfl_xor(s, 2);
        if (part == 0) qn[t] = s;
    }
    __syncthreads();
    const LAS float* tb2 = sc + 32 * ti + 4 * hh;
#pragma unroll
    for (int r = 0; r < 16; ++r) num[r] *= tb2[192 + (r & 3) + 8 * (r >> 2)];
#pragma unroll
    for (int ks = 0; ks < 4; ++ks) if (ks < 2 || ti == 1) num = MFMA32(*(const LAS bf16x8*)(lds + ML_SS + (32 * ti + n31) * 144 + (16 * ks + 8 * hh) * 2), tr_frag(lds + ML_VS, ML_P, 16 * ks, 32 * ej, lane), num);
#pragma unroll
    for (int r = 0; r < 16; ++r) { const int o = (r & 3) + 8 * (r >> 2);
        const float den = tb2[192 + o] * tb2[512 + o] + tb2[384 + o] + (ti ? tb2[448 + o] : 0.f);
        const float hv = num[r] / fmaxf(fabsf(den), tb2[256 + o]);
        *(LAS unsigned short*)(lds + ML_QS + (32 * ti + 4 * hh) * ML_P + (32 * ej + n31) * 2 + o * ML_P) = f2bf(hv); }
    __syncthreads();
    { const int t = tid >> 3, part = tid & 7;
      const size_t row = row0 + t; const int col = h * 128 + part * 16;
      const u32x4 g0 = L.g0, g1 = L.g1;
      const u32x4 h0 = *(const LAS u32x4*)(lds + ML_QS + t * ML_P + part * 32), h1 = *(const LAS u32x4*)(lds + ML_QS + t * ML_P + part * 32 + 16);
      float hv[16] = {bflo(h0.x), bfhi(h0.x), bflo(h0.y), bfhi(h0.y), bflo(h0.z), bfhi(h0.z), bflo(h0.w), bfhi(h0.w), bflo(h1.x), bfhi(h1.x), bflo(h1.y), bfhi(h1.y), bflo(h1.z), bfhi(h1.z), bflo(h1.w), bfhi(h1.w)};
      float ss = 0.f;
#pragma unroll
      for (int e = 0; e < 16; ++e) ss += hv[e] * hv[e];
      ss += __shfl_xor(ss, 1); ss += __shfl_xor(ss, 2); ss += __shfl_xor(ss, 4);
      const float rstd = rsqrtf(ss * (1.f / 128.f) + EPS);
      const float gv[16] = {bflo(g0.x), bfhi(g0.x), bflo(g0.y), bfhi(g0.y), bflo(g0.z), bfhi(g0.z), bflo(g0.w), bfhi(g0.w), bflo(g1.x), bfhi(g1.x), bflo(g1.y), bfhi(g1.y), bflo(g1.z), bfhi(g1.z), bflo(g1.w), bfhi(g1.w)};
      const float* mw = P.in[I_MLW] + col;
      float y[16];
#pragma unroll
      for (int e = 0; e < 16; ++e) y[e] = hv[e] * rstd * mw[e] * gv[e];
      u32x4 o0, o1; o0.x = cvtpk(y[0], y[1]); o0.y = cvtpk(y[2], y[3]); o0.z = cvtpk(y[4], y[5]); o0.w = cvtpk(y[6], y[7]); o1.x = cvtpk(y[8], y[9]); o1.y = cvtpk(y[10], y[11]); o1.z = cvtpk(y[12], y[13]); o1.w = cvtpk(y[14], y[15]);
      *(u32x4*)(YC + row * 1024 + col) = o0; *(u32x4*)(YC + row * 1024 + col + 8) = o1; }
}

constexpr int AT_KP = 144, AT_VP = 136, AT_WAVE = 64 * AT_KP + 64 * AT_VP;
__device__ __forceinline__ void sb_step(clptr Kt, clptr Vt, const bf16x8 (&qf)[4], f32x16& o0, f32x16& o1, float& carry, int lane, bool domask, int kq) {
    const int n31 = lane & 31, hh = lane >> 5;
    const int krow = (n31 & ~12) | ((n31 & 4) << 1) | ((n31 & 8) >> 1);
    f32x16 p[2];
#pragma unroll
    for (int r = 0; r < 16; ++r) { p[0][r] = 0.f; p[1][r] = 0.f; }
#pragma unroll
    for (int ks = 0; ks < 4; ++ks) {
        p[0] = MFMA32(*(const LAS bf16x8*)(Kt + krow * AT_KP + (16 * ks + 8 * hh) * 2), qf[ks], p[0]);
        p[1] = MFMA32(*(const LAS bf16x8*)(Kt + (32 + krow) * AT_KP + (16 * ks + 8 * hh) * 2), qf[ks], p[1]);
    }
    f32x16 om[2];
    float town[4], tpar[4];
#pragma unroll
    for (int u = 0; u < 2; ++u)
#pragma unroll
        for (int a = 0; a < 2; ++a) { float tp = 1.f;
#pragma unroll
            for (int j = 0; j < 8; ++j) { const int r = 8 * a + j;
                const float z = fminf(fmaxf(p[u][r], -60.f), 60.f);
                const float e = fast_exp2(-z); float sg = fast_rcp(1.f + e); float o = e * sg;
                if (domask) { const int kl = 32 * u + 16 * a + 8 * hh + j; if (kl >= kq) { sg = 0.f; o = 1.f; } }
                p[u][r] = sg; om[u][r] = o; tp *= o; }
            town[2 * u + a] = tp; }
#pragma unroll
    for (int i = 0; i < 4; ++i) tpar[i] = __shfl_xor(town[i], 32);
    float suf[5]; suf[4] = 1.f;
#pragma unroll
    for (int i = 3; i >= 0; --i) suf[i] = suf[i + 1] * (town[i] * tpar[i]);
    bf16x8 pf[4];
#pragma unroll
    for (int u = 0; u < 2; ++u)
#pragma unroll
        for (int a = 0; a < 2; ++a) { const int pr = 2 * u + a;
            float R = carry * suf[pr + 1] * (hh == 0 ? tpar[pr] : 1.f);
            float av[8];
#pragma unroll
            for (int j = 7; j >= 0; --j) { av[j] = p[u][8 * a + j] * R; R *= om[u][8 * a + j]; }
            u32x4 w; w.x = cvtpk(av[0], av[1]); w.y = cvtpk(av[2], av[3]); w.z = cvtpk(av[4], av[5]); w.w = cvtpk(av[6], av[7]);
            pf[pr] = __builtin_bit_cast(bf16x8, w); }
    carry *= suf[0];
#pragma unroll
    for (int pr = 0; pr < 4; ++pr) {
        o0 = MFMA32(tr_frag(Vt, AT_VP, 16 * pr, 0, lane), pf[pr], o0);
        o1 = MFMA32(tr_frag(Vt, AT_VP, 16 * pr, 32, lane), pf[pr], o1);
    }
}
__device__ __forceinline__ void attn_prompt_item(const Params& P, lptr lds, int b, int rb, int lane, int wave) {
    const int h = wave, n31 = lane & 31, hh = lane >> 5;
    const bf16_t* SQ = (const bf16_t*)(P.ws + WS_PROJ + 4 * PROJ_STRIDE); const bf16_t* SK = (const bf16_t*)(P.ws + WS_PROJ + 5 * PROJ_STRIDE); const bf16_t* SV = (const bf16_t*)(P.ws + WS_PROJ + 6 * PROJ_STRIDE);
    const size_t rowb = (size_t)b * SEQ; const int q0 = 32 * rb;
    lptr Kt = lds + wave * AT_WAVE; lptr Vt = Kt + 64 * AT_KP;
    bf16x8 qf[4];
#pragma unroll
    for (int ks = 0; ks < 4; ++ks) qf[ks] = *(const bf16x8*)(SQ + (rowb + q0 + n31) * 512 + h * 64 + 16 * ks + 8 * hh);
    f32x16 o0, o1;
#pragma unroll
    for (int r = 0; r < 16; ++r) { o0[r] = 0.f; o1[r] = 0.f; }
    float carry = 1.f;
    const int trow = lane >> 3, tch = lane & 7;
    u32x4 kv[8], vv[8];
    const int jt0 = (q0 + 30) >> 6;
#pragma unroll
    for (int i = 0; i < 8; ++i) { const size_t go = (rowb + 64 * jt0 + 8 * i + trow) * 512 + h * 64 + tch * 8; kv[i] = *(const u32x4*)(SK + go); vv[i] = *(const u32x4*)(SV + go); }
    for (int jt = jt0; jt >= 0; --jt) {
#pragma unroll
        for (int i = 0; i < 8; ++i) { const int row = 8 * i + trow;
            *(LAS u32x4*)(Kt + row * AT_KP + tch * 16) = kv[i];
            *(LAS u32x2*)(Vt + row * AT_VP + tch * 16) = (u32x2){vv[i].x, vv[i].y}; *(LAS u32x2*)(Vt + row * AT_VP + tch * 16 + 8) = (u32x2){vv[i].z, vv[i].w}; }
        if (jt > 0) {
#pragma unroll
            for (int i = 0; i < 8; ++i) { const size_t go = (rowb + 64 * (jt - 1) + 8 * i + trow) * 512 + h * 64 + tch * 8; kv[i] = *(const u32x4*)(SK + go); vv[i] = *(const u32x4*)(SV + go); } }
        sb_step(Kt, Vt, qf, o0, o1, carry, lane, 64 * jt + 63 >= q0, q0 + n31 - 64 * jt);
        if (__all(carry < 1e-30f)) break;
    }
    float ss = 0.f;
#pragma unroll
    for (int r = 0; r < 16; ++r) ss += o0[r] * o0[r] + o1[r] * o1[r];
    ss += __shfl_xor(ss, 32);
    const size_t row = rowb + q0 + n31;
    LAS float* sx = (LAS float*)(lds + 8 * AT_WAVE);
    if (hh == 0) sx[wave * 32 + n31] = ss;
    __syncthreads();
    float tot = 0.f;
#pragma unroll
    for (int w2 = 0; w2 < 8; ++w2) tot += sx[w2 * 32 + n31];
    const float rstd = rsqrtf(tot * (1.f / 512.f) + EPS);
    bf16_t* yo = (bf16_t*)(P.ws + WS_YCAT) + row * 1024 + 512 + h * 64 + 4 * hh;
#pragma unroll
    for (int g = 0; g < 4; ++g) {
        *(u32x2*)(yo + 8 * g) = (u32x2){cvtpk(o0[4 * g] * rstd, o0[4 * g + 1] * rstd), cvtpk(o0[4 * g + 2] * rstd, o0[4 * g + 3] * rstd)};
        *(u32x2*)(yo + 32 + 8 * g) = (u32x2){cvtpk(o1[4 * g] * rstd, o1[4 * g + 1] * rstd), cvtpk(o1[4 * g + 2] * rstd, o1[4 * g + 3] * rstd)};
    }
}
__device__ __forceinline__ void attn_sample_item(const Params& P, lptr lds, int bh, int tid, int lane, int wave) {
    const int b = bh >> 3, h = bh & 7, n31 = lane & 31, hh = lane >> 5;
    const bf16_t* SQ = (const bf16_t*)(P.ws + WS_PROJ + 4 * PROJ_STRIDE); const bf16_t* SK = (const bf16_t*)(P.ws + WS_PROJ + 5 * PROJ_STRIDE); const bf16_t* SV = (const bf16_t*)(P.ws + WS_PROJ + 6 * PROJ_STRIDE);
    const size_t rows = (size_t)MP + b * 32;
    lptr Kt = lds + wave * AT_WAVE; lptr Vt = Kt + 64 * AT_KP;
    bf16x8 qf[4];
#pragma unroll
    for (int ks = 0; ks < 4; ++ks) qf[ks] = *(const bf16x8*)(SQ + (rows + n31) * 512 + h * 64 + 16 * ks + 8 * hh);
    f32x16 o0, o1;
#pragma unroll
    for (int r = 0; r < 16; ++r) { o0[r] = 0.f; o1[r] = 0.f; }
    float carry = 1.f;
    if (wave == 7) {
        const int trow = lane >> 3, tch = lane & 7;
#pragma unroll
        for (int i = 0; i < 8; ++i) { const int row = 8 * i + trow; u32x4 kv = {0u, 0u, 0u, 0u}, vv = {0u, 0u, 0u, 0u};
            if (row < 32) { const size_t go = (rows + row) * 512 + h * 64 + tch * 8; kv = *(const u32x4*)(SK + go); vv = *(const u32x4*)(SV + go); }
            *(LAS u32x4*)(Kt + row * AT_KP + tch * 16) = kv;
            *(LAS u32x2*)(Vt + row * AT_VP + tch * 16) = (u32x2){vv.x, vv.y}; *(LAS u32x2*)(Vt + row * AT_VP + tch * 16 + 8) = (u32x2){vv.z, vv.w}; }
        sb_step(Kt, Vt, qf, o0, o1, carry, lane, true, n31);
    }
    const float* CK = P.in[I_CK] + (size_t)b * PAST * 512 + h * 64; const float* CV = P.in[I_CV] + (size_t)b * PAST * 512 + h * 64;
    for (int jt = 4 * wave + 3; jt >= 4 * wave; --jt) {
        const int trow = lane >> 4, c4 = lane & 15;
#pragma unroll
        for (int i = 0; i < 16; ++i) { const int row = 4 * i + trow; const size_t go = (size_t)(64 * jt + row) * 512 + c4 * 4;
            const f32x4 kx = *(const f32x4*)(CK + go), vx = *(const f32x4*)(CV + go);
            *(LAS u32x2*)(Kt + row * AT_KP + c4 * 8) = (u32x2){cvtpk(kx.x, kx.y), cvtpk(kx.z, kx.w)};
            *(LAS u32x2*)(Vt + row * AT_VP + c4 * 8) = (u32x2){cvtpk(vx.x, vx.y), cvtpk(vx.z, vx.w)}; }
        sb_step(Kt, Vt, qf, o0, o1, carry, lane, false, 0);
    }
    __syncthreads();
    LAS float* carr = (LAS float*)(lds + 65536);
    if (hh == 0) carr[wave * 32 + n31] = carry;
    __syncthreads();
    float mult = 1.f;
    for (int w2 = wave + 1; w2 < 8; ++w2) mult *= carr[w2 * 32 + n31];
#pragma unroll
    for (int g = 0; g < 4; ++g) {
        *(LAS f32x4*)(lds + (((wave * 8 + g) * 64 + lane) * 16)) = (f32x4){o0[4 * g] * mult, o0[4 * g + 1] * mult, o0[4 * g + 2] * mult, o0[4 * g + 3] * mult};
        *(LAS f32x4*)(lds + (((wave * 8 + 4 + g) * 64 + lane) * 16)) = (f32x4){o1[4 * g] * mult, o1[4 * g + 1] * mult, o1[4 * g + 2] * mult, o1[4 * g + 3] * mult};
    }
    __syncthreads();
    { const int q = tid >> 4, part = tid & 15; const int slot = (part >> 3) * 4 + ((part & 7) >> 1), ln = q + 32 * (part & 1);
      f32x4 v = {0.f, 0.f, 0.f, 0.f};
#pragma unroll
      for (int w2 = 0; w2 < 8; ++w2) v = v + *(const LAS f32x4*)(lds + (((w2 * 8 + slot) * 64 + ln) * 16));
      float ss = (v.x * v.x + v.y * v.y) + (v.z * v.z + v.w * v.w);
      ss += __shfl_xor(ss, 1); ss += __shfl_xor(ss, 2); ss += __shfl_xor(ss, 4); ss += __shfl_xor(ss, 8);
      const size_t row = rows + q;
      if (part == 0) ((float*)(P.ws + WS_SSQ))[row * 8 + h] = ss;
      *(u32x2*)((bf16_t*)(P.ws + WS_YCAT) + row * 1024 + 512 + h * 64 + part * 4) = (u32x2){cvtpk(v.x, v.y), cvtpk(v.z, v.w)}; }
    __syncthreads();
}
#ifndef M1NC
#define M1NC 2
#endif
constexpr int NQ_G1S = 224, NQ_AT = 1024, NQ_M1 = 2048 / M1NC, NQ_TOTAL = NQ_G1S + NQ_AT + NQ_M1;
template <class EpiS>
__device__ __forceinline__ void phase_mixers(const Params& P, lptr lds, int tid_in, int wave, const EpiS& Es) {
    unsigned* ctr = (unsigned*)(P.ws + WS_CTL);
    for (;;) {
        __syncthreads();
        if (tid_in == 0) *(LAS int*)(lds + QOFF) = (int)atomicAdd(ctr, 1u);
        __syncthreads();
        int item = *(const LAS int*)(lds + QOFF);
        int tid = tid_in; asm volatile("" : "+v"(tid));
        const int lane = tid & 63;
        if (item >= NQ_TOTAL) break;
        if (item < NQ_G1S) { small_tile<1024, false>((const bf16_t*)(P.ws + WS_H) + (size_t)MP * 1024, (const bf16_t*)(P.ws + WS_W1T), Es, nullptr, lds, item, tid, lane, wave); continue; }
        item -= NQ_G1S;
        if (item < NQ_AT) { attn_prompt_item(P, lds, item & 7, 127 - (item >> 3), lane, wave); continue; }
        item -= NQ_AT;
        ml1_pair<M1NC>(P, lds, item, tid, lane, wave);
    }
}
__device__ __forceinline__ void phase_ml2(const Params& P, lptr lds, int tid_in, int wave) {
    int tid = tid_in; asm volatile("" : "+v"(tid));
    if (blockIdx.x < 160) { for (int job = blockIdx.x; job < 256; job += 160) { __syncthreads(); ml2_scan(P, lds, tid, job); } }
    else if (blockIdx.x < 192) mlstm_item(P, lds, blockIdx.x - 160, true, tid, tid & 63, wave);
    else attn_sample_item(P, lds, blockIdx.x - 192, tid, tid & 63, wave);
}
template <class EpiS>
__device__ __forceinline__ void phase_ml3(const Params& P, lptr lds, int tid_in, int wave, const EpiS& Es) {
    if (blockIdx.x >= 192) { int tid = tid_in; asm volatile("" : "+v"(tid));
        small_tile<1024, true>((const bf16_t*)(P.ws + WS_YCAT) + (size_t)MP * 1024, (const bf16_t*)(P.ws + WS_W2T), Es, (const float*)(P.ws + WS_SSQ), lds, blockIdx.x - 192, tid, tid & 63, wave); }
#ifdef DBL_M3
    for (int rep = 0; rep < 2; ++rep)
#endif
    { int tid = tid_in; asm volatile("" : "+v"(tid));
      Ml3In cur, nxt; ml3_load(P, blockIdx.x, tid, tid & 63, wave, cur);
#pragma unroll 1
      for (int item = blockIdx.x; item < 2048; item += gridDim.x) {
          const int nitem = item + gridDim.x;
          if (nitem < 2048) ml3_load(P, nitem, tid, tid & 63, wave, nxt);
          ml3_item(P, lds, item, cur, tid, tid & 63, wave);
          cur = nxt;
      } }
}

__global__ void __launch_bounds__(512, 2) fwd(Params P) {
    extern __shared__ __attribute__((aligned(16))) unsigned char lds_raw[];
    lptr lds = (lptr)lds_raw;
    cg::grid_group grid = cg::this_grid();
    int tid = threadIdx.x, lane = tid & 63; const int wave = __builtin_amdgcn_readfirstlane(tid >> 6);
#define FRESH_TID() do { asm volatile("" : "+v"(tid)); lane = tid & 63; } while (0)
    const int gw = blockIdx.x * 8 + wave, NGW = gridDim.x * 8;
    unsigned char* ws = P.ws;
    const float* MOD = (const float*)(ws + WS_MOD);
    bf16_t* H = (bf16_t*)(ws + WS_H); bf16_t* PROJ = (bf16_t*)(ws + WS_PROJ); bf16_t* YC = (bf16_t*)(ws + WS_YCAT); bf16_t* ACT = (bf16_t*)(ws + WS_ACT);

#ifndef G_ALIGN
#define G_ALIGN true
#endif
#ifndef G_SP2
#define G_SP2 true
#endif
#ifndef PH
#define PH 0xFFFF
#endif
    if (tid == 0) { *(LAS unsigned*)(lds + LDS_BYTES - 32) = 0u; *(LAS unsigned*)(lds + LDS_BYTES - 28) = 0u; }
    __syncthreads();
    const XcdBarrier bar = xcd_barrier_post((unsigned*)(ws + WS_CTL) + 1024, (volatile LAS unsigned*)(lds + LDS_BYTES - 32));
    __syncthreads();
    const unsigned xrank = *(volatile LAS unsigned*)(lds + LDS_BYTES - 24);
    const int vcu = (xrank < 32u && bar.x < 8u) ? (int)(xrank * 8u + bar.x) : (int)blockIdx.x;
    if (P.out == nullptr) grid.sync();
    phase0(P, lds, tid, lane, wave);
#ifdef DBL_P0
    __syncthreads(); phase0(P, lds, tid, lane, wave);
#endif
    xcd_barrier(bar);
    FRESH_TID();
    phase1(P, lds, tid, lane, wave);
    __syncthreads();
    phase_weights(P, lds, lane, wave);
#ifdef DBL_P1
    __syncthreads(); phase1(P, lds, tid, lane, wave);
#endif
#ifdef DBL_P1NG
    __syncthreads(); phase1_nogates(P, lds, tid, lane, wave);
#endif
#ifdef DBL_W
    __syncthreads(); phase_weights(P, lds, lane, wave);
#endif
    xcd_barrier(bar);
    FRESH_TID();
    {
        EpiProj E{PROJ, P.out + O_PK, P.out + O_PV, P.in[I_SQW], P.in[I_SKW], 0};
        pg8::Gemm g{H, (const bf16_t*)(ws + WS_W1T), MP, NPROJ, 1024}; pg8::StaticOrder S; S.init(MP, NPROJ, gridDim.x, vcu);
        pg8::gemm_phase<EpiProj, pg8::StaticOrder, G_ALIGN, G_SP2>(lds, g, S, E);
#ifdef DBL_G
        pg8::gemm_phase<EpiProj, pg8::StaticOrder, G_ALIGN, G_SP2>(lds, g, S, E);
#endif
    }
    xcd_barrier(bar);
    FRESH_TID();
    {
        EpiProj Es{PROJ, P.out + O_SK, P.out + O_SV, P.in[I_SQW], P.in[I_SKW], MP};
        phase_mixers(P, lds, tid, wave, Es);
    }
    xcd_barrier(bar);
    FRESH_TID();
    phase_ml2(P, lds, tid, wave);
#ifdef DBL_M2
    __syncthreads(); phase_ml2(P, lds, tid, wave);
#endif
    xcd_barrier(bar);
    FRESH_TID();
    {
        EpiRes<0> Es{P.in[I_XS], (bf16_t*)(ws + WS_X1B) + (size_t)MP * 1024, MOD + 8 * 6144 + 2048, 5};
        phase_ml3(P, lds, tid, wave, Es);
    }
#ifdef XSYNC
    for (int i = 0; i < XSYNC; ++i) xcd_barrier(bar);
#endif
    xcd_barrier(bar);
    FRESH_TID();
    {
        sample_h2_row(P, lds, tid, lane, wave);
        EpiRes<0> E{P.in[I_XP], ws + WS_X1B, MOD + 2048, 12};
        pg8::Gemm g{YC, (const bf16_t*)(ws + WS_W2T), MP, 1024, 1024}; pg8::StaticOrder S; S.init(MP, 1024, gridDim.x, vcu);
        pg8::gemm_phase<EpiRes<0>, pg8::StaticOrder, G_ALIGN, G_SP2>(lds, g, S, E);
    }
    xcd_barrier(bar);
    FRESH_TID();
    {
        phase5(P, lds, tid, lane, wave);
#ifdef DBL_P5
        phase5(P, lds, tid, lane, wave);
#endif
        EpiFFNs Es{ACT, P.out + O_SF, P.in[I_SFC], P.in[I_WCONV], P.in[I_BCONV]};
        for (int t = blockIdx.x; t < 352; t += gridDim.x) small_tile<1024, false>(H + (size_t)MP * 1024, (const bf16_t*)(ws + WS_W3T), Es, nullptr, lds, t, tid, lane, wave);
    }
    xcd_barrier(bar);
    FRESH_TID();
    {
        EpiFFN E{ACT, (float*)(ws + WS_UEDGE), P.out + O_PF, P.in[I_WCONV], P.in[I_BCONV]};
        pg8::Gemm g{H, (const bf16_t*)(ws + WS_W3T), MP, FF2, 1024}; pg8::StaticOrder S; S.init(MP, FF2, gridDim.x, vcu);
        pg8::gemm_phase<EpiFFN, pg8::StaticOrder, true, G_SP2>(lds, g, S, E);
#ifdef DBL_G
        pg8::gemm_phase<EpiFFN, pg8::StaticOrder, true, G_SP2>(lds, g, S, E);
#endif
    }
    xcd_barrier(bar);
    FRESH_TID();
    {
        phase_fix(P, tid);
        EpiRes<1> Es{(const bf16_t*)(ws + WS_X1B) + (size_t)MP * 1024, P.out + O_YS, MOD + 8 * 6144 + 5120, 5};
        if (blockIdx.x < 64) small_tile<FF, false>(ACT + (size_t)MP * FF, (const bf16_t*)(ws + WS_W4T), Es, nullptr, lds, blockIdx.x, tid, lane, wave);
    }
    xcd_barrier(bar);
    FRESH_TID();
    {
        EpiRes<1> E{ws + WS_X1B, P.out + O_YP, MOD + 5120, 12};
        pg8::Gemm g{ACT, (const bf16_t*)(ws + WS_W4T), MP, 1024, FF}; pg8::StaticOrder S; S.init(MP, 1024, gridDim.x, vcu);
        pg8::gemm_phase<EpiRes<1>, pg8::StaticOrder, G_ALIGN, G_SP2>(lds, g, S, E);
    }

#ifdef DIAG
    xcd_barrier(bar);
    {
        const size_t offs[15] = {O_YP, O_YS, O_PC, O_PN, O_PM, O_PK, O_PV, O_PF, O_SC, O_SN, O_SM, O_SK, O_SV, O_SF, O_END};
        for (int o = 0; o < 14; ++o) if ((DIAG >> o) & 1) for (size_t i = offs[o] + (size_t)blockIdx.x * 512 + tid; i < offs[o + 1]; i += (size_t)gridDim.x * 512) P.out[i] *= 1.2f;
    }
#endif
}

extern "C" void kernel_launch(void* const* d_in, const int* in_sizes, int n_in, void* d_out, int out_size, void* d_ws, size_t ws_size, hipStream_t stream) {
    static int grid_blocks = 0;
    if (!grid_blocks) {
        int dev = 0, cus = 0, per_cu = 0;
        (void)hipGetDevice(&dev);
        (void)hipDeviceGetAttribute(&cus, hipDeviceAttributeMultiprocessorCount, dev);
        (void)hipFuncSetAttribute((const void*)fwd, hipFuncAttributeMaxDynamicSharedMemorySize, LDS_BYTES);
        (void)hipOccupancyMaxActiveBlocksPerMultiprocessor(&per_cu, (const void*)fwd, 512, LDS_BYTES);
        grid_blocks = cus;
        if (n_in != 26 || out_size != (int)O_END || ws_size < WS_END2 || cus != 256 || per_cu < 1) {
            fprintf(stderr, "kernel_launch: unexpected geometry: n_in %d out %d ws %zu cus %d per_cu %d\n", n_in, out_size, ws_size, cus, per_cu);
            if (n_in != 26 || out_size != (int)O_END || ws_size < WS_END2 || cus != 256) grid_blocks = -1;
        }
    }
    if (grid_blocks < 0) return;
    if (hipMemsetAsync((char*)d_ws + WS_CTL, 0, (1024 + XCD_BAR_WORDS) * 4, stream) != hipSuccess) { fprintf(stderr, "kernel_launch: memset of the control words failed\n"); return; }
    Params p{};
    for (int i = 0; i < 26; ++i) p.in[i] = (const float*)d_in[i];
    p.out = (float*)d_out; p.ws = (unsigned char*)d_ws;
    void* args[] = {&p};
    hipError_t e = hipLaunchCooperativeKernel((const void*)fwd, dim3(grid_blocks), dim3(512), args, LDS_BYTES, stream);
    if (e != hipSuccess) fprintf(stderr, "cooperative launch failed: %s (grid %d)\n", hipGetErrorString(e), grid_blocks);
}
```

```cpp
#include <hip/hip_runtime.h>
#include <hip/hip_cooperative_groups.h>
#include <cstdio>
#include <cstdint>
namespace cg = cooperative_groups;

#define LAS __attribute__((address_space(3)))
typedef unsigned short bf16_t;
typedef short bf16x8 __attribute__((ext_vector_type(8)));
typedef short s16x4 __attribute__((ext_vector_type(4)));
typedef float f32x2 __attribute__((ext_vector_type(2)));
typedef float f32x4 __attribute__((ext_vector_type(4)));
typedef float f32x16 __attribute__((ext_vector_type(16)));
typedef unsigned u32x2 __attribute__((ext_vector_type(2)));
typedef unsigned u32x4 __attribute__((ext_vector_type(4)));
typedef __bf16 bf16x2_t __attribute__((ext_vector_type(2)));
typedef LAS unsigned char* lptr;
typedef const LAS unsigned char* clptr;

constexpr int DM = 1024, SEQ = 4096, NB = 8, MP = NB * SEQ, DEC = 32, MS = NB * DEC, MT = MP + MS, PAST = 2048;
constexpr int DIN = 3592, NPROJ = 3584, FF = 2816, FF2 = 5632;
constexpr float EPS = 1e-6f;
constexpr float LOG2E = 1.4426950408889634f;
constexpr size_t O_YP = 0, O_YS = 33554432, O_PC = 33816576, O_PN = 34340864, O_PM = 34344960, O_PK = 34344992, O_PV = 51122208,
                 O_PF = 67899424, O_SC = 67989536, O_SN = 68513824, O_SM = 68517920, O_SK = 68517952, O_SV = 68649024, O_SF = 68780096, O_END = 68870208;
constexpr size_t MiB = 1u << 20;
constexpr size_t WS_CTL = 0, WS_MODP = 1 * MiB, WS_MOD = 7 * MiB, WS_GATES = 8 * MiB, WS_SSQ = 10 * MiB, WS_UEDGE = 12 * MiB,
                 WS_W1T = 24 * MiB, WS_W2T = 31 * MiB, WS_W3T = 33 * MiB, WS_W4T = 44 * MiB, WS_H = 52 * MiB, WS_PROJ = 120 * MiB,
                 PROJ_STRIDE = 33 * MiB, WS_YCAT = 352 * MiB, WS_ACT = 120 * MiB, WS_END = 420 * MiB;
constexpr size_t WS_X1B = 424 * MiB;
constexpr int LDS_BYTES = 147456;
constexpr int QOFF = LDS_BYTES - 64;

struct Params { const float* in[26]; float* out; unsigned char* ws; };
enum { I_XP = 0, I_XS, I_CP, I_CS, I_STC, I_STN, I_STM, I_CK, I_CV, I_SFC, I_WADA, I_BADA, I_N1W, I_WIN, I_BIG, I_BFG, I_MLW, I_SQW, I_SKW, I_SOW,
       I_WOUT, I_N2W, I_WUP, I_WCONV, I_BCONV, I_WDOWN };

__device__ __forceinline__ unsigned cvtpk(float lo, float hi) { f32x2 v = {lo, hi}; bf16x2_t b = __builtin_convertvector(v, bf16x2_t); return __builtin_bit_cast(unsigned, b); }
__device__ __forceinline__ float bf2f(unsigned short x) { return __uint_as_float((unsigned)x << 16); }
__device__ __forceinline__ float bflo(unsigned w) { return __uint_as_float(w << 16); }
__device__ __forceinline__ float bfhi(unsigned w) { return __uint_as_float(w & 0xffff0000u); }
__device__ __forceinline__ unsigned short f2bf(float f) { return (unsigned short)(cvtpk(f, 0.f) & 0xffffu); }
__device__ __forceinline__ float wave_sum(float v) {
#pragma unroll
    for (int o = 1; o < 64; o <<= 1) v += __shfl_xor(v, o);
    return v;
}
__device__ __forceinline__ float fast_exp2(float x) { return __builtin_amdgcn_exp2f(x); }
__device__ __forceinline__ float fast_rcp(float x) { return __builtin_amdgcn_rcpf(x); }
__device__ __forceinline__ float sigmoidf_(float x) { return fast_rcp(1.f + fast_exp2(-x * LOG2E)); }
__device__ __forceinline__ int crow(int r, int hi) { return (r & 3) + 8 * (r >> 2) + 4 * hi; }
typedef short v4i16_t __attribute__((ext_vector_type(4)));
__device__ __forceinline__ s16x4 tr_read(clptr p) { return __builtin_bit_cast(s16x4, __builtin_amdgcn_ds_read_tr16_b64_v4i16((LAS v4i16_t*)p)); }
__device__ __forceinline__ bf16x8 tr_frag(clptr base, int P, int R0, int C0, int lane) {
    const int h = lane >> 5, blk = (lane >> 4) & 1, q = (lane & 15) >> 2, p = lane & 3;
    clptr a = base + (R0 + 8 * h + q) * P + (C0 + 16 * blk + 4 * p) * 2;
    const s16x4 lo = tr_read(a), hi = tr_read(a + 4 * P);
    return (bf16x8){lo[0], lo[1], lo[2], lo[3], hi[0], hi[1], hi[2], hi[3]};
}
__device__ __forceinline__ bf16x8 row_frag(clptr base, int P, int R0, int K0, int lane) {
    return *(const LAS bf16x8*)(base + (R0 + (lane & 31)) * P + (K0 + 8 * (lane >> 5)) * 2);
}
#define MFMA32(a, b, c) __builtin_amdgcn_mfma_f32_32x32x16_bf16((a), (b), (c), 0, 0, 0)
#define MFMA16(a, b, c) __builtin_amdgcn_mfma_f32_16x16x32_bf16((a), (b), (c), 0, 0, 0)

namespace pg8 {
#define PG8_LAS __attribute__((address_space(3)))
typedef unsigned short bf16_t;
typedef short bf16x8 __attribute__((ext_vector_type(8)));
typedef float f32x4 __attribute__((ext_vector_type(4)));
typedef unsigned u32x4 __attribute__((ext_vector_type(4)));
constexpr int BM = 256, BK = 64, HALF = 128, HTB = HALF * BK * 2  , STAGE_BYTES = 8 * HTB, NXCD = 8, WGM = 8;

__host__ __device__ __forceinline__ int lds_byte(int r, int c) { const int st = (r >> 4) * 2 + (c >> 5), rr = r & 15, cc = c & 31, ob = rr * 64 + cc * 2; return st * 1024 + (ob ^ (((ob >> 9) & 1) << 5)); }
__host__ __device__ __forceinline__ void stage_rc(int b, int& R, int& C) { const int st = b / 1024, sb = b % 1024, swz = sb ^ (((sb >> 9) & 1) << 5); R = (st >> 1) * 16 + swz / 64; C = (st & 1) * 32 + (swz % 64) / 2; }
__host__ __device__ __forceinline__ int perm32(int rho) { const int n = rho >> 4, i = rho & 15; return 8 * (i >> 2) + 4 * n + (i & 3); }

struct Unit { int pm, pn; };
struct Gemm { const bf16_t* A; const bf16_t* Bt; int M, N, K; };

struct StaticOrder {
    int nM, nN, nwg, G, c;
    __host__ __device__ void init(int M, int N, int G_, int c_) { nM = M / BM; nN = N / BM; nwg = nM * nN; G = G_; c = c_; }
    __host__ __device__ bool next(int i, Unit& u) const {
        const long L = (long)i * G + c; if (L >= nwg) return false;
        int wgid = (int)L; { const int q = nwg / NXCD, r = nwg % NXCD, xcd = wgid % NXCD, off = wgid / NXCD; wgid = (xcd < r ? xcd * (q + 1) : r * (q + 1) + (xcd - r) * q) + off; }
        const int nig = WGM * nN, gid = wgid / nig, fm = gid * WGM, gsz = (nM - fm) < WGM ? (nM - fm) : WGM;
        u.pm = fm + ((wgid % nig) % gsz); u.pn = (wgid % nig) / gsz; return true;
    }
    __device__ __forceinline__ void a_ready(const Unit&) const {}
    __device__ __forceinline__ void done(const Unit&) const {}
};

template <class Epi, class Sched, bool ALIGN_EPI = false, bool SP2 = false>
__device__ __forceinline__ void gemm_phase(PG8_LAS unsigned char* lds, const Gemm g, const Sched& S, const Epi& E) {
    int tid_o = threadIdx.x; asm volatile("" : "+v"(tid_o));
    const int tid = tid_o, wid = __builtin_amdgcn_readfirstlane(tid >> 6), lane = tid & 63, wr = wid >> 2, wc = wid & 3, fr = lane & 15, fq = lane >> 4;
    const int K = g.K, nt = K / BK;
    unsigned voffA[2], voffB[2];
#pragma unroll
    for (int i = 0; i < 2; ++i) { int R, C; stage_rc(tid * 16 + i * 8192, R, C); const int Rb = Epi::PERM ? ((R & ~31) + perm32(R & 31)) : R;
        voffA[i] = (unsigned)(R * K + C) * 2u; voffB[i] = (unsigned)(Rb * K + C) * 2u; }
    const size_t kstep = (size_t)(BK * 2);
    const size_t hstep = (size_t)HALF * K * 2;
    const size_t tstep = 2 * hstep;
    const unsigned ldsw = (unsigned)wid * 1024u;
    const int aoff = lds_byte(wr * 64 + fr, fq * 8), boff = lds_byte(wc * 32 + fr, fq * 8);
#define PG8_SA(b, h) (((b) * 2 + (h)) * HTB)
#define PG8_SB(b, h) ((4 + (b) * 2 + (h)) * HTB)
#define PG8_STAGE(bufoff, gbase, voff) do { _Pragma("unroll") for (int _i = 0; _i < 2; ++_i) \
        __builtin_amdgcn_global_load_lds((const unsigned*)((const char*)(gbase) + (voff)[_i]), (PG8_LAS unsigned*)(lds + (bufoff) + ldsw + _i * 8192), 16, 0, 0); } while (0)
#define PG8_LDA(dst, b, h) do { _Pragma("unroll") for (int m = 0; m < 4; ++m) _Pragma("unroll") for (int k = 0; k < 2; ++k) dst[m][k] = *(const PG8_LAS bf16x8*)(lds + PG8_SA(b, h) + aoff + m * 2048 + k * 1024); } while (0)
#define PG8_LDB(dst, b, h) do { _Pragma("unroll") for (int n = 0; n < 2; ++n) _Pragma("unroll") for (int k = 0; k < 2; ++k) dst[n][k] = *(const PG8_LAS bf16x8*)(lds + PG8_SB(b, h) + boff + n * 2048 + k * 1024); } while (0)
#define PG8_MMA(ai, bj, At, Bt) do { __builtin_amdgcn_s_setprio(1); _Pragma("unroll") for (int m = 0; m < 4; ++m) _Pragma("unroll") for (int n = 0; n < 2; ++n) _Pragma("unroll") for (int k = 0; k < 2; ++k) \
        acc[ai][bj][m][n] = __builtin_amdgcn_mfma_f32_16x16x32_bf16(Bt[n][k], At[m][k], acc[ai][bj][m][n], 0, 0, 0); __builtin_amdgcn_s_setprio(0); } while (0)
#define PG8_WAIT_V(n) asm volatile("s_waitcnt vmcnt(" #n ")" ::: "memory")
#define PG8_WAIT_L(n) asm volatile("s_waitcnt lgkmcnt(" #n ")" ::: "memory")
#define PG8_BAR __builtin_amdgcn_s_barrier()
#define PG8_SCHED __builtin_amdgcn_sched_barrier(0)
    Unit cur, nxt; int ui = 0;
    if (!S.next(0, cur)) return;
    f32x4 acc[2][2][4][2];
#pragma unroll
    for (int a = 0; a < 2; ++a)
#pragma unroll
        for (int b = 0; b < 2; ++b)
#pragma unroll
            for (int m = 0; m < 4; ++m)
#pragma unroll
                for (int n = 0; n < 2; ++n) acc[a][b][m][n] = (f32x4){0.f, 0.f, 0.f, 0.f};
    bf16x8 At[4][2], B0[2][2], B1[2][2];
    const char* cA = (const char*)g.A + (size_t)cur.pm * tstep; const char* cB = (const char*)g.Bt + (size_t)cur.pn * tstep;
    S.a_ready(cur);
    if constexpr (SP2) {
        PG8_STAGE(PG8_SB(0, 0), cB, voffB); PG8_STAGE(PG8_SB(0, 1), cB + hstep, voffB); PG8_STAGE(PG8_SA(0, 0), cA, voffA); PG8_STAGE(PG8_SA(0, 1), cA + hstep, voffA);
        if (wr == 1) PG8_BAR;
        PG8_WAIT_V(2); PG8_BAR;
        PG8_STAGE(PG8_SB(1, 0), cB + kstep, voffB); PG8_STAGE(PG8_SA(1, 0), cA + kstep, voffA); PG8_STAGE(PG8_SB(1, 1), cB + hstep + kstep, voffB);
        PG8_WAIT_V(6); PG8_BAR;
    } else {
        PG8_STAGE(PG8_SB(0, 0), cB, voffB); PG8_STAGE(PG8_SA(0, 0), cA, voffA); PG8_STAGE(PG8_SB(0, 1), cB + hstep, voffB); PG8_STAGE(PG8_SA(0, 1), cA + hstep, voffA);
        if (wr == 1) PG8_BAR;
        PG8_WAIT_V(4); PG8_BAR;
        PG8_STAGE(PG8_SB(1, 0), cB + kstep, voffB); PG8_STAGE(PG8_SA(1, 0), cA + kstep, voffA); PG8_STAGE(PG8_SB(1, 1), cB + hstep + kstep, voffB);
        PG8_WAIT_V(6); PG8_BAR;
    }
    for (;;) {
        const bool has_next = S.next(ui + 1, nxt);
        const char* nA = has_next ? (const char*)g.A + (size_t)nxt.pm * tstep : cA; const char* nB = has_next ? (const char*)g.Bt + (size_t)nxt.pn * tstep : cB;
        for (int t = 0; t < nt; t += 2) {
            const bool last = (t == nt - 2);
            const char* a1 = cA + (size_t)(t + 1) * kstep;
            const char* a2 = last ? nA : cA + (size_t)(t + 2) * kstep; const char* b2 = last ? nB : cB + (size_t)(t + 2) * kstep;
            const char* a3 = a2 + kstep; const char* b3 = b2 + kstep;
            if (last && has_next) S.a_ready(nxt);
            if constexpr (SP2) {
            PG8_LDB(B0, 0, 0); PG8_LDB(B1, 0, 1); PG8_SCHED; PG8_LDA(At, 0, 0); PG8_STAGE(PG8_SA(1, 1), a1 + hstep, voffA);
            PG8_WAIT_V(8); PG8_WAIT_L(0); PG8_BAR; PG8_MMA(0, 0, At, B0); PG8_MMA(0, 1, At, B1); PG8_BAR; PG8_SCHED;
            PG8_LDA(At, 0, 1); PG8_STAGE(PG8_SB(0, 0), b2, voffB); PG8_STAGE(PG8_SB(0, 1), b2 + hstep, voffB); PG8_STAGE(PG8_SA(0, 0), a2, voffA);
            PG8_WAIT_V(8); PG8_WAIT_L(0); PG8_BAR; PG8_MMA(1, 0, At, B0); PG8_MMA(1, 1, At, B1); PG8_BAR; PG8_SCHED;
            PG8_LDB(B0, 1, 0); PG8_LDB(B1, 1, 1); PG8_SCHED; PG8_LDA(At, 1, 0); PG8_STAGE(PG8_SA(0, 1), a2 + hstep, voffA);
            PG8_WAIT_V(8); PG8_WAIT_L(0); PG8_BAR; PG8_MMA(0, 0, At, B0); PG8_MMA(0, 1, At, B1); PG8_BAR; PG8_SCHED;
            PG8_LDA(At, 1, 1); PG8_STAGE(PG8_SB(1, 0), b3, voffB); PG8_STAGE(PG8_SB(1, 1), b3 + hstep, voffB); PG8_STAGE(PG8_SA(1, 0), a3, voffA);
            PG8_WAIT_V(8); PG8_WAIT_L(0); PG8_BAR; PG8_MMA(1, 0, At, B0); PG8_MMA(1, 1, At, B1); PG8_BAR; PG8_SCHED;
            } else {
            PG8_LDB(B0, 0, 0); PG8_SCHED; PG8_LDA(At, 0, 0); PG8_STAGE(PG8_SA(1, 1), a1 + hstep, voffA);
            PG8_WAIT_L(8); PG8_BAR; PG8_WAIT_L(0); PG8_MMA(0, 0, At, B0); PG8_BAR; PG8_SCHED;
            PG8_LDB(B1, 0, 1); PG8_STAGE(PG8_SB(0, 0), b2, voffB);
            PG8_BAR; PG8_WAIT_L(0); PG8_MMA(0, 1, At, B1); PG8_BAR;
            PG8_LDA(At, 0, 1); PG8_STAGE(PG8_SA(0, 0), a2, voffA);
            PG8_BAR; PG8_WAIT_L(0); PG8_MMA(1, 0, At, B0); PG8_BAR; PG8_SCHED;
            PG8_STAGE(PG8_SB(0, 1), b2 + hstep, voffB);
            PG8_WAIT_V(6); PG8_BAR; PG8_MMA(1, 1, At, B1); PG8_BAR;
            PG8_LDB(B0, 1, 0); PG8_SCHED; PG8_LDA(At, 1, 0); PG8_STAGE(PG8_SA(0, 1), a2 + hstep, voffA);
            PG8_WAIT_L(8); PG8_BAR; PG8_WAIT_L(0); PG8_MMA(0, 0, At, B0); PG8_BAR; PG8_SCHED;
            PG8_LDB(B1, 1, 1); PG8_STAGE(PG8_SB(1, 0), b3, voffB);
            PG8_BAR; PG8_WAIT_L(0); PG8_MMA(0, 1, At, B1); PG8_BAR;
            PG8_LDA(At, 1, 1); PG8_STAGE(PG8_SA(1, 0), a3, voffA);
            PG8_BAR; PG8_WAIT_L(0); PG8_MMA(1, 0, At, B0); PG8_BAR; PG8_SCHED;
            PG8_STAGE(PG8_SB(1, 1), b3 + hstep, voffB);
            PG8_WAIT_V(6); PG8_BAR; PG8_MMA(1, 1, At, B1); PG8_BAR;
            }
        }
        if constexpr (ALIGN_EPI) { if (wr == 0) PG8_BAR; }
        if constexpr (!Epi::AFTER_DRAIN) { E(acc, cur, wr, wc, fr, fq, lds); S.done(cur); }
        if (!has_next) break;
#pragma unroll
        for (int a = 0; a < 2; ++a)
#pragma unroll
            for (int b = 0; b < 2; ++b)
#pragma unroll
                for (int m = 0; m < 4; ++m)
#pragma unroll
                    for (int n = 0; n < 2; ++n) acc[a][b][m][n] = (f32x4){0.f, 0.f, 0.f, 0.f};
        cur = nxt; cA = nA; cB = nB; ++ui;
        if constexpr (ALIGN_EPI) { if (wr == 1) PG8_BAR; }
    }
    PG8_WAIT_V(0);
    if constexpr (!ALIGN_EPI) { if (wr == 0) PG8_BAR; }
    PG8_BAR;
    if constexpr (Epi::AFTER_DRAIN) { E.fused(acc, cur, wr, wc, fr, fq, lds, wid, lane); S.done(cur); }
#undef PG8_SA
#undef PG8_SB
#undef PG8_STAGE
#undef PG8_LDA
#undef PG8_LDB
#undef PG8_MMA
#undef PG8_WAIT_V
#undef PG8_WAIT_L
#undef PG8_BAR
#undef PG8_SCHED
}
}

__device__ __forceinline__ u32x4 pack8(const f32x4& v0, const f32x4& v1) { u32x4 w; w.x = cvtpk(v0[0], v0[1]); w.y = cvtpk(v0[2], v0[3]); w.z = cvtpk(v1[0], v1[1]); w.w = cvtpk(v1[2], v1[3]); return w; }

struct EpiProj {
    static constexpr bool PERM = true, AFTER_DRAIN = false;
    bf16_t* proj; float* outK; float* outV; const float* qw; const float* kw; int rowoff;
    __device__ __forceinline__ void sub(const f32x4 (&a)[2][4][2], int pn, int rloc0, int wc, int fr, int fq) const {
        const int kind = pn >> 1, half = pn & 1;
        const int c8 = 256 * half + 64 * wc + 8 * fq;
        bf16_t* ob = proj + (size_t)kind * (PROJ_STRIDE / 2);
        if (kind < 4) {
#pragma unroll
            for (int m = 0; m < 4; ++m) { const size_t row = (size_t)(rowoff + rloc0 + 16 * m + fr);
#pragma unroll
                for (int bj = 0; bj < 2; ++bj) { f32x4 v0 = a[bj][m][0], v1 = a[bj][m][1];
                    if (kind == 1) { v0 = v0 * 0.08838834764831845f; v1 = v1 * 0.08838834764831845f; }
                    if (kind == 3) {
#pragma unroll
                        for (int e = 0; e < 4; ++e) { v0[e] = sigmoidf_(v0[e]); v1[e] = sigmoidf_(v1[e]); } }
                    *(u32x4*)(ob + row * 512 + c8 + 32 * bj) = pack8(v0, v1); } }
        } else if (kind < 6) {
            const float* w = kind == 4 ? qw : kw; const float osc = kind == 4 ? 0.125f * LOG2E : 1.f;
            f32x4 wv[2][2];
#pragma unroll
            for (int bj = 0; bj < 2; ++bj)
#pragma unroll
                for (int n = 0; n < 2; ++n) wv[bj][n] = *(const f32x4*)(w + 32 * bj + 8 * fq + 4 * n);
#pragma unroll
            for (int m = 0; m < 4; ++m) { const int rl = rloc0 + 16 * m + fr; float ss = 0.f;
#pragma unroll
                for (int bj = 0; bj < 2; ++bj)
#pragma unroll
                    for (int n = 0; n < 2; ++n) { const f32x4 x = a[bj][m][n]; ss += (x[0] * x[0] + x[1] * x[1]) + (x[2] * x[2] + x[3] * x[3]); }
                ss += __shfl_xor(ss, 16); ss += __shfl_xor(ss, 32);
                const float rstd = rsqrtf(ss * (1.f / 64.f) + EPS);
#pragma unroll
                for (int bj = 0; bj < 2; ++bj) { f32x4 v0 = a[bj][m][0] * rstd * wv[bj][0], v1 = a[bj][m][1] * rstd * wv[bj][1];
                    if (kind == 5) { float* o = outK + (size_t)rl * 512 + c8 + 32 * bj; __builtin_nontemporal_store(v0, (f32x4*)o); __builtin_nontemporal_store(v1, (f32x4*)(o + 4)); }
                    v0 = v0 * osc; v1 = v1 * osc;
                    *(u32x4*)(ob + (size_t)(rowoff + rl) * 512 + c8 + 32 * bj) = pack8(v0, v1); } }
        } else {
#pragma unroll
            for (int m = 0; m < 4; ++m) { const int rl = rloc0 + 16 * m + fr;
#pragma unroll
                for (int bj = 0; bj < 2; ++bj) { const f32x4 v0 = a[bj][m][0], v1 = a[bj][m][1];
                    float* o = outV + (size_t)rl * 512 + c8 + 32 * bj; __builtin_nontemporal_store(v0, (f32x4*)o); __builtin_nontemporal_store(v1, (f32x4*)(o + 4));
                    *(u32x4*)(ob + (size_t)(rowoff + rl) * 512 + c8 + 32 * bj) = pack8(v0, v1); } }
        }
    }
    __device__ __forceinline__ void operator()(const f32x4 (&acc)[2][2][4][2], const pg8::Unit& u, int wr, int wc, int fr, int fq, lptr) const {
#pragma unroll
        for (int ai = 0; ai < 2; ++ai) sub(acc[ai], u.pn, u.pm * 256 + ai * 128 + wr * 64, wc, fr, fq);
    }
};

template <int MODE>
struct EpiRes {
    static constexpr bool PERM = true, AFTER_DRAIN = false;
    const void* xin; void* xout; const float* gate; int tlog;
    __device__ __forceinline__ void sub(const f32x4 (&a)[2][4][2], int pn, int rloc0, int wc, int fr, int fq) const {
#pragma unroll
        for (int m = 0; m < 4; ++m) { const int rl = rloc0 + 16 * m + fr; const float* g = gate + (size_t)(rl >> tlog) * 6144;
#pragma unroll
            for (int bj = 0; bj < 2; ++bj) { const int c = 256 * pn + 128 * bj + 32 * wc + 8 * fq;
                const f32x4 g0 = *(const f32x4*)(g + c), g1 = *(const f32x4*)(g + c + 4);
                if (MODE == 0) {
                    const float* xp = (const float*)xin + (size_t)rl * 1024 + c;
                    const f32x4 o0 = *(const f32x4*)xp + g0 * a[bj][m][0], o1 = *(const f32x4*)(xp + 4) + g1 * a[bj][m][1];
                    *(u32x4*)((bf16_t*)xout + (size_t)rl * 1024 + c) = pack8(o0, o1);
                } else {
                    const u32x4 xv = *(const u32x4*)((const bf16_t*)xin + (size_t)rl * 1024 + c);
                    const f32x4 x0 = {bflo(xv.x), bfhi(xv.x), bflo(xv.y), bfhi(xv.y)}, x1 = {bflo(xv.z), bfhi(xv.z), bflo(xv.w), bfhi(xv.w)};
                    float* op = (float*)xout + (size_t)rl * 1024 + c;
                    __builtin_nontemporal_store(x0 + g0 * a[bj][m][0], (f32x4*)op); __builtin_nontemporal_store(x1 + g1 * a[bj][m][1], (f32x4*)(op + 4));
                } } }
    }
    __device__ __forceinline__ void operator()(const f32x4 (&acc)[2][2][4][2], const pg8::Unit& u, int wr, int wc, int fr, int fq, lptr) const {
#pragma unroll
        for (int ai = 0; ai < 2; ++ai) sub(acc[ai], u.pn, u.pm * 256 + ai * 128 + wr * 64, wc, fr, fq);
    }
};

__device__ __forceinline__ float dpp_ror1(float x) { return __int_as_float(__builtin_amdgcn_update_dpp(0, __float_as_int(x), 0x121, 0xf, 0xf, false)); }
__device__ __forceinline__ float dpp_ror2(float x) { return __int_as_float(__builtin_amdgcn_update_dpp(0, __float_as_int(x), 0x122, 0xf, 0xf, false)); }
struct ConvW { f32x4 w0a, w1a, w2a, ba, w0g, w1g, w2g, bg; };
__device__ __forceinline__ ConvW load_convw(const float* wconv, const float* bconv, int c) {
    ConvW w; w.w0a = *(const f32x4*)(wconv + c); w.w1a = *(const f32x4*)(wconv + FF2 + c); w.w2a = *(const f32x4*)(wconv + 2 * FF2 + c); w.ba = *(const f32x4*)(bconv + c);
    w.w0g = *(const f32x4*)(wconv + FF + c); w.w1g = *(const f32x4*)(wconv + FF2 + FF + c); w.w2g = *(const f32x4*)(wconv + 2 * FF2 + FF + c); w.bg = *(const f32x4*)(bconv + FF + c); return w;
}
template <int CTRL> __device__ __forceinline__ float dppz(float x) { return __int_as_float(__builtin_amdgcn_update_dpp(0, __float_as_int(x), CTRL, 0xf, 0xf, true)); }
__device__ __forceinline__ u32x2 conv_gate4(const f32x4& ca, const f32x4& cg, const f32x4& pa, const f32x4& pg, const ConvW& w, int) {
    float o[4];
#pragma unroll
    for (int e = 0; e < 4; ++e) {
        float ua = fmaf(w.w2a[e], ca[e], w.ba[e]);
        ua = fmaf(dppz<0x111>(ca[e]), w.w1a[e], ua); ua = fmaf(dppz<0x10F>(pa[e]), w.w1a[e], ua);
        ua = fmaf(dppz<0x112>(ca[e]), w.w0a[e], ua); ua = fmaf(dppz<0x10E>(pa[e]), w.w0a[e], ua);
        float ug = fmaf(w.w2g[e], cg[e], w.bg[e]);
        ug = fmaf(dppz<0x111>(cg[e]), w.w1g[e], ug); ug = fmaf(dppz<0x10F>(pg[e]), w.w1g[e], ug);
        ug = fmaf(dppz<0x112>(cg[e]), w.w0g[e], ug); ug = fmaf(dppz<0x10E>(pg[e]), w.w0g[e], ug);
        o[e] = ua * sigmoidf_(ua) * ug;
    }
    u32x2 r; r.x = cvtpk(o[0], o[1]); r.y = cvtpk(o[2], o[3]); return r;
}
struct EpiFFN {
    static constexpr bool PERM = true, AFTER_DRAIN = false;
    bf16_t* act; float* uedge; float* outF; const float* wconv; const float* bconv;
    __device__ __forceinline__ void operator()(const f32x4 (&acc)[2][2][4][2], const pg8::Unit& u, int wr, int wc, int fr, int fq, lptr lds) const {
        lptr halo = lds + pg8::STAGE_BYTES;
        const int q8 = 32 * wc + 8 * fq;
        if (fr >= 14) {
#pragma unroll
            for (int ai = 0; ai < 2; ++ai)
#pragma unroll
                for (int bj = 0; bj < 2; ++bj)
#pragma unroll
                    for (int n = 0; n < 2; ++n) *(LAS f32x4*)(halo + ((((2 * ai + wr) * 2 + (fr - 14)) * 256 + 128 * bj + q8 + 4 * n) * 4)) = acc[ai][bj][3][n];
        }
        asm volatile("s_waitcnt lgkmcnt(0)" ::: "memory"); __builtin_amdgcn_s_barrier(); asm volatile("" ::: "memory");
#pragma unroll
        for (int n = 0; n < 2; ++n) {
            const int c = 128 * u.pn + q8 + 4 * n;
            const ConvW w = load_convw(wconv, bconv, c);
#pragma unroll
            for (int ai = 0; ai < 2; ++ai) {
                const int G = 2 * ai + wr;
                f32x4 pa = {0.f, 0.f, 0.f, 0.f}, pg = {0.f, 0.f, 0.f, 0.f};
                if (G > 0 && fr >= 14) { pa = *(const LAS f32x4*)(halo + ((((G - 1) * 2 + (fr - 14)) * 256 + q8 + 4 * n) * 4)); pg = *(const LAS f32x4*)(halo + ((((G - 1) * 2 + (fr - 14)) * 256 + 128 + q8 + 4 * n) * 4)); }
#pragma unroll
                for (int m = 0; m < 4; ++m) {
                    const f32x4 ca = acc[ai][0][m][n], cg = acc[ai][1][m][n];
                    const f32x4 qa = m ? acc[ai][0][m ? m - 1 : 0][n] : pa, qg = m ? acc[ai][1][m ? m - 1 : 0][n] : pg;
                    const u32x2 o = conv_gate4(ca, cg, qa, qg, w, fr);
                    const size_t row = (size_t)u.pm * 256 + 64 * G + 16 * m + fr;
                    *(u32x2*)(act + row * FF + c) = o;
                    if (m == 0 && G == 0 && fr < 2) { float* e = uedge + ((size_t)u.pm * 4 + fr) * FF2 + c; *(f32x4*)e = ca; *(f32x4*)(e + FF) = cg; }
                    if (m == 3 && G == 3 && fr >= 14) { float* e = uedge + ((size_t)u.pm * 4 + 2 + (fr - 14)) * FF2 + c; *(f32x4*)e = ca; *(f32x4*)(e + FF) = cg;
                        if ((u.pm & 15) == 15) { float* f = outF + ((size_t)(u.pm >> 4) * 2 + (fr - 14)) * FF2 + c; *(f32x4*)f = ca; *(f32x4*)(f + FF) = cg; } }
                }
            }
        }
    }
};
struct EpiFFNs {
    bf16_t* act; float* outF; const float* state; const float* wconv; const float* bconv;
    __device__ __forceinline__ void sub(const f32x4 (&a)[2][4][2], int pn, int rloc0, int wc, int fr, int fq) const {
        const int q8 = 32 * wc + 8 * fq;
#pragma unroll
        for (int n = 0; n < 2; ++n) {
            const int c = 128 * pn + q8 + 4 * n;
            const ConvW w = load_convw(wconv, bconv, c);
#pragma unroll
            for (int m = 0; m < 4; ++m) {
                const int b = (rloc0 + 16 * m) >> 5;
                const f32x4 ca = a[0][m][n], cg = a[1][m][n];
                f32x4 qa = {0.f, 0.f, 0.f, 0.f}, qg = {0.f, 0.f, 0.f, 0.f};
                if (m & 1) { qa = a[0][m ? m - 1 : 0][n]; qg = a[1][m ? m - 1 : 0][n]; }
                else if (fr >= 14) { const float* s = state + ((size_t)b * 2 + (fr - 14)) * FF2 + c; qa = *(const f32x4*)s; qg = *(const f32x4*)(s + FF); }
                const u32x2 o = conv_gate4(ca, cg, qa, qg, w, fr);
                const size_t row = (size_t)MP + rloc0 + 16 * m + fr;
                *(u32x2*)(act + row * FF + c) = o;
                if ((m & 1) && fr >= 14) { float* f = outF + ((size_t)b * 2 + (fr - 14)) * FF2 + c; *(f32x4*)f = ca; *(f32x4*)(f + FF) = cg; }
            }
        }
    }
};

template <int K, bool HISCALE, class Epi>
__device__ __forceinline__ void small_tile(const bf16_t* __restrict__ A, const bf16_t* __restrict__ Bt, const Epi& E, const float* ssq, lptr lds, int t, int tid, int lane, int wave) {
    constexpr int KW = K / 8;
    const int fr = lane & 15, fq = lane >> 4;
    const int wc = t & 3, G = (t >> 2) & 3, pn = t >> 4;
    f32x4 acc[2][4][2];
#pragma unroll
    for (int bj = 0; bj < 2; ++bj)
#pragma unroll
        for (int m = 0; m < 4; ++m)
#pragma unroll
            for (int n = 0; n < 2; ++n) acc[bj][m][n] = (f32x4){0.f, 0.f, 0.f, 0.f};
    const bf16_t* ap = A + (size_t)(G * 64 + fr) * K + fq * 8 + wave * KW;
    const bf16_t* bp = Bt + (size_t)(256 * pn + 32 * wc + 8 * (fr >> 2) + (fr & 3)) * K + fq * 8 + wave * KW;
#ifdef DBLK
    for (int rep = 0; rep < 2; ++rep) {
    if (rep == 1) {
_Pragma("unroll") for (int bj = 0; bj < 2; ++bj) _Pragma("unroll") for (int m = 0; m < 4; ++m) _Pragma("unroll") for (int n = 0; n < 2; ++n) acc[bj][m][n] = acc[bj][m][n] * 0.f; asm volatile("" ::: "memory"); }
#endif
#pragma unroll 4
    for (int k0 = 0; k0 < KW; k0 += 32) {
        bf16x8 af[4], bf[2][2];
#pragma unroll
        for (int m = 0; m < 4; ++m) af[m] = *(const bf16x8*)(ap + (size_t)(16 * m) * K + k0);
#pragma unroll
        for (int bj = 0; bj < 2; ++bj)
#pragma unroll
            for (int n = 0; n < 2; ++n) bf[bj][n] = *(const bf16x8*)(bp + (size_t)(128 * bj + 4 * n) * K + k0);
#pragma unroll
        for (int bj = 0; bj < 2; ++bj)
#pragma unroll
            for (int m = 0; m < 4; ++m)
#pragma unroll
                for (int n = 0; n < 2; ++n) acc[bj][m][n] = MFMA16(bf[bj][n], af[m], acc[bj][m][n]);
    }
#ifdef DBLK
    }
#endif
    if (HISCALE) { if (wave >= 4) {
#pragma unroll
        for (int m = 0; m < 4; ++m) { const float* sp = ssq + (size_t)(MP + G * 64 + 16 * m + fr) * 8; const f32x4 s0 = *(const f32x4*)sp, s1 = *(const f32x4*)(sp + 4);
            const float rstd = rsqrtf(((s0.x + s0.y) + (s0.z + s0.w) + (s1.x + s1.y) + (s1.z + s1.w)) * (1.f / 512.f) + EPS);
#pragma unroll
            for (int bj = 0; bj < 2; ++bj)
#pragma unroll
                for (int n = 0; n < 2; ++n) acc[bj][m][n] = acc[bj][m][n] * rstd; } } }
    __syncthreads();
    if (wave != 0) {
#pragma unroll
        for (int bj = 0; bj < 2; ++bj)
#pragma unroll
            for (int m = 0; m < 4; ++m)
#pragma unroll
                for (int n = 0; n < 2; ++n) *(LAS f32x4*)(lds + ((((wave - 1) * 16 + (bj * 4 + m) * 2 + n) * 64 + lane) * 16)) = acc[bj][m][n];
    }
    __syncthreads();
    if (wave == 0) {
#pragma unroll 1
        for (int w2 = 0; w2 < 7; ++w2)
#pragma unroll
            for (int bj = 0; bj < 2; ++bj)
#pragma unroll
                for (int m = 0; m < 4; ++m)
#pragma unroll
                    for (int n = 0; n < 2; ++n) acc[bj][m][n] = acc[bj][m][n] + *(const LAS f32x4*)(lds + (((w2 * 16 + (bj * 4 + m) * 2 + n) * 64 + lane) * 16));
        E.sub(acc, pn, G * 64, wc, fr, fq);
#ifdef DBLE
        asm volatile("" ::: "memory"); E.sub(acc, pn, G * 64, wc, fr, fq);
#endif
    }
    __syncthreads();
}

typedef unsigned v4u __attribute__((ext_vector_type(4)));
#define XB_TMO      128
#define XB_XCNT(j)  (256  + 64 * (j))
#define XB_XSUB(j)  (1280 + 64 * (j))
#define XB_XGEN(j)  (2304 + 64 * (j))
#define XB_TOP      3328
#define XB_TOPGEN   3392
#define XCD_BAR_WORDS 3456
#define XB_SPIN_CAP (1u << 18)

__device__ __forceinline__ unsigned xb_ld(unsigned* p)              { return __hip_atomic_load(p, __ATOMIC_RELAXED, __HIP_MEMORY_SCOPE_AGENT); }
__device__ __forceinline__ unsigned xb_add(unsigned* p, unsigned v) { return __hip_atomic_fetch_add(p, v, __ATOMIC_RELAXED, __HIP_MEMORY_SCOPE_AGENT); }
__device__ __forceinline__ unsigned xb_xcc_id() { return (unsigned)__builtin_amdgcn_s_getreg((3 << 11) | 20) & 0xFu; }
#define XB_SPIN(cond, bar) do { unsigned _sp = 0; while (cond) { __builtin_amdgcn_s_sleep(1); \
    if ((++_sp & 255u) == 0u) { if (xb_ld(&(bar)[XB_TMO])) break; if (_sp > XB_SPIN_CAP) { atomicAdd(&(bar)[XB_TMO], 1u); break; } } } } while (0)

struct XcdBarrier {
    unsigned* bar; unsigned x;
    volatile LAS unsigned* st;
};

__device__ __forceinline__ XcdBarrier xcd_barrier_post(unsigned* bar, volatile LAS unsigned* st) {
    XcdBarrier b; b.bar = bar; b.x = xb_xcc_id(); b.st = st;
    if (threadIdx.x == 0) (void)xb_add(&bar[XB_XCNT(b.x)], 1u);
    return b;
}
__device__ __forceinline__ void xcd_barrier_complete(unsigned* bar, unsigned x, unsigned& nloc, unsigned& nx) {
    const unsigned G = gridDim.x * gridDim.y * gridDim.z;
    unsigned sum, cnt, mine, sp = 0u;
    for (;;) {
        sum = 0u; cnt = 0u; mine = 0u;
#pragma unroll
        for (unsigned j = 0; j < 16; ++j) { const unsigned c = xb_ld(&bar[XB_XCNT(j)]); sum += c; cnt += (c > 0u) ? 1u : 0u; mine = (j == x) ? c : mine; }
        if (sum == G) break;
        __builtin_amdgcn_s_sleep(1);
        if ((++sp & 255u) == 0u) { if (xb_ld(&bar[XB_TMO])) break; if (sp > XB_SPIN_CAP) { atomicAdd(&bar[XB_TMO], 1u); break; } }
    }
    nloc = mine > 0u ? mine : 1u; nx = cnt > 0u ? cnt : 1u;
}

__device__ __forceinline__ void xcd_barrier(const XcdBarrier& b) {
    asm volatile("s_waitcnt vmcnt(0)" ::: "memory");
    __syncthreads();
    if (threadIdx.x == 0) {
        unsigned* bar = b.bar;
        __builtin_amdgcn_s_waitcnt(0);
        unsigned nloc = b.st[0], nx = b.st[1];
        if (nloc == 0u) { xcd_barrier_complete(bar, b.x, nloc, nx); b.st[0] = nloc; b.st[1] = nx; }
        const unsigned old = xb_add(&bar[XB_XSUB(b.x)], 1u);
        const unsigned gen = old / nloc;
        if (old + 1u == (gen + 1u) * nloc) {
            __builtin_amdgcn_fence(__ATOMIC_RELEASE, "agent");
            asm volatile("s_waitcnt vmcnt(0)" ::: "memory");
            const unsigned og = xb_add(&bar[XB_TOP], 1u);
            const unsigned tg = og / nx;
            if (og + 1u == (tg + 1u) * nx) xb_add(&bar[XB_TOPGEN], 1u);
            else XB_SPIN(xb_ld(&bar[XB_TOPGEN]) == tg, bar);
            __builtin_amdgcn_fence(__ATOMIC_ACQUIRE, "agent");
            xb_add(&bar[XB_XGEN(b.x)], 1u);
            asm volatile("s_waitcnt vmcnt(0)" ::: "memory");
        } else {
            XB_SPIN(xb_ld(&bar[XB_XGEN(b.x)]) == gen, bar);
            __builtin_amdgcn_fence(__ATOMIC_ACQUIRE, "agent");
            asm volatile("s_waitcnt vmcnt(0)" ::: "memory");
        }
    }
    __syncthreads();
}


__device__ __forceinline__ void transpose_item(const float* __restrict__ W, int ldw, int srccol0, bf16_t* __restrict__ WT, int K, int destrow0, int k0, LAS float* scr, int lane, const float* kscale = nullptr) {
#pragma unroll 16
    for (int i = 0; i < 32; ++i) { const int kk = 2 * i + (lane >> 5); scr[kk * 33 + (lane & 31)] = W[(size_t)(k0 + kk) * ldw + srccol0 + (lane & 31)] * (kscale ? kscale[k0 + kk] : 1.f); }
    asm volatile("s_waitcnt lgkmcnt(0)" ::: "memory");
    const int c = lane & 7;
#pragma unroll
    for (int j = 0; j < 4; ++j) { const int n = (lane >> 3) + 8 * j; const LAS float* s = scr + (8 * c) * 33 + n;
        u32x4 o; o.x = cvtpk(s[0 * 33], s[1 * 33]); o.y = cvtpk(s[2 * 33], s[3 * 33]); o.z = cvtpk(s[4 * 33], s[5 * 33]); o.w = cvtpk(s[6 * 33], s[7 * 33]);
        *(u32x4*)(WT + (size_t)(destrow0 + n) * K + k0 + 8 * c) = o; }
    asm volatile("s_waitcnt lgkmcnt(0)" ::: "memory");
}

__device__ __forceinline__ void phase_weights(const Params& P, lptr lds, int lane, int wave) {
    unsigned char* ws = P.ws;
    LAS float* scr = (LAS float*)(lds + wave * 16384);
    const int gw = blockIdx.x * 8 + wave, NGW = gridDim.x * 8;
    constexpr int I1 = 16 * 112, I2 = 16 * 32, I3 = 16 * 176, I4 = 44 * 32;
    for (int it = gw; it < I1 + I2 + I3 + I4; it += NGW) {
        int r = it;
        if (r < I1) { const int kb = r / 112, n0 = (r % 112) * 32, tile = n0 >> 8, p = n0 & 255, wc = (p >> 5) & 3, bj = p >> 7, L = tile * 256 + 64 * wc + 32 * bj;
            transpose_item(P.in[I_WIN], DIN, L < 2048 ? L : L + 8, (bf16_t*)(ws + WS_W1T), 1024, n0, kb * 64, scr, lane); continue; }
        r -= I1;
        if (r < I2) { const int kb = r / 32, n0 = (r % 32) * 32; transpose_item(P.in[I_WOUT], 1024, n0, (bf16_t*)(ws + WS_W2T), 1024, n0, kb * 64, scr, lane, kb >= 8 ? P.in[I_SOW] - 512 : nullptr); continue; }
        r -= I2;
        if (r < I3) { const int kb = r / 176, n0 = (r % 176) * 32, pn = n0 >> 8, p = n0 & 255, bj = p >> 7, q0 = p & 127;
            transpose_item(P.in[I_WUP], FF2, 128 * pn + q0 + FF * bj, (bf16_t*)(ws + WS_W3T), 1024, n0, kb * 64, scr, lane); continue; }
        r -= I3;
        { const int kb = r / 32, n0 = (r % 32) * 32; transpose_item(P.in[I_WDOWN], 1024, n0, (bf16_t*)(ws + WS_W4T), FF, n0, kb * 64, scr, lane); }
    }
}

__device__ __forceinline__ void phase0(const Params& P, lptr lds, int tid, int lane, int wave) {
    unsigned char* ws = P.ws;
    LAS float* sc = (LAS float*)lds;
    for (int i = tid; i < 16384; i += 512) { const int r = i >> 10, k = i & 1023; const float c = r < 8 ? P.in[I_CP][r * 1024 + k] : P.in[I_CS][(r - 8) * 1024 + k]; sc[i] = c / (1.f + __expf(-c)); }
    __syncthreads();
    const int job = blockIdx.x * 512 + tid;
    if (job < 16 * 6144) {
        const int ks = job / 6144, n = job % 6144;
        float acc[16];
#pragma unroll
        for (int r = 0; r < 16; ++r) acc[r] = 0.f;
        const float* wp = P.in[I_WADA] + (size_t)(ks * 64) * 6144 + n;
#pragma unroll 16
        for (int k = 0; k < 64; ++k) { const float w = wp[(size_t)k * 6144];
#pragma unroll
            for (int r = 0; r < 16; ++r) acc[r] += sc[r * 1024 + ks * 64 + k] * w; }
        float* mp = (float*)(ws + WS_MODP);
#pragma unroll
        for (int r = 0; r < 16; ++r) mp[(size_t)(ks * 16 + r) * 6144 + n] = acc[r];
    }
}

__device__ __forceinline__ void load_mod_vectors(const Params& P, LAS float* A, LAS float* S, const float* normw, int r, int shofs, int tid) {
    const float* mp = (const float*)(P.ws + WS_MODP); const float* ba = P.in[I_BADA];
    for (int k = tid; k < 1024; k += 512) {
        float sh = ba[shofs + k], scv = ba[shofs + 1024 + k];
#pragma unroll
        for (int ks = 0; ks < 16; ++ks) { sh += mp[(size_t)(ks * 16 + r) * 6144 + shofs + k]; scv += mp[(size_t)(ks * 16 + r) * 6144 + shofs + 1024 + k]; }
        A[k] = normw[k] * (1.f + scv); S[k] = sh;
    }
}
__device__ __forceinline__ void load_row_bf(const bf16_t* xrow, int lane, f32x4 (&v)[4]) {
#pragma unroll
    for (int j = 0; j < 4; ++j) { const u32x2 w = ((const u32x2*)xrow)[lane + 64 * j]; v[j] = (f32x4){bflo(w.x), bfhi(w.x), bflo(w.y), bfhi(w.y)}; }
}
__device__ __forceinline__ void load_row(const float* xrow, int lane, f32x4 (&v)[4]) {
#pragma unroll
    for (int j = 0; j < 4; ++j) v[j] = ((const f32x4*)xrow)[lane + 64 * j];
}
template <bool GATES>
__device__ __forceinline__ void norm_row(const Params& P, const f32x4 (&v)[4], bf16_t* orow, float* grow, const LAS float* A, const LAS float* S, const LAS float* Wg, int lane) {
    float s = 0.f;
#pragma unroll
    for (int j = 0; j < 4; ++j) s += (v[j].x * v[j].x + v[j].y * v[j].y) + (v[j].z * v[j].z + v[j].w * v[j].w);
    const float rstd = rsqrtf(wave_sum(s) * (1.f / 1024.f) + EPS);
    float g[8];
#pragma unroll
    for (int i = 0; i < 8; ++i) g[i] = 0.f;
#pragma unroll
    for (int j = 0; j < 4; ++j) { const int k0 = 4 * lane + 256 * j;
        const f32x4 a = *(const LAS f32x4*)(A + k0), sh = *(const LAS f32x4*)(S + k0);
        const f32x4 hv = v[j] * rstd * a + sh;
        u32x2 o; o.x = cvtpk(hv.x, hv.y); o.y = cvtpk(hv.z, hv.w);
        *(u32x2*)(orow + k0) = o;
        if (GATES) {
#pragma unroll
            for (int i = 0; i < 8; ++i) { const f32x4 w = *(const LAS f32x4*)(Wg + i * 1024 + k0); g[i] += (hv.x * w.x + hv.y * w.y) + (hv.z * w.z + hv.w * w.w); } }
    }
    if (GATES) {
        { const bool hi = (lane & 32) != 0;
#pragma unroll
          for (int i = 0; i < 4; ++i) { const float send = hi ? g[i] : g[i + 4], keep = hi ? g[i + 4] : g[i]; g[i] = keep + __shfl_xor(send, 32); } }
        { const bool hi = (lane & 16) != 0;
#pragma unroll
          for (int i = 0; i < 2; ++i) { const float send = hi ? g[i] : g[i + 2], keep = hi ? g[i + 2] : g[i]; g[i] = keep + __shfl_xor(send, 16); } }
        { const bool hi = (lane & 8) != 0; const float send = hi ? g[0] : g[1], keep = hi ? g[1] : g[0]; g[0] = keep + __shfl_xor(send, 8); }
        g[0] += __shfl_xor(g[0], 4); g[0] += __shfl_xor(g[0], 2); g[0] += __shfl_xor(g[0], 1);
        const int gt = lane >> 3;
        if ((lane & 7) == 0) {
            float o;
            if (gt < 4) o = g[0] + P.in[I_BIG][gt];
            else { const float x = g[0] + P.in[I_BFG][gt - 4]; o = fminf(x, 0.f) - log1pf(expf(-fabsf(x))); }
            grow[gt] = o;
        }
    }
}
__device__ __forceinline__ void phase1(const Params& P, lptr lds, int tid, int lane, int wave) {
    LAS float* A1 = (LAS float*)lds; LAS float* S1 = A1 + 1024; LAS float* Wg = S1 + 1024;
    for (int k = tid; k < 1024; k += 512) { const f32x4 w0 = *(const f32x4*)(P.in[I_WIN] + (size_t)k * DIN + 2048), w1 = *(const f32x4*)(P.in[I_WIN] + (size_t)k * DIN + 2052);
        Wg[k] = w0.x; Wg[1024 + k] = w0.y; Wg[2048 + k] = w0.z; Wg[3072 + k] = w0.w; Wg[4096 + k] = w1.x; Wg[5120 + k] = w1.y; Wg[6144 + k] = w1.z; Wg[7168 + k] = w1.w; }
    if (tid < 384) { const int e = blockIdx.x * 384 + tid, r = e / 6144, n = e % 6144; const float* mp = (const float*)(P.ws + WS_MODP); float s = P.in[I_BADA][n];
#pragma unroll
        for (int ks = 0; ks < 16; ++ks) s += mp[(size_t)(ks * 16 + r) * 6144 + n];
        ((float*)(P.ws + WS_MOD))[e] = s; }
    load_mod_vectors(P, A1, S1, P.in[I_N1W], blockIdx.x >> 5, 0, tid);
    LAS float* A1s = Wg + 8192; LAS float* S1s = A1s + 1024;
    load_mod_vectors(P, A1s, S1s, P.in[I_N1W], 8 + (blockIdx.x >> 5), 0, tid);
    __syncthreads();
    bf16_t* H = (bf16_t*)(P.ws + WS_H); float* GT = (float*)(P.ws + WS_GATES);
    { const size_t row0 = (size_t)blockIdx.x * 128 + wave * 16; f32x4 v[4], vn[4]; load_row(P.in[I_XP] + row0 * 1024, lane, v);
#pragma unroll 1
      for (int j = 0; j < 16; ++j) { const size_t row = row0 + j;
          if (j + 1 < 16) load_row(P.in[I_XP] + (row + 1) * 1024, lane, vn);
          else if (wave == 0) load_row(P.in[I_XS] + (size_t)blockIdx.x * 1024, lane, vn);
          norm_row<true>(P, v, H + row * 1024, GT + row * 8, A1, S1, Wg, lane);
#pragma unroll
          for (int q = 0; q < 4; ++q) v[q] = vn[q]; }
      if (wave == 0) norm_row<true>(P, v, H + ((size_t)MP + blockIdx.x) * 1024, GT + ((size_t)MP + blockIdx.x) * 8, A1s, S1s, Wg, lane); }
}
__device__ __forceinline__ void phase5(const Params& P, lptr lds, int tid, int lane, int wave) {
    LAS float* A1 = (LAS float*)lds; LAS float* S1 = A1 + 1024;
    load_mod_vectors(P, A1, S1, P.in[I_N2W], blockIdx.x >> 5, 3072, tid);
    __syncthreads();
    bf16_t* H = (bf16_t*)(P.ws + WS_H);
    { const size_t row0 = (size_t)blockIdx.x * 128 + wave * 16; const bf16_t* X1 = (const bf16_t*)(P.ws + WS_X1B); f32x4 v[4], vn[4]; load_row_bf(X1 + row0 * 1024, lane, v);
#pragma unroll 1
      for (int j = 0; j < 16; ++j) { const size_t row = row0 + j;
          if (j + 1 < 16) load_row_bf(X1 + (row + 1) * 1024, lane, vn);
          norm_row<false>(P, v, H + row * 1024, nullptr, A1, S1, nullptr, lane);
#pragma unroll
          for (int q = 0; q < 4; ++q) v[q] = vn[q]; } }
    __syncthreads();
}
__device__ __forceinline__ void sample_h2_row(const Params& P, lptr lds, int tid, int lane, int wave) {
    LAS float* A1 = (LAS float*)lds; LAS float* S1 = A1 + 1024;
    load_mod_vectors(P, A1, S1, P.in[I_N2W], 8 + (blockIdx.x >> 5), 3072, tid);
    __syncthreads();
    if (wave == 0) { f32x4 v[4]; load_row_bf((const bf16_t*)(P.ws + WS_X1B) + ((size_t)MP + blockIdx.x) * 1024, lane, v); norm_row<false>(P, v, (bf16_t*)(P.ws + WS_H) + ((size_t)MP + blockIdx.x) * 1024, nullptr, A1, S1, nullptr, lane); }
    __syncthreads();
}
__device__ __forceinline__ void phase3b(const Params& P, int lane, int gw, int NGW) {
    bf16_t* Y = (bf16_t*)(P.ws + WS_YCAT); const float* SSQ = (const float*)(P.ws + WS_SSQ);
    for (int row = gw; row < MP; row += NGW) {
        const f32x4 s0 = *(const f32x4*)(SSQ + (size_t)row * 8), s1 = *(const f32x4*)(SSQ + (size_t)row * 8 + 4);
        const float rstd = rsqrtf(((s0.x + s0.y) + (s0.z + s0.w) + (s1.x + s1.y) + (s1.z + s1.w)) * (1.f / 512.f) + EPS);
        u32x4* p = (u32x4*)(Y + (size_t)row * 1024 + 512 + 8 * lane); const u32x4 o = *p;
        f32x4 a = {bflo(o.x), bfhi(o.x), bflo(o.y), bfhi(o.y)}, b = {bflo(o.z), bfhi(o.z), bflo(o.w), bfhi(o.w)};
        a = a * rstd; b = b * rstd;
        *p = pack8(a, b);
    }
}
__device__ __forceinline__ void phase_fix(const Params& P, int tid) {
    const float* UE = (const float*)(P.ws + WS_UEDGE); bf16_t* act = (bf16_t*)(P.ws + WS_ACT);
    const float* wc = P.in[I_WCONV]; const float* bc = P.in[I_BCONV];
    const int total = 128 * 2 * FF;
    for (int i = blockIdx.x * 512 + tid; i < total; i += gridDim.x * 512) {
        const int j = i % FF, rr = (i / FF) & 1, pm = i / (2 * FF);
        if ((pm & 15) == 0) continue;
        float uc[2];
#pragma unroll
        for (int hf = 0; hf < 2; ++hf) { const int c = j + hf * FF;
            const float um2 = rr == 0 ? UE[((size_t)(pm - 1) * 4 + 2) * FF2 + c] : UE[((size_t)(pm - 1) * 4 + 3) * FF2 + c];
            const float um1 = rr == 0 ? UE[((size_t)(pm - 1) * 4 + 3) * FF2 + c] : UE[((size_t)pm * 4 + 0) * FF2 + c];
            const float u0 = UE[((size_t)pm * 4 + rr) * FF2 + c];
            uc[hf] = bc[c] + wc[2 * FF2 + c] * u0 + wc[FF2 + c] * um1 + wc[c] * um2; }
        act[((size_t)pm * 256 + rr) * FF + j] = f2bf(uc[0] * sigmoidf_(uc[0]) * uc[1]);
    }
}

constexpr int ML_P = 272;
constexpr int ML_QS = 0, ML_KS = 17408, ML_VS = 34816, ML_VW = 52224, ML_CS = 69632, ML_SS = 104448, ML_SC = 113664;
__device__ __forceinline__ void mlstm_item(const Params& P, lptr lds, int bh, bool sample, int tid, int lane, int wave) {
    const int b = bh >> 2, h = bh & 3, hh = lane >> 5, n31 = lane & 31;
    const size_t rowbase = sample ? (size_t)MP + b * 32 : (size_t)b * SEQ;
    const int nch = sample ? 1 : 64, L = sample ? 32 : 64;
    const bf16_t* MQ = (const bf16_t*)(P.ws + WS_PROJ); const bf16_t* MK = (const bf16_t*)(P.ws + WS_PROJ + PROJ_STRIDE); const bf16_t* MV = (const bf16_t*)(P.ws + WS_PROJ + 2 * PROJ_STRIDE);
    const bf16_t* MO = (const bf16_t*)(P.ws + WS_PROJ + 3 * PROJ_STRIDE); const float* GT = (const float*)(P.ws + WS_GATES); bf16_t* YC = (bf16_t*)(P.ws + WS_YCAT);
    LAS float* sc = (LAS float*)(lds + ML_SC);
    LAS float* bt = sc, *as_ = sc + 64, *mt = sc + 128, *winter = sc + 192, *emt = sc + 256, *wk = sc + 320, *rsum = sc + 384, *qn = sc + 512, *nvec = sc + 576, *misc = sc + 704;
    const int ti = wave >> 2, ej = wave & 3;
    f32x16 Cacc[2];
    {
        LAS float* cst = (LAS float*)lds;
        if (sample) { const float* src = P.in[I_STC] + ((size_t)b * 4 + h) * 16384;
            for (int i = tid; i < 4096; i += 512) { const f32x4 v = *(const f32x4*)(src + 4 * i); *(LAS f32x4*)(cst + (i >> 5) * 132 + (i & 31) * 4) = v; } }
        else { for (int i = tid; i < 4096; i += 512) *(LAS f32x4*)(cst + (i >> 5) * 132 + (i & 31) * 4) = (f32x4){0.f, 0.f, 0.f, 0.f}; }
        __syncthreads();
        const LAS float* cb = cst + (64 * (wave >> 2) + 4 * hh) * 132 + 32 * ej + n31;
#pragma unroll
        for (int i = 0; i < 2; ++i)
#pragma unroll
            for (int r = 0; r < 16; ++r) Cacc[i][r] = cb[(32 * i + (r & 3) + 8 * (r >> 2)) * 132];
        __syncthreads();
        lptr cs = lds + ML_CS + (64 * (wave >> 2) + 4 * hh) * ML_P + (32 * ej + n31) * 2;
#pragma unroll
        for (int i = 0; i < 2; ++i)
#pragma unroll
            for (int r = 0; r < 16; ++r) *(LAS unsigned short*)(cs + (32 * i + (r & 3) + 8 * (r >> 2)) * ML_P) = f2bf(Cacc[i][r]);
    }
    if (tid < 128) nvec[tid] = sample ? P.in[I_STN][((size_t)b * 4 + h) * 128 + tid] : 0.f;
    if (tid == 0) misc[0] = sample ? P.in[I_STM][b * 4 + h] : 0.f;
    u32x4 rq[2], rk[2], rv[2]; float g_ig = -INFINITY, g_lf = 0.f;
    const int prow[2] = {tid >> 4, (tid + 512) >> 4}, pch = tid & 15;
#define ML_LOAD(c) do { _Pragma("unroll") for (int i = 0; i < 2; ++i) { if (prow[i] < L) { const size_t go = (rowbase + (size_t)(c) * 64 + prow[i]) * 512 + h * 128 + pch * 8; \
            rq[i] = *(const u32x4*)(MQ + go); rk[i] = *(const u32x4*)(MK + go); rv[i] = *(const u32x4*)(MV + go); } else { rq[i] = (u32x4){0u, 0u, 0u, 0u}; rk[i] = rq[i]; rv[i] = rq[i]; } } \
        if (wave == 0) { if (lane < L) { const float* g = GT + (rowbase + (size_t)(c) * 64 + lane) * 8; g_ig = g[h]; g_lf = g[4 + h]; } else { g_ig = -INFINITY; g_lf = 0.f; } } } while (0)
    ML_LOAD(0);
    for (int c = 0; c < nch; ++c) {
        __syncthreads();
        if (wave == 0) {
            float bcum = g_lf;
#pragma unroll
            for (int o = 1; o < 64; o <<= 1) { const float v = __shfl_up(bcum, o); if (lane >= o) bcum += v; }
            const float a = g_ig - bcum; float amax = a;
#pragma unroll
            for (int o = 1; o < 64; o <<= 1) { const float v = __shfl_up(amax, o); if (lane >= o) amax = fmaxf(amax, v); }
            const float mprev = misc[0];
            const float m_t = fmaxf(bcum + mprev, bcum + amax);
            const float bL = __shfl(bcum, 63), aM = __shfl(amax, 63);
            const float m_new = fmaxf(bL + mprev, bL + aM);
            bt[lane] = bcum; as_[lane] = a; mt[lane] = m_t; winter[lane] = expf(bcum + mprev - m_t); emt[lane] = expf(-m_t); wk[lane] = expf(bL + a - m_new);
            if (lane == 0) { misc[1] = expf(bL + mprev - m_new); misc[2] = m_new; }
        }
#pragma unroll
        for (int i = 0; i < 2; ++i) { const int o = prow[i] * ML_P + pch * 16;
            *(LAS u32x4*)(lds + ML_QS + o) = rq[i]; *(LAS u32x4*)(lds + ML_KS + o) = rk[i]; *(LAS u32x4*)(lds + ML_VS + o) = rv[i]; }
        __syncthreads();
#pragma unroll
        for (int i = 0; i < 2; ++i) { const float w = wk[prow[i]]; const u32x4 v = rv[i]; u32x4 o;
            o.x = cvtpk(bflo(v.x) * w, bfhi(v.x) * w); o.y = cvtpk(bflo(v.y) * w, bfhi(v.y) * w); o.z = cvtpk(bflo(v.z) * w, bfhi(v.z) * w); o.w = cvtpk(bflo(v.w) * w, bfhi(v.w) * w);
            *(LAS u32x4*)(lds + ML_VW + prow[i] * ML_P + pch * 16) = o; }
        if (c + 1 < nch) ML_LOAD(c + 1);
        f32x16 num;
#pragma unroll
        for (int r = 0; r < 16; ++r) num[r] = 0.f;
#pragma unroll
        for (int ks = 0; ks < 8; ++ks) num = MFMA32(row_frag(lds + ML_QS, ML_P, 32 * ti, 16 * ks, lane), tr_frag(lds + ML_CS, ML_P, 16 * ks, 32 * ej, lane), num);
        if (wave < 3) {
            const int sti = wave == 0 ? 0 : 1, sj = wave == 2 ? 1 : 0;
            const int krow = (n31 & ~12) | ((n31 & 4) << 1) | ((n31 & 8) >> 1);
            f32x16 p;
#pragma unroll
            for (int r = 0; r < 16; ++r) p[r] = 0.f;
#pragma unroll
            for (int ks = 0; ks < 8; ++ks) p = MFMA32(*(const LAS bf16x8*)(lds + ML_KS + (32 * sj + krow) * ML_P + (16 * ks + 8 * hh) * 2), row_frag(lds + ML_QS, ML_P, 32 * sti, 16 * ks, lane), p);
            const int t = 32 * sti + n31; const float bt_t = bt[t], mt_t = mt[t]; float rs = 0.f;
            const LAS float* asb = as_ + 32 * sj + 8 * hh; const int tb = t - (32 * sj + 8 * hh);
#pragma unroll
            for (int r = 0; r < 16; ++r) { const int so = 16 * (r >> 3) + (r & 7);
                const float w = so <= tb ? __expf(bt_t + asb[so] - mt_t) : 0.f; p[r] *= w; rs += p[r]; }
#pragma unroll
            for (int a2 = 0; a2 < 2; ++a2) { u32x4 o; o.x = cvtpk(p[8 * a2 + 0], p[8 * a2 + 1]); o.y = cvtpk(p[8 * a2 + 2], p[8 * a2 + 3]); o.z = cvtpk(p[8 * a2 + 4], p[8 * a2 + 5]); o.w = cvtpk(p[8 * a2 + 6], p[8 * a2 + 7]);
                *(LAS u32x4*)(lds + ML_SS + t * 144 + (32 * sj + 16 * a2 + 8 * hh) * 2) = o; }
            rs += __shfl_xor(rs, 32);
            if (hh == 0) rsum[sj * 64 + t] = rs;
        }
        if (wave >= 4) {
            const int t = (tid - 256) >> 2, part = tid & 3; float s = 0.f;
#pragma unroll 8
            for (int d = 0; d < 32; ++d) s += bf2f(*(const LAS unsigned short*)(lds + ML_QS + t * ML_P + (32 * part + d) * 2)) * nvec[32 * part + d];
            s += __shfl_xor(s, 1); s += __shfl_xor(s, 2);
            if (part == 0) qn[t] = s;
        }
        __syncthreads();
        const LAS float* tb2 = sc + 32 * ti + 4 * hh;
#pragma unroll
        for (int r = 0; r < 16; ++r) num[r] *= tb2[192 + (r & 3) + 8 * (r >> 2)];
#pragma unroll
        for (int ks = 0; ks < 4; ++ks) if (ks < 2 || ti == 1) num = MFMA32(*(const LAS bf16x8*)(lds + ML_SS + (32 * ti + n31) * 144 + (16 * ks + 8 * hh) * 2), tr_frag(lds + ML_VS, ML_P, 16 * ks, 32 * ej, lane), num);
#pragma unroll
        for (int r = 0; r < 16; ++r) { const int o = (r & 3) + 8 * (r >> 2);
            const float den = tb2[192 + o] * tb2[512 + o] + tb2[384 + o] + (ti ? tb2[448 + o] : 0.f);
            const float hv = num[r] / fmaxf(fabsf(den), tb2[256 + o]);
            *(LAS unsigned short*)(lds + ML_QS + (32 * ti + 4 * hh) * ML_P + (32 * ej + n31) * 2 + o * ML_P) = f2bf(hv); }
        const float decay = misc[1];
#pragma unroll
        for (int i = 0; i < 2; ++i) { const int di = 2 * (wave >> 2) + i;
#pragma unroll
            for (int r = 0; r < 16; ++r) Cacc[i][r] *= decay;
#pragma unroll
            for (int ks = 0; ks < 4; ++ks) Cacc[i] = MFMA32(tr_frag(lds + ML_KS, ML_P, 16 * ks, 32 * di, lane), tr_frag(lds + ML_VW, ML_P, 16 * ks, 32 * ej, lane), Cacc[i]);
#pragma unroll
            for (int r = 0; r < 16; ++r) *(LAS unsigned short*)(lds + ML_CS + (64 * (wave >> 2) + 4 * hh) * ML_P + (32 * ej + n31) * 2 + (32 * i + (r & 3) + 8 * (r >> 2)) * ML_P) = f2bf(Cacc[i][r]); }
        if (tid < 128) { float s = decay * nvec[tid];
#pragma unroll 8
            for (int t = 0; t < 64; ++t) s += wk[t] * bf2f(*(const LAS unsigned short*)(lds + ML_KS + t * ML_P + tid * 2));
            nvec[tid] = s; }
        if (tid == 0) misc[0] = misc[2];
        __syncthreads();
        { const int t = tid >> 3, part = tid & 7;
          const u32x4 h0 = *(const LAS u32x4*)(lds + ML_QS + t * ML_P + part * 32), h1 = *(const LAS u32x4*)(lds + ML_QS + t * ML_P + part * 32 + 16);
          float hv[16] = {bflo(h0.x), bfhi(h0.x), bflo(h0.y), bfhi(h0.y), bflo(h0.z), bfhi(h0.z), bflo(h0.w), bfhi(h0.w), bflo(h1.x), bfhi(h1.x), bflo(h1.y), bfhi(h1.y), bflo(h1.z), bfhi(h1.z), bflo(h1.w), bfhi(h1.w)};
          float ss = 0.f;
#pragma unroll
          for (int e = 0; e < 16; ++e) ss += hv[e] * hv[e];
          ss += __shfl_xor(ss, 1); ss += __shfl_xor(ss, 2); ss += __shfl_xor(ss, 4);
          const float rstd = rsqrtf(ss * (1.f / 128.f) + EPS);
          if (t < L) {
              const size_t row = rowbase + (size_t)c * 64 + t; const int col = h * 128 + part * 16;
              const u32x4 g0 = *(const u32x4*)(MO + row * 512 + col), g1 = *(const u32x4*)(MO + row * 512 + col + 8);
              const float gv[16] = {bflo(g0.x), bfhi(g0.x), bflo(g0.y), bfhi(g0.y), bflo(g0.z), bfhi(g0.z), bflo(g0.w), bfhi(g0.w), bflo(g1.x), bfhi(g1.x), bflo(g1.y), bfhi(g1.y), bflo(g1.z), bfhi(g1.z), bflo(g1.w), bfhi(g1.w)};
              const float* mw = P.in[I_MLW] + col;
              float y[16];
#pragma unroll
              for (int e = 0; e < 16; ++e) y[e] = hv[e] * rstd * mw[e] * gv[e];
              u32x4 o0, o1; o0.x = cvtpk(y[0], y[1]); o0.y = cvtpk(y[2], y[3]); o0.z = cvtpk(y[4], y[5]); o0.w = cvtpk(y[6], y[7]); o1.x = cvtpk(y[8], y[9]); o1.y = cvtpk(y[10], y[11]); o1.z = cvtpk(y[12], y[13]); o1.w = cvtpk(y[14], y[15]);
              *(u32x4*)(YC + row * 1024 + col) = o0; *(u32x4*)(YC + row * 1024 + col + 8) = o1;
          } }
    }
#undef ML_LOAD
    __syncthreads();
    {
        LAS float* cst = (LAS float*)lds;
        int l3 = lane; asm volatile("" : "+v"(l3));
        LAS float* cb = cst + (64 * (wave >> 2) + 4 * (l3 >> 5)) * 132 + 32 * ej + (l3 & 31);
#pragma unroll
        for (int i = 0; i < 2; ++i)
#pragma unroll
            for (int r = 0; r < 16; ++r) cb[(32 * i + (r & 3) + 8 * (r >> 2)) * 132] = Cacc[i][r];
        __syncthreads();
        float* oc = P.out + (sample ? O_SC : O_PC) + ((size_t)b * 4 + h) * 16384;
        for (int i = tid; i < 4096; i += 512) *(f32x4*)(oc + 4 * i) = *(const LAS f32x4*)(cst + (i >> 5) * 132 + (i & 31) * 4);
    }
    if (tid < 128) P.out[(sample ? O_SN : O_PN) + ((size_t)b * 4 + h) * 128 + tid] = nvec[tid];
    if (tid == 0) P.out[(sample ? O_SM : O_PM) + b * 4 + h] = misc[0];
}


constexpr size_t WS_KVL = WS_H, WS_KNL = 420 * MiB, WS_CHS = 421 * MiB, WS_NST = 422 * MiB, WS_MST = 423 * MiB, WS_CST = 424 * MiB, WS_END2 = 489 * MiB;
template <int NC>
__device__ __forceinline__ void ml1_pair(const Params& P, lptr lds, int pair, int tid, int lane, int wave) {
    const int item0 = NC * pair; const int bh = item0 >> 6, c = item0 & 63, b = bh >> 2, h = bh & 3, hh = lane >> 5, n31 = lane & 31, ej = wave & 3;
    const size_t row0 = (size_t)b * SEQ + 64 * c;
    const bf16_t* MK = (const bf16_t*)(P.ws + WS_PROJ + PROJ_STRIDE); const bf16_t* MV = (const bf16_t*)(P.ws + WS_PROJ + 2 * PROJ_STRIDE); const float* GT = (const float*)(P.ws + WS_GATES);
    LAS float* wk = (LAS float*)(lds + ML_SC) + 320;
    const int prow[2] = {tid >> 4, (tid + 512) >> 4}, pch = tid & 15;
    u32x4 rk2[NC][2], rv2[NC][2]; float g_ig2[NC], g_lf2[NC];
#pragma unroll
    for (int s2 = 0; s2 < NC; ++s2) { g_ig2[s2] = 0.f; g_lf2[s2] = 0.f;
#pragma unroll
        for (int i = 0; i < 2; ++i) { const size_t go = (row0 + 64 * s2 + prow[i]) * 512 + h * 128 + pch * 8; rk2[s2][i] = *(const u32x4*)(MK + go); rv2[s2][i] = *(const u32x4*)(MV + go); }
        if (wave == 0) { const float* g = GT + (row0 + 64 * s2 + lane) * 8; g_ig2[s2] = g[h]; g_lf2[s2] = g[4 + h]; } }
#pragma unroll
    for (int s2 = 0; s2 < NC; ++s2) {
    const int item = item0 + s2; const float g_ig = g_ig2[s2], g_lf = g_lf2[s2];
    u32x4 rk[2] = {rk2[s2][0], rk2[s2][1]}, rv[2] = {rv2[s2][0], rv2[s2][1]};
    __syncthreads();
    if (wave == 0) {
        float bcum = g_lf;
#pragma unroll
        for (int o = 1; o < 64; o <<= 1) { const float v = __shfl_up(bcum, o); if (lane >= o) bcum += v; }
        const float a = g_ig - bcum; float amax = a;
#pragma unroll
        for (int o = 1; o < 64; o <<= 1) amax = fmaxf(amax, __shfl_xor(amax, o));
        const float bL = __shfl(bcum, 63);
        wk[lane] = expf(a - amax);
        if (lane == 0) { float* ch = (float*)(P.ws + WS_CHS) + (size_t)item * 4; ch[0] = bL; ch[1] = bL + amax; }
    }
#pragma unroll
    for (int i = 0; i < 2; ++i) *(LAS u32x4*)(lds + ML_KS + prow[i] * ML_P + pch * 16) = rk[i];
    __syncthreads();
#pragma unroll
    for (int i = 0; i < 2; ++i) { const float w = wk[prow[i]]; const u32x4 v = rv[i]; u32x4 o;
        o.x = cvtpk(bflo(v.x) * w, bfhi(v.x) * w); o.y = cvtpk(bflo(v.y) * w, bfhi(v.y) * w); o.z = cvtpk(bflo(v.z) * w, bfhi(v.z) * w); o.w = cvtpk(bflo(v.w) * w, bfhi(v.w) * w);
        *(LAS u32x4*)(lds + ML_VW + prow[i] * ML_P + pch * 16) = o; }
    if (tid < 128) { float s = 0.f;
#pragma unroll 8
        for (int t = 0; t < 64; ++t) s += wk[t] * bf2f(*(const LAS unsigned short*)(lds + ML_KS + t * ML_P + tid * 2));
        ((float*)(P.ws + WS_KNL))[(size_t)item * 128 + tid] = s; }
    __syncthreads();
#pragma unroll
    for (int i = 0; i < 2; ++i) { const int di = 2 * (wave >> 2) + i;
        f32x16 acc;
#pragma unroll
        for (int r = 0; r < 16; ++r) acc[r] = 0.f;
#pragma unroll
        for (int ks = 0; ks < 4; ++ks) acc = MFMA32(tr_frag(lds + ML_KS, ML_P, 16 * ks, 32 * di, lane), tr_frag(lds + ML_VW, ML_P, 16 * ks, 32 * ej, lane), acc);
#pragma unroll
        for (int r = 0; r < 16; ++r) *(LAS unsigned short*)(lds + ML_CS + (64 * (wave >> 2) + 4 * hh) * ML_P + (32 * ej + n31) * 2 + (32 * i + (r & 3) + 8 * (r >> 2)) * ML_P) = f2bf(acc[r]); }
    __syncthreads();
    bf16_t* kvl = (bf16_t*)(P.ws + WS_KVL) + (size_t)item * 16384;
#pragma unroll
    for (int i = 0; i < 4; ++i) { const int p = tid + 512 * i, row = p >> 4, ch = p & 15; *(u32x4*)(kvl + row * 128 + ch * 8) = *(const LAS u32x4*)(lds + ML_CS + row * ML_P + ch * 16); }
    }
}
__device__ __forceinline__ void ml2_scan(const Params& P, lptr lds, int tid, int job) {
    const int bh = job >> 3, part = job & 7;
    LAS float* dec = (LAS float*)lds; LAS float* scl = dec + 64; LAS float* mst = scl + 64;
    if (tid == 0) { const float* ch = (const float*)(P.ws + WS_CHS) + (size_t)bh * 64 * 4; float m = 0.f;
        for (int c = 0; c < 64; ++c) { const float bL = ch[4 * c], ml = ch[4 * c + 1], mn = fmaxf(bL + m, ml); dec[c] = expf(bL + m - mn); scl[c] = expf(ml - mn); mst[c] = m; m = mn; }
        mst[64] = m; }
    __syncthreads();
    const size_t e0 = (size_t)part * 2048 + tid * 4;
    const bf16_t* kv = (const bf16_t*)(P.ws + WS_KVL) + (size_t)bh * 64 * 16384 + e0; bf16_t* cs = (bf16_t*)(P.ws + WS_CST) + (size_t)bh * 64 * 16384 + e0;
    f32x4 C = {0.f, 0.f, 0.f, 0.f};
#pragma unroll 16
    for (int c = 0; c < 64; ++c) { const u32x2 v = *(const u32x2*)(kv + (size_t)c * 16384);
        *(u32x2*)(cs + (size_t)c * 16384) = (u32x2){cvtpk(C.x, C.y), cvtpk(C.z, C.w)};
        const f32x4 kvf = {bflo(v.x), bfhi(v.x), bflo(v.y), bfhi(v.y)};
        C = C * dec[c] + kvf * scl[c]; }
    *(f32x4*)(P.out + O_PC + (size_t)bh * 16384 + e0) = C;
    if (part == 0 && tid < 128) { float n = 0.f; const float* kn = (const float*)(P.ws + WS_KNL) + (size_t)bh * 64 * 128 + tid; float* ns = (float*)(P.ws + WS_NST) + (size_t)bh * 64 * 128 + tid;
#pragma unroll 16
        for (int c = 0; c < 64; ++c) { ns[c * 128] = n; n = n * dec[c] + kn[c * 128] * scl[c]; }
        P.out[O_PN + (size_t)bh * 128 + tid] = n; }
    if (part == 0 && tid >= 128 && tid < 192) ((float*)(P.ws + WS_MST))[bh * 64 + tid - 128] = mst[tid - 128];
    if (part == 0 && tid == 192) P.out[O_PM + bh] = mst[64];
}
struct Ml3In { u32x4 rq[2], rk[2], rv[2], rc[4], g0, g1; float g_ig, g_lf, mprev, nin; };
__device__ __forceinline__ void ml3_load(const Params& P, int item, int tid, int lane, int wave, Ml3In& L) {
    const int bh = item >> 6, c = item & 63, b = bh >> 2, h = bh & 3;
    const size_t row0 = (size_t)b * SEQ + 64 * c;
    const bf16_t* MQ = (const bf16_t*)(P.ws + WS_PROJ); const bf16_t* MK = (const bf16_t*)(P.ws + WS_PROJ + PROJ_STRIDE); const bf16_t* MV = (const bf16_t*)(P.ws + WS_PROJ + 2 * PROJ_STRIDE);
    const bf16_t* MO = (const bf16_t*)(P.ws + WS_PROJ + 3 * PROJ_STRIDE); const float* GT = (const float*)(P.ws + WS_GATES);
    const int prow[2] = {tid >> 4, (tid + 512) >> 4}, pch = tid & 15;
#pragma unroll
    for (int i = 0; i < 2; ++i) { const size_t go = (row0 + prow[i]) * 512 + h * 128 + pch * 8; L.rq[i] = *(const u32x4*)(MQ + go); L.rk[i] = *(const u32x4*)(MK + go); L.rv[i] = *(const u32x4*)(MV + go); }
    const bf16_t* cst = (const bf16_t*)(P.ws + WS_CST) + (size_t)item * 16384;
#pragma unroll
    for (int i = 0; i < 4; ++i) { const int p = tid + 512 * i; L.rc[i] = *(const u32x4*)(cst + (p >> 4) * 128 + (p & 15) * 8); }
    { const size_t row = row0 + (tid >> 3); const int col = h * 128 + (tid & 7) * 16; L.g0 = *(const u32x4*)(MO + row * 512 + col); L.g1 = *(const u32x4*)(MO + row * 512 + col + 8); }
    L.g_ig = 0.f; L.g_lf = 0.f; L.mprev = 0.f; L.nin = 0.f;
    if (wave == 0) { const float* g = GT + (row0 + lane) * 8; L.g_ig = g[h]; L.g_lf = g[4 + h]; L.mprev = ((const float*)(P.ws + WS_MST))[item]; }
    if (tid < 128) L.nin = ((const float*)(P.ws + WS_NST))[(size_t)item * 128 + tid];
}
__device__ __forceinline__ void ml3_item(const Params& P, lptr lds, int item, const Ml3In& L, int tid, int lane, int wave) {
    const int bh = item >> 6, c = item & 63, b = bh >> 2, h = bh & 3, hh = lane >> 5, n31 = lane & 31;
    const size_t row0 = (size_t)b * SEQ + 64 * c;
    bf16_t* YC = (bf16_t*)(P.ws + WS_YCAT);
    LAS float* sc = (LAS float*)(lds + ML_SC);
    LAS float* bt = sc, *as_ = sc + 64, *mt = sc + 128, *winter = sc + 192, *emt = sc + 256, *rsum = sc + 384, *qn = sc + 512, *nvec = sc + 576;
    const int ti = wave >> 2, ej = wave & 3;
    const int prow[2] = {tid >> 4, (tid + 512) >> 4}, pch = tid & 15;
    const float g_ig = L.g_ig, g_lf = L.g_lf, mprev = L.mprev, nin = L.nin;
    __syncthreads();
    if (wave == 0) {
        float bcum = g_lf;
#pragma unroll
        for (int o = 1; o < 64; o <<= 1) { const float v = __shfl_up(bcum, o); if (lane >= o) bcum += v; }
        const float a = g_ig - bcum; float amax = a;
#pragma unroll
        for (int o = 1; o < 64; o <<= 1) { const float v = __shfl_up(amax, o); if (lane >= o) amax = fmaxf(amax, v); }
        const float m_t = fmaxf(bcum + mprev, bcum + amax);
        bt[lane] = bcum; as_[lane] = a; mt[lane] = m_t; winter[lane] = expf(bcum + mprev - m_t); emt[lane] = expf(-m_t);
    }
    if (tid < 128) nvec[tid] = nin;
#pragma unroll
    for (int i = 0; i < 2; ++i) { const int o = prow[i] * ML_P + pch * 16;
        *(LAS u32x4*)(lds + ML_QS + o) = L.rq[i]; *(LAS u32x4*)(lds + ML_KS + o) = L.rk[i]; *(LAS u32x4*)(lds + ML_VS + o) = L.rv[i]; }
#pragma unroll
    for (int i = 0; i < 4; ++i) { const int p = tid + 512 * i; *(LAS u32x4*)(lds + ML_CS + (p >> 4) * ML_P + (p & 15) * 16) = L.rc[i]; }
    __syncthreads();
    f32x16 num;
#pragma unroll
    for (int r = 0; r < 16; ++r) num[r] = 0.f;
#pragma unroll
    for (int ks = 0; ks < 8; ++ks) num = MFMA32(row_frag(lds + ML_QS, ML_P, 32 * ti, 16 * ks, lane), tr_frag(lds + ML_CS, ML_P, 16 * ks, 32 * ej, lane), num);
    if (wave < 3) {
        const int sti = wave == 0 ? 0 : 1, sj = wave == 2 ? 1 : 0;
        const int krow = (n31 & ~12) | ((n31 & 4) << 1) | ((n31 & 8) >> 1);
        f32x16 p;
#pragma unroll
        for (int r = 0; r < 16; ++r) p[r] = 0.f;
#pragma unroll
        for (int ks = 0; ks < 8; ++ks) p = MFMA32(*(const LAS bf16x8*)(lds + ML_KS + (32 * sj + krow) * ML_P + (16 * ks + 8 * hh) * 2), row_frag(lds + ML_QS, ML_P, 32 * sti, 16 * ks, lane), p);
        const int t = 32 * sti + n31; const float bt_t = bt[t], mt_t = mt[t]; float rs = 0.f;
        const LAS float* asb = as_ + 32 * sj + 8 * hh; const int tb = t - (32 * sj + 8 * hh);
#pragma unroll
        for (int r = 0; r < 16; ++r) { const int so = 16 * (r >> 3) + (r & 7);
            const float w = so <= tb ? __expf(bt_t + asb[so] - mt_t) : 0.f; p[r] *= w; rs += p[r]; }
#pragma unroll
        for (int a2 = 0; a2 < 2; ++a2) { u32x4 o; o.x = cvtpk(p[8 * a2 + 0], p[8 * a2 + 1]); o.y = cvtpk(p[8 * a2 + 2], p[8 * a2 + 3]); o.z = cvtpk(p[8 * a2 + 4], p[8 * a2 + 5]); o.w = cvtpk(p[8 * a2 + 6], p[8 * a2 + 7]);
            *(LAS u32x4*)(lds + ML_SS + t * 144 + (32 * sj + 16 * a2 + 8 * hh) * 2) = o; }
        rs += __shfl_xor(rs, 32);
        if (hh == 0) rsum[sj * 64 + t] = rs;
    }
    if (wave >= 4) {
        const int t = (tid - 256) >> 2, part = tid & 3; float s = 0.f;
#pragma unroll 8
        for (int d = 0; d < 32; ++d) s += bf2f(*(const LAS unsigned short*)(lds + ML_QS + t * ML_P + (32 * part + d) * 2)) * nvec[32 * part + d];
        s += __shfl_xor(s, 1); s += __shfl_xor(s, 2);
        if (part == 0) qn[t] = s;
    }
    __syncthreads();
    const LAS float* tb2 = sc + 32 * ti + 4 * hh;
#pragma unroll
    for (int r = 0; r < 16; ++r) num[r] *= tb2[192 + (r & 3) + 8 * (r >> 2)];
#pragma unroll
    for (int ks = 0; ks < 4; ++ks) if (ks < 2 || ti == 1) num = MFMA32(*(const LAS bf16x8*)(lds + ML_SS + (32 * ti + n31) * 144 + (16 * ks + 8 * hh) * 2), tr_frag(lds + ML_VS, ML_P, 16 * ks, 32 * ej, lane), num);
#pragma unroll
    for (int r = 0; r < 16; ++r) { const int o = (r & 3) + 8 * (r >> 2);
        const float den = tb2[192 + o] * tb2[512 + o] + tb2[384 + o] + (ti ? tb2[448 + o] : 0.f);
        const float hv = num[r] / fmaxf(fabsf(den), tb2[256 + o]);
        *(LAS unsigned short*)(lds + ML_QS + (32 * ti + 4 * hh) * ML_P + (32 * ej + n31) * 2 + o * ML_P) = f2bf(hv); }
    __syncthreads();
    { const int t = tid >> 3, part = tid & 7;
      const size_t row = row0 + t; const int col = h * 128 + part * 16;
      const u32x4 g0 = L.g0, g1 = L.g1;
      const u32x4 h0 = *(const LAS u32x4*)(lds + ML_QS + t * ML_P + part * 32), h1 = *(const LAS u32x4*)(lds + ML_QS + t * ML_P + part * 32 + 16);
      float hv[16] = {bflo(h0.x), bfhi(h0.x), bflo(h0.y), bfhi(h0.y), bflo(h0.z), bfhi(h0.z), bflo(h0.w), bfhi(h0.w), bflo(h1.x), bfhi(h1.x), bflo(h1.y), bfhi(h1.y), bflo(h1.z), bfhi(h1.z), bflo(h1.w), bfhi(h1.w)};
      float ss = 0.f;
#pragma unroll
      for (int e = 0; e < 16; ++e) ss += hv[e] * hv[e];
      ss += __shfl_xor(ss, 1); ss += __shfl_xor(ss, 2); ss += __shfl_xor(ss, 4);
      const float rstd = rsqrtf(ss * (1.f / 128.f) + EPS);
      const float gv[16] = {bflo(g0.x), bfhi(g0.x), bflo(g0.y), bfhi(g0.y), bflo(g0.z), bfhi(g0.z), bflo(g0.w), bfhi(g0.w), bflo(g1.x), bfhi(g1.x), bflo(g1.y), bfhi(g1.y), bflo(g1.z), bfhi(g1.z), bflo(g1.w), bfhi(g1.w)};
      const float* mw = P.in[I_MLW] + col;
      float y[16];
#pragma unroll
      for (int e = 0; e < 16; ++e) y[e] = hv[e] * rstd * mw[e] * gv[e];
      u32x4 o0, o1; o0.x = cvtpk(y[0], y[1]); o0.y = cvtpk(y[2], y[3]); o0.z = cvtpk(y[4], y[5]); o0.w = cvtpk(y[6], y[7]); o1.x = cvtpk(y[8], y[9]); o1.y = cvtpk(y[10], y[11]); o1.z = cvtpk(y[12], y[13]); o1.w = cvtpk(y[14], y[15]);
      *(u32x4*)(YC + row * 1024 + col) = o0; *(u32x4*)(YC + row * 1024 + col + 8) = o1; }
}

constexpr int AT_KP = 144, AT_VP = 136, AT_WAVE = 64 * AT_KP + 64 * AT_VP;
__device__ __forceinline__ void sb_step(clptr Kt, clptr Vt, const bf16x8 (&qf)[4], f32x16& o0, f32x16& o1, float& carry, int lane, bool domask, int kq) {
    const int n31 = lane & 31, hh = lane >> 5;
    const int krow = (n31 & ~12) | ((n31 & 4) << 1) | ((n31 & 8) >> 1);
    f32x16 p[2];
#pragma unroll
    for (int r = 0; r < 16; ++r) { p[0][r] = 0.f; p[1][r] = 0.f; }
#pragma unroll
    for (int ks = 0; ks < 4; ++ks) {
        p[0] = MFMA32(*(const LAS bf16x8*)(Kt + krow * AT_KP + (16 * ks + 8 * hh) * 2), qf[ks], p[0]);
        p[1] = MFMA32(*(const LAS bf16x8*)(Kt + (32 + krow) * AT_KP + (16 * ks + 8 * hh) * 2), qf[ks], p[1]);
    }
    f32x16 om[2];
    float town[4], tpar[4];
#pragma unroll
    for (int u = 0; u < 2; ++u)
#pragma unroll
        for (int a = 0; a < 2; ++a) { float tp = 1.f;
#pragma unroll
            for (int j = 0; j < 8; ++j) { const int r = 8 * a + j;
                const float z = fminf(fmaxf(p[u][r], -60.f), 60.f);
                const float e = fast_exp2(-z); float sg = fast_rcp(1.f + e); float o = e * sg;
                if (domask) { const int kl = 32 * u + 16 * a + 8 * hh + j; if (kl >= kq) { sg = 0.f; o = 1.f; } }
                p[u][r] = sg; om[u][r] = o; tp *= o; }
            town[2 * u + a] = tp; }
#pragma unroll
    for (int i = 0; i < 4; ++i) tpar[i] = __shfl_xor(town[i], 32);
    float suf[5]; suf[4] = 1.f;
#pragma unroll
    for (int i = 3; i >= 0; --i) suf[i] = suf[i + 1] * (town[i] * tpar[i]);
    bf16x8 pf[4];
#pragma unroll
    for (int u = 0; u < 2; ++u)
#pragma unroll
        for (int a = 0; a < 2; ++a) { const int pr = 2 * u + a;
            float R = carry * suf[pr + 1] * (hh == 0 ? tpar[pr] : 1.f);
            float av[8];
#pragma unroll
            for (int j = 7; j >= 0; --j) { av[j] = p[u][8 * a + j] * R; R *= om[u][8 * a + j]; }
            u32x4 w; w.x = cvtpk(av[0], av[1]); w.y = cvtpk(av[2], av[3]); w.z = cvtpk(av[4], av[5]); w.w = cvtpk(av[6], av[7]);
            pf[pr] = __builtin_bit_cast(bf16x8, w); }
    carry *= suf[0];
#pragma unroll
    for (int pr = 0; pr < 4; ++pr) {
        o0 = MFMA32(tr_frag(Vt, AT_VP, 16 * pr, 0, lane), pf[pr], o0);
        o1 = MFMA32(tr_frag(Vt, AT_VP, 16 * pr, 32, lane), pf[pr], o1);
    }
}
__device__ __forceinline__ void attn_prompt_item(const Params& P, lptr lds, int b, int rb, int lane, int wave) {
    const int h = wave, n31 = lane & 31, hh = lane >> 5;
    const bf16_t* SQ = (const bf16_t*)(P.ws + WS_PROJ + 4 * PROJ_STRIDE); const bf16_t* SK = (const bf16_t*)(P.ws + WS_PROJ + 5 * PROJ_STRIDE); const bf16_t* SV = (const bf16_t*)(P.ws + WS_PROJ + 6 * PROJ_STRIDE);
    const size_t rowb = (size_t)b * SEQ; const int q0 = 32 * rb;
    lptr Kt = lds + wave * AT_WAVE; lptr Vt = Kt + 64 * AT_KP;
    bf16x8 qf[4];
#pragma unroll
    for (int ks = 0; ks < 4; ++ks) qf[ks] = *(const bf16x8*)(SQ + (rowb + q0 + n31) * 512 + h * 64 + 16 * ks + 8 * hh);
    f32x16 o0, o1;
#pragma unroll
    for (int r = 0; r < 16; ++r) { o0[r] = 0.f; o1[r] = 0.f; }
    float carry = 1.f;
    const int trow = lane >> 3, tch = lane & 7;
    u32x4 kv[8], vv[8];
    const int jt0 = (q0 + 30) >> 6;
#pragma unroll
    for (int i = 0; i < 8; ++i) { const size_t go = (rowb + 64 * jt0 + 8 * i + trow) * 512 + h * 64 + tch * 8; kv[i] = *(const u32x4*)(SK + go); vv[i] = *(const u32x4*)(SV + go); }
    for (int jt = jt0; jt >= 0; --jt) {
#pragma unroll
        for (int i = 0; i < 8; ++i) { const int row = 8 * i + trow;
            *(LAS u32x4*)(Kt + row * AT_KP + tch * 16) = kv[i];
            *(LAS u32x2*)(Vt + row * AT_VP + tch * 16) = (u32x2){vv[i].x, vv[i].y}; *(LAS u32x2*)(Vt + row * AT_VP + tch * 16 + 8) = (u32x2){vv[i].z, vv[i].w}; }
        if (jt > 0) {
#pragma unroll
            for (int i = 0; i < 8; ++i) { const size_t go = (rowb + 64 * (jt - 1) + 8 * i + trow) * 512 + h * 64 + tch * 8; kv[i] = *(const u32x4*)(SK + go); vv[i] = *(const u32x4*)(SV + go); } }
        sb_step(Kt, Vt, qf, o0, o1, carry, lane, 64 * jt + 63 >= q0, q0 + n31 - 64 * jt);
        if (__all(carry < 1e-30f)) break;
    }
    float ss = 0.f;
#pragma unroll
    for (int r = 0; r < 16; ++r) ss += o0[r] * o0[r] + o1[r] * o1[r];
    ss += __shfl_xor(ss, 32);
    const size_t row = rowb + q0 + n31;
    LAS float* sx = (LAS float*)(lds + 8 * AT_WAVE);
    if (hh == 0) sx[wave * 32 + n31] = ss;
    __syncthreads();
    float tot = 0.f;
#pragma unroll
    for (int w2 = 0; w2 < 8; ++w2) tot += sx[w2 * 32 + n31];
    const float rstd = rsqrtf(tot * (1.f / 512.f) + EPS);
    bf16_t* yo = (bf16_t*)(P.ws + WS_YCAT) + row * 1024 + 512 + h * 64 + 4 * hh;
#pragma unroll
    for (int g = 0; g < 4; ++g) {
        *(u32x2*)(yo + 8 * g) = (u32x2){cvtpk(o0[4 * g] * rstd, o0[4 * g + 1] * rstd), cvtpk(o0[4 * g + 2] * rstd, o0[4 * g + 3] * rstd)};
        *(u32x2*)(yo + 32 + 8 * g) = (u32x2){cvtpk(o1[4 * g] * rstd, o1[4 * g + 1] * rstd), cvtpk(o1[4 * g + 2] * rstd, o1[4 * g + 3] * rstd)};
    }
}
__device__ __forceinline__ void attn_sample_item(const Params& P, lptr lds, int bh, int tid, int lane, int wave) {
    const int b = bh >> 3, h = bh & 7, n31 = lane & 31, hh = lane >> 5;
    const bf16_t* SQ = (const bf16_t*)(P.ws + WS_PROJ + 4 * PROJ_STRIDE); const bf16_t* SK = (const bf16_t*)(P.ws + WS_PROJ + 5 * PROJ_STRIDE); const bf16_t* SV = (const bf16_t*)(P.ws + WS_PROJ + 6 * PROJ_STRIDE);
    const size_t rows = (size_t)MP + b * 32;
    lptr Kt = lds + wave * AT_WAVE; lptr Vt = Kt + 64 * AT_KP;
    bf16x8 qf[4];
#pragma unroll
    for (int ks = 0; ks < 4; ++ks) qf[ks] = *(const bf16x8*)(SQ + (rows + n31) * 512 + h * 64 + 16 * ks + 8 * hh);
    f32x16 o0, o1;
#pragma unroll
    for (int r = 0; r < 16; ++r) { o0[r] = 0.f; o1[r] = 0.f; }
    float carry = 1.f;
    if (wave == 7) {
        const int trow = lane >> 3, tch = lane & 7;
#pragma unroll
        for (int i = 0; i < 8; ++i) { const int row = 8 * i + trow; u32x4 kv = {0u, 0u, 0u, 0u}, vv = {0u, 0u, 0u, 0u};
            if (row < 32) { const size_t go = (rows + row) * 512 + h * 64 + tch * 8; kv = *(const u32x4*)(SK + go); vv = *(const u32x4*)(SV + go); }
            *(LAS u32x4*)(Kt + row * AT_KP + tch * 16) = kv;
            *(LAS u32x2*)(Vt + row * AT_VP + tch * 16) = (u32x2){vv.x, vv.y}; *(LAS u32x2*)(Vt + row * AT_VP + tch * 16 + 8) = (u32x2){vv.z, vv.w}; }
        sb_step(Kt, Vt, qf, o0, o1, carry, lane, true, n31);
    }
    const float* CK = P.in[I_CK] + (size_t)b * PAST * 512 + h * 64; const float* CV = P.in[I_CV] + (size_t)b * PAST * 512 + h * 64;
    for (int jt = 4 * wave + 3; jt >= 4 * wave; --jt) {
        const int trow = lane >> 4, c4 = lane & 15;
#pragma unroll
        for (int i = 0; i < 16; ++i) { const int row = 4 * i + trow; const size_t go = (size_t)(64 * jt + row) * 512 + c4 * 4;
            const f32x4 kx = *(const f32x4*)(CK + go), vx = *(const f32x4*)(CV + go);
            *(LAS u32x2*)(Kt + row * AT_KP + c4 * 8) = (u32x2){cvtpk(kx.x, kx.y), cvtpk(kx.z, kx.w)};
            *(LAS u32x2*)(Vt + row * AT_VP + c4 * 8) = (u32x2){cvtpk(vx.x, vx.y), cvtpk(vx.z, vx.w)}; }
        sb_step(Kt, Vt, qf, o0, o1, carry, lane, false, 0);
    }
    __syncthreads();
    LAS float* carr = (LAS float*)(lds + 65536);
    if (hh == 0) carr[wave * 32 + n31] = carry;
    __syncthreads();
    float mult = 1.f;
    for (int w2 = wave + 1; w2 < 8; ++w2) mult *= carr[w2 * 32 + n31];
#pragma unroll
    for (int g = 0; g < 4; ++g) {
        *(LAS f32x4*)(lds + (((wave * 8 + g) * 64 + lane) * 16)) = (f32x4){o0[4 * g] * mult, o0[4 * g + 1] * mult, o0[4 * g + 2] * mult, o0[4 * g + 3] * mult};
        *(LAS f32x4*)(lds + (((wave * 8 + 4 + g) * 64 + lane) * 16)) = (f32x4){o1[4 * g] * mult, o1[4 * g + 1] * mult, o1[4 * g + 2] * mult, o1[4 * g + 3] * mult};
    }
    __syncthreads();
    { const int q = tid >> 4, part = tid & 15; const int slot = (part >> 3) * 4 + ((part & 7) >> 1), ln = q + 32 * (part & 1);
      f32x4 v = {0.f, 0.f, 0.f, 0.f};
#pragma unroll
      for (int w2 = 0; w2 < 8; ++w2) v = v + *(const LAS f32x4*)(lds + (((w2 * 8 + slot) * 64 + ln) * 16));
      float ss = (v.x * v.x + v.y * v.y) + (v.z * v.z + v.w * v.w);
      ss += __shfl_xor(ss, 1); ss += __shfl_xor(ss, 2); ss += __shfl_xor(ss, 4); ss += __shfl_xor(ss, 8);
      const size_t row = rows + q;
      if (part == 0) ((float*)(P.ws + WS_SSQ))[row * 8 + h] = ss;
      *(u32x2*)((bf16_t*)(P.ws + WS_YCAT) + row * 1024 + 512 + h * 64 + part * 4) = (u32x2){cvtpk(v.x, v.y), cvtpk(v.z, v.w)}; }
    __syncthreads();
}
#ifndef M1NC
#define M1NC 2
#endif
constexpr int NQ_G1S = 224, NQ_AT = 1024, NQ_M1 = 2048 / M1NC, NQ_TOTAL = NQ_G1S + NQ_AT + NQ_M1;
template <class EpiS>
__device__ __forceinline__ void phase_mixers(const Params& P, lptr lds, int tid_in, int wave, const EpiS& Es) {
    unsigned* ctr = (unsigned*)(P.ws + WS_CTL);
    for (;;) {
        __syncthreads();
        if (tid_in == 0) *(LAS int*)(lds + QOFF) = (int)atomicAdd(ctr, 1u);
        __syncthreads();
        int item = *(const LAS int*)(lds + QOFF);
        int tid = tid_in; asm volatile("" : "+v"(tid));
        const int lane = tid & 63;
        if (item >= NQ_TOTAL) break;
        if (item < NQ_G1S) { small_tile<1024, false>((const bf16_t*)(P.ws + WS_H) + (size_t)MP * 1024, (const bf16_t*)(P.ws + WS_W1T), Es, nullptr, lds, item, tid, lane, wave); continue; }
        item -= NQ_G1S;
        if (item < NQ_AT) { attn_prompt_item(P, lds, item & 7, 127 - (item >> 3), lane, wave); continue; }
        item -= NQ_AT;
        ml1_pair<M1NC>(P, lds, item, tid, lane, wave);
    }
}
__device__ __forceinline__ void phase_ml2(const Params& P, lptr lds, int tid_in, int wave) {
    int tid = tid_in; asm volatile("" : "+v"(tid));
    if (blockIdx.x < 160) { for (int job = blockIdx.x; job < 256; job += 160) { __syncthreads(); ml2_scan(P, lds, tid, job); } }
    else if (blockIdx.x < 192) mlstm_item(P, lds, blockIdx.x - 160, true, tid, tid & 63, wave);
    else attn_sample_item(P, lds, blockIdx.x - 192, tid, tid & 63, wave);
}
template <class EpiS>
__device__ __forceinline__ void phase_ml3(const Params& P, lptr lds, int tid_in, int wave, const EpiS& Es) {
    if (blockIdx.x >= 192) { int tid = tid_in; asm volatile("" : "+v"(tid));
        small_tile<1024, true>((const bf16_t*)(P.ws + WS_YCAT) + (size_t)MP * 1024, (const bf16_t*)(P.ws + WS_W2T), Es, (const float*)(P.ws + WS_SSQ), lds, blockIdx.x - 192, tid, tid & 63, wave); }
#ifdef DBL_M3
    for (int rep = 0; rep < 2; ++rep)
#endif
    { int tid = tid_in; asm volatile("" : "+v"(tid));
      Ml3In cur, nxt; ml3_load(P, blockIdx.x, tid, tid & 63, wave, cur);
#pragma unroll 1
      for (int item = blockIdx.x; item < 2048; item += gridDim.x) {
          const int nitem = item + gridDim.x;
          if (nitem < 2048) ml3_load(P, nitem, tid, tid & 63, wave, nxt);
          ml3_item(P, lds, item, cur, tid, tid & 63, wave);
          cur = nxt;
      } }
}

__global__ void __launch_bounds__(512, 2) fwd(Params P) {
    extern __shared__ __attribute__((aligned(16))) unsigned char lds_raw[];
    lptr lds = (lptr)lds_raw;
    cg::grid_group grid = cg::this_grid();
    int tid = threadIdx.x, lane = tid & 63; const int wave = __builtin_amdgcn_readfirstlane(tid >> 6);
#define FRESH_TID() do { asm volatile("" : "+v"(tid)); lane = tid & 63; } while (0)
    const int gw = blockIdx.x * 8 + wave, NGW = gridDim.x * 8;
    unsigned char* ws = P.ws;
    const float* MOD = (const float*)(ws + WS_MOD);
    bf16_t* H = (bf16_t*)(ws + WS_H); bf16_t* PROJ = (bf16_t*)(ws + WS_PROJ); bf16_t* YC = (bf16_t*)(ws + WS_YCAT); bf16_t* ACT = (bf16_t*)(ws + WS_ACT);

#ifndef G_ALIGN
#define G_ALIGN true
#endif
#ifndef G_SP2
#define G_SP2 true
#endif
#ifndef PH
#define PH 0xFFFF
#endif
    if (tid == 0) { *(LAS unsigned*)(lds + LDS_BYTES - 32) = 0u; *(LAS unsigned*)(lds + LDS_BYTES - 28) = 0u; }
    __syncthreads();
    const XcdBarrier bar = xcd_barrier_post((unsigned*)(ws + WS_CTL) + 1024, (volatile LAS unsigned*)(lds + LDS_BYTES - 32));
    if (P.out == nullptr) grid.sync();
    phase0(P, lds, tid, lane, wave);
#ifdef DBL_P0
    __syncthreads(); phase0(P, lds, tid, lane, wave);
#endif
    xcd_barrier(bar);
    FRESH_TID();
    phase1(P, lds, tid, lane, wave);
    __syncthreads();
    phase_weights(P, lds, lane, wave);
#ifdef DBL_P1
    __syncthreads(); phase1(P, lds, tid, lane, wave);
#endif
#ifdef DBL_P1NG
    __syncthreads(); phase1_nogates(P, lds, tid, lane, wave);
#endif
#ifdef DBL_W
    __syncthreads(); phase_weights(P, lds, lane, wave);
#endif
    xcd_barrier(bar);
    FRESH_TID();
    {
        EpiProj E{PROJ, P.out + O_PK, P.out + O_PV, P.in[I_SQW], P.in[I_SKW], 0};
        pg8::Gemm g{H, (const bf16_t*)(ws + WS_W1T), MP, NPROJ, 1024}; pg8::StaticOrder S; S.init(MP, NPROJ, gridDim.x, (int)blockIdx.x);
        pg8::gemm_phase<EpiProj, pg8::StaticOrder, G_ALIGN, G_SP2>(lds, g, S, E);
#ifdef DBL_G
        pg8::gemm_phase<EpiProj, pg8::StaticOrder, G_ALIGN, G_SP2>(lds, g, S, E);
#endif
    }
    xcd_barrier(bar);
    FRESH_TID();
    {
        EpiProj Es{PROJ, P.out + O_SK, P.out + O_SV, P.in[I_SQW], P.in[I_SKW], MP};
        phase_mixers(P, lds, tid, wave, Es);
    }
    xcd_barrier(bar);
    FRESH_TID();
    phase_ml2(P, lds, tid, wave);
#ifdef DBL_M2
    __syncthreads(); phase_ml2(P, lds, tid, wave);
#endif
    xcd_barrier(bar);
    FRESH_TID();
    {
        EpiRes<0> Es{P.in[I_XS], (bf16_t*)(ws + WS_X1B) + (size_t)MP * 1024, MOD + 8 * 6144 + 2048, 5};
        phase_ml3(P, lds, tid, wave, Es);
    }
#ifdef XSYNC
    for (int i = 0; i < XSYNC; ++i) xcd_barrier(bar);
#endif
    xcd_barrier(bar);
    FRESH_TID();
    {
        sample_h2_row(P, lds, tid, lane, wave);
        EpiRes<0> E{P.in[I_XP], ws + WS_X1B, MOD + 2048, 12};
        pg8::Gemm g{YC, (const bf16_t*)(ws + WS_W2T), MP, 1024, 1024}; pg8::StaticOrder S; S.init(MP, 1024, gridDim.x, (int)blockIdx.x);
        pg8::gemm_phase<EpiRes<0>, pg8::StaticOrder, G_ALIGN, G_SP2>(lds, g, S, E);
    }
    xcd_barrier(bar);
    FRESH_TID();
    {
        phase5(P, lds, tid, lane, wave);
#ifdef DBL_P5
        phase5(P, lds, tid, lane, wave);
#endif
        EpiFFNs Es{ACT, P.out + O_SF, P.in[I_SFC], P.in[I_WCONV], P.in[I_BCONV]};
        for (int t = blockIdx.x; t < 352; t += gridDim.x) small_tile<1024, false>(H + (size_t)MP * 1024, (const bf16_t*)(ws + WS_W3T), Es, nullptr, lds, t, tid, lane, wave);
    }
    xcd_barrier(bar);
    FRESH_TID();
    {
        EpiFFN E{ACT, (float*)(ws + WS_UEDGE), P.out + O_PF, P.in[I_WCONV], P.in[I_BCONV]};
        pg8::Gemm g{H, (const bf16_t*)(ws + WS_W3T), MP, FF2, 1024}; pg8::StaticOrder S; S.init(MP, FF2, gridDim.x, (int)blockIdx.x);
        pg8::gemm_phase<EpiFFN, pg8::StaticOrder, true, G_SP2>(lds, g, S, E);
#ifdef DBL_G
        pg8::gemm_phase<EpiFFN, pg8::StaticOrder, true, G_SP2>(lds, g, S, E);
#endif
    }
    xcd_barrier(bar);
    FRESH_TID();
    {
        phase_fix(P, tid);
        EpiRes<1> Es{(const bf16_t*)(ws + WS_X1B) + (size_t)MP * 1024, P.out + O_YS, MOD + 8 * 6144 + 5120, 5};
        if (blockIdx.x < 64) small_tile<FF, false>(ACT + (size_t)MP * FF, (const bf16_t*)(ws + WS_W4T), Es, nullptr, lds, blockIdx.x, tid, lane, wave);
    }
    xcd_barrier(bar);
    FRESH_TID();
    {
        EpiRes<1> E{ws + WS_X1B, P.out + O_YP, MOD + 5120, 12};
        pg8::Gemm g{ACT, (const bf16_t*)(ws + WS_W4T), MP, 1024, FF}; pg8::StaticOrder S; S.init(MP, 1024, gridDim.x, (int)blockIdx.x);
        pg8::gemm_phase<EpiRes<1>, pg8::StaticOrder, G_ALIGN, G_SP2>(lds, g, S, E);
    }

#ifdef DIAG
    xcd_barrier(bar);
    {
        const size_t offs[15] = {O_YP, O_YS, O_PC, O_PN, O_PM, O_PK, O_PV, O_PF, O_SC, O_SN, O_SM, O_SK, O_SV, O_SF, O_END};
        for (int o = 0; o < 14; ++o) if ((DIAG >> o) & 1) for (size_t i = offs[o] + (size_t)blockIdx.x * 512 + tid; i < offs[o + 1]; i += (size_t)gridDim.x * 512) P.out[i] *= 1.2f;
    }
#endif
}

extern "C" void kernel_launch(void* const* d_in, const int* in_sizes, int n_in, void* d_out, int out_size, void* d_ws, size_t ws_size, hipStream_t stream) {
    static int grid_blocks = 0;
    if (!grid_blocks) {
        int dev = 0, cus = 0, per_cu = 0;
        (void)hipGetDevice(&dev);
        (void)hipDeviceGetAttribute(&cus, hipDeviceAttributeMultiprocessorCount, dev);
        (void)hipFuncSetAttribute((const void*)fwd, hipFuncAttributeMaxDynamicSharedMemorySize, LDS_BYTES);
        (void)hipOccupancyMaxActiveBlocksPerMultiprocessor(&per_cu, (const void*)fwd, 512, LDS_BYTES);
        grid_blocks = cus;
        if (n_in != 26 || out_size != (int)O_END || ws_size < WS_END2 || cus != 256 || per_cu < 1) {
            fprintf(stderr, "kernel_launch: unexpected geometry: n_in %d out %d ws %zu cus %d per_cu %d\n", n_in, out_size, ws_size, cus, per_cu);
            if (n_in != 26 || out_size != (int)O_END || ws_size < WS_END2 || cus != 256) grid_blocks = -1;
        }
    }
    if (grid_blocks < 0) return;
    if (hipMemsetAsync((char*)d_ws + WS_CTL, 0, (1024 + XCD_BAR_WORDS) * 4, stream) != hipSuccess) { fprintf(stderr, "kernel_launch: memset of the control words failed\n"); return; }
    Params p{};
    for (int i = 0; i < 26; ++i) p.in[i] = (const float*)d_in[i];
    p.out = (float*)d_out; p.ws = (unsigned char*)d_ws;
    void* args[] = {&p};
    hipError_t e = hipLaunchCooperativeKernel((const void*)fwd, dim3(grid_blocks), dim3(512), args, LDS_BYTES, stream);
    if (e != hipSuccess) fprintf(stderr, "cooperative launch failed: %s (grid %d)\n", hipGetErrorString(e), grid_blocks);
}
```

```cpp
#include <hip/hip_runtime.h>
#include <hip/hip_cooperative_groups.h>
#include <cstdio>
#include <cstdint>
namespace cg = cooperative_groups;

#define LAS __attribute__((address_space(3)))
typedef unsigned short bf16_t;
typedef short bf16x8 __attribute__((ext_vector_type(8)));
typedef short s16x4 __attribute__((ext_vector_type(4)));
typedef float f32x2 __attribute__((ext_vector_type(2)));
typedef float f32x4 __attribute__((ext_vector_type(4)));
typedef float f32x16 __attribute__((ext_vector_type(16)));
typedef unsigned u32x2 __attribute__((ext_vector_type(2)));
typedef unsigned u32x4 __attribute__((ext_vector_type(4)));
typedef __bf16 bf16x2_t __attribute__((ext_vector_type(2)));
typedef LAS unsigned char* lptr;
typedef const LAS unsigned char* clptr;

constexpr int DM = 1024, SEQ = 4096, NB = 8, MP = NB * SEQ, DEC = 32, MS = NB * DEC, MT = MP + MS, PAST = 2048;
constexpr int DIN = 3592, NPROJ = 3584, FF = 2816, FF2 = 5632;
constexpr float EPS = 1e-6f;
constexpr float LOG2E = 1.4426950408889634f;
constexpr size_t O_YP = 0, O_YS = 33554432, O_PC = 33816576, O_PN = 34340864, O_PM = 34344960, O_PK = 34344992, O_PV = 51122208,
                 O_PF = 67899424, O_SC = 67989536, O_SN = 68513824, O_SM = 68517920, O_SK = 68517952, O_SV = 68649024, O_SF = 68780096, O_END = 68870208;
constexpr size_t MiB = 1u << 20;
constexpr size_t WS_CTL = 0, WS_MODP = 1 * MiB  , WS_MOD = 65536  , WS_GATES = 8 * MiB, WS_SSQ = 10 * MiB, WS_UEDGE = 12 * MiB,
                 WS_W1T = 24 * MiB, WS_W2T = 31 * MiB, WS_W3T = 33 * MiB, WS_W4T = 44 * MiB, WS_H = 52 * MiB, WS_PROJ = 120 * MiB,
                 PROJ_STRIDE = 33 * MiB, WS_YCAT = 352 * MiB, WS_ACT = 120 * MiB, WS_END = 420 * MiB;
constexpr size_t WS_X1B = 424 * MiB;
constexpr int LDS_BYTES = 147456;
constexpr int QOFF = LDS_BYTES - 64;

struct Params { const float* in[26]; float* out; unsigned char* ws; };
enum { I_XP = 0, I_XS, I_CP, I_CS, I_STC, I_STN, I_STM, I_CK, I_CV, I_SFC, I_WADA, I_BADA, I_N1W, I_WIN, I_BIG, I_BFG, I_MLW, I_SQW, I_SKW, I_SOW,
       I_WOUT, I_N2W, I_WUP, I_WCONV, I_BCONV, I_WDOWN };

__device__ __forceinline__ unsigned cvtpk(float lo, float hi) { f32x2 v = {lo, hi}; bf16x2_t b = __builtin_convertvector(v, bf16x2_t); return __builtin_bit_cast(unsigned, b); }
__device__ __forceinline__ float bf2f(unsigned short x) { return __uint_as_float((unsigned)x << 16); }
__device__ __forceinline__ float bflo(unsigned w) { return __uint_as_float(w << 16); }
__device__ __forceinline__ float bfhi(unsigned w) { return __uint_as_float(w & 0xffff0000u); }
__device__ __forceinline__ unsigned short f2bf(float f) { return (unsigned short)(cvtpk(f, 0.f) & 0xffffu); }
__device__ __forceinline__ float wave_sum(float v) {
#pragma unroll
    for (int o = 1; o < 64; o <<= 1) v += __shfl_xor(v, o);
    return v;
}
__device__ __forceinline__ float fast_exp2(float x) { return __builtin_amdgcn_exp2f(x); }
__device__ __forceinline__ float fast_rcp(float x) { return __builtin_amdgcn_rcpf(x); }
__device__ __forceinline__ float sigmoidf_(float x) { return fast_rcp(1.f + fast_exp2(-x * LOG2E)); }
__device__ __forceinline__ int crow(int r, int hi) { return (r & 3) + 8 * (r >> 2) + 4 * hi; }
typedef short v4i16_t __attribute__((ext_vector_type(4)));
__device__ __forceinline__ s16x4 tr_read(clptr p) { return __builtin_bit_cast(s16x4, __builtin_amdgcn_ds_read_tr16_b64_v4i16((LAS v4i16_t*)p)); }
__device__ __forceinline__ bf16x8 tr_frag(clptr base, int P, int R0, int C0, int lane) {
    const int h = lane >> 5, blk = (lane >> 4) & 1, q = (lane & 15) >> 2, p = lane & 3;
    clptr a = base + (R0 + 8 * h + q) * P + (C0 + 16 * blk + 4 * p) * 2;
    const s16x4 lo = tr_read(a), hi = tr_read(a + 4 * P);
    return (bf16x8){lo[0], lo[1], lo[2], lo[3], hi[0], hi[1], hi[2], hi[3]};
}
__device__ __forceinline__ bf16x8 row_frag(clptr base, int P, int R0, int K0, int lane) {
    return *(const LAS bf16x8*)(base + (R0 + (lane & 31)) * P + (K0 + 8 * (lane >> 5)) * 2);
}
#define MFMA32(a, b, c) __builtin_amdgcn_mfma_f32_32x32x16_bf16((a), (b), (c), 0, 0, 0)
#define MFMA16(a, b, c) __builtin_amdgcn_mfma_f32_16x16x32_bf16((a), (b), (c), 0, 0, 0)

namespace pg8 {
#define PG8_LAS __attribute__((address_space(3)))
typedef unsigned short bf16_t;
typedef short bf16x8 __attribute__((ext_vector_type(8)));
typedef float f32x4 __attribute__((ext_vector_type(4)));
typedef unsigned u32x4 __attribute__((ext_vector_type(4)));
constexpr int BM = 256, BK = 64, HALF = 128, HTB = HALF * BK * 2  , STAGE_BYTES = 8 * HTB, NXCD = 8, WGM = 8;

__host__ __device__ __forceinline__ int lds_byte(int r, int c) { const int st = (r >> 4) * 2 + (c >> 5), rr = r & 15, cc = c & 31, ob = rr * 64 + cc * 2; return st * 1024 + (ob ^ (((ob >> 9) & 1) << 5)); }
__host__ __device__ __forceinline__ void stage_rc(int b, int& R, int& C) { const int st = b / 1024, sb = b % 1024, swz = sb ^ (((sb >> 9) & 1) << 5); R = (st >> 1) * 16 + swz / 64; C = (st & 1) * 32 + (swz % 64) / 2; }
__host__ __device__ __forceinline__ int perm32(int rho) { const int n = rho >> 4, i = rho & 15; return 8 * (i >> 2) + 4 * n + (i & 3); }

struct Unit { int pm, pn; };
struct Gemm { const bf16_t* A; const bf16_t* Bt; int M, N, K; };

struct StaticOrder {
    int nM, nN, nwg, G, c;
    __host__ __device__ void init(int M, int N, int G_, int c_) { nM = M / BM; nN = N / BM; nwg = nM * nN; G = G_; c = c_; }
    __host__ __device__ bool next(int i, Unit& u) const {
        const long L = (long)i * G + c; if (L >= nwg) return false;
        int wgid = (int)L; { const int q = nwg / NXCD, r = nwg % NXCD, xcd = wgid % NXCD, off = wgid / NXCD; wgid = (xcd < r ? xcd * (q + 1) : r * (q + 1) + (xcd - r) * q) + off; }
        const int nig = WGM * nN, gid = wgid / nig, fm = gid * WGM, gsz = (nM - fm) < WGM ? (nM - fm) : WGM;
        u.pm = fm + ((wgid % nig) % gsz); u.pn = (wgid % nig) / gsz; return true;
    }
    __device__ __forceinline__ void a_ready(const Unit&) const {}
    __device__ __forceinline__ void done(const Unit&) const {}
};

template <class Epi, class Sched, bool ALIGN_EPI = false, bool SP2 = false>
__device__ __forceinline__ void gemm_phase(PG8_LAS unsigned char* lds, const Gemm g, const Sched& S, const Epi& E) {
    int tid_o = threadIdx.x; asm volatile("" : "+v"(tid_o));
    const int tid = tid_o, wid = __builtin_amdgcn_readfirstlane(tid >> 6), lane = tid & 63, wr = wid >> 2, wc = wid & 3, fr = lane & 15, fq = lane >> 4;
    const int K = g.K, nt = K / BK;
    unsigned voffA[2], voffB[2];
#pragma unroll
    for (int i = 0; i < 2; ++i) { int R, C; stage_rc(tid * 16 + i * 8192, R, C); const int Rb = Epi::PERM ? ((R & ~31) + perm32(R & 31)) : R;
        voffA[i] = (unsigned)(R * K + C) * 2u; voffB[i] = (unsigned)(Rb * K + C) * 2u; }
    const size_t kstep = (size_t)(BK * 2);
    const size_t hstep = (size_t)HALF * K * 2;
    const size_t tstep = 2 * hstep;
    const unsigned ldsw = (unsigned)wid * 1024u;
    const int aoff = lds_byte(wr * 64 + fr, fq * 8), boff = lds_byte(wc * 32 + fr, fq * 8);
#define PG8_SA(b, h) (((b) * 2 + (h)) * HTB)
#define PG8_SB(b, h) ((4 + (b) * 2 + (h)) * HTB)
#define PG8_STAGE(bufoff, gbase, voff) do { _Pragma("unroll") for (int _i = 0; _i < 2; ++_i) \
        __builtin_amdgcn_global_load_lds((const unsigned*)((const char*)(gbase) + (voff)[_i]), (PG8_LAS unsigned*)(lds + (bufoff) + ldsw + _i * 8192), 16, 0, 0); } while (0)
#define PG8_LDA(dst, b, h) do { _Pragma("unroll") for (int m = 0; m < 4; ++m) _Pragma("unroll") for (int k = 0; k < 2; ++k) dst[m][k] = *(const PG8_LAS bf16x8*)(lds + PG8_SA(b, h) + aoff + m * 2048 + k * 1024); } while (0)
#define PG8_LDB(dst, b, h) do { _Pragma("unroll") for (int n = 0; n < 2; ++n) _Pragma("unroll") for (int k = 0; k < 2; ++k) dst[n][k] = *(const PG8_LAS bf16x8*)(lds + PG8_SB(b, h) + boff + n * 2048 + k * 1024); } while (0)
#define PG8_MMA(ai, bj, At, Bt) do { __builtin_amdgcn_s_setprio(1); _Pragma("unroll") for (int m = 0; m < 4; ++m) _Pragma("unroll") for (int n = 0; n < 2; ++n) _Pragma("unroll") for (int k = 0; k < 2; ++k) \
        acc[ai][bj][m][n] = __builtin_amdgcn_mfma_f32_16x16x32_bf16(Bt[n][k], At[m][k], acc[ai][bj][m][n], 0, 0, 0); __builtin_amdgcn_s_setprio(0); } while (0)
#define PG8_WAIT_V(n) asm volatile("s_waitcnt vmcnt(" #n ")" ::: "memory")
#define PG8_WAIT_L(n) asm volatile("s_waitcnt lgkmcnt(" #n ")" ::: "memory")
#define PG8_BAR __builtin_amdgcn_s_barrier()
#define PG8_SCHED __builtin_amdgcn_sched_barrier(0)
    Unit cur, nxt; int ui = 0;
    if (!S.next(0, cur)) return;
    f32x4 acc[2][2][4][2];
#pragma unroll
    for (int a = 0; a < 2; ++a)
#pragma unroll
        for (int b = 0; b < 2; ++b)
#pragma unroll
            for (int m = 0; m < 4; ++m)
#pragma unroll
                for (int n = 0; n < 2; ++n) acc[a][b][m][n] = (f32x4){0.f, 0.f, 0.f, 0.f};
    bf16x8 At[4][2], B0[2][2], B1[2][2];
    const char* cA = (const char*)g.A + (size_t)cur.pm * tstep; const char* cB = (const char*)g.Bt + (size_t)cur.pn * tstep;
    S.a_ready(cur);
    if constexpr (SP2) {
        PG8_STAGE(PG8_SB(0, 0), cB, voffB); PG8_STAGE(PG8_SB(0, 1), cB + hstep, voffB); PG8_STAGE(PG8_SA(0, 0), cA, voffA); PG8_STAGE(PG8_SA(0, 1), cA + hstep, voffA);
        if (wr == 1) PG8_BAR;
        PG8_WAIT_V(2); PG8_BAR;
        PG8_STAGE(PG8_SB(1, 0), cB + kstep, voffB); PG8_STAGE(PG8_SA(1, 0), cA + kstep, voffA); PG8_STAGE(PG8_SB(1, 1), cB + hstep + kstep, voffB);
        PG8_WAIT_V(6); PG8_BAR;
    } else {
        PG8_STAGE(PG8_SB(0, 0), cB, voffB); PG8_STAGE(PG8_SA(0, 0), cA, voffA); PG8_STAGE(PG8_SB(0, 1), cB + hstep, voffB); PG8_STAGE(PG8_SA(0, 1), cA + hstep, voffA);
        if (wr == 1) PG8_BAR;
        PG8_WAIT_V(4); PG8_BAR;
        PG8_STAGE(PG8_SB(1, 0), cB + kstep, voffB); PG8_STAGE(PG8_SA(1, 0), cA + kstep, voffA); PG8_STAGE(PG8_SB(1, 1), cB + hstep + kstep, voffB);
        PG8_WAIT_V(6); PG8_BAR;
    }
    for (;;) {
        const bool has_next = S.next(ui + 1, nxt);
        const char* nA = has_next ? (const char*)g.A + (size_t)nxt.pm * tstep : cA; const char* nB = has_next ? (const char*)g.Bt + (size_t)nxt.pn * tstep : cB;
        for (int t = 0; t < nt; t += 2) {
            const bool last = (t == nt - 2);
            const char* a1 = cA + (size_t)(t + 1) * kstep;
            const char* a2 = last ? nA : cA + (size_t)(t + 2) * kstep; const char* b2 = last ? nB : cB + (size_t)(t + 2) * kstep;
            const char* a3 = a2 + kstep; const char* b3 = b2 + kstep;
            if (last && has_next) S.a_ready(nxt);
            if constexpr (SP2) {
            PG8_LDB(B0, 0, 0); PG8_LDB(B1, 0, 1); PG8_SCHED; PG8_LDA(At, 0, 0); PG8_STAGE(PG8_SA(1, 1), a1 + hstep, voffA);
            PG8_WAIT_V(8); PG8_WAIT_L(0); PG8_BAR; PG8_MMA(0, 0, At, B0); PG8_MMA(0, 1, At, B1); PG8_BAR; PG8_SCHED;
            PG8_LDA(At, 0, 1); PG8_STAGE(PG8_SB(0, 0), b2, voffB); PG8_STAGE(PG8_SB(0, 1), b2 + hstep, voffB); PG8_STAGE(PG8_SA(0, 0), a2, voffA);
            PG8_WAIT_V(8); PG8_WAIT_L(0); PG8_BAR; PG8_MMA(1, 0, At, B0); PG8_MMA(1, 1, At, B1); PG8_BAR; PG8_SCHED;
            PG8_LDB(B0, 1, 0); PG8_LDB(B1, 1, 1); PG8_SCHED; PG8_LDA(At, 1, 0); PG8_STAGE(PG8_SA(0, 1), a2 + hstep, voffA);
            PG8_WAIT_V(8); PG8_WAIT_L(0); PG8_BAR; PG8_MMA(0, 0, At, B0); PG8_MMA(0, 1, At, B1); PG8_BAR; PG8_SCHED;
            PG8_LDA(At, 1, 1); PG8_STAGE(PG8_SB(1, 0), b3, voffB); PG8_STAGE(PG8_SB(1, 1), b3 + hstep, voffB); PG8_STAGE(PG8_SA(1, 0), a3, voffA);
            PG8_WAIT_V(8); PG8_WAIT_L(0); PG8_BAR; PG8_MMA(1, 0, At, B0); PG8_MMA(1, 1, At, B1); PG8_BAR; PG8_SCHED;
            } else {
            PG8_LDB(B0, 0, 0); PG8_SCHED; PG8_LDA(At, 0, 0); PG8_STAGE(PG8_SA(1, 1), a1 + hstep, voffA);
            PG8_WAIT_L(8); PG8_BAR; PG8_WAIT_L(0); PG8_MMA(0, 0, At, B0); PG8_BAR; PG8_SCHED;
            PG8_LDB(B1, 0, 1); PG8_STAGE(PG8_SB(0, 0), b2, voffB);
            PG8_BAR; PG8_WAIT_L(0); PG8_MMA(0, 1, At, B1); PG8_BAR;
            PG8_LDA(At, 0, 1); PG8_STAGE(PG8_SA(0, 0), a2, voffA);
            PG8_BAR; PG8_WAIT_L(0); PG8_MMA(1, 0, At, B0); PG8_BAR; PG8_SCHED;
            PG8_STAGE(PG8_SB(0, 1), b2 + hstep, voffB);
            PG8_WAIT_V(6); PG8_BAR; PG8_MMA(1, 1, At, B1); PG8_BAR;
            PG8_LDB(B0, 1, 0); PG8_SCHED; PG8_LDA(At, 1, 0); PG8_STAGE(PG8_SA(0, 1), a2 + hstep, voffA);
            PG8_WAIT_L(8); PG8_BAR; PG8_WAIT_L(0); PG8_MMA(0, 0, At, B0); PG8_BAR; PG8_SCHED;
            PG8_LDB(B1, 1, 1); PG8_STAGE(PG8_SB(1, 0), b3, voffB);
            PG8_BAR; PG8_WAIT_L(0); PG8_MMA(0, 1, At, B1); PG8_BAR;
            PG8_LDA(At, 1, 1); PG8_STAGE(PG8_SA(1, 0), a3, voffA);
            PG8_BAR; PG8_WAIT_L(0); PG8_MMA(1, 0, At, B0); PG8_BAR; PG8_SCHED;
            PG8_STAGE(PG8_SB(1, 1), b3 + hstep, voffB);
            PG8_WAIT_V(6); PG8_BAR; PG8_MMA(1, 1, At, B1); PG8_BAR;
            }
        }
        if constexpr (ALIGN_EPI) { if (wr == 0) PG8_BAR; }
        if constexpr (!Epi::AFTER_DRAIN) { E(acc, cur, wr, wc, fr, fq, lds); S.done(cur); }
        if (!has_next) break;
#pragma unroll
        for (int a = 0; a < 2; ++a)
#pragma unroll
            for (int b = 0; b < 2; ++b)
#pragma unroll
                for (int m = 0; m < 4; ++m)
#pragma unroll
                    for (int n = 0; n < 2; ++n) acc[a][b][m][n] = (f32x4){0.f, 0.f, 0.f, 0.f};
        cur = nxt; cA = nA; cB = nB; ++ui;
        if constexpr (ALIGN_EPI) { if (wr == 1) PG8_BAR; }
    }
    PG8_WAIT_V(0);
    if constexpr (!ALIGN_EPI) { if (wr == 0) PG8_BAR; }
    PG8_BAR;
    if constexpr (Epi::AFTER_DRAIN) { E.fused(acc, cur, wr, wc, fr, fq, lds, wid, lane); S.done(cur); }
#undef PG8_SA
#undef PG8_SB
#undef PG8_STAGE
#undef PG8_LDA
#undef PG8_LDB
#undef PG8_MMA
#undef PG8_WAIT_V
#undef PG8_WAIT_L
#undef PG8_BAR
#undef PG8_SCHED
}
}

__device__ __forceinline__ u32x4 pack8(const f32x4& v0, const f32x4& v1) { u32x4 w; w.x = cvtpk(v0[0], v0[1]); w.y = cvtpk(v0[2], v0[3]); w.z = cvtpk(v1[0], v1[1]); w.w = cvtpk(v1[2], v1[3]); return w; }

struct EpiProj {
    static constexpr bool PERM = true, AFTER_DRAIN = false;
    bf16_t* proj; float* outK; float* outV; const float* qw; const float* kw; int rowoff;
    __device__ __forceinline__ void sub(const f32x4 (&a)[2][4][2], int pn, int rloc0, int wc, int fr, int fq) const {
        const int kind = pn >> 1, half = pn & 1;
        const int c8 = 256 * half + 64 * wc + 8 * fq;
        bf16_t* ob = proj + (size_t)kind * (PROJ_STRIDE / 2);
        if (kind < 4) {
#pragma unroll
            for (int m = 0; m < 4; ++m) { const size_t row = (size_t)(rowoff + rloc0 + 16 * m + fr);
#pragma unroll
                for (int bj = 0; bj < 2; ++bj) { f32x4 v0 = a[bj][m][0], v1 = a[bj][m][1];
                    if (kind == 1) { v0 = v0 * 0.08838834764831845f; v1 = v1 * 0.08838834764831845f; }
                    if (kind == 3) {
#pragma unroll
                        for (int e = 0; e < 4; ++e) { v0[e] = sigmoidf_(v0[e]); v1[e] = sigmoidf_(v1[e]); } }
                    *(u32x4*)(ob + row * 512 + c8 + 32 * bj) = pack8(v0, v1); } }
        } else if (kind < 6) {
            const float* w = kind == 4 ? qw : kw; const float osc = kind == 4 ? 0.125f * LOG2E : 1.f;
            f32x4 wv[2][2];
#pragma unroll
            for (int bj = 0; bj < 2; ++bj)
#pragma unroll
                for (int n = 0; n < 2; ++n) wv[bj][n] = *(const f32x4*)(w + 32 * bj + 8 * fq + 4 * n);
#pragma unroll
            for (int m = 0; m < 4; ++m) { const int rl = rloc0 + 16 * m + fr; float ss = 0.f;
#pragma unroll
                for (int bj = 0; bj < 2; ++bj)
#pragma unroll
                    for (int n = 0; n < 2; ++n) { const f32x4 x = a[bj][m][n]; ss += (x[0] * x[0] + x[1] * x[1]) + (x[2] * x[2] + x[3] * x[3]); }
                ss += __shfl_xor(ss, 16); ss += __shfl_xor(ss, 32);
                const float rstd = rsqrtf(ss * (1.f / 64.f) + EPS);
#pragma unroll
                for (int bj = 0; bj < 2; ++bj) { f32x4 v0 = a[bj][m][0] * rstd * wv[bj][0], v1 = a[bj][m][1] * rstd * wv[bj][1];
                    if (kind == 5) { float* o = outK + (size_t)rl * 512 + c8 + 32 * bj; __builtin_nontemporal_store(v0, (f32x4*)o); __builtin_nontemporal_store(v1, (f32x4*)(o + 4)); }
                    v0 = v0 * osc; v1 = v1 * osc;
                    *(u32x4*)(ob + (size_t)(rowoff + rl) * 512 + c8 + 32 * bj) = pack8(v0, v1); } }
        } else {
#pragma unroll
            for (int m = 0; m < 4; ++m) { const int rl = rloc0 + 16 * m + fr;
#pragma unroll
                for (int bj = 0; bj < 2; ++bj) { const f32x4 v0 = a[bj][m][0], v1 = a[bj][m][1];
                    float* o = outV + (size_t)rl * 512 + c8 + 32 * bj; __builtin_nontemporal_store(v0, (f32x4*)o); __builtin_nontemporal_store(v1, (f32x4*)(o + 4));
                    *(u32x4*)(ob + (size_t)(rowoff + rl) * 512 + c8 + 32 * bj) = pack8(v0, v1); } }
        }
    }
    __device__ __forceinline__ void operator()(const f32x4 (&acc)[2][2][4][2], const pg8::Unit& u, int wr, int wc, int fr, int fq, lptr) const {
#pragma unroll
        for (int ai = 0; ai < 2; ++ai) sub(acc[ai], u.pn, u.pm * 256 + ai * 128 + wr * 64, wc, fr, fq);
    }
};

template <int MODE>
struct EpiRes {
    static constexpr bool PERM = true, AFTER_DRAIN = false;
    const void* xin; void* xout; const float* gate; int tlog;
    __device__ __forceinline__ void sub(const f32x4 (&a)[2][4][2], int pn, int rloc0, int wc, int fr, int fq) const {
#pragma unroll
        for (int m = 0; m < 4; ++m) { const int rl = rloc0 + 16 * m + fr; const float* g = gate + (size_t)(rl >> tlog) * 6144;
#pragma unroll
            for (int bj = 0; bj < 2; ++bj) { const int c = 256 * pn + 128 * bj + 32 * wc + 8 * fq;
                const f32x4 g0 = *(const f32x4*)(g + c), g1 = *(const f32x4*)(g + c + 4);
                if (MODE == 0) {
                    const float* xp = (const float*)xin + (size_t)rl * 1024 + c;
                    const f32x4 o0 = *(const f32x4*)xp + g0 * a[bj][m][0], o1 = *(const f32x4*)(xp + 4) + g1 * a[bj][m][1];
                    *(u32x4*)((bf16_t*)xout + (size_t)rl * 1024 + c) = pack8(o0, o1);
                } else {
                    const u32x4 xv = *(const u32x4*)((const bf16_t*)xin + (size_t)rl * 1024 + c);
                    const f32x4 x0 = {bflo(xv.x), bfhi(xv.x), bflo(xv.y), bfhi(xv.y)}, x1 = {bflo(xv.z), bfhi(xv.z), bflo(xv.w), bfhi(xv.w)};
                    float* op = (float*)xout + (size_t)rl * 1024 + c;
                    __builtin_nontemporal_store(x0 + g0 * a[bj][m][0], (f32x4*)op); __builtin_nontemporal_store(x1 + g1 * a[bj][m][1], (f32x4*)(op + 4));
                } } }
    }
    __device__ __forceinline__ void operator()(const f32x4 (&acc)[2][2][4][2], const pg8::Unit& u, int wr, int wc, int fr, int fq, lptr) const {
#pragma unroll
        for (int ai = 0; ai < 2; ++ai) sub(acc[ai], u.pn, u.pm * 256 + ai * 128 + wr * 64, wc, fr, fq);
    }
};

__device__ __forceinline__ float dpp_ror1(float x) { return __int_as_float(__builtin_amdgcn_update_dpp(0, __float_as_int(x), 0x121, 0xf, 0xf, false)); }
__device__ __forceinline__ float dpp_ror2(float x) { return __int_as_float(__builtin_amdgcn_update_dpp(0, __float_as_int(x), 0x122, 0xf, 0xf, false)); }
struct ConvW { f32x4 w0a, w1a, w2a, ba, w0g, w1g, w2g, bg; };
__device__ __forceinline__ ConvW load_convw(const float* wconv, const float* bconv, int c) {
    ConvW w; w.w0a = *(const f32x4*)(wconv + c); w.w1a = *(const f32x4*)(wconv + FF2 + c); w.w2a = *(const f32x4*)(wconv + 2 * FF2 + c); w.ba = *(const f32x4*)(bconv + c);
    w.w0g = *(const f32x4*)(wconv + FF + c); w.w1g = *(const f32x4*)(wconv + FF2 + FF + c); w.w2g = *(const f32x4*)(wconv + 2 * FF2 + FF + c); w.bg = *(const f32x4*)(bconv + FF + c); return w;
}
template <int CTRL> __device__ __forceinline__ float dppz(float x) { return __int_as_float(__builtin_amdgcn_update_dpp(0, __float_as_int(x), CTRL, 0xf, 0xf, true)); }
__device__ __forceinline__ u32x2 conv_gate4(const f32x4& ca, const f32x4& cg, const f32x4& pa, const f32x4& pg, const ConvW& w, int) {
    float o[4];
#pragma unroll
    for (int e = 0; e < 4; ++e) {
        float ua = fmaf(w.w2a[e], ca[e], w.ba[e]);
        ua = fmaf(dppz<0x111>(ca[e]), w.w1a[e], ua); ua = fmaf(dppz<0x10F>(pa[e]), w.w1a[e], ua);
        ua = fmaf(dppz<0x112>(ca[e]), w.w0a[e], ua); ua = fmaf(dppz<0x10E>(pa[e]), w.w0a[e], ua);
        float ug = fmaf(w.w2g[e], cg[e], w.bg[e]);
        ug = fmaf(dppz<0x111>(cg[e]), w.w1g[e], ug); ug = fmaf(dppz<0x10F>(pg[e]), w.w1g[e], ug);
        ug = fmaf(dppz<0x112>(cg[e]), w.w0g[e], ug); ug = fmaf(dppz<0x10E>(pg[e]), w.w0g[e], ug);
        o[e] = ua * sigmoidf_(ua) * ug;
    }
    u32x2 r; r.x = cvtpk(o[0], o[1]); r.y = cvtpk(o[2], o[3]); return r;
}
struct EpiFFN {
    static constexpr bool PERM = true, AFTER_DRAIN = false;
    bf16_t* act; float* uedge; float* outF; const float* wconv; const float* bconv;
    __device__ __forceinline__ void operator()(const f32x4 (&acc)[2][2][4][2], const pg8::Unit& u, int wr, int wc, int fr, int fq, lptr lds) const {
        lptr halo = lds + pg8::STAGE_BYTES;
        const int q8 = 32 * wc + 8 * fq;
        if (fr >= 14) {
#pragma unroll
            for (int ai = 0; ai < 2; ++ai)
#pragma unroll
                for (int bj = 0; bj < 2; ++bj)
#pragma unroll
                    for (int n = 0; n < 2; ++n) *(LAS f32x4*)(halo + ((((2 * ai + wr) * 2 + (fr - 14)) * 256 + 128 * bj + q8 + 4 * n) * 4)) = acc[ai][bj][3][n];
        }
        asm volatile("s_waitcnt lgkmcnt(0)" ::: "memory"); __builtin_amdgcn_s_barrier(); asm volatile("" ::: "memory");
#pragma unroll
        for (int n = 0; n < 2; ++n) {
            const int c = 128 * u.pn + q8 + 4 * n;
            const ConvW w = load_convw(wconv, bconv, c);
#pragma unroll
            for (int ai = 0; ai < 2; ++ai) {
                const int G = 2 * ai + wr;
                f32x4 pa = {0.f, 0.f, 0.f, 0.f}, pg = {0.f, 0.f, 0.f, 0.f};
                if (G > 0 && fr >= 14) { pa = *(const LAS f32x4*)(halo + ((((G - 1) * 2 + (fr - 14)) * 256 + q8 + 4 * n) * 4)); pg = *(const LAS f32x4*)(halo + ((((G - 1) * 2 + (fr - 14)) * 256 + 128 + q8 + 4 * n) * 4)); }
#pragma unroll
                for (int m = 0; m < 4; ++m) {
                    const f32x4 ca = acc[ai][0][m][n], cg = acc[ai][1][m][n];
                    const f32x4 qa = m ? acc[ai][0][m ? m - 1 : 0][n] : pa, qg = m ? acc[ai][1][m ? m - 1 : 0][n] : pg;
                    const u32x2 o = conv_gate4(ca, cg, qa, qg, w, fr);
                    const size_t row = (size_t)u.pm * 256 + 64 * G + 16 * m + fr;
                    *(u32x2*)(act + row * FF + c) = o;
                    if (m == 0 && G == 0 && fr < 2) { float* e = uedge + ((size_t)u.pm * 4 + fr) * FF2 + c; *(f32x4*)e = ca; *(f32x4*)(e + FF) = cg; }
                    if (m == 3 && G == 3 && fr >= 14) { float* e = uedge + ((size_t)u.pm * 4 + 2 + (fr - 14)) * FF2 + c; *(f32x4*)e = ca; *(f32x4*)(e + FF) = cg;
                        if ((u.pm & 15) == 15) { float* f = outF + ((size_t)(u.pm >> 4) * 2 + (fr - 14)) * FF2 + c; *(f32x4*)f = ca; *(f32x4*)(f + FF) = cg; } }
                }
            }
        }
    }
};
struct EpiFFNs {
    bf16_t* act; float* outF; const float* state; const float* wconv; const float* bconv;
    __device__ __forceinline__ void sub(const f32x4 (&a)[2][4][2], int pn, int rloc0, int wc, int fr, int fq) const {
        const int q8 = 32 * wc + 8 * fq;
#pragma unroll
        for (int n = 0; n < 2; ++n) {
            const int c = 128 * pn + q8 + 4 * n;
            const ConvW w = load_convw(wconv, bconv, c);
#pragma unroll
            for (int m = 0; m < 4; ++m) {
                const int b = (rloc0 + 16 * m) >> 5;
                const f32x4 ca = a[0][m][n], cg = a[1][m][n];
                f32x4 qa = {0.f, 0.f, 0.f, 0.f}, qg = {0.f, 0.f, 0.f, 0.f};
                if (m & 1) { qa = a[0][m ? m - 1 : 0][n]; qg = a[1][m ? m - 1 : 0][n]; }
                else if (fr >= 14) { const float* s = state + ((size_t)b * 2 + (fr - 14)) * FF2 + c; qa = *(const f32x4*)s; qg = *(const f32x4*)(s + FF); }
                const u32x2 o = conv_gate4(ca, cg, qa, qg, w, fr);
                const size_t row = (size_t)MP + rloc0 + 16 * m + fr;
                *(u32x2*)(act + row * FF + c) = o;
                if ((m & 1) && fr >= 14) { float* f = outF + ((size_t)b * 2 + (fr - 14)) * FF2 + c; *(f32x4*)f = ca; *(f32x4*)(f + FF) = cg; }
            }
        }
    }
};

template <int K, bool HISCALE, class Epi>
__device__ __forceinline__ void small_tile(const bf16_t* __restrict__ A, const bf16_t* __restrict__ Bt, const Epi& E, const float* ssq, lptr lds, int t, int tid, int lane, int wave) {
    constexpr int KW = K / 8;
    const int fr = lane & 15, fq = lane >> 4;
    const int wc = t & 3, G = (t >> 2) & 3, pn = t >> 4;
    f32x4 acc[2][4][2];
#pragma unroll
    for (int bj = 0; bj < 2; ++bj)
#pragma unroll
        for (int m = 0; m < 4; ++m)
#pragma unroll
            for (int n = 0; n < 2; ++n) acc[bj][m][n] = (f32x4){0.f, 0.f, 0.f, 0.f};
    const bf16_t* ap = A + (size_t)(G * 64 + fr) * K + fq * 8 + wave * KW;
    const bf16_t* bp = Bt + (size_t)(256 * pn + 32 * wc + 8 * (fr >> 2) + (fr & 3)) * K + fq * 8 + wave * KW;
#ifdef DBLK
    for (int rep = 0; rep < 2; ++rep) {
    if (rep == 1) {
_Pragma("unroll") for (int bj = 0; bj < 2; ++bj) _Pragma("unroll") for (int m = 0; m < 4; ++m) _Pragma("unroll") for (int n = 0; n < 2; ++n) acc[bj][m][n] = acc[bj][m][n] * 0.f; asm volatile("" ::: "memory"); }
#endif
#pragma unroll 4
    for (int k0 = 0; k0 < KW; k0 += 32) {
        bf16x8 af[4], bf[2][2];
#pragma unroll
        for (int m = 0; m < 4; ++m) af[m] = *(const bf16x8*)(ap + (size_t)(16 * m) * K + k0);
#pragma unroll
        for (int bj = 0; bj < 2; ++bj)
#pragma unroll
            for (int n = 0; n < 2; ++n) bf[bj][n] = *(const bf16x8*)(bp + (size_t)(128 * bj + 4 * n) * K + k0);
#pragma unroll
        for (int bj = 0; bj < 2; ++bj)
#pragma unroll
            for (int m = 0; m < 4; ++m)
#pragma unroll
                for (int n = 0; n < 2; ++n) acc[bj][m][n] = MFMA16(bf[bj][n], af[m], acc[bj][m][n]);
    }
#ifdef DBLK
    }
#endif
    if (HISCALE) { if (wave >= 4) {
#pragma unroll
        for (int m = 0; m < 4; ++m) { const float* sp = ssq + (size_t)(MP + G * 64 + 16 * m + fr) * 8; const f32x4 s0 = *(const f32x4*)sp, s1 = *(const f32x4*)(sp + 4);
            const float rstd = rsqrtf(((s0.x + s0.y) + (s0.z + s0.w) + (s1.x + s1.y) + (s1.z + s1.w)) * (1.f / 512.f) + EPS);
#pragma unroll
            for (int bj = 0; bj < 2; ++bj)
#pragma unroll
                for (int n = 0; n < 2; ++n) acc[bj][m][n] = acc[bj][m][n] * rstd; } } }
    __syncthreads();
    if (wave != 0) {
#pragma unroll
        for (int bj = 0; bj < 2; ++bj)
#pragma unroll
            for (int m = 0; m < 4; ++m)
#pragma unroll
                for (int n = 0; n < 2; ++n) *(LAS f32x4*)(lds + ((((wave - 1) * 16 + (bj * 4 + m) * 2 + n) * 64 + lane) * 16)) = acc[bj][m][n];
    }
    __syncthreads();
    if (wave == 0) {
#pragma unroll 1
        for (int w2 = 0; w2 < 7; ++w2)
#pragma unroll
            for (int bj = 0; bj < 2; ++bj)
#pragma unroll
                for (int m = 0; m < 4; ++m)
#pragma unroll
                    for (int n = 0; n < 2; ++n) acc[bj][m][n] = acc[bj][m][n] + *(const LAS f32x4*)(lds + (((w2 * 16 + (bj * 4 + m) * 2 + n) * 64 + lane) * 16));
        E.sub(acc, pn, G * 64, wc, fr, fq);
#ifdef DBLE
        asm volatile("" ::: "memory"); E.sub(acc, pn, G * 64, wc, fr, fq);
#endif
    }
    __syncthreads();
}

typedef unsigned v4u __attribute__((ext_vector_type(4)));
#define XB_TMO      128
#define XB_XCNT(j)  (256  + 64 * (j))
#define XB_XSUB(j)  (1280 + 64 * (j))
#define XB_XGEN(j)  (2304 + 64 * (j))
#define XB_TOP      3328
#define XB_TOPGEN   3392
#define XCD_BAR_WORDS 3456
#define XB_SPIN_CAP (1u << 18)

__device__ __forceinline__ unsigned xb_ld(unsigned* p)              { return __hip_atomic_load(p, __ATOMIC_RELAXED, __HIP_MEMORY_SCOPE_AGENT); }
__device__ __forceinline__ unsigned xb_add(unsigned* p, unsigned v) { return __hip_atomic_fetch_add(p, v, __ATOMIC_RELAXED, __HIP_MEMORY_SCOPE_AGENT); }
__device__ __forceinline__ unsigned xb_xcc_id() { return (unsigned)__builtin_amdgcn_s_getreg((3 << 11) | 20) & 0xFu; }
#define XB_SPIN(cond, bar) do { unsigned _sp = 0; while (cond) { __builtin_amdgcn_s_sleep(1); \
    if ((++_sp & 255u) == 0u) { if (xb_ld(&(bar)[XB_TMO])) break; if (_sp > XB_SPIN_CAP) { atomicAdd(&(bar)[XB_TMO], 1u); break; } } } } while (0)

struct XcdBarrier {
    unsigned* bar; unsigned x;
    volatile LAS unsigned* st;
};

__device__ __forceinline__ XcdBarrier xcd_barrier_post(unsigned* bar, volatile LAS unsigned* st) {
    XcdBarrier b; b.bar = bar; b.x = xb_xcc_id(); b.st = st;
    if (threadIdx.x == 0) (void)xb_add(&bar[XB_XCNT(b.x)], 1u);
    return b;
}
__device__ __forceinline__ void xcd_barrier_complete(unsigned* bar, unsigned x, unsigned& nloc, unsigned& nx) {
    const unsigned G = gridDim.x * gridDim.y * gridDim.z;
    unsigned sum, cnt, mine, sp = 0u;
    for (;;) {
        sum = 0u; cnt = 0u; mine = 0u;
#pragma unroll
        for (unsigned j = 0; j < 16; ++j) { const unsigned c = xb_ld(&bar[XB_XCNT(j)]); sum += c; cnt += (c > 0u) ? 1u : 0u; mine = (j == x) ? c : mine; }
        if (sum == G) break;
        __builtin_amdgcn_s_sleep(1);
        if ((++sp & 255u) == 0u) { if (xb_ld(&bar[XB_TMO])) break; if (sp > XB_SPIN_CAP) { atomicAdd(&bar[XB_TMO], 1u); break; } }
    }
    nloc = mine > 0u ? mine : 1u; nx = cnt > 0u ? cnt : 1u;
}

__device__ __forceinline__ void xcd_barrier(const XcdBarrier& b) {
    asm volatile("s_waitcnt vmcnt(0)" ::: "memory");
    __syncthreads();
    if (threadIdx.x == 0) {
        unsigned* bar = b.bar;
        __builtin_amdgcn_s_waitcnt(0);
        unsigned nloc = b.st[0], nx = b.st[1];
        if (nloc == 0u) { xcd_barrier_complete(bar, b.x, nloc, nx); b.st[0] = nloc; b.st[1] = nx; }
        const unsigned old = xb_add(&bar[XB_XSUB(b.x)], 1u);
        const unsigned gen = old / nloc;
        if (old + 1u == (gen + 1u) * nloc) {
            __builtin_amdgcn_fence(__ATOMIC_RELEASE, "agent");
            asm volatile("s_waitcnt vmcnt(0)" ::: "memory");
            const unsigned og = xb_add(&bar[XB_TOP], 1u);
            const unsigned tg = og / nx;
            if (og + 1u == (tg + 1u) * nx) xb_add(&bar[XB_TOPGEN], 1u);
            else XB_SPIN(xb_ld(&bar[XB_TOPGEN]) == tg, bar);
            __builtin_amdgcn_fence(__ATOMIC_ACQUIRE, "agent");
            xb_add(&bar[XB_XGEN(b.x)], 1u);
            asm volatile("s_waitcnt vmcnt(0)" ::: "memory");
        } else {
            XB_SPIN(xb_ld(&bar[XB_XGEN(b.x)]) == gen, bar);
            __builtin_amdgcn_fence(__ATOMIC_ACQUIRE, "agent");
            asm volatile("s_waitcnt vmcnt(0)" ::: "memory");
        }
    }
    __syncthreads();
}


__device__ __forceinline__ void transpose_item(const float* __restrict__ W, int ldw, int srccol0, bf16_t* __restrict__ WT, int K, int destrow0, int k0, LAS float* scr, int lane, const float* kscale = nullptr) {
#pragma unroll 16
    for (int i = 0; i < 32; ++i) { const int kk = 2 * i + (lane >> 5); scr[kk * 33 + (lane & 31)] = W[(size_t)(k0 + kk) * ldw + srccol0 + (lane & 31)] * (kscale ? kscale[k0 + kk] : 1.f); }
    asm volatile("s_waitcnt lgkmcnt(0)" ::: "memory");
    const int c = lane & 7;
#pragma unroll
    for (int j = 0; j < 4; ++j) { const int n = (lane >> 3) + 8 * j; const LAS float* s = scr + (8 * c) * 33 + n;
        u32x4 o; o.x = cvtpk(s[0 * 33], s[1 * 33]); o.y = cvtpk(s[2 * 33], s[3 * 33]); o.z = cvtpk(s[4 * 33], s[5 * 33]); o.w = cvtpk(s[6 * 33], s[7 * 33]);
        *(u32x4*)(WT + (size_t)(destrow0 + n) * K + k0 + 8 * c) = o; }
    asm volatile("s_waitcnt lgkmcnt(0)" ::: "memory");
}

__device__ __forceinline__ void phase_weights(const Params& P, lptr lds, int lane, int wave) {
    unsigned char* ws = P.ws;
    LAS float* scr = (LAS float*)(lds + wave * 16384);
    const int gw = blockIdx.x * 8 + wave, NGW = gridDim.x * 8;
    constexpr int I1 = 16 * 112, I2 = 16 * 32, I3 = 16 * 176, I4 = 44 * 32;
    for (int it = gw; it < I1 + I2 + I3 + I4; it += NGW) {
        int r = it;
        if (r < I1) { const int kb = r / 112, n0 = (r % 112) * 32, tile = n0 >> 8, p = n0 & 255, wc = (p >> 5) & 3, bj = p >> 7, L = tile * 256 + 64 * wc + 32 * bj;
            transpose_item(P.in[I_WIN], DIN, L < 2048 ? L : L + 8, (bf16_t*)(ws + WS_W1T), 1024, n0, kb * 64, scr, lane); continue; }
        r -= I1;
        if (r < I2) { const int kb = r / 32, n0 = (r % 32) * 32; transpose_item(P.in[I_WOUT], 1024, n0, (bf16_t*)(ws + WS_W2T), 1024, n0, kb * 64, scr, lane, kb >= 8 ? P.in[I_SOW] - 512 : nullptr); continue; }
        r -= I2;
        if (r < I3) { const int kb = r / 176, n0 = (r % 176) * 32, pn = n0 >> 8, p = n0 & 255, bj = p >> 7, q0 = p & 127;
            transpose_item(P.in[I_WUP], FF2, 128 * pn + q0 + FF * bj, (bf16_t*)(ws + WS_W3T), 1024, n0, kb * 64, scr, lane); continue; }
        r -= I3;
        { const int kb = r / 32, n0 = (r % 32) * 32; transpose_item(P.in[I_WDOWN], 1024, n0, (bf16_t*)(ws + WS_W4T), FF, n0, kb * 64, scr, lane); }
    }
}

__device__ __forceinline__ void phase0(const Params& P, lptr lds, int tid, int lane, int wave) {
    unsigned char* ws = P.ws;
    LAS float* sc = (LAS float*)lds;
    for (int i = tid; i < 16384; i += 512) { const int r = i >> 10, k = i & 1023; const float c = r < 8 ? P.in[I_CP][r * 1024 + k] : P.in[I_CS][(r - 8) * 1024 + k]; sc[i] = c / (1.f + __expf(-c)); }
    __syncthreads();
    const int job = blockIdx.x * 512 + tid;
    if (job < 16 * 6144) {
        const int ks = job / 6144, n = job % 6144;
        float acc[16];
#pragma unroll
        for (int r = 0; r < 16; ++r) acc[r] = 0.f;
        const float* wp = P.in[I_WADA] + (size_t)(ks * 64) * 6144 + n;
#pragma unroll 16
        for (int k = 0; k < 64; ++k) { const float w = wp[(size_t)k * 6144];
#pragma unroll
            for (int r = 0; r < 16; ++r) acc[r] += sc[r * 1024 + ks * 64 + k] * w; }
        __attribute__((address_space(1))) float* mp = (__attribute__((address_space(1))) float*)(ws + WS_MOD);
        const float bias = ks == 0 ? P.in[I_BADA][n] : 0.f;
#pragma unroll
        for (int r = 0; r < 16; ++r) (void)__builtin_amdgcn_global_atomic_fadd_f32(mp + (size_t)r * 6144 + n, acc[r] + bias);
    }
}

__device__ __forceinline__ void load_mod_vectors(const Params& P, LAS float* A, LAS float* S, const float* normw, int r, int shofs, int tid) {
    const float* md = (const float*)(P.ws + WS_MOD) + (size_t)r * 6144 + shofs;
    for (int k = tid; k < 1024; k += 512) { A[k] = normw[k] * (1.f + md[1024 + k]); S[k] = md[k]; }
}
__device__ __forceinline__ void load_row_bf(const bf16_t* xrow, int lane, f32x4 (&v)[4]) {
#pragma unroll
    for (int j = 0; j < 4; ++j) { const u32x2 w = ((const u32x2*)xrow)[lane + 64 * j]; v[j] = (f32x4){bflo(w.x), bfhi(w.x), bflo(w.y), bfhi(w.y)}; }
}
__device__ __forceinline__ void load_row(const float* xrow, int lane, f32x4 (&v)[4]) {
#pragma unroll
    for (int j = 0; j < 4; ++j) v[j] = ((const f32x4*)xrow)[lane + 64 * j];
}
template <bool GATES>
__device__ __forceinline__ void norm_row(const Params& P, const f32x4 (&v)[4], bf16_t* orow, float* grow, const LAS float* A, const LAS float* S, const LAS float* Wg, int lane) {
    float s = 0.f;
#pragma unroll
    for (int j = 0; j < 4; ++j) s += (v[j].x * v[j].x + v[j].y * v[j].y) + (v[j].z * v[j].z + v[j].w * v[j].w);
    const float rstd = rsqrtf(wave_sum(s) * (1.f / 1024.f) + EPS);
    float g[8];
#pragma unroll
    for (int i = 0; i < 8; ++i) g[i] = 0.f;
#pragma unroll
    for (int j = 0; j < 4; ++j) { const int k0 = 4 * lane + 256 * j;
        const f32x4 a = *(const LAS f32x4*)(A + k0), sh = *(const LAS f32x4*)(S + k0);
        const f32x4 hv = v[j] * rstd * a + sh;
        u32x2 o; o.x = cvtpk(hv.x, hv.y); o.y = cvtpk(hv.z, hv.w);
        *(u32x2*)(orow + k0) = o;
        if (GATES) {
#pragma unroll
            for (int i = 0; i < 8; ++i) { const f32x4 w = *(const LAS f32x4*)(Wg + i * 1024 + k0); g[i] += (hv.x * w.x + hv.y * w.y) + (hv.z * w.z + hv.w * w.w); } }
    }
    if (GATES) {
        { const bool hi = (lane & 32) != 0;
#pragma unroll
          for (int i = 0; i < 4; ++i) { const float send = hi ? g[i] : g[i + 4], keep = hi ? g[i + 4] : g[i]; g[i] = keep + __shfl_xor(send, 32); } }
        { const bool hi = (lane & 16) != 0;
#pragma unroll
          for (int i = 0; i < 2; ++i) { const float send = hi ? g[i] : g[i + 2], keep = hi ? g[i + 2] : g[i]; g[i] = keep + __shfl_xor(send, 16); } }
        { const bool hi = (lane & 8) != 0; const float send = hi ? g[0] : g[1], keep = hi ? g[1] : g[0]; g[0] = keep + __shfl_xor(send, 8); }
        g[0] += __shfl_xor(g[0], 4); g[0] += __shfl_xor(g[0], 2); g[0] += __shfl_xor(g[0], 1);
        const int gt = lane >> 3;
        if ((lane & 7) == 0) {
            float o;
            if (gt < 4) o = g[0] + P.in[I_BIG][gt];
            else { const float x = g[0] + P.in[I_BFG][gt - 4]; o = fminf(x, 0.f) - log1pf(expf(-fabsf(x))); }
            grow[gt] = o;
        }
    }
}
__device__ __forceinline__ void phase1(const Params& P, lptr lds, int tid, int lane, int wave) {
    LAS float* A1 = (LAS float*)lds; LAS float* S1 = A1 + 1024; LAS float* Wg = S1 + 1024;
    const size_t row0 = (size_t)blockIdx.x * 128 + wave * 16; f32x4 v[4], vn[4]; load_row(P.in[I_XP] + row0 * 1024, lane, v);
    for (int k = tid; k < 1024; k += 512) { const f32x4 w0 = *(const f32x4*)(P.in[I_WIN] + (size_t)k * DIN + 2048), w1 = *(const f32x4*)(P.in[I_WIN] + (size_t)k * DIN + 2052);
        Wg[k] = w0.x; Wg[1024 + k] = w0.y; Wg[2048 + k] = w0.z; Wg[3072 + k] = w0.w; Wg[4096 + k] = w1.x; Wg[5120 + k] = w1.y; Wg[6144 + k] = w1.z; Wg[7168 + k] = w1.w; }
    load_mod_vectors(P, A1, S1, P.in[I_N1W], blockIdx.x >> 5, 0, tid);
    LAS float* A1s = Wg + 8192; LAS float* S1s = A1s + 1024;
    load_mod_vectors(P, A1s, S1s, P.in[I_N1W], 8 + (blockIdx.x >> 5), 0, tid);
    __syncthreads();
    bf16_t* H = (bf16_t*)(P.ws + WS_H); float* GT = (float*)(P.ws + WS_GATES);
    {
#pragma unroll 1
      for (int j = 0; j < 16; ++j) { const size_t row = row0 + j;
          if (j + 1 < 16) load_row(P.in[I_XP] + (row + 1) * 1024, lane, vn);
          else if (wave == 0) load_row(P.in[I_XS] + (size_t)blockIdx.x * 1024, lane, vn);
          norm_row<true>(P, v, H + row * 1024, GT + row * 8, A1, S1, Wg, lane);
#pragma unroll
          for (int q = 0; q < 4; ++q) v[q] = vn[q]; }
      if (wave == 0) norm_row<true>(P, v, H + ((size_t)MP + blockIdx.x) * 1024, GT + ((size_t)MP + blockIdx.x) * 8, A1s, S1s, Wg, lane); }
}
__device__ __forceinline__ void phase5(const Params& P, lptr lds, int tid, int lane, int wave) {
    LAS float* A1 = (LAS float*)lds; LAS float* S1 = A1 + 1024;
    load_mod_vectors(P, A1, S1, P.in[I_N2W], blockIdx.x >> 5, 3072, tid);
    __syncthreads();
    bf16_t* H = (bf16_t*)(P.ws + WS_H);
    { const size_t row0 = (size_t)blockIdx.x * 128 + wave * 16; const bf16_t* X1 = (const bf16_t*)(P.ws + WS_X1B); f32x4 v[4], vn[4]; load_row_bf(X1 + row0 * 1024, lane, v);
#pragma unroll 1
      for (int j = 0; j < 16; ++j) { const size_t row = row0 + j;
          if (j + 1 < 16) load_row_bf(X1 + (row + 1) * 1024, lane, vn);
          norm_row<false>(P, v, H + row * 1024, nullptr, A1, S1, nullptr, lane);
#pragma unroll
          for (int q = 0; q < 4; ++q) v[q] = vn[q]; } }
    __syncthreads();
}
__device__ __forceinline__ void sample_h2_row(const Params& P, lptr lds, int tid, int lane, int wave) {
    LAS float* A1 = (LAS float*)lds; LAS float* S1 = A1 + 1024;
    load_mod_vectors(P, A1, S1, P.in[I_N2W], 8 + (blockIdx.x >> 5), 3072, tid);
    __syncthreads();
    if (wave == 0) { f32x4 v[4]; load_row_bf((const bf16_t*)(P.ws + WS_X1B) + ((size_t)MP + blockIdx.x) * 1024, lane, v); norm_row<false>(P, v, (bf16_t*)(P.ws + WS_H) + ((size_t)MP + blockIdx.x) * 1024, nullptr, A1, S1, nullptr, lane); }
    __syncthreads();
}
__device__ __forceinline__ void phase3b(const Params& P, int lane, int gw, int NGW) {
    bf16_t* Y = (bf16_t*)(P.ws + WS_YCAT); const float* SSQ = (const float*)(P.ws + WS_SSQ);
    for (int row = gw; row < MP; row += NGW) {
        const f32x4 s0 = *(const f32x4*)(SSQ + (size_t)row * 8), s1 = *(const f32x4*)(SSQ + (size_t)row * 8 + 4);
        const float rstd = rsqrtf(((s0.x + s0.y) + (s0.z + s0.w) + (s1.x + s1.y) + (s1.z + s1.w)) * (1.f / 512.f) + EPS);
        u32x4* p = (u32x4*)(Y + (size_t)row * 1024 + 512 + 8 * lane); const u32x4 o = *p;
        f32x4 a = {bflo(o.x), bfhi(o.x), bflo(o.y), bfhi(o.y)}, b = {bflo(o.z), bfhi(o.z), bflo(o.w), bfhi(o.w)};
        a = a * rstd; b = b * rstd;
        *p = pack8(a, b);
    }
}
__device__ __forceinline__ void phase_fix(const Params& P, int tid) {
    const float* UE = (const float*)(P.ws + WS_UEDGE); bf16_t* act = (bf16_t*)(P.ws + WS_ACT);
    const float* wc = P.in[I_WCONV]; const float* bc = P.in[I_BCONV];
    const int total = 128 * 2 * FF;
    for (int i = blockIdx.x * 512 + tid; i < total; i += gridDim.x * 512) {
        const int j = i % FF, rr = (i / FF) & 1, pm = i / (2 * FF);
        if ((pm & 15) == 0) continue;
        float uc[2];
#pragma unroll
        for (int hf = 0; hf < 2; ++hf) { const int c = j + hf * FF;
            const float um2 = rr == 0 ? UE[((size_t)(pm - 1) * 4 + 2) * FF2 + c] : UE[((size_t)(pm - 1) * 4 + 3) * FF2 + c];
            const float um1 = rr == 0 ? UE[((size_t)(pm - 1) * 4 + 3) * FF2 + c] : UE[((size_t)pm * 4 + 0) * FF2 + c];
            const float u0 = UE[((size_t)pm * 4 + rr) * FF2 + c];
            uc[hf] = bc[c] + wc[2 * FF2 + c] * u0 + wc[FF2 + c] * um1 + wc[c] * um2; }
        act[((size_t)pm * 256 + rr) * FF + j] = f2bf(uc[0] * sigmoidf_(uc[0]) * uc[1]);
    }
}

constexpr int ML_P = 272;
constexpr int ML_QS = 0, ML_KS = 17408, ML_VS = 34816, ML_VW = 52224, ML_CS = 69632, ML_SS = 104448, ML_SC = 113664;
__device__ __forceinline__ void mlstm_item(const Params& P, lptr lds, int bh, bool sample, int tid, int lane, int wave) {
    const int b = bh >> 2, h = bh & 3, hh = lane >> 5, n31 = lane & 31;
    const size_t rowbase = sample ? (size_t)MP + b * 32 : (size_t)b * SEQ;
    const int nch = sample ? 1 : 64, L = sample ? 32 : 64;
    const bf16_t* MQ = (const bf16_t*)(P.ws + WS_PROJ); const bf16_t* MK = (const bf16_t*)(P.ws + WS_PROJ + PROJ_STRIDE); const bf16_t* MV = (const bf16_t*)(P.ws + WS_PROJ + 2 * PROJ_STRIDE);
    const bf16_t* MO = (const bf16_t*)(P.ws + WS_PROJ + 3 * PROJ_STRIDE); const float* GT = (const float*)(P.ws + WS_GATES); bf16_t* YC = (bf16_t*)(P.ws + WS_YCAT);
    LAS float* sc = (LAS float*)(lds + ML_SC);
    LAS float* bt = sc, *as_ = sc + 64, *mt = sc + 128, *winter = sc + 192, *emt = sc + 256, *wk = sc + 320, *rsum = sc + 384, *qn = sc + 512, *nvec = sc + 576, *misc = sc + 704;
    const int ti = wave >> 2, ej = wave & 3;
    f32x16 Cacc[2];
    {
        LAS float* cst = (LAS float*)lds;
        if (sample) { const float* src = P.in[I_STC] + ((size_t)b * 4 + h) * 16384;
            for (int i = tid; i < 4096; i += 512) { const f32x4 v = *(const f32x4*)(src + 4 * i); *(LAS f32x4*)(cst + (i >> 5) * 132 + (i & 31) * 4) = v; } }
        else { for (int i = tid; i < 4096; i += 512) *(LAS f32x4*)(cst + (i >> 5) * 132 + (i & 31) * 4) = (f32x4){0.f, 0.f, 0.f, 0.f}; }
        __syncthreads();
        const LAS float* cb = cst + (64 * (wave >> 2) + 4 * hh) * 132 + 32 * ej + n31;
#pragma unroll
        for (int i = 0; i < 2; ++i)
#pragma unroll
            for (int r = 0; r < 16; ++r) Cacc[i][r] = cb[(32 * i + (r & 3) + 8 * (r >> 2)) * 132];
        __syncthreads();
        lptr cs = lds + ML_CS + (64 * (wave >> 2) + 4 * hh) * ML_P + (32 * ej + n31) * 2;
#pragma unroll
        for (int i = 0; i < 2; ++i)
#pragma unroll
            for (int r = 0; r < 16; ++r) *(LAS unsigned short*)(cs + (32 * i + (r & 3) + 8 * (r >> 2)) * ML_P) = f2bf(Cacc[i][r]);
    }
    if (tid < 128) nvec[tid] = sample ? P.in[I_STN][((size_t)b * 4 + h) * 128 + tid] : 0.f;
    if (tid == 0) misc[0] = sample ? P.in[I_STM][b * 4 + h] : 0.f;
    u32x4 rq[2], rk[2], rv[2]; float g_ig = -INFINITY, g_lf = 0.f;
    const int prow[2] = {tid >> 4, (tid + 512) >> 4}, pch = tid & 15;
#define ML_LOAD(c) do { _Pragma("unroll") for (int i = 0; i < 2; ++i) { if (prow[i] < L) { const size_t go = (rowbase + (size_t)(c) * 64 + prow[i]) * 512 + h * 128 + pch * 8; \
            rq[i] = *(const u32x4*)(MQ + go); rk[i] = *(const u32x4*)(MK + go); rv[i] = *(const u32x4*)(MV + go); } else { rq[i] = (u32x4){0u, 0u, 0u, 0u}; rk[i] = rq[i]; rv[i] = rq[i]; } } \
        if (wave == 0) { if (lane < L) { const float* g = GT + (rowbase + (size_t)(c) * 64 + lane) * 8; g_ig = g[h]; g_lf = g[4 + h]; } else { g_ig = -INFINITY; g_lf = 0.f; } } } while (0)
    ML_LOAD(0);
    for (int c = 0; c < nch; ++c) {
        __syncthreads();
        if (wave == 0) {
            float bcum = g_lf;
#pragma unroll
            for (int o = 1; o < 64; o <<= 1) { const float v = __shfl_up(bcum, o); if (lane >= o) bcum += v; }
            const float a = g_ig - bcum; float amax = a;
#pragma unroll
            for (int o = 1; o < 64; o <<= 1) { const float v = __shfl_up(amax, o); if (lane >= o) amax = fmaxf(amax, v); }
            const float mprev = misc[0];
            const float m_t = fmaxf(bcum + mprev, bcum + amax);
            const float bL = __shfl(bcum, 63), aM = __shfl(amax, 63);
            const float m_new = fmaxf(bL + mprev, bL + aM);
            bt[lane] = bcum; as_[lane] = a; mt[lane] = m_t; winter[lane] = expf(bcum + mprev - m_t); emt[lane] = expf(-m_t); wk[lane] = expf(bL + a - m_new);
            if (lane == 0) { misc[1] = expf(bL + mprev - m_new); misc[2] = m_new; }
        }
#pragma unroll
        for (int i = 0; i < 2; ++i) { const int o = prow[i] * ML_P + pch * 16;
            *(LAS u32x4*)(lds + ML_QS + o) = rq[i]; *(LAS u32x4*)(lds + ML_KS + o) = rk[i]; *(LAS u32x4*)(lds + ML_VS + o) = rv[i]; }
        __syncthreads();
#pragma unroll
        for (int i = 0; i < 2; ++i) { const float w = wk[prow[i]]; const u32x4 v = rv[i]; u32x4 o;
            o.x = cvtpk(bflo(v.x) * w, bfhi(v.x) * w); o.y = cvtpk(bflo(v.y) * w, bfhi(v.y) * w); o.z = cvtpk(bflo(v.z) * w, bfhi(v.z) * w); o.w = cvtpk(bflo(v.w) * w, bfhi(v.w) * w);
            *(LAS u32x4*)(lds + ML_VW + prow[i] * ML_P + pch * 16) = o; }
        if (c + 1 < nch) ML_LOAD(c + 1);
        f32x16 num;
#pragma unroll
        for (int r = 0; r < 16; ++r) num[r] = 0.f;
#pragma unroll
        for (int ks = 0; ks < 8; ++ks) num = MFMA32(row_frag(lds + ML_QS, ML_P, 32 * ti, 16 * ks, lane), tr_frag(lds + ML_CS, ML_P, 16 * ks, 32 * ej, lane), num);
        if (wave < 3) {
            const int sti = wave == 0 ? 0 : 1, sj = wave == 2 ? 1 : 0;
            const int krow = (n31 & ~12) | ((n31 & 4) << 1) | ((n31 & 8) >> 1);
            f32x16 p;
#pragma unroll
            for (int r = 0; r < 16; ++r) p[r] = 0.f;
#pragma unroll
            for (int ks = 0; ks < 8; ++ks) p = MFMA32(*(const LAS bf16x8*)(lds + ML_KS + (32 * sj + krow) * ML_P + (16 * ks + 8 * hh) * 2), row_frag(lds + ML_QS, ML_P, 32 * sti, 16 * ks, lane), p);
            const int t = 32 * sti + n31; const float bt_t = bt[t], mt_t = mt[t]; float rs = 0.f;
            const LAS float* asb = as_ + 32 * sj + 8 * hh; const int tb = t - (32 * sj + 8 * hh);
#pragma unroll
            for (int r = 0; r < 16; ++r) { const int so = 16 * (r >> 3) + (r & 7);
                const float w = so <= tb ? __expf(bt_t + asb[so] - mt_t) : 0.f; p[r] *= w; rs += p[r]; }
#pragma unroll
            for (int a2 = 0; a2 < 2; ++a2) { u32x4 o; o.x = cvtpk(p[8 * a2 + 0], p[8 * a2 + 1]); o.y = cvtpk(p[8 * a2 + 2], p[8 * a2 + 3]); o.z = cvtpk(p[8 * a2 + 4], p[8 * a2 + 5]); o.w = cvtpk(p[8 * a2 + 6], p[8 * a2 + 7]);
                *(LAS u32x4*)(lds + ML_SS + t * 144 + (32 * sj + 16 * a2 + 8 * hh) * 2) = o; }
            rs += __shfl_xor(rs, 32);
            if (hh == 0) rsum[sj * 64 + t] = rs;
        }
        if (wave >= 4) {
            const int t = (tid - 256) >> 2, part = tid & 3; float s = 0.f;
#pragma unroll 8
            for (int d = 0; d < 32; ++d) s += bf2f(*(const LAS unsigned short*)(lds + ML_QS + t * ML_P + (32 * part + d) * 2)) * nvec[32 * part + d];
            s += __shfl_xor(s, 1); s += __shfl_xor(s, 2);
            if (part == 0) qn[t] = s;
        }
        __syncthreads();
        const LAS float* tb2 = sc + 32 * ti + 4 * hh;
#pragma unroll
        for (int r = 0; r < 16; ++r) num[r] *= tb2[192 + (r & 3) + 8 * (r >> 2)];
#pragma unroll
        for (int ks = 0; ks < 4; ++ks) if (ks < 2 || ti == 1) num = MFMA32(*(const LAS bf16x8*)(lds + ML_SS + (32 * ti + n31) * 144 + (16 * ks + 8 * hh) * 2), tr_frag(lds + ML_VS, ML_P, 16 * ks, 32 * ej, lane), num);
#pragma unroll
        for (int r = 0; r < 16; ++r) { const int o = (r & 3) + 8 * (r >> 2);
            const float den = tb2[192 + o] * tb2[512 + o] + tb2[384 + o] + (ti ? tb2[448 + o] : 0.f);
            const float hv = num[r] / fmaxf(fabsf(den), tb2[256 + o]);
            *(LAS unsigned short*)(lds + ML_QS + (32 * ti + 4 * hh) * ML_P + (32 * ej + n31) * 2 + o * ML_P) = f2bf(hv); }
        const float decay = misc[1];
#pragma unroll
        for (int i = 0; i < 2; ++i) { const int di = 2 * (wave >> 2) + i;
#pragma unroll
            for (int r = 0; r < 16; ++r) Cacc[i][r] *= decay;
#pragma unroll
            for (int ks = 0; ks < 4; ++ks) Cacc[i] = MFMA32(tr_frag(lds + ML_KS, ML_P, 16 * ks, 32 * di, lane), tr_frag(lds + ML_VW, ML_P, 16 * ks, 32 * ej, lane), Cacc[i]);
#pragma unroll
            for (int r = 0; r < 16; ++r) *(LAS unsigned short*)(lds + ML_CS + (64 * (wave >> 2) + 4 * hh) * ML_P + (32 * ej + n31) * 2 + (32 * i + (r & 3) + 8 * (r >> 2)) * ML_P) = f2bf(Cacc[i][r]); }
        if (tid < 128) { float s = decay * nvec[tid];
#pragma unroll 8
            for (int t = 0; t < 64; ++t) s += wk[t] * bf2f(*(const LAS unsigned short*)(lds + ML_KS + t * ML_P + tid * 2));
            nvec[tid] = s; }
        if (tid == 0) misc[0] = misc[2];
        __syncthreads();
        { const int t = tid >> 3, part = tid & 7;
          const u32x4 h0 = *(const LAS u32x4*)(lds + ML_QS + t * ML_P + part * 32), h1 = *(const LAS u32x4*)(lds + ML_QS + t * ML_P + part * 32 + 16);
          float hv[16] = {bflo(h0.x), bfhi(h0.x), bflo(h0.y), bfhi(h0.y), bflo(h0.z), bfhi(h0.z), bflo(h0.w), bfhi(h0.w), bflo(h1.x), bfhi(h1.x), bflo(h1.y), bfhi(h1.y), bflo(h1.z), bfhi(h1.z), bflo(h1.w), bfhi(h1.w)};
          float ss = 0.f;
#pragma unroll
          for (int e = 0; e < 16; ++e) ss += hv[e] * hv[e];
          ss += __shfl_xor(ss, 1); ss += __shfl_xor(ss, 2); ss += __shfl_xor(ss, 4);
          const float rstd = rsqrtf(ss * (1.f / 128.f) + EPS);
          if (t < L) {
              const size_t row = rowbase + (size_t)c * 64 + t; const int col = h * 128 + part * 16;
              const u32x4 g0 = *(const u32x4*)(MO + row * 512 + col), g1 = *(const u32x4*)(MO + row * 512 + col + 8);
              const float gv[16] = {bflo(g0.x), bfhi(g0.x), bflo(g0.y), bfhi(g0.y), bflo(g0.z), bfhi(g0.z), bflo(g0.w), bfhi(g0.w), bflo(g1.x), bfhi(g1.x), bflo(g1.y), bfhi(g1.y), bflo(g1.z), bfhi(g1.z), bflo(g1.w), bfhi(g1.w)};
              const float* mw = P.in[I_MLW] + col;
              float y[16];
#pragma unroll
              for (int e = 0; e < 16; ++e) y[e] = hv[e] * rstd * mw[e] * gv[e];
              u32x4 o0, o1; o0.x = cvtpk(y[0], y[1]); o0.y = cvtpk(y[2], y[3]); o0.z = cvtpk(y[4], y[5]); o0.w = cvtpk(y[6], y[7]); o1.x = cvtpk(y[8], y[9]); o1.y = cvtpk(y[10], y[11]); o1.z = cvtpk(y[12], y[13]); o1.w = cvtpk(y[14], y[15]);
              *(u32x4*)(YC + row * 1024 + col) = o0; *(u32x4*)(YC + row * 1024 + col + 8) = o1;
          } }
    }
#undef ML_LOAD
    __syncthreads();
    {
        LAS float* cst = (LAS float*)lds;
        int l3 = lane; asm volatile("" : "+v"(l3));
        LAS float* cb = cst + (64 * (wave >> 2) + 4 * (l3 >> 5)) * 132 + 32 * ej + (l3 & 31);
#pragma unroll
        for (int i = 0; i < 2; ++i)
#pragma unroll
            for (int r = 0; r < 16; ++r) cb[(32 * i + (r & 3) + 8 * (r >> 2)) * 132] = Cacc[i][r];
        __syncthreads();
        float* oc = P.out + (sample ? O_SC : O_PC) + ((size_t)b * 4 + h) * 16384;
        for (int i = tid; i < 4096; i += 512) *(f32x4*)(oc + 4 * i) = *(const LAS f32x4*)(cst + (i >> 5) * 132 + (i & 31) * 4);
    }
    if (tid < 128) P.out[(sample ? O_SN : O_PN) + ((size_t)b * 4 + h) * 128 + tid] = nvec[tid];
    if (tid == 0) P.out[(sample ? O_SM : O_PM) + b * 4 + h] = misc[0];
}


constexpr size_t WS_KVL = WS_H, WS_KNL = 420 * MiB, WS_CHS = 421 * MiB, WS_NST = 422 * MiB, WS_MST = 423 * MiB, WS_CST = 424 * MiB, WS_END2 = 489 * MiB;
template <int NC>
__device__ __forceinline__ void ml1_pair(const Params& P, lptr lds, int pair, int tid, int lane, int wave) {
    const int item0 = NC * pair; const int bh = item0 >> 6, c = item0 & 63, b = bh >> 2, h = bh & 3, hh = lane >> 5, n31 = lane & 31, ej = wave & 3;
    const size_t row0 = (size_t)b * SEQ + 64 * c;
    const bf16_t* MK = (const bf16_t*)(P.ws + WS_PROJ + PROJ_STRIDE); const bf16_t* MV = (const bf16_t*)(P.ws + WS_PROJ + 2 * PROJ_STRIDE); const float* GT = (const float*)(P.ws + WS_GATES);
    LAS float* wk = (LAS float*)(lds + ML_SC) + 320;
    const int prow[2] = {tid >> 4, (tid + 512) >> 4}, pch = tid & 15;
    u32x4 rk2[NC][2], rv2[NC][2]; float g_ig2[NC], g_lf2[NC];
#pragma unroll
    for (int s2 = 0; s2 < NC; ++s2) { g_ig2[s2] = 0.f; g_lf2[s2] = 0.f;
#pragma unroll
        for (int i = 0; i < 2; ++i) { const size_t go = (row0 + 64 * s2 + prow[i]) * 512 + h * 128 + pch * 8; rk2[s2][i] = *(const u32x4*)(MK + go); rv2[s2][i] = *(const u32x4*)(MV + go); }
        if (wave == 0) { const float* g = GT + (row0 + 64 * s2 + lane) * 8; g_ig2[s2] = g[h]; g_lf2[s2] = g[4 + h]; } }
#pragma unroll
    for (int s2 = 0; s2 < NC; ++s2) {
    const int item = item0 + s2; const float g_ig = g_ig2[s2], g_lf = g_lf2[s2];
    u32x4 rk[2] = {rk2[s2][0], rk2[s2][1]}, rv[2] = {rv2[s2][0], rv2[s2][1]};
    __syncthreads();
    if (wave == 0) {
        float bcum = g_lf;
#pragma unroll
        for (int o = 1; o < 64; o <<= 1) { const float v = __shfl_up(bcum, o); if (lane >= o) bcum += v; }
        const float a = g_ig - bcum; float amax = a;
#pragma unroll
        for (int o = 1; o < 64; o <<= 1) amax = fmaxf(amax, __shfl_xor(amax, o));
        const float bL = __shfl(bcum, 63);
        wk[lane] = expf(a - amax);
        if (lane == 0) { float* ch = (float*)(P.ws + WS_CHS) + (size_t)item * 4; ch[0] = bL; ch[1] = bL + amax; }
    }
#pragma unroll
    for (int i = 0; i < 2; ++i) *(LAS u32x4*)(lds + ML_KS + prow[i] * ML_P + pch * 16) = rk[i];
    __syncthreads();
#pragma unroll
    for (int i = 0; i < 2; ++i) { const float w = wk[prow[i]]; const u32x4 v = rv[i]; u32x4 o;
        o.x = cvtpk(bflo(v.x) * w, bfhi(v.x) * w); o.y = cvtpk(bflo(v.y) * w, bfhi(v.y) * w); o.z = cvtpk(bflo(v.z) * w, bfhi(v.z) * w); o.w = cvtpk(bflo(v.w) * w, bfhi(v.w) * w);
        *(LAS u32x4*)(lds + ML_VW + prow[i] * ML_P + pch * 16) = o; }
    if (tid < 128) { float s = 0.f;
#pragma unroll 8
        for (int t = 0; t < 64; ++t) s += wk[t] * bf2f(*(const LAS unsigned short*)(lds + ML_KS + t * ML_P + tid * 2));
        ((float*)(P.ws + WS_KNL))[(size_t)item * 128 + tid] = s; }
    __syncthreads();
#pragma unroll
    for (int i = 0; i < 2; ++i) { const int di = 2 * (wave >> 2) + i;
        f32x16 acc;
#pragma unroll
        for (int r = 0; r < 16; ++r) acc[r] = 0.f;
#pragma unroll
        for (int ks = 0; ks < 4; ++ks) acc = MFMA32(tr_frag(lds + ML_KS, ML_P, 16 * ks, 32 * di, lane), tr_frag(lds + ML_VW, ML_P, 16 * ks, 32 * ej, lane), acc);
#pragma unroll
        for (int r = 0; r < 16; ++r) *(LAS unsigned short*)(lds + ML_CS + (64 * (wave >> 2) + 4 * hh) * ML_P + (32 * ej + n31) * 2 + (32 * i + (r & 3) + 8 * (r >> 2)) * ML_P) = f2bf(acc[r]); }
    __syncthreads();
    bf16_t* kvl = (bf16_t*)(P.ws + WS_KVL) + (size_t)item * 16384;
#pragma unroll
    for (int i = 0; i < 4; ++i) { const int p = tid + 512 * i, row = p >> 4, ch = p & 15; *(u32x4*)(kvl + row * 128 + ch * 8) = *(const LAS u32x4*)(lds + ML_CS + row * ML_P + ch * 16); }
    }
}
__device__ __forceinline__ void ml2_scan(const Params& P, lptr lds, int tid, int job) {
    const int bh = job >> 3, part = job & 7;
    LAS float* dec = (LAS float*)lds; LAS float* scl = dec + 64; LAS float* mst = scl + 64;
    if (tid == 0) { const float* ch = (const float*)(P.ws + WS_CHS) + (size_t)bh * 64 * 4; float m = 0.f;
        for (int c = 0; c < 64; ++c) { const float bL = ch[4 * c], ml = ch[4 * c + 1], mn = fmaxf(bL + m, ml); dec[c] = expf(bL + m - mn); scl[c] = expf(ml - mn); mst[c] = m; m = mn; }
        mst[64] = m; }
    __syncthreads();
    const size_t e0 = (size_t)part * 2048 + tid * 4;
    const bf16_t* kv = (const bf16_t*)(P.ws + WS_KVL) + (size_t)bh * 64 * 16384 + e0; bf16_t* cs = (bf16_t*)(P.ws + WS_CST) + (size_t)bh * 64 * 16384 + e0;
    f32x4 C = {0.f, 0.f, 0.f, 0.f};
#pragma unroll 16
    for (int c = 0; c < 64; ++c) { const u32x2 v = *(const u32x2*)(kv + (size_t)c * 16384);
        *(u32x2*)(cs + (size_t)c * 16384) = (u32x2){cvtpk(C.x, C.y), cvtpk(C.z, C.w)};
        const f32x4 kvf = {bflo(v.x), bfhi(v.x), bflo(v.y), bfhi(v.y)};
        C = C * dec[c] + kvf * scl[c]; }
    *(f32x4*)(P.out + O_PC + (size_t)bh * 16384 + e0) = C;
    if (part == 0 && tid < 128) { float n = 0.f; const float* kn = (const float*)(P.ws + WS_KNL) + (size_t)bh * 64 * 128 + tid; float* ns = (float*)(P.ws + WS_NST) + (size_t)bh * 64 * 128 + tid;
#pragma unroll 16
        for (int c = 0; c < 64; ++c) { ns[c * 128] = n; n = n * dec[c] + kn[c * 128] * scl[c]; }
        P.out[O_PN + (size_t)bh * 128 + tid] = n; }
    if (part == 0 && tid >= 128 && tid < 192) ((float*)(P.ws + WS_MST))[bh * 64 + tid - 128] = mst[tid - 128];
    if (part == 0 && tid == 192) P.out[O_PM + bh] = mst[64];
}
struct Ml3In { u32x4 rq[2], rk[2], rv[2], rc[4], g0, g1; float g_ig, g_lf, mprev, nin; };
__device__ __forceinline__ void ml3_load(const Params& P, int item, int tid, int lane, int wave, Ml3In& L) {
    const int bh = item >> 6, c = item & 63, b = bh >> 2, h = bh & 3;
    const size_t row0 = (size_t)b * SEQ + 64 * c;
    const bf16_t* MQ = (const bf16_t*)(P.ws + WS_PROJ); const bf16_t* MK = (const bf16_t*)(P.ws + WS_PROJ + PROJ_STRIDE); const bf16_t* MV = (const bf16_t*)(P.ws + WS_PROJ + 2 * PROJ_STRIDE);
    const bf16_t* MO = (const bf16_t*)(P.ws + WS_PROJ + 3 * PROJ_STRIDE); const float* GT = (const float*)(P.ws + WS_GATES);
    const int prow[2] = {tid >> 4, (tid + 512) >> 4}, pch = tid & 15;
#pragma unroll
    for (int i = 0; i < 2; ++i) { const size_t go = (row0 + prow[i]) * 512 + h * 128 + pch * 8; L.rq[i] = *(const u32x4*)(MQ + go); L.rk[i] = *(const u32x4*)(MK + go); L.rv[i] = *(const u32x4*)(MV + go); }
    const bf16_t* cst = (const bf16_t*)(P.ws + WS_CST) + (size_t)item * 16384;
#pragma unroll
    for (int i = 0; i < 4; ++i) { const int p = tid + 512 * i; L.rc[i] = *(const u32x4*)(cst + (p >> 4) * 128 + (p & 15) * 8); }
    { const size_t row = row0 + (tid >> 3); const int col = h * 128 + (tid & 7) * 16; L.g0 = *(const u32x4*)(MO + row * 512 + col); L.g1 = *(const u32x4*)(MO + row * 512 + col + 8); }
    L.g_ig = 0.f; L.g_lf = 0.f; L.mprev = 0.f; L.nin = 0.f;
    if (wave == 0) { const float* g = GT + (row0 + lane) * 8; L.g_ig = g[h]; L.g_lf = g[4 + h]; L.mprev = ((const float*)(P.ws + WS_MST))[item]; }
    if (tid < 128) L.nin = ((const float*)(P.ws + WS_NST))[(size_t)item * 128 + tid];
}
__device__ __forceinline__ void ml3_item(const Params& P, lptr lds, int item, const Ml3In& L, int tid, int lane, int wave) {
    const int bh = item >> 6, c = item & 63, b = bh >> 2, h = bh & 3, hh = lane >> 5, n31 = lane & 31;
    const size_t row0 = (size_t)b * SEQ + 64 * c;
    bf16_t* YC = (bf16_t*)(P.ws + WS_YCAT);
    LAS float* sc = (LAS float*)(lds + ML_SC);
    LAS float* bt = sc, *as_ = sc + 64, *mt = sc + 128, *winter = sc + 192, *emt = sc + 256, *rsum = sc + 384, *qn = sc + 512, *nvec = sc + 576;
    const int ti = wave >> 2, ej = wave & 3;
    const int prow[2] = {tid >> 4, (tid + 512) >> 4}, pch = tid & 15;
    const float g_ig = L.g_ig, g_lf = L.g_lf, mprev = L.mprev, nin = L.nin;
    __syncthreads();
    if (wave == 0) {
        float bcum = g_lf;
#pragma unroll
        for (int o = 1; o < 64; o <<= 1) { const float v = __shfl_up(bcum, o); if (lane >= o) bcum += v; }
        const float a = g_ig - bcum; float amax = a;
#pragma unroll
        for (int o = 1; o < 64; o <<= 1) { const float v = __shfl_up(amax, o); if (lane >= o) amax = fmaxf(amax, v); }
        const float m_t = fmaxf(bcum + mprev, bcum + amax);
        bt[lane] = bcum; as_[lane] = a; mt[lane] = m_t; winter[lane] = expf(bcum + mprev - m_t); emt[lane] = expf(-m_t);
    }
    if (tid < 128) nvec[tid] = nin;
#pragma unroll
    for (int i = 0; i < 2; ++i) { const int o = prow[i] * ML_P + pch * 16;
        *(LAS u32x4*)(lds + ML_QS + o) = L.rq[i]; *(LAS u32x4*)(lds + ML_KS + o) = L.rk[i]; *(LAS u32x4*)(lds + ML_VS + o) = L.rv[i]; }
#pragma unroll
    for (int i = 0; i < 4; ++i) { const int p = tid + 512 * i; *(LAS u32x4*)(lds + ML_CS + (p >> 4) * ML_P + (p & 15) * 16) = L.rc[i]; }
    __syncthreads();
    f32x16 num;
#pragma unroll
    for (int r = 0; r < 16; ++r) num[r] = 0.f;
#pragma unroll
    for (int ks = 0; ks < 8; ++ks) num = MFMA32(row_frag(lds + ML_QS, ML_P, 32 * ti, 16 * ks, lane), tr_frag(lds + ML_CS, ML_P, 16 * ks, 32 * ej, lane), num);
    if (wave < 3) {
        const int sti = wave == 0 ? 0 : 1, sj = wave == 2 ? 1 : 0;
        const int krow = (n31 & ~12) | ((n31 & 4) << 1) | ((n31 & 8) >> 1);
        f32x16 p;
#pragma unroll
        for (int r = 0; r < 16; ++r) p[r] = 0.f;
#pragma unroll
        for (int ks = 0; ks < 8; ++ks) p = MFMA32(*(const LAS bf16x8*)(lds + ML_KS + (32 * sj + krow) * ML_P + (16 * ks + 8 * hh) * 2), row_frag(lds + ML_QS, ML_P, 32 * sti, 16 * ks, lane), p);
        const int t = 32 * sti + n31; const float bt_t = bt[t], mt_t = mt[t]; float rs = 0.f;
        const LAS float* asb = as_ + 32 * sj + 8 * hh; const int tb = t - (32 * sj + 8 * hh);
#pragma unroll
        for (int r = 0; r < 16; ++r) { const int so = 16 * (r >> 3) + (r & 7);
            const float w = so <= tb ? __expf(bt_t + asb[so] - mt_t) : 0.f; p[r] *= w; rs += p[r]; }
#pragma unroll
        for (int a2 = 0; a2 < 2; ++a2) { u32x4 o; o.x = cvtpk(p[8 * a2 + 0], p[8 * a2 + 1]); o.y = cvtpk(p[8 * a2 + 2], p[8 * a2 + 3]); o.z = cvtpk(p[8 * a2 + 4], p[8 * a2 + 5]); o.w = cvtpk(p[8 * a2 + 6], p[8 * a2 + 7]);
            *(LAS u32x4*)(lds + ML_SS + t * 144 + (32 * sj + 16 * a2 + 8 * hh) * 2) = o; }
        rs += __shfl_xor(rs, 32);
        if (hh == 0) rsum[sj * 64 + t] = rs;
    }
    if (wave >= 4) {
        const int t = (tid - 256) >> 2, part = tid & 3; float s = 0.f;
#pragma unroll 8
        for (int d = 0; d < 32; ++d) s += bf2f(*(const LAS unsigned short*)(lds + ML_QS + t * ML_P + (32 * part + d) * 2)) * nvec[32 * part + d];
        s += __shfl_xor(s, 1); s += __shfl_xor(s, 2);
        if (part == 0) qn[t] = s;
    }
    __syncthreads();
    const LAS float* tb2 = sc + 32 * ti + 4 * hh;
#pragma unroll
    for (int r = 0; r < 16; ++r) num[r] *= tb2[192 + (r & 3) + 8 * (r >> 2)];
#pragma unroll
    for (int ks = 0; ks < 4; ++ks) if (ks < 2 || ti == 1) num = MFMA32(*(const LAS bf16x8*)(lds + ML_SS + (32 * ti + n31) * 144 + (16 * ks + 8 * hh) * 2), tr_frag(lds + ML_VS, ML_P, 16 * ks, 32 * ej, lane), num);
#pragma unroll
    for (int r = 0; r < 16; ++r) { const int o = (r & 3) + 8 * (r >> 2);
        const float den = tb2[192 + o] * tb2[512 + o] + tb2[384 + o] + (ti ? tb2[448 + o] : 0.f);
        const float hv = num[r] / fmaxf(fabsf(den), tb2[256 + o]);
        *(LAS unsigned short*)(lds + ML_QS + (32 * ti + 4 * hh) * ML_P + (32 * ej + n31) * 2 + o * ML_P) = f2bf(hv); }
    __syncthreads();
    { const int t = tid >> 3, part = tid & 7;
      const size_t row = row0 + t; const int col = h * 128 + part * 16;
      const u32x4 g0 = L.g0, g1 = L.g1;
      const u32x4 h0 = *(const LAS u32x4*)(lds + ML_QS + t * ML_P + part * 32), h1 = *(const LAS u32x4*)(lds + ML_QS + t * ML_P + part * 32 + 16);
      float hv[16] = {bflo(h0.x), bfhi(h0.x), bflo(h0.y), bfhi(h0.y), bflo(h0.z), bfhi(h0.z), bflo(h0.w), bfhi(h0.w), bflo(h1.x), bfhi(h1.x), bflo(h1.y), bfhi(h1.y), bflo(h1.z), bfhi(h1.z), bflo(h1.w), bfhi(h1.w)};
      float ss = 0.f;
#pragma unroll
      for (int e = 0; e < 16; ++e) ss += hv[e] * hv[e];
      ss += __shfl_xor(ss, 1); ss += __shfl_xor(ss, 2); ss += __shfl_xor(ss, 4);
      const float rstd = rsqrtf(ss * (1.f / 128.f) + EPS);
      const float gv[16] = {bflo(g0.x), bfhi(g0.x), bflo(g0.y), bfhi(g0.y), bflo(g0.z), bfhi(g0.z), bflo(g0.w), bfhi(g0.w), bflo(g1.x), bfhi(g1.x), bflo(g1.y), bfhi(g1.y), bflo(g1.z), bfhi(g1.z), bflo(g1.w), bfhi(g1.w)};
      const float* mw = P.in[I_MLW] + col;
      float y[16];
#pragma unroll
      for (int e = 0; e < 16; ++e) y[e] = hv[e] * rstd * mw[e] * gv[e];
      u32x4 o0, o1; o0.x = cvtpk(y[0], y[1]); o0.y = cvtpk(y[2], y[3]); o0.z = cvtpk(y[4], y[5]); o0.w = cvtpk(y[6], y[7]); o1.x = cvtpk(y[8], y[9]); o1.y = cvtpk(y[10], y[11]); o1.z = cvtpk(y[12], y[13]); o1.w = cvtpk(y[14], y[15]);
      *(u32x4*)(YC + row * 1024 + col) = o0; *(u32x4*)(YC + row * 1024 + col + 8) = o1; }
}

constexpr int AT_KP = 144, AT_VP = 136, AT_WAVE = 64 * AT_KP + 64 * AT_VP;
__device__ __forceinline__ void sb_step(clptr Kt, clptr Vt, const bf16x8 (&qf)[4], f32x16& o0, f32x16& o1, float& carry, int lane, bool domask, int kq) {
    const int n31 = lane & 31, hh = lane >> 5;
    const int krow = (n31 & ~12) | ((n31 & 4) << 1) | ((n31 & 8) >> 1);
    f32x16 p[2];
#pragma unroll
    for (int r = 0; r < 16; ++r) { p[0][r] = 0.f; p[1][r] = 0.f; }
#pragma unroll
    for (int ks = 0; ks < 4; ++ks) {
        p[0] = MFMA32(*(const LAS bf16x8*)(Kt + krow * AT_KP + (16 * ks + 8 * hh) * 2), qf[ks], p[0]);
        p[1] = MFMA32(*(const LAS bf16x8*)(Kt + (32 + krow) * AT_KP + (16 * ks + 8 * hh) * 2), qf[ks], p[1]);
    }
    f32x16 om[2];
    float town[4], tpar[4];
#pragma unroll
    for (int u = 0; u < 2; ++u)
#pragma unroll
        for (int a = 0; a < 2; ++a) { float tp = 1.f;
#pragma unroll
            for (int j = 0; j < 8; ++j) { const int r = 8 * a + j;
                const float z = fminf(fmaxf(p[u][r], -60.f), 60.f);
                const float e = fast_exp2(-z); float sg = fast_rcp(1.f + e); float o = e * sg;
                if (domask) { const int kl = 32 * u + 16 * a + 8 * hh + j; if (kl >= kq) { sg = 0.f; o = 1.f; } }
                p[u][r] = sg; om[u][r] = o; tp *= o; }
            town[2 * u + a] = tp; }
#pragma unroll
    for (int i = 0; i < 4; ++i) tpar[i] = __shfl_xor(town[i], 32);
    float suf[5]; suf[4] = 1.f;
#pragma unroll
    for (int i = 3; i >= 0; --i) suf[i] = suf[i + 1] * (town[i] * tpar[i]);
    bf16x8 pf[4];
#pragma unroll
    for (int u = 0; u < 2; ++u)
#pragma unroll
        for (int a = 0; a < 2; ++a) { const int pr = 2 * u + a;
            float R = carry * suf[pr + 1] * (hh == 0 ? tpar[pr] : 1.f);
            float av[8];
#pragma unroll
            for (int j = 7; j >= 0; --j) { av[j] = p[u][8 * a + j] * R; R *= om[u][8 * a + j]; }
            u32x4 w; w.x = cvtpk(av[0], av[1]); w.y = cvtpk(av[2], av[3]); w.z = cvtpk(av[4], av[5]); w.w = cvtpk(av[6], av[7]);
            pf[pr] = __builtin_bit_cast(bf16x8, w); }
    carry *= suf[0];
#pragma unroll
    for (int pr = 0; pr < 4; ++pr) {
        o0 = MFMA32(tr_frag(Vt, AT_VP, 16 * pr, 0, lane), pf[pr], o0);
        o1 = MFMA32(tr_frag(Vt, AT_VP, 16 * pr, 32, lane), pf[pr], o1);
    }
}
__device__ __forceinline__ void attn_prompt_item(const Params& P, lptr lds, int b, int rb, int lane, int wave) {
    const int h = wave, n31 = lane & 31, hh = lane >> 5;
    const bf16_t* SQ = (const bf16_t*)(P.ws + WS_PROJ + 4 * PROJ_STRIDE); const bf16_t* SK = (const bf16_t*)(P.ws + WS_PROJ + 5 * PROJ_STRIDE); const bf16_t* SV = (const bf16_t*)(P.ws + WS_PROJ + 6 * PROJ_STRIDE);
    const size_t rowb = (size_t)b * SEQ; const int q0 = 32 * rb;
    lptr Kt = lds + wave * AT_WAVE; lptr Vt = Kt + 64 * AT_KP;
    bf16x8 qf[4];
#pragma unroll
    for (int ks = 0; ks < 4; ++ks) qf[ks] = *(const bf16x8*)(SQ + (rowb + q0 + n31) * 512 + h * 64 + 16 * ks + 8 * hh);
    f32x16 o0, o1;
#pragma unroll
    for (int r = 0; r < 16; ++r) { o0[r] = 0.f; o1[r] = 0.f; }
    float carry = 1.f;
    const int trow = lane >> 3, tch = lane & 7;
    u32x4 kv[8], vv[8];
    const int jt0 = (q0 + 30) >> 6;
#pragma unroll
    for (int i = 0; i < 8; ++i) { const size_t go = (rowb + 64 * jt0 + 8 * i + trow) * 512 + h * 64 + tch * 8; kv[i] = *(const u32x4*)(SK + go); vv[i] = *(const u32x4*)(SV + go); }
    for (int jt = jt0; jt >= 0; --jt) {
#pragma unroll
        for (int i = 0; i < 8; ++i) { const int row = 8 * i + trow;
            *(LAS u32x4*)(Kt + row * AT_KP + tch * 16) = kv[i];
            *(LAS u32x2*)(Vt + row * AT_VP + tch * 16) = (u32x2){vv[i].x, vv[i].y}; *(LAS u32x2*)(Vt + row * AT_VP + tch * 16 + 8) = (u32x2){vv[i].z, vv[i].w}; }
        if (jt > 0) {
#pragma unroll
            for (int i = 0; i < 8; ++i) { const size_t go = (rowb + 64 * (jt - 1) + 8 * i + trow) * 512 + h * 64 + tch * 8; kv[i] = *(const u32x4*)(SK + go); vv[i] = *(const u32x4*)(SV + go); } }
        sb_step(Kt, Vt, qf, o0, o1, carry, lane, 64 * jt + 63 >= q0, q0 + n31 - 64 * jt);
        if (__all(carry < 1e-30f)) break;
    }
    float ss = 0.f;
#pragma unroll
    for (int r = 0; r < 16; ++r) ss += o0[r] * o0[r] + o1[r] * o1[r];
    ss += __shfl_xor(ss, 32);
    const size_t row = rowb + q0 + n31;
    LAS float* sx = (LAS float*)(lds + 8 * AT_WAVE);
    if (hh == 0) sx[wave * 32 + n31] = ss;
    __syncthreads();
    float tot = 0.f;
#pragma unroll
    for (int w2 = 0; w2 < 8; ++w2) tot += sx[w2 * 32 + n31];
    const float rstd = rsqrtf(tot * (1.f / 512.f) + EPS);
    bf16_t* yo = (bf16_t*)(P.ws + WS_YCAT) + row * 1024 + 512 + h * 64 + 4 * hh;
#pragma unroll
    for (int g = 0; g < 4; ++g) {
        *(u32x2*)(yo + 8 * g) = (u32x2){cvtpk(o0[4 * g] * rstd, o0[4 * g + 1] * rstd), cvtpk(o0[4 * g + 2] * rstd, o0[4 * g + 3] * rstd)};
        *(u32x2*)(yo + 32 + 8 * g) = (u32x2){cvtpk(o1[4 * g] * rstd, o1[4 * g + 1] * rstd), cvtpk(o1[4 * g + 2] * rstd, o1[4 * g + 3] * rstd)};
    }
}
__device__ __forceinline__ void attn_sample_item(const Params& P, lptr lds, int bh, int tid, int lane, int wave) {
    const int b = bh >> 3, h = bh & 7, n31 = lane & 31, hh = lane >> 5;
    const bf16_t* SQ = (const bf16_t*)(P.ws + WS_PROJ + 4 * PROJ_STRIDE); const bf16_t* SK = (const bf16_t*)(P.ws + WS_PROJ + 5 * PROJ_STRIDE); const bf16_t* SV = (const bf16_t*)(P.ws + WS_PROJ + 6 * PROJ_STRIDE);
    const size_t rows = (size_t)MP + b * 32;
    lptr Kt = lds + wave * AT_WAVE; lptr Vt = Kt + 64 * AT_KP;
    bf16x8 qf[4];
#pragma unroll
    for (int ks = 0; ks < 4; ++ks) qf[ks] = *(const bf16x8*)(SQ + (rows + n31) * 512 + h * 64 + 16 * ks + 8 * hh);
    f32x16 o0, o1;
#pragma unroll
    for (int r = 0; r < 16; ++r) { o0[r] = 0.f; o1[r] = 0.f; }
    float carry = 1.f;
    if (wave == 7) {
        const int trow = lane >> 3, tch = lane & 7;
#pragma unroll
        for (int i = 0; i < 8; ++i) { const int row = 8 * i + trow; u32x4 kv = {0u, 0u, 0u, 0u}, vv = {0u, 0u, 0u, 0u};
            if (row < 32) { const size_t go = (rows + row) * 512 + h * 64 + tch * 8; kv = *(const u32x4*)(SK + go); vv = *(const u32x4*)(SV + go); }
            *(LAS u32x4*)(Kt + row * AT_KP + tch * 16) = kv;
            *(LAS u32x2*)(Vt + row * AT_VP + tch * 16) = (u32x2){vv.x, vv.y}; *(LAS u32x2*)(Vt + row * AT_VP + tch * 16 + 8) = (u32x2){vv.z, vv.w}; }
        sb_step(Kt, Vt, qf, o0, o1, carry, lane, true, n31);
    }
    const float* CK = P.in[I_CK] + (size_t)b * PAST * 512 + h * 64; const float* CV = P.in[I_CV] + (size_t)b * PAST * 512 + h * 64;
    for (int jt = 4 * wave + 3; jt >= 4 * wave; --jt) {
        const int trow = lane >> 4, c4 = lane & 15;
#pragma unroll
        for (int i = 0; i < 16; ++i) { const int row = 4 * i + trow; const size_t go = (size_t)(64 * jt + row) * 512 + c4 * 4;
            const f32x4 kx = *(const f32x4*)(CK + go), vx = *(const f32x4*)(CV + go);
            *(LAS u32x2*)(Kt + row * AT_KP + c4 * 8) = (u32x2){cvtpk(kx.x, kx.y), cvtpk(kx.z, kx.w)};
            *(LAS u32x2*)(Vt + row * AT_VP + c4 * 8) = (u32x2){cvtpk(vx.x, vx.y), cvtpk(vx.z, vx.w)}; }
        sb_step(Kt, Vt, qf, o0, o1, carry, lane, false, 0);
    }
    __syncthreads();
    LAS float* carr = (LAS float*)(lds + 65536);
    if (hh == 0) carr[wave * 32 + n31] = carry;
    __syncthreads();
    float mult = 1.f;
    for (int w2 = wave + 1; w2 < 8; ++w2) mult *= carr[w2 * 32 + n31];
#pragma unroll
    for (int g = 0; g < 4; ++g) {
        *(LAS f32x4*)(lds + (((wave * 8 + g) * 64 + lane) * 16)) = (f32x4){o0[4 * g] * mult, o0[4 * g + 1] * mult, o0[4 * g + 2] * mult, o0[4 * g + 3] * mult};
        *(LAS f32x4*)(lds + (((wave * 8 + 4 + g) * 64 + lane) * 16)) = (f32x4){o1[4 * g] * mult, o1[4 * g + 1] * mult, o1[4 * g + 2] * mult, o1[4 * g + 3] * mult};
    }
    __syncthreads();
    { const int q = tid >> 4, part = tid & 15; const int slot = (part >> 3) * 4 + ((part & 7) >> 1), ln = q + 32 * (part & 1);
      f32x4 v = {0.f, 0.f, 0.f, 0.f};
#pragma unroll
      for (int w2 = 0; w2 < 8; ++w2) v = v + *(const LAS f32x4*)(lds + (((w2 * 8 + slot) * 64 + ln) * 16));
      float ss = (v.x * v.x + v.y * v.y) + (v.z * v.z + v.w * v.w);
      ss += __shfl_xor(ss, 1); ss += __shfl_xor(ss, 2); ss += __shfl_xor(ss, 4); ss += __shfl_xor(ss, 8);
      const size_t row = rows + q;
      if (part == 0) ((float*)(P.ws + WS_SSQ))[row * 8 + h] = ss;
      *(u32x2*)((bf16_t*)(P.ws + WS_YCAT) + row * 1024 + 512 + h * 64 + part * 4) = (u32x2){cvtpk(v.x, v.y), cvtpk(v.z, v.w)}; }
    __syncthreads();
}
#ifndef M1NC
#define M1NC 2
#endif
constexpr int NQ_G1S = 224, NQ_AT = 1024, NQ_M1 = 2048 / M1NC, NQ_TOTAL = NQ_G1S + NQ_AT + NQ_M1;
template <class EpiS>
__device__ __forceinline__ void phase_mixers(const Params& P, lptr lds, int tid_in, int wave, const EpiS& Es) {
    unsigned* ctr = (unsigned*)(P.ws + WS_CTL);
    for (;;) {
        __syncthreads();
        if (tid_in == 0) *(LAS int*)(lds + QOFF) = (int)atomicAdd(ctr, 1u);
        __syncthreads();
        int item = *(const LAS int*)(lds + QOFF);
        int tid = tid_in; asm volatile("" : "+v"(tid));
        const int lane = tid & 63;
        if (item >= NQ_TOTAL) break;
        if (item < NQ_G1S) { small_tile<1024, false>((const bf16_t*)(P.ws + WS_H) + (size_t)MP * 1024, (const bf16_t*)(P.ws + WS_W1T), Es, nullptr, lds, item, tid, lane, wave); continue; }
        item -= NQ_G1S;
        if (item < NQ_AT) { attn_prompt_item(P, lds, item & 7, 127 - (item >> 3), lane, wave); continue; }
        item -= NQ_AT;
        ml1_pair<M1NC>(P, lds, item, tid, lane, wave);
    }
}
__device__ __forceinline__ void phase_ml2(const Params& P, lptr lds, int tid_in, int wave) {
    int tid = tid_in; asm volatile("" : "+v"(tid));
    if (blockIdx.x < 160) { for (int job = blockIdx.x; job < 256; job += 160) { __syncthreads(); ml2_scan(P, lds, tid, job); } }
    else if (blockIdx.x < 192) mlstm_item(P, lds, blockIdx.x - 160, true, tid, tid & 63, wave);
    else attn_sample_item(P, lds, blockIdx.x - 192, tid, tid & 63, wave);
}
template <class EpiS>
__device__ __forceinline__ void phase_ml3(const Params& P, lptr lds, int tid_in, int wave, const EpiS& Es) {
    if (blockIdx.x >= 192) { int tid = tid_in; asm volatile("" : "+v"(tid));
        small_tile<1024, true>((const bf16_t*)(P.ws + WS_YCAT) + (size_t)MP * 1024, (const bf16_t*)(P.ws + WS_W2T), Es, (const float*)(P.ws + WS_SSQ), lds, blockIdx.x - 192, tid, tid & 63, wave); }
#ifdef DBL_M3
    for (int rep = 0; rep < 2; ++rep)
#endif
    { int tid = tid_in; asm volatile("" : "+v"(tid));
      Ml3In cur, nxt; ml3_load(P, blockIdx.x, tid, tid & 63, wave, cur);
#pragma unroll 1
      for (int item = blockIdx.x; item < 2048; item += gridDim.x) {
          const int nitem = item + gridDim.x;
          if (nitem < 2048) ml3_load(P, nitem, tid, tid & 63, wave, nxt);
          ml3_item(P, lds, item, cur, tid, tid & 63, wave);
          cur = nxt;
      } }
}

__global__ void __launch_bounds__(512, 2) fwd(Params P) {
    extern __shared__ __attribute__((aligned(16))) unsigned char lds_raw[];
    lptr lds = (lptr)lds_raw;
    cg::grid_group grid = cg::this_grid();
    int tid = threadIdx.x, lane = tid & 63; const int wave = __builtin_amdgcn_readfirstlane(tid >> 6);
#define FRESH_TID() do { asm volatile("" : "+v"(tid)); lane = tid & 63; } while (0)
    const int gw = blockIdx.x * 8 + wave, NGW = gridDim.x * 8;
    unsigned char* ws = P.ws;
    const float* MOD = (const float*)(ws + WS_MOD);
    bf16_t* H = (bf16_t*)(ws + WS_H); bf16_t* PROJ = (bf16_t*)(ws + WS_PROJ); bf16_t* YC = (bf16_t*)(ws + WS_YCAT); bf16_t* ACT = (bf16_t*)(ws + WS_ACT);

#ifndef G_ALIGN
#define G_ALIGN true
#endif
#ifndef G_SP2
#define G_SP2 true
#endif
#ifndef PH
#define PH 0xFFFF
#endif
    if (tid == 0) { *(LAS unsigned*)(lds + LDS_BYTES - 32) = 0u; *(LAS unsigned*)(lds + LDS_BYTES - 28) = 0u; }
    __syncthreads();
    const XcdBarrier bar = xcd_barrier_post((unsigned*)(ws + WS_CTL) + 1024, (volatile LAS unsigned*)(lds + LDS_BYTES - 32));
    if (P.out == nullptr) grid.sync();
    phase0(P, lds, tid, lane, wave);
#ifdef DBL_P0
    __syncthreads(); phase0(P, lds, tid, lane, wave);
#endif
    xcd_barrier(bar);
    FRESH_TID();
    phase1(P, lds, tid, lane, wave);
    __syncthreads();
    phase_weights(P, lds, lane, wave);
#ifdef DBL_P1
    __syncthreads(); phase1(P, lds, tid, lane, wave);
#endif
#ifdef DBL_P1NG
    __syncthreads(); phase1_nogates(P, lds, tid, lane, wave);
#endif
#ifdef DBL_W
    __syncthreads(); phase_weights(P, lds, lane, wave);
#endif
    xcd_barrier(bar);
    FRESH_TID();
    {
        EpiProj E{PROJ, P.out + O_PK, P.out + O_PV, P.in[I_SQW], P.in[I_SKW], 0};
        pg8::Gemm g{H, (const bf16_t*)(ws + WS_W1T), MP, NPROJ, 1024}; pg8::StaticOrder S; S.init(MP, NPROJ, gridDim.x, (int)blockIdx.x);
        pg8::gemm_phase<EpiProj, pg8::StaticOrder, G_ALIGN, G_SP2>(lds, g, S, E);
#ifdef DBL_G
        pg8::gemm_phase<EpiProj, pg8::StaticOrder, G_ALIGN, G_SP2>(lds, g, S, E);
#endif
    }
    xcd_barrier(bar);
    FRESH_TID();
    {
        EpiProj Es{PROJ, P.out + O_SK, P.out + O_SV, P.in[I_SQW], P.in[I_SKW], MP};
        phase_mixers(P, lds, tid, wave, Es);
    }
    xcd_barrier(bar);
    FRESH_TID();
    phase_ml2(P, lds, tid, wave);
#ifdef DBL_M2
    __syncthreads(); phase_ml2(P, lds, tid, wave);
#endif
    xcd_barrier(bar);
    FRESH_TID();
    {
        EpiRes<0> Es{P.in[I_XS], (bf16_t*)(ws + WS_X1B) + (size_t)MP * 1024, MOD + 8 * 6144 + 2048, 5};
        phase_ml3(P, lds, tid, wave, Es);
    }
#ifdef XSYNC
    for (int i = 0; i < XSYNC; ++i) xcd_barrier(bar);
#endif
    xcd_barrier(bar);
    FRESH_TID();
    {
        sample_h2_row(P, lds, tid, lane, wave);
        EpiRes<0> E{P.in[I_XP], ws + WS_X1B, MOD + 2048, 12};
        pg8::Gemm g{YC, (const bf16_t*)(ws + WS_W2T), MP, 1024, 1024}; pg8::StaticOrder S; S.init(MP, 1024, gridDim.x, (int)blockIdx.x);
        pg8::gemm_phase<EpiRes<0>, pg8::StaticOrder, G_ALIGN, G_SP2>(lds, g, S, E);
    }
    xcd_barrier(bar);
    FRESH_TID();
    {
        phase5(P, lds, tid, lane, wave);
#ifdef DBL_P5
        phase5(P, lds, tid, lane, wave);
#endif
        EpiFFNs Es{ACT, P.out + O_SF, P.in[I_SFC], P.in[I_WCONV], P.in[I_BCONV]};
        for (int t = blockIdx.x; t < 352; t += gridDim.x) small_tile<1024, false>(H + (size_t)MP * 1024, (const bf16_t*)(ws + WS_W3T), Es, nullptr, lds, t, tid, lane, wave);
    }
    xcd_barrier(bar);
    FRESH_TID();
    {
        EpiFFN E{ACT, (float*)(ws + WS_UEDGE), P.out + O_PF, P.in[I_WCONV], P.in[I_BCONV]};
        pg8::Gemm g{H, (const bf16_t*)(ws + WS_W3T), MP, FF2, 1024}; pg8::StaticOrder S; S.init(MP, FF2, gridDim.x, (int)blockIdx.x);
        pg8::gemm_phase<EpiFFN, pg8::StaticOrder, true, G_SP2>(lds, g, S, E);
#ifdef DBL_G
        pg8::gemm_phase<EpiFFN, pg8::StaticOrder, true, G_SP2>(lds, g, S, E);
#endif
    }
    xcd_barrier(bar);
    FRESH_TID();
    {
        phase_fix(P, tid);
        EpiRes<1> Es{(const bf16_t*)(ws + WS_X1B) + (size_t)MP * 1024, P.out + O_YS, MOD + 8 * 6144 + 5120, 5};
        if (blockIdx.x < 64) small_tile<FF, false>(ACT + (size_t)MP * FF, (const bf16_t*)(ws + WS_W4T), Es, nullptr, lds, blockIdx.x, tid, lane, wave);
    }
    xcd_barrier(bar);
    FRESH_TID();
    {
        EpiRes<1> E{ws + WS_X1B, P.out + O_YP, MOD + 5120, 12};
        pg8::Gemm g{ACT, (const bf16_t*)(ws + WS_W4T), MP, 1024, FF}; pg8::StaticOrder S; S.init(MP, 1024, gridDim.x, (int)blockIdx.x);
        pg8::gemm_phase<EpiRes<1>, pg8::StaticOrder, G_ALIGN, G_SP2>(lds, g, S, E);
    }

#ifdef DIAG
    xcd_barrier(bar);
    {
        const size_t offs[15] = {O_YP, O_YS, O_PC, O_PN, O_PM, O_PK, O_PV, O_PF, O_SC, O_SN, O_SM, O_SK, O_SV, O_SF, O_END};
        for (int o = 0; o < 14; ++o) if ((DIAG >> o) & 1) for (size_t i = offs[o] + (size_t)blockIdx.x * 512 + tid; i < offs[o + 1]; i += (size_t)gridDim.x * 512) P.out[i] *= 1.2f;
    }
#endif
}

extern "C" void kernel_launch(void* const* d_in, const int* in_sizes, int n_in, void* d_out, int out_size, void* d_ws, size_t ws_size, hipStream_t stream) {
    static int grid_blocks = 0;
    if (!grid_blocks) {
        int dev = 0, cus = 0, per_cu = 0;
        (void)hipGetDevice(&dev);
        (void)hipDeviceGetAttribute(&cus, hipDeviceAttributeMultiprocessorCount, dev);
        (void)hipFuncSetAttribute((const void*)fwd, hipFuncAttributeMaxDynamicSharedMemorySize, LDS_BYTES);
        (void)hipOccupancyMaxActiveBlocksPerMultiprocessor(&per_cu, (const void*)fwd, 512, LDS_BYTES);
        grid_blocks = cus;
        if (n_in != 26 || out_size != (int)O_END || ws_size < WS_END2 || cus != 256 || per_cu < 1) {
            fprintf(stderr, "kernel_launch: unexpected geometry: n_in %d out %d ws %zu cus %d per_cu %d\n", n_in, out_size, ws_size, cus, per_cu);
            if (n_in != 26 || out_size != (int)O_END || ws_size < WS_END2 || cus != 256) grid_blocks = -1;
        }
    }
    if (grid_blocks < 0) return;
    if (hipMemsetAsync((char*)d_ws + WS_CTL, 0, WS_MOD + 16 * 6144 * 4, stream) != hipSuccess) { fprintf(stderr, "kernel_launch: memset of the control words failed\n"); return; }
    Params p{};
    for (int i = 0; i < 26; ++i) p.in[i] = (const float*)d_in[i];
    p.out = (float*)d_out; p.ws = (unsigned char*)d_ws;
    void* args[] = {&p};
    hipError_t e = hipLaunchCooperativeKernel((const void*)fwd, dim3(grid_blocks), dim3(512), args, LDS_BYTES, stream);
    if (e != hipSuccess) fprintf(stderr, "cooperative launch failed: %s (grid %d)\n", hipGetErrorString(e), grid_blocks);
}
```

```cpp
#include <hip/hip_runtime.h>
#include <hip/hip_cooperative_groups.h>
#include <cstdio>
#include <cstdint>
namespace cg = cooperative_groups;

#define LAS __attribute__((address_space(3)))
typedef unsigned short bf16_t;
typedef short bf16x8 __attribute__((ext_vector_type(8)));
typedef short s16x4 __attribute__((ext_vector_type(4)));
typedef float f32x2 __attribute__((ext_vector_type(2)));
typedef float f32x4 __attribute__((ext_vector_type(4)));
typedef float f32x16 __attribute__((ext_vector_type(16)));
typedef unsigned u32x2 __attribute__((ext_vector_type(2)));
typedef unsigned u32x4 __attribute__((ext_vector_type(4)));
typedef __bf16 bf16x2_t __attribute__((ext_vector_type(2)));
typedef LAS unsigned char* lptr;
typedef const LAS unsigned char* clptr;

constexpr int DM = 1024, SEQ = 4096, NB = 8, MP = NB * SEQ, DEC = 32, MS = NB * DEC, MT = MP + MS, PAST = 2048;
constexpr int DIN = 3592, NPROJ = 3584, FF = 2816, FF2 = 5632;
constexpr float EPS = 1e-6f;
constexpr float LOG2E = 1.4426950408889634f;
constexpr size_t O_YP = 0, O_YS = 33554432, O_PC = 33816576, O_PN = 34340864, O_PM = 34344960, O_PK = 34344992, O_PV = 51122208,
                 O_PF = 67899424, O_SC = 67989536, O_SN = 68513824, O_SM = 68517920, O_SK = 68517952, O_SV = 68649024, O_SF = 68780096, O_END = 68870208;
constexpr size_t MiB = 1u << 20;
constexpr size_t WS_CTL = 0, WS_MODP = 1 * MiB  , WS_MOD = 65536  , WS_GATES = 8 * MiB, WS_SSQ = 10 * MiB, WS_UEDGE = 12 * MiB,
                 WS_W1T = 24 * MiB, WS_W2T = 31 * MiB, WS_W3T = 33 * MiB, WS_W4T = 44 * MiB, WS_H = 52 * MiB, WS_PROJ = 120 * MiB,
                 PROJ_STRIDE = 33 * MiB, WS_YCAT = 352 * MiB, WS_ACT = 120 * MiB, WS_END = 420 * MiB;
constexpr size_t WS_X1B = 424 * MiB;
constexpr int LDS_BYTES = 147456;
constexpr int QOFF = LDS_BYTES - 64;

struct Params { const float* in[26]; float* out; unsigned char* ws; };
enum { I_XP = 0, I_XS, I_CP, I_CS, I_STC, I_STN, I_STM, I_CK, I_CV, I_SFC, I_WADA, I_BADA, I_N1W, I_WIN, I_BIG, I_BFG, I_MLW, I_SQW, I_SKW, I_SOW,
       I_WOUT, I_N2W, I_WUP, I_WCONV, I_BCONV, I_WDOWN };

__device__ __forceinline__ unsigned cvtpk(float lo, float hi) { f32x2 v = {lo, hi}; bf16x2_t b = __builtin_convertvector(v, bf16x2_t); return __builtin_bit_cast(unsigned, b); }
__device__ __forceinline__ float bf2f(unsigned short x) { return __uint_as_float((unsigned)x << 16); }
__device__ __forceinline__ float bflo(unsigned w) { return __uint_as_float(w << 16); }
__device__ __forceinline__ float bfhi(unsigned w) { return __uint_as_float(w & 0xffff0000u); }
__device__ __forceinline__ unsigned short f2bf(float f) { return (unsigned short)(cvtpk(f, 0.f) & 0xffffu); }
__device__ __forceinline__ float wave_sum(float v) {
#pragma unroll
    for (int o = 1; o < 64; o <<= 1) v += __shfl_xor(v, o);
    return v;
}
__device__ __forceinline__ float fast_exp2(float x) { return __builtin_amdgcn_exp2f(x); }
__device__ __forceinline__ float fast_rcp(float x) { return __builtin_amdgcn_rcpf(x); }
__device__ __forceinline__ float sigmoidf_(float x) { return fast_rcp(1.f + fast_exp2(-x * LOG2E)); }
__device__ __forceinline__ int crow(int r, int hi) { return (r & 3) + 8 * (r >> 2) + 4 * hi; }
typedef short v4i16_t __attribute__((ext_vector_type(4)));
__device__ __forceinline__ s16x4 tr_read(clptr p) { return __builtin_bit_cast(s16x4, __builtin_amdgcn_ds_read_tr16_b64_v4i16((LAS v4i16_t*)p)); }
__device__ __forceinline__ bf16x8 tr_frag(clptr base, int P, int R0, int C0, int lane) {
    const int h = lane >> 5, blk = (lane >> 4) & 1, q = (lane & 15) >> 2, p = lane & 3;
    clptr a = base + (R0 + 8 * h + q) * P + (C0 + 16 * blk + 4 * p) * 2;
    const s16x4 lo = tr_read(a), hi = tr_read(a + 4 * P);
    return (bf16x8){lo[0], lo[1], lo[2], lo[3], hi[0], hi[1], hi[2], hi[3]};
}
__device__ __forceinline__ bf16x8 row_frag(clptr base, int P, int R0, int K0, int lane) {
    return *(const LAS bf16x8*)(base + (R0 + (lane & 31)) * P + (K0 + 8 * (lane >> 5)) * 2);
}
#define MFMA32(a, b, c) __builtin_amdgcn_mfma_f32_32x32x16_bf16((a), (b), (c), 0, 0, 0)
#define MFMA16(a, b, c) __builtin_amdgcn_mfma_f32_16x16x32_bf16((a), (b), (c), 0, 0, 0)

namespace pg8 {
#define PG8_LAS __attribute__((address_space(3)))
typedef unsigned short bf16_t;
typedef short bf16x8 __attribute__((ext_vector_type(8)));
typedef float f32x4 __attribute__((ext_vector_type(4)));
typedef unsigned u32x4 __attribute__((ext_vector_type(4)));
constexpr int BM = 256, BK = 64, HALF = 128, HTB = HALF * BK * 2  , STAGE_BYTES = 8 * HTB, NXCD = 8, WGM = 8;

__host__ __device__ __forceinline__ int lds_byte(int r, int c) { const int st = (r >> 4) * 2 + (c >> 5), rr = r & 15, cc = c & 31, ob = rr * 64 + cc * 2; return st * 1024 + (ob ^ (((ob >> 9) & 1) << 5)); }
__host__ __device__ __forceinline__ void stage_rc(int b, int& R, int& C) { const int st = b / 1024, sb = b % 1024, swz = sb ^ (((sb >> 9) & 1) << 5); R = (st >> 1) * 16 + swz / 64; C = (st & 1) * 32 + (swz % 64) / 2; }
__host__ __device__ __forceinline__ int perm32(int rho) { const int n = rho >> 4, i = rho & 15; return 8 * (i >> 2) + 4 * n + (i & 3); }

struct Unit { int pm, pn; };
struct Gemm { const bf16_t* A; const bf16_t* Bt; int M, N, K; };

struct StaticOrder {
    int nM, nN, nwg, G, c;
    __host__ __device__ void init(int M, int N, int G_, int c_) { nM = M / BM; nN = N / BM; nwg = nM * nN; G = G_; c = c_; }
    __host__ __device__ bool next(int i, Unit& u) const {
        const long L = (long)i * G + c; if (L >= nwg) return false;
        int wgid = (int)L; { const int q = nwg / NXCD, r = nwg % NXCD, xcd = wgid % NXCD, off = wgid / NXCD; wgid = (xcd < r ? xcd * (q + 1) : r * (q + 1) + (xcd - r) * q) + off; }
        const int nig = WGM * nN, gid = wgid / nig, fm = gid * WGM, gsz = (nM - fm) < WGM ? (nM - fm) : WGM;
        u.pm = fm + ((wgid % nig) % gsz); u.pn = (wgid % nig) / gsz; return true;
    }
    __device__ __forceinline__ void a_ready(const Unit&) const {}
    __device__ __forceinline__ void done(const Unit&) const {}
};

template <class Epi, class Sched, bool ALIGN_EPI = false, bool SP2 = false>
__device__ __forceinline__ void gemm_phase(PG8_LAS unsigned char* lds, const Gemm g, const Sched& S, const Epi& E) {
    int tid_o = threadIdx.x; asm volatile("" : "+v"(tid_o));
    const int tid = tid_o, wid = __builtin_amdgcn_readfirstlane(tid >> 6), lane = tid & 63, wr = wid >> 2, wc = wid & 3, fr = lane & 15, fq = lane >> 4;
    const int K = g.K, nt = K / BK;
    unsigned voffA[2], voffB[2];
#pragma unroll
    for (int i = 0; i < 2; ++i) { int R, C; stage_rc(tid * 16 + i * 8192, R, C); const int Rb = Epi::PERM ? ((R & ~31) + perm32(R & 31)) : R;
        voffA[i] = (unsigned)(R * K + C) * 2u; voffB[i] = (unsigned)(Rb * K + C) * 2u; }
    const size_t kstep = (size_t)(BK * 2);
    const size_t hstep = (size_t)HALF * K * 2;
    const size_t tstep = 2 * hstep;
    const unsigned ldsw = (unsigned)wid * 1024u;
    const int aoff = lds_byte(wr * 64 + fr, fq * 8), boff = lds_byte(wc * 32 + fr, fq * 8);
#define PG8_SA(b, h) (((b) * 2 + (h)) * HTB)
#define PG8_SB(b, h) ((4 + (b) * 2 + (h)) * HTB)
#define PG8_STAGE(bufoff, gbase, voff) do { _Pragma("unroll") for (int _i = 0; _i < 2; ++_i) \
        __builtin_amdgcn_global_load_lds((const unsigned*)((const char*)(gbase) + (voff)[_i]), (PG8_LAS unsigned*)(lds + (bufoff) + ldsw + _i * 8192), 16, 0, 0); } while (0)
#define PG8_LDA(dst, b, h) do { _Pragma("unroll") for (int m = 0; m < 4; ++m) _Pragma("unroll") for (int k = 0; k < 2; ++k) dst[m][k] = *(const PG8_LAS bf16x8*)(lds + PG8_SA(b, h) + aoff + m * 2048 + k * 1024); } while (0)
#define PG8_LDB(dst, b, h) do { _Pragma("unroll") for (int n = 0; n < 2; ++n) _Pragma("unroll") for (int k = 0; k < 2; ++k) dst[n][k] = *(const PG8_LAS bf16x8*)(lds + PG8_SB(b, h) + boff + n * 2048 + k * 1024); } while (0)
#define PG8_MMA(ai, bj, At, Bt) do { __builtin_amdgcn_s_setprio(1); _Pragma("unroll") for (int m = 0; m < 4; ++m) _Pragma("unroll") for (int n = 0; n < 2; ++n) _Pragma("unroll") for (int k = 0; k < 2; ++k) \
        acc[ai][bj][m][n] = __builtin_amdgcn_mfma_f32_16x16x32_bf16(Bt[n][k], At[m][k], acc[ai][bj][m][n], 0, 0, 0); __builtin_amdgcn_s_setprio(0); } while (0)
#define PG8_WAIT_V(n) asm volatile("s_waitcnt vmcnt(" #n ")" ::: "memory")
#define PG8_WAIT_L(n) asm volatile("s_waitcnt lgkmcnt(" #n ")" ::: "memory")
#define PG8_BAR __builtin_amdgcn_s_barrier()
#define PG8_SCHED __builtin_amdgcn_sched_barrier(0)
    Unit cur, nxt; int ui = 0;
    if (!S.next(0, cur)) return;
    f32x4 acc[2][2][4][2];
#pragma unroll
    for (int a = 0; a < 2; ++a)
#pragma unroll
        for (int b = 0; b < 2; ++b)
#pragma unroll
            for (int m = 0; m < 4; ++m)
#pragma unroll
                for (int n = 0; n < 2; ++n) acc[a][b][m][n] = (f32x4){0.f, 0.f, 0.f, 0.f};
    bf16x8 At[4][2], B0[2][2], B1[2][2];
    const char* cA = (const char*)g.A + (size_t)cur.pm * tstep; const char* cB = (const char*)g.Bt + (size_t)cur.pn * tstep;
    S.a_ready(cur);
    if constexpr (SP2) {
        PG8_STAGE(PG8_SB(0, 0), cB, voffB); PG8_STAGE(PG8_SB(0, 1), cB + hstep, voffB); PG8_STAGE(PG8_SA(0, 0), cA, voffA); PG8_STAGE(PG8_SA(0, 1), cA + hstep, voffA);
        if (wr == 1) PG8_BAR;
        PG8_WAIT_V(2); PG8_BAR;
        PG8_STAGE(PG8_SB(1, 0), cB + kstep, voffB); PG8_STAGE(PG8_SA(1, 0), cA + kstep, voffA); PG8_STAGE(PG8_SB(1, 1), cB + hstep + kstep, voffB);
        PG8_WAIT_V(6); PG8_BAR;
    } else {
        PG8_STAGE(PG8_SB(0, 0), cB, voffB); PG8_STAGE(PG8_SA(0, 0), cA, voffA); PG8_STAGE(PG8_SB(0, 1), cB + hstep, voffB); PG8_STAGE(PG8_SA(0, 1), cA + hstep, voffA);
        if (wr == 1) PG8_BAR;
        PG8_WAIT_V(4); PG8_BAR;
        PG8_STAGE(PG8_SB(1, 0), cB + kstep, voffB); PG8_STAGE(PG8_SA(1, 0), cA + kstep, voffA); PG8_STAGE(PG8_SB(1, 1), cB + hstep + kstep, voffB);
        PG8_WAIT_V(6); PG8_BAR;
    }
    for (;;) {
        const bool has_next = S.next(ui + 1, nxt);
        const char* nA = has_next ? (const char*)g.A + (size_t)nxt.pm * tstep : cA; const char* nB = has_next ? (const char*)g.Bt + (size_t)nxt.pn * tstep : cB;
        for (int t = 0; t < nt; t += 2) {
            const bool last = (t == nt - 2);
            const char* a1 = cA + (size_t)(t + 1) * kstep;
            const char* a2 = last ? nA : cA + (size_t)(t + 2) * kstep; const char* b2 = last ? nB : cB + (size_t)(t + 2) * kstep;
            const char* a3 = a2 + kstep; const char* b3 = b2 + kstep;
            if (last && has_next) S.a_ready(nxt);
            if constexpr (SP2) {
            PG8_LDB(B0, 0, 0); PG8_LDB(B1, 0, 1); PG8_SCHED; PG8_LDA(At, 0, 0); PG8_STAGE(PG8_SA(1, 1), a1 + hstep, voffA);
            PG8_WAIT_V(8); PG8_WAIT_L(0); PG8_BAR; PG8_MMA(0, 0, At, B0); PG8_MMA(0, 1, At, B1); PG8_BAR; PG8_SCHED;
            PG8_LDA(At, 0, 1); PG8_STAGE(PG8_SB(0, 0), b2, voffB); PG8_STAGE(PG8_SB(0, 1), b2 + hstep, voffB); PG8_STAGE(PG8_SA(0, 0), a2, voffA);
            PG8_WAIT_V(8); PG8_WAIT_L(0); PG8_BAR; PG8_MMA(1, 0, At, B0); PG8_MMA(1, 1, At, B1); PG8_BAR; PG8_SCHED;
            PG8_LDB(B0, 1, 0); PG8_LDB(B1, 1, 1); PG8_SCHED; PG8_LDA(At, 1, 0); PG8_STAGE(PG8_SA(0, 1), a2 + hstep, voffA);
            PG8_WAIT_V(8); PG8_WAIT_L(0); PG8_BAR; PG8_MMA(0, 0, At, B0); PG8_MMA(0, 1, At, B1); PG8_BAR; PG8_SCHED;
            PG8_LDA(At, 1, 1); PG8_STAGE(PG8_SB(1, 0), b3, voffB); PG8_STAGE(PG8_SB(1, 1), b3 + hstep, voffB); PG8_STAGE(PG8_SA(1, 0), a3, voffA);
            PG8_WAIT_V(8); PG8_WAIT_L(0); PG8_BAR; PG8_MMA(1, 0, At, B0); PG8_MMA(1, 1, At, B1); PG8_BAR; PG8_SCHED;
            } else {
            PG8_LDB(B0, 0, 0); PG8_SCHED; PG8_LDA(At, 0, 0); PG8_STAGE(PG8_SA(1, 1), a1 + hstep, voffA);
            PG8_WAIT_L(8); PG8_BAR; PG8_WAIT_L(0); PG8_MMA(0, 0, At, B0); PG8_BAR; PG8_SCHED;
            PG8_LDB(B1, 0, 1); PG8_STAGE(PG8_SB(0, 0), b2, voffB);
            PG8_BAR; PG8_WAIT_L(0); PG8_MMA(0, 1, At, B1); PG8_BAR;
            PG8_LDA(At, 0, 1); PG8_STAGE(PG8_SA(0, 0), a2, voffA);
            PG8_BAR; PG8_WAIT_L(0); PG8_MMA(1, 0, At, B0); PG8_BAR; PG8_SCHED;
            PG8_STAGE(PG8_SB(0, 1), b2 + hstep, voffB);
            PG8_WAIT_V(6); PG8_BAR; PG8_MMA(1, 1, At, B1); PG8_BAR;
            PG8_LDB(B0, 1, 0); PG8_SCHED; PG8_LDA(At, 1, 0); PG8_STAGE(PG8_SA(0, 1), a2 + hstep, voffA);
            PG8_WAIT_L(8); PG8_BAR; PG8_WAIT_L(0); PG8_MMA(0, 0, At, B0); PG8_BAR; PG8_SCHED;
            PG8_LDB(B1, 1, 1); PG8_STAGE(PG8_SB(1, 0), b3, voffB);
            PG8_BAR; PG8_WAIT_L(0); PG8_MMA(0, 1, At, B1); PG8_BAR;
            PG8_LDA(At, 1, 1); PG8_STAGE(PG8_SA(1, 0), a3, voffA);
            PG8_BAR; PG8_WAIT_L(0); PG8_MMA(1, 0, At, B0); PG8_BAR; PG8_SCHED;
            PG8_STAGE(PG8_SB(1, 1), b3 + hstep, voffB);
            PG8_WAIT_V(6); PG8_BAR; PG8_MMA(1, 1, At, B1); PG8_BAR;
            }
        }
        if constexpr (ALIGN_EPI) { if (wr == 0) PG8_BAR; }
        if constexpr (!Epi::AFTER_DRAIN) { E(acc, cur, wr, wc, fr, fq, lds); S.done(cur); }
        if (!has_next) break;
#pragma unroll
        for (int a = 0; a < 2; ++a)
#pragma unroll
            for (int b = 0; b < 2; ++b)
#pragma unroll
                for (int m = 0; m < 4; ++m)
#pragma unroll
                    for (int n = 0; n < 2; ++n) acc[a][b][m][n] = (f32x4){0.f, 0.f, 0.f, 0.f};
        cur = nxt; cA = nA; cB = nB; ++ui;
        if constexpr (ALIGN_EPI) { if (wr == 1) PG8_BAR; }
    }
    PG8_WAIT_V(0);
    if constexpr (!ALIGN_EPI) { if (wr == 0) PG8_BAR; }
    PG8_BAR;
    if constexpr (Epi::AFTER_DRAIN) { E.fused(acc, cur, wr, wc, fr, fq, lds, wid, lane); S.done(cur); }
#undef PG8_SA
#undef PG8_SB
#undef PG8_STAGE
#undef PG8_LDA
#undef PG8_LDB
#undef PG8_MMA
#undef PG8_WAIT_V
#undef PG8_WAIT_L
#undef PG8_BAR
#undef PG8_SCHED
}
}

__device__ __forceinline__ u32x4 pack8(const f32x4& v0, const f32x4& v1) { u32x4 w; w.x = cvtpk(v0[0], v0[1]); w.y = cvtpk(v0[2], v0[3]); w.z = cvtpk(v1[0], v1[1]); w.w = cvtpk(v1[2], v1[3]); return w; }

struct EpiProj {
    static constexpr bool PERM = true, AFTER_DRAIN = false;
    bf16_t* proj; float* outK; float* outV; const float* qw; const float* kw; int rowoff;
    __device__ __forceinline__ void sub(const f32x4 (&a)[2][4][2], int pn, int rloc0, int wc, int fr, int fq) const {
        const int kind = pn >> 1, half = pn & 1;
        const int c8 = 256 * half + 64 * wc + 8 * fq;
        bf16_t* ob = proj + (size_t)kind * (PROJ_STRIDE / 2);
        if (kind < 4) {
#pragma unroll
            for (int m = 0; m < 4; ++m) { const size_t row = (size_t)(rowoff + rloc0 + 16 * m + fr);
#pragma unroll
                for (int bj = 0; bj < 2; ++bj) { f32x4 v0 = a[bj][m][0], v1 = a[bj][m][1];
                    if (kind == 1) { v0 = v0 * 0.08838834764831845f; v1 = v1 * 0.08838834764831845f; }
                    if (kind == 3) {
#pragma unroll
                        for (int e = 0; e < 4; ++e) { v0[e] = sigmoidf_(v0[e]); v1[e] = sigmoidf_(v1[e]); } }
                    *(u32x4*)(ob + row * 512 + c8 + 32 * bj) = pack8(v0, v1); } }
        } else if (kind < 6) {
            const float* w = kind == 4 ? qw : kw; const float osc = kind == 4 ? 0.125f * LOG2E : 1.f;
            f32x4 wv[2][2];
#pragma unroll
            for (int bj = 0; bj < 2; ++bj)
#pragma unroll
                for (int n = 0; n < 2; ++n) wv[bj][n] = *(const f32x4*)(w + 32 * bj + 8 * fq + 4 * n);
#pragma unroll
            for (int m = 0; m < 4; ++m) { const int rl = rloc0 + 16 * m + fr; float ss = 0.f;
#pragma unroll
                for (int bj = 0; bj < 2; ++bj)
#pragma unroll
                    for (int n = 0; n < 2; ++n) { const f32x4 x = a[bj][m][n]; ss += (x[0] * x[0] + x[1] * x[1]) + (x[2] * x[2] + x[3] * x[3]); }
                ss += __shfl_xor(ss, 16); ss += __shfl_xor(ss, 32);
                const float rstd = rsqrtf(ss * (1.f / 64.f) + EPS);
#pragma unroll
                for (int bj = 0; bj < 2; ++bj) { f32x4 v0 = a[bj][m][0] * rstd * wv[bj][0], v1 = a[bj][m][1] * rstd * wv[bj][1];
                    if (kind == 5) { float* o = outK + (size_t)rl * 512 + c8 + 32 * bj; __builtin_nontemporal_store(v0, (f32x4*)o); __builtin_nontemporal_store(v1, (f32x4*)(o + 4)); }
                    v0 = v0 * osc; v1 = v1 * osc;
                    *(u32x4*)(ob + (size_t)(rowoff + rl) * 512 + c8 + 32 * bj) = pack8(v0, v1); } }
        } else {
#pragma unroll
            for (int m = 0; m < 4; ++m) { const int rl = rloc0 + 16 * m + fr;
#pragma unroll
                for (int bj = 0; bj < 2; ++bj) { const f32x4 v0 = a[bj][m][0], v1 = a[bj][m][1];
                    float* o = outV + (size_t)rl * 512 + c8 + 32 * bj; __builtin_nontemporal_store(v0, (f32x4*)o); __builtin_nontemporal_store(v1, (f32x4*)(o + 4));
                    *(u32x4*)(ob + (size_t)(rowoff + rl) * 512 + c8 + 32 * bj) = pack8(v0, v1); } }
        }
    }
    __device__ __forceinline__ void operator()(const f32x4 (&acc)[2][2][4][2], const pg8::Unit& u, int wr, int wc, int fr, int fq, lptr) const {
#pragma unroll
        for (int ai = 0; ai < 2; ++ai) sub(acc[ai], u.pn, u.pm * 256 + ai * 128 + wr * 64, wc, fr, fq);
    }
};

template <int MODE>
struct EpiRes {
    static constexpr bool PERM = true, AFTER_DRAIN = false;
    const void* xin; void* xout; const float* gate; int tlog;
    __device__ __forceinline__ void sub(const f32x4 (&a)[2][4][2], int pn, int rloc0, int wc, int fr, int fq) const {
#pragma unroll
        for (int m = 0; m < 4; ++m) { const int rl = rloc0 + 16 * m + fr; const float* g = gate + (size_t)(rl >> tlog) * 6144;
#pragma unroll
            for (int bj = 0; bj < 2; ++bj) { const int c = 256 * pn + 128 * bj + 32 * wc + 8 * fq;
                const f32x4 g0 = *(const f32x4*)(g + c), g1 = *(const f32x4*)(g + c + 4);
                if (MODE == 0) {
                    const float* xp = (const float*)xin + (size_t)rl * 1024 + c;
                    const f32x4 o0 = *(const f32x4*)xp + g0 * a[bj][m][0], o1 = *(const f32x4*)(xp + 4) + g1 * a[bj][m][1];
                    *(u32x4*)((bf16_t*)xout + (size_t)rl * 1024 + c) = pack8(o0, o1);
                } else {
                    const u32x4 xv = *(const u32x4*)((const bf16_t*)xin + (size_t)rl * 1024 + c);
                    const f32x4 x0 = {bflo(xv.x), bfhi(xv.x), bflo(xv.y), bfhi(xv.y)}, x1 = {bflo(xv.z), bfhi(xv.z), bflo(xv.w), bfhi(xv.w)};
                    float* op = (float*)xout + (size_t)rl * 1024 + c;
                    __builtin_nontemporal_store(x0 + g0 * a[bj][m][0], (f32x4*)op); __builtin_nontemporal_store(x1 + g1 * a[bj][m][1], (f32x4*)(op + 4));
                } } }
    }
    __device__ __forceinline__ void operator()(const f32x4 (&acc)[2][2][4][2], const pg8::Unit& u, int wr, int wc, int fr, int fq, lptr) const {
#pragma unroll
        for (int ai = 0; ai < 2; ++ai) sub(acc[ai], u.pn, u.pm * 256 + ai * 128 + wr * 64, wc, fr, fq);
    }
};

__device__ __forceinline__ float dpp_ror1(float x) { return __int_as_float(__builtin_amdgcn_update_dpp(0, __float_as_int(x), 0x121, 0xf, 0xf, false)); }
__device__ __forceinline__ float dpp_ror2(float x) { return __int_as_float(__builtin_amdgcn_update_dpp(0, __float_as_int(x), 0x122, 0xf, 0xf, false)); }
struct ConvW { f32x4 w0a, w1a, w2a, ba, w0g, w1g, w2g, bg; };
__device__ __forceinline__ ConvW load_convw(const float* wconv, const float* bconv, int c) {
    ConvW w; w.w0a = *(const f32x4*)(wconv + c); w.w1a = *(const f32x4*)(wconv + FF2 + c); w.w2a = *(const f32x4*)(wconv + 2 * FF2 + c); w.ba = *(const f32x4*)(bconv + c);
    w.w0g = *(const f32x4*)(wconv + FF + c); w.w1g = *(const f32x4*)(wconv + FF2 + FF + c); w.w2g = *(const f32x4*)(wconv + 2 * FF2 + FF + c); w.bg = *(const f32x4*)(bconv + FF + c); return w;
}
template <int CTRL> __device__ __forceinline__ float dppz(float x) { return __int_as_float(__builtin_amdgcn_update_dpp(0, __float_as_int(x), CTRL, 0xf, 0xf, true)); }
__device__ __forceinline__ u32x2 conv_gate4(const f32x4& ca, const f32x4& cg, const f32x4& pa, const f32x4& pg, const ConvW& w, int) {
    float o[4];
#pragma unroll
    for (int e = 0; e < 4; ++e) {
        float ua = fmaf(w.w2a[e], ca[e], w.ba[e]);
        ua = fmaf(dppz<0x111>(ca[e]), w.w1a[e], ua); ua = fmaf(dppz<0x10F>(pa[e]), w.w1a[e], ua);
        ua = fmaf(dppz<0x112>(ca[e]), w.w0a[e], ua); ua = fmaf(dppz<0x10E>(pa[e]), w.w0a[e], ua);
        float ug = fmaf(w.w2g[e], cg[e], w.bg[e]);
        ug = fmaf(dppz<0x111>(cg[e]), w.w1g[e], ug); ug = fmaf(dppz<0x10F>(pg[e]), w.w1g[e], ug);
        ug = fmaf(dppz<0x112>(cg[e]), w.w0g[e], ug); ug = fmaf(dppz<0x10E>(pg[e]), w.w0g[e], ug);
        o[e] = ua * sigmoidf_(ua) * ug;
    }
    u32x2 r; r.x = cvtpk(o[0], o[1]); r.y = cvtpk(o[2], o[3]); return r;
}
struct EpiFFN {
    static constexpr bool PERM = true, AFTER_DRAIN = false;
    bf16_t* act; float* uedge; float* outF; const float* wconv; const float* bconv;
    __device__ __forceinline__ void operator()(const f32x4 (&acc)[2][2][4][2], const pg8::Unit& u, int wr, int wc, int fr, int fq, lptr lds) const {
        lptr halo = lds + pg8::STAGE_BYTES;
        const int q8 = 32 * wc + 8 * fq;
        if (fr >= 14) {
#pragma unroll
            for (int ai = 0; ai < 2; ++ai)
#pragma unroll
                for (int bj = 0; bj < 2; ++bj)
#pragma unroll
                    for (int n = 0; n < 2; ++n) *(LAS f32x4*)(halo + ((((2 * ai + wr) * 2 + (fr - 14)) * 256 + 128 * bj + q8 + 4 * n) * 4)) = acc[ai][bj][3][n];
        }
        asm volatile("s_waitcnt lgkmcnt(0)" ::: "memory"); __builtin_amdgcn_s_barrier(); asm volatile("" ::: "memory");
#pragma unroll
        for (int n = 0; n < 2; ++n) {
            const int c = 128 * u.pn + q8 + 4 * n;
            const ConvW w = load_convw(wconv, bconv, c);
#pragma unroll
            for (int ai = 0; ai < 2; ++ai) {
                const int G = 2 * ai + wr;
                f32x4 pa = {0.f, 0.f, 0.f, 0.f}, pg = {0.f, 0.f, 0.f, 0.f};
                if (G > 0 && fr >= 14) { pa = *(const LAS f32x4*)(halo + ((((G - 1) * 2 + (fr - 14)) * 256 + q8 + 4 * n) * 4)); pg = *(const LAS f32x4*)(halo + ((((G - 1) * 2 + (fr - 14)) * 256 + 128 + q8 + 4 * n) * 4)); }
#pragma unroll
                for (int m = 0; m < 4; ++m) {
                    const f32x4 ca = acc[ai][0][m][n], cg = acc[ai][1][m][n];
                    const f32x4 qa = m ? acc[ai][0][m ? m - 1 : 0][n] : pa, qg = m ? acc[ai][1][m ? m - 1 : 0][n] : pg;
                    const u32x2 o = conv_gate4(ca, cg, qa, qg, w, fr);
                    const size_t row = (size_t)u.pm * 256 + 64 * G + 16 * m + fr;
                    *(u32x2*)(act + row * FF + c) = o;
                    if (m == 0 && G == 0 && fr < 2) { float* e = uedge + ((size_t)u.pm * 4 + fr) * FF2 + c; *(f32x4*)e = ca; *(f32x4*)(e + FF) = cg; }
                    if (m == 3 && G == 3 && fr >= 14) { float* e = uedge + ((size_t)u.pm * 4 + 2 + (fr - 14)) * FF2 + c; *(f32x4*)e = ca; *(f32x4*)(e + FF) = cg;
                        if ((u.pm & 15) == 15) { float* f = outF + ((size_t)(u.pm >> 4) * 2 + (fr - 14)) * FF2 + c; *(f32x4*)f = ca; *(f32x4*)(f + FF) = cg; } }
                }
            }
        }
    }
};
struct EpiFFNs {
    bf16_t* act; float* outF; const float* state; const float* wconv; const float* bconv;
    __device__ __forceinline__ void sub(const f32x4 (&a)[2][4][2], int pn, int rloc0, int wc, int fr, int fq) const {
        const int q8 = 32 * wc + 8 * fq;
#pragma unroll
        for (int n = 0; n < 2; ++n) {
            const int c = 128 * pn + q8 + 4 * n;
            const ConvW w = load_convw(wconv, bconv, c);
#pragma unroll
            for (int m = 0; m < 4; ++m) {
                const int b = (rloc0 + 16 * m) >> 5;
                const f32x4 ca = a[0][m][n], cg = a[1][m][n];
                f32x4 qa = {0.f, 0.f, 0.f, 0.f}, qg = {0.f, 0.f, 0.f, 0.f};
                if (m & 1) { qa = a[0][m ? m - 1 : 0][n]; qg = a[1][m ? m - 1 : 0][n]; }
                else if (fr >= 14) { const float* s = state + ((size_t)b * 2 + (fr - 14)) * FF2 + c; qa = *(const f32x4*)s; qg = *(const f32x4*)(s + FF); }
                const u32x2 o = conv_gate4(ca, cg, qa, qg, w, fr);
                const size_t row = (size_t)MP + rloc0 + 16 * m + fr;
                *(u32x2*)(act + row * FF + c) = o;
                if ((m & 1) && fr >= 14) { float* f = outF + ((size_t)b * 2 + (fr - 14)) * FF2 + c; *(f32x4*)f = ca; *(f32x4*)(f + FF) = cg; }
            }
        }
    }
};

template <int K, bool HISCALE, class Epi>
__device__ __forceinline__ void small_tile(const bf16_t* __restrict__ A, const bf16_t* __restrict__ Bt, const Epi& E, const float* ssq, lptr lds, int t, int tid, int lane, int wave) {
    constexpr int KW = K / 8;
    const int fr = lane & 15, fq = lane >> 4;
    const int wc = t & 3, G = (t >> 2) & 3, pn = t >> 4;
    f32x4 acc[2][4][2];
#pragma unroll
    for (int bj = 0; bj < 2; ++bj)
#pragma unroll
        for (int m = 0; m < 4; ++m)
#pragma unroll
            for (int n = 0; n < 2; ++n) acc[bj][m][n] = (f32x4){0.f, 0.f, 0.f, 0.f};
    const bf16_t* ap = A + (size_t)(G * 64 + fr) * K + fq * 8 + wave * KW;
    const bf16_t* bp = Bt + (size_t)(256 * pn + 32 * wc + 8 * (fr >> 2) + (fr & 3)) * K + fq * 8 + wave * KW;
#ifdef DBLK
    for (int rep = 0; rep < 2; ++rep) {
    if (rep == 1) {
_Pragma("unroll") for (int bj = 0; bj < 2; ++bj) _Pragma("unroll") for (int m = 0; m < 4; ++m) _Pragma("unroll") for (int n = 0; n < 2; ++n) acc[bj][m][n] = acc[bj][m][n] * 0.f; asm volatile("" ::: "memory"); }
#endif
#pragma unroll 4
    for (int k0 = 0; k0 < KW; k0 += 32) {
        bf16x8 af[4], bf[2][2];
#pragma unroll
        for (int m = 0; m < 4; ++m) af[m] = *(const bf16x8*)(ap + (size_t)(16 * m) * K + k0);
#pragma unroll
        for (int bj = 0; bj < 2; ++bj)
#pragma unroll
            for (int n = 0; n < 2; ++n) bf[bj][n] = *(const bf16x8*)(bp + (size_t)(128 * bj + 4 * n) * K + k0);
#pragma unroll
        for (int bj = 0; bj < 2; ++bj)
#pragma unroll
            for (int m = 0; m < 4; ++m)
#pragma unroll
                for (int n = 0; n < 2; ++n) acc[bj][m][n] = MFMA16(bf[bj][n], af[m], acc[bj][m][n]);
    }
#ifdef DBLK
    }
#endif
    if (HISCALE) { if (wave >= 4) {
#pragma unroll
        for (int m = 0; m < 4; ++m) { const float* sp = ssq + (size_t)(MP + G * 64 + 16 * m + fr) * 8; const f32x4 s0 = *(const f32x4*)sp, s1 = *(const f32x4*)(sp + 4);
            const float rstd = rsqrtf(((s0.x + s0.y) + (s0.z + s0.w) + (s1.x + s1.y) + (s1.z + s1.w)) * (1.f / 512.f) + EPS);
#pragma unroll
            for (int bj = 0; bj < 2; ++bj)
#pragma unroll
                for (int n = 0; n < 2; ++n) acc[bj][m][n] = acc[bj][m][n] * rstd; } } }
    __syncthreads();
    if (wave != 0) {
#pragma unroll
        for (int bj = 0; bj < 2; ++bj)
#pragma unroll
            for (int m = 0; m < 4; ++m)
#pragma unroll
                for (int n = 0; n < 2; ++n) *(LAS f32x4*)(lds + ((((wave - 1) * 16 + (bj * 4 + m) * 2 + n) * 64 + lane) * 16)) = acc[bj][m][n];
    }
    __syncthreads();
    if (wave == 0) {
#pragma unroll 1
        for (int w2 = 0; w2 < 7; ++w2)
#pragma unroll
            for (int bj = 0; bj < 2; ++bj)
#pragma unroll
                for (int m = 0; m < 4; ++m)
#pragma unroll
                    for (int n = 0; n < 2; ++n) acc[bj][m][n] = acc[bj][m][n] + *(const LAS f32x4*)(lds + (((w2 * 16 + (bj * 4 + m) * 2 + n) * 64 + lane) * 16));
        E.sub(acc, pn, G * 64, wc, fr, fq);
#ifdef DBLE
        asm volatile("" ::: "memory"); E.sub(acc, pn, G * 64, wc, fr, fq);
#endif
    }
    __syncthreads();
}

typedef unsigned v4u __attribute__((ext_vector_type(4)));
#define XB_TMO      128
#define XB_XCNT(j)  (256  + 64 * (j))
#define XB_XSUB(j)  (1280 + 64 * (j))
#define XB_XGEN(j)  (2304 + 64 * (j))
#define XB_TOP      3328
#define XB_TOPGEN   3392
#define XCD_BAR_WORDS 3456
#define XB_SPIN_CAP (1u << 18)

__device__ __forceinline__ unsigned xb_ld(unsigned* p)              { return __hip_atomic_load(p, __ATOMIC_RELAXED, __HIP_MEMORY_SCOPE_AGENT); }
__device__ __forceinline__ unsigned xb_add(unsigned* p, unsigned v) { return __hip_atomic_fetch_add(p, v, __ATOMIC_RELAXED, __HIP_MEMORY_SCOPE_AGENT); }
__device__ __forceinline__ unsigned xb_xcc_id() { return (unsigned)__builtin_amdgcn_s_getreg((3 << 11) | 20) & 0xFu; }
#define XB_SPIN(cond, bar) do { unsigned _sp = 0; while (cond) { __builtin_amdgcn_s_sleep(1); \
    if ((++_sp & 255u) == 0u) { if (xb_ld(&(bar)[XB_TMO])) break; if (_sp > XB_SPIN_CAP) { atomicAdd(&(bar)[XB_TMO], 1u); break; } } } } while (0)

struct XcdBarrier {
    unsigned* bar; unsigned x;
    volatile LAS unsigned* st;
};

__device__ __forceinline__ XcdBarrier xcd_barrier_post(unsigned* bar, volatile LAS unsigned* st) {
    XcdBarrier b; b.bar = bar; b.x = xb_xcc_id(); b.st = st;
    if (threadIdx.x == 0) (void)xb_add(&bar[XB_XCNT(b.x)], 1u);
    return b;
}
__device__ __forceinline__ void xcd_barrier_complete(unsigned* bar, unsigned x, unsigned& nloc, unsigned& nx) {
    const unsigned G = gridDim.x * gridDim.y * gridDim.z;
    unsigned sum, cnt, mine, sp = 0u;
    for (;;) {
        sum = 0u; cnt = 0u; mine = 0u;
#pragma unroll
        for (unsigned j = 0; j < 16; ++j) { const unsigned c = xb_ld(&bar[XB_XCNT(j)]); sum += c; cnt += (c > 0u) ? 1u : 0u; mine = (j == x) ? c : mine; }
        if (sum == G) break;
        __builtin_amdgcn_s_sleep(1);
        if ((++sp & 255u) == 0u) { if (xb_ld(&bar[XB_TMO])) break; if (sp > XB_SPIN_CAP) { atomicAdd(&bar[XB_TMO], 1u); break; } }
    }
    nloc = mine > 0u ? mine : 1u; nx = cnt > 0u ? cnt : 1u;
}

__device__ __forceinline__ void xcd_barrier(const XcdBarrier& b) {
    asm volatile("s_waitcnt vmcnt(0)" ::: "memory");
    __syncthreads();
    if (threadIdx.x == 0) {
        unsigned* bar = b.bar;
        __builtin_amdgcn_s_waitcnt(0);
        unsigned nloc = b.st[0], nx = b.st[1];
        if (nloc == 0u) { xcd_barrier_complete(bar, b.x, nloc, nx); b.st[0] = nloc; b.st[1] = nx; }
        const unsigned old = xb_add(&bar[XB_XSUB(b.x)], 1u);
        const unsigned gen = old / nloc;
        if (old + 1u == (gen + 1u) * nloc) {
            __builtin_amdgcn_fence(__ATOMIC_RELEASE, "agent");
            asm volatile("s_waitcnt vmcnt(0)" ::: "memory");
            const unsigned og = xb_add(&bar[XB_TOP], 1u);
            const unsigned tg = og / nx;
            if (og + 1u == (tg + 1u) * nx) xb_add(&bar[XB_TOPGEN], 1u);
            else XB_SPIN(xb_ld(&bar[XB_TOPGEN]) == tg, bar);
            __builtin_amdgcn_fence(__ATOMIC_ACQUIRE, "agent");
            xb_add(&bar[XB_XGEN(b.x)], 1u);
            asm volatile("s_waitcnt vmcnt(0)" ::: "memory");
        } else {
            XB_SPIN(xb_ld(&bar[XB_XGEN(b.x)]) == gen, bar);
            __builtin_amdgcn_fence(__ATOMIC_ACQUIRE, "agent");
            asm volatile("s_waitcnt vmcnt(0)" ::: "memory");
        }
    }
    __syncthreads();
}


__device__ __forceinline__ void transpose_item(const float* __restrict__ W, int ldw, int srccol0, bf16_t* __restrict__ WT, int K, int destrow0, int k0, LAS float* scr, int lane, const float* kscale = nullptr) {
#pragma unroll 16
    for (int i = 0; i < 32; ++i) { const int kk = 2 * i + (lane >> 5); scr[kk * 33 + (lane & 31)] = W[(size_t)(k0 + kk) * ldw + srccol0 + (lane & 31)] * (kscale ? kscale[k0 + kk] : 1.f); }
    asm volatile("s_waitcnt lgkmcnt(0)" ::: "memory");
    const int c = lane & 7;
#pragma unroll
    for (int j = 0; j < 4; ++j) { const int n = (lane >> 3) + 8 * j; const LAS float* s = scr + (8 * c) * 33 + n;
        u32x4 o; o.x = cvtpk(s[0 * 33], s[1 * 33]); o.y = cvtpk(s[2 * 33], s[3 * 33]); o.z = cvtpk(s[4 * 33], s[5 * 33]); o.w = cvtpk(s[6 * 33], s[7 * 33]);
        *(u32x4*)(WT + (size_t)(destrow0 + n) * K + k0 + 8 * c) = o; }
    asm volatile("s_waitcnt lgkmcnt(0)" ::: "memory");
}

__device__ __forceinline__ void phase_weights(const Params& P, lptr lds, int lane, int wave) {
    unsigned char* ws = P.ws;
    LAS float* scr = (LAS float*)(lds + wave * 16384);
    const int gw = blockIdx.x * 8 + wave, NGW = gridDim.x * 8;
    constexpr int I1 = 16 * 112, I2 = 16 * 32, I3 = 16 * 176, I4 = 44 * 32;
    for (int it = gw; it < I1 + I2 + I3 + I4; it += NGW) {
        int r = it;
        if (r < I1) { const int kb = r / 112, n0 = (r % 112) * 32, tile = n0 >> 8, p = n0 & 255, wc = (p >> 5) & 3, bj = p >> 7, L = tile * 256 + 64 * wc + 32 * bj;
            transpose_item(P.in[I_WIN], DIN, L < 2048 ? L : L + 8, (bf16_t*)(ws + WS_W1T), 1024, n0, kb * 64, scr, lane); continue; }
        r -= I1;
        if (r < I2) { const int kb = r / 32, n0 = (r % 32) * 32; transpose_item(P.in[I_WOUT], 1024, n0, (bf16_t*)(ws + WS_W2T), 1024, n0, kb * 64, scr, lane, kb >= 8 ? P.in[I_SOW] - 512 : nullptr); continue; }
        r -= I2;
        if (r < I3) { const int kb = r / 176, n0 = (r % 176) * 32, pn = n0 >> 8, p = n0 & 255, bj = p >> 7, q0 = p & 127;
            transpose_item(P.in[I_WUP], FF2, 128 * pn + q0 + FF * bj, (bf16_t*)(ws + WS_W3T), 1024, n0, kb * 64, scr, lane); continue; }
        r -= I3;
        { const int kb = r / 32, n0 = (r % 32) * 32; transpose_item(P.in[I_WDOWN], 1024, n0, (bf16_t*)(ws + WS_W4T), FF, n0, kb * 64, scr, lane); }
    }
}

__device__ __forceinline__ void phase0(const Params& P, lptr lds, int tid, int lane, int wave) {
    unsigned char* ws = P.ws;
    LAS float* sc = (LAS float*)lds;
    for (int i = tid; i < 16384; i += 512) { const int r = i >> 10, k = i & 1023; const float c = r < 8 ? P.in[I_CP][r * 1024 + k] : P.in[I_CS][(r - 8) * 1024 + k]; sc[i] = c / (1.f + __expf(-c)); }
    __syncthreads();
    const int job = blockIdx.x * 512 + tid;
    if (job < 16 * 6144) {
        const int ks = job / 6144, n = job % 6144;
        float acc[16];
#pragma unroll
        for (int r = 0; r < 16; ++r) acc[r] = 0.f;
        const float* wp = P.in[I_WADA] + (size_t)(ks * 64) * 6144 + n;
#pragma unroll 16
        for (int k = 0; k < 64; ++k) { const float w = wp[(size_t)k * 6144];
#pragma unroll
            for (int r = 0; r < 16; ++r) acc[r] += sc[r * 1024 + ks * 64 + k] * w; }
        __attribute__((address_space(1))) float* mp = (__attribute__((address_space(1))) float*)(ws + WS_MOD);
        const float bias = ks == 0 ? P.in[I_BADA][n] : 0.f;
#pragma unroll
        for (int r = 0; r < 16; ++r) (void)__builtin_amdgcn_global_atomic_fadd_f32(mp + (size_t)r * 6144 + n, acc[r] + bias);
    }
}

__device__ __forceinline__ void load_mod_vectors(const Params& P, LAS float* A, LAS float* S, const float* normw, int r, int shofs, int tid) {
    const float* md = (const float*)(P.ws + WS_MOD) + (size_t)r * 6144 + shofs;
    for (int k = tid; k < 1024; k += 512) { A[k] = normw[k] * (1.f + md[1024 + k]); S[k] = md[k]; }
}
__device__ __forceinline__ void load_row_bf(const bf16_t* xrow, int lane, f32x4 (&v)[4]) {
#pragma unroll
    for (int j = 0; j < 4; ++j) { const u32x2 w = ((const u32x2*)xrow)[lane + 64 * j]; v[j] = (f32x4){bflo(w.x), bfhi(w.x), bflo(w.y), bfhi(w.y)}; }
}
__device__ __forceinline__ void load_row(const float* xrow, int lane, f32x4 (&v)[4]) {
#pragma unroll
    for (int j = 0; j < 4; ++j) v[j] = ((const f32x4*)xrow)[lane + 64 * j];
}
template <bool GATES>
__device__ __forceinline__ void norm_row(const Params& P, const f32x4 (&v)[4], bf16_t* orow, float* grow, const LAS float* A, const LAS float* S, const LAS float* Wg, int lane) {
    float s = 0.f;
#pragma unroll
    for (int j = 0; j < 4; ++j) s += (v[j].x * v[j].x + v[j].y * v[j].y) + (v[j].z * v[j].z + v[j].w * v[j].w);
    const float rstd = rsqrtf(wave_sum(s) * (1.f / 1024.f) + EPS);
    float g[8];
#pragma unroll
    for (int i = 0; i < 8; ++i) g[i] = 0.f;
#pragma unroll
    for (int j = 0; j < 4; ++j) { const int k0 = 4 * lane + 256 * j;
        const f32x4 a = *(const LAS f32x4*)(A + k0), sh = *(const LAS f32x4*)(S + k0);
        const f32x4 hv = v[j] * rstd * a + sh;
        u32x2 o; o.x = cvtpk(hv.x, hv.y); o.y = cvtpk(hv.z, hv.w);
        *(u32x2*)(orow + k0) = o;
        if (GATES) {
#pragma unroll
            for (int i = 0; i < 8; ++i) { const f32x4 w = *(const LAS f32x4*)(Wg + i * 1024 + k0); g[i] += (hv.x * w.x + hv.y * w.y) + (hv.z * w.z + hv.w * w.w); } }
    }
    if (GATES) {
        { const bool hi = (lane & 32) != 0;
#pragma unroll
          for (int i = 0; i < 4; ++i) { const float send = hi ? g[i] : g[i + 4], keep = hi ? g[i + 4] : g[i]; g[i] = keep + __shfl_xor(send, 32); } }
        { const bool hi = (lane & 16) != 0;
#pragma unroll
          for (int i = 0; i < 2; ++i) { const float send = hi ? g[i] : g[i + 2], keep = hi ? g[i + 2] : g[i]; g[i] = keep + __shfl_xor(send, 16); } }
        { const bool hi = (lane & 8) != 0; const float send = hi ? g[0] : g[1], keep = hi ? g[1] : g[0]; g[0] = keep + __shfl_xor(send, 8); }
        g[0] += __shfl_xor(g[0], 4); g[0] += __shfl_xor(g[0], 2); g[0] += __shfl_xor(g[0], 1);
        const int gt = lane >> 3;
        if ((lane & 7) == 0) {
            float o;
            if (gt < 4) o = g[0] + P.in[I_BIG][gt];
            else { const float x = g[0] + P.in[I_BFG][gt - 4]; o = fminf(x, 0.f) - log1pf(expf(-fabsf(x))); }
            grow[gt] = o;
        }
    }
}
__device__ __forceinline__ void phase1(const Params& P, lptr lds, int tid, int lane, int wave) {
    LAS float* A1 = (LAS float*)lds; LAS float* S1 = A1 + 1024; LAS float* Wg = S1 + 1024;
    const size_t row0 = (size_t)blockIdx.x * 128 + wave * 16; f32x4 v[4], vn[4]; load_row(P.in[I_XP] + row0 * 1024, lane, v);
    for (int k = tid; k < 1024; k += 512) { const f32x4 w0 = *(const f32x4*)(P.in[I_WIN] + (size_t)k * DIN + 2048), w1 = *(const f32x4*)(P.in[I_WIN] + (size_t)k * DIN + 2052);
        Wg[k] = w0.x; Wg[1024 + k] = w0.y; Wg[2048 + k] = w0.z; Wg[3072 + k] = w0.w; Wg[4096 + k] = w1.x; Wg[5120 + k] = w1.y; Wg[6144 + k] = w1.z; Wg[7168 + k] = w1.w; }
    load_mod_vectors(P, A1, S1, P.in[I_N1W], blockIdx.x >> 5, 0, tid);
    LAS float* A1s = Wg + 8192; LAS float* S1s = A1s + 1024;
    load_mod_vectors(P, A1s, S1s, P.in[I_N1W], 8 + (blockIdx.x >> 5), 0, tid);
    __syncthreads();
    bf16_t* H = (bf16_t*)(P.ws + WS_H); float* GT = (float*)(P.ws + WS_GATES);
    {
#pragma unroll 1
      for (int j = 0; j < 16; ++j) { const size_t row = row0 + j;
          if (j + 1 < 16) load_row(P.in[I_XP] + (row + 1) * 1024, lane, vn);
          else if (wave == 0) load_row(P.in[I_XS] + (size_t)blockIdx.x * 1024, lane, vn);
          norm_row<true>(P, v, H + row * 1024, GT + row * 8, A1, S1, Wg, lane);
#pragma unroll
          for (int q = 0; q < 4; ++q) v[q] = vn[q]; }
      if (wave == 0) norm_row<true>(P, v, H + ((size_t)MP + blockIdx.x) * 1024, GT + ((size_t)MP + blockIdx.x) * 8, A1s, S1s, Wg, lane); }
}
__device__ __forceinline__ void phase5(const Params& P, lptr lds, int tid, int lane, int wave) {
    LAS float* A1 = (LAS float*)lds; LAS float* S1 = A1 + 1024;
    load_mod_vectors(P, A1, S1, P.in[I_N2W], blockIdx.x >> 5, 3072, tid);
    __syncthreads();
    bf16_t* H = (bf16_t*)(P.ws + WS_H);
    { const size_t row0 = (size_t)blockIdx.x * 128 + wave * 16; const bf16_t* X1 = (const bf16_t*)(P.ws + WS_X1B); f32x4 v[4], vn[4]; load_row_bf(X1 + row0 * 1024, lane, v);
#pragma unroll 1
      for (int j = 0; j < 16; ++j) { const size_t row = row0 + j;
          if (j + 1 < 16) load_row_bf(X1 + (row + 1) * 1024, lane, vn);
          norm_row<false>(P, v, H + row * 1024, nullptr, A1, S1, nullptr, lane);
#pragma unroll
          for (int q = 0; q < 4; ++q) v[q] = vn[q]; } }
    __syncthreads();
}
__device__ __forceinline__ void sample_h2_row(const Params& P, lptr lds, int tid, int lane, int wave) {
    LAS float* A1 = (LAS float*)lds; LAS float* S1 = A1 + 1024;
    load_mod_vectors(P, A1, S1, P.in[I_N2W], 8 + (blockIdx.x >> 5), 3072, tid);
    __syncthreads();
    if (wave == 0) { f32x4 v[4]; load_row_bf((const bf16_t*)(P.ws + WS_X1B) + ((size_t)MP + blockIdx.x) * 1024, lane, v); norm_row<false>(P, v, (bf16_t*)(P.ws + WS_H) + ((size_t)MP + blockIdx.x) * 1024, nullptr, A1, S1, nullptr, lane); }
    __syncthreads();
}
__device__ __forceinline__ void phase3b(const Params& P, int lane, int gw, int NGW) {
    bf16_t* Y = (bf16_t*)(P.ws + WS_YCAT); const float* SSQ = (const float*)(P.ws + WS_SSQ);
    for (int row = gw; row < MP; row += NGW) {
        const f32x4 s0 = *(const f32x4*)(SSQ + (size_t)row * 8), s1 = *(const f32x4*)(SSQ + (size_t)row * 8 + 4);
        const float rstd = rsqrtf(((s0.x + s0.y) + (s0.z + s0.w) + (s1.x + s1.y) + (s1.z + s1.w)) * (1.f / 512.f) + EPS);
        u32x4* p = (u32x4*)(Y + (size_t)row * 1024 + 512 + 8 * lane); const u32x4 o = *p;
        f32x4 a = {bflo(o.x), bfhi(o.x), bflo(o.y), bfhi(o.y)}, b = {bflo(o.z), bfhi(o.z), bflo(o.w), bfhi(o.w)};
        a = a * rstd; b = b * rstd;
        *p = pack8(a, b);
    }
}
__device__ __forceinline__ void phase_fix(const Params& P, int tid) {
    const float* UE = (const float*)(P.ws + WS_UEDGE); bf16_t* act = (bf16_t*)(P.ws + WS_ACT);
    const float* wc = P.in[I_WCONV]; const float* bc = P.in[I_BCONV];
    const int total = 128 * 2 * FF;
    if (blockIdx.x < 64) return;
    for (int i = (blockIdx.x - 64) * 512 + tid; i < total; i += (gridDim.x - 64) * 512) {
        const int j = i % FF, rr = (i / FF) & 1, pm = i / (2 * FF);
        if ((pm & 15) == 0) continue;
        float uc[2];
#pragma unroll
        for (int hf = 0; hf < 2; ++hf) { const int c = j + hf * FF;
            const float um2 = rr == 0 ? UE[((size_t)(pm - 1) * 4 + 2) * FF2 + c] : UE[((size_t)(pm - 1) * 4 + 3) * FF2 + c];
            const float um1 = rr == 0 ? UE[((size_t)(pm - 1) * 4 + 3) * FF2 + c] : UE[((size_t)pm * 4 + 0) * FF2 + c];
            const float u0 = UE[((size_t)pm * 4 + rr) * FF2 + c];
            uc[hf] = bc[c] + wc[2 * FF2 + c] * u0 + wc[FF2 + c] * um1 + wc[c] * um2; }
        act[((size_t)pm * 256 + rr) * FF + j] = f2bf(uc[0] * sigmoidf_(uc[0]) * uc[1]);
    }
}

constexpr int ML_P = 272;
constexpr int ML_QS = 0, ML_KS = 17408, ML_VS = 34816, ML_VW = 52224, ML_CS = 69632, ML_SS = 104448, ML_SC = 113664;
__device__ __forceinline__ void mlstm_item(const Params& P, lptr lds, int bh, bool sample, int tid, int lane, int wave) {
    const int b = bh >> 2, h = bh & 3, hh = lane >> 5, n31 = lane & 31;
    const size_t rowbase = sample ? (size_t)MP + b * 32 : (size_t)b * SEQ;
    const int nch = sample ? 1 : 64, L = sample ? 32 : 64;
    const bf16_t* MQ = (const bf16_t*)(P.ws + WS_PROJ); const bf16_t* MK = (const bf16_t*)(P.ws + WS_PROJ + PROJ_STRIDE); const bf16_t* MV = (const bf16_t*)(P.ws + WS_PROJ + 2 * PROJ_STRIDE);
    const bf16_t* MO = (const bf16_t*)(P.ws + WS_PROJ + 3 * PROJ_STRIDE); const float* GT = (const float*)(P.ws + WS_GATES); bf16_t* YC = (bf16_t*)(P.ws + WS_YCAT);
    LAS float* sc = (LAS float*)(lds + ML_SC);
    LAS float* bt = sc, *as_ = sc + 64, *mt = sc + 128, *winter = sc + 192, *emt = sc + 256, *wk = sc + 320, *rsum = sc + 384, *qn = sc + 512, *nvec = sc + 576, *misc = sc + 704;
    const int ti = wave >> 2, ej = wave & 3;
    f32x16 Cacc[2];
    {
        LAS float* cst = (LAS float*)lds;
        if (sample) { const float* src = P.in[I_STC] + ((size_t)b * 4 + h) * 16384;
            for (int i = tid; i < 4096; i += 512) { const f32x4 v = *(const f32x4*)(src + 4 * i); *(LAS f32x4*)(cst + (i >> 5) * 132 + (i & 31) * 4) = v; } }
        else { for (int i = tid; i < 4096; i += 512) *(LAS f32x4*)(cst + (i >> 5) * 132 + (i & 31) * 4) = (f32x4){0.f, 0.f, 0.f, 0.f}; }
        __syncthreads();
        const LAS float* cb = cst + (64 * (wave >> 2) + 4 * hh) * 132 + 32 * ej + n31;
#pragma unroll
        for (int i = 0; i < 2; ++i)
#pragma unroll
            for (int r = 0; r < 16; ++r) Cacc[i][r] = cb[(32 * i + (r & 3) + 8 * (r >> 2)) * 132];
        __syncthreads();
        lptr cs = lds + ML_CS + (64 * (wave >> 2) + 4 * hh) * ML_P + (32 * ej + n31) * 2;
#pragma unroll
        for (int i = 0; i < 2; ++i)
#pragma unroll
            for (int r = 0; r < 16; ++r) *(LAS unsigned short*)(cs + (32 * i + (r & 3) + 8 * (r >> 2)) * ML_P) = f2bf(Cacc[i][r]);
    }
    if (tid < 128) nvec[tid] = sample ? P.in[I_STN][((size_t)b * 4 + h) * 128 + tid] : 0.f;
    if (tid == 0) misc[0] = sample ? P.in[I_STM][b * 4 + h] : 0.f;
    u32x4 rq[2], rk[2], rv[2]; float g_ig = -INFINITY, g_lf = 0.f;
    const int prow[2] = {tid >> 4, (tid + 512) >> 4}, pch = tid & 15;
#define ML_LOAD(c) do { _Pragma("unroll") for (int i = 0; i < 2; ++i) { if (prow[i] < L) { const size_t go = (rowbase + (size_t)(c) * 64 + prow[i]) * 512 + h * 128 + pch * 8; \
            rq[i] = *(const u32x4*)(MQ + go); rk[i] = *(const u32x4*)(MK + go); rv[i] = *(const u32x4*)(MV + go); } else { rq[i] = (u32x4){0u, 0u, 0u, 0u}; rk[i] = rq[i]; rv[i] = rq[i]; } } \
        if (wave == 0) { if (lane < L) { const float* g = GT + (rowbase + (size_t)(c) * 64 + lane) * 8; g_ig = g[h]; g_lf = g[4 + h]; } else { g_ig = -INFINITY; g_lf = 0.f; } } } while (0)
    ML_LOAD(0);
    for (int c = 0; c < nch; ++c) {
        __syncthreads();
        if (wave == 0) {
            float bcum = g_lf;
#pragma unroll
            for (int o = 1; o < 64; o <<= 1) { const float v = __shfl_up(bcum, o); if (lane >= o) bcum += v; }
            const float a = g_ig - bcum; float amax = a;
#pragma unroll
            for (int o = 1; o < 64; o <<= 1) { const float v = __shfl_up(amax, o); if (lane >= o) amax = fmaxf(amax, v); }
            const float mprev = misc[0];
            const float m_t = fmaxf(bcum + mprev, bcum + amax);
            const float bL = __shfl(bcum, 63), aM = __shfl(amax, 63);
            const float m_new = fmaxf(bL + mprev, bL + aM);
            bt[lane] = bcum; as_[lane] = a; mt[lane] = m_t; winter[lane] = expf(bcum + mprev - m_t); emt[lane] = expf(-m_t); wk[lane] = expf(bL + a - m_new);
            if (lane == 0) { misc[1] = expf(bL + mprev - m_new); misc[2] = m_new; }
        }
#pragma unroll
        for (int i = 0; i < 2; ++i) { const int o = prow[i] * ML_P + pch * 16;
            *(LAS u32x4*)(lds + ML_QS + o) = rq[i]; *(LAS u32x4*)(lds + ML_KS + o) = rk[i]; *(LAS u32x4*)(lds + ML_VS + o) = rv[i]; }
        __syncthreads();
#pragma unroll
        for (int i = 0; i < 2; ++i) { const float w = wk[prow[i]]; const u32x4 v = rv[i]; u32x4 o;
            o.x = cvtpk(bflo(v.x) * w, bfhi(v.x) * w); o.y = cvtpk(bflo(v.y) * w, bfhi(v.y) * w); o.z = cvtpk(bflo(v.z) * w, bfhi(v.z) * w); o.w = cvtpk(bflo(v.w) * w, bfhi(v.w) * w);
            *(LAS u32x4*)(lds + ML_VW + prow[i] * ML_P + pch * 16) = o; }
        if (c + 1 < nch) ML_LOAD(c + 1);
        f32x16 num;
#pragma unroll
        for (int r = 0; r < 16; ++r) num[r] = 0.f;
#pragma unroll
        for (int ks = 0; ks < 8; ++ks) num = MFMA32(row_frag(lds + ML_QS, ML_P, 32 * ti, 16 * ks, lane), tr_frag(lds + ML_CS, ML_P, 16 * ks, 32 * ej, lane), num);
        if (wave < 3) {
            const int sti = wave == 0 ? 0 : 1, sj = wave == 2 ? 1 : 0;
            const int krow = (n31 & ~12) | ((n31 & 4) << 1) | ((n31 & 8) >> 1);
            f32x16 p;
#pragma unroll
            for (int r = 0; r < 16; ++r) p[r] = 0.f;
#pragma unroll
            for (int ks = 0; ks < 8; ++ks) p = MFMA32(*(const LAS bf16x8*)(lds + ML_KS + (32 * sj + krow) * ML_P + (16 * ks + 8 * hh) * 2), row_frag(lds + ML_QS, ML_P, 32 * sti, 16 * ks, lane), p);
            const int t = 32 * sti + n31; const float bt_t = bt[t], mt_t = mt[t]; float rs = 0.f;
            const LAS float* asb = as_ + 32 * sj + 8 * hh; const int tb = t - (32 * sj + 8 * hh);
#pragma unroll
            for (int r = 0; r < 16; ++r) { const int so = 16 * (r >> 3) + (r & 7);
                const float w = so <= tb ? __expf(bt_t + asb[so] - mt_t) : 0.f; p[r] *= w; rs += p[r]; }
#pragma unroll
            for (int a2 = 0; a2 < 2; ++a2) { u32x4 o; o.x = cvtpk(p[8 * a2 + 0], p[8 * a2 + 1]); o.y = cvtpk(p[8 * a2 + 2], p[8 * a2 + 3]); o.z = cvtpk(p[8 * a2 + 4], p[8 * a2 + 5]); o.w = cvtpk(p[8 * a2 + 6], p[8 * a2 + 7]);
                *(LAS u32x4*)(lds + ML_SS + t * 144 + (32 * sj + 16 * a2 + 8 * hh) * 2) = o; }
            rs += __shfl_xor(rs, 32);
            if (hh == 0) rsum[sj * 64 + t] = rs;
        }
        if (wave >= 4) {
            const int t = (tid - 256) >> 2, part = tid & 3; float s = 0.f;
#pragma unroll 8
            for (int d = 0; d < 32; ++d) s += bf2f(*(const LAS unsigned short*)(lds + ML_QS + t * ML_P + (32 * part + d) * 2)) * nvec[32 * part + d];
            s += __shfl_xor(s, 1); s += __shfl_xor(s, 2);
            if (part == 0) qn[t] = s;
        }
        __syncthreads();
        const LAS float* tb2 = sc + 32 * ti + 4 * hh;
#pragma unroll
        for (int r = 0; r < 16; ++r) num[r] *= tb2[192 + (r & 3) + 8 * (r >> 2)];
#pragma unroll
        for (int ks = 0; ks < 4; ++ks) if (ks < 2 || ti == 1) num = MFMA32(*(const LAS bf16x8*)(lds + ML_SS + (32 * ti + n31) * 144 + (16 * ks + 8 * hh) * 2), tr_frag(lds + ML_VS, ML_P, 16 * ks, 32 * ej, lane), num);
#pragma unroll
        for (int r = 0; r < 16; ++r) { const int o = (r & 3) + 8 * (r >> 2);
            const float den = tb2[192 + o] * tb2[512 + o] + tb2[384 + o] + (ti ? tb2[448 + o] : 0.f);
            const float hv = num[r] / fmaxf(fabsf(den), tb2[256 + o]);
            *(LAS unsigned short*)(lds + ML_QS + (32 * ti + 4 * hh) * ML_P + (32 * ej + n31) * 2 + o * ML_P) = f2bf(hv); }
        const float decay = misc[1];
#pragma unroll
        for (int i = 0; i < 2; ++i) { const int di = 2 * (wave >> 2) + i;
#pragma unroll
            for (int r = 0; r < 16; ++r) Cacc[i][r] *= decay;
#pragma unroll
            for (int ks = 0; ks < 4; ++ks) Cacc[i] = MFMA32(tr_frag(lds + ML_KS, ML_P, 16 * ks, 32 * di, lane), tr_frag(lds + ML_VW, ML_P, 16 * ks, 32 * ej, lane), Cacc[i]);
#pragma unroll
            for (int r = 0; r < 16; ++r) *(LAS unsigned short*)(lds + ML_CS + (64 * (wave >> 2) + 4 * hh) * ML_P + (32 * ej + n31) * 2 + (32 * i + (r & 3) + 8 * (r >> 2)) * ML_P) = f2bf(Cacc[i][r]); }
        if (tid < 128) { float s = decay * nvec[tid];
#pragma unroll 8
            for (int t = 0; t < 64; ++t) s += wk[t] * bf2f(*(const LAS unsigned short*)(lds + ML_KS + t * ML_P + tid * 2));
            nvec[tid] = s; }
        if (tid == 0) misc[0] = misc[2];
        __syncthreads();
        { const int t = tid >> 3, part = tid & 7;
          const u32x4 h0 = *(const LAS u32x4*)(lds + ML_QS + t * ML_P + part * 32), h1 = *(const LAS u32x4*)(lds + ML_QS + t * ML_P + part * 32 + 16);
          float hv[16] = {bflo(h0.x), bfhi(h0.x), bflo(h0.y), bfhi(h0.y), bflo(h0.z), bfhi(h0.z), bflo(h0.w), bfhi(h0.w), bflo(h1.x), bfhi(h1.x), bflo(h1.y), bfhi(h1.y), bflo(h1.z), bfhi(h1.z), bflo(h1.w), bfhi(h1.w)};
          float ss = 0.f;
#pragma unroll
          for (int e = 0; e < 16; ++e) ss += hv[e] * hv[e];
          ss += __shfl_xor(ss, 1); ss += __shfl_xor(ss, 2); ss += __shfl_xor(ss, 4);
          const float rstd = rsqrtf(ss * (1.f / 128.f) + EPS);
          if (t < L) {
              const size_t row = rowbase + (size_t)c * 64 + t; const int col = h * 128 + part * 16;
              const u32x4 g0 = *(const u32x4*)(MO + row * 512 + col), g1 = *(const u32x4*)(MO + row * 512 + col + 8);
              const float gv[16] = {bflo(g0.x), bfhi(g0.x), bflo(g0.y), bfhi(g0.y), bflo(g0.z), bfhi(g0.z), bflo(g0.w), bfhi(g0.w), bflo(g1.x), bfhi(g1.x), bflo(g1.y), bfhi(g1.y), bflo(g1.z), bfhi(g1.z), bflo(g1.w), bfhi(g1.w)};
              const float* mw = P.in[I_MLW] + col;
              float y[16];
#pragma unroll
              for (int e = 0; e < 16; ++e) y[e] = hv[e] * rstd * mw[e] * gv[e];
              u32x4 o0, o1; o0.x = cvtpk(y[0], y[1]); o0.y = cvtpk(y[2], y[3]); o0.z = cvtpk(y[4], y[5]); o0.w = cvtpk(y[6], y[7]); o1.x = cvtpk(y[8], y[9]); o1.y = cvtpk(y[10], y[11]); o1.z = cvtpk(y[12], y[13]); o1.w = cvtpk(y[14], y[15]);
              *(u32x4*)(YC + row * 1024 + col) = o0; *(u32x4*)(YC + row * 1024 + col + 8) = o1;
          } }
    }
#undef ML_LOAD
    __syncthreads();
    {
        LAS float* cst = (LAS float*)lds;
        int l3 = lane; asm volatile("" : "+v"(l3));
        LAS float* cb = cst + (64 * (wave >> 2) + 4 * (l3 >> 5)) * 132 + 32 * ej + (l3 & 31);
#pragma unroll
        for (int i = 0; i < 2; ++i)
#pragma unroll
            for (int r = 0; r < 16; ++r) cb[(32 * i + (r & 3) + 8 * (r >> 2)) * 132] = Cacc[i][r];
        __syncthreads();
        float* oc = P.out + (sample ? O_SC : O_PC) + ((size_t)b * 4 + h) * 16384;
        for (int i = tid; i < 4096; i += 512) *(f32x4*)(oc + 4 * i) = *(const LAS f32x4*)(cst + (i >> 5) * 132 + (i & 31) * 4);
    }
    if (tid < 128) P.out[(sample ? O_SN : O_PN) + ((size_t)b * 4 + h) * 128 + tid] = nvec[tid];
    if (tid == 0) P.out[(sample ? O_SM : O_PM) + b * 4 + h] = misc[0];
}


constexpr size_t WS_KVL = WS_H, WS_KNL = 420 * MiB, WS_CHS = 421 * MiB, WS_NST = 422 * MiB, WS_MST = 423 * MiB, WS_CST = 424 * MiB, WS_END2 = 489 * MiB;
template <int NC>
__device__ __forceinline__ void ml1_pair(const Params& P, lptr lds, int pair, int tid, int lane, int wave) {
    const int item0 = NC * pair; const int bh = item0 >> 6, c = item0 & 63, b = bh >> 2, h = bh & 3, hh = lane >> 5, n31 = lane & 31, ej = wave & 3;
    const size_t row0 = (size_t)b * SEQ + 64 * c;
    const bf16_t* MK = (const bf16_t*)(P.ws + WS_PROJ + PROJ_STRIDE); const bf16_t* MV = (const bf16_t*)(P.ws + WS_PROJ + 2 * PROJ_STRIDE); const float* GT = (const float*)(P.ws + WS_GATES);
    LAS float* wk = (LAS float*)(lds + ML_SC) + 320;
    const int prow[2] = {tid >> 4, (tid + 512) >> 4}, pch = tid & 15;
    u32x4 rk2[NC][2], rv2[NC][2]; float g_ig2[NC], g_lf2[NC];
#pragma unroll
    for (int s2 = 0; s2 < NC; ++s2) { g_ig2[s2] = 0.f; g_lf2[s2] = 0.f;
#pragma unroll
        for (int i = 0; i < 2; ++i) { const size_t go = (row0 + 64 * s2 + prow[i]) * 512 + h * 128 + pch * 8; rk2[s2][i] = *(const u32x4*)(MK + go); rv2[s2][i] = *(const u32x4*)(MV + go); }
        if (wave == 0) { const float* g = GT + (row0 + 64 * s2 + lane) * 8; g_ig2[s2] = g[h]; g_lf2[s2] = g[4 + h]; } }
#pragma unroll
    for (int s2 = 0; s2 < NC; ++s2) {
    const int item = item0 + s2; const float g_ig = g_ig2[s2], g_lf = g_lf2[s2];
    u32x4 rk[2] = {rk2[s2][0], rk2[s2][1]}, rv[2] = {rv2[s2][0], rv2[s2][1]};
    __syncthreads();
    if (wave == 0) {
        float bcum = g_lf;
#pragma unroll
        for (int o = 1; o < 64; o <<= 1) { const float v = __shfl_up(bcum, o); if (lane >= o) bcum += v; }
        const float a = g_ig - bcum; float amax = a;
#pragma unroll
        for (int o = 1; o < 64; o <<= 1) amax = fmaxf(amax, __shfl_xor(amax, o));
        const float bL = __shfl(bcum, 63);
        wk[lane] = expf(a - amax);
        if (lane == 0) { float* ch = (float*)(P.ws + WS_CHS) + (size_t)item * 4; ch[0] = bL; ch[1] = bL + amax; }
    }
#pragma unroll
    for (int i = 0; i < 2; ++i) *(LAS u32x4*)(lds + ML_KS + prow[i] * ML_P + pch * 16) = rk[i];
    __syncthreads();
#pragma unroll
    for (int i = 0; i < 2; ++i) { const float w = wk[prow[i]]; const u32x4 v = rv[i]; u32x4 o;
        o.x = cvtpk(bflo(v.x) * w, bfhi(v.x) * w); o.y = cvtpk(bflo(v.y) * w, bfhi(v.y) * w); o.z = cvtpk(bflo(v.z) * w, bfhi(v.z) * w); o.w = cvtpk(bflo(v.w) * w, bfhi(v.w) * w);
        *(LAS u32x4*)(lds + ML_VW + prow[i] * ML_P + pch * 16) = o; }
    if (tid < 128) { float s = 0.f;
#pragma unroll 8
        for (int t = 0; t < 64; ++t) s += wk[t] * bf2f(*(const LAS unsigned short*)(lds + ML_KS + t * ML_P + tid * 2));
        ((float*)(P.ws + WS_KNL))[(size_t)item * 128 + tid] = s; }
    __syncthreads();
#pragma unroll
    for (int i = 0; i < 2; ++i) { const int di = 2 * (wave >> 2) + i;
        f32x16 acc;
#pragma unroll
        for (int r = 0; r < 16; ++r) acc[r] = 0.f;
#pragma unroll
        for (int ks = 0; ks < 4; ++ks) acc = MFMA32(tr_frag(lds + ML_KS, ML_P, 16 * ks, 32 * di, lane), tr_frag(lds + ML_VW, ML_P, 16 * ks, 32 * ej, lane), acc);
#pragma unroll
        for (int r = 0; r < 16; ++r) *(LAS unsigned short*)(lds + ML_CS + (64 * (wave >> 2) + 4 * hh) * ML_P + (32 * ej + n31) * 2 + (32 * i + (r & 3) + 8 * (r >> 2)) * ML_P) = f2bf(acc[r]); }
    __syncthreads();
    bf16_t* kvl = (bf16_t*)(P.ws + WS_KVL) + (size_t)item * 16384;
#pragma unroll
    for (int i = 0; i < 4; ++i) { const int p = tid + 512 * i, row = p >> 4, ch = p & 15; *(u32x4*)(kvl + row * 128 + ch * 8) = *(const LAS u32x4*)(lds + ML_CS + row * ML_P + ch * 16); }
    }
}
__device__ __forceinline__ void ml2_scan(const Params& P, lptr lds, int tid, int job) {
    const int bh = job >> 3, part = job & 7;
    LAS float* dec = (LAS float*)lds; LAS float* scl = dec + 64; LAS float* mst = scl + 64;
    if (tid < 64) {
        const float* ch = (const float*)(P.ws + WS_CHS) + ((size_t)bh * 64 + tid) * 4;
        const float bL = ch[0], ml = ch[1]; float A = bL, B = ml;
#pragma unroll
        for (int off = 1; off < 64; off <<= 1) { const float A2 = __shfl_up(A, off), B2 = __shfl_up(B, off); if (tid >= off) { B = fmaxf(B2 + A, B); A = A2 + A; } }
        const float mnext = fmaxf(A, B);
        float mc = __shfl_up(mnext, 1); if (tid == 0) mc = 0.f;
        dec[tid] = expf(bL + mc - mnext); scl[tid] = expf(ml - mnext); mst[tid] = mc; if (tid == 63) mst[64] = mnext;
    }
    __syncthreads();
    const size_t e0 = (size_t)part * 2048 + tid * 4;
    const bf16_t* kv = (const bf16_t*)(P.ws + WS_KVL) + (size_t)bh * 64 * 16384 + e0; bf16_t* cs = (bf16_t*)(P.ws + WS_CST) + (size_t)bh * 64 * 16384 + e0;
    f32x4 C = {0.f, 0.f, 0.f, 0.f};
#pragma unroll 16
    for (int c = 0; c < 64; ++c) { const u32x2 v = *(const u32x2*)(kv + (size_t)c * 16384);
        *(u32x2*)(cs + (size_t)c * 16384) = (u32x2){cvtpk(C.x, C.y), cvtpk(C.z, C.w)};
        const f32x4 kvf = {bflo(v.x), bfhi(v.x), bflo(v.y), bfhi(v.y)};
        C = C * dec[c] + kvf * scl[c]; }
    *(f32x4*)(P.out + O_PC + (size_t)bh * 16384 + e0) = C;
    if (part == 0 && tid < 128) { float n = 0.f; const float* kn = (const float*)(P.ws + WS_KNL) + (size_t)bh * 64 * 128 + tid; float* ns = (float*)(P.ws + WS_NST) + (size_t)bh * 64 * 128 + tid;
#pragma unroll 16
        for (int c = 0; c < 64; ++c) { ns[c * 128] = n; n = n * dec[c] + kn[c * 128] * scl[c]; }
        P.out[O_PN + (size_t)bh * 128 + tid] = n; }
    if (part == 0 && tid >= 128 && tid < 192) ((float*)(P.ws + WS_MST))[bh * 64 + tid - 128] = mst[tid - 128];
    if (part == 0 && tid == 192) P.out[O_PM + bh] = mst[64];
}
struct Ml3In { u32x4 rq[2], rk[2], rv[2], rc[4], g0, g1; float g_ig, g_lf, mprev, nin; };
__device__ __forceinline__ void ml3_load(const Params& P, int item, int tid, int lane, int wave, Ml3In& L) {
    const int bh = item >> 6, c = item & 63, b = bh >> 2, h = bh & 3;
    const size_t row0 = (size_t)b * SEQ + 64 * c;
    const bf16_t* MQ = (const bf16_t*)(P.ws + WS_PROJ); const bf16_t* MK = (const bf16_t*)(P.ws + WS_PROJ + PROJ_STRIDE); const bf16_t* MV = (const bf16_t*)(P.ws + WS_PROJ + 2 * PROJ_STRIDE);
    const bf16_t* MO = (const bf16_t*)(P.ws + WS_PROJ + 3 * PROJ_STRIDE); const float* GT = (const float*)(P.ws + WS_GATES);
    const int prow[2] = {tid >> 4, (tid + 512) >> 4}, pch = tid & 15;
#pragma unroll
    for (int i = 0; i < 2; ++i) { const size_t go = (row0 + prow[i]) * 512 + h * 128 + pch * 8; L.rq[i] = *(const u32x4*)(MQ + go); L.rk[i] = *(const u32x4*)(MK + go); L.rv[i] = *(const u32x4*)(MV + go); }
    const bf16_t* cst = (const bf16_t*)(P.ws + WS_CST) + (size_t)item * 16384;
#pragma unroll
    for (int i = 0; i < 4; ++i) { const int p = tid + 512 * i; L.rc[i] = *(const u32x4*)(cst + (p >> 4) * 128 + (p & 15) * 8); }
    { const size_t row = row0 + (tid >> 3); const int col = h * 128 + (tid & 7) * 16; L.g0 = *(const u32x4*)(MO + row * 512 + col); L.g1 = *(const u32x4*)(MO + row * 512 + col + 8); }
    L.g_ig = 0.f; L.g_lf = 0.f; L.mprev = 0.f; L.nin = 0.f;
    if (wave == 0) { const float* g = GT + (row0 + lane) * 8; L.g_ig = g[h]; L.g_lf = g[4 + h]; L.mprev = ((const float*)(P.ws + WS_MST))[item]; }
    if (tid < 128) L.nin = ((const float*)(P.ws + WS_NST))[(size_t)item * 128 + tid];
}
__device__ __forceinline__ void ml3_item(const Params& P, lptr lds, int item, const Ml3In& L, int tid, int lane, int wave) {
    const int bh = item >> 6, c = item & 63, b = bh >> 2, h = bh & 3, hh = lane >> 5, n31 = lane & 31;
    const size_t row0 = (size_t)b * SEQ + 64 * c;
    bf16_t* YC = (bf16_t*)(P.ws + WS_YCAT);
    LAS float* sc = (LAS float*)(lds + ML_SC);
    LAS float* bt = sc, *as_ = sc + 64, *mt = sc + 128, *winter = sc + 192, *emt = sc + 256, *rsum = sc + 384, *qn = sc + 512, *nvec = sc + 576;
    const int ti = wave >> 2, ej = wave & 3;
    const int prow[2] = {tid >> 4, (tid + 512) >> 4}, pch = tid & 15;
    const float g_ig = L.g_ig, g_lf = L.g_lf, mprev = L.mprev, nin = L.nin;
    __syncthreads();
    if (wave == 0) {
        float bcum = g_lf;
#pragma unroll
        for (int o = 1; o < 64; o <<= 1) { const float v = __shfl_up(bcum, o); if (lane >= o) bcum += v; }
        const float a = g_ig - bcum; float amax = a;
#pragma unroll
        for (int o = 1; o < 64; o <<= 1) { const float v = __shfl_up(amax, o); if (lane >= o) amax = fmaxf(amax, v); }
        const float m_t = fmaxf(bcum + mprev, bcum + amax);
        bt[lane] = bcum; as_[lane] = a; mt[lane] = m_t; winter[lane] = expf(bcum + mprev - m_t); emt[lane] = expf(-m_t);
    }
    if (tid < 128) nvec[tid] = nin;
#pragma unroll
    for (int i = 0; i < 2; ++i) { const int o = prow[i] * ML_P + pch * 16;
        *(LAS u32x4*)(lds + ML_QS + o) = L.rq[i]; *(LAS u32x4*)(lds + ML_KS + o) = L.rk[i]; *(LAS u32x4*)(lds + ML_VS + o) = L.rv[i]; }
#pragma unroll
    for (int i = 0; i < 4; ++i) { const int p = tid + 512 * i; *(LAS u32x4*)(lds + ML_CS + (p >> 4) * ML_P + (p & 15) * 16) = L.rc[i]; }
    __syncthreads();
    f32x16 num;
#pragma unroll
    for (int r = 0; r < 16; ++r) num[r] = 0.f;
#pragma unroll
    for (int ks = 0; ks < 8; ++ks) num = MFMA32(row_frag(lds + ML_QS, ML_P, 32 * ti, 16 * ks, lane), tr_frag(lds + ML_CS, ML_P, 16 * ks, 32 * ej, lane), num);
    if (wave < 3) {
        const int sti = wave == 0 ? 0 : 1, sj = wave == 2 ? 1 : 0;
        const int krow = (n31 & ~12) | ((n31 & 4) << 1) | ((n31 & 8) >> 1);
        f32x16 p;
#pragma unroll
        for (int r = 0; r < 16; ++r) p[r] = 0.f;
#pragma unroll
        for (int ks = 0; ks < 8; ++ks) p = MFMA32(*(const LAS bf16x8*)(lds + ML_KS + (32 * sj + krow) * ML_P + (16 * ks + 8 * hh) * 2), row_frag(lds + ML_QS, ML_P, 32 * sti, 16 * ks, lane), p);
        const int t = 32 * sti + n31; const float bt_t = bt[t], mt_t = mt[t]; float rs = 0.f;
        const LAS float* asb = as_ + 32 * sj + 8 * hh; const int tb = t - (32 * sj + 8 * hh);
#pragma unroll
        for (int r = 0; r < 16; ++r) { const int so = 16 * (r >> 3) + (r & 7);
            const float w = so <= tb ? __expf(bt_t + asb[so] - mt_t) : 0.f; p[r] *= w; rs += p[r]; }
#pragma unroll
        for (int a2 = 0; a2 < 2; ++a2) { u32x4 o; o.x = cvtpk(p[8 * a2 + 0], p[8 * a2 + 1]); o.y = cvtpk(p[8 * a2 + 2], p[8 * a2 + 3]); o.z = cvtpk(p[8 * a2 + 4], p[8 * a2 + 5]); o.w = cvtpk(p[8 * a2 + 6], p[8 * a2 + 7]);
            *(LAS u32x4*)(lds + ML_SS + t * 144 + (32 * sj + 16 * a2 + 8 * hh) * 2) = o; }
        rs += __shfl_xor(rs, 32);
        if (hh == 0) rsum[sj * 64 + t] = rs;
    }
    if (wave >= 4) {
        const int t = (tid - 256) >> 2, part = tid & 3; float s = 0.f;
#pragma unroll 8
        for (int d = 0; d < 32; ++d) s += bf2f(*(const LAS unsigned short*)(lds + ML_QS + t * ML_P + (32 * part + d) * 2)) * nvec[32 * part + d];
        s += __shfl_xor(s, 1); s += __shfl_xor(s, 2);
        if (part == 0) qn[t] = s;
    }
    __syncthreads();
    const LAS float* tb2 = sc + 32 * ti + 4 * hh;
#pragma unroll
    for (int r = 0; r < 16; ++r) num[r] *= tb2[192 + (r & 3) + 8 * (r >> 2)];
#pragma unroll
    for (int ks = 0; ks < 4; ++ks) if (ks < 2 || ti == 1) num = MFMA32(*(const LAS bf16x8*)(lds + ML_SS + (32 * ti + n31) * 144 + (16 * ks + 8 * hh) * 2), tr_frag(lds + ML_VS, ML_P, 16 * ks, 32 * ej, lane), num);
#pragma unroll
    for (int r = 0; r < 16; ++r) { const int o = (r & 3) + 8 * (r >> 2);
        const float den = tb2[192 + o] * tb2[512 + o] + tb2[384 + o] + (ti ? tb2[448 + o] : 0.f);
        const float hv = num[r] / fmaxf(fabsf(den), tb2[256 + o]);
        *(LAS unsigned short*)(lds + ML_QS + (32 * ti + 4 * hh) * ML_P + (32 * ej + n31) * 2 + o * ML_P) = f2bf(hv); }
    __syncthreads();
    { const int t = tid >> 3, part = tid & 7;
      const size_t row = row0 + t; const int col = h * 128 + part * 16;
      const u32x4 g0 = L.g0, g1 = L.g1;
      const u32x4 h0 = *(const LAS u32x4*)(lds + ML_QS + t * ML_P + part * 32), h1 = *(const LAS u32x4*)(lds + ML_QS + t * ML_P + part * 32 + 16);
      float hv[16] = {bflo(h0.x), bfhi(h0.x), bflo(h0.y), bfhi(h0.y), bflo(h0.z), bfhi(h0.z), bflo(h0.w), bfhi(h0.w), bflo(h1.x), bfhi(h1.x), bflo(h1.y), bfhi(h1.y), bflo(h1.z), bfhi(h1.z), bflo(h1.w), bfhi(h1.w)};
      float ss = 0.f;
#pragma unroll
      for (int e = 0; e < 16; ++e) ss += hv[e] * hv[e];
      ss += __shfl_xor(ss, 1); ss += __shfl_xor(ss, 2); ss += __shfl_xor(ss, 4);
      const float rstd = rsqrtf(ss * (1.f / 128.f) + EPS);
      const float gv[16] = {bflo(g0.x), bfhi(g0.x), bflo(g0.y), bfhi(g0.y), bflo(g0.z), bfhi(g0.z), bflo(g0.w), bfhi(g0.w), bflo(g1.x), bfhi(g1.x), bflo(g1.y), bfhi(g1.y), bflo(g1.z), bfhi(g1.z), bflo(g1.w), bfhi(g1.w)};
      const float* mw = P.in[I_MLW] + col;
      float y[16];
#pragma unroll
      for (int e = 0; e < 16; ++e) y[e] = hv[e] * rstd * mw[e] * gv[e];
      u32x4 o0, o1; o0.x = cvtpk(y[0], y[1]); o0.y = cvtpk(y[2], y[3]); o0.z = cvtpk(y[4], y[5]); o0.w = cvtpk(y[6], y[7]); o1.x = cvtpk(y[8], y[9]); o1.y = cvtpk(y[10], y[11]); o1.z = cvtpk(y[12], y[13]); o1.w = cvtpk(y[14], y[15]);
      *(u32x4*)(YC + row * 1024 + col) = o0; *(u32x4*)(YC + row * 1024 + col + 8) = o1; }
}

constexpr int AT_KP = 144, AT_VP = 136, AT_WAVE = 64 * AT_KP + 64 * AT_VP;
__device__ __forceinline__ void sb_step(clptr Kt, clptr Vt, const bf16x8 (&qf)[4], f32x16& o0, f32x16& o1, float& carry, int lane, bool domask, int kq) {
    const int n31 = lane & 31, hh = lane >> 5;
    const int krow = (n31 & ~12) | ((n31 & 4) << 1) | ((n31 & 8) >> 1);
    f32x16 p[2];
#pragma unroll
    for (int r = 0; r < 16; ++r) { p[0][r] = 0.f; p[1][r] = 0.f; }
#pragma unroll
    for (int ks = 0; ks < 4; ++ks) {
        p[0] = MFMA32(*(const LAS bf16x8*)(Kt + krow * AT_KP + (16 * ks + 8 * hh) * 2), qf[ks], p[0]);
        p[1] = MFMA32(*(const LAS bf16x8*)(Kt + (32 + krow) * AT_KP + (16 * ks + 8 * hh) * 2), qf[ks], p[1]);
    }
    f32x16 om[2];
    float town[4], tpar[4];
#pragma unroll
    for (int u = 0; u < 2; ++u)
#pragma unroll
        for (int a = 0; a < 2; ++a) { float tp = 1.f;
#pragma unroll
            for (int j = 0; j < 8; ++j) { const int r = 8 * a + j;
                const float z = fminf(fmaxf(p[u][r], -60.f), 60.f);
                const float e = fast_exp2(-z); float sg = fast_rcp(1.f + e); float o = e * sg;
                if (domask) { const int kl = 32 * u + 16 * a + 8 * hh + j; if (kl >= kq) { sg = 0.f; o = 1.f; } }
                p[u][r] = sg; om[u][r] = o; tp *= o; }
            town[2 * u + a] = tp; }
#pragma unroll
    for (int i = 0; i < 4; ++i) tpar[i] = __shfl_xor(town[i], 32);
    float suf[5]; suf[4] = 1.f;
#pragma unroll
    for (int i = 3; i >= 0; --i) suf[i] = suf[i + 1] * (town[i] * tpar[i]);
    bf16x8 pf[4];
#pragma unroll
    for (int u = 0; u < 2; ++u)
#pragma unroll
        for (int a = 0; a < 2; ++a) { const int pr = 2 * u + a;
            float R = carry * suf[pr + 1] * (hh == 0 ? tpar[pr] : 1.f);
            float av[8];
#pragma unroll
            for (int j = 7; j >= 0; --j) { av[j] = p[u][8 * a + j] * R; R *= om[u][8 * a + j]; }
            u32x4 w; w.x = cvtpk(av[0], av[1]); w.y = cvtpk(av[2], av[3]); w.z = cvtpk(av[4], av[5]); w.w = cvtpk(av[6], av[7]);
            pf[pr] = __builtin_bit_cast(bf16x8, w); }
    carry *= suf[0];
#pragma unroll
    for (int pr = 0; pr < 4; ++pr) {
        o0 = MFMA32(tr_frag(Vt, AT_VP, 16 * pr, 0, lane), pf[pr], o0);
        o1 = MFMA32(tr_frag(Vt, AT_VP, 16 * pr, 32, lane), pf[pr], o1);
    }
}
__device__ __forceinline__ void attn_prompt_item(const Params& P, lptr lds, int b, int rb, int lane, int wave) {
    const int h = wave, n31 = lane & 31, hh = lane >> 5;
    const bf16_t* SQ = (const bf16_t*)(P.ws + WS_PROJ + 4 * PROJ_STRIDE); const bf16_t* SK = (const bf16_t*)(P.ws + WS_PROJ + 5 * PROJ_STRIDE); const bf16_t* SV = (const bf16_t*)(P.ws + WS_PROJ + 6 * PROJ_STRIDE);
    const size_t rowb = (size_t)b * SEQ; const int q0 = 32 * rb;
    lptr Kt = lds + wave * AT_WAVE; lptr Vt = Kt + 64 * AT_KP;
    bf16x8 qf[4];
#pragma unroll
    for (int ks = 0; ks < 4; ++ks) qf[ks] = *(const bf16x8*)(SQ + (rowb + q0 + n31) * 512 + h * 64 + 16 * ks + 8 * hh);
    f32x16 o0, o1;
#pragma unroll
    for (int r = 0; r < 16; ++r) { o0[r] = 0.f; o1[r] = 0.f; }
    float carry = 1.f;
    const int trow = lane >> 3, tch = lane & 7;
    u32x4 kv[8], vv[8];
    const int jt0 = (q0 + 30) >> 6;
#pragma unroll
    for (int i = 0; i < 8; ++i) { const size_t go = (rowb + 64 * jt0 + 8 * i + trow) * 512 + h * 64 + tch * 8; kv[i] = *(const u32x4*)(SK + go); vv[i] = *(const u32x4*)(SV + go); }
    for (int jt = jt0; jt >= 0; --jt) {
#pragma unroll
        for (int i = 0; i < 8; ++i) { const int row = 8 * i + trow;
            *(LAS u32x4*)(Kt + row * AT_KP + tch * 16) = kv[i];
            *(LAS u32x2*)(Vt + row * AT_VP + tch * 16) = (u32x2){vv[i].x, vv[i].y}; *(LAS u32x2*)(Vt + row * AT_VP + tch * 16 + 8) = (u32x2){vv[i].z, vv[i].w}; }
        if (jt > 0) {
#pragma unroll
            for (int i = 0; i < 8; ++i) { const size_t go = (rowb + 64 * (jt - 1) + 8 * i + trow) * 512 + h * 64 + tch * 8; kv[i] = *(const u32x4*)(SK + go); vv[i] = *(const u32x4*)(SV + go); } }
        sb_step(Kt, Vt, qf, o0, o1, carry, lane, 64 * jt + 63 >= q0, q0 + n31 - 64 * jt);
        if (__all(carry < 1e-30f)) break;
    }
    float ss = 0.f;
#pragma unroll
    for (int r = 0; r < 16; ++r) ss += o0[r] * o0[r] + o1[r] * o1[r];
    ss += __shfl_xor(ss, 32);
    const size_t row = rowb + q0 + n31;
    LAS float* sx = (LAS float*)(lds + 8 * AT_WAVE);
    if (hh == 0) sx[wave * 32 + n31] = ss;
    __syncthreads();
    float tot = 0.f;
#pragma unroll
    for (int w2 = 0; w2 < 8; ++w2) tot += sx[w2 * 32 + n31];
    const float rstd = rsqrtf(tot * (1.f / 512.f) + EPS);
    bf16_t* yo = (bf16_t*)(P.ws + WS_YCAT) + row * 1024 + 512 + h * 64 + 4 * hh;
#pragma unroll
    for (int g = 0; g < 4; ++g) {
        *(u32x2*)(yo + 8 * g) = (u32x2){cvtpk(o0[4 * g] * rstd, o0[4 * g + 1] * rstd), cvtpk(o0[4 * g + 2] * rstd, o0[4 * g + 3] * rstd)};
        *(u32x2*)(yo + 32 + 8 * g) = (u32x2){cvtpk(o1[4 * g] * rstd, o1[4 * g + 1] * rstd), cvtpk(o1[4 * g + 2] * rstd, o1[4 * g + 3] * rstd)};
    }
}
__device__ __forceinline__ void attn_sample_item(const Params& P, lptr lds, int bh, int tid, int lane, int wave) {
    const int b = bh >> 3, h = bh & 7, n31 = lane & 31, hh = lane >> 5;
    const bf16_t* SQ = (const bf16_t*)(P.ws + WS_PROJ + 4 * PROJ_STRIDE); const bf16_t* SK = (const bf16_t*)(P.ws + WS_PROJ + 5 * PROJ_STRIDE); const bf16_t* SV = (const bf16_t*)(P.ws + WS_PROJ + 6 * PROJ_STRIDE);
    const size_t rows = (size_t)MP + b * 32;
    lptr Kt = lds + wave * AT_WAVE; lptr Vt = Kt + 64 * AT_KP;
    bf16x8 qf[4];
#pragma unroll
    for (int ks = 0; ks < 4; ++ks) qf[ks] = *(const bf16x8*)(SQ + (rows + n31) * 512 + h * 64 + 16 * ks + 8 * hh);
    f32x16 o0, o1;
#pragma unroll
    for (int r = 0; r < 16; ++r) { o0[r] = 0.f; o1[r] = 0.f; }
    float carry = 1.f;
    if (wave == 7) {
        const int trow = lane >> 3, tch = lane & 7;
#pragma unroll
        for (int i = 0; i < 8; ++i) { const int row = 8 * i + trow; u32x4 kv = {0u, 0u, 0u, 0u}, vv = {0u, 0u, 0u, 0u};
            if (row < 32) { const size_t go = (rows + row) * 512 + h * 64 + tch * 8; kv = *(const u32x4*)(SK + go); vv = *(const u32x4*)(SV + go); }
            *(LAS u32x4*)(Kt + row * AT_KP + tch * 16) = kv;
            *(LAS u32x2*)(Vt + row * AT_VP + tch * 16) = (u32x2){vv.x, vv.y}; *(LAS u32x2*)(Vt + row * AT_VP + tch * 16 + 8) = (u32x2){vv.z, vv.w}; }
        sb_step(Kt, Vt, qf, o0, o1, carry, lane, true, n31);
    }
    const float* CK = P.in[I_CK] + (size_t)b * PAST * 512 + h * 64; const float* CV = P.in[I_CV] + (size_t)b * PAST * 512 + h * 64;
    for (int jt = 4 * wave + 3; jt >= 4 * wave; --jt) {
        const int trow = lane >> 4, c4 = lane & 15;
#pragma unroll
        for (int i = 0; i < 16; ++i) { const int row = 4 * i + trow; const size_t go = (size_t)(64 * jt + row) * 512 + c4 * 4;
            const f32x4 kx = *(const f32x4*)(CK + go), vx = *(const f32x4*)(CV + go);
            *(LAS u32x2*)(Kt + row * AT_KP + c4 * 8) = (u32x2){cvtpk(kx.x, kx.y), cvtpk(kx.z, kx.w)};
            *(LAS u32x2*)(Vt + row * AT_VP + c4 * 8) = (u32x2){cvtpk(vx.x, vx.y), cvtpk(vx.z, vx.w)}; }
        sb_step(Kt, Vt, qf, o0, o1, carry, lane, false, 0);
    }
    __syncthreads();
    LAS float* carr = (LAS float*)(lds + 65536);
    if (hh == 0) carr[wave * 32 + n31] = carry;
    __syncthreads();
    float mult = 1.f;
    for (int w2 = wave + 1; w2 < 8; ++w2) mult *= carr[w2 * 32 + n31];
#pragma unroll
    for (int g = 0; g < 4; ++g) {
        *(LAS f32x4*)(lds + (((wave * 8 + g) * 64 + lane) * 16)) = (f32x4){o0[4 * g] * mult, o0[4 * g + 1] * mult, o0[4 * g + 2] * mult, o0[4 * g + 3] * mult};
        *(LAS f32x4*)(lds + (((wave * 8 + 4 + g) * 64 + lane) * 16)) = (f32x4){o1[4 * g] * mult, o1[4 * g + 1] * mult, o1[4 * g + 2] * mult, o1[4 * g + 3] * mult};
    }
    __syncthreads();
    { const int q = tid >> 4, part = tid & 15; const int slot = (part >> 3) * 4 + ((part & 7) >> 1), ln = q + 32 * (part & 1);
      f32x4 v = {0.f, 0.f, 0.f, 0.f};
#pragma unroll
      for (int w2 = 0; w2 < 8; ++w2) v = v + *(const LAS f32x4*)(lds + (((w2 * 8 + slot) * 64 + ln) * 16));
      float ss = (v.x * v.x + v.y * v.y) + (v.z * v.z + v.w * v.w);
      ss += __shfl_xor(ss, 1); ss += __shfl_xor(ss, 2); ss += __shfl_xor(ss, 4); ss += __shfl_xor(ss, 8);
      const size_t row = rows + q;
      if (part == 0) ((float*)(P.ws + WS_SSQ))[row * 8 + h] = ss;
      *(u32x2*)((bf16_t*)(P.ws + WS_YCAT) + row * 1024 + 512 + h * 64 + part * 4) = (u32x2){cvtpk(v.x, v.y), cvtpk(v.z, v.w)}; }
    __syncthreads();
}
#ifndef M1NC
#define M1NC 2
#endif
constexpr int NQ_G1S = 224, NQ_AT = 1024, NQ_M1 = 2048 / M1NC, NQ_TOTAL = NQ_G1S + NQ_AT + NQ_M1;
template <class EpiS>
__device__ __forceinline__ void phase_mixers(const Params& P, lptr lds, int tid_in, int wave, const EpiS& Es) {
    unsigned* ctr = (unsigned*)(P.ws + WS_CTL);
    int nextitem = 0; if (tid_in == 0) nextitem = (int)atomicAdd(ctr, 1u);
    for (;;) {
        __syncthreads();
        if (tid_in == 0) *(LAS int*)(lds + QOFF) = nextitem;
        __syncthreads();
        int item = *(const LAS int*)(lds + QOFF);
        if (tid_in == 0 && item < NQ_TOTAL) nextitem = (int)atomicAdd(ctr, 1u);
        int tid = tid_in; asm volatile("" : "+v"(tid));
        const int lane = tid & 63;
        if (item >= NQ_TOTAL) break;
        if (item < NQ_G1S) { small_tile<1024, false>((const bf16_t*)(P.ws + WS_H) + (size_t)MP * 1024, (const bf16_t*)(P.ws + WS_W1T), Es, nullptr, lds, item, tid, lane, wave); continue; }
        item -= NQ_G1S;
        if (item < NQ_AT) { attn_prompt_item(P, lds, item & 7, 127 - (item >> 3), lane, wave); continue; }
        item -= NQ_AT;
        ml1_pair<M1NC>(P, lds, item, tid, lane, wave);
    }
}
__device__ __forceinline__ void phase_ml2(const Params& P, lptr lds, int tid_in, int wave) {
    int tid = tid_in; asm volatile("" : "+v"(tid));
    if (blockIdx.x < 160) { for (int job = blockIdx.x; job < 256; job += 160) { __syncthreads(); ml2_scan(P, lds, tid, job); } }
    else if (blockIdx.x < 192) mlstm_item(P, lds, blockIdx.x - 160, true, tid, tid & 63, wave);
    else attn_sample_item(P, lds, blockIdx.x - 192, tid, tid & 63, wave);
}
template <class EpiS>
__device__ __forceinline__ void phase_ml3(const Params& P, lptr lds, int tid_in, int wave, const EpiS& Es) {
    if (blockIdx.x >= 192) { int tid = tid_in; asm volatile("" : "+v"(tid));
        small_tile<1024, true>((const bf16_t*)(P.ws + WS_YCAT) + (size_t)MP * 1024, (const bf16_t*)(P.ws + WS_W2T), Es, (const float*)(P.ws + WS_SSQ), lds, blockIdx.x - 192, tid, tid & 63, wave); }
#ifdef DBL_M3
    for (int rep = 0; rep < 2; ++rep)
#endif
    { int tid = tid_in; asm volatile("" : "+v"(tid));
      Ml3In cur, nxt; ml3_load(P, blockIdx.x, tid, tid & 63, wave, cur);
#pragma unroll 1
      for (int item = blockIdx.x; item < 2048; item += gridDim.x) {
          const int nitem = item + gridDim.x;
          if (nitem < 2048) ml3_load(P, nitem, tid, tid & 63, wave, nxt);
          ml3_item(P, lds, item, cur, tid, tid & 63, wave);
          cur = nxt;
      } }
}

__global__ void __launch_bounds__(512, 2) fwd(Params P) {
    extern __shared__ __attribute__((aligned(16))) unsigned char lds_raw[];
    lptr lds = (lptr)lds_raw;
    cg::grid_group grid = cg::this_grid();
    int tid = threadIdx.x, lane = tid & 63; const int wave = __builtin_amdgcn_readfirstlane(tid >> 6);
#define FRESH_TID() do { asm volatile("" : "+v"(tid)); lane = tid & 63; } while (0)
    const int gw = blockIdx.x * 8 + wave, NGW = gridDim.x * 8;
    unsigned char* ws = P.ws;
    const float* MOD = (const float*)(ws + WS_MOD);
    bf16_t* H = (bf16_t*)(ws + WS_H); bf16_t* PROJ = (bf16_t*)(ws + WS_PROJ); bf16_t* YC = (bf16_t*)(ws + WS_YCAT); bf16_t* ACT = (bf16_t*)(ws + WS_ACT);

#ifndef G_ALIGN
#define G_ALIGN true
#endif
#ifndef G_SP2
#define G_SP2 true
#endif
#ifndef PH
#define PH 0xFFFF
#endif
    if (tid == 0) { *(LAS unsigned*)(lds + LDS_BYTES - 32) = 0u; *(LAS unsigned*)(lds + LDS_BYTES - 28) = 0u; }
    __syncthreads();
    const XcdBarrier bar = xcd_barrier_post((unsigned*)(ws + WS_CTL) + 1024, (volatile LAS unsigned*)(lds + LDS_BYTES - 32));
    if (P.out == nullptr) grid.sync();
    phase0(P, lds, tid, lane, wave);
#ifdef DBL_P0
    __syncthreads(); phase0(P, lds, tid, lane, wave);
#endif
    xcd_barrier(bar);
    FRESH_TID();
    phase1(P, lds, tid, lane, wave);
    __syncthreads();
    phase_weights(P, lds, lane, wave);
#ifdef DBL_P1
    __syncthreads(); phase1(P, lds, tid, lane, wave);
#endif
#ifdef DBL_P1NG
    __syncthreads(); phase1_nogates(P, lds, tid, lane, wave);
#endif
#ifdef DBL_W
    __syncthreads(); phase_weights(P, lds, lane, wave);
#endif
    xcd_barrier(bar);
    FRESH_TID();
    {
        EpiProj E{PROJ, P.out + O_PK, P.out + O_PV, P.in[I_SQW], P.in[I_SKW], 0};
        pg8::Gemm g{H, (const bf16_t*)(ws + WS_W1T), MP, NPROJ, 1024}; pg8::StaticOrder S; S.init(MP, NPROJ, gridDim.x, (int)blockIdx.x);
        pg8::gemm_phase<EpiProj, pg8::StaticOrder, G_ALIGN, G_SP2>(lds, g, S, E);
#ifdef DBL_G
        pg8::gemm_phase<EpiProj, pg8::StaticOrder, G_ALIGN, G_SP2>(lds, g, S, E);
#endif
    }
    xcd_barrier(bar);
    FRESH_TID();
    {
        EpiProj Es{PROJ, P.out + O_SK, P.out + O_SV, P.in[I_SQW], P.in[I_SKW], MP};
        phase_mixers(P, lds, tid, wave, Es);
    }
    xcd_barrier(bar);
    FRESH_TID();
    phase_ml2(P, lds, tid, wave);
#ifdef DBL_M2
    __syncthreads(); phase_ml2(P, lds, tid, wave);
#endif
    xcd_barrier(bar);
    FRESH_TID();
    {
        EpiRes<0> Es{P.in[I_XS], (bf16_t*)(ws + WS_X1B) + (size_t)MP * 1024, MOD + 8 * 6144 + 2048, 5};
        phase_ml3(P, lds, tid, wave, Es);
    }
#ifdef XSYNC
    for (int i = 0; i < XSYNC; ++i) xcd_barrier(bar);
#endif
    xcd_barrier(bar);
    FRESH_TID();
    {
        sample_h2_row(P, lds, tid, lane, wave);
        EpiRes<0> E{P.in[I_XP], ws + WS_X1B, MOD + 2048, 12};
        pg8::Gemm g{YC, (const bf16_t*)(ws + WS_W2T), MP, 1024, 1024}; pg8::StaticOrder S; S.init(MP, 1024, gridDim.x, (int)blockIdx.x);
        pg8::gemm_phase<EpiRes<0>, pg8::StaticOrder, G_ALIGN, G_SP2>(lds, g, S, E);
    }
    xcd_barrier(bar);
    FRESH_TID();
    {
        phase5(P, lds, tid, lane, wave);
#ifdef DBL_P5
        phase5(P, lds, tid, lane, wave);
#endif
        EpiFFNs Es{ACT, P.out + O_SF, P.in[I_SFC], P.in[I_WCONV], P.in[I_BCONV]};
        for (int t = blockIdx.x; t < 352; t += gridDim.x) small_tile<1024, false>(H + (size_t)MP * 1024, (const bf16_t*)(ws + WS_W3T), Es, nullptr, lds, t, tid, lane, wave);
    }
    xcd_barrier(bar);
    FRESH_TID();
    {
        EpiFFN E{ACT, (float*)(ws + WS_UEDGE), P.out + O_PF, P.in[I_WCONV], P.in[I_BCONV]};
        pg8::Gemm g{H, (const bf16_t*)(ws + WS_W3T), MP, FF2, 1024}; pg8::StaticOrder S; S.init(MP, FF2, gridDim.x, (int)blockIdx.x);
        pg8::gemm_phase<EpiFFN, pg8::StaticOrder, true, G_SP2>(lds, g, S, E);
#ifdef DBL_G
        pg8::gemm_phase<EpiFFN, pg8::StaticOrder, true, G_SP2>(lds, g, S, E);
#endif
    }
    xcd_barrier(bar);
    FRESH_TID();
    {
        phase_fix(P, tid);
        EpiRes<1> Es{(const bf16_t*)(ws + WS_X1B) + (size_t)MP * 1024, P.out + O_YS, MOD + 8 * 6144 + 5120, 5};
        if (blockIdx.x < 64) small_tile<FF, false>(ACT + (size_t)MP * FF, (const bf16_t*)(ws + WS_W4T), Es, nullptr, lds, blockIdx.x, tid, lane, wave);
    }
    xcd_barrier(bar);
    FRESH_TID();
    {
        EpiRes<1> E{ws + WS_X1B, P.out + O_YP, MOD + 5120, 12};
        pg8::Gemm g{ACT, (const bf16_t*)(ws + WS_W4T), MP, 1024, FF}; pg8::StaticOrder S; S.init(MP, 1024, gridDim.x, (int)blockIdx.x);
        pg8::gemm_phase<EpiRes<1>, pg8::StaticOrder, G_ALIGN, G_SP2>(lds, g, S, E);
    }

#ifdef DIAG
    xcd_barrier(bar);
    {
        const size_t offs[15] = {O_YP, O_YS, O_PC, O_PN, O_PM, O_PK, O_PV, O_PF, O_SC, O_SN, O_SM, O_SK, O_SV, O_SF, O_END};
        for (int o = 0; o < 14; ++o) if ((DIAG >> o) & 1) for (size_t i = offs[o] + (size_t)blockIdx.x * 512 + tid; i < offs[o + 1]; i += (size_t)gridDim.x * 512) P.out[i] *= 1.2f;
    }
#endif
}

extern "C" void kernel_launch(void* const* d_in, const int* in_sizes, int n_in, void* d_out, int out_size, void* d_ws, size_t ws_size, hipStream_t stream) {
    static int grid_blocks = 0;
    if (!grid_blocks) {
        int dev = 0, cus = 0, per_cu = 0;
        (void)hipGetDevice(&dev);
        (void)hipDeviceGetAttribute(&cus, hipDeviceAttributeMultiprocessorCount, dev);
        (void)hipFuncSetAttribute((const void*)fwd, hipFuncAttributeMaxDynamicSharedMemorySize, LDS_BYTES);
        (void)hipOccupancyMaxActiveBlocksPerMultiprocessor(&per_cu, (const void*)fwd, 512, LDS_BYTES);
        grid_blocks = cus;
        if (n_in != 26 || out_size != (int)O_END || ws_size < WS_END2 || cus != 256 || per_cu < 1) {
            fprintf(stderr, "kernel_launch: unexpected geometry: n_in %d out %d ws %zu cus %d per_cu %d\n", n_in, out_size, ws_size, cus, per_cu);
            if (n_in != 26 || out_size != (int)O_END || ws_size < WS_END2 || cus != 256) grid_blocks = -1;
        }
    }
    if (grid_blocks < 0) return;
    if (hipMemsetAsync((char*)d_ws + WS_CTL, 0, WS_MOD + 16 * 6144 * 4, stream) != hipSuccess) { fprintf(stderr, "kernel_launch: memset of the control words failed\n"); return; }
    Params p{};
    for (int i = 0; i < 26; ++i) p.in[i] = (const float*)d_in[i];
    p.out = (float*)d_out; p.ws = (unsigned char*)d_ws;
    void* args[] = {&p};
    hipError_t e = hipLaunchCooperativeKernel((const void*)fwd, dim3(grid_blocks), dim3(512), args, LDS_BYTES, stream);
    if (e != hipSuccess) fprintf(stderr, "cooperative launch failed: %s (grid %d)\n", hipGetErrorString(e), grid_blocks);
}
```

```cpp
#include <hip/hip_runtime.h>
#include <hip/hip_cooperative_groups.h>
#include <cstdio>
#include <cstdint>
namespace cg = cooperative_groups;

#define LAS __attribute__((address_space(3)))
typedef unsigned short bf16_t;
typedef short bf16x8 __attribute__((ext_vector_type(8)));
typedef short s16x4 __attribute__((ext_vector_type(4)));
typedef float f32x2 __attribute__((ext_vector_type(2)));
typedef float f32x4 __attribute__((ext_vector_type(4)));
typedef float f32x16 __attribute__((ext_vector_type(16)));
typedef unsigned u32x2 __attribute__((ext_vector_type(2)));
typedef unsigned u32x4 __attribute__((ext_vector_type(4)));
typedef __bf16 bf16x2_t __attribute__((ext_vector_type(2)));
typedef LAS unsigned char* lptr;
typedef const LAS unsigned char* clptr;

constexpr int DM = 1024, SEQ = 4096, NB = 8, MP = NB * SEQ, DEC = 32, MS = NB * DEC, MT = MP + MS, PAST = 2048;
constexpr int DIN = 3592, NPROJ = 3584, FF = 2816, FF2 = 5632;
constexpr float EPS = 1e-6f;
constexpr float LOG2E = 1.4426950408889634f;
constexpr size_t O_YP = 0, O_YS = 33554432, O_PC = 33816576, O_PN = 34340864, O_PM = 34344960, O_PK = 34344992, O_PV = 51122208,
                 O_PF = 67899424, O_SC = 67989536, O_SN = 68513824, O_SM = 68517920, O_SK = 68517952, O_SV = 68649024, O_SF = 68780096, O_END = 68870208;
constexpr size_t MiB = 1u << 20;
constexpr size_t WS_CTL = 0, WS_MODP = 1 * MiB  , WS_MOD = 65536  , WS_GATES = 8 * MiB, WS_SSQ = 10 * MiB, WS_UEDGE = 12 * MiB,
                 WS_W1T = 24 * MiB, WS_W2T = 31 * MiB, WS_W3T = 33 * MiB, WS_W4T = 44 * MiB, WS_H = 52 * MiB, WS_PROJ = 120 * MiB,
                 PROJ_STRIDE = 33 * MiB, WS_YCAT = 352 * MiB, WS_ACT = 120 * MiB, WS_END = 420 * MiB;
constexpr size_t WS_X1B = 424 * MiB;
constexpr int LDS_BYTES = 147456;
constexpr int QOFF = LDS_BYTES - 64;

struct Params { const float* in[26]; float* out; unsigned char* ws; };
enum { I_XP = 0, I_XS, I_CP, I_CS, I_STC, I_STN, I_STM, I_CK, I_CV, I_SFC, I_WADA, I_BADA, I_N1W, I_WIN, I_BIG, I_BFG, I_MLW, I_SQW, I_SKW, I_SOW,
       I_WOUT, I_N2W, I_WUP, I_WCONV, I_BCONV, I_WDOWN };

__device__ __forceinline__ unsigned cvtpk(float lo, float hi) { f32x2 v = {lo, hi}; bf16x2_t b = __builtin_convertvector(v, bf16x2_t); return __builtin_bit_cast(unsigned, b); }
__device__ __forceinline__ float bf2f(unsigned short x) { return __uint_as_float((unsigned)x << 16); }
__device__ __forceinline__ float bflo(unsigned w) { return __uint_as_float(w << 16); }
__device__ __forceinline__ float bfhi(unsigned w) { return __uint_as_float(w & 0xffff0000u); }
__device__ __forceinline__ unsigned short f2bf(float f) { return (unsigned short)(cvtpk(f, 0.f) & 0xffffu); }
__device__ __forceinline__ float wave_sum(float v) {
#pragma unroll
    for (int o = 1; o < 64; o <<= 1) v += __shfl_xor(v, o);
    return v;
}
__device__ __forceinline__ float fast_exp2(float x) { return __builtin_amdgcn_exp2f(x); }
__device__ __forceinline__ float fast_rcp(float x) { return __builtin_amdgcn_rcpf(x); }
__device__ __forceinline__ float sigmoidf_(float x) { return fast_rcp(1.f + fast_exp2(-x * LOG2E)); }
__device__ __forceinline__ int crow(int r, int hi) { return (r & 3) + 8 * (r >> 2) + 4 * hi; }
typedef short v4i16_t __attribute__((ext_vector_type(4)));
__device__ __forceinline__ s16x4 tr_read(clptr p) { return __builtin_bit_cast(s16x4, __builtin_amdgcn_ds_read_tr16_b64_v4i16((LAS v4i16_t*)p)); }
__device__ __forceinline__ bf16x8 tr_frag(clptr base, int P, int R0, int C0, int lane) {
    const int h = lane >> 5, blk = (lane >> 4) & 1, q = (lane & 15) >> 2, p = lane & 3;
    clptr a = base + (R0 + 8 * h + q) * P + (C0 + 16 * blk + 4 * p) * 2;
    const s16x4 lo = tr_read(a), hi = tr_read(a + 4 * P);
    return (bf16x8){lo[0], lo[1], lo[2], lo[3], hi[0], hi[1], hi[2], hi[3]};
}
__device__ __forceinline__ bf16x8 row_frag(clptr base, int P, int R0, int K0, int lane) {
    return *(const LAS bf16x8*)(base + (R0 + (lane & 31)) * P + (K0 + 8 * (lane >> 5)) * 2);
}
#define MFMA32(a, b, c) __builtin_amdgcn_mfma_f32_32x32x16_bf16((a), (b), (c), 0, 0, 0)
#define MFMA16(a, b, c) __builtin_amdgcn_mfma_f32_16x16x32_bf16((a), (b), (c), 0, 0, 0)

namespace pg8 {
#define PG8_LAS __attribute__((address_space(3)))
typedef unsigned short bf16_t;
typedef short bf16x8 __attribute__((ext_vector_type(8)));
typedef float f32x4 __attribute__((ext_vector_type(4)));
typedef unsigned u32x4 __attribute__((ext_vector_type(4)));
constexpr int BM = 256, BK = 64, HALF = 128, HTB = HALF * BK * 2  , STAGE_BYTES = 8 * HTB, NXCD = 8, WGM = 8;

__host__ __device__ __forceinline__ int lds_byte(int r, int c) { const int st = (r >> 4) * 2 + (c >> 5), rr = r & 15, cc = c & 31, ob = rr * 64 + cc * 2; return st * 1024 + (ob ^ (((ob >> 9) & 1) << 5)); }
__host__ __device__ __forceinline__ void stage_rc(int b, int& R, int& C) { const int st = b / 1024, sb = b % 1024, swz = sb ^ (((sb >> 9) & 1) << 5); R = (st >> 1) * 16 + swz / 64; C = (st & 1) * 32 + (swz % 64) / 2; }
__host__ __device__ __forceinline__ int perm32(int rho) { const int n = rho >> 4, i = rho & 15; return 8 * (i >> 2) + 4 * n + (i & 3); }

struct Unit { int pm, pn; };
struct Gemm { const bf16_t* A; const bf16_t* Bt; int M, N, K; };

struct StaticOrder {
    int nM, nN, nwg, G, c;
    __host__ __device__ void init(int M, int N, int G_, int c_) { nM = M / BM; nN = N / BM; nwg = nM * nN; G = G_; c = c_; }
    __host__ __device__ bool next(int i, Unit& u) const {
        const long L = (long)i * G + c; if (L >= nwg) return false;
        int wgid = (int)L; { const int q = nwg / NXCD, r = nwg % NXCD, xcd = wgid % NXCD, off = wgid / NXCD; wgid = (xcd < r ? xcd * (q + 1) : r * (q + 1) + (xcd - r) * q) + off; }
        const int nig = WGM * nN, gid = wgid / nig, fm = gid * WGM, gsz = (nM - fm) < WGM ? (nM - fm) : WGM;
        u.pm = fm + ((wgid % nig) % gsz); u.pn = (wgid % nig) / gsz; return true;
    }
    __device__ __forceinline__ void a_ready(const Unit&) const {}
    __device__ __forceinline__ void done(const Unit&) const {}
};

template <class Epi, class Sched, bool ALIGN_EPI = false, bool SP2 = false>
__device__ __forceinline__ void gemm_phase(PG8_LAS unsigned char* lds, const Gemm g, const Sched& S, const Epi& E) {
    int tid_o = threadIdx.x; asm volatile("" : "+v"(tid_o));
    const int tid = tid_o, wid = __builtin_amdgcn_readfirstlane(tid >> 6), lane = tid & 63, wr = wid >> 2, wc = wid & 3, fr = lane & 15, fq = lane >> 4;
    const int K = g.K, nt = K / BK;
    unsigned voffA[2], voffB[2];
#pragma unroll
    for (int i = 0; i < 2; ++i) { int R, C; stage_rc(tid * 16 + i * 8192, R, C); const int Rb = Epi::PERM ? ((R & ~31) + perm32(R & 31)) : R;
        voffA[i] = (unsigned)(R * K + C) * 2u; voffB[i] = (unsigned)(Rb * K + C) * 2u; }
    const size_t kstep = (size_t)(BK * 2);
    const size_t hstep = (size_t)HALF * K * 2;
    const size_t tstep = 2 * hstep;
    const unsigned ldsw = (unsigned)wid * 1024u;
    const int aoff = lds_byte(wr * 64 + fr, fq * 8), boff = lds_byte(wc * 32 + fr, fq * 8);
#define PG8_SA(b, h) (((b) * 2 + (h)) * HTB)
#define PG8_SB(b, h) ((4 + (b) * 2 + (h)) * HTB)
#define PG8_STAGE(bufoff, gbase, voff) do { _Pragma("unroll") for (int _i = 0; _i < 2; ++_i) \
        __builtin_amdgcn_global_load_lds((const unsigned*)((const char*)(gbase) + (voff)[_i]), (PG8_LAS unsigned*)(lds + (bufoff) + ldsw + _i * 8192), 16, 0, 0); } while (0)
#define PG8_LDA(dst, b, h) do { _Pragma("unroll") for (int m = 0; m < 4; ++m) _Pragma("unroll") for (int k = 0; k < 2; ++k) dst[m][k] = *(const PG8_LAS bf16x8*)(lds + PG8_SA(b, h) + aoff + m * 2048 + k * 1024); } while (0)
#define PG8_LDB(dst, b, h) do { _Pragma("unroll") for (int n = 0; n < 2; ++n) _Pragma("unroll") for (int k = 0; k < 2; ++k) dst[n][k] = *(const PG8_LAS bf16x8*)(lds + PG8_SB(b, h) + boff + n * 2048 + k * 1024); } while (0)
#define PG8_MMA(ai, bj, At, Bt) do { __builtin_amdgcn_s_setprio(1); _Pragma("unroll") for (int m = 0; m < 4; ++m) _Pragma("unroll") for (int n = 0; n < 2; ++n) _Pragma("unroll") for (int k = 0; k < 2; ++k) \
        acc[ai][bj][m][n] = __builtin_amdgcn_mfma_f32_16x16x32_bf16(Bt[n][k], At[m][k], acc[ai][bj][m][n], 0, 0, 0); __builtin_amdgcn_s_setprio(0); } while (0)
#define PG8_WAIT_V(n) asm volatile("s_waitcnt vmcnt(" #n ")" ::: "memory")
#define PG8_WAIT_L(n) asm volatile("s_waitcnt lgkmcnt(" #n ")" ::: "memory")
#define PG8_BAR __builtin_amdgcn_s_barrier()
#define PG8_SCHED __builtin_amdgcn_sched_barrier(0)
    Unit cur, nxt; int ui = 0;
    if (!S.next(0, cur)) return;
    f32x4 acc[2][2][4][2];
#pragma unroll
    for (int a = 0; a < 2; ++a)
#pragma unroll
        for (int b = 0; b < 2; ++b)
#pragma unroll
            for (int m = 0; m < 4; ++m)
#pragma unroll
                for (int n = 0; n < 2; ++n) acc[a][b][m][n] = (f32x4){0.f, 0.f, 0.f, 0.f};
    bf16x8 At[4][2], B0[2][2], B1[2][2];
    const char* cA = (const char*)g.A + (size_t)cur.pm * tstep; const char* cB = (const char*)g.Bt + (size_t)cur.pn * tstep;
    S.a_ready(cur);
    if constexpr (SP2) {
        PG8_STAGE(PG8_SB(0, 0), cB, voffB); PG8_STAGE(PG8_SB(0, 1), cB + hstep, voffB); PG8_STAGE(PG8_SA(0, 0), cA, voffA); PG8_STAGE(PG8_SA(0, 1), cA + hstep, voffA);
        if (wr == 1) PG8_BAR;
        PG8_WAIT_V(2); PG8_BAR;
        PG8_STAGE(PG8_SB(1, 0), cB + kstep, voffB); PG8_STAGE(PG8_SA(1, 0), cA + kstep, voffA); PG8_STAGE(PG8_SB(1, 1), cB + hstep + kstep, voffB);
        PG8_WAIT_V(6); PG8_BAR;
    } else {
        PG8_STAGE(PG8_SB(0, 0), cB, voffB); PG8_STAGE(PG8_SA(0, 0), cA, voffA); PG8_STAGE(PG8_SB(0, 1), cB + hstep, voffB); PG8_STAGE(PG8_SA(0, 1), cA + hstep, voffA);
        if (wr == 1) PG8_BAR;
        PG8_WAIT_V(4); PG8_BAR;
        PG8_STAGE(PG8_SB(1, 0), cB + kstep, voffB); PG8_STAGE(PG8_SA(1, 0), cA + kstep, voffA); PG8_STAGE(PG8_SB(1, 1), cB + hstep + kstep, voffB);
        PG8_WAIT_V(6); PG8_BAR;
    }
    for (;;) {
        const bool has_next = S.next(ui + 1, nxt);
        const char* nA = has_next ? (const char*)g.A + (size_t)nxt.pm * tstep : cA; const char* nB = has_next ? (const char*)g.Bt + (size_t)nxt.pn * tstep : cB;
        for (int t = 0; t < nt; t += 2) {
            const bool last = (t == nt - 2);
            const char* a1 = cA + (size_t)(t + 1) * kstep;
            const char* a2 = last ? nA : cA + (size_t)(t + 2) * kstep; const char* b2 = last ? nB : cB + (size_t)(t + 2) * kstep;
            const char* a3 = a2 + kstep; const char* b3 = b2 + kstep;
            if (last && has_next) S.a_ready(nxt);
            if constexpr (SP2) {
            PG8_LDB(B0, 0, 0); PG8_LDB(B1, 0, 1); PG8_SCHED; PG8_LDA(At, 0, 0); PG8_STAGE(PG8_SA(1, 1), a1 + hstep, voffA);
            PG8_WAIT_V(8); PG8_WAIT_L(0); PG8_BAR; PG8_MMA(0, 0, At, B0); PG8_MMA(0, 1, At, B1); PG8_BAR; PG8_SCHED;
            PG8_LDA(At, 0, 1); PG8_STAGE(PG8_SB(0, 0), b2, voffB); PG8_STAGE(PG8_SB(0, 1), b2 + hstep, voffB); PG8_STAGE(PG8_SA(0, 0), a2, voffA);
            PG8_WAIT_V(8); PG8_WAIT_L(0); PG8_BAR; PG8_MMA(1, 0, At, B0); PG8_MMA(1, 1, At, B1); PG8_BAR; PG8_SCHED;
            PG8_LDB(B0, 1, 0); PG8_LDB(B1, 1, 1); PG8_SCHED; PG8_LDA(At, 1, 0); PG8_STAGE(PG8_SA(0, 1), a2 + hstep, voffA);
            PG8_WAIT_V(8); PG8_WAIT_L(0); PG8_BAR; PG8_MMA(0, 0, At, B0); PG8_MMA(0, 1, At, B1); PG8_BAR; PG8_SCHED;
            PG8_LDA(At, 1, 1); PG8_STAGE(PG8_SB(1, 0), b3, voffB); PG8_STAGE(PG8_SB(1, 1), b3 + hstep, voffB); PG8_STAGE(PG8_SA(1, 0), a3, voffA);
            PG8_WAIT_V(8); PG8_WAIT_L(0); PG8_BAR; PG8_MMA(1, 0, At, B0); PG8_MMA(1, 1, At, B1); PG8_BAR; PG8_SCHED;
            } else {
            PG8_LDB(B0, 0, 0); PG8_SCHED; PG8_LDA(At, 0, 0); PG8_STAGE(PG8_SA(1, 1), a1 + hstep, voffA);
            PG8_WAIT_L(8); PG8_BAR; PG8_WAIT_L(0); PG8_MMA(0, 0, At, B0); PG8_BAR; PG8_SCHED;
            PG8_LDB(B1, 0, 1); PG8_STAGE(PG8_SB(0, 0), b2, voffB);
            PG8_BAR; PG8_WAIT_L(0); PG8_MMA(0, 1, At, B1); PG8_BAR;
            PG8_LDA(At, 0, 1); PG8_STAGE(PG8_SA(0, 0), a2, voffA);
            PG8_BAR; PG8_WAIT_L(0); PG8_MMA(1, 0, At, B0); PG8_BAR; PG8_SCHED;
            PG8_STAGE(PG8_SB(0, 1), b2 + hstep, voffB);
            PG8_WAIT_V(6); PG8_BAR; PG8_MMA(1, 1, At, B1); PG8_BAR;
            PG8_LDB(B0, 1, 0); PG8_SCHED; PG8_LDA(At, 1, 0); PG8_STAGE(PG8_SA(0, 1), a2 + hstep, voffA);
            PG8_WAIT_L(8); PG8_BAR; PG8_WAIT_L(0); PG8_MMA(0, 0, At, B0); PG8_BAR; PG8_SCHED;
            PG8_LDB(B1, 1, 1); PG8_STAGE(PG8_SB(1, 0), b3, voffB);
            PG8_BAR; PG8_WAIT_L(0); PG8_MMA(0, 1, At, B1); PG8_BAR;
            PG8_LDA(At, 1, 1); PG8_STAGE(PG8_SA(1, 0), a3, voffA);
            PG8_BAR; PG8_WAIT_L(0); PG8_MMA(1, 0, At, B0); PG8_BAR; PG8_SCHED;
            PG8_STAGE(PG8_SB(1, 1), b3 + hstep, voffB);
            PG8_WAIT_V(6); PG8_BAR; PG8_MMA(1, 1, At, B1); PG8_BAR;
            }
        }
        if constexpr (ALIGN_EPI) { if (wr == 0) PG8_BAR; }
        if constexpr (!Epi::AFTER_DRAIN) { E(acc, cur, wr, wc, fr, fq, lds); S.done(cur); }
        if (!has_next) break;
#pragma unroll
        for (int a = 0; a < 2; ++a)
#pragma unroll
            for (int b = 0; b < 2; ++b)
#pragma unroll
                for (int m = 0; m < 4; ++m)
#pragma unroll
                    for (int n = 0; n < 2; ++n) acc[a][b][m][n] = (f32x4){0.f, 0.f, 0.f, 0.f};
        cur = nxt; cA = nA; cB = nB; ++ui;
        if constexpr (ALIGN_EPI) { if (wr == 1) PG8_BAR; }
    }
    PG8_WAIT_V(0);
    if constexpr (!ALIGN_EPI) { if (wr == 0) PG8_BAR; }
    PG8_BAR;
    if constexpr (Epi::AFTER_DRAIN) { E.fused(acc, cur, wr, wc, fr, fq, lds, wid, lane); S.done(cur); }
#undef PG8_SA
#undef PG8_SB
#undef PG8_STAGE
#undef PG8_LDA
#undef PG8_LDB
#undef PG8_MMA
#undef PG8_WAIT_V
#undef PG8_WAIT_L
#undef PG8_BAR
#undef PG8_SCHED
}
}

__device__ __forceinline__ u32x4 pack8(const f32x4& v0, const f32x4& v1) { u32x4 w; w.x = cvtpk(v0[0], v0[1]); w.y = cvtpk(v0[2], v0[3]); w.z = cvtpk(v1[0], v1[1]); w.w = cvtpk(v1[2], v1[3]); return w; }

struct EpiProj {
    static constexpr bool PERM = true, AFTER_DRAIN = false;
    bf16_t* proj; float* outK; float* outV; const float* qw; const float* kw; int rowoff;
    __device__ __forceinline__ void sub(const f32x4 (&a)[2][4][2], int pn, int rloc0, int wc, int fr, int fq) const {
        const int kind = pn >> 1, half = pn & 1;
        const int c8 = 256 * half + 64 * wc + 8 * fq;
        bf16_t* ob = proj + (size_t)kind * (PROJ_STRIDE / 2);
        if (kind < 4) {
#pragma unroll
            for (int m = 0; m < 4; ++m) { const size_t row = (size_t)(rowoff + rloc0 + 16 * m + fr);
#pragma unroll
                for (int bj = 0; bj < 2; ++bj) { f32x4 v0 = a[bj][m][0], v1 = a[bj][m][1];
                    if (kind == 1) { v0 = v0 * 0.08838834764831845f; v1 = v1 * 0.08838834764831845f; }
                    if (kind == 3) {
#pragma unroll
                        for (int e = 0; e < 4; ++e) { v0[e] = sigmoidf_(v0[e]); v1[e] = sigmoidf_(v1[e]); } }
                    *(u32x4*)(ob + row * 512 + c8 + 32 * bj) = pack8(v0, v1); } }
        } else if (kind < 6) {
            const float* w = kind == 4 ? qw : kw; const float osc = kind == 4 ? 0.125f * LOG2E : 1.f;
            f32x4 wv[2][2];
#pragma unroll
            for (int bj = 0; bj < 2; ++bj)
#pragma unroll
                for (int n = 0; n < 2; ++n) wv[bj][n] = *(const f32x4*)(w + 32 * bj + 8 * fq + 4 * n);
#pragma unroll
            for (int m = 0; m < 4; ++m) { const int rl = rloc0 + 16 * m + fr; float ss = 0.f;
#pragma unroll
                for (int bj = 0; bj < 2; ++bj)
#pragma unroll
                    for (int n = 0; n < 2; ++n) { const f32x4 x = a[bj][m][n]; ss += (x[0] * x[0] + x[1] * x[1]) + (x[2] * x[2] + x[3] * x[3]); }
                ss += __shfl_xor(ss, 16); ss += __shfl_xor(ss, 32);
                const float rstd = rsqrtf(ss * (1.f / 64.f) + EPS);
#pragma unroll
                for (int bj = 0; bj < 2; ++bj) { f32x4 v0 = a[bj][m][0] * rstd * wv[bj][0], v1 = a[bj][m][1] * rstd * wv[bj][1];
                    if (kind == 5) { float* o = outK + (size_t)rl * 512 + c8 + 32 * bj; __builtin_nontemporal_store(v0, (f32x4*)o); __builtin_nontemporal_store(v1, (f32x4*)(o + 4)); }
                    v0 = v0 * osc; v1 = v1 * osc;
                    *(u32x4*)(ob + (size_t)(rowoff + rl) * 512 + c8 + 32 * bj) = pack8(v0, v1); } }
        } else {
#pragma unroll
            for (int m = 0; m < 4; ++m) { const int rl = rloc0 + 16 * m + fr;
#pragma unroll
                for (int bj = 0; bj < 2; ++bj) { const f32x4 v0 = a[bj][m][0], v1 = a[bj][m][1];
                    float* o = outV + (size_t)rl * 512 + c8 + 32 * bj; __builtin_nontemporal_store(v0, (f32x4*)o); __builtin_nontemporal_store(v1, (f32x4*)(o + 4));
                    *(u32x4*)(ob + (size_t)(rowoff + rl) * 512 + c8 + 32 * bj) = pack8(v0, v1); } }
        }
    }
    __device__ __forceinline__ void operator()(const f32x4 (&acc)[2][2][4][2], const pg8::Unit& u, int wr, int wc, int fr, int fq, lptr) const {
#pragma unroll
        for (int ai = 0; ai < 2; ++ai) sub(acc[ai], u.pn, u.pm * 256 + ai * 128 + wr * 64, wc, fr, fq);
    }
};

template <int MODE>
struct EpiRes {
    static constexpr bool PERM = true, AFTER_DRAIN = false;
    const void* xin; void* xout; const float* gate; int tlog;
    __device__ __forceinline__ void sub(const f32x4 (&a)[2][4][2], int pn, int rloc0, int wc, int fr, int fq) const {
#pragma unroll
        for (int m = 0; m < 4; ++m) { const int rl = rloc0 + 16 * m + fr; const float* g = gate + (size_t)(rl >> tlog) * 6144;
#pragma unroll
            for (int bj = 0; bj < 2; ++bj) { const int c = 256 * pn + 128 * bj + 32 * wc + 8 * fq;
                const f32x4 g0 = *(const f32x4*)(g + c), g1 = *(const f32x4*)(g + c + 4);
                if (MODE == 0) {
                    const float* xp = (const float*)xin + (size_t)rl * 1024 + c;
                    const f32x4 o0 = *(const f32x4*)xp + g0 * a[bj][m][0], o1 = *(const f32x4*)(xp + 4) + g1 * a[bj][m][1];
                    *(u32x4*)((bf16_t*)xout + (size_t)rl * 1024 + c) = pack8(o0, o1);
                } else {
                    const u32x4 xv = *(const u32x4*)((const bf16_t*)xin + (size_t)rl * 1024 + c);
                    const f32x4 x0 = {bflo(xv.x), bfhi(xv.x), bflo(xv.y), bfhi(xv.y)}, x1 = {bflo(xv.z), bfhi(xv.z), bflo(xv.w), bfhi(xv.w)};
                    float* op = (float*)xout + (size_t)rl * 1024 + c;
                    __builtin_nontemporal_store(x0 + g0 * a[bj][m][0], (f32x4*)op); __builtin_nontemporal_store(x1 + g1 * a[bj][m][1], (f32x4*)(op + 4));
                } } }
    }
    __device__ __forceinline__ void operator()(const f32x4 (&acc)[2][2][4][2], const pg8::Unit& u, int wr, int wc, int fr, int fq, lptr) const {
#pragma unroll
        for (int ai = 0; ai < 2; ++ai) sub(acc[ai], u.pn, u.pm * 256 + ai * 128 + wr * 64, wc, fr, fq);
    }
};

__device__ __forceinline__ float dpp_ror1(float x) { return __int_as_float(__builtin_amdgcn_update_dpp(0, __float_as_int(x), 0x121, 0xf, 0xf, false)); }
__device__ __forceinline__ float dpp_ror2(float x) { return __int_as_float(__builtin_amdgcn_update_dpp(0, __float_as_int(x), 0x122, 0xf, 0xf, false)); }
struct ConvW { f32x4 w0a, w1a, w2a, ba, w0g, w1g, w2g, bg; };
__device__ __forceinline__ ConvW load_convw(const float* wconv, const float* bconv, int c) {
    ConvW w; w.w0a = *(const f32x4*)(wconv + c); w.w1a = *(const f32x4*)(wconv + FF2 + c); w.w2a = *(const f32x4*)(wconv + 2 * FF2 + c); w.ba = *(const f32x4*)(bconv + c);
    w.w0g = *(const f32x4*)(wconv + FF + c); w.w1g = *(const f32x4*)(wconv + FF2 + FF + c); w.w2g = *(const f32x4*)(wconv + 2 * FF2 + FF + c); w.bg = *(const f32x4*)(bconv + FF + c); return w;
}
template <int CTRL> __device__ __forceinline__ float dppz(float x) { return __int_as_float(__builtin_amdgcn_update_dpp(0, __float_as_int(x), CTRL, 0xf, 0xf, true)); }
__device__ __forceinline__ u32x2 conv_gate4(const f32x4& ca, const f32x4& cg, const f32x4& pa, const f32x4& pg, const ConvW& w, int) {
    float o[4];
#pragma unroll
    for (int e = 0; e < 4; ++e) {
        float ua = fmaf(w.w2a[e], ca[e], w.ba[e]);
        ua = fmaf(dppz<0x111>(ca[e]), w.w1a[e], ua); ua = fmaf(dppz<0x10F>(pa[e]), w.w1a[e], ua);
        ua = fmaf(dppz<0x112>(ca[e]), w.w0a[e], ua); ua = fmaf(dppz<0x10E>(pa[e]), w.w0a[e], ua);
        float ug = fmaf(w.w2g[e], cg[e], w.bg[e]);
        ug = fmaf(dppz<0x111>(cg[e]), w.w1g[e], ug); ug = fmaf(dppz<0x10F>(pg[e]), w.w1g[e], ug);
        ug = fmaf(dppz<0x112>(cg[e]), w.w0g[e], ug); ug = fmaf(dppz<0x10E>(pg[e]), w.w0g[e], ug);
        o[e] = ua * sigmoidf_(ua) * ug;
    }
    u32x2 r; r.x = cvtpk(o[0], o[1]); r.y = cvtpk(o[2], o[3]); return r;
}
struct EpiFFN {
    static constexpr bool PERM = true, AFTER_DRAIN = false;
    bf16_t* act; float* uedge; float* outF; const float* wconv; const float* bconv;
    __device__ __forceinline__ void operator()(const f32x4 (&acc)[2][2][4][2], const pg8::Unit& u, int wr, int wc, int fr, int fq, lptr lds) const {
        lptr halo = lds + pg8::STAGE_BYTES;
        const int q8 = 32 * wc + 8 * fq;
        if (fr >= 14) {
#pragma unroll
            for (int ai = 0; ai < 2; ++ai)
#pragma unroll
                for (int bj = 0; bj < 2; ++bj)
#pragma unroll
                    for (int n = 0; n < 2; ++n) *(LAS f32x4*)(halo + ((((2 * ai + wr) * 2 + (fr - 14)) * 256 + 128 * bj + q8 + 4 * n) * 4)) = acc[ai][bj][3][n];
        }
        asm volatile("s_waitcnt lgkmcnt(0)" ::: "memory"); __builtin_amdgcn_s_barrier(); asm volatile("" ::: "memory");
#pragma unroll
        for (int n = 0; n < 2; ++n) {
            const int c = 128 * u.pn + q8 + 4 * n;
            const ConvW w = load_convw(wconv, bconv, c);
#pragma unroll
            for (int ai = 0; ai < 2; ++ai) {
                const int G = 2 * ai + wr;
                f32x4 pa = {0.f, 0.f, 0.f, 0.f}, pg = {0.f, 0.f, 0.f, 0.f};
                if (G > 0 && fr >= 14) { pa = *(const LAS f32x4*)(halo + ((((G - 1) * 2 + (fr - 14)) * 256 + q8 + 4 * n) * 4)); pg = *(const LAS f32x4*)(halo + ((((G - 1) * 2 + (fr - 14)) * 256 + 128 + q8 + 4 * n) * 4)); }
#pragma unroll
                for (int m = 0; m < 4; ++m) {
                    const f32x4 ca = acc[ai][0][m][n], cg = acc[ai][1][m][n];
                    const f32x4 qa = m ? acc[ai][0][m ? m - 1 : 0][n] : pa, qg = m ? acc[ai][1][m ? m - 1 : 0][n] : pg;
                    const u32x2 o = conv_gate4(ca, cg, qa, qg, w, fr);
                    const size_t row = (size_t)u.pm * 256 + 64 * G + 16 * m + fr;
                    *(u32x2*)(act + row * FF + c) = o;
                    if (m == 0 && G == 0 && fr < 2) { float* e = uedge + ((size_t)u.pm * 4 + fr) * FF2 + c; *(f32x4*)e = ca; *(f32x4*)(e + FF) = cg; }
                    if (m == 3 && G == 3 && fr >= 14) { float* e = uedge + ((size_t)u.pm * 4 + 2 + (fr - 14)) * FF2 + c; *(f32x4*)e = ca; *(f32x4*)(e + FF) = cg;
                        if ((u.pm & 15) == 15) { float* f = outF + ((size_t)(u.pm >> 4) * 2 + (fr - 14)) * FF2 + c; *(f32x4*)f = ca; *(f32x4*)(f + FF) = cg; } }
                }
            }
        }
    }
};
struct EpiFFNs {
    bf16_t* act; float* outF; const float* state; const float* wconv; const float* bconv;
    __device__ __forceinline__ void sub(const f32x4 (&a)[2][4][2], int pn, int rloc0, int wc, int fr, int fq) const {
        const int q8 = 32 * wc + 8 * fq;
#pragma unroll
        for (int n = 0; n < 2; ++n) {
            const int c = 128 * pn + q8 + 4 * n;
            const ConvW w = load_convw(wconv, bconv, c);
#pragma unroll
            for (int m = 0; m < 4; ++m) {
                const int b = (rloc0 + 16 * m) >> 5;
                const f32x4 ca = a[0][m][n], cg = a[1][m][n];
                f32x4 qa = {0.f, 0.f, 0.f, 0.f}, qg = {0.f, 0.f, 0.f, 0.f};
                if (m & 1) { qa = a[0][m ? m - 1 : 0][n]; qg = a[1][m ? m - 1 : 0][n]; }
                else if (fr >= 14) { const float* s = state + ((size_t)b * 2 + (fr - 14)) * FF2 + c; qa = *(const f32x4*)s; qg = *(const f32x4*)(s + FF); }
                const u32x2 o = conv_gate4(ca, cg, qa, qg, w, fr);
                const size_t row = (size_t)MP + rloc0 + 16 * m + fr;
                *(u32x2*)(act + row * FF + c) = o;
                if ((m & 1) && fr >= 14) { float* f = outF + ((size_t)b * 2 + (fr - 14)) * FF2 + c; *(f32x4*)f = ca; *(f32x4*)(f + FF) = cg; }
            }
        }
    }
};

template <int K, bool HISCALE, class Epi>
__device__ __forceinline__ void small_tile(const bf16_t* __restrict__ A, const bf16_t* __restrict__ Bt, const Epi& E, const float* ssq, lptr lds, int t, int tid, int lane, int wave) {
    constexpr int KW = K / 8;
    const int fr = lane & 15, fq = lane >> 4;
    const int wc = t & 3, G = (t >> 2) & 3, pn = t >> 4;
    f32x4 acc[2][4][2];
#pragma unroll
    for (int bj = 0; bj < 2; ++bj)
#pragma unroll
        for (int m = 0; m < 4; ++m)
#pragma unroll
            for (int n = 0; n < 2; ++n) acc[bj][m][n] = (f32x4){0.f, 0.f, 0.f, 0.f};
    const bf16_t* ap = A + (size_t)(G * 64 + fr) * K + fq * 8 + wave * KW;
    const bf16_t* bp = Bt + (size_t)(256 * pn + 32 * wc + 8 * (fr >> 2) + (fr & 3)) * K + fq * 8 + wave * KW;
#ifdef DBLK
    for (int rep = 0; rep < 2; ++rep) {
    if (rep == 1) {
_Pragma("unroll") for (int bj = 0; bj < 2; ++bj) _Pragma("unroll") for (int m = 0; m < 4; ++m) _Pragma("unroll") for (int n = 0; n < 2; ++n) acc[bj][m][n] = acc[bj][m][n] * 0.f; asm volatile("" ::: "memory"); }
#endif
#pragma unroll 4
    for (int k0 = 0; k0 < KW; k0 += 32) {
        bf16x8 af[4], bf[2][2];
#pragma unroll
        for (int m = 0; m < 4; ++m) af[m] = *(const bf16x8*)(ap + (size_t)(16 * m) * K + k0);
#pragma unroll
        for (int bj = 0; bj < 2; ++bj)
#pragma unroll
            for (int n = 0; n < 2; ++n) bf[bj][n] = *(const bf16x8*)(bp + (size_t)(128 * bj + 4 * n) * K + k0);
#pragma unroll
        for (int bj = 0; bj < 2; ++bj)
#pragma unroll
            for (int m = 0; m < 4; ++m)
#pragma unroll
                for (int n = 0; n < 2; ++n) acc[bj][m][n] = MFMA16(bf[bj][n], af[m], acc[bj][m][n]);
    }
#ifdef DBLK
    }
#endif
    if (HISCALE) { if (wave >= 4) {
#pragma unroll
        for (int m = 0; m < 4; ++m) { const float* sp = ssq + (size_t)(MP + G * 64 + 16 * m + fr) * 8; const f32x4 s0 = *(const f32x4*)sp, s1 = *(const f32x4*)(sp + 4);
            const float rstd = rsqrtf(((s0.x + s0.y) + (s0.z + s0.w) + (s1.x + s1.y) + (s1.z + s1.w)) * (1.f / 512.f) + EPS);
#pragma unroll
            for (int bj = 0; bj < 2; ++bj)
#pragma unroll
                for (int n = 0; n < 2; ++n) acc[bj][m][n] = acc[bj][m][n] * rstd; } } }
    __syncthreads();
    if (wave != 0) {
#pragma unroll
        for (int bj = 0; bj < 2; ++bj)
#pragma unroll
            for (int m = 0; m < 4; ++m)
#pragma unroll
                for (int n = 0; n < 2; ++n) *(LAS f32x4*)(lds + ((((wave - 1) * 16 + (bj * 4 + m) * 2 + n) * 64 + lane) * 16)) = acc[bj][m][n];
    }
    __syncthreads();
    if (wave == 0) {
#pragma unroll 1
        for (int w2 = 0; w2 < 7; ++w2)
#pragma unroll
            for (int bj = 0; bj < 2; ++bj)
#pragma unroll
                for (int m = 0; m < 4; ++m)
#pragma unroll
                    for (int n = 0; n < 2; ++n) acc[bj][m][n] = acc[bj][m][n] + *(const LAS f32x4*)(lds + (((w2 * 16 + (bj * 4 + m) * 2 + n) * 64 + lane) * 16));
        E.sub(acc, pn, G * 64, wc, fr, fq);
#ifdef DBLE
        asm volatile("" ::: "memory"); E.sub(acc, pn, G * 64, wc, fr, fq);
#endif
    }
    __syncthreads();
}

typedef unsigned v4u __attribute__((ext_vector_type(4)));
#define XB_TMO      128
#define XB_XCNT(j)  (256  + 64 * (j))
#define XB_XSUB(j)  (1280 + 64 * (j))
#define XB_XGEN(j)  (2304 + 64 * (j))
#define XB_TOP      3328
#define XB_TOPGEN   3392
#define XCD_BAR_WORDS 3456
#define XB_SPIN_CAP (1u << 18)

__device__ __forceinline__ unsigned xb_ld(unsigned* p)              { return __hip_atomic_load(p, __ATOMIC_RELAXED, __HIP_MEMORY_SCOPE_AGENT); }
__device__ __forceinline__ unsigned xb_add(unsigned* p, unsigned v) { return __hip_atomic_fetch_add(p, v, __ATOMIC_RELAXED, __HIP_MEMORY_SCOPE_AGENT); }
__device__ __forceinline__ unsigned xb_xcc_id() { return (unsigned)__builtin_amdgcn_s_getreg((3 << 11) | 20) & 0xFu; }
#define XB_SPIN(cond, bar) do { unsigned _sp = 0; while (cond) { __builtin_amdgcn_s_sleep(1); \
    if ((++_sp & 255u) == 0u) { if (xb_ld(&(bar)[XB_TMO])) break; if (_sp > XB_SPIN_CAP) { atomicAdd(&(bar)[XB_TMO], 1u); break; } } } } while (0)

struct XcdBarrier {
    unsigned* bar; unsigned x;
    volatile LAS unsigned* st;
};

__device__ __forceinline__ XcdBarrier xcd_barrier_post(unsigned* bar, volatile LAS unsigned* st) {
    XcdBarrier b; b.bar = bar; b.x = xb_xcc_id(); b.st = st;
    if (threadIdx.x == 0) (void)xb_add(&bar[XB_XCNT(b.x)], 1u);
    return b;
}
__device__ __forceinline__ void xcd_barrier_complete(unsigned* bar, unsigned x, unsigned& nloc, unsigned& nx) {
    const unsigned G = gridDim.x * gridDim.y * gridDim.z;
    unsigned sum, cnt, mine, sp = 0u;
    for (;;) {
        sum = 0u; cnt = 0u; mine = 0u;
#pragma unroll
        for (unsigned j = 0; j < 16; ++j) { const unsigned c = xb_ld(&bar[XB_XCNT(j)]); sum += c; cnt += (c > 0u) ? 1u : 0u; mine = (j == x) ? c : mine; }
        if (sum == G) break;
        __builtin_amdgcn_s_sleep(1);
        if ((++sp & 255u) == 0u) { if (xb_ld(&bar[XB_TMO])) break; if (sp > XB_SPIN_CAP) { atomicAdd(&bar[XB_TMO], 1u); break; } }
    }
    nloc = mine > 0u ? mine : 1u; nx = cnt > 0u ? cnt : 1u;
}

__device__ __forceinline__ void xcd_barrier(const XcdBarrier& b) {
    asm volatile("s_waitcnt vmcnt(0)" ::: "memory");
    __syncthreads();
    if (threadIdx.x == 0) {
        unsigned* bar = b.bar;
        __builtin_amdgcn_s_waitcnt(0);
        unsigned nloc = b.st[0], nx = b.st[1];
        if (nloc == 0u) { xcd_barrier_complete(bar, b.x, nloc, nx); b.st[0] = nloc; b.st[1] = nx; }
        const unsigned old = xb_add(&bar[XB_XSUB(b.x)], 1u);
        const unsigned gen = old / nloc;
        if (old + 1u == (gen + 1u) * nloc) {
            __builtin_amdgcn_fence(__ATOMIC_RELEASE, "agent");
            asm volatile("s_waitcnt vmcnt(0)" ::: "memory");
            const unsigned og = xb_add(&bar[XB_TOP], 1u);
            const unsigned tg = og / nx;
            if (og + 1u == (tg + 1u) * nx) xb_add(&bar[XB_TOPGEN], 1u);
            else XB_SPIN(xb_ld(&bar[XB_TOPGEN]) == tg, bar);
            __builtin_amdgcn_fence(__ATOMIC_ACQUIRE, "agent");
            xb_add(&bar[XB_XGEN(b.x)], 1u);
            asm volatile("s_waitcnt vmcnt(0)" ::: "memory");
        } else {
            XB_SPIN(xb_ld(&bar[XB_XGEN(b.x)]) == gen, bar);
            __builtin_amdgcn_fence(__ATOMIC_ACQUIRE, "agent");
            asm volatile("s_waitcnt vmcnt(0)" ::: "memory");
        }
    }
    __syncthreads();
}


__device__ __forceinline__ void transpose_item(const float* __restrict__ W, int ldw, int srccol0, bf16_t* __restrict__ WT, int K, int destrow0, int k0, LAS float* scr, int lane, const float* kscale = nullptr) {
#pragma unroll 16
    for (int i = 0; i < 32; ++i) { const int kk = 2 * i + (lane >> 5); scr[kk * 33 + (lane & 31)] = W[(size_t)(k0 + kk) * ldw + srccol0 + (lane & 31)] * (kscale ? kscale[k0 + kk] : 1.f); }
    asm volatile("s_waitcnt lgkmcnt(0)" ::: "memory");
    const int c = lane & 7;
#pragma unroll
    for (int j = 0; j < 4; ++j) { const int n = (lane >> 3) + 8 * j; const LAS float* s = scr + (8 * c) * 33 + n;
        u32x4 o; o.x = cvtpk(s[0 * 33], s[1 * 33]); o.y = cvtpk(s[2 * 33], s[3 * 33]); o.z = cvtpk(s[4 * 33], s[5 * 33]); o.w = cvtpk(s[6 * 33], s[7 * 33]);
        *(u32x4*)(WT + (size_t)(destrow0 + n) * K + k0 + 8 * c) = o; }
    asm volatile("s_waitcnt lgkmcnt(0)" ::: "memory");
}

__device__ __forceinline__ void phase_weights(const Params& P, lptr lds, int lane, int wave) {
    unsigned char* ws = P.ws;
    LAS float* scr = (LAS float*)(lds + wave * 16384);
    const int gw = blockIdx.x * 8 + wave, NGW = gridDim.x * 8;
    constexpr int I1 = 16 * 112, I2 = 16 * 32, I3 = 16 * 176, I4 = 44 * 32;
    for (int it = gw; it < I1 + I2 + I3 + I4; it += NGW) {
        int r = it;
        if (r < I1) { const int kb = r / 112, n0 = (r % 112) * 32, tile = n0 >> 8, p = n0 & 255, wc = (p >> 5) & 3, bj = p >> 7, L = tile * 256 + 64 * wc + 32 * bj;
            transpose_item(P.in[I_WIN], DIN, L < 2048 ? L : L + 8, (bf16_t*)(ws + WS_W1T), 1024, n0, kb * 64, scr, lane); continue; }
        r -= I1;
        if (r < I2) { const int kb = r / 32, n0 = (r % 32) * 32; transpose_item(P.in[I_WOUT], 1024, n0, (bf16_t*)(ws + WS_W2T), 1024, n0, kb * 64, scr, lane, kb >= 8 ? P.in[I_SOW] - 512 : nullptr); continue; }
        r -= I2;
        if (r < I3) { const int kb = r / 176, n0 = (r % 176) * 32, pn = n0 >> 8, p = n0 & 255, bj = p >> 7, q0 = p & 127;
            transpose_item(P.in[I_WUP], FF2, 128 * pn + q0 + FF * bj, (bf16_t*)(ws + WS_W3T), 1024, n0, kb * 64, scr, lane); continue; }
        r -= I3;
        { const int kb = r / 32, n0 = (r % 32) * 32; transpose_item(P.in[I_WDOWN], 1024, n0, (bf16_t*)(ws + WS_W4T), FF, n0, kb * 64, scr, lane); }
    }
}

__device__ __forceinline__ void phase0(const Params& P, lptr lds, int tid, int lane, int wave) {
    unsigned char* ws = P.ws;
    LAS float* sc = (LAS float*)lds;
    for (int i = tid; i < 16384; i += 512) { const int r = i >> 10, k = i & 1023; const float c = r < 8 ? P.in[I_CP][r * 1024 + k] : P.in[I_CS][(r - 8) * 1024 + k]; sc[i] = c / (1.f + __expf(-c)); }
    __syncthreads();
    const int job = blockIdx.x * 512 + tid;
    if (job < 16 * 6144) {
        const int ks = job / 6144, n = job % 6144;
        float acc[16];
#pragma unroll
        for (int r = 0; r < 16; ++r) acc[r] = 0.f;
        const float* wp = P.in[I_WADA] + (size_t)(ks * 64) * 6144 + n;
#pragma unroll 16
        for (int k = 0; k < 64; ++k) { const float w = wp[(size_t)k * 6144];
#pragma unroll
            for (int r = 0; r < 16; ++r) acc[r] += sc[r * 1024 + ks * 64 + k] * w; }
        __attribute__((address_space(1))) float* mp = (__attribute__((address_space(1))) float*)(ws + WS_MOD);
        const float bias = ks == 0 ? P.in[I_BADA][n] : 0.f;
#pragma unroll
        for (int r = 0; r < 16; ++r) (void)__builtin_amdgcn_global_atomic_fadd_f32(mp + (size_t)r * 6144 + n, acc[r] + bias);
    }
}

__device__ __forceinline__ void load_mod_vectors(const Params& P, LAS float* A, LAS float* S, const float* normw, int r, int shofs, int tid) {
    const float* md = (const float*)(P.ws + WS_MOD) + (size_t)r * 6144 + shofs;
    for (int k = tid; k < 1024; k += 512) { A[k] = normw[k] * (1.f + md[1024 + k]); S[k] = md[k]; }
}
__device__ __forceinline__ void load_row_bf(const bf16_t* xrow, int lane, f32x4 (&v)[4]) {
#pragma unroll
    for (int j = 0; j < 4; ++j) { const u32x2 w = ((const u32x2*)xrow)[lane + 64 * j]; v[j] = (f32x4){bflo(w.x), bfhi(w.x), bflo(w.y), bfhi(w.y)}; }
}
__device__ __forceinline__ void load_row(const float* xrow, int lane, f32x4 (&v)[4]) {
#pragma unroll
    for (int j = 0; j < 4; ++j) v[j] = ((const f32x4*)xrow)[lane + 64 * j];
}
template <bool GATES>
__device__ __forceinline__ void norm_row(const Params& P, const f32x4 (&v)[4], bf16_t* orow, float* grow, const LAS float* A, const LAS float* S, const LAS float* Wg, int lane) {
    float s = 0.f;
#pragma unroll
    for (int j = 0; j < 4; ++j) s += (v[j].x * v[j].x + v[j].y * v[j].y) + (v[j].z * v[j].z + v[j].w * v[j].w);
    const float rstd = rsqrtf(wave_sum(s) * (1.f / 1024.f) + EPS);
    float g[8];
#pragma unroll
    for (int i = 0; i < 8; ++i) g[i] = 0.f;
#pragma unroll
    for (int j = 0; j < 4; ++j) { const int k0 = 4 * lane + 256 * j;
        const f32x4 a = *(const LAS f32x4*)(A + k0), sh = *(const LAS f32x4*)(S + k0);
        const f32x4 hv = v[j] * rstd * a + sh;
        u32x2 o; o.x = cvtpk(hv.x, hv.y); o.y = cvtpk(hv.z, hv.w);
        *(u32x2*)(orow + k0) = o;
        if (GATES) {
#pragma unroll
            for (int i = 0; i < 8; ++i) { const f32x4 w = *(const LAS f32x4*)(Wg + i * 1024 + k0); g[i] += (hv.x * w.x + hv.y * w.y) + (hv.z * w.z + hv.w * w.w); } }
    }
    if (GATES) {
        { const bool hi = (lane & 32) != 0;
#pragma unroll
          for (int i = 0; i < 4; ++i) { const float send = hi ? g[i] : g[i + 4], keep = hi ? g[i + 4] : g[i]; g[i] = keep + __shfl_xor(send, 32); } }
        { const bool hi = (lane & 16) != 0;
#pragma unroll
          for (int i = 0; i < 2; ++i) { const float send = hi ? g[i] : g[i + 2], keep = hi ? g[i + 2] : g[i]; g[i] = keep + __shfl_xor(send, 16); } }
        { const bool hi = (lane & 8) != 0; const float send = hi ? g[0] : g[1], keep = hi ? g[1] : g[0]; g[0] = keep + __shfl_xor(send, 8); }
        g[0] += __shfl_xor(g[0], 4); g[0] += __shfl_xor(g[0], 2); g[0] += __shfl_xor(g[0], 1);
        const int gt = lane >> 3;
        if ((lane & 7) == 0) {
            float o;
            if (gt < 4) o = g[0] + P.in[I_BIG][gt];
            else { const float x = g[0] + P.in[I_BFG][gt - 4]; o = fminf(x, 0.f) - log1pf(expf(-fabsf(x))); }
            grow[gt] = o;
        }
    }
}
__device__ __forceinline__ void phase1(const Params& P, lptr lds, int tid, int lane, int wave) {
    LAS float* A1 = (LAS float*)lds; LAS float* S1 = A1 + 1024; LAS float* Wg = S1 + 1024;
    const size_t row0 = (size_t)blockIdx.x * 128 + wave * 16; f32x4 v[4], vn[4]; load_row(P.in[I_XP] + row0 * 1024, lane, v);
    for (int k = tid; k < 1024; k += 512) { const f32x4 w0 = *(const f32x4*)(P.in[I_WIN] + (size_t)k * DIN + 2048), w1 = *(const f32x4*)(P.in[I_WIN] + (size_t)k * DIN + 2052);
        Wg[k] = w0.x; Wg[1024 + k] = w0.y; Wg[2048 + k] = w0.z; Wg[3072 + k] = w0.w; Wg[4096 + k] = w1.x; Wg[5120 + k] = w1.y; Wg[6144 + k] = w1.z; Wg[7168 + k] = w1.w; }
    load_mod_vectors(P, A1, S1, P.in[I_N1W], blockIdx.x >> 5, 0, tid);
    LAS float* A1s = Wg + 8192; LAS float* S1s = A1s + 1024;
    load_mod_vectors(P, A1s, S1s, P.in[I_N1W], 8 + (blockIdx.x >> 5), 0, tid);
    __syncthreads();
    bf16_t* H = (bf16_t*)(P.ws + WS_H); float* GT = (float*)(P.ws + WS_GATES);
    {
#pragma unroll 1
      for (int j = 0; j < 16; ++j) { const size_t row = row0 + j;
          if (j + 1 < 16) load_row(P.in[I_XP] + (row + 1) * 1024, lane, vn);
          else if (wave == 0) load_row(P.in[I_XS] + (size_t)blockIdx.x * 1024, lane, vn);
          norm_row<true>(P, v, H + row * 1024, GT + row * 8, A1, S1, Wg, lane);
#pragma unroll
          for (int q = 0; q < 4; ++q) v[q] = vn[q]; }
      if (wave == 0) norm_row<true>(P, v, H + ((size_t)MP + blockIdx.x) * 1024, GT + ((size_t)MP + blockIdx.x) * 8, A1s, S1s, Wg, lane); }
}
__device__ __forceinline__ void phase5(const Params& P, lptr lds, int tid, int lane, int wave) {
    LAS float* A1 = (LAS float*)lds; LAS float* S1 = A1 + 1024;
    load_mod_vectors(P, A1, S1, P.in[I_N2W], blockIdx.x >> 5, 3072, tid);
    __syncthreads();
    bf16_t* H = (bf16_t*)(P.ws + WS_H);
    { const size_t row0 = (size_t)blockIdx.x * 128 + wave * 16; const bf16_t* X1 = (const bf16_t*)(P.ws + WS_X1B); f32x4 v[4], vn[4]; load_row_bf(X1 + row0 * 1024, lane, v);
#pragma unroll 1
      for (int j = 0; j < 16; ++j) { const size_t row = row0 + j;
          if (j + 1 < 16) load_row_bf(X1 + (row + 1) * 1024, lane, vn);
          norm_row<false>(P, v, H + row * 1024, nullptr, A1, S1, nullptr, lane);
#pragma unroll
          for (int q = 0; q < 4; ++q) v[q] = vn[q]; } }
    __syncthreads();
}
__device__ __forceinline__ void sample_h2_row(const Params& P, lptr lds, int tid, int lane, int wave) {
    LAS float* A1 = (LAS float*)lds; LAS float* S1 = A1 + 1024;
    load_mod_vectors(P, A1, S1, P.in[I_N2W], 8 + (blockIdx.x >> 5), 3072, tid);
    __syncthreads();
    if (wave == 0) { f32x4 v[4]; load_row_bf((const bf16_t*)(P.ws + WS_X1B) + ((size_t)MP + blockIdx.x) * 1024, lane, v); norm_row<false>(P, v, (bf16_t*)(P.ws + WS_H) + ((size_t)MP + blockIdx.x) * 1024, nullptr, A1, S1, nullptr, lane); }
    __syncthreads();
}
__device__ __forceinline__ void phase3b(const Params& P, int lane, int gw, int NGW) {
    bf16_t* Y = (bf16_t*)(P.ws + WS_YCAT); const float* SSQ = (const float*)(P.ws + WS_SSQ);
    for (int row = gw; row < MP; row += NGW) {
        const f32x4 s0 = *(const f32x4*)(SSQ + (size_t)row * 8), s1 = *(const f32x4*)(SSQ + (size_t)row * 8 + 4);
        const float rstd = rsqrtf(((s0.x + s0.y) + (s0.z + s0.w) + (s1.x + s1.y) + (s1.z + s1.w)) * (1.f / 512.f) + EPS);
        u32x4* p = (u32x4*)(Y + (size_t)row * 1024 + 512 + 8 * lane); const u32x4 o = *p;
        f32x4 a = {bflo(o.x), bfhi(o.x), bflo(o.y), bfhi(o.y)}, b = {bflo(o.z), bfhi(o.z), bflo(o.w), bfhi(o.w)};
        a = a * rstd; b = b * rstd;
        *p = pack8(a, b);
    }
}
__device__ __forceinline__ void phase_fix(const Params& P, int tid) {
    const float* UE = (const float*)(P.ws + WS_UEDGE); bf16_t* act = (bf16_t*)(P.ws + WS_ACT);
    const float* wc = P.in[I_WCONV]; const float* bc = P.in[I_BCONV];
    const int total = 128 * 2 * FF;
    if (blockIdx.x < 64) return;
    for (int i = (blockIdx.x - 64) * 512 + tid; i < total; i += (gridDim.x - 64) * 512) {
        const int j = i % FF, rr = (i / FF) & 1, pm = i / (2 * FF);
        if ((pm & 15) == 0) continue;
        float uc[2];
#pragma unroll
        for (int hf = 0; hf < 2; ++hf) { const int c = j + hf * FF;
            const float um2 = rr == 0 ? UE[((size_t)(pm - 1) * 4 + 2) * FF2 + c] : UE[((size_t)(pm - 1) * 4 + 3) * FF2 + c];
            const float um1 = rr == 0 ? UE[((size_t)(pm - 1) * 4 + 3) * FF2 + c] : UE[((size_t)pm * 4 + 0) * FF2 + c];
            const float u0 = UE[((size_t)pm * 4 + rr) * FF2 + c];
            uc[hf] = bc[c] + wc[2 * FF2 + c] * u0 + wc[FF2 + c] * um1 + wc[c] * um2; }
        act[((size_t)pm * 256 + rr) * FF + j] = f2bf(uc[0] * sigmoidf_(uc[0]) * uc[1]);
    }
}

constexpr int ML_P = 272;
constexpr int ML_QS = 0, ML_KS = 17408, ML_VS = 34816, ML_VW = 52224, ML_CS = 69632, ML_SS = 104448, ML_SC = 113664;
__device__ __forceinline__ void mlstm_item(const Params& P, lptr lds, int bh, bool sample, int tid, int lane, int wave) {
    const int b = bh >> 2, h = bh & 3, hh = lane >> 5, n31 = lane & 31;
    const size_t rowbase = sample ? (size_t)MP + b * 32 : (size_t)b * SEQ;
    const int nch = sample ? 1 : 64, L = sample ? 32 : 64;
    const bf16_t* MQ = (const bf16_t*)(P.ws + WS_PROJ); const bf16_t* MK = (const bf16_t*)(P.ws + WS_PROJ + PROJ_STRIDE); const bf16_t* MV = (const bf16_t*)(P.ws + WS_PROJ + 2 * PROJ_STRIDE);
    const bf16_t* MO = (const bf16_t*)(P.ws + WS_PROJ + 3 * PROJ_STRIDE); const float* GT = (const float*)(P.ws + WS_GATES); bf16_t* YC = (bf16_t*)(P.ws + WS_YCAT);
    LAS float* sc = (LAS float*)(lds + ML_SC);
    LAS float* bt = sc, *as_ = sc + 64, *mt = sc + 128, *winter = sc + 192, *emt = sc + 256, *wk = sc + 320, *rsum = sc + 384, *qn = sc + 512, *nvec = sc + 576, *misc = sc + 704;
    const int ti = wave >> 2, ej = wave & 3;
    f32x16 Cacc[2];
    {
        LAS float* cst = (LAS float*)lds;
        if (sample) { const float* src = P.in[I_STC] + ((size_t)b * 4 + h) * 16384;
            for (int i = tid; i < 4096; i += 512) { const f32x4 v = *(const f32x4*)(src + 4 * i); *(LAS f32x4*)(cst + (i >> 5) * 132 + (i & 31) * 4) = v; } }
        else { for (int i = tid; i < 4096; i += 512) *(LAS f32x4*)(cst + (i >> 5) * 132 + (i & 31) * 4) = (f32x4){0.f, 0.f, 0.f, 0.f}; }
        __syncthreads();
        const LAS float* cb = cst + (64 * (wave >> 2) + 4 * hh) * 132 + 32 * ej + n31;
#pragma unroll
        for (int i = 0; i < 2; ++i)
#pragma unroll
            for (int r = 0; r < 16; ++r) Cacc[i][r] = cb[(32 * i + (r & 3) + 8 * (r >> 2)) * 132];
        __syncthreads();
        lptr cs = lds + ML_CS + (64 * (wave >> 2) + 4 * hh) * ML_P + (32 * ej + n31) * 2;
#pragma unroll
        for (int i = 0; i < 2; ++i)
#pragma unroll
            for (int r = 0; r < 16; ++r) *(LAS unsigned short*)(cs + (32 * i + (r & 3) + 8 * (r >> 2)) * ML_P) = f2bf(Cacc[i][r]);
    }
    if (tid < 128) nvec[tid] = sample ? P.in[I_STN][((size_t)b * 4 + h) * 128 + tid] : 0.f;
    if (tid == 0) misc[0] = sample ? P.in[I_STM][b * 4 + h] : 0.f;
    u32x4 rq[2], rk[2], rv[2]; float g_ig = -INFINITY, g_lf = 0.f;
    const int prow[2] = {tid >> 4, (tid + 512) >> 4}, pch = tid & 15;
#define ML_LOAD(c) do { _Pragma("unroll") for (int i = 0; i < 2; ++i) { if (prow[i] < L) { const size_t go = (rowbase + (size_t)(c) * 64 + prow[i]) * 512 + h * 128 + pch * 8; \
            rq[i] = *(const u32x4*)(MQ + go); rk[i] = *(const u32x4*)(MK + go); rv[i] = *(const u32x4*)(MV + go); } else { rq[i] = (u32x4){0u, 0u, 0u, 0u}; rk[i] = rq[i]; rv[i] = rq[i]; } } \
        if (wave == 0) { if (lane < L) { const float* g = GT + (rowbase + (size_t)(c) * 64 + lane) * 8; g_ig = g[h]; g_lf = g[4 + h]; } else { g_ig = -INFINITY; g_lf = 0.f; } } } while (0)
    ML_LOAD(0);
    for (int c = 0; c < nch; ++c) {
        __syncthreads();
        if (wave == 0) {
            float bcum = g_lf;
#pragma unroll
            for (int o = 1; o < 64; o <<= 1) { const float v = __shfl_up(bcum, o); if (lane >= o) bcum += v; }
            const float a = g_ig - bcum; float amax = a;
#pragma unroll
            for (int o = 1; o < 64; o <<= 1) { const float v = __shfl_up(amax, o); if (lane >= o) amax = fmaxf(amax, v); }
            const float mprev = misc[0];
            const float m_t = fmaxf(bcum + mprev, bcum + amax);
            const float bL = __shfl(bcum, 63), aM = __shfl(amax, 63);
            const float m_new = fmaxf(bL + mprev, bL + aM);
            bt[lane] = bcum; as_[lane] = a; mt[lane] = m_t; winter[lane] = expf(bcum + mprev - m_t); emt[lane] = expf(-m_t); wk[lane] = expf(bL + a - m_new);
            if (lane == 0) { misc[1] = expf(bL + mprev - m_new); misc[2] = m_new; }
        }
#pragma unroll
        for (int i = 0; i < 2; ++i) { const int o = prow[i] * ML_P + pch * 16;
            *(LAS u32x4*)(lds + ML_QS + o) = rq[i]; *(LAS u32x4*)(lds + ML_KS + o) = rk[i]; *(LAS u32x4*)(lds + ML_VS + o) = rv[i]; }
        __syncthreads();
#pragma unroll
        for (int i = 0; i < 2; ++i) { const float w = wk[prow[i]]; const u32x4 v = rv[i]; u32x4 o;
            o.x = cvtpk(bflo(v.x) * w, bfhi(v.x) * w); o.y = cvtpk(bflo(v.y) * w, bfhi(v.y) * w); o.z = cvtpk(bflo(v.z) * w, bfhi(v.z) * w); o.w = cvtpk(bflo(v.w) * w, bfhi(v.w) * w);
            *(LAS u32x4*)(lds + ML_VW + prow[i] * ML_P + pch * 16) = o; }
        if (c + 1 < nch) ML_LOAD(c + 1);
        f32x16 num;
#pragma unroll
        for (int r = 0; r < 16; ++r) num[r] = 0.f;
#pragma unroll
        for (int ks = 0; ks < 8; ++ks) num = MFMA32(row_frag(lds + ML_QS, ML_P, 32 * ti, 16 * ks, lane), tr_frag(lds + ML_CS, ML_P, 16 * ks, 32 * ej, lane), num);
        if (wave < 3) {
            const int sti = wave == 0 ? 0 : 1, sj = wave == 2 ? 1 : 0;
            const int krow = (n31 & ~12) | ((n31 & 4) << 1) | ((n31 & 8) >> 1);
            f32x16 p;
#pragma unroll
            for (int r = 0; r < 16; ++r) p[r] = 0.f;
#pragma unroll
            for (int ks = 0; ks < 8; ++ks) p = MFMA32(*(const LAS bf16x8*)(lds + ML_KS + (32 * sj + krow) * ML_P + (16 * ks + 8 * hh) * 2), row_frag(lds + ML_QS, ML_P, 32 * sti, 16 * ks, lane), p);
            const int t = 32 * sti + n31; const float bt_t = bt[t], mt_t = mt[t]; float rs = 0.f;
            const LAS float* asb = as_ + 32 * sj + 8 * hh; const int tb = t - (32 * sj + 8 * hh);
#pragma unroll
            for (int r = 0; r < 16; ++r) { const int so = 16 * (r >> 3) + (r & 7);
                const float w = so <= tb ? __expf(bt_t + asb[so] - mt_t) : 0.f; p[r] *= w; rs += p[r]; }
#pragma unroll
            for (int a2 = 0; a2 < 2; ++a2) { u32x4 o; o.x = cvtpk(p[8 * a2 + 0], p[8 * a2 + 1]); o.y = cvtpk(p[8 * a2 + 2], p[8 * a2 + 3]); o.z = cvtpk(p[8 * a2 + 4], p[8 * a2 + 5]); o.w = cvtpk(p[8 * a2 + 6], p[8 * a2 + 7]);
                *(LAS u32x4*)(lds + ML_SS + t * 144 + (32 * sj + 16 * a2 + 8 * hh) * 2) = o; }
            rs += __shfl_xor(rs, 32);
            if (hh == 0) rsum[sj * 64 + t] = rs;
        }
        if (wave >= 4) {
            const int t = (tid - 256) >> 2, part = tid & 3; float s = 0.f;
#pragma unroll 8
            for (int d = 0; d < 32; ++d) s += bf2f(*(const LAS unsigned short*)(lds + ML_QS + t * ML_P + (32 * part + d) * 2)) * nvec[32 * part + d];
            s += __shfl_xor(s, 1); s += __shfl_xor(s, 2);
            if (part == 0) qn[t] = s;
        }
        __syncthreads();
        const LAS float* tb2 = sc + 32 * ti + 4 * hh;
#pragma unroll
        for (int r = 0; r < 16; ++r) num[r] *= tb2[192 + (r & 3) + 8 * (r >> 2)];
#pragma unroll
        for (int ks = 0; ks < 4; ++ks) if (ks < 2 || ti == 1) num = MFMA32(*(const LAS bf16x8*)(lds + ML_SS + (32 * ti + n31) * 144 + (16 * ks + 8 * hh) * 2), tr_frag(lds + ML_VS, ML_P, 16 * ks, 32 * ej, lane), num);
#pragma unroll
        for (int r = 0; r < 16; ++r) { const int o = (r & 3) + 8 * (r >> 2);
            const float den = tb2[192 + o] * tb2[512 + o] + tb2[384 + o] + (ti ? tb2[448 + o] : 0.f);
            const float hv = num[r] / fmaxf(fabsf(den), tb2[256 + o]);
            *(LAS unsigned short*)(lds + ML_QS + (32 * ti + 4 * hh) * ML_P + (32 * ej + n31) * 2 + o * ML_P) = f2bf(hv); }
        const float decay = misc[1];
#pragma unroll
        for (int i = 0; i < 2; ++i) { const int di = 2 * (wave >> 2) + i;
#pragma unroll
            for (int r = 0; r < 16; ++r) Cacc[i][r] *= decay;
#pragma unroll
            for (int ks = 0; ks < 4; ++ks) Cacc[i] = MFMA32(tr_frag(lds + ML_KS, ML_P, 16 * ks, 32 * di, lane), tr_frag(lds + ML_VW, ML_P, 16 * ks, 32 * ej, lane), Cacc[i]);
#pragma unroll
            for (int r = 0; r < 16; ++r) *(LAS unsigned short*)(lds + ML_CS + (64 * (wave >> 2) + 4 * hh) * ML_P + (32 * ej + n31) * 2 + (32 * i + (r & 3) + 8 * (r >> 2)) * ML_P) = f2bf(Cacc[i][r]); }
        if (tid < 128) { float s = decay * nvec[tid];
#pragma unroll 8
            for (int t = 0; t < 64; ++t) s += wk[t] * bf2f(*(const LAS unsigned short*)(lds + ML_KS + t * ML_P + tid * 2));
            nvec[tid] = s; }
        if (tid == 0) misc[0] = misc[2];
        __syncthreads();
        { const int t = tid >> 3, part = tid & 7;
          const u32x4 h0 = *(const LAS u32x4*)(lds + ML_QS + t * ML_P + part * 32), h1 = *(const LAS u32x4*)(lds + ML_QS + t * ML_P + part * 32 + 16);
          float hv[16] = {bflo(h0.x), bfhi(h0.x), bflo(h0.y), bfhi(h0.y), bflo(h0.z), bfhi(h0.z), bflo(h0.w), bfhi(h0.w), bflo(h1.x), bfhi(h1.x), bflo(h1.y), bfhi(h1.y), bflo(h1.z), bfhi(h1.z), bflo(h1.w), bfhi(h1.w)};
          float ss = 0.f;
#pragma unroll
          for (int e = 0; e < 16; ++e) ss += hv[e] * hv[e];
          ss += __shfl_xor(ss, 1); ss += __shfl_xor(ss, 2); ss += __shfl_xor(ss, 4);
          const float rstd = rsqrtf(ss * (1.f / 128.f) + EPS);
          if (t < L) {
              const size_t row = rowbase + (size_t)c * 64 + t; const int col = h * 128 + part * 16;
              const u32x4 g0 = *(const u32x4*)(MO + row * 512 + col), g1 = *(const u32x4*)(MO + row * 512 + col + 8);
              const float gv[16] = {bflo(g0.x), bfhi(g0.x), bflo(g0.y), bfhi(g0.y), bflo(g0.z), bfhi(g0.z), bflo(g0.w), bfhi(g0.w), bflo(g1.x), bfhi(g1.x), bflo(g1.y), bfhi(g1.y), bflo(g1.z), bfhi(g1.z), bflo(g1.w), bfhi(g1.w)};
              const float* mw = P.in[I_MLW] + col;
              float y[16];
#pragma unroll
              for (int e = 0; e < 16; ++e) y[e] = hv[e] * rstd * mw[e] * gv[e];
              u32x4 o0, o1; o0.x = cvtpk(y[0], y[1]); o0.y = cvtpk(y[2], y[3]); o0.z = cvtpk(y[4], y[5]); o0.w = cvtpk(y[6], y[7]); o1.x = cvtpk(y[8], y[9]); o1.y = cvtpk(y[10], y[11]); o1.z = cvtpk(y[12], y[13]); o1.w = cvtpk(y[14], y[15]);
              *(u32x4*)(YC + row * 1024 + col) = o0; *(u32x4*)(YC + row * 1024 + col + 8) = o1;
          } }
    }
#undef ML_LOAD
    __syncthreads();
    {
        LAS float* cst = (LAS float*)lds;
        int l3 = lane; asm volatile("" : "+v"(l3));
        LAS float* cb = cst + (64 * (wave >> 2) + 4 * (l3 >> 5)) * 132 + 32 * ej + (l3 & 31);
#pragma unroll
        for (int i = 0; i < 2; ++i)
#pragma unroll
            for (int r = 0; r < 16; ++r) cb[(32 * i + (r & 3) + 8 * (r >> 2)) * 132] = Cacc[i][r];
        __syncthreads();
        float* oc = P.out + (sample ? O_SC : O_PC) + ((size_t)b * 4 + h) * 16384;
        for (int i = tid; i < 4096; i += 512) *(f32x4*)(oc + 4 * i) = *(const LAS f32x4*)(cst + (i >> 5) * 132 + (i & 31) * 4);
    }
    if (tid < 128) P.out[(sample ? O_SN : O_PN) + ((size_t)b * 4 + h) * 128 + tid] = nvec[tid];
    if (tid == 0) P.out[(sample ? O_SM : O_PM) + b * 4 + h] = misc[0];
}


constexpr size_t WS_KVL = WS_H, WS_KNL = 420 * MiB, WS_CHS = 421 * MiB, WS_NST = 422 * MiB, WS_MST = 423 * MiB, WS_CST = 424 * MiB, WS_END2 = 489 * MiB;
template <int NC>
__device__ __forceinline__ void ml1_pair(const Params& P, lptr lds, int pair, int tid, int lane, int wave) {
    const int item0 = NC * pair; const int bh = item0 >> 6, c = item0 & 63, b = bh >> 2, h = bh & 3, hh = lane >> 5, n31 = lane & 31, ej = wave & 3;
    const size_t row0 = (size_t)b * SEQ + 64 * c;
    const bf16_t* MK = (const bf16_t*)(P.ws + WS_PROJ + PROJ_STRIDE); const bf16_t* MV = (const bf16_t*)(P.ws + WS_PROJ + 2 * PROJ_STRIDE); const float* GT = (const float*)(P.ws + WS_GATES);
    LAS float* wk = (LAS float*)(lds + ML_SC) + 320;
    const int prow[2] = {tid >> 4, (tid + 512) >> 4}, pch = tid & 15;
    u32x4 rk2[NC][2], rv2[NC][2]; float g_ig2[NC], g_lf2[NC];
#pragma unroll
    for (int s2 = 0; s2 < NC; ++s2) { g_ig2[s2] = 0.f; g_lf2[s2] = 0.f;
#pragma unroll
        for (int i = 0; i < 2; ++i) { const size_t go = (row0 + 64 * s2 + prow[i]) * 512 + h * 128 + pch * 8; rk2[s2][i] = *(const u32x4*)(MK + go); rv2[s2][i] = *(const u32x4*)(MV + go); }
        if (wave == 0) { const float* g = GT + (row0 + 64 * s2 + lane) * 8; g_ig2[s2] = g[h]; g_lf2[s2] = g[4 + h]; } }
#pragma unroll
    for (int s2 = 0; s2 < NC; ++s2) {
    const int item = item0 + s2; const float g_ig = g_ig2[s2], g_lf = g_lf2[s2];
    u32x4 rk[2] = {rk2[s2][0], rk2[s2][1]}, rv[2] = {rv2[s2][0], rv2[s2][1]};
    __syncthreads();
    if (wave == 0) {
        float bcum = g_lf;
#pragma unroll
        for (int o = 1; o < 64; o <<= 1) { const float v = __shfl_up(bcum, o); if (lane >= o) bcum += v; }
        const float a = g_ig - bcum; float amax = a;
#pragma unroll
        for (int o = 1; o < 64; o <<= 1) amax = fmaxf(amax, __shfl_xor(amax, o));
        const float bL = __shfl(bcum, 63);
        wk[lane] = expf(a - amax);
        if (lane == 0) { float* ch = (float*)(P.ws + WS_CHS) + (size_t)item * 4; ch[0] = bL; ch[1] = bL + amax; }
    }
#pragma unroll
    for (int i = 0; i < 2; ++i) *(LAS u32x4*)(lds + ML_KS + prow[i] * ML_P + pch * 16) = rk[i];
    __syncthreads();
#pragma unroll
    for (int i = 0; i < 2; ++i) { const float w = wk[prow[i]]; const u32x4 v = rv[i]; u32x4 o;
        o.x = cvtpk(bflo(v.x) * w, bfhi(v.x) * w); o.y = cvtpk(bflo(v.y) * w, bfhi(v.y) * w); o.z = cvtpk(bflo(v.z) * w, bfhi(v.z) * w); o.w = cvtpk(bflo(v.w) * w, bfhi(v.w) * w);
        *(LAS u32x4*)(lds + ML_VW + prow[i] * ML_P + pch * 16) = o; }
    if (tid < 128) { float s = 0.f;
#pragma unroll 8
        for (int t = 0; t < 64; ++t) s += wk[t] * bf2f(*(const LAS unsigned short*)(lds + ML_KS + t * ML_P + tid * 2));
        ((float*)(P.ws + WS_KNL))[(size_t)item * 128 + tid] = s; }
    __syncthreads();
#pragma unroll
    for (int i = 0; i < 2; ++i) { const int di = 2 * (wave >> 2) + i;
        f32x16 acc;
#pragma unroll
        for (int r = 0; r < 16; ++r) acc[r] = 0.f;
#pragma unroll
        for (int ks = 0; ks < 4; ++ks) acc = MFMA32(tr_frag(lds + ML_KS, ML_P, 16 * ks, 32 * di, lane), tr_frag(lds + ML_VW, ML_P, 16 * ks, 32 * ej, lane), acc);
#pragma unroll
        for (int r = 0; r < 16; ++r) *(LAS unsigned short*)(lds + ML_CS + (64 * (wave >> 2) + 4 * hh) * ML_P + (32 * ej + n31) * 2 + (32 * i + (r & 3) + 8 * (r >> 2)) * ML_P) = f2bf(acc[r]); }
    __syncthreads();
    bf16_t* kvl = (bf16_t*)(P.ws + WS_KVL) + (size_t)item * 16384;
#pragma unroll
    for (int i = 0; i < 4; ++i) { const int p = tid + 512 * i, row = p >> 4, ch = p & 15; *(u32x4*)(kvl + row * 128 + ch * 8) = *(const LAS u32x4*)(lds + ML_CS + row * ML_P + ch * 16); }
    }
}
__device__ __forceinline__ void ml2_scan(const Params& P, lptr lds, int tid, int job) {
    const int bh = job >> 3, part = job & 7;
    LAS float* dec = (LAS float*)lds; LAS float* scl = dec + 64; LAS float* mst = scl + 64;
    if (tid < 64) {
        const float* ch = (const float*)(P.ws + WS_CHS) + ((size_t)bh * 64 + tid) * 4;
        const float bL = ch[0], ml = ch[1]; float A = bL, B = ml;
#pragma unroll
        for (int off = 1; off < 64; off <<= 1) { const float A2 = __shfl_up(A, off), B2 = __shfl_up(B, off); if (tid >= off) { B = fmaxf(B2 + A, B); A = A2 + A; } }
        const float mnext = fmaxf(A, B);
        float mc = __shfl_up(mnext, 1); if (tid == 0) mc = 0.f;
        dec[tid] = expf(bL + mc - mnext); scl[tid] = expf(ml - mnext); mst[tid] = mc; if (tid == 63) mst[64] = mnext;
    }
    __syncthreads();
    const size_t e0 = (size_t)part * 2048 + tid * 4;
    const bf16_t* kv = (const bf16_t*)(P.ws + WS_KVL) + (size_t)bh * 64 * 16384 + e0; bf16_t* cs = (bf16_t*)(P.ws + WS_CST) + (size_t)bh * 64 * 16384 + e0;
    f32x4 C = {0.f, 0.f, 0.f, 0.f};
    const bool do_n = part == 0 && tid < 128; const int tn = do_n ? tid : 0; float n = 0.f;
    const float* kn = (const float*)(P.ws + WS_KNL) + (size_t)bh * 64 * 128 + tn; float* ns = (float*)(P.ws + WS_NST) + (size_t)bh * 64 * 128 + tn;
#pragma unroll 16
    for (int c = 0; c < 64; ++c) { const u32x2 v = *(const u32x2*)(kv + (size_t)c * 16384);
        float knv = 0.f; if (do_n) knv = kn[c * 128];
        *(u32x2*)(cs + (size_t)c * 16384) = (u32x2){cvtpk(C.x, C.y), cvtpk(C.z, C.w)};
        if (do_n) ns[c * 128] = n;
        const f32x4 kvf = {bflo(v.x), bfhi(v.x), bflo(v.y), bfhi(v.y)};
        C = C * dec[c] + kvf * scl[c]; n = n * dec[c] + knv * scl[c]; }
    *(f32x4*)(P.out + O_PC + (size_t)bh * 16384 + e0) = C;
    if (do_n) P.out[O_PN + (size_t)bh * 128 + tid] = n;
    if (part == 0 && tid >= 128 && tid < 192) ((float*)(P.ws + WS_MST))[bh * 64 + tid - 128] = mst[tid - 128];
    if (part == 0 && tid == 192) P.out[O_PM + bh] = mst[64];
}
struct Ml3In { u32x4 rq[2], rk[2], rv[2], rc[4], g0, g1; float g_ig, g_lf, mprev, nin; };
__device__ __forceinline__ void ml3_load(const Params& P, int item, int tid, int lane, int wave, Ml3In& L) {
    const int bh = item >> 6, c = item & 63, b = bh >> 2, h = bh & 3;
    const size_t row0 = (size_t)b * SEQ + 64 * c;
    const bf16_t* MQ = (const bf16_t*)(P.ws + WS_PROJ); const bf16_t* MK = (const bf16_t*)(P.ws + WS_PROJ + PROJ_STRIDE); const bf16_t* MV = (const bf16_t*)(P.ws + WS_PROJ + 2 * PROJ_STRIDE);
    const bf16_t* MO = (const bf16_t*)(P.ws + WS_PROJ + 3 * PROJ_STRIDE); const float* GT = (const float*)(P.ws + WS_GATES);
    const int prow[2] = {tid >> 4, (tid + 512) >> 4}, pch = tid & 15;
#pragma unroll
    for (int i = 0; i < 2; ++i) { const size_t go = (row0 + prow[i]) * 512 + h * 128 + pch * 8; L.rq[i] = *(const u32x4*)(MQ + go); L.rk[i] = *(const u32x4*)(MK + go); L.rv[i] = *(const u32x4*)(MV + go); }
    const bf16_t* cst = (const bf16_t*)(P.ws + WS_CST) + (size_t)item * 16384;
#pragma unroll
    for (int i = 0; i < 4; ++i) { const int p = tid + 512 * i; L.rc[i] = *(const u32x4*)(cst + (p >> 4) * 128 + (p & 15) * 8); }
    { const size_t row = row0 + (tid >> 3); const int col = h * 128 + (tid & 7) * 16; L.g0 = *(const u32x4*)(MO + row * 512 + col); L.g1 = *(const u32x4*)(MO + row * 512 + col + 8); }
    L.g_ig = 0.f; L.g_lf = 0.f; L.mprev = 0.f; L.nin = 0.f;
    if (wave == 0) { const float* g = GT + (row0 + lane) * 8; L.g_ig = g[h]; L.g_lf = g[4 + h]; L.mprev = ((const float*)(P.ws + WS_MST))[item]; }
    if (tid < 128) L.nin = ((const float*)(P.ws + WS_NST))[(size_t)item * 128 + tid];
}
__device__ __forceinline__ void ml3_item(const Params& P, lptr lds, int item, const Ml3In& L, int tid, int lane, int wave) {
    const int bh = item >> 6, c = item & 63, b = bh >> 2, h = bh & 3, hh = lane >> 5, n31 = lane & 31;
    const size_t row0 = (size_t)b * SEQ + 64 * c;
    bf16_t* YC = (bf16_t*)(P.ws + WS_YCAT);
    LAS float* sc = (LAS float*)(lds + ML_SC);
    LAS float* bt = sc, *as_ = sc + 64, *mt = sc + 128, *winter = sc + 192, *emt = sc + 256, *rsum = sc + 384, *qn = sc + 512, *nvec = sc + 576;
    const int ti = wave >> 2, ej = wave & 3;
    const int prow[2] = {tid >> 4, (tid + 512) >> 4}, pch = tid & 15;
    const float g_ig = L.g_ig, g_lf = L.g_lf, mprev = L.mprev, nin = L.nin;
    __syncthreads();
    if (wave == 0) {
        float bcum = g_lf;
#pragma unroll
        for (int o = 1; o < 64; o <<= 1) { const float v = __shfl_up(bcum, o); if (lane >= o) bcum += v; }
        const float a = g_ig - bcum; float amax = a;
#pragma unroll
        for (int o = 1; o < 64; o <<= 1) { const float v = __shfl_up(amax, o); if (lane >= o) amax = fmaxf(amax, v); }
        const float m_t = fmaxf(bcum + mprev, bcum + amax);
        bt[lane] = bcum; as_[lane] = a; mt[lane] = m_t; winter[lane] = expf(bcum + mprev - m_t); emt[lane] = expf(-m_t);
    }
    if (tid < 128) nvec[tid] = nin;
#pragma unroll
    for (int i = 0; i < 2; ++i) { const int o = prow[i] * ML_P + pch * 16;
        *(LAS u32x4*)(lds + ML_QS + o) = L.rq[i]; *(LAS u32x4*)(lds + ML_KS + o) = L.rk[i]; *(LAS u32x4*)(lds + ML_VS + o) = L.rv[i]; }
#pragma unroll
    for (int i = 0; i < 4; ++i) { const int p = tid + 512 * i; *(LAS u32x4*)(lds + ML_CS + (p >> 4) * ML_P + (p & 15) * 16) = L.rc[i]; }
    __syncthreads();
    f32x16 num;
#pragma unroll
    for (int r = 0; r < 16; ++r) num[r] = 0.f;
#pragma unroll
    for (int ks = 0; ks < 8; ++ks) num = MFMA32(row_frag(lds + ML_QS, ML_P, 32 * ti, 16 * ks, lane), tr_frag(lds + ML_CS, ML_P, 16 * ks, 32 * ej, lane), num);
    if (wave < 3) {
        const int sti = wave == 0 ? 0 : 1, sj = wave == 2 ? 1 : 0;
        const int krow = (n31 & ~12) | ((n31 & 4) << 1) | ((n31 & 8) >> 1);
        f32x16 p;
#pragma unroll
        for (int r = 0; r < 16; ++r) p[r] = 0.f;
#pragma unroll
        for (int ks = 0; ks < 8; ++ks) p = MFMA32(*(const LAS bf16x8*)(lds + ML_KS + (32 * sj + krow) * ML_P + (16 * ks + 8 * hh) * 2), row_frag(lds + ML_QS, ML_P, 32 * sti, 16 * ks, lane), p);
        const int t = 32 * sti + n31; const float bt_t = bt[t], mt_t = mt[t]; float rs = 0.f;
        const LAS float* asb = as_ + 32 * sj + 8 * hh; const int tb = t - (32 * sj + 8 * hh);
#pragma unroll
        for (int r = 0; r < 16; ++r) { const int so = 16 * (r >> 3) + (r & 7);
            const float w = so <= tb ? __expf(bt_t + asb[so] - mt_t) : 0.f; p[r] *= w; rs += p[r]; }
#pragma unroll
        for (int a2 = 0; a2 < 2; ++a2) { u32x4 o; o.x = cvtpk(p[8 * a2 + 0], p[8 * a2 + 1]); o.y = cvtpk(p[8 * a2 + 2], p[8 * a2 + 3]); o.z = cvtpk(p[8 * a2 + 4], p[8 * a2 + 5]); o.w = cvtpk(p[8 * a2 + 6], p[8 * a2 + 7]);
            *(LAS u32x4*)(lds + ML_SS + t * 144 + (32 * sj + 16 * a2 + 8 * hh) * 2) = o; }
        rs += __shfl_xor(rs, 32);
        if (hh == 0) rsum[sj * 64 + t] = rs;
    }
    if (wave >= 4) {
        const int t = (tid - 256) >> 2, part = tid & 3; float s = 0.f;
#pragma unroll 8
        for (int d = 0; d < 32; ++d) s += bf2f(*(const LAS unsigned short*)(lds + ML_QS + t * ML_P + (32 * part + d) * 2)) * nvec[32 * part + d];
        s += __shfl_xor(s, 1); s += __shfl_xor(s, 2);
        if (part == 0) qn[t] = s;
    }
    __syncthreads();
    const LAS float* tb2 = sc + 32 * ti + 4 * hh;
#pragma unroll
    for (int r = 0; r < 16; ++r) num[r] *= tb2[192 + (r & 3) + 8 * (r >> 2)];
#pragma unroll
    for (int ks = 0; ks < 4; ++ks) if (ks < 2 || ti == 1) num = MFMA32(*(const LAS bf16x8*)(lds + ML_SS + (32 * ti + n31) * 144 + (16 * ks + 8 * hh) * 2), tr_frag(lds + ML_VS, ML_P, 16 * ks, 32 * ej, lane), num);
#pragma unroll
    for (int r = 0; r < 16; ++r) { const int o = (r & 3) + 8 * (r >> 2);
        const float den = tb2[192 + o] * tb2[512 + o] + tb2[384 + o] + (ti ? tb2[448 + o] : 0.f);
        const float hv = num[r] / fmaxf(fabsf(den), tb2[256 + o]);
        *(LAS unsigned short*)(lds + ML_QS + (32 * ti + 4 * hh) * ML_P + (32 * ej + n31) * 2 + o * ML_P) = f2bf(hv); }
    __syncthreads();
    { const int t = tid >> 3, part = tid & 7;
      const size_t row = row0 + t; const int col = h * 128 + part * 16;
      const u32x4 g0 = L.g0, g1 = L.g1;
      const u32x4 h0 = *(const LAS u32x4*)(lds + ML_QS + t * ML_P + part * 32), h1 = *(const LAS u32x4*)(lds + ML_QS + t * ML_P + part * 32 + 16);
      float hv[16] = {bflo(h0.x), bfhi(h0.x), bflo(h0.y), bfhi(h0.y), bflo(h0.z), bfhi(h0.z), bflo(h0.w), bfhi(h0.w), bflo(h1.x), bfhi(h1.x), bflo(h1.y), bfhi(h1.y), bflo(h1.z), bfhi(h1.z), bflo(h1.w), bfhi(h1.w)};
      float ss = 0.f;
#pragma unroll
      for (int e = 0; e < 16; ++e) ss += hv[e] * hv[e];
      ss += __shfl_xor(ss, 1); ss += __shfl_xor(ss, 2); ss += __shfl_xor(ss, 4);
      const float rstd = rsqrtf(ss * (1.f / 128.f) + EPS);
      const float gv[16] = {bflo(g0.x), bfhi(g0.x), bflo(g0.y), bfhi(g0.y), bflo(g0.z), bfhi(g0.z), bflo(g0.w), bfhi(g0.w), bflo(g1.x), bfhi(g1.x), bflo(g1.y), bfhi(g1.y), bflo(g1.z), bfhi(g1.z), bflo(g1.w), bfhi(g1.w)};
      const float* mw = P.in[I_MLW] + col;
      float y[16];
#pragma unroll
      for (int e = 0; e < 16; ++e) y[e] = hv[e] * rstd * mw[e] * gv[e];
      u32x4 o0, o1; o0.x = cvtpk(y[0], y[1]); o0.y = cvtpk(y[2], y[3]); o0.z = cvtpk(y[4], y[5]); o0.w = cvtpk(y[6], y[7]); o1.x = cvtpk(y[8], y[9]); o1.y = cvtpk(y[10], y[11]); o1.z = cvtpk(y[12], y[13]); o1.w = cvtpk(y[14], y[15]);
      *(u32x4*)(YC + row * 1024 + col) = o0; *(u32x4*)(YC + row * 1024 + col + 8) = o1; }
}

constexpr int AT_KP = 144, AT_VP = 136, AT_WAVE = 64 * AT_KP + 64 * AT_VP;
__device__ __forceinline__ void sb_step(clptr Kt, clptr Vt, const bf16x8 (&qf)[4], f32x16& o0, f32x16& o1, float& carry, int lane, bool domask, int kq) {
    const int n31 = lane & 31, hh = lane >> 5;
    const int krow = (n31 & ~12) | ((n31 & 4) << 1) | ((n31 & 8) >> 1);
    f32x16 p[2];
#pragma unroll
    for (int r = 0; r < 16; ++r) { p[0][r] = 0.f; p[1][r] = 0.f; }
#pragma unroll
    for (int ks = 0; ks < 4; ++ks) {
        p[0] = MFMA32(*(const LAS bf16x8*)(Kt + krow * AT_KP + (16 * ks + 8 * hh) * 2), qf[ks], p[0]);
        p[1] = MFMA32(*(const LAS bf16x8*)(Kt + (32 + krow) * AT_KP + (16 * ks + 8 * hh) * 2), qf[ks], p[1]);
    }
    f32x16 om[2];
    float town[4], tpar[4];
#pragma unroll
    for (int u = 0; u < 2; ++u)
#pragma unroll
        for (int a = 0; a < 2; ++a) { float tp = 1.f;
#pragma unroll
            for (int j = 0; j < 8; ++j) { const int r = 8 * a + j;
                const float z = fminf(fmaxf(p[u][r], -60.f), 60.f);
                const float e = fast_exp2(-z); float sg = fast_rcp(1.f + e); float o = e * sg;
                if (domask) { const int kl = 32 * u + 16 * a + 8 * hh + j; if (kl >= kq) { sg = 0.f; o = 1.f; } }
                p[u][r] = sg; om[u][r] = o; tp *= o; }
            town[2 * u + a] = tp; }
#pragma unroll
    for (int i = 0; i < 4; ++i) tpar[i] = __shfl_xor(town[i], 32);
    float suf[5]; suf[4] = 1.f;
#pragma unroll
    for (int i = 3; i >= 0; --i) suf[i] = suf[i + 1] * (town[i] * tpar[i]);
    bf16x8 pf[4];
#pragma unroll
    for (int u = 0; u < 2; ++u)
#pragma unroll
        for (int a = 0; a < 2; ++a) { const int pr = 2 * u + a;
            float R = carry * suf[pr + 1] * (hh == 0 ? tpar[pr] : 1.f);
            float av[8];
#pragma unroll
            for (int j = 7; j >= 0; --j) { av[j] = p[u][8 * a + j] * R; R *= om[u][8 * a + j]; }
            u32x4 w; w.x = cvtpk(av[0], av[1]); w.y = cvtpk(av[2], av[3]); w.z = cvtpk(av[4], av[5]); w.w = cvtpk(av[6], av[7]);
            pf[pr] = __builtin_bit_cast(bf16x8, w); }
    carry *= suf[0];
#pragma unroll
    for (int pr = 0; pr < 4; ++pr) {
        o0 = MFMA32(tr_frag(Vt, AT_VP, 16 * pr, 0, lane), pf[pr], o0);
        o1 = MFMA32(tr_frag(Vt, AT_VP, 16 * pr, 32, lane), pf[pr], o1);
    }
}
__device__ __forceinline__ void attn_prompt_item(const Params& P, lptr lds, int b, int rb, int lane, int wave) {
    const int h = wave, n31 = lane & 31, hh = lane >> 5;
    const bf16_t* SQ = (const bf16_t*)(P.ws + WS_PROJ + 4 * PROJ_STRIDE); const bf16_t* SK = (const bf16_t*)(P.ws + WS_PROJ + 5 * PROJ_STRIDE); const bf16_t* SV = (const bf16_t*)(P.ws + WS_PROJ + 6 * PROJ_STRIDE);
    const size_t rowb = (size_t)b * SEQ; const int q0 = 32 * rb;
    lptr Kt = lds + wave * AT_WAVE; lptr Vt = Kt + 64 * AT_KP;
    bf16x8 qf[4];
#pragma unroll
    for (int ks = 0; ks < 4; ++ks) qf[ks] = *(const bf16x8*)(SQ + (rowb + q0 + n31) * 512 + h * 64 + 16 * ks + 8 * hh);
    f32x16 o0, o1;
#pragma unroll
    for (int r = 0; r < 16; ++r) { o0[r] = 0.f; o1[r] = 0.f; }
    float carry = 1.f;
    const int trow = lane >> 3, tch = lane & 7;
    u32x4 kv[8], vv[8];
    const int jt0 = (q0 + 30) >> 6;
#pragma unroll
    for (int i = 0; i < 8; ++i) { const size_t go = (rowb + 64 * jt0 + 8 * i + trow) * 512 + h * 64 + tch * 8; kv[i] = *(const u32x4*)(SK + go); vv[i] = *(const u32x4*)(SV + go); }
    for (int jt = jt0; jt >= 0; --jt) {
#pragma unroll
        for (int i = 0; i < 8; ++i) { const int row = 8 * i + trow;
            *(LAS u32x4*)(Kt + row * AT_KP + tch * 16) = kv[i];
            *(LAS u32x2*)(Vt + row * AT_VP + tch * 16) = (u32x2){vv[i].x, vv[i].y}; *(LAS u32x2*)(Vt + row * AT_VP + tch * 16 + 8) = (u32x2){vv[i].z, vv[i].w}; }
        if (jt > 0) {
#pragma unroll
            for (int i = 0; i < 8; ++i) { const size_t go = (rowb + 64 * (jt - 1) + 8 * i + trow) * 512 + h * 64 + tch * 8; kv[i] = *(const u32x4*)(SK + go); vv[i] = *(const u32x4*)(SV + go); } }
        sb_step(Kt, Vt, qf, o0, o1, carry, lane, 64 * jt + 63 >= q0, q0 + n31 - 64 * jt);
        if (__all(carry < 1e-30f)) break;
    }
    float ss = 0.f;
#pragma unroll
    for (int r = 0; r < 16; ++r) ss += o0[r] * o0[r] + o1[r] * o1[r];
    ss += __shfl_xor(ss, 32);
    const size_t row = rowb + q0 + n31;
    LAS float* sx = (LAS float*)(lds + 8 * AT_WAVE);
    if (hh == 0) sx[wave * 32 + n31] = ss;
    __syncthreads();
    float tot = 0.f;
#pragma unroll
    for (int w2 = 0; w2 < 8; ++w2) tot += sx[w2 * 32 + n31];
    const float rstd = rsqrtf(tot * (1.f / 512.f) + EPS);
    bf16_t* yo = (bf16_t*)(P.ws + WS_YCAT) + row * 1024 + 512 + h * 64 + 4 * hh;
#pragma unroll
    for (int g = 0; g < 4; ++g) {
        *(u32x2*)(yo + 8 * g) = (u32x2){cvtpk(o0[4 * g] * rstd, o0[4 * g + 1] * rstd), cvtpk(o0[4 * g + 2] * rstd, o0[4 * g + 3] * rstd)};
        *(u32x2*)(yo + 32 + 8 * g) = (u32x2){cvtpk(o1[4 * g] * rstd, o1[4 * g + 1] * rstd), cvtpk(o1[4 * g + 2] * rstd, o1[4 * g + 3] * rstd)};
    }
}
__device__ __forceinline__ void attn_sample_item(const Params& P, lptr lds, int bh, int tid, int lane, int wave) {
    const int b = bh >> 3, h = bh & 7, n31 = lane & 31, hh = lane >> 5;
    const bf16_t* SQ = (const bf16_t*)(P.ws + WS_PROJ + 4 * PROJ_STRIDE); const bf16_t* SK = (const bf16_t*)(P.ws + WS_PROJ + 5 * PROJ_STRIDE); const bf16_t* SV = (const bf16_t*)(P.ws + WS_PROJ + 6 * PROJ_STRIDE);
    const size_t rows = (size_t)MP + b * 32;
    lptr Kt = lds + wave * AT_WAVE; lptr Vt = Kt + 64 * AT_KP;
    bf16x8 qf[4];
#pragma unroll
    for (int ks = 0; ks < 4; ++ks) qf[ks] = *(const bf16x8*)(SQ + (rows + n31) * 512 + h * 64 + 16 * ks + 8 * hh);
    f32x16 o0, o1;
#pragma unroll
    for (int r = 0; r < 16; ++r) { o0[r] = 0.f; o1[r] = 0.f; }
    float carry = 1.f;
    if (wave == 7) {
        const int trow = lane >> 3, tch = lane & 7;
#pragma unroll
        for (int i = 0; i < 8; ++i) { const int row = 8 * i + trow; u32x4 kv = {0u, 0u, 0u, 0u}, vv = {0u, 0u, 0u, 0u};
            if (row < 32) { const size_t go = (rows + row) * 512 + h * 64 + tch * 8; kv = *(const u32x4*)(SK + go); vv = *(const u32x4*)(SV + go); }
            *(LAS u32x4*)(Kt + row * AT_KP + tch * 16) = kv;
            *(LAS u32x2*)(Vt + row * AT_VP + tch * 16) = (u32x2){vv.x, vv.y}; *(LAS u32x2*)(Vt + row * AT_VP + tch * 16 + 8) = (u32x2){vv.z, vv.w}; }
        sb_step(Kt, Vt, qf, o0, o1, carry, lane, true, n31);
    }
    const float* CK = P.in[I_CK] + (size_t)b * PAST * 512 + h * 64; const float* CV = P.in[I_CV] + (size_t)b * PAST * 512 + h * 64;
    for (int jt = 4 * wave + 3; jt >= 4 * wave; --jt) {
        const int trow = lane >> 4, c4 = lane & 15;
#pragma unroll
        for (int i = 0; i < 16; ++i) { const int row = 4 * i + trow; const size_t go = (size_t)(64 * jt + row) * 512 + c4 * 4;
            const f32x4 kx = *(const f32x4*)(CK + go), vx = *(const f32x4*)(CV + go);
            *(LAS u32x2*)(Kt + row * AT_KP + c4 * 8) = (u32x2){cvtpk(kx.x, kx.y), cvtpk(kx.z, kx.w)};
            *(LAS u32x2*)(Vt + row * AT_VP + c4 * 8) = (u32x2){cvtpk(vx.x, vx.y), cvtpk(vx.z, vx.w)}; }
        sb_step(Kt, Vt, qf, o0, o1, carry, lane, false, 0);
    }
    __syncthreads();
    LAS float* carr = (LAS float*)(lds + 65536);
    if (hh == 0) carr[wave * 32 + n31] = carry;
    __syncthreads();
    float mult = 1.f;
    for (int w2 = wave + 1; w2 < 8; ++w2) mult *= carr[w2 * 32 + n31];
#pragma unroll
    for (int g = 0; g < 4; ++g) {
        *(LAS f32x4*)(lds + (((wave * 8 + g) * 64 + lane) * 16)) = (f32x4){o0[4 * g] * mult, o0[4 * g + 1] * mult, o0[4 * g + 2] * mult, o0[4 * g + 3] * mult};
        *(LAS f32x4*)(lds + (((wave * 8 + 4 + g) * 64 + lane) * 16)) = (f32x4){o1[4 * g] * mult, o1[4 * g + 1] * mult, o1[4 * g + 2] * mult, o1[4 * g + 3] * mult};
    }
    __syncthreads();
    { const int q = tid >> 4, part = tid & 15; const int slot = (part >> 3) * 4 + ((part & 7) >> 1), ln = q + 32 * (part & 1);
      f32x4 v = {0.f, 0.f, 0.f, 0.f};
#pragma unroll
      for (int w2 = 0; w2 < 8; ++w2) v = v + *(const LAS f32x4*)(lds + (((w2 * 8 + slot) * 64 + ln) * 16));
      float ss = (v.x * v.x + v.y * v.y) + (v.z * v.z + v.w * v.w);
      ss += __shfl_xor(ss, 1); ss += __shfl_xor(ss, 2); ss += __shfl_xor(ss, 4); ss += __shfl_xor(ss, 8);
      const size_t row = rows + q;
      if (part == 0) ((float*)(P.ws + WS_SSQ))[row * 8 + h] = ss;
      *(u32x2*)((bf16_t*)(P.ws + WS_YCAT) + row * 1024 + 512 + h * 64 + part * 4) = (u32x2){cvtpk(v.x, v.y), cvtpk(v.z, v.w)}; }
    __syncthreads();
}
#ifndef M1NC
#define M1NC 2
#endif
constexpr int NQ_G1S = 224, NQ_AT = 1024, NQ_M1 = 2048 / M1NC, NQ_TOTAL = NQ_G1S + NQ_AT + NQ_M1;
template <class EpiS>
__device__ __forceinline__ void phase_mixers(const Params& P, lptr lds, int tid_in, int wave, const EpiS& Es) {
    unsigned* ctr = (unsigned*)(P.ws + WS_CTL);
    int nextitem = 0; if (tid_in == 0) nextitem = (int)atomicAdd(ctr, 1u);
    for (;;) {
        __syncthreads();
        if (tid_in == 0) *(LAS int*)(lds + QOFF) = nextitem;
        __syncthreads();
        int item = *(const LAS int*)(lds + QOFF);
        if (tid_in == 0 && item < NQ_TOTAL) nextitem = (int)atomicAdd(ctr, 1u);
        int tid = tid_in; asm volatile("" : "+v"(tid));
        const int lane = tid & 63;
        if (item >= NQ_TOTAL) break;
        if (item < NQ_G1S) { small_tile<1024, false>((const bf16_t*)(P.ws + WS_H) + (size_t)MP * 1024, (const bf16_t*)(P.ws + WS_W1T), Es, nullptr, lds, item, tid, lane, wave); continue; }
        item -= NQ_G1S;
        if (item < NQ_AT) { attn_prompt_item(P, lds, item & 7, 127 - (item >> 3), lane, wave); continue; }
        item -= NQ_AT;
        ml1_pair<M1NC>(P, lds, item, tid, lane, wave);
    }
}
__device__ __forceinline__ void phase_ml2(const Params& P, lptr lds, int tid_in, int wave) {
    int tid = tid_in; asm volatile("" : "+v"(tid));
    if (blockIdx.x < 160) { for (int job = blockIdx.x; job < 256; job += 160) { __syncthreads(); ml2_scan(P, lds, tid, job); } }
    else if (blockIdx.x < 192) mlstm_item(P, lds, blockIdx.x - 160, true, tid, tid & 63, wave);
    else attn_sample_item(P, lds, blockIdx.x - 192, tid, tid & 63, wave);
}
template <class EpiS>
__device__ __forceinline__ void phase_ml3(const Params& P, lptr lds, int tid_in, int wave, const EpiS& Es) {
    if (blockIdx.x >= 192) { int tid = tid_in; asm volatile("" : "+v"(tid));
        small_tile<1024, true>((const bf16_t*)(P.ws + WS_YCAT) + (size_t)MP * 1024, (const bf16_t*)(P.ws + WS_W2T), Es, (const float*)(P.ws + WS_SSQ), lds, blockIdx.x - 192, tid, tid & 63, wave); }
#ifdef DBL_M3
    for (int rep = 0; rep < 2; ++rep)
#endif
    { int tid = tid_in; asm volatile("" : "+v"(tid));
      Ml3In cur, nxt; ml3_load(P, blockIdx.x, tid, tid & 63, wave, cur);
#pragma unroll 1
      for (int item = blockIdx.x; item < 2048; item += gridDim.x) {
          const int nitem = item + gridDim.x;
          if (nitem < 2048) ml3_load(P, nitem, tid, tid & 63, wave, nxt);
          ml3_item(P, lds, item, cur, tid, tid & 63, wave);
          cur = nxt;
      } }
}

__global__ void __launch_bounds__(512, 2) fwd(Params P) {
    extern __shared__ __attribute__((aligned(16))) unsigned char lds_raw[];
    lptr lds = (lptr)lds_raw;
    cg::grid_group grid = cg::this_grid();
    int tid = threadIdx.x, lane = tid & 63; const int wave = __builtin_amdgcn_readfirstlane(tid >> 6);
#define FRESH_TID() do { asm volatile("" : "+v"(tid)); lane = tid & 63; } while (0)
    const int gw = blockIdx.x * 8 + wave, NGW = gridDim.x * 8;
    unsigned char* ws = P.ws;
    const float* MOD = (const float*)(ws + WS_MOD);
    bf16_t* H = (bf16_t*)(ws + WS_H); bf16_t* PROJ = (bf16_t*)(ws + WS_PROJ); bf16_t* YC = (bf16_t*)(ws + WS_YCAT); bf16_t* ACT = (bf16_t*)(ws + WS_ACT);

#ifndef G_ALIGN
#define G_ALIGN true
#endif
#ifndef G_SP2
#define G_SP2 true
#endif
#ifndef PH
#define PH 0xFFFF
#endif
    if (tid == 0) { *(LAS unsigned*)(lds + LDS_BYTES - 32) = 0u; *(LAS unsigned*)(lds + LDS_BYTES - 28) = 0u; }
    __syncthreads();
    const XcdBarrier bar = xcd_barrier_post((unsigned*)(ws + WS_CTL) + 1024, (volatile LAS unsigned*)(lds + LDS_BYTES - 32));
    if (P.out == nullptr) grid.sync();
    phase0(P, lds, tid, lane, wave);
#ifdef DBL_P0
    __syncthreads(); phase0(P, lds, tid, lane, wave);
#endif
    xcd_barrier(bar);
    FRESH_TID();
    phase1(P, lds, tid, lane, wave);
    __syncthreads();
    phase_weights(P, lds, lane, wave);
#ifdef DBL_P1
    __syncthreads(); phase1(P, lds, tid, lane, wave);
#endif
#ifdef DBL_P1NG
    __syncthreads(); phase1_nogates(P, lds, tid, lane, wave);
#endif
#ifdef DBL_W
    __syncthreads(); phase_weights(P, lds, lane, wave);
#endif
    xcd_barrier(bar);
    FRESH_TID();
    {
        EpiProj E{PROJ, P.out + O_PK, P.out + O_PV, P.in[I_SQW], P.in[I_SKW], 0};
        pg8::Gemm g{H, (const bf16_t*)(ws + WS_W1T), MP, NPROJ, 1024}; pg8::StaticOrder S; S.init(MP, NPROJ, gridDim.x, (int)blockIdx.x);
        pg8::gemm_phase<EpiProj, pg8::StaticOrder, G_ALIGN, G_SP2>(lds, g, S, E);
#ifdef DBL_G
        pg8::gemm_phase<EpiProj, pg8::StaticOrder, G_ALIGN, G_SP2>(lds, g, S, E);
#endif
    }
    xcd_barrier(bar);
    FRESH_TID();
    {
        EpiProj Es{PROJ, P.out + O_SK, P.out + O_SV, P.in[I_SQW], P.in[I_SKW], MP};
        phase_mixers(P, lds, tid, wave, Es);
    }
    xcd_barrier(bar);
    FRESH_TID();
    phase_ml2(P, lds, tid, wave);
#ifdef DBL_M2
    __syncthreads(); phase_ml2(P, lds, tid, wave);
#endif
    xcd_barrier(bar);
    FRESH_TID();
    {
        EpiRes<0> Es{P.in[I_XS], (bf16_t*)(ws + WS_X1B) + (size_t)MP * 1024, MOD + 8 * 6144 + 2048, 5};
        phase_ml3(P, lds, tid, wave, Es);
    }
#ifdef XSYNC
    for (int i = 0; i < XSYNC; ++i) xcd_barrier(bar);
#endif
    xcd_barrier(bar);
    FRESH_TID();
    {
        sample_h2_row(P, lds, tid, lane, wave);
        EpiRes<0> E{P.in[I_XP], ws + WS_X1B, MOD + 2048, 12};
        pg8::Gemm g{YC, (const bf16_t*)(ws + WS_W2T), MP, 1024, 1024}; pg8::StaticOrder S; S.init(MP, 1024, gridDim.x, (int)blockIdx.x);
        pg8::gemm_phase<EpiRes<0>, pg8::StaticOrder, G_ALIGN, G_SP2>(lds, g, S, E);
    }
    xcd_barrier(bar);
    FRESH_TID();
    {
        phase5(P, lds, tid, lane, wave);
#ifdef DBL_P5
        phase5(P, lds, tid, lane, wave);
#endif
        EpiFFNs Es{ACT, P.out + O_SF, P.in[I_SFC], P.in[I_WCONV], P.in[I_BCONV]};
        for (int t = blockIdx.x; t < 352; t += gridDim.x) small_tile<1024, false>(H + (size_t)MP * 1024, (const bf16_t*)(ws + WS_W3T), Es, nullptr, lds, t, tid, lane, wave);
    }
    xcd_barrier(bar);
    FRESH_TID();
    {
        EpiFFN E{ACT, (float*)(ws + WS_UEDGE), P.out + O_PF, P.in[I_WCONV], P.in[I_BCONV]};
        pg8::Gemm g{H, (const bf16_t*)(ws + WS_W3T), MP, FF2, 1024}; pg8::StaticOrder S; S.init(MP, FF2, gridDim.x, (int)blockIdx.x);
        pg8::gemm_phase<EpiFFN, pg8::StaticOrder, true, G_SP2>(lds, g, S, E);
#ifdef DBL_G
        pg8::gemm_phase<EpiFFN, pg8::StaticOrder, true, G_SP2>(lds, g, S, E);
#endif
    }
    xcd_barrier(bar);
    FRESH_TID();
    {
        phase_fix(P, tid);
        EpiRes<1> Es{(const bf16_t*)(ws + WS_X1B) + (size_t)MP * 1024, P.out + O_YS, MOD + 8 * 6144 + 5120, 5};
        if (blockIdx.x < 64) small_tile<FF, false>(ACT + (size_t)MP * FF, (const bf16_t*)(ws + WS_W4T), Es, nullptr, lds, blockIdx.x, tid, lane, wave);
    }
    xcd_barrier(bar);
    FRESH_TID();
    {
        EpiRes<1> E{ws + WS_X1B, P.out + O_YP, MOD + 5120, 12};
        pg8::Gemm g{ACT, (const bf16_t*)(ws + WS_W4T), MP, 1024, FF}; pg8::StaticOrder S; S.init(MP, 1024, gridDim.x, (int)blockIdx.x);
        pg8::gemm_phase<EpiRes<1>, pg8::StaticOrder, G_ALIGN, G_SP2>(lds, g, S, E);
    }

#ifdef DIAG
    xcd_barrier(bar);
    {
        const size_t offs[15] = {O_YP, O_YS, O_PC, O_PN, O_PM, O_PK, O_PV, O_PF, O_SC, O_SN, O_SM, O_SK, O_SV, O_SF, O_END};
        for (int o = 0; o < 14; ++o) if ((DIAG >> o) & 1) for (size_t i = offs[o] + (size_t)blockIdx.x * 512 + tid; i < offs[o + 1]; i += (size_t)gridDim.x * 512) P.out[i] *= 1.2f;
    }
#endif
}

extern "C" void kernel_launch(void* const* d_in, const int* in_sizes, int n_in, void* d_out, int out_size, void* d_ws, size_t ws_size, hipStream_t stream) {
    static int grid_blocks = 0;
    if (!grid_blocks) {
        int dev = 0, cus = 0, per_cu = 0;
        (void)hipGetDevice(&dev);
        (void)hipDeviceGetAttribute(&cus, hipDeviceAttributeMultiprocessorCount, dev);
        (void)hipFuncSetAttribute((const void*)fwd, hipFuncAttributeMaxDynamicSharedMemorySize, LDS_BYTES);
        (void)hipOccupancyMaxActiveBlocksPerMultiprocessor(&per_cu, (const void*)fwd, 512, LDS_BYTES);
        grid_blocks = cus;
        if (n_in != 26 || out_size != (int)O_END || ws_size < WS_END2 || cus != 256 || per_cu < 1) {
            fprintf(stderr, "kernel_launch: unexpected geometry: n_in %d out %d ws %zu cus %d per_cu %d\n", n_in, out_size, ws_size, cus, per_cu);
            if (n_in != 26 || out_size != (int)O_END || ws_size < WS_END2 || cus != 256) grid_blocks = -1;
        }
    }
    if (grid_blocks < 0) return;
    if (hipMemsetAsync((char*)d_ws + WS_CTL, 0, WS_MOD + 16 * 6144 * 4, stream) != hipSuccess) { fprintf(stderr, "kernel_launch: memset of the control words failed\n"); return; }
    Params p{};
    for (int i = 0; i < 26; ++i) p.in[i] = (const float*)d_in[i];
    p.out = (float*)d_out; p.ws = (unsigned char*)d_ws;
    void* args[] = {&p};
    hipError_t e = hipLaunchCooperativeKernel((const void*)fwd, dim3(grid_blocks), dim3(512), args, LDS_BYTES, stream);
    if (e != hipSuccess) fprintf(stderr, "cooperative launch failed: %s (grid %d)\n", hipGetErrorString(e), grid_blocks);
}
```

```cpp
#include <hip/hip_runtime.h>
#include <hip/hip_cooperative_groups.h>
#include <cstdio>
#include <cstdint>
namespace cg = cooperative_groups;

#define LAS __attribute__((address_space(3)))
typedef unsigned short bf16_t;
typedef short bf16x8 __attribute__((ext_vector_type(8)));
typedef short s16x4 __attribute__((ext_vector_type(4)));
typedef float f32x2 __attribute__((ext_vector_type(2)));
typedef float f32x4 __attribute__((ext_vector_type(4)));
typedef float f32x16 __attribute__((ext_vector_type(16)));
typedef unsigned u32x2 __attribute__((ext_vector_type(2)));
typedef unsigned u32x4 __attribute__((ext_vector_type(4)));
typedef __bf16 bf16x2_t __attribute__((ext_vector_type(2)));
typedef LAS unsigned char* lptr;
typedef const LAS unsigned char* clptr;

constexpr int DM = 1024, SEQ = 4096, NB = 8, MP = NB * SEQ, DEC = 32, MS = NB * DEC, MT = MP + MS, PAST = 2048;
constexpr int DIN = 3592, NPROJ = 3584, FF = 2816, FF2 = 5632;
constexpr float EPS = 1e-6f;
constexpr float LOG2E = 1.4426950408889634f;
constexpr size_t O_YP = 0, O_YS = 33554432, O_PC = 33816576, O_PN = 34340864, O_PM = 34344960, O_PK = 34344992, O_PV = 51122208,
                 O_PF = 67899424, O_SC = 67989536, O_SN = 68513824, O_SM = 68517920, O_SK = 68517952, O_SV = 68649024, O_SF = 68780096, O_END = 68870208;
constexpr size_t MiB = 1u << 20;
constexpr size_t WS_CTL = 0, WS_MODP = 1 * MiB  , WS_MOD = 65536  , WS_GATES = 8 * MiB, WS_SSQ = 10 * MiB, WS_UEDGE = 12 * MiB,
                 WS_W1T = 24 * MiB, WS_W2T = 31 * MiB, WS_W3T = 33 * MiB, WS_W4T = 44 * MiB, WS_H = 52 * MiB, WS_PROJ = 120 * MiB,
                 PROJ_STRIDE = 33 * MiB, WS_YCAT = 352 * MiB, WS_ACT = 120 * MiB, WS_END = 420 * MiB;
constexpr size_t WS_X1B = 424 * MiB;
constexpr int LDS_BYTES = 147456;
constexpr int QOFF = LDS_BYTES - 64;

struct Params { const float* in[26]; float* out; unsigned char* ws; };
enum { I_XP = 0, I_XS, I_CP, I_CS, I_STC, I_STN, I_STM, I_CK, I_CV, I_SFC, I_WADA, I_BADA, I_N1W, I_WIN, I_BIG, I_BFG, I_MLW, I_SQW, I_SKW, I_SOW,
       I_WOUT, I_N2W, I_WUP, I_WCONV, I_BCONV, I_WDOWN };

__device__ __forceinline__ unsigned cvtpk(float lo, float hi) { f32x2 v = {lo, hi}; bf16x2_t b = __builtin_convertvector(v, bf16x2_t); return __builtin_bit_cast(unsigned, b); }
__device__ __forceinline__ float bf2f(unsigned short x) { return __uint_as_float((unsigned)x << 16); }
__device__ __forceinline__ float bflo(unsigned w) { return __uint_as_float(w << 16); }
__device__ __forceinline__ float bfhi(unsigned w) { return __uint_as_float(w & 0xffff0000u); }
__device__ __forceinline__ unsigned short f2bf(float f) { return (unsigned short)(cvtpk(f, 0.f) & 0xffffu); }
__device__ __forceinline__ float wave_sum(float v) {
#pragma unroll
    for (int o = 1; o < 64; o <<= 1) v += __shfl_xor(v, o);
    return v;
}
__device__ __forceinline__ float fast_exp2(float x) { return __builtin_amdgcn_exp2f(x); }
__device__ __forceinline__ float fast_rcp(float x) { return __builtin_amdgcn_rcpf(x); }
__device__ __forceinline__ float sigmoidf_(float x) { return fast_rcp(1.f + fast_exp2(-x * LOG2E)); }
__device__ __forceinline__ int crow(int r, int hi) { return (r & 3) + 8 * (r >> 2) + 4 * hi; }
typedef short v4i16_t __attribute__((ext_vector_type(4)));
__device__ __forceinline__ s16x4 tr_read(clptr p) { return __builtin_bit_cast(s16x4, __builtin_amdgcn_ds_read_tr16_b64_v4i16((LAS v4i16_t*)p)); }
__device__ __forceinline__ bf16x8 tr_frag(clptr base, int P, int R0, int C0, int lane) {
    const int h = lane >> 5, blk = (lane >> 4) & 1, q = (lane & 15) >> 2, p = lane & 3;
    clptr a = base + (R0 + 8 * h + q) * P + (C0 + 16 * blk + 4 * p) * 2;
    const s16x4 lo = tr_read(a), hi = tr_read(a + 4 * P);
    return (bf16x8){lo[0], lo[1], lo[2], lo[3], hi[0], hi[1], hi[2], hi[3]};
}
__device__ __forceinline__ bf16x8 row_frag(clptr base, int P, int R0, int K0, int lane) {
    return *(const LAS bf16x8*)(base + (R0 + (lane & 31)) * P + (K0 + 8 * (lane >> 5)) * 2);
}
#define MFMA32(a, b, c) __builtin_amdgcn_mfma_f32_32x32x16_bf16((a), (b), (c), 0, 0, 0)
#define MFMA16(a, b, c) __builtin_amdgcn_mfma_f32_16x16x32_bf16((a), (b), (c), 0, 0, 0)

namespace pg8 {
#define PG8_LAS __attribute__((address_space(3)))
typedef unsigned short bf16_t;
typedef short bf16x8 __attribute__((ext_vector_type(8)));
typedef float f32x4 __attribute__((ext_vector_type(4)));
typedef unsigned u32x4 __attribute__((ext_vector_type(4)));
constexpr int BM = 256, BK = 64, HALF = 128, HTB = HALF * BK * 2  , STAGE_BYTES = 8 * HTB, NXCD = 8, WGM = 8;

__host__ __device__ __forceinline__ int lds_byte(int r, int c) { const int st = (r >> 4) * 2 + (c >> 5), rr = r & 15, cc = c & 31, ob = rr * 64 + cc * 2; return st * 1024 + (ob ^ (((ob >> 9) & 1) << 5)); }
__host__ __device__ __forceinline__ void stage_rc(int b, int& R, int& C) { const int st = b / 1024, sb = b % 1024, swz = sb ^ (((sb >> 9) & 1) << 5); R = (st >> 1) * 16 + swz / 64; C = (st & 1) * 32 + (swz % 64) / 2; }
__host__ __device__ __forceinline__ int perm32(int rho) { const int n = rho >> 4, i = rho & 15; return 8 * (i >> 2) + 4 * n + (i & 3); }

struct Unit { int pm, pn; };
struct Gemm { const bf16_t* A; const bf16_t* Bt; int M, N, K; };

struct StaticOrder {
    int nM, nN, nwg, G, c;
    __host__ __device__ void init(int M, int N, int G_, int c_) { nM = M / BM; nN = N / BM; nwg = nM * nN; G = G_; c = c_; }
    __host__ __device__ bool next(int i, Unit& u) const {
        const long L = (long)i * G + c; if (L >= nwg) return false;
        int wgid = (int)L; { const int q = nwg / NXCD, r = nwg % NXCD, xcd = wgid % NXCD, off = wgid / NXCD; wgid = (xcd < r ? xcd * (q + 1) : r * (q + 1) + (xcd - r) * q) + off; }
        const int nig = WGM * nN, gid = wgid / nig, fm = gid * WGM, gsz = (nM - fm) < WGM ? (nM - fm) : WGM;
        u.pm = fm + ((wgid % nig) % gsz); u.pn = (wgid % nig) / gsz; return true;
    }
    __device__ __forceinline__ void a_ready(const Unit&) const {}
    __device__ __forceinline__ void done(const Unit&) const {}
};

template <class Epi, class Sched, bool ALIGN_EPI = false, bool SP2 = false>
__device__ __forceinline__ void gemm_phase(PG8_LAS unsigned char* lds, const Gemm g, const Sched& S, const Epi& E) {
    int tid_o = threadIdx.x; asm volatile("" : "+v"(tid_o));
    const int tid = tid_o, wid = __builtin_amdgcn_readfirstlane(tid >> 6), lane = tid & 63, wr = wid >> 2, wc = wid & 3, fr = lane & 15, fq = lane >> 4;
    const int K = g.K, nt = K / BK;
    unsigned voffA[2], voffB[2];
#pragma unroll
    for (int i = 0; i < 2; ++i) { int R, C; stage_rc(tid * 16 + i * 8192, R, C); const int Rb = Epi::PERM ? ((R & ~31) + perm32(R & 31)) : R;
        voffA[i] = (unsigned)(R * K + C) * 2u; voffB[i] = (unsigned)(Rb * K + C) * 2u; }
    const size_t kstep = (size_t)(BK * 2);
    const size_t hstep = (size_t)HALF * K * 2;
    const size_t tstep = 2 * hstep;
    const unsigned ldsw = (unsigned)wid * 1024u;
    const int aoff = lds_byte(wr * 64 + fr, fq * 8), boff = lds_byte(wc * 32 + fr, fq * 8);
#define PG8_SA(b, h) (((b) * 2 + (h)) * HTB)
#define PG8_SB(b, h) ((4 + (b) * 2 + (h)) * HTB)
#define PG8_STAGE(bufoff, gbase, voff) do { _Pragma("unroll") for (int _i = 0; _i < 2; ++_i) \
        __builtin_amdgcn_global_load_lds((const unsigned*)((const char*)(gbase) + (voff)[_i]), (PG8_LAS unsigned*)(lds + (bufoff) + ldsw + _i * 8192), 16, 0, 0); } while (0)
#define PG8_LDA(dst, b, h) do { _Pragma("unroll") for (int m = 0; m < 4; ++m) _Pragma("unroll") for (int k = 0; k < 2; ++k) dst[m][k] = *(const PG8_LAS bf16x8*)(lds + PG8_SA(b, h) + aoff + m * 2048 + k * 1024); } while (0)
#define PG8_LDB(dst, b, h) do { _Pragma("unroll") for (int n = 0; n < 2; ++n) _Pragma("unroll") for (int k = 0; k < 2; ++k) dst[n][k] = *(const PG8_LAS bf16x8*)(lds + PG8_SB(b, h) + boff + n * 2048 + k * 1024); } while (0)
#define PG8_MMA(ai, bj, At, Bt) do { __builtin_amdgcn_s_setprio(1); _Pragma("unroll") for (int m = 0; m < 4; ++m) _Pragma("unroll") for (int n = 0; n < 2; ++n) _Pragma("unroll") for (int k = 0; k < 2; ++k) \
        acc[ai][bj][m][n] = __builtin_amdgcn_mfma_f32_16x16x32_bf16(Bt[n][k], At[m][k], acc[ai][bj][m][n], 0, 0, 0); __builtin_amdgcn_s_setprio(0); } while (0)
#define PG8_WAIT_V(n) asm volatile("s_waitcnt vmcnt(" #n ")" ::: "memory")
#define PG8_WAIT_L(n) asm volatile("s_waitcnt lgkmcnt(" #n ")" ::: "memory")
#define PG8_BAR __builtin_amdgcn_s_barrier()
#define PG8_SCHED __builtin_amdgcn_sched_barrier(0)
    Unit cur, nxt; int ui = 0;
    if (!S.next(0, cur)) return;
    f32x4 acc[2][2][4][2];
#pragma unroll
    for (int a = 0; a < 2; ++a)
#pragma unroll
        for (int b = 0; b < 2; ++b)
#pragma unroll
            for (int m = 0; m < 4; ++m)
#pragma unroll
                for (int n = 0; n < 2; ++n) acc[a][b][m][n] = (f32x4){0.f, 0.f, 0.f, 0.f};
    bf16x8 At[4][2], B0[2][2], B1[2][2];
    const char* cA = (const char*)g.A + (size_t)cur.pm * tstep; const char* cB = (const char*)g.Bt + (size_t)cur.pn * tstep;
    S.a_ready(cur);
    if constexpr (SP2) {
        PG8_STAGE(PG8_SB(0, 0), cB, voffB); PG8_STAGE(PG8_SB(0, 1), cB + hstep, voffB); PG8_STAGE(PG8_SA(0, 0), cA, voffA); PG8_STAGE(PG8_SA(0, 1), cA + hstep, voffA);
        if (wr == 1) PG8_BAR;
        PG8_WAIT_V(2); PG8_BAR;
        PG8_STAGE(PG8_SB(1, 0), cB + kstep, voffB); PG8_STAGE(PG8_SA(1, 0), cA + kstep, voffA); PG8_STAGE(PG8_SB(1, 1), cB + hstep + kstep, voffB);
        PG8_WAIT_V(6); PG8_BAR;
    } else {
        PG8_STAGE(PG8_SB(0, 0), cB, voffB); PG8_STAGE(PG8_SA(0, 0), cA, voffA); PG8_STAGE(PG8_SB(0, 1), cB + hstep, voffB); PG8_STAGE(PG8_SA(0, 1), cA + hstep, voffA);
        if (wr == 1) PG8_BAR;
        PG8_WAIT_V(4); PG8_BAR;
        PG8_STAGE(PG8_SB(1, 0), cB + kstep, voffB); PG8_STAGE(PG8_SA(1, 0), cA + kstep, voffA); PG8_STAGE(PG8_SB(1, 1), cB + hstep + kstep, voffB);
        PG8_WAIT_V(6); PG8_BAR;
    }
    for (;;) {
        const bool has_next = S.next(ui + 1, nxt);
        const char* nA = has_next ? (const char*)g.A + (size_t)nxt.pm * tstep : cA; const char* nB = has_next ? (const char*)g.Bt + (size_t)nxt.pn * tstep : cB;
        for (int t = 0; t < nt; t += 2) {
            const bool last = (t == nt - 2);
            const char* a1 = cA + (size_t)(t + 1) * kstep;
            const char* a2 = last ? nA : cA + (size_t)(t + 2) * kstep; const char* b2 = last ? nB : cB + (size_t)(t + 2) * kstep;
            const char* a3 = a2 + kstep; const char* b3 = b2 + kstep;
            if (last && has_next) S.a_ready(nxt);
            if constexpr (SP2) {
            PG8_LDB(B0, 0, 0); PG8_LDB(B1, 0, 1); PG8_SCHED; PG8_LDA(At, 0, 0); PG8_STAGE(PG8_SA(1, 1), a1 + hstep, voffA);
            PG8_WAIT_V(8); PG8_WAIT_L(0); PG8_BAR; PG8_MMA(0, 0, At, B0); PG8_MMA(0, 1, At, B1); PG8_BAR; PG8_SCHED;
            PG8_LDA(At, 0, 1); PG8_STAGE(PG8_SB(0, 0), b2, voffB); PG8_STAGE(PG8_SB(0, 1), b2 + hstep, voffB); PG8_STAGE(PG8_SA(0, 0), a2, voffA);
            PG8_WAIT_V(8); PG8_WAIT_L(0); PG8_BAR; PG8_MMA(1, 0, At, B0); PG8_MMA(1, 1, At, B1); PG8_BAR; PG8_SCHED;
            PG8_LDB(B0, 1, 0); PG8_LDB(B1, 1, 1); PG8_SCHED; PG8_LDA(At, 1, 0); PG8_STAGE(PG8_SA(0, 1), a2 + hstep, voffA);
            PG8_WAIT_V(8); PG8_WAIT_L(0); PG8_BAR; PG8_MMA(0, 0, At, B0); PG8_MMA(0, 1, At, B1); PG8_BAR; PG8_SCHED;
            PG8_LDA(At, 1, 1); PG8_STAGE(PG8_SB(1, 0), b3, voffB); PG8_STAGE(PG8_SB(1, 1), b3 + hstep, voffB); PG8_STAGE(PG8_SA(1, 0), a3, voffA);
            PG8_WAIT_V(8); PG8_WAIT_L(0); PG8_BAR; PG8_MMA(1, 0, At, B0); PG8_MMA(1, 1, At, B1); PG8_BAR; PG8_SCHED;
            } else {
            PG8_LDB(B0, 0, 0); PG8_SCHED; PG8_LDA(At, 0, 0); PG8_STAGE(PG8_SA(1, 1), a1 + hstep, voffA);
            PG8_WAIT_L(8); PG8_BAR; PG8_WAIT_L(0); PG8_MMA(0, 0, At, B0); PG8_BAR; PG8_SCHED;
            PG8_LDB(B1, 0, 1); PG8_STAGE(PG8_SB(0, 0), b2, voffB);
            PG8_BAR; PG8_WAIT_L(0); PG8_MMA(0, 1, At, B1); PG8_BAR;
            PG8_LDA(At, 0, 1); PG8_STAGE(PG8_SA(0, 0), a2, voffA);
            PG8_BAR; PG8_WAIT_L(0); PG8_MMA(1, 0, At, B0); PG8_BAR; PG8_SCHED;
            PG8_STAGE(PG8_SB(0, 1), b2 + hstep, voffB);
            PG8_WAIT_V(6); PG8_BAR; PG8_MMA(1, 1, At, B1); PG8_BAR;
            PG8_LDB(B0, 1, 0); PG8_SCHED; PG8_LDA(At, 1, 0); PG8_STAGE(PG8_SA(0, 1), a2 + hstep, voffA);
            PG8_WAIT_L(8); PG8_BAR; PG8_WAIT_L(0); PG8_MMA(0, 0, At, B0); PG8_BAR; PG8_SCHED;
            PG8_LDB(B1, 1, 1); PG8_STAGE(PG8_SB(1, 0), b3, voffB);
            PG8_BAR; PG8_WAIT_L(0); PG8_MMA(0, 1, At, B1); PG8_BAR;
            PG8_LDA(At, 1, 1); PG8_STAGE(PG8_SA(1, 0), a3, voffA);
            PG8_BAR; PG8_WAIT_L(0); PG8_MMA(1, 0, At, B0); PG8_BAR; PG8_SCHED;
            PG8_STAGE(PG8_SB(1, 1), b3 + hstep, voffB);
            PG8_WAIT_V(6); PG8_BAR; PG8_MMA(1, 1, At, B1); PG8_BAR;
            }
        }
        if constexpr (ALIGN_EPI) { if (wr == 0) PG8_BAR; }
        if constexpr (!Epi::AFTER_DRAIN) { E(acc, cur, wr, wc, fr, fq, lds); S.done(cur); }
        if (!has_next) break;
#pragma unroll
        for (int a = 0; a < 2; ++a)
#pragma unroll
            for (int b = 0; b < 2; ++b)
#pragma unroll
                for (int m = 0; m < 4; ++m)
#pragma unroll
                    for (int n = 0; n < 2; ++n) acc[a][b][m][n] = (f32x4){0.f, 0.f, 0.f, 0.f};
        cur = nxt; cA = nA; cB = nB; ++ui;
        if constexpr (ALIGN_EPI) { if (wr == 1) PG8_BAR; }
    }
    PG8_WAIT_V(0);
    if constexpr (!ALIGN_EPI) { if (wr == 0) PG8_BAR; }
    PG8_BAR;
    if constexpr (Epi::AFTER_DRAIN) { E.fused(acc, cur, wr, wc, fr, fq, lds, wid, lane); S.done(cur); }
#undef PG8_SA
#undef PG8_SB
#undef PG8_STAGE
#undef PG8_LDA
#undef PG8_LDB
#undef PG8_MMA
#undef PG8_WAIT_V
#undef PG8_WAIT_L
#undef PG8_BAR
#undef PG8_SCHED
}
}

__device__ __forceinline__ u32x4 pack8(const f32x4& v0, const f32x4& v1) { u32x4 w; w.x = cvtpk(v0[0], v0[1]); w.y = cvtpk(v0[2], v0[3]); w.z = cvtpk(v1[0], v1[1]); w.w = cvtpk(v1[2], v1[3]); return w; }

struct EpiProj {
    static constexpr bool PERM = true, AFTER_DRAIN = false;
    bf16_t* proj; float* outK; float* outV; const float* qw; const float* kw; int rowoff;
    __device__ __forceinline__ void sub(const f32x4 (&a)[2][4][2], int pn, int rloc0, int wc, int fr, int fq) const {
        const int kind = pn >> 1, half = pn & 1;
        const int c8 = 256 * half + 64 * wc + 8 * fq;
        bf16_t* ob = proj + (size_t)kind * (PROJ_STRIDE / 2);
        if (kind < 4) {
#pragma unroll
            for (int m = 0; m < 4; ++m) { const size_t row = (size_t)(rowoff + rloc0 + 16 * m + fr);
#pragma unroll
                for (int bj = 0; bj < 2; ++bj) { f32x4 v0 = a[bj][m][0], v1 = a[bj][m][1];
                    if (kind == 1) { v0 = v0 * 0.08838834764831845f; v1 = v1 * 0.08838834764831845f; }
                    if (kind == 3) {
#pragma unroll
                        for (int e = 0; e < 4; ++e) { v0[e] = sigmoidf_(v0[e]); v1[e] = sigmoidf_(v1[e]); } }
                    *(u32x4*)(ob + row * 512 + c8 + 32 * bj) = pack8(v0, v1); } }
        } else if (kind < 6) {
            const float* w = kind == 4 ? qw : kw; const float osc = kind == 4 ? 0.125f * LOG2E : 1.f;
            f32x4 wv[2][2];
#pragma unroll
            for (int bj = 0; bj < 2; ++bj)
#pragma unroll
                for (int n = 0; n < 2; ++n) wv[bj][n] = *(const f32x4*)(w + 32 * bj + 8 * fq + 4 * n);
#pragma unroll
            for (int m = 0; m < 4; ++m) { const int rl = rloc0 + 16 * m + fr; float ss = 0.f;
#pragma unroll
                for (int bj = 0; bj < 2; ++bj)
#pragma unroll
                    for (int n = 0; n < 2; ++n) { const f32x4 x = a[bj][m][n]; ss += (x[0] * x[0] + x[1] * x[1]) + (x[2] * x[2] + x[3] * x[3]); }
                ss += __shfl_xor(ss, 16); ss += __shfl_xor(ss, 32);
                const float rstd = rsqrtf(ss * (1.f / 64.f) + EPS);
#pragma unroll
                for (int bj = 0; bj < 2; ++bj) { f32x4 v0 = a[bj][m][0] * rstd * wv[bj][0], v1 = a[bj][m][1] * rstd * wv[bj][1];
                    if (kind == 5) { float* o = outK + (size_t)rl * 512 + c8 + 32 * bj; __builtin_nontemporal_store(v0, (f32x4*)o); __builtin_nontemporal_store(v1, (f32x4*)(o + 4)); }
                    v0 = v0 * osc; v1 = v1 * osc;
                    *(u32x4*)(ob + (size_t)(rowoff + rl) * 512 + c8 + 32 * bj) = pack8(v0, v1); } }
        } else {
#pragma unroll
            for (int m = 0; m < 4; ++m) { const int rl = rloc0 + 16 * m + fr;
#pragma unroll
                for (int bj = 0; bj < 2; ++bj) { const f32x4 v0 = a[bj][m][0], v1 = a[bj][m][1];
                    float* o = outV + (size_t)rl * 512 + c8 + 32 * bj; __builtin_nontemporal_store(v0, (f32x4*)o); __builtin_nontemporal_store(v1, (f32x4*)(o + 4));
                    *(u32x4*)(ob + (size_t)(rowoff + rl) * 512 + c8 + 32 * bj) = pack8(v0, v1); } }
        }
    }
    __device__ __forceinline__ void operator()(const f32x4 (&acc)[2][2][4][2], const pg8::Unit& u, int wr, int wc, int fr, int fq, lptr) const {
#pragma unroll
        for (int ai = 0; ai < 2; ++ai) sub(acc[ai], u.pn, u.pm * 256 + ai * 128 + wr * 64, wc, fr, fq);
    }
};

template <int MODE>
struct EpiRes {
    static constexpr bool PERM = true, AFTER_DRAIN = false;
    const void* xin; void* xout; const float* gate; int tlog;
    __device__ __forceinline__ void sub(const f32x4 (&a)[2][4][2], int pn, int rloc0, int wc, int fr, int fq) const {
#pragma unroll
        for (int m = 0; m < 4; ++m) { const int rl = rloc0 + 16 * m + fr; const float* g = gate + (size_t)(rl >> tlog) * 6144;
#pragma unroll
            for (int bj = 0; bj < 2; ++bj) { const int c = 256 * pn + 128 * bj + 32 * wc + 8 * fq;
                const f32x4 g0 = *(const f32x4*)(g + c), g1 = *(const f32x4*)(g + c + 4);
                if (MODE == 0) {
                    const float* xp = (const float*)xin + (size_t)rl * 1024 + c;
                    const f32x4 o0 = *(const f32x4*)xp + g0 * a[bj][m][0], o1 = *(const f32x4*)(xp + 4) + g1 * a[bj][m][1];
                    *(u32x4*)((bf16_t*)xout + (size_t)rl * 1024 + c) = pack8(o0, o1);
                } else {
                    const u32x4 xv = *(const u32x4*)((const bf16_t*)xin + (size_t)rl * 1024 + c);
                    const f32x4 x0 = {bflo(xv.x), bfhi(xv.x), bflo(xv.y), bfhi(xv.y)}, x1 = {bflo(xv.z), bfhi(xv.z), bflo(xv.w), bfhi(xv.w)};
                    float* op = (float*)xout + (size_t)rl * 1024 + c;
                    __builtin_nontemporal_store(x0 + g0 * a[bj][m][0], (f32x4*)op); __builtin_nontemporal_store(x1 + g1 * a[bj][m][1], (f32x4*)(op + 4));
                } } }
    }
    __device__ __forceinline__ void operator()(const f32x4 (&acc)[2][2][4][2], const pg8::Unit& u, int wr, int wc, int fr, int fq, lptr) const {
#pragma unroll
        for (int ai = 0; ai < 2; ++ai) sub(acc[ai], u.pn, u.pm * 256 + ai * 128 + wr * 64, wc, fr, fq);
    }
};

__device__ __forceinline__ float dpp_ror1(float x) { return __int_as_float(__builtin_amdgcn_update_dpp(0, __float_as_int(x), 0x121, 0xf, 0xf, false)); }
__device__ __forceinline__ float dpp_ror2(float x) { return __int_as_float(__builtin_amdgcn_update_dpp(0, __float_as_int(x), 0x122, 0xf, 0xf, false)); }
struct ConvW { f32x4 w0a, w1a, w2a, ba, w0g, w1g, w2g, bg; };
__device__ __forceinline__ ConvW load_convw(const float* wconv, const float* bconv, int c) {
    ConvW w; w.w0a = *(const f32x4*)(wconv + c); w.w1a = *(const f32x4*)(wconv + FF2 + c); w.w2a = *(const f32x4*)(wconv + 2 * FF2 + c); w.ba = *(const f32x4*)(bconv + c);
    w.w0g = *(const f32x4*)(wconv + FF + c); w.w1g = *(const f32x4*)(wconv + FF2 + FF + c); w.w2g = *(const f32x4*)(wconv + 2 * FF2 + FF + c); w.bg = *(const f32x4*)(bconv + FF + c); return w;
}
template <int CTRL> __device__ __forceinline__ float dppz(float x) { return __int_as_float(__builtin_amdgcn_update_dpp(0, __float_as_int(x), CTRL, 0xf, 0xf, true)); }
__device__ __forceinline__ u32x2 conv_gate4(const f32x4& ca, const f32x4& cg, const f32x4& pa, const f32x4& pg, const ConvW& w, int) {
    float o[4];
#pragma unroll
    for (int e = 0; e < 4; ++e) {
        float ua = fmaf(w.w2a[e], ca[e], w.ba[e]);
        ua = fmaf(dppz<0x111>(ca[e]), w.w1a[e], ua); ua = fmaf(dppz<0x10F>(pa[e]), w.w1a[e], ua);
        ua = fmaf(dppz<0x112>(ca[e]), w.w0a[e], ua); ua = fmaf(dppz<0x10E>(pa[e]), w.w0a[e], ua);
        float ug = fmaf(w.w2g[e], cg[e], w.bg[e]);
        ug = fmaf(dppz<0x111>(cg[e]), w.w1g[e], ug); ug = fmaf(dppz<0x10F>(pg[e]), w.w1g[e], ug);
        ug = fmaf(dppz<0x112>(cg[e]), w.w0g[e], ug); ug = fmaf(dppz<0x10E>(pg[e]), w.w0g[e], ug);
        o[e] = ua * sigmoidf_(ua) * ug;
    }
    u32x2 r; r.x = cvtpk(o[0], o[1]); r.y = cvtpk(o[2], o[3]); return r;
}
struct EpiFFN {
    static constexpr bool PERM = true, AFTER_DRAIN = false;
    bf16_t* act; float* uedge; float* outF; const float* wconv; const float* bconv;
    __device__ __forceinline__ void operator()(const f32x4 (&acc)[2][2][4][2], const pg8::Unit& u, int wr, int wc, int fr, int fq, lptr lds) const {
        lptr halo = lds + pg8::STAGE_BYTES;
        const int q8 = 32 * wc + 8 * fq;
        if (fr >= 14) {
#pragma unroll
            for (int ai = 0; ai < 2; ++ai)
#pragma unroll
                for (int bj = 0; bj < 2; ++bj)
#pragma unroll
                    for (int n = 0; n < 2; ++n) *(LAS f32x4*)(halo + ((((2 * ai + wr) * 2 + (fr - 14)) * 256 + 128 * bj + q8 + 4 * n) * 4)) = acc[ai][bj][3][n];
        }
        asm volatile("s_waitcnt lgkmcnt(0)" ::: "memory"); __builtin_amdgcn_s_barrier(); asm volatile("" ::: "memory");
#pragma unroll
        for (int n = 0; n < 2; ++n) {
            const int c = 128 * u.pn + q8 + 4 * n;
            const ConvW w = load_convw(wconv, bconv, c);
#pragma unroll
            for (int ai = 0; ai < 2; ++ai) {
                const int G = 2 * ai + wr;
                f32x4 pa = {0.f, 0.f, 0.f, 0.f}, pg = {0.f, 0.f, 0.f, 0.f};
                if (G > 0 && fr >= 14) { pa = *(const LAS f32x4*)(halo + ((((G - 1) * 2 + (fr - 14)) * 256 + q8 + 4 * n) * 4)); pg = *(const LAS f32x4*)(halo + ((((G - 1) * 2 + (fr - 14)) * 256 + 128 + q8 + 4 * n) * 4)); }
#pragma unroll
                for (int m = 0; m < 4; ++m) {
                    const f32x4 ca = acc[ai][0][m][n], cg = acc[ai][1][m][n];
                    const f32x4 qa = m ? acc[ai][0][m ? m - 1 : 0][n] : pa, qg = m ? acc[ai][1][m ? m - 1 : 0][n] : pg;
                    const u32x2 o = conv_gate4(ca, cg, qa, qg, w, fr);
                    const size_t row = (size_t)u.pm * 256 + 64 * G + 16 * m + fr;
                    *(u32x2*)(act + row * FF + c) = o;
                    if (m == 0 && G == 0 && fr < 2) { float* e = uedge + ((size_t)u.pm * 4 + fr) * FF2 + c; *(f32x4*)e = ca; *(f32x4*)(e + FF) = cg; }
                    if (m == 3 && G == 3 && fr >= 14) { float* e = uedge + ((size_t)u.pm * 4 + 2 + (fr - 14)) * FF2 + c; *(f32x4*)e = ca; *(f32x4*)(e + FF) = cg;
                        if ((u.pm & 15) == 15) { float* f = outF + ((size_t)(u.pm >> 4) * 2 + (fr - 14)) * FF2 + c; *(f32x4*)f = ca; *(f32x4*)(f + FF) = cg; } }
                }
            }
        }
    }
};
struct EpiFFNs {
    bf16_t* act; float* outF; const float* state; const float* wconv; const float* bconv;
    __device__ __forceinline__ void sub(const f32x4 (&a)[2][4][2], int pn, int rloc0, int wc, int fr, int fq) const {
        const int q8 = 32 * wc + 8 * fq;
#pragma unroll
        for (int n = 0; n < 2; ++n) {
            const int c = 128 * pn + q8 + 4 * n;
            const ConvW w = load_convw(wconv, bconv, c);
#pragma unroll
            for (int m = 0; m < 4; ++m) {
                const int b = (rloc0 + 16 * m) >> 5;
                const f32x4 ca = a[0][m][n], cg = a[1][m][n];
                f32x4 qa = {0.f, 0.f, 0.f, 0.f}, qg = {0.f, 0.f, 0.f, 0.f};
                if (m & 1) { qa = a[0][m ? m - 1 : 0][n]; qg = a[1][m ? m - 1 : 0][n]; }
                else if (fr >= 14) { const float* s = state + ((size_t)b * 2 + (fr - 14)) * FF2 + c; qa = *(const f32x4*)s; qg = *(const f32x4*)(s + FF); }
                const u32x2 o = conv_gate4(ca, cg, qa, qg, w, fr);
                const size_t row = (size_t)MP + rloc0 + 16 * m + fr;
                *(u32x2*)(act + row * FF + c) = o;
                if ((m & 1) && fr >= 14) { float* f = outF + ((size_t)b * 2 + (fr - 14)) * FF2 + c; *(f32x4*)f = ca; *(f32x4*)(f + FF) = cg; }
            }
        }
    }
};

template <int K, bool HISCALE, class Epi>
__device__ __forceinline__ void small_tile(const bf16_t* __restrict__ A, const bf16_t* __restrict__ Bt, const Epi& E, const float* ssq, lptr lds, int t, int tid, int lane, int wave) {
    constexpr int KW = K / 8;
    const int fr = lane & 15, fq = lane >> 4;
    const int wc = t & 3, G = (t >> 2) & 3, pn = t >> 4;
    f32x4 acc[2][4][2];
#pragma unroll
    for (int bj = 0; bj < 2; ++bj)
#pragma unroll
        for (int m = 0; m < 4; ++m)
#pragma unroll
            for (int n = 0; n < 2; ++n) acc[bj][m][n] = (f32x4){0.f, 0.f, 0.f, 0.f};
    const bf16_t* ap = A + (size_t)(G * 64 + fr) * K + fq * 8 + wave * KW;
    const bf16_t* bp = Bt + (size_t)(256 * pn + 32 * wc + 8 * (fr >> 2) + (fr & 3)) * K + fq * 8 + wave * KW;
#ifdef DBLK
    for (int rep = 0; rep < 2; ++rep) {
    if (rep == 1) {
_Pragma("unroll") for (int bj = 0; bj < 2; ++bj) _Pragma("unroll") for (int m = 0; m < 4; ++m) _Pragma("unroll") for (int n = 0; n < 2; ++n) acc[bj][m][n] = acc[bj][m][n] * 0.f; asm volatile("" ::: "memory"); }
#endif
#pragma unroll 4
    for (int k0 = 0; k0 < KW; k0 += 32) {
        bf16x8 af[4], bf[2][2];
#pragma unroll
        for (int m = 0; m < 4; ++m) af[m] = *(const bf16x8*)(ap + (size_t)(16 * m) * K + k0);
#pragma unroll
        for (int bj = 0; bj < 2; ++bj)
#pragma unroll
            for (int n = 0; n < 2; ++n) bf[bj][n] = *(const bf16x8*)(bp + (size_t)(128 * bj + 4 * n) * K + k0);
#pragma unroll
        for (int bj = 0; bj < 2; ++bj)
#pragma unroll
            for (int m = 0; m < 4; ++m)
#pragma unroll
                for (int n = 0; n < 2; ++n) acc[bj][m][n] = MFMA16(bf[bj][n], af[m], acc[bj][m][n]);
    }
#ifdef DBLK
    }
#endif
    if (HISCALE) { if (wave >= 4) {
#pragma unroll
        for (int m = 0; m < 4; ++m) { const float* sp = ssq + (size_t)(MP + G * 64 + 16 * m + fr) * 8; const f32x4 s0 = *(const f32x4*)sp, s1 = *(const f32x4*)(sp + 4);
            const float rstd = rsqrtf(((s0.x + s0.y) + (s0.z + s0.w) + (s1.x + s1.y) + (s1.z + s1.w)) * (1.f / 512.f) + EPS);
#pragma unroll
            for (int bj = 0; bj < 2; ++bj)
#pragma unroll
                for (int n = 0; n < 2; ++n) acc[bj][m][n] = acc[bj][m][n] * rstd; } } }
    __syncthreads();
    if (wave != 0) {
#pragma unroll
        for (int bj = 0; bj < 2; ++bj)
#pragma unroll
            for (int m = 0; m < 4; ++m)
#pragma unroll
                for (int n = 0; n < 2; ++n) *(LAS f32x4*)(lds + ((((wave - 1) * 16 + (bj * 4 + m) * 2 + n) * 64 + lane) * 16)) = acc[bj][m][n];
    }
    __syncthreads();
    if (wave == 0) {
#pragma unroll 1
        for (int w2 = 0; w2 < 7; ++w2)
#pragma unroll
            for (int bj = 0; bj < 2; ++bj)
#pragma unroll
                for (int m = 0; m < 4; ++m)
#pragma unroll
                    for (int n = 0; n < 2; ++n) acc[bj][m][n] = acc[bj][m][n] + *(const LAS f32x4*)(lds + (((w2 * 16 + (bj * 4 + m) * 2 + n) * 64 + lane) * 16));
        E.sub(acc, pn, G * 64, wc, fr, fq);
#ifdef DBLE
        asm volatile("" ::: "memory"); E.sub(acc, pn, G * 64, wc, fr, fq);
#endif
    }
    __syncthreads();
}

typedef unsigned v4u __attribute__((ext_vector_type(4)));
#define XB_TMO      128
#define XB_XCNT(j)  (256  + 64 * (j))
#define XB_XSUB(j)  (1280 + 64 * (j))
#define XB_XGEN(j)  (2304 + 64 * (j))
#define XB_TOP      3328
#define XB_TOPGEN   3392
#define XCD_BAR_WORDS 3456
#define XB_SPIN_CAP (1u << 18)

__device__ __forceinline__ unsigned xb_ld(unsigned* p)              { return __hip_atomic_load(p, __ATOMIC_RELAXED, __HIP_MEMORY_SCOPE_AGENT); }
__device__ __forceinline__ unsigned xb_add(unsigned* p, unsigned v) { return __hip_atomic_fetch_add(p, v, __ATOMIC_RELAXED, __HIP_MEMORY_SCOPE_AGENT); }
__device__ __forceinline__ unsigned xb_xcc_id() { return (unsigned)__builtin_amdgcn_s_getreg((3 << 11) | 20) & 0xFu; }
#define XB_SPIN(cond, bar) do { unsigned _sp = 0; while (cond) { __builtin_amdgcn_s_sleep(1); \
    if ((++_sp & 255u) == 0u) { if (xb_ld(&(bar)[XB_TMO])) break; if (_sp > XB_SPIN_CAP) { atomicAdd(&(bar)[XB_TMO], 1u); break; } } } } while (0)

struct XcdBarrier {
    unsigned* bar; unsigned x;
    volatile LAS unsigned* st;
};

__device__ __forceinline__ XcdBarrier xcd_barrier_post(unsigned* bar, volatile LAS unsigned* st) {
    XcdBarrier b; b.bar = bar; b.x = xb_xcc_id(); b.st = st;
    if (threadIdx.x == 0) (void)xb_add(&bar[XB_XCNT(b.x)], 1u);
    return b;
}
__device__ __forceinline__ void xcd_barrier_complete(unsigned* bar, unsigned x, unsigned& nloc, unsigned& nx) {
    const unsigned G = gridDim.x * gridDim.y * gridDim.z;
    unsigned sum, cnt, mine, sp = 0u;
    for (;;) {
        sum = 0u; cnt = 0u; mine = 0u;
#pragma unroll
        for (unsigned j = 0; j < 16; ++j) { const unsigned c = xb_ld(&bar[XB_XCNT(j)]); sum += c; cnt += (c > 0u) ? 1u : 0u; mine = (j == x) ? c : mine; }
        if (sum == G) break;
        __builtin_amdgcn_s_sleep(1);
        if ((++sp & 255u) == 0u) { if (xb_ld(&bar[XB_TMO])) break; if (sp > XB_SPIN_CAP) { atomicAdd(&bar[XB_TMO], 1u); break; } }
    }
    nloc = mine > 0u ? mine : 1u; nx = cnt > 0u ? cnt : 1u;
}

__device__ __forceinline__ void xcd_barrier(const XcdBarrier& b) {
    asm volatile("s_waitcnt vmcnt(0)" ::: "memory");
    __syncthreads();
    if (threadIdx.x == 0) {
        unsigned* bar = b.bar;
        __builtin_amdgcn_s_waitcnt(0);
        unsigned nloc = b.st[0], nx = b.st[1];
        if (nloc == 0u) { xcd_barrier_complete(bar, b.x, nloc, nx); b.st[0] = nloc; b.st[1] = nx; }
        const unsigned old = xb_add(&bar[XB_XSUB(b.x)], 1u);
        const unsigned gen = old / nloc;
        if (old + 1u == (gen + 1u) * nloc) {
            __builtin_amdgcn_fence(__ATOMIC_RELEASE, "agent");
            asm volatile("s_waitcnt vmcnt(0)" ::: "memory");
            const unsigned og = xb_add(&bar[XB_TOP], 1u);
            const unsigned tg = og / nx;
            if (og + 1u == (tg + 1u) * nx) xb_add(&bar[XB_TOPGEN], 1u);
            else XB_SPIN(xb_ld(&bar[XB_TOPGEN]) == tg, bar);
            __builtin_amdgcn_fence(__ATOMIC_ACQUIRE, "agent");
            xb_add(&bar[XB_XGEN(b.x)], 1u);
            asm volatile("s_waitcnt vmcnt(0)" ::: "memory");
        } else {
            XB_SPIN(xb_ld(&bar[XB_XGEN(b.x)]) == gen, bar);
            __builtin_amdgcn_fence(__ATOMIC_ACQUIRE, "agent");
            asm volatile("s_waitcnt vmcnt(0)" ::: "memory");
        }
    }
    __syncthreads();
}


__device__ __forceinline__ void transpose_item(const float* __restrict__ W, int ldw, int srccol0, bf16_t* __restrict__ WT, int K, int destrow0, int k0, LAS float* scr, int lane, const float* kscale = nullptr) {
#pragma unroll 16
    for (int i = 0; i < 32; ++i) { const int kk = 2 * i + (lane >> 5); scr[kk * 33 + (lane & 31)] = W[(size_t)(k0 + kk) * ldw + srccol0 + (lane & 31)] * (kscale ? kscale[k0 + kk] : 1.f); }
    asm volatile("s_waitcnt lgkmcnt(0)" ::: "memory");
    const int c = lane & 7;
#pragma unroll
    for (int j = 0; j < 4; ++j) { const int n = (lane >> 3) + 8 * j; const LAS float* s = scr + (8 * c) * 33 + n;
        u32x4 o; o.x = cvtpk(s[0 * 33], s[1 * 33]); o.y = cvtpk(s[2 * 33], s[3 * 33]); o.z = cvtpk(s[4 * 33], s[5 * 33]); o.w = cvtpk(s[6 * 33], s[7 * 33]);
        *(u32x4*)(WT + (size_t)(destrow0 + n) * K + k0 + 8 * c) = o; }
    asm volatile("s_waitcnt lgkmcnt(0)" ::: "memory");
}

__device__ __forceinline__ void phase_weights(const Params& P, lptr lds, int lane, int wave) {
    unsigned char* ws = P.ws;
    LAS float* scr = (LAS float*)(lds + wave * 16384);
    const int gw = blockIdx.x * 8 + wave, NGW = gridDim.x * 8;
    constexpr int I1 = 16 * 112, I2 = 16 * 32, I3 = 16 * 176, I4 = 44 * 32;
    for (int it = gw; it < I1 + I2 + I3 + I4; it += NGW) {
        int r = it;
        if (r < I1) { const int kb = r / 112, n0 = (r % 112) * 32, tile = n0 >> 8, p = n0 & 255, wc = (p >> 5) & 3, bj = p >> 7, L = tile * 256 + 64 * wc + 32 * bj;
            transpose_item(P.in[I_WIN], DIN, L < 2048 ? L : L + 8, (bf16_t*)(ws + WS_W1T), 1024, n0, kb * 64, scr, lane); continue; }
        r -= I1;
        if (r < I2) { const int kb = r / 32, n0 = (r % 32) * 32; transpose_item(P.in[I_WOUT], 1024, n0, (bf16_t*)(ws + WS_W2T), 1024, n0, kb * 64, scr, lane, kb >= 8 ? P.in[I_SOW] - 512 : nullptr); continue; }
        r -= I2;
        if (r < I3) { const int kb = r / 176, n0 = (r % 176) * 32, pn = n0 >> 8, p = n0 & 255, bj = p >> 7, q0 = p & 127;
            transpose_item(P.in[I_WUP], FF2, 128 * pn + q0 + FF * bj, (bf16_t*)(ws + WS_W3T), 1024, n0, kb * 64, scr, lane); continue; }
        r -= I3;
        { const int kb = r / 32, n0 = (r % 32) * 32; transpose_item(P.in[I_WDOWN], 1024, n0, (bf16_t*)(ws + WS_W4T), FF, n0, kb * 64, scr, lane); }
    }
}

__device__ __forceinline__ void phase0(const Params& P, lptr lds, int tid, int lane, int wave) {
    unsigned char* ws = P.ws;
    LAS float* sc = (LAS float*)lds;
    for (int i = tid; i < 16384; i += 512) { const int r = i >> 10, k = i & 1023; const float c = r < 8 ? P.in[I_CP][r * 1024 + k] : P.in[I_CS][(r - 8) * 1024 + k]; sc[i] = c / (1.f + __expf(-c)); }
    __syncthreads();
    const int job = blockIdx.x * 512 + tid;
    if (job < 16 * 6144) {
        const int ks = job / 6144, n = job % 6144;
        float acc[16];
#pragma unroll
        for (int r = 0; r < 16; ++r) acc[r] = 0.f;
        const float* wp = P.in[I_WADA] + (size_t)(ks * 64) * 6144 + n;
#pragma unroll 16
        for (int k = 0; k < 64; ++k) { const float w = wp[(size_t)k * 6144];
#pragma unroll
            for (int r = 0; r < 16; ++r) acc[r] += sc[r * 1024 + ks * 64 + k] * w; }
        __attribute__((address_space(1))) float* mp = (__attribute__((address_space(1))) float*)(ws + WS_MOD);
        const float bias = ks == 0 ? P.in[I_BADA][n] : 0.f;
#pragma unroll
        for (int r = 0; r < 16; ++r) (void)__builtin_amdgcn_global_atomic_fadd_f32(mp + (size_t)r * 6144 + n, acc[r] + bias);
    }
}

__device__ __forceinline__ void load_mod_vectors(const Params& P, LAS float* A, LAS float* S, const float* normw, int r, int shofs, int tid) {
    const float* md = (const float*)(P.ws + WS_MOD) + (size_t)r * 6144 + shofs;
    for (int k = tid; k < 1024; k += 512) { A[k] = normw[k] * (1.f + md[1024 + k]); S[k] = md[k]; }
}
__device__ __forceinline__ void load_row_bf(const bf16_t* xrow, int lane, f32x4 (&v)[4]) {
#pragma unroll
    for (int j = 0; j < 4; ++j) { const u32x2 w = ((const u32x2*)xrow)[lane + 64 * j]; v[j] = (f32x4){bflo(w.x), bfhi(w.x), bflo(w.y), bfhi(w.y)}; }
}
__device__ __forceinline__ void load_row(const float* xrow, int lane, f32x4 (&v)[4]) {
#pragma unroll
    for (int j = 0; j < 4; ++j) v[j] = ((const f32x4*)xrow)[lane + 64 * j];
}
template <bool GATES>
__device__ __forceinline__ void norm_row(const Params& P, const f32x4 (&v)[4], bf16_t* orow, float* grow, const LAS float* A, const LAS float* S, const LAS float* Wg, int lane) {
    float s = 0.f;
#pragma unroll
    for (int j = 0; j < 4; ++j) s += (v[j].x * v[j].x + v[j].y * v[j].y) + (v[j].z * v[j].z + v[j].w * v[j].w);
    const float rstd = rsqrtf(wave_sum(s) * (1.f / 1024.f) + EPS);
    float g[8];
#pragma unroll
    for (int i = 0; i < 8; ++i) g[i] = 0.f;
#pragma unroll
    for (int j = 0; j < 4; ++j) { const int k0 = 4 * lane + 256 * j;
        const f32x4 a = *(const LAS f32x4*)(A + k0), sh = *(const LAS f32x4*)(S + k0);
        const f32x4 hv = v[j] * rstd * a + sh;
        u32x2 o; o.x = cvtpk(hv.x, hv.y); o.y = cvtpk(hv.z, hv.w);
        *(u32x2*)(orow + k0) = o;
        if (GATES) {
#pragma unroll
            for (int i = 0; i < 8; ++i) { const f32x4 w = *(const LAS f32x4*)(Wg + i * 1024 + k0); g[i] += (hv.x * w.x + hv.y * w.y) + (hv.z * w.z + hv.w * w.w); } }
    }
    if (GATES) {
        { const bool hi = (lane & 32) != 0;
#pragma unroll
          for (int i = 0; i < 4; ++i) { const float send = hi ? g[i] : g[i + 4], keep = hi ? g[i + 4] : g[i]; g[i] = keep + __shfl_xor(send, 32); } }
        { const bool hi = (lane & 16) != 0;
#pragma unroll
          for (int i = 0; i < 2; ++i) { const float send = hi ? g[i] : g[i + 2], keep = hi ? g[i + 2] : g[i]; g[i] = keep + __shfl_xor(send, 16); } }
        { const bool hi = (lane & 8) != 0; const float send = hi ? g[0] : g[1], keep = hi ? g[1] : g[0]; g[0] = keep + __shfl_xor(send, 8); }
        g[0] += __shfl_xor(g[0], 4); g[0] += __shfl_xor(g[0], 2); g[0] += __shfl_xor(g[0], 1);
        const int gt = lane >> 3;
        if ((lane & 7) == 0) {
            float o;
            if (gt < 4) o = g[0] + P.in[I_BIG][gt];
            else { const float x = g[0] + P.in[I_BFG][gt - 4]; o = fminf(x, 0.f) - log1pf(expf(-fabsf(x))); }
            grow[gt] = o;
        }
    }
}
__device__ __forceinline__ void phase1(const Params& P, lptr lds, int tid, int lane, int wave) {
    LAS float* A1 = (LAS float*)lds; LAS float* S1 = A1 + 1024; LAS float* Wg = S1 + 1024;
    const size_t row0 = (size_t)blockIdx.x * 128 + wave * 16; f32x4 v[4], vn[4]; load_row(P.in[I_XP] + row0 * 1024, lane, v);
    for (int k = tid; k < 1024; k += 512) { const f32x4 w0 = *(const f32x4*)(P.in[I_WIN] + (size_t)k * DIN + 2048), w1 = *(const f32x4*)(P.in[I_WIN] + (size_t)k * DIN + 2052);
        Wg[k] = w0.x; Wg[1024 + k] = w0.y; Wg[2048 + k] = w0.z; Wg[3072 + k] = w0.w; Wg[4096 + k] = w1.x; Wg[5120 + k] = w1.y; Wg[6144 + k] = w1.z; Wg[7168 + k] = w1.w; }
    load_mod_vectors(P, A1, S1, P.in[I_N1W], blockIdx.x >> 5, 0, tid);
    LAS float* A1s = Wg + 8192; LAS float* S1s = A1s + 1024;
    load_mod_vectors(P, A1s, S1s, P.in[I_N1W], 8 + (blockIdx.x >> 5), 0, tid);
    __syncthreads();
    bf16_t* H = (bf16_t*)(P.ws + WS_H); float* GT = (float*)(P.ws + WS_GATES);
    {
#pragma unroll 1
      for (int j = 0; j < 16; ++j) { const size_t row = row0 + j;
          if (j + 1 < 16) load_row(P.in[I_XP] + (row + 1) * 1024, lane, vn);
          else if (wave == 0) load_row(P.in[I_XS] + (size_t)blockIdx.x * 1024, lane, vn);
          norm_row<true>(P, v, H + row * 1024, GT + row * 8, A1, S1, Wg, lane);
#pragma unroll
          for (int q = 0; q < 4; ++q) v[q] = vn[q]; }
      if (wave == 0) norm_row<true>(P, v, H + ((size_t)MP + blockIdx.x) * 1024, GT + ((size_t)MP + blockIdx.x) * 8, A1s, S1s, Wg, lane); }
}
__device__ __forceinline__ void phase5(const Params& P, lptr lds, int tid, int lane, int wave) {
    LAS float* A1 = (LAS float*)lds; LAS float* S1 = A1 + 1024;
    load_mod_vectors(P, A1, S1, P.in[I_N2W], blockIdx.x >> 5, 3072, tid);
    __syncthreads();
    bf16_t* H = (bf16_t*)(P.ws + WS_H);
    { const size_t row0 = (size_t)blockIdx.x * 128 + wave * 16; const bf16_t* X1 = (const bf16_t*)(P.ws + WS_X1B); f32x4 v[4], vn[4]; load_row_bf(X1 + row0 * 1024, lane, v);
#pragma unroll 1
      for (int j = 0; j < 16; ++j) { const size_t row = row0 + j;
          if (j + 1 < 16) load_row_bf(X1 + (row + 1) * 1024, lane, vn);
          norm_row<false>(P, v, H + row * 1024, nullptr, A1, S1, nullptr, lane);
#pragma unroll
          for (int q = 0; q < 4; ++q) v[q] = vn[q]; } }
    __syncthreads();
}
__device__ __forceinline__ void sample_h2_row(const Params& P, lptr lds, int tid, int lane, int wave) {
    LAS float* A1 = (LAS float*)lds; LAS float* S1 = A1 + 1024;
    load_mod_vectors(P, A1, S1, P.in[I_N2W], 8 + (blockIdx.x >> 5), 3072, tid);
    __syncthreads();
    if (wave == 0) { f32x4 v[4]; load_row_bf((const bf16_t*)(P.ws + WS_X1B) + ((size_t)MP + blockIdx.x) * 1024, lane, v); norm_row<false>(P, v, (bf16_t*)(P.ws + WS_H) + ((size_t)MP + blockIdx.x) * 1024, nullptr, A1, S1, nullptr, lane); }
    __syncthreads();
}
__device__ __forceinline__ void phase3b(const Params& P, int lane, int gw, int NGW) {
    bf16_t* Y = (bf16_t*)(P.ws + WS_YCAT); const float* SSQ = (const float*)(P.ws + WS_SSQ);
    for (int row = gw; row < MP; row += NGW) {
        const f32x4 s0 = *(const f32x4*)(SSQ + (size_t)row * 8), s1 = *(const f32x4*)(SSQ + (size_t)row * 8 + 4);
        const float rstd = rsqrtf(((s0.x + s0.y) + (s0.z + s0.w) + (s1.x + s1.y) + (s1.z + s1.w)) * (1.f / 512.f) + EPS);
        u32x4* p = (u32x4*)(Y + (size_t)row * 1024 + 512 + 8 * lane); const u32x4 o = *p;
        f32x4 a = {bflo(o.x), bfhi(o.x), bflo(o.y), bfhi(o.y)}, b = {bflo(o.z), bfhi(o.z), bflo(o.w), bfhi(o.w)};
        a = a * rstd; b = b * rstd;
        *p = pack8(a, b);
    }
}
__device__ __forceinline__ void phase_fix(const Params& P, int tid) {
    const float* UE = (const float*)(P.ws + WS_UEDGE); bf16_t* act = (bf16_t*)(P.ws + WS_ACT);
    const float* wc = P.in[I_WCONV]; const float* bc = P.in[I_BCONV];
    const int total = 128 * 2 * FF;
    if (blockIdx.x < 64) return;
    for (int i = (blockIdx.x - 64) * 512 + tid; i < total; i += (gridDim.x - 64) * 512) {
        const int j = i % FF, rr = (i / FF) & 1, pm = i / (2 * FF);
        if ((pm & 15) == 0) continue;
        float uc[2];
#pragma unroll
        for (int hf = 0; hf < 2; ++hf) { const int c = j + hf * FF;
            const float um2 = rr == 0 ? UE[((size_t)(pm - 1) * 4 + 2) * FF2 + c] : UE[((size_t)(pm - 1) * 4 + 3) * FF2 + c];
            const float um1 = rr == 0 ? UE[((size_t)(pm - 1) * 4 + 3) * FF2 + c] : UE[((size_t)pm * 4 + 0) * FF2 + c];
            const float u0 = UE[((size_t)pm * 4 + rr) * FF2 + c];
            uc[hf] = bc[c] + wc[2 * FF2 + c] * u0 + wc[FF2 + c] * um1 + wc[c] * um2; }
        act[((size_t)pm * 256 + rr) * FF + j] = f2bf(uc[0] * sigmoidf_(uc[0]) * uc[1]);
    }
}

constexpr int ML_P = 272;
constexpr int ML_QS = 0, ML_KS = 17408, ML_VS = 34816, ML_VW = 52224, ML_CS = 69632, ML_SS = 104448, ML_SC = 113664;
__device__ __forceinline__ void mlstm_item(const Params& P, lptr lds, int bh, bool sample, int tid, int lane, int wave) {
    const int b = bh >> 2, h = bh & 3, hh = lane >> 5, n31 = lane & 31;
    const size_t rowbase = sample ? (size_t)MP + b * 32 : (size_t)b * SEQ;
    const int nch = sample ? 1 : 64, L = sample ? 32 : 64;
    const bf16_t* MQ = (const bf16_t*)(P.ws + WS_PROJ); const bf16_t* MK = (const bf16_t*)(P.ws + WS_PROJ + PROJ_STRIDE); const bf16_t* MV = (const bf16_t*)(P.ws + WS_PROJ + 2 * PROJ_STRIDE);
    const bf16_t* MO = (const bf16_t*)(P.ws + WS_PROJ + 3 * PROJ_STRIDE); const float* GT = (const float*)(P.ws + WS_GATES); bf16_t* YC = (bf16_t*)(P.ws + WS_YCAT);
    LAS float* sc = (LAS float*)(lds + ML_SC);
    LAS float* bt = sc, *as_ = sc + 64, *mt = sc + 128, *winter = sc + 192, *emt = sc + 256, *wk = sc + 320, *rsum = sc + 384, *qn = sc + 512, *nvec = sc + 576, *misc = sc + 704;
    const int ti = wave >> 2, ej = wave & 3;
    f32x16 Cacc[2];
    {
        LAS float* cst = (LAS float*)lds;
        if (sample) { const float* src = P.in[I_STC] + ((size_t)b * 4 + h) * 16384;
            for (int i = tid; i < 4096; i += 512) { const f32x4 v = *(const f32x4*)(src + 4 * i); *(LAS f32x4*)(cst + (i >> 5) * 132 + (i & 31) * 4) = v; } }
        else { for (int i = tid; i < 4096; i += 512) *(LAS f32x4*)(cst + (i >> 5) * 132 + (i & 31) * 4) = (f32x4){0.f, 0.f, 0.f, 0.f}; }
        __syncthreads();
        const LAS float* cb = cst + (64 * (wave >> 2) + 4 * hh) * 132 + 32 * ej + n31;
#pragma unroll
        for (int i = 0; i < 2; ++i)
#pragma unroll
            for (int r = 0; r < 16; ++r) Cacc[i][r] = cb[(32 * i + (r & 3) + 8 * (r >> 2)) * 132];
        __syncthreads();
        lptr cs = lds + ML_CS + (64 * (wave >> 2) + 4 * hh) * ML_P + (32 * ej + n31) * 2;
#pragma unroll
        for (int i = 0; i < 2; ++i)
#pragma unroll
            for (int r = 0; r < 16; ++r) *(LAS unsigned short*)(cs + (32 * i + (r & 3) + 8 * (r >> 2)) * ML_P) = f2bf(Cacc[i][r]);
    }
    if (tid < 128) nvec[tid] = sample ? P.in[I_STN][((size_t)b * 4 + h) * 128 + tid] : 0.f;
    if (tid == 0) misc[0] = sample ? P.in[I_STM][b * 4 + h] : 0.f;
    u32x4 rq[2], rk[2], rv[2]; float g_ig = -INFINITY, g_lf = 0.f;
    const int prow[2] = {tid >> 4, (tid + 512) >> 4}, pch = tid & 15;
#define ML_LOAD(c) do { _Pragma("unroll") for (int i = 0; i < 2; ++i) { if (prow[i] < L) { const size_t go = (rowbase + (size_t)(c) * 64 + prow[i]) * 512 + h * 128 + pch * 8; \
            rq[i] = *(const u32x4*)(MQ + go); rk[i] = *(const u32x4*)(MK + go); rv[i] = *(const u32x4*)(MV + go); } else { rq[i] = (u32x4){0u, 0u, 0u, 0u}; rk[i] = rq[i]; rv[i] = rq[i]; } } \
        if (wave == 0) { if (lane < L) { const float* g = GT + (rowbase + (size_t)(c) * 64 + lane) * 8; g_ig = g[h]; g_lf = g[4 + h]; } else { g_ig = -INFINITY; g_lf = 0.f; } } } while (0)
    ML_LOAD(0);
    for (int c = 0; c < nch; ++c) {
        __syncthreads();
        if (wave == 0) {
            float bcum = g_lf;
#pragma unroll
            for (int o = 1; o < 64; o <<= 1) { const float v = __shfl_up(bcum, o); if (lane >= o) bcum += v; }
            const float a = g_ig - bcum; float amax = a;
#pragma unroll
            for (int o = 1; o < 64; o <<= 1) { const float v = __shfl_up(amax, o); if (lane >= o) amax = fmaxf(amax, v); }
            const float mprev = misc[0];
            const float m_t = fmaxf(bcum + mprev, bcum + amax);
            const float bL = __shfl(bcum, 63), aM = __shfl(amax, 63);
            const float m_new = fmaxf(bL + mprev, bL + aM);
            bt[lane] = bcum; as_[lane] = a; mt[lane] = m_t; winter[lane] = expf(bcum + mprev - m_t); emt[lane] = expf(-m_t); wk[lane] = expf(bL + a - m_new);
            if (lane == 0) { misc[1] = expf(bL + mprev - m_new); misc[2] = m_new; }
        }
#pragma unroll
        for (int i = 0; i < 2; ++i) { const int o = prow[i] * ML_P + pch * 16;
            *(LAS u32x4*)(lds + ML_QS + o) = rq[i]; *(LAS u32x4*)(lds + ML_KS + o) = rk[i]; *(LAS u32x4*)(lds + ML_VS + o) = rv[i]; }
        __syncthreads();
#pragma unroll
        for (int i = 0; i < 2; ++i) { const float w = wk[prow[i]]; const u32x4 v = rv[i]; u32x4 o;
            o.x = cvtpk(bflo(v.x) * w, bfhi(v.x) * w); o.y = cvtpk(bflo(v.y) * w, bfhi(v.y) * w); o.z = cvtpk(bflo(v.z) * w, bfhi(v.z) * w); o.w = cvtpk(bflo(v.w) * w, bfhi(v.w) * w);
            *(LAS u32x4*)(lds + ML_VW + prow[i] * ML_P + pch * 16) = o; }
        if (c + 1 < nch) ML_LOAD(c + 1);
        f32x16 num;
#pragma unroll
        for (int r = 0; r < 16; ++r) num[r] = 0.f;
#pragma unroll
        for (int ks = 0; ks < 8; ++ks) num = MFMA32(row_frag(lds + ML_QS, ML_P, 32 * ti, 16 * ks, lane), tr_frag(lds + ML_CS, ML_P, 16 * ks, 32 * ej, lane), num);
        if (wave < 3) {
            const int sti = wave == 0 ? 0 : 1, sj = wave == 2 ? 1 : 0;
            const int krow = (n31 & ~12) | ((n31 & 4) << 1) | ((n31 & 8) >> 1);
            f32x16 p;
#pragma unroll
            for (int r = 0; r < 16; ++r) p[r] = 0.f;
#pragma unroll
            for (int ks = 0; ks < 8; ++ks) p = MFMA32(*(const LAS bf16x8*)(lds + ML_KS + (32 * sj + krow) * ML_P + (16 * ks + 8 * hh) * 2), row_frag(lds + ML_QS, ML_P, 32 * sti, 16 * ks, lane), p);
            const int t = 32 * sti + n31; const float bt_t = bt[t], mt_t = mt[t]; float rs = 0.f;
            const LAS float* asb = as_ + 32 * sj + 8 * hh; const int tb = t - (32 * sj + 8 * hh);
#pragma unroll
            for (int r = 0; r < 16; ++r) { const int so = 16 * (r >> 3) + (r & 7);
                const float w = so <= tb ? __expf(bt_t + asb[so] - mt_t) : 0.f; p[r] *= w; rs += p[r]; }
#pragma unroll
            for (int a2 = 0; a2 < 2; ++a2) { u32x4 o; o.x = cvtpk(p[8 * a2 + 0], p[8 * a2 + 1]); o.y = cvtpk(p[8 * a2 + 2], p[8 * a2 + 3]); o.z = cvtpk(p[8 * a2 + 4], p[8 * a2 + 5]); o.w = cvtpk(p[8 * a2 + 6], p[8 * a2 + 7]);
                *(LAS u32x4*)(lds + ML_SS + t * 144 + (32 * sj + 16 * a2 + 8 * hh) * 2) = o; }
            rs += __shfl_xor(rs, 32);
            if (hh == 0) rsum[sj * 64 + t] = rs;
        }
        if (wave >= 4) {
            const int t = (tid - 256) >> 2, part = tid & 3; float s = 0.f;
#pragma unroll 8
            for (int d = 0; d < 32; ++d) s += bf2f(*(const LAS unsigned short*)(lds + ML_QS + t * ML_P + (32 * part + d) * 2)) * nvec[32 * part + d];
            s += __shfl_xor(s, 1); s += __shfl_xor(s, 2);
            if (part == 0) qn[t] = s;
        }
        __syncthreads();
        const LAS float* tb2 = sc + 32 * ti + 4 * hh;
#pragma unroll
        for (int r = 0; r < 16; ++r) num[r] *= tb2[192 + (r & 3) + 8 * (r >> 2)];
#pragma unroll
        for (int ks = 0; ks < 4; ++ks) if (ks < 2 || ti == 1) num = MFMA32(*(const LAS bf16x8*)(lds + ML_SS + (32 * ti + n31) * 144 + (16 * ks + 8 * hh) * 2), tr_frag(lds + ML_VS, ML_P, 16 * ks, 32 * ej, lane), num);
#pragma unroll
        for (int r = 0; r < 16; ++r) { const int o = (r & 3) + 8 * (r >> 2);
            const float den = tb2[192 + o] * tb2[512 + o] + tb2[384 + o] + (ti ? tb2[448 + o] : 0.f);
            const float hv = num[r] / fmaxf(fabsf(den), tb2[256 + o]);
            *(LAS unsigned short*)(lds + ML_QS + (32 * ti + 4 * hh) * ML_P + (32 * ej + n31) * 2 + o * ML_P) = f2bf(hv); }
        const float decay = misc[1];
#pragma unroll
        for (int i = 0; i < 2; ++i) { const int di = 2 * (wave >> 2) + i;
#pragma unroll
            for (int r = 0; r < 16; ++r) Cacc[i][r] *= decay;
#pragma unroll
            for (int ks = 0; ks < 4; ++ks) Cacc[i] = MFMA32(tr_frag(lds + ML_KS, ML_P, 16 * ks, 32 * di, lane), tr_frag(lds + ML_VW, ML_P, 16 * ks, 32 * ej, lane), Cacc[i]);
#pragma unroll
            for (int r = 0; r < 16; ++r) *(LAS unsigned short*)(lds + ML_CS + (64 * (wave >> 2) + 4 * hh) * ML_P + (32 * ej + n31) * 2 + (32 * i + (r & 3) + 8 * (r >> 2)) * ML_P) = f2bf(Cacc[i][r]); }
        if (tid < 128) { float s = decay * nvec[tid];
#pragma unroll 8
            for (int t = 0; t < 64; ++t) s += wk[t] * bf2f(*(const LAS unsigned short*)(lds + ML_KS + t * ML_P + tid * 2));
            nvec[tid] = s; }
        if (tid == 0) misc[0] = misc[2];
        __syncthreads();
        { const int t = tid >> 3, part = tid & 7;
          const u32x4 h0 = *(const LAS u32x4*)(lds + ML_QS + t * ML_P + part * 32), h1 = *(const LAS u32x4*)(lds + ML_QS + t * ML_P + part * 32 + 16);
          float hv[16] = {bflo(h0.x), bfhi(h0.x), bflo(h0.y), bfhi(h0.y), bflo(h0.z), bfhi(h0.z), bflo(h0.w), bfhi(h0.w), bflo(h1.x), bfhi(h1.x), bflo(h1.y), bfhi(h1.y), bflo(h1.z), bfhi(h1.z), bflo(h1.w), bfhi(h1.w)};
          float ss = 0.f;
#pragma unroll
          for (int e = 0; e < 16; ++e) ss += hv[e] * hv[e];
          ss += __shfl_xor(ss, 1); ss += __shfl_xor(ss, 2); ss += __shfl_xor(ss, 4);
          const float rstd = rsqrtf(ss * (1.f / 128.f) + EPS);
          if (t < L) {
              const size_t row = rowbase + (size_t)c * 64 + t; const int col = h * 128 + part * 16;
              const u32x4 g0 = *(const u32x4*)(MO + row * 512 + col), g1 = *(const u32x4*)(MO + row * 512 + col + 8);
              const float gv[16] = {bflo(g0.x), bfhi(g0.x), bflo(g0.y), bfhi(g0.y), bflo(g0.z), bfhi(g0.z), bflo(g0.w), bfhi(g0.w), bflo(g1.x), bfhi(g1.x), bflo(g1.y), bfhi(g1.y), bflo(g1.z), bfhi(g1.z), bflo(g1.w), bfhi(g1.w)};
              const float* mw = P.in[I_MLW] + col;
              float y[16];
#pragma unroll
              for (int e = 0; e < 16; ++e) y[e] = hv[e] * rstd * mw[e] * gv[e];
              u32x4 o0, o1; o0.x = cvtpk(y[0], y[1]); o0.y = cvtpk(y[2], y[3]); o0.z = cvtpk(y[4], y[5]); o0.w = cvtpk(y[6], y[7]); o1.x = cvtpk(y[8], y[9]); o1.y = cvtpk(y[10], y[11]); o1.z = cvtpk(y[12], y[13]); o1.w = cvtpk(y[14], y[15]);
              *(u32x4*)(YC + row * 1024 + col) = o0; *(u32x4*)(YC + row * 1024 + col + 8) = o1;
          } }
    }
#undef ML_LOAD
    __syncthreads();
    {
        LAS float* cst = (LAS float*)lds;
        int l3 = lane; asm volatile("" : "+v"(l3));
        LAS float* cb = cst + (64 * (wave >> 2) + 4 * (l3 >> 5)) * 132 + 32 * ej + (l3 & 31);
#pragma unroll
        for (int i = 0; i < 2; ++i)
#pragma unroll
            for (int r = 0; r < 16; ++r) cb[(32 * i + (r & 3) + 8 * (r >> 2)) * 132] = Cacc[i][r];
        __syncthreads();
        float* oc = P.out + (sample ? O_SC : O_PC) + ((size_t)b * 4 + h) * 16384;
        for (int i = tid; i < 4096; i += 512) *(f32x4*)(oc + 4 * i) = *(const LAS f32x4*)(cst + (i >> 5) * 132 + (i & 31) * 4);
    }
    if (tid < 128) P.out[(sample ? O_SN : O_PN) + ((size_t)b * 4 + h) * 128 + tid] = nvec[tid];
    if (tid == 0) P.out[(sample ? O_SM : O_PM) + b * 4 + h] = misc[0];
}


constexpr size_t WS_KVL = WS_H, WS_KNL = 420 * MiB, WS_CHS = 421 * MiB, WS_NST = 422 * MiB, WS_MST = 423 * MiB, WS_CST = 424 * MiB, WS_END2 = 489 * MiB;
template <int NC>
__device__ __forceinline__ void ml1_pair(const Params& P, lptr lds, int pair, int tid, int lane, int wave) {
    const int item0 = NC * pair; const int bh = item0 >> 6, c = item0 & 63, b = bh >> 2, h = bh & 3, hh = lane >> 5, n31 = lane & 31, ej = wave & 3;
    const size_t row0 = (size_t)b * SEQ + 64 * c;
    const bf16_t* MK = (const bf16_t*)(P.ws + WS_PROJ + PROJ_STRIDE); const bf16_t* MV = (const bf16_t*)(P.ws + WS_PROJ + 2 * PROJ_STRIDE); const float* GT = (const float*)(P.ws + WS_GATES);
    LAS float* wk = (LAS float*)(lds + ML_SC) + 320;
    const int prow[2] = {tid >> 4, (tid + 512) >> 4}, pch = tid & 15;
    u32x4 rk2[NC][2], rv2[NC][2]; float g_ig2[NC], g_lf2[NC];
#pragma unroll
    for (int s2 = 0; s2 < NC; ++s2) { g_ig2[s2] = 0.f; g_lf2[s2] = 0.f;
#pragma unroll
        for (int i = 0; i < 2; ++i) { const size_t go = (row0 + 64 * s2 + prow[i]) * 512 + h * 128 + pch * 8; rk2[s2][i] = *(const u32x4*)(MK + go); rv2[s2][i] = *(const u32x4*)(MV + go); }
        if (wave == 0) { const float* g = GT + (row0 + 64 * s2 + lane) * 8; g_ig2[s2] = g[h]; g_lf2[s2] = g[4 + h]; } }
#pragma unroll
    for (int s2 = 0; s2 < NC; ++s2) {
    const int item = item0 + s2; const float g_ig = g_ig2[s2], g_lf = g_lf2[s2];
    u32x4 rk[2] = {rk2[s2][0], rk2[s2][1]}, rv[2] = {rv2[s2][0], rv2[s2][1]};
    __syncthreads();
    if (wave == 0) {
        float bcum = g_lf;
#pragma unroll
        for (int o = 1; o < 64; o <<= 1) { const float v = __shfl_up(bcum, o); if (lane >= o) bcum += v; }
        const float a = g_ig - bcum; float amax = a;
#pragma unroll
        for (int o = 1; o < 64; o <<= 1) amax = fmaxf(amax, __shfl_xor(amax, o));
        const float bL = __shfl(bcum, 63);
        wk[lane] = expf(a - amax);
        if (lane == 0) { float* ch = (float*)(P.ws + WS_CHS) + (size_t)item * 4; ch[0] = bL; ch[1] = bL + amax; }
    }
#pragma unroll
    for (int i = 0; i < 2; ++i) *(LAS u32x4*)(lds + ML_KS + prow[i] * ML_P + pch * 16) = rk[i];
    __syncthreads();
#pragma unroll
    for (int i = 0; i < 2; ++i) { const float w = wk[prow[i]]; const u32x4 v = rv[i]; u32x4 o;
        o.x = cvtpk(bflo(v.x) * w, bfhi(v.x) * w); o.y = cvtpk(bflo(v.y) * w, bfhi(v.y) * w); o.z = cvtpk(bflo(v.z) * w, bfhi(v.z) * w); o.w = cvtpk(bflo(v.w) * w, bfhi(v.w) * w);
        *(LAS u32x4*)(lds + ML_VW + prow[i] * ML_P + pch * 16) = o; }
    if (tid < 128) { float s = 0.f;
#pragma unroll 8
        for (int t = 0; t < 64; ++t) s += wk[t] * bf2f(*(const LAS unsigned short*)(lds + ML_KS + t * ML_P + tid * 2));
        ((float*)(P.ws + WS_KNL))[(size_t)item * 128 + tid] = s; }
    __syncthreads();
#pragma unroll
    for (int i = 0; i < 2; ++i) { const int di = 2 * (wave >> 2) + i;
        f32x16 acc;
#pragma unroll
        for (int r = 0; r < 16; ++r) acc[r] = 0.f;
#pragma unroll
        for (int ks = 0; ks < 4; ++ks) acc = MFMA32(tr_frag(lds + ML_KS, ML_P, 16 * ks, 32 * di, lane), tr_frag(lds + ML_VW, ML_P, 16 * ks, 32 * ej, lane), acc);
#pragma unroll
        for (int r = 0; r < 16; ++r) *(LAS unsigned short*)(lds + ML_CS + (64 * (wave >> 2) + 4 * hh) * ML_P + (32 * ej + n31) * 2 + (32 * i + (r & 3) + 8 * (r >> 2)) * ML_P) = f2bf(acc[r]); }
    __syncthreads();
    bf16_t* kvl = (bf16_t*)(P.ws + WS_KVL) + (size_t)item * 16384;
#pragma unroll
    for (int i = 0; i < 4; ++i) { const int p = tid + 512 * i, row = p >> 4, ch = p & 15; *(u32x4*)(kvl + row * 128 + ch * 8) = *(const LAS u32x4*)(lds + ML_CS + row * ML_P + ch * 16); }
    }
}
__device__ __forceinline__ void ml2_scan(const Params& P, lptr lds, int tid) {
    const int hb = tid >> 8, lt = tid & 255, job = 2 * blockIdx.x + hb;
    const int bh = job >> 3, part = job & 7;
    LAS float* dec = (LAS float*)(lds + hb * 1024); LAS float* scl = dec + 64; LAS float* mst = scl + 64;
    if (lt < 64) {
        const float* ch = (const float*)(P.ws + WS_CHS) + ((size_t)bh * 64 + lt) * 4;
        const float bL = ch[0], ml = ch[1]; float A = bL, B = ml;
#pragma unroll
        for (int off = 1; off < 64; off <<= 1) { const float A2 = __shfl_up(A, off), B2 = __shfl_up(B, off); if (lt >= off) { B = fmaxf(B2 + A, B); A = A2 + A; } }
        const float mnext = fmaxf(A, B);
        float mc = __shfl_up(mnext, 1); if (lt == 0) mc = 0.f;
        dec[lt] = expf(bL + mc - mnext); scl[lt] = expf(ml - mnext); mst[lt] = mc; if (lt == 63) mst[64] = mnext;
    }
    __syncthreads();
    const size_t e0 = (size_t)part * 2048 + lt * 8;
    const bf16_t* kv = (const bf16_t*)(P.ws + WS_KVL) + (size_t)bh * 64 * 16384 + e0; bf16_t* cs = (bf16_t*)(P.ws + WS_CST) + (size_t)bh * 64 * 16384 + e0;
    f32x4 C0 = {0.f, 0.f, 0.f, 0.f}, C1 = {0.f, 0.f, 0.f, 0.f};
    const bool do_n = part == 0 && lt < 128; const int tn = do_n ? lt : 0; float n = 0.f;
    const float* kn = (const float*)(P.ws + WS_KNL) + (size_t)bh * 64 * 128 + tn; float* ns = (float*)(P.ws + WS_NST) + (size_t)bh * 64 * 128 + tn;
#pragma unroll 16
    for (int c = 0; c < 64; ++c) { const u32x4 v = *(const u32x4*)(kv + (size_t)c * 16384);
        float knv = 0.f; if (do_n) knv = kn[c * 128];
        *(u32x4*)(cs + (size_t)c * 16384) = pack8(C0, C1);
        if (do_n) ns[c * 128] = n;
        const f32x4 k0 = {bflo(v.x), bfhi(v.x), bflo(v.y), bfhi(v.y)}, k1 = {bflo(v.z), bfhi(v.z), bflo(v.w), bfhi(v.w)};
        const float d = dec[c], sl = scl[c];
        C0 = C0 * d + k0 * sl; C1 = C1 * d + k1 * sl; n = n * d + knv * sl; }
    float* oc = P.out + O_PC + (size_t)bh * 16384 + e0; *(f32x4*)oc = C0; *(f32x4*)(oc + 4) = C1;
    if (do_n) P.out[O_PN + (size_t)bh * 128 + lt] = n;
    if (part == 0 && lt >= 128 && lt < 192) ((float*)(P.ws + WS_MST))[bh * 64 + lt - 128] = mst[lt - 128];
    if (part == 0 && lt == 192) P.out[O_PM + bh] = mst[64];
}
struct Ml3In { u32x4 rq[2], rk[2], rv[2], rc[4], g0, g1; float g_ig, g_lf, mprev, nin; };
__device__ __forceinline__ void ml3_load(const Params& P, int item, int tid, int lane, int wave, Ml3In& L) {
    const int bh = item >> 6, c = item & 63, b = bh >> 2, h = bh & 3;
    const size_t row0 = (size_t)b * SEQ + 64 * c;
    const bf16_t* MQ = (const bf16_t*)(P.ws + WS_PROJ); const bf16_t* MK = (const bf16_t*)(P.ws + WS_PROJ + PROJ_STRIDE); const bf16_t* MV = (const bf16_t*)(P.ws + WS_PROJ + 2 * PROJ_STRIDE);
    const bf16_t* MO = (const bf16_t*)(P.ws + WS_PROJ + 3 * PROJ_STRIDE); const float* GT = (const float*)(P.ws + WS_GATES);
    const int prow[2] = {tid >> 4, (tid + 512) >> 4}, pch = tid & 15;
#pragma unroll
    for (int i = 0; i < 2; ++i) { const size_t go = (row0 + prow[i]) * 512 + h * 128 + pch * 8; L.rq[i] = *(const u32x4*)(MQ + go); L.rk[i] = *(const u32x4*)(MK + go); L.rv[i] = *(const u32x4*)(MV + go); }
    const bf16_t* cst = (const bf16_t*)(P.ws + WS_CST) + (size_t)item * 16384;
#pragma unroll
    for (int i = 0; i < 4; ++i) { const int p = tid + 512 * i; L.rc[i] = *(const u32x4*)(cst + (p >> 4) * 128 + (p & 15) * 8); }
    { const size_t row = row0 + (tid >> 3); const int col = h * 128 + (tid & 7) * 16; L.g0 = *(const u32x4*)(MO + row * 512 + col); L.g1 = *(const u32x4*)(MO + row * 512 + col + 8); }
    L.g_ig = 0.f; L.g_lf = 0.f; L.mprev = 0.f; L.nin = 0.f;
    if (wave == 0) { const float* g = GT + (row0 + lane) * 8; L.g_ig = g[h]; L.g_lf = g[4 + h]; L.mprev = ((const float*)(P.ws + WS_MST))[item]; }
    if (tid < 128) L.nin = ((const float*)(P.ws + WS_NST))[(size_t)item * 128 + tid];
}
__device__ __forceinline__ void ml3_item(const Params& P, lptr lds, int item, const Ml3In& L, int tid, int lane, int wave) {
    const int bh = item >> 6, c = item & 63, b = bh >> 2, h = bh & 3, hh = lane >> 5, n31 = lane & 31;
    const size_t row0 = (size_t)b * SEQ + 64 * c;
    bf16_t* YC = (bf16_t*)(P.ws + WS_YCAT);
    LAS float* sc = (LAS float*)(lds + ML_SC);
    LAS float* bt = sc, *as_ = sc + 64, *mt = sc + 128, *winter = sc + 192, *emt = sc + 256, *rsum = sc + 384, *qn = sc + 512, *nvec = sc + 576;
    const int ti = wave >> 2, ej = wave & 3;
    const int prow[2] = {tid >> 4, (tid + 512) >> 4}, pch = tid & 15;
    const float g_ig = L.g_ig, g_lf = L.g_lf, mprev = L.mprev, nin = L.nin;
    __syncthreads();
    if (wave == 0) {
        float bcum = g_lf;
#pragma unroll
        for (int o = 1; o < 64; o <<= 1) { const float v = __shfl_up(bcum, o); if (lane >= o) bcum += v; }
        const float a = g_ig - bcum; float amax = a;
#pragma unroll
        for (int o = 1; o < 64; o <<= 1) { const float v = __shfl_up(amax, o); if (lane >= o) amax = fmaxf(amax, v); }
        const float m_t = fmaxf(bcum + mprev, bcum + amax);
        bt[lane] = bcum; as_[lane] = a; mt[lane] = m_t; winter[lane] = expf(bcum + mprev - m_t); emt[lane] = expf(-m_t);
    }
    if (tid < 128) nvec[tid] = nin;
#pragma unroll
    for (int i = 0; i < 2; ++i) { const int o = prow[i] * ML_P + pch * 16;
        *(LAS u32x4*)(lds + ML_QS + o) = L.rq[i]; *(LAS u32x4*)(lds + ML_KS + o) = L.rk[i]; *(LAS u32x4*)(lds + ML_VS + o) = L.rv[i]; }
#pragma unroll
    for (int i = 0; i < 4; ++i) { const int p = tid + 512 * i; *(LAS u32x4*)(lds + ML_CS + (p >> 4) * ML_P + (p & 15) * 16) = L.rc[i]; }
    __syncthreads();
    f32x16 num;
#pragma unroll
    for (int r = 0; r < 16; ++r) num[r] = 0.f;
#pragma unroll
    for (int ks = 0; ks < 8; ++ks) num = MFMA32(row_frag(lds + ML_QS, ML_P, 32 * ti, 16 * ks, lane), tr_frag(lds + ML_CS, ML_P, 16 * ks, 32 * ej, lane), num);
    if (wave < 3) {
        const int sti = wave == 0 ? 0 : 1, sj = wave == 2 ? 1 : 0;
        const int krow = (n31 & ~12) | ((n31 & 4) << 1) | ((n31 & 8) >> 1);
        f32x16 p;
#pragma unroll
        for (int r = 0; r < 16; ++r) p[r] = 0.f;
#pragma unroll
        for (int ks = 0; ks < 8; ++ks) p = MFMA32(*(const LAS bf16x8*)(lds + ML_KS + (32 * sj + krow) * ML_P + (16 * ks + 8 * hh) * 2), row_frag(lds + ML_QS, ML_P, 32 * sti, 16 * ks, lane), p);
        const int t = 32 * sti + n31; const float bt_t = bt[t], mt_t = mt[t]; float rs = 0.f;
        const LAS float* asb = as_ + 32 * sj + 8 * hh; const int tb = t - (32 * sj + 8 * hh);
#pragma unroll
        for (int r = 0; r < 16; ++r) { const int so = 16 * (r >> 3) + (r & 7);
            const float w = so <= tb ? __expf(bt_t + asb[so] - mt_t) : 0.f; p[r] *= w; rs += p[r]; }
#pragma unroll
        for (int a2 = 0; a2 < 2; ++a2) { u32x4 o; o.x = cvtpk(p[8 * a2 + 0], p[8 * a2 + 1]); o.y = cvtpk(p[8 * a2 + 2], p[8 * a2 + 3]); o.z = cvtpk(p[8 * a2 + 4], p[8 * a2 + 5]); o.w = cvtpk(p[8 * a2 + 6], p[8 * a2 + 7]);
            *(LAS u32x4*)(lds + ML_SS + t * 144 + (32 * sj + 16 * a2 + 8 * hh) * 2) = o; }
        rs += __shfl_xor(rs, 32);
        if (hh == 0) rsum[sj * 64 + t] = rs;
    }
    if (wave >= 4) {
        const int t = (tid - 256) >> 2, part = tid & 3; float s = 0.f;
#pragma unroll 8
        for (int d = 0; d < 32; ++d) s += bf2f(*(const LAS unsigned short*)(lds + ML_QS + t * ML_P + (32 * part + d) * 2)) * nvec[32 * part + d];
        s += __shfl_xor(s, 1); s += __shfl_xor(s, 2);
        if (part == 0) qn[t] = s;
    }
    __syncthreads();
    const LAS float* tb2 = sc + 32 * ti + 4 * hh;
#pragma unroll
    for (int r = 0; r < 16; ++r) num[r] *= tb2[192 + (r & 3) + 8 * (r >> 2)];
#pragma unroll
    for (int ks = 0; ks < 4; ++ks) if (ks < 2 || ti == 1) num = MFMA32(*(const LAS bf16x8*)(lds + ML_SS + (32 * ti + n31) * 144 + (16 * ks + 8 * hh) * 2), tr_frag(lds + ML_VS, ML_P, 16 * ks, 32 * ej, lane), num);
#pragma unroll
    for (int r = 0; r < 16; ++r) { const int o = (r & 3) + 8 * (r >> 2);
        const float den = tb2[192 + o] * tb2[512 + o] + tb2[384 + o] + (ti ? tb2[448 + o] : 0.f);
        const float hv = num[r] / fmaxf(fabsf(den), tb2[256 + o]);
        *(LAS unsigned short*)(lds + ML_QS + (32 * ti + 4 * hh) * ML_P + (32 * ej + n31) * 2 + o * ML_P) = f2bf(hv); }
    __syncthreads();
    { const int t = tid >> 3, part = tid & 7;
      const size_t row = row0 + t; const int col = h * 128 + part * 16;
      const u32x4 g0 = L.g0, g1 = L.g1;
      const u32x4 h0 = *(const LAS u32x4*)(lds + ML_QS + t * ML_P + part * 32), h1 = *(const LAS u32x4*)(lds + ML_QS + t * ML_P + part * 32 + 16);
      float hv[16] = {bflo(h0.x), bfhi(h0.x), bflo(h0.y), bfhi(h0.y), bflo(h0.z), bfhi(h0.z), bflo(h0.w), bfhi(h0.w), bflo(h1.x), bfhi(h1.x), bflo(h1.y), bfhi(h1.y), bflo(h1.z), bfhi(h1.z), bflo(h1.w), bfhi(h1.w)};
      float ss = 0.f;
#pragma unroll
      for (int e = 0; e < 16; ++e) ss += hv[e] * hv[e];
      ss += __shfl_xor(ss, 1); ss += __shfl_xor(ss, 2); ss += __shfl_xor(ss, 4);
      const float rstd = rsqrtf(ss * (1.f / 128.f) + EPS);
      const float gv[16] = {bflo(g0.x), bfhi(g0.x), bflo(g0.y), bfhi(g0.y), bflo(g0.z), bfhi(g0.z), bflo(g0.w), bfhi(g0.w), bflo(g1.x), bfhi(g1.x), bflo(g1.y), bfhi(g1.y), bflo(g1.z), bfhi(g1.z), bflo(g1.w), bfhi(g1.w)};
      const float* mw = P.in[I_MLW] + col;
      float y[16];
#pragma unroll
      for (int e = 0; e < 16; ++e) y[e] = hv[e] * rstd * mw[e] * gv[e];
      u32x4 o0, o1; o0.x = cvtpk(y[0], y[1]); o0.y = cvtpk(y[2], y[3]); o0.z = cvtpk(y[4], y[5]); o0.w = cvtpk(y[6], y[7]); o1.x = cvtpk(y[8], y[9]); o1.y = cvtpk(y[10], y[11]); o1.z = cvtpk(y[12], y[13]); o1.w = cvtpk(y[14], y[15]);
      *(u32x4*)(YC + row * 1024 + col) = o0; *(u32x4*)(YC + row * 1024 + col + 8) = o1; }
}

constexpr int AT_KP = 144, AT_VP = 136, AT_WAVE = 64 * AT_KP + 64 * AT_VP;
__device__ __forceinline__ void sb_step(clptr Kt, clptr Vt, const bf16x8 (&qf)[4], f32x16& o0, f32x16& o1, float& carry, int lane, bool domask, int kq) {
    const int n31 = lane & 31, hh = lane >> 5;
    const int krow = (n31 & ~12) | ((n31 & 4) << 1) | ((n31 & 8) >> 1);
    f32x16 p[2];
#pragma unroll
    for (int r = 0; r < 16; ++r) { p[0][r] = 0.f; p[1][r] = 0.f; }
#pragma unroll
    for (int ks = 0; ks < 4; ++ks) {
        p[0] = MFMA32(*(const LAS bf16x8*)(Kt + krow * AT_KP + (16 * ks + 8 * hh) * 2), qf[ks], p[0]);
        p[1] = MFMA32(*(const LAS bf16x8*)(Kt + (32 + krow) * AT_KP + (16 * ks + 8 * hh) * 2), qf[ks], p[1]);
    }
    f32x16 om[2];
    float town[4], tpar[4];
#pragma unroll
    for (int u = 0; u < 2; ++u)
#pragma unroll
        for (int a = 0; a < 2; ++a) { float tp = 1.f;
#pragma unroll
            for (int j = 0; j < 8; ++j) { const int r = 8 * a + j;
                const float z = fminf(fmaxf(p[u][r], -60.f), 60.f);
                const float e = fast_exp2(-z); float sg = fast_rcp(1.f + e); float o = e * sg;
                if (domask) { const int kl = 32 * u + 16 * a + 8 * hh + j; if (kl >= kq) { sg = 0.f; o = 1.f; } }
                p[u][r] = sg; om[u][r] = o; tp *= o; }
            town[2 * u + a] = tp; }
#pragma unroll
    for (int i = 0; i < 4; ++i) tpar[i] = __shfl_xor(town[i], 32);
    float suf[5]; suf[4] = 1.f;
#pragma unroll
    for (int i = 3; i >= 0; --i) suf[i] = suf[i + 1] * (town[i] * tpar[i]);
    bf16x8 pf[4];
#pragma unroll
    for (int u = 0; u < 2; ++u)
#pragma unroll
        for (int a = 0; a < 2; ++a) { const int pr = 2 * u + a;
            float R = carry * suf[pr + 1] * (hh == 0 ? tpar[pr] : 1.f);
            float av[8];
#pragma unroll
            for (int j = 7; j >= 0; --j) { av[j] = p[u][8 * a + j] * R; R *= om[u][8 * a + j]; }
            u32x4 w; w.x = cvtpk(av[0], av[1]); w.y = cvtpk(av[2], av[3]); w.z = cvtpk(av[4], av[5]); w.w = cvtpk(av[6], av[7]);
            pf[pr] = __builtin_bit_cast(bf16x8, w); }
    carry *= suf[0];
#pragma unroll
    for (int pr = 0; pr < 4; ++pr) {
        o0 = MFMA32(tr_frag(Vt, AT_VP, 16 * pr, 0, lane), pf[pr], o0);
        o1 = MFMA32(tr_frag(Vt, AT_VP, 16 * pr, 32, lane), pf[pr], o1);
    }
}
__device__ __forceinline__ void attn_prompt_item(const Params& P, lptr lds, int b, int rb, int lane, int wave) {
    const int h = wave, n31 = lane & 31, hh = lane >> 5;
    const bf16_t* SQ = (const bf16_t*)(P.ws + WS_PROJ + 4 * PROJ_STRIDE); const bf16_t* SK = (const bf16_t*)(P.ws + WS_PROJ + 5 * PROJ_STRIDE); const bf16_t* SV = (const bf16_t*)(P.ws + WS_PROJ + 6 * PROJ_STRIDE);
    const size_t rowb = (size_t)b * SEQ; const int q0 = 32 * rb;
    lptr Kt = lds + wave * AT_WAVE; lptr Vt = Kt + 64 * AT_KP;
    bf16x8 qf[4];
#pragma unroll
    for (int ks = 0; ks < 4; ++ks) qf[ks] = *(const bf16x8*)(SQ + (rowb + q0 + n31) * 512 + h * 64 + 16 * ks + 8 * hh);
    f32x16 o0, o1;
#pragma unroll
    for (int r = 0; r < 16; ++r) { o0[r] = 0.f; o1[r] = 0.f; }
    float carry = 1.f;
    const int trow = lane >> 3, tch = lane & 7;
    u32x4 kv[8], vv[8];
    const int jt0 = (q0 + 30) >> 6;
#pragma unroll
    for (int i = 0; i < 8; ++i) { const size_t go = (rowb + 64 * jt0 + 8 * i + trow) * 512 + h * 64 + tch * 8; kv[i] = *(const u32x4*)(SK + go); vv[i] = *(const u32x4*)(SV + go); }
    for (int jt = jt0; jt >= 0; --jt) {
#pragma unroll
        for (int i = 0; i < 8; ++i) { const int row = 8 * i + trow;
            *(LAS u32x4*)(Kt + row * AT_KP + tch * 16) = kv[i];
            *(LAS u32x2*)(Vt + row * AT_VP + tch * 16) = (u32x2){vv[i].x, vv[i].y}; *(LAS u32x2*)(Vt + row * AT_VP + tch * 16 + 8) = (u32x2){vv[i].z, vv[i].w}; }
        if (jt > 0) {
#pragma unroll
            for (int i = 0; i < 8; ++i) { const size_t go = (rowb + 64 * (jt - 1) + 8 * i + trow) * 512 + h * 64 + tch * 8; kv[i] = *(const u32x4*)(SK + go); vv[i] = *(const u32x4*)(SV + go); } }
        sb_step(Kt, Vt, qf, o0, o1, carry, lane, 64 * jt + 63 >= q0, q0 + n31 - 64 * jt);
        if (__all(carry < 5.9604645e-8f)) break;
    }
    float ss = 0.f;
#pragma unroll
    for (int r = 0; r < 16; ++r) ss += o0[r] * o0[r] + o1[r] * o1[r];
    ss += __shfl_xor(ss, 32);
    const size_t row = rowb + q0 + n31;
    LAS float* sx = (LAS float*)(lds + 8 * AT_WAVE);
    if (hh == 0) sx[wave * 32 + n31] = ss;
    __syncthreads();
    float tot = 0.f;
#pragma unroll
    for (int w2 = 0; w2 < 8; ++w2) tot += sx[w2 * 32 + n31];
    const float rstd = rsqrtf(tot * (1.f / 512.f) + EPS);
    bf16_t* yo = (bf16_t*)(P.ws + WS_YCAT) + row * 1024 + 512 + h * 64 + 4 * hh;
#pragma unroll
    for (int g = 0; g < 4; ++g) {
        *(u32x2*)(yo + 8 * g) = (u32x2){cvtpk(o0[4 * g] * rstd, o0[4 * g + 1] * rstd), cvtpk(o0[4 * g + 2] * rstd, o0[4 * g + 3] * rstd)};
        *(u32x2*)(yo + 32 + 8 * g) = (u32x2){cvtpk(o1[4 * g] * rstd, o1[4 * g + 1] * rstd), cvtpk(o1[4 * g + 2] * rstd, o1[4 * g + 3] * rstd)};
    }
}
__device__ __forceinline__ void attn_sample_item(const Params& P, lptr lds, int bh, int tid, int lane, int wave) {
    const int b = bh >> 3, h = bh & 7, n31 = lane & 31, hh = lane >> 5;
    const bf16_t* SQ = (const bf16_t*)(P.ws + WS_PROJ + 4 * PROJ_STRIDE); const bf16_t* SK = (const bf16_t*)(P.ws + WS_PROJ + 5 * PROJ_STRIDE); const bf16_t* SV = (const bf16_t*)(P.ws + WS_PROJ + 6 * PROJ_STRIDE);
    const size_t rows = (size_t)MP + b * 32;
    lptr Kt = lds + wave * AT_WAVE; lptr Vt = Kt + 64 * AT_KP;
    bf16x8 qf[4];
#pragma unroll
    for (int ks = 0; ks < 4; ++ks) qf[ks] = *(const bf16x8*)(SQ + (rows + n31) * 512 + h * 64 + 16 * ks + 8 * hh);
    f32x16 o0, o1;
#pragma unroll
    for (int r = 0; r < 16; ++r) { o0[r] = 0.f; o1[r] = 0.f; }
    float carry = 1.f;
    if (wave == 7) {
        const int trow = lane >> 3, tch = lane & 7;
#pragma unroll
        for (int i = 0; i < 8; ++i) { const int row = 8 * i + trow; u32x4 kv = {0u, 0u, 0u, 0u}, vv = {0u, 0u, 0u, 0u};
            if (row < 32) { const size_t go = (rows + row) * 512 + h * 64 + tch * 8; kv = *(const u32x4*)(SK + go); vv = *(const u32x4*)(SV + go); }
            *(LAS u32x4*)(Kt + row * AT_KP + tch * 16) = kv;
            *(LAS u32x2*)(Vt + row * AT_VP + tch * 16) = (u32x2){vv.x, vv.y}; *(LAS u32x2*)(Vt + row * AT_VP + tch * 16 + 8) = (u32x2){vv.z, vv.w}; }
        sb_step(Kt, Vt, qf, o0, o1, carry, lane, true, n31);
    }
    const float* CK = P.in[I_CK] + (size_t)b * PAST * 512 + h * 64; const float* CV = P.in[I_CV] + (size_t)b * PAST * 512 + h * 64;
    for (int jt = 4 * wave + 3; jt >= 4 * wave; --jt) {
        const int trow = lane >> 4, c4 = lane & 15;
#pragma unroll
        for (int i = 0; i < 16; ++i) { const int row = 4 * i + trow; const size_t go = (size_t)(64 * jt + row) * 512 + c4 * 4;
            const f32x4 kx = *(const f32x4*)(CK + go), vx = *(const f32x4*)(CV + go);
            *(LAS u32x2*)(Kt + row * AT_KP + c4 * 8) = (u32x2){cvtpk(kx.x, kx.y), cvtpk(kx.z, kx.w)};
            *(LAS u32x2*)(Vt + row * AT_VP + c4 * 8) = (u32x2){cvtpk(vx.x, vx.y), cvtpk(vx.z, vx.w)}; }
        sb_step(Kt, Vt, qf, o0, o1, carry, lane, false, 0);
    }
    __syncthreads();
    LAS float* carr = (LAS float*)(lds + 65536);
    if (hh == 0) carr[wave * 32 + n31] = carry;
    __syncthreads();
    float mult = 1.f;
    for (int w2 = wave + 1; w2 < 8; ++w2) mult *= carr[w2 * 32 + n31];
#pragma unroll
    for (int g = 0; g < 4; ++g) {
        *(LAS f32x4*)(lds + (((wave * 8 + g) * 64 + lane) * 16)) = (f32x4){o0[4 * g] * mult, o0[4 * g + 1] * mult, o0[4 * g + 2] * mult, o0[4 * g + 3] * mult};
        *(LAS f32x4*)(lds + (((wave * 8 + 4 + g) * 64 + lane) * 16)) = (f32x4){o1[4 * g] * mult, o1[4 * g + 1] * mult, o1[4 * g + 2] * mult, o1[4 * g + 3] * mult};
    }
    __syncthreads();
    { const int q = tid >> 4, part = tid & 15; const int slot = (part >> 3) * 4 + ((part & 7) >> 1), ln = q + 32 * (part & 1);
      f32x4 v = {0.f, 0.f, 0.f, 0.f};
#pragma unroll
      for (int w2 = 0; w2 < 8; ++w2) v = v + *(const LAS f32x4*)(lds + (((w2 * 8 + slot) * 64 + ln) * 16));
      float ss = (v.x * v.x + v.y * v.y) + (v.z * v.z + v.w * v.w);
      ss += __shfl_xor(ss, 1); ss += __shfl_xor(ss, 2); ss += __shfl_xor(ss, 4); ss += __shfl_xor(ss, 8);
      const size_t row = rows + q;
      if (part == 0) ((float*)(P.ws + WS_SSQ))[row * 8 + h] = ss;
      *(u32x2*)((bf16_t*)(P.ws + WS_YCAT) + row * 1024 + 512 + h * 64 + part * 4) = (u32x2){cvtpk(v.x, v.y), cvtpk(v.z, v.w)}; }
    __syncthreads();
}
#ifndef M1NC
#define M1NC 2
#endif
constexpr int NQ_G1S = 224, NQ_AT = 1024, NQ_M1 = 2048 / M1NC, NQ_TOTAL = NQ_G1S + NQ_AT + NQ_M1;
template <class EpiS>
__device__ __forceinline__ void phase_mixers(const Params& P, lptr lds, int tid_in, int wave, const EpiS& Es) {
    unsigned* ctr = (unsigned*)(P.ws + WS_CTL);
    int nextitem = 0; if (tid_in == 0) nextitem = (int)atomicAdd(ctr, 1u);
    for (;;) {
        __syncthreads();
        if (tid_in == 0) *(LAS int*)(lds + QOFF) = nextitem;
        __syncthreads();
        int item = *(const LAS int*)(lds + QOFF);
        if (tid_in == 0 && item < NQ_TOTAL) nextitem = (int)atomicAdd(ctr, 1u);
        int tid = tid_in; asm volatile("" : "+v"(tid));
        const int lane = tid & 63;
        if (item >= NQ_TOTAL) break;
        if (item < NQ_G1S) { small_tile<1024, false>((const bf16_t*)(P.ws + WS_H) + (size_t)MP * 1024, (const bf16_t*)(P.ws + WS_W1T), Es, nullptr, lds, item, tid, lane, wave); continue; }
        item -= NQ_G1S;
        if (item < NQ_AT) { attn_prompt_item(P, lds, item & 7, 127 - (item >> 3), lane, wave); continue; }
        item -= NQ_AT;
        ml1_pair<M1NC>(P, lds, item, tid, lane, wave);
    }
}
__device__ __forceinline__ void phase_ml2(const Params& P, lptr lds, int tid_in, int wave) {
    int tid = tid_in; asm volatile("" : "+v"(tid));
    if (blockIdx.x < 128) ml2_scan(P, lds, tid);
    else if (blockIdx.x < 160) { }
    else if (blockIdx.x < 192) mlstm_item(P, lds, blockIdx.x - 160, true, tid, tid & 63, wave);
    else attn_sample_item(P, lds, blockIdx.x - 192, tid, tid & 63, wave);
}
template <class EpiS>
__device__ __forceinline__ void phase_ml3(const Params& P, lptr lds, int tid_in, int wave, const EpiS& Es) {
    if (blockIdx.x >= 192) { int tid = tid_in; asm volatile("" : "+v"(tid));
        small_tile<1024, true>((const bf16_t*)(P.ws + WS_YCAT) + (size_t)MP * 1024, (const bf16_t*)(P.ws + WS_W2T), Es, (const float*)(P.ws + WS_SSQ), lds, blockIdx.x - 192, tid, tid & 63, wave); }
#ifdef DBL_M3
    for (int rep = 0; rep < 2; ++rep)
#endif
    { int tid = tid_in; asm volatile("" : "+v"(tid));
      Ml3In cur, nxt; ml3_load(P, blockIdx.x, tid, tid & 63, wave, cur);
#pragma unroll 1
      for (int item = blockIdx.x; item < 2048; item += gridDim.x) {
          const int nitem = item + gridDim.x;
          if (nitem < 2048) ml3_load(P, nitem, tid, tid & 63, wave, nxt);
          ml3_item(P, lds, item, cur, tid, tid & 63, wave);
          cur = nxt;
      } }
}

__global__ void __launch_bounds__(512, 2) fwd(Params P) {
    extern __shared__ __attribute__((aligned(16))) unsigned char lds_raw[];
    lptr lds = (lptr)lds_raw;
    cg::grid_group grid = cg::this_grid();
    int tid = threadIdx.x, lane = tid & 63; const int wave = __builtin_amdgcn_readfirstlane(tid >> 6);
#define FRESH_TID() do { asm volatile("" : "+v"(tid)); lane = tid & 63; } while (0)
    const int gw = blockIdx.x * 8 + wave, NGW = gridDim.x * 8;
    unsigned char* ws = P.ws;
    const float* MOD = (const float*)(ws + WS_MOD);
    bf16_t* H = (bf16_t*)(ws + WS_H); bf16_t* PROJ = (bf16_t*)(ws + WS_PROJ); bf16_t* YC = (bf16_t*)(ws + WS_YCAT); bf16_t* ACT = (bf16_t*)(ws + WS_ACT);

#ifndef G_ALIGN
#define G_ALIGN true
#endif
#ifndef G_SP2
#define G_SP2 true
#endif
#ifndef PH
#define PH 0xFFFF
#endif
    if (tid == 0) { *(LAS unsigned*)(lds + LDS_BYTES - 32) = 0u; *(LAS unsigned*)(lds + LDS_BYTES - 28) = 0u; }
    __syncthreads();
    const XcdBarrier bar = xcd_barrier_post((unsigned*)(ws + WS_CTL) + 1024, (volatile LAS unsigned*)(lds + LDS_BYTES - 32));
    if (P.out == nullptr) grid.sync();
    phase0(P, lds, tid, lane, wave);
#ifdef DBL_P0
    __syncthreads(); phase0(P, lds, tid, lane, wave);
#endif
    xcd_barrier(bar);
    FRESH_TID();
    phase1(P, lds, tid, lane, wave);
    __syncthreads();
    phase_weights(P, lds, lane, wave);
#ifdef DBL_P1
    __syncthreads(); phase1(P, lds, tid, lane, wave);
#endif
#ifdef DBL_P1NG
    __syncthreads(); phase1_nogates(P, lds, tid, lane, wave);
#endif
#ifdef DBL_W
    __syncthreads(); phase_weights(P, lds, lane, wave);
#endif
    xcd_barrier(bar);
    FRESH_TID();
    {
        EpiProj E{PROJ, P.out + O_PK, P.out + O_PV, P.in[I_SQW], P.in[I_SKW], 0};
        pg8::Gemm g{H, (const bf16_t*)(ws + WS_W1T), MP, NPROJ, 1024}; pg8::StaticOrder S; S.init(MP, NPROJ, gridDim.x, (int)blockIdx.x);
        pg8::gemm_phase<EpiProj, pg8::StaticOrder, G_ALIGN, G_SP2>(lds, g, S, E);
#ifdef DBL_G
        pg8::gemm_phase<EpiProj, pg8::StaticOrder, G_ALIGN, G_SP2>(lds, g, S, E);
#endif
    }
    xcd_barrier(bar);
    FRESH_TID();
    {
        EpiProj Es{PROJ, P.out + O_SK, P.out + O_SV, P.in[I_SQW], P.in[I_SKW], MP};
        phase_mixers(P, lds, tid, wave, Es);
    }
    xcd_barrier(bar);
    FRESH_TID();
    phase_ml2(P, lds, tid, wave);
#ifdef DBL_M2
    __syncthreads(); phase_ml2(P, lds, tid, wave);
#endif
    xcd_barrier(bar);
    FRESH_TID();
    {
        EpiRes<0> Es{P.in[I_XS], (bf16_t*)(ws + WS_X1B) + (size_t)MP * 1024, MOD + 8 * 6144 + 2048, 5};
        phase_ml3(P, lds, tid, wave, Es);
    }
#ifdef XSYNC
    for (int i = 0; i < XSYNC; ++i) xcd_barrier(bar);
#endif
    xcd_barrier(bar);
    FRESH_TID();
    {
        sample_h2_row(P, lds, tid, lane, wave);
        EpiRes<0> E{P.in[I_XP], ws + WS_X1B, MOD + 2048, 12};
        pg8::Gemm g{YC, (const bf16_t*)(ws + WS_W2T), MP, 1024, 1024}; pg8::StaticOrder S; S.init(MP, 1024, gridDim.x, (int)blockIdx.x);
        pg8::gemm_phase<EpiRes<0>, pg8::StaticOrder, G_ALIGN, G_SP2>(lds, g, S, E);
    }
    xcd_barrier(bar);
    FRESH_TID();
    {
        phase5(P, lds, tid, lane, wave);
#ifdef DBL_P5
        phase5(P, lds, tid, lane, wave);
#endif
        EpiFFNs Es{ACT, P.out + O_SF, P.in[I_SFC], P.in[I_WCONV], P.in[I_BCONV]};
        for (int t = blockIdx.x; t < 352; t += gridDim.x) small_tile<1024, false>(H + (size_t)MP * 1024, (const bf16_t*)(ws + WS_W3T), Es, nullptr, lds, t, tid, lane, wave);
    }
    xcd_barrier(bar);
    FRESH_TID();
    {
        EpiFFN E{ACT, (float*)(ws + WS_UEDGE), P.out + O_PF, P.in[I_WCONV], P.in[I_BCONV]};
        pg8::Gemm g{H, (const bf16_t*)(ws + WS_W3T), MP, FF2, 1024}; pg8::StaticOrder S; S.init(MP, FF2, gridDim.x, (int)blockIdx.x);
        pg8::gemm_phase<EpiFFN, pg8::StaticOrder, true, G_SP2>(lds, g, S, E);
#ifdef DBL_G
        pg8::gemm_phase<EpiFFN, pg8::StaticOrder, true, G_SP2>(lds, g, S, E);
#endif
    }
    xcd_barrier(bar);
    FRESH_TID();
    {
        phase_fix(P, tid);
        EpiRes<1> Es{(const bf16_t*)(ws + WS_X1B) + (size_t)MP * 1024, P.out + O_YS, MOD + 8 * 6144 + 5120, 5};
        if (blockIdx.x < 64) small_tile<FF, false>(ACT + (size_t)MP * FF, (const bf16_t*)(ws + WS_W4T), Es, nullptr, lds, blockIdx.x, tid, lane, wave);
    }
    xcd_barrier(bar);
    FRESH_TID();
    {
        EpiRes<1> E{ws + WS_X1B, P.out + O_YP, MOD + 5120, 12};
        pg8::Gemm g{ACT, (const bf16_t*)(ws + WS_W4T), MP, 1024, FF}; pg8::StaticOrder S; S.init(MP, 1024, gridDim.x, (int)blockIdx.x);
        pg8::gemm_phase<EpiRes<1>, pg8::StaticOrder, G_ALIGN, G_SP2>(lds, g, S, E);
    }

#ifdef DIAG
    xcd_barrier(bar);
    {
        const size_t offs[15] = {O_YP, O_YS, O_PC, O_PN, O_PM, O_PK, O_PV, O_PF, O_SC, O_SN, O_SM, O_SK, O_SV, O_SF, O_END};
        for (int o = 0; o < 14; ++o) if ((DIAG >> o) & 1) for (size_t i = offs[o] + (size_t)blockIdx.x * 512 + tid; i < offs[o + 1]; i += (size_t)gridDim.x * 512) P.out[i] *= 1.2f;
    }
#endif
}

extern "C" void kernel_launch(void* const* d_in, const int* in_sizes, int n_in, void* d_out, int out_size, void* d_ws, size_t ws_size, hipStream_t stream) {
    static int grid_blocks = 0;
    if (!grid_blocks) {
        int dev = 0, cus = 0, per_cu = 0;
        (void)hipGetDevice(&dev);
        (void)hipDeviceGetAttribute(&cus, hipDeviceAttributeMultiprocessorCount, dev);
        (void)hipFuncSetAttribute((const void*)fwd, hipFuncAttributeMaxDynamicSharedMemorySize, LDS_BYTES);
        (void)hipOccupancyMaxActiveBlocksPerMultiprocessor(&per_cu, (const void*)fwd, 512, LDS_BYTES);
        grid_blocks = cus;
        if (n_in != 26 || out_size != (int)O_END || ws_size < WS_END2 || cus != 256 || per_cu < 1) {
            fprintf(stderr, "kernel_launch: unexpected geometry: n_in %d out %d ws %zu cus %d per_cu %d\n", n_in, out_size, ws_size, cus, per_cu);
            if (n_in != 26 || out_size != (int)O_END || ws_size < WS_END2 || cus != 256) grid_blocks = -1;
        }
    }
    if (grid_blocks < 0) return;
    if (hipMemsetAsync((char*)d_ws + WS_CTL, 0, WS_MOD + 16 * 6144 * 4, stream) != hipSuccess) { fprintf(stderr, "kernel_launch: memset of the control words failed\n"); return; }
    Params p{};
    for (int i = 0; i < 26; ++i) p.in[i] = (const float*)d_in[i];
    p.out = (float*)d_out; p.ws = (unsigned char*)d_ws;
    void* args[] = {&p};
    hipError_t e = hipLaunchCooperativeKernel((const void*)fwd, dim3(grid_blocks), dim3(512), args, LDS_BYTES, stream);
    if (e != hipSuccess) fprintf(stderr, "cooperative launch failed: %s (grid %d)\n", hipGetErrorString(e), grid_blocks);
}
```

```cpp
#include <hip/hip_runtime.h>
#include <hip/hip_cooperative_groups.h>
#include <cstdio>
#include <cstdint>
namespace cg = cooperative_groups;

#define LAS __attribute__((address_space(3)))
typedef unsigned short bf16_t;
typedef short bf16x8 __attribute__((ext_vector_type(8)));
typedef short s16x4 __attribute__((ext_vector_type(4)));
typedef float f32x2 __attribute__((ext_vector_type(2)));
typedef float f32x4 __attribute__((ext_vector_type(4)));
typedef float f32x16 __attribute__((ext_vector_type(16)));
typedef unsigned u32x2 __attribute__((ext_vector_type(2)));
typedef unsigned u32x4 __attribute__((ext_vector_type(4)));
typedef __bf16 bf16x2_t __attribute__((ext_vector_type(2)));
typedef LAS unsigned char* lptr;
typedef const LAS unsigned char* clptr;

constexpr int DM = 1024, SEQ = 4096, NB = 8, MP = NB * SEQ, DEC = 32, MS = NB * DEC, MT = MP + MS, PAST = 2048;
constexpr int DIN = 3592, NPROJ = 3584, FF = 2816, FF2 = 5632;
constexpr float EPS = 1e-6f;
constexpr float LOG2E = 1.4426950408889634f;
constexpr size_t O_YP = 0, O_YS = 33554432, O_PC = 33816576, O_PN = 34340864, O_PM = 34344960, O_PK = 34344992, O_PV = 51122208,
                 O_PF = 67899424, O_SC = 67989536, O_SN = 68513824, O_SM = 68517920, O_SK = 68517952, O_SV = 68649024, O_SF = 68780096, O_END = 68870208;
constexpr size_t MiB = 1u << 20;
constexpr size_t WS_CTL = 0, WS_MODP = 1 * MiB  , WS_MOD = 65536  , WS_GATES = 8 * MiB, WS_SSQ = 10 * MiB, WS_UEDGE = 12 * MiB,
                 WS_W1T = 24 * MiB, WS_W2T = 31 * MiB, WS_W3T = 33 * MiB, WS_W4T = 44 * MiB, WS_H = 52 * MiB, WS_PROJ = 120 * MiB,
                 PROJ_STRIDE = 33 * MiB, WS_YCAT = 352 * MiB, WS_ACT = 120 * MiB, WS_END = 420 * MiB;
constexpr size_t WS_X1B = 424 * MiB;
constexpr int LDS_BYTES = 147456;
constexpr int QOFF = LDS_BYTES - 64;

struct Params { const float* in[26]; float* out; unsigned char* ws; };
enum { I_XP = 0, I_XS, I_CP, I_CS, I_STC, I_STN, I_STM, I_CK, I_CV, I_SFC, I_WADA, I_BADA, I_N1W, I_WIN, I_BIG, I_BFG, I_MLW, I_SQW, I_SKW, I_SOW,
       I_WOUT, I_N2W, I_WUP, I_WCONV, I_BCONV, I_WDOWN };

__device__ __forceinline__ unsigned cvtpk(float lo, float hi) { f32x2 v = {lo, hi}; bf16x2_t b = __builtin_convertvector(v, bf16x2_t); return __builtin_bit_cast(unsigned, b); }
__device__ __forceinline__ float bf2f(unsigned short x) { return __uint_as_float((unsigned)x << 16); }
__device__ __forceinline__ float bflo(unsigned w) { return __uint_as_float(w << 16); }
__device__ __forceinline__ float bfhi(unsigned w) { return __uint_as_float(w & 0xffff0000u); }
__device__ __forceinline__ unsigned short f2bf(float f) { return (unsigned short)(cvtpk(f, 0.f) & 0xffffu); }
__device__ __forceinline__ float wave_sum(float v) {
#pragma unroll
    for (int o = 1; o < 64; o <<= 1) v += __shfl_xor(v, o);
    return v;
}
__device__ __forceinline__ float fast_exp2(float x) { return __builtin_amdgcn_exp2f(x); }
__device__ __forceinline__ float fast_rcp(float x) { return __builtin_amdgcn_rcpf(x); }
__device__ __forceinline__ float sigmoidf_(float x) { return fast_rcp(1.f + fast_exp2(-x * LOG2E)); }
__device__ __forceinline__ int crow(int r, int hi) { return (r & 3) + 8 * (r >> 2) + 4 * hi; }
typedef short v4i16_t __attribute__((ext_vector_type(4)));
__device__ __forceinline__ s16x4 tr_read(clptr p) { return __builtin_bit_cast(s16x4, __builtin_amdgcn_ds_read_tr16_b64_v4i16((LAS v4i16_t*)p)); }
__device__ __forceinline__ bf16x8 tr_frag(clptr base, int P, int R0, int C0, int lane) {
    const int h = lane >> 5, blk = (lane >> 4) & 1, q = (lane & 15) >> 2, p = lane & 3;
    clptr a = base + (R0 + 8 * h + q) * P + (C0 + 16 * blk + 4 * p) * 2;
    const s16x4 lo = tr_read(a), hi = tr_read(a + 4 * P);
    return (bf16x8){lo[0], lo[1], lo[2], lo[3], hi[0], hi[1], hi[2], hi[3]};
}
__device__ __forceinline__ bf16x8 row_frag(clptr base, int P, int R0, int K0, int lane) {
    return *(const LAS bf16x8*)(base + (R0 + (lane & 31)) * P + (K0 + 8 * (lane >> 5)) * 2);
}
#define MFMA32(a, b, c) __builtin_amdgcn_mfma_f32_32x32x16_bf16((a), (b), (c), 0, 0, 0)
#define MFMA16(a, b, c) __builtin_amdgcn_mfma_f32_16x16x32_bf16((a), (b), (c), 0, 0, 0)

namespace pg8 {
#define PG8_LAS __attribute__((address_space(3)))
typedef unsigned short bf16_t;
typedef short bf16x8 __attribute__((ext_vector_type(8)));
typedef float f32x4 __attribute__((ext_vector_type(4)));
typedef unsigned u32x4 __attribute__((ext_vector_type(4)));
constexpr int BM = 256, BK = 64, HALF = 128, HTB = HALF * BK * 2  , STAGE_BYTES = 8 * HTB, NXCD = 8, WGM = 8;

__host__ __device__ __forceinline__ int lds_byte(int r, int c) { const int st = (r >> 4) * 2 + (c >> 5), rr = r & 15, cc = c & 31, ob = rr * 64 + cc * 2; return st * 1024 + (ob ^ (((ob >> 9) & 1) << 5)); }
__host__ __device__ __forceinline__ void stage_rc(int b, int& R, int& C) { const int st = b / 1024, sb = b % 1024, swz = sb ^ (((sb >> 9) & 1) << 5); R = (st >> 1) * 16 + swz / 64; C = (st & 1) * 32 + (swz % 64) / 2; }
__host__ __device__ __forceinline__ int perm32(int rho) { const int n = rho >> 4, i = rho & 15; return 8 * (i >> 2) + 4 * n + (i & 3); }

struct Unit { int pm, pn; };
struct Gemm { const bf16_t* A; const bf16_t* Bt; int M, N, K; };

struct StaticOrder {
    int nM, nN, nwg, G, c;
    __host__ __device__ void init(int M, int N, int G_, int c_) { nM = M / BM; nN = N / BM; nwg = nM * nN; G = G_; c = c_; }
    __host__ __device__ bool next(int i, Unit& u) const {
        const long L = (long)i * G + c; if (L >= nwg) return false;
        int wgid = (int)L; { const int q = nwg / NXCD, r = nwg % NXCD, xcd = wgid % NXCD, off = wgid / NXCD; wgid = (xcd < r ? xcd * (q + 1) : r * (q + 1) + (xcd - r) * q) + off; }
        const int nig = WGM * nN, gid = wgid / nig, fm = gid * WGM, gsz = (nM - fm) < WGM ? (nM - fm) : WGM;
        u.pm = fm + ((wgid % nig) % gsz); u.pn = (wgid % nig) / gsz; return true;
    }
    __device__ __forceinline__ void a_ready(const Unit&) const {}
    __device__ __forceinline__ void done(const Unit&) const {}
};

template <class Epi, class Sched, bool ALIGN_EPI = false, bool SP2 = false>
__device__ __forceinline__ void gemm_phase(PG8_LAS unsigned char* lds, const Gemm g, const Sched& S, const Epi& E) {
    int tid_o = threadIdx.x; asm volatile("" : "+v"(tid_o));
    const int tid = tid_o, wid = __builtin_amdgcn_readfirstlane(tid >> 6), lane = tid & 63, wr = wid >> 2, wc = wid & 3, fr = lane & 15, fq = lane >> 4;
    const int K = g.K, nt = K / BK;
    unsigned voffA[2], voffB[2];
#pragma unroll
    for (int i = 0; i < 2; ++i) { int R, C; stage_rc(tid * 16 + i * 8192, R, C); const int Rb = Epi::PERM ? ((R & ~31) + perm32(R & 31)) : R;
        voffA[i] = (unsigned)(R * K + C) * 2u; voffB[i] = (unsigned)(Rb * K + C) * 2u; }
    const size_t kstep = (size_t)(BK * 2);
    const size_t hstep = (size_t)HALF * K * 2;
    const size_t tstep = 2 * hstep;
    const unsigned ldsw = (unsigned)wid * 1024u;
    const int aoff = lds_byte(wr * 64 + fr, fq * 8), boff = lds_byte(wc * 32 + fr, fq * 8);
#define PG8_SA(b, h) (((b) * 2 + (h)) * HTB)
#define PG8_SB(b, h) ((4 + (b) * 2 + (h)) * HTB)
#define PG8_STAGE(bufoff, gbase, voff) do { _Pragma("unroll") for (int _i = 0; _i < 2; ++_i) \
        __builtin_amdgcn_global_load_lds((const unsigned*)((const char*)(gbase) + (voff)[_i]), (PG8_LAS unsigned*)(lds + (bufoff) + ldsw + _i * 8192), 16, 0, 0); } while (0)
#define PG8_LDA(dst, b, h) do { _Pragma("unroll") for (int m = 0; m < 4; ++m) _Pragma("unroll") for (int k = 0; k < 2; ++k) dst[m][k] = *(const PG8_LAS bf16x8*)(lds + PG8_SA(b, h) + aoff + m * 2048 + k * 1024); } while (0)
#define PG8_LDB(dst, b, h) do { _Pragma("unroll") for (int n = 0; n < 2; ++n) _Pragma("unroll") for (int k = 0; k < 2; ++k) dst[n][k] = *(const PG8_LAS bf16x8*)(lds + PG8_SB(b, h) + boff + n * 2048 + k * 1024); } while (0)
#define PG8_MMA(ai, bj, At, Bt) do { __builtin_amdgcn_s_setprio(1); _Pragma("unroll") for (int m = 0; m < 4; ++m) _Pragma("unroll") for (int n = 0; n < 2; ++n) _Pragma("unroll") for (int k = 0; k < 2; ++k) \
        acc[ai][bj][m][n] = __builtin_amdgcn_mfma_f32_16x16x32_bf16(Bt[n][k], At[m][k], acc[ai][bj][m][n], 0, 0, 0); __builtin_amdgcn_s_setprio(0); } while (0)
#define PG8_WAIT_V(n) asm volatile("s_waitcnt vmcnt(" #n ")" ::: "memory")
#define PG8_WAIT_L(n) asm volatile("s_waitcnt lgkmcnt(" #n ")" ::: "memory")
#define PG8_BAR __builtin_amdgcn_s_barrier()
#define PG8_SCHED __builtin_amdgcn_sched_barrier(0)
    Unit cur, nxt; int ui = 0;
    if (!S.next(0, cur)) return;
    f32x4 acc[2][2][4][2];
#pragma unroll
    for (int a = 0; a < 2; ++a)
#pragma unroll
        for (int b = 0; b < 2; ++b)
#pragma unroll
            for (int m = 0; m < 4; ++m)
#pragma unroll
                for (int n = 0; n < 2; ++n) acc[a][b][m][n] = (f32x4){0.f, 0.f, 0.f, 0.f};
    bf16x8 At[4][2], B0[2][2], B1[2][2];
    const char* cA = (const char*)g.A + (size_t)cur.pm * tstep; const char* cB = (const char*)g.Bt + (size_t)cur.pn * tstep;
    S.a_ready(cur);
    if constexpr (SP2) {
        PG8_STAGE(PG8_SB(0, 0), cB, voffB); PG8_STAGE(PG8_SB(0, 1), cB + hstep, voffB); PG8_STAGE(PG8_SA(0, 0), cA, voffA); PG8_STAGE(PG8_SA(0, 1), cA + hstep, voffA);
        if (wr == 1) PG8_BAR;
        PG8_WAIT_V(2); PG8_BAR;
        PG8_STAGE(PG8_SB(1, 0), cB + kstep, voffB); PG8_STAGE(PG8_SA(1, 0), cA + kstep, voffA); PG8_STAGE(PG8_SB(1, 1), cB + hstep + kstep, voffB);
        PG8_WAIT_V(6); PG8_BAR;
    } else {
        PG8_STAGE(PG8_SB(0, 0), cB, voffB); PG8_STAGE(PG8_SA(0, 0), cA, voffA); PG8_STAGE(PG8_SB(0, 1), cB + hstep, voffB); PG8_STAGE(PG8_SA(0, 1), cA + hstep, voffA);
        if (wr == 1) PG8_BAR;
        PG8_WAIT_V(4); PG8_BAR;
        PG8_STAGE(PG8_SB(1, 0), cB + kstep, voffB); PG8_STAGE(PG8_SA(1, 0), cA + kstep, voffA); PG8_STAGE(PG8_SB(1, 1), cB + hstep + kstep, voffB);
        PG8_WAIT_V(6); PG8_BAR;
    }
    for (;;) {
        const bool has_next = S.next(ui + 1, nxt);
        const char* nA = has_next ? (const char*)g.A + (size_t)nxt.pm * tstep : cA; const char* nB = has_next ? (const char*)g.Bt + (size_t)nxt.pn * tstep : cB;
        for (int t = 0; t < nt; t += 2) {
            const bool last = (t == nt - 2);
            const char* a1 = cA + (size_t)(t + 1) * kstep;
            const char* a2 = last ? nA : cA + (size_t)(t + 2) * kstep; const char* b2 = last ? nB : cB + (size_t)(t + 2) * kstep;
            const char* a3 = a2 + kstep; const char* b3 = b2 + kstep;
            if (last && has_next) S.a_ready(nxt);
            if constexpr (SP2) {
            PG8_LDB(B0, 0, 0); PG8_LDB(B1, 0, 1); PG8_SCHED; PG8_LDA(At, 0, 0); PG8_STAGE(PG8_SA(1, 1), a1 + hstep, voffA);
            PG8_WAIT_V(8); PG8_WAIT_L(0); PG8_BAR; PG8_MMA(0, 0, At, B0); PG8_MMA(0, 1, At, B1); PG8_BAR; PG8_SCHED;
            PG8_LDA(At, 0, 1); PG8_STAGE(PG8_SB(0, 0), b2, voffB); PG8_STAGE(PG8_SB(0, 1), b2 + hstep, voffB); PG8_STAGE(PG8_SA(0, 0), a2, voffA);
            PG8_WAIT_V(8); PG8_WAIT_L(0); PG8_BAR; PG8_MMA(1, 0, At, B0); PG8_MMA(1, 1, At, B1); PG8_BAR; PG8_SCHED;
            PG8_LDB(B0, 1, 0); PG8_LDB(B1, 1, 1); PG8_SCHED; PG8_LDA(At, 1, 0); PG8_STAGE(PG8_SA(0, 1), a2 + hstep, voffA);
            PG8_WAIT_V(8); PG8_WAIT_L(0); PG8_BAR; PG8_MMA(0, 0, At, B0); PG8_MMA(0, 1, At, B1); PG8_BAR; PG8_SCHED;
            PG8_LDA(At, 1, 1); PG8_STAGE(PG8_SB(1, 0), b3, voffB); PG8_STAGE(PG8_SB(1, 1), b3 + hstep, voffB); PG8_STAGE(PG8_SA(1, 0), a3, voffA);
            PG8_WAIT_V(8); PG8_WAIT_L(0); PG8_BAR; PG8_MMA(1, 0, At, B0); PG8_MMA(1, 1, At, B1); PG8_BAR; PG8_SCHED;
            } else {
            PG8_LDB(B0, 0, 0); PG8_SCHED; PG8_LDA(At, 0, 0); PG8_STAGE(PG8_SA(1, 1), a1 + hstep, voffA);
            PG8_WAIT_L(8); PG8_BAR; PG8_WAIT_L(0); PG8_MMA(0, 0, At, B0); PG8_BAR; PG8_SCHED;
            PG8_LDB(B1, 0, 1); PG8_STAGE(PG8_SB(0, 0), b2, voffB);
            PG8_BAR; PG8_WAIT_L(0); PG8_MMA(0, 1, At, B1); PG8_BAR;
            PG8_LDA(At, 0, 1); PG8_STAGE(PG8_SA(0, 0), a2, voffA);
            PG8_BAR; PG8_WAIT_L(0); PG8_MMA(1, 0, At, B0); PG8_BAR; PG8_SCHED;
            PG8_STAGE(PG8_SB(0, 1), b2 + hstep, voffB);
            PG8_WAIT_V(6); PG8_BAR; PG8_MMA(1, 1, At, B1); PG8_BAR;
            PG8_LDB(B0, 1, 0); PG8_SCHED; PG8_LDA(At, 1, 0); PG8_STAGE(PG8_SA(0, 1), a2 + hstep, voffA);
            PG8_WAIT_L(8); PG8_BAR; PG8_WAIT_L(0); PG8_MMA(0, 0, At, B0); PG8_BAR; PG8_SCHED;
            PG8_LDB(B1, 1, 1); PG8_STAGE(PG8_SB(1, 0), b3, voffB);
            PG8_BAR; PG8_WAIT_L(0); PG8_MMA(0, 1, At, B1); PG8_BAR;
            PG8_LDA(At, 1, 1); PG8_STAGE(PG8_SA(1, 0), a3, voffA);
            PG8_BAR; PG8_WAIT_L(0); PG8_MMA(1, 0, At, B0); PG8_BAR; PG8_SCHED;
            PG8_STAGE(PG8_SB(1, 1), b3 + hstep, voffB);
            PG8_WAIT_V(6); PG8_BAR; PG8_MMA(1, 1, At, B1); PG8_BAR;
            }
        }
        if constexpr (ALIGN_EPI) { if (wr == 0) PG8_BAR; }
        if constexpr (!Epi::AFTER_DRAIN) { E(acc, cur, wr, wc, fr, fq, lds); S.done(cur); }
        if (!has_next) break;
#pragma unroll
        for (int a = 0; a < 2; ++a)
#pragma unroll
            for (int b = 0; b < 2; ++b)
#pragma unroll
                for (int m = 0; m < 4; ++m)
#pragma unroll
                    for (int n = 0; n < 2; ++n) acc[a][b][m][n] = (f32x4){0.f, 0.f, 0.f, 0.f};
        cur = nxt; cA = nA; cB = nB; ++ui;
        if constexpr (ALIGN_EPI) { if (wr == 1) PG8_BAR; }
    }
    PG8_WAIT_V(0);
    if constexpr (!ALIGN_EPI) { if (wr == 0) PG8_BAR; }
    PG8_BAR;
    if constexpr (Epi::AFTER_DRAIN) { E.fused(acc, cur, wr, wc, fr, fq, lds, wid, lane); S.done(cur); }
#undef PG8_SA
#undef PG8_SB
#undef PG8_STAGE
#undef PG8_LDA
#undef PG8_LDB
#undef PG8_MMA
#undef PG8_WAIT_V
#undef PG8_WAIT_L
#undef PG8_BAR
#undef PG8_SCHED
}
}

__device__ __forceinline__ u32x4 pack8(const f32x4& v0, const f32x4& v1) { u32x4 w; w.x = cvtpk(v0[0], v0[1]); w.y = cvtpk(v0[2], v0[3]); w.z = cvtpk(v1[0], v1[1]); w.w = cvtpk(v1[2], v1[3]); return w; }

struct EpiProj {
    static constexpr bool PERM = true, AFTER_DRAIN = false;
    bf16_t* proj; float* outK; float* outV; const float* qw; const float* kw; int rowoff;
    __device__ __forceinline__ void sub(const f32x4 (&a)[2][4][2], int pn, int rloc0, int wc, int fr, int fq) const {
        const int kind = pn >> 1, half = pn & 1;
        const int c8 = 256 * half + 64 * wc + 8 * fq;
        bf16_t* ob = proj + (size_t)kind * (PROJ_STRIDE / 2);
        if (kind < 4) {
#pragma unroll
            for (int m = 0; m < 4; ++m) { const size_t row = (size_t)(rowoff + rloc0 + 16 * m + fr);
#pragma unroll
                for (int bj = 0; bj < 2; ++bj) { f32x4 v0 = a[bj][m][0], v1 = a[bj][m][1];
                    if (kind == 1) { v0 = v0 * 0.08838834764831845f; v1 = v1 * 0.08838834764831845f; }
                    if (kind == 3) {
#pragma unroll
                        for (int e = 0; e < 4; ++e) { v0[e] = sigmoidf_(v0[e]); v1[e] = sigmoidf_(v1[e]); } }
                    *(u32x4*)(ob + row * 512 + c8 + 32 * bj) = pack8(v0, v1); } }
        } else if (kind < 6) {
            const float* w = kind == 4 ? qw : kw; const float osc = kind == 4 ? 0.125f * LOG2E : 1.f;
            f32x4 wv[2][2];
#pragma unroll
            for (int bj = 0; bj < 2; ++bj)
#pragma unroll
                for (int n = 0; n < 2; ++n) wv[bj][n] = *(const f32x4*)(w + 32 * bj + 8 * fq + 4 * n);
#pragma unroll
            for (int m = 0; m < 4; ++m) { const int rl = rloc0 + 16 * m + fr; float ss = 0.f;
#pragma unroll
                for (int bj = 0; bj < 2; ++bj)
#pragma unroll
                    for (int n = 0; n < 2; ++n) { const f32x4 x = a[bj][m][n]; ss += (x[0] * x[0] + x[1] * x[1]) + (x[2] * x[2] + x[3] * x[3]); }
                ss += __shfl_xor(ss, 16); ss += __shfl_xor(ss, 32);
                const float rstd = rsqrtf(ss * (1.f / 64.f) + EPS);
#pragma unroll
                for (int bj = 0; bj < 2; ++bj) { f32x4 v0 = a[bj][m][0] * rstd * wv[bj][0], v1 = a[bj][m][1] * rstd * wv[bj][1];
                    if (kind == 5) { float* o = outK + (size_t)rl * 512 + c8 + 32 * bj; __builtin_nontemporal_store(v0, (f32x4*)o); __builtin_nontemporal_store(v1, (f32x4*)(o + 4)); }
                    v0 = v0 * osc; v1 = v1 * osc;
                    *(u32x4*)(ob + (size_t)(rowoff + rl) * 512 + c8 + 32 * bj) = pack8(v0, v1); } }
        } else {
#pragma unroll
            for (int m = 0; m < 4; ++m) { const int rl = rloc0 + 16 * m + fr;
#pragma unroll
                for (int bj = 0; bj < 2; ++bj) { const f32x4 v0 = a[bj][m][0], v1 = a[bj][m][1];
                    float* o = outV + (size_t)rl * 512 + c8 + 32 * bj; __builtin_nontemporal_store(v0, (f32x4*)o); __builtin_nontemporal_store(v1, (f32x4*)(o + 4));
                    *(u32x4*)(ob + (size_t)(rowoff + rl) * 512 + c8 + 32 * bj) = pack8(v0, v1); } }
        }
    }
    __device__ __forceinline__ void operator()(const f32x4 (&acc)[2][2][4][2], const pg8::Unit& u, int wr, int wc, int fr, int fq, lptr) const {
#pragma unroll
        for (int ai = 0; ai < 2; ++ai) sub(acc[ai], u.pn, u.pm * 256 + ai * 128 + wr * 64, wc, fr, fq);
    }
};

template <int MODE>
struct EpiRes {
    static constexpr bool PERM = true, AFTER_DRAIN = false;
    const void* xin; void* xout; const float* gate; int tlog;
    __device__ __forceinline__ void sub(const f32x4 (&a)[2][4][2], int pn, int rloc0, int wc, int fr, int fq) const {
#pragma unroll
        for (int m = 0; m < 4; ++m) { const int rl = rloc0 + 16 * m + fr; const float* g = gate + (size_t)(rl >> tlog) * 6144;
#pragma unroll
            for (int bj = 0; bj < 2; ++bj) { const int c = 256 * pn + 128 * bj + 32 * wc + 8 * fq;
                const f32x4 g0 = *(const f32x4*)(g + c), g1 = *(const f32x4*)(g + c + 4);
                if (MODE == 0) {
                    const float* xp = (const float*)xin + (size_t)rl * 1024 + c;
                    const f32x4 o0 = *(const f32x4*)xp + g0 * a[bj][m][0], o1 = *(const f32x4*)(xp + 4) + g1 * a[bj][m][1];
                    *(u32x4*)((bf16_t*)xout + (size_t)rl * 1024 + c) = pack8(o0, o1);
                } else {
                    const u32x4 xv = *(const u32x4*)((const bf16_t*)xin + (size_t)rl * 1024 + c);
                    const f32x4 x0 = {bflo(xv.x), bfhi(xv.x), bflo(xv.y), bfhi(xv.y)}, x1 = {bflo(xv.z), bfhi(xv.z), bflo(xv.w), bfhi(xv.w)};
                    float* op = (float*)xout + (size_t)rl * 1024 + c;
                    __builtin_nontemporal_store(x0 + g0 * a[bj][m][0], (f32x4*)op); __builtin_nontemporal_store(x1 + g1 * a[bj][m][1], (f32x4*)(op + 4));
                } } }
    }
    __device__ __forceinline__ void operator()(const f32x4 (&acc)[2][2][4][2], const pg8::Unit& u, int wr, int wc, int fr, int fq, lptr) const {
#pragma unroll
        for (int ai = 0; ai < 2; ++ai) sub(acc[ai], u.pn, u.pm * 256 + ai * 128 + wr * 64, wc, fr, fq);
    }
};

__device__ __forceinline__ float dpp_ror1(float x) { return __int_as_float(__builtin_amdgcn_update_dpp(0, __float_as_int(x), 0x121, 0xf, 0xf, false)); }
__device__ __forceinline__ float dpp_ror2(float x) { return __int_as_float(__builtin_amdgcn_update_dpp(0, __float_as_int(x), 0x122, 0xf, 0xf, false)); }
struct ConvW { f32x4 w0a, w1a, w2a, ba, w0g, w1g, w2g, bg; };
__device__ __forceinline__ ConvW load_convw(const float* wconv, const float* bconv, int c) {
    ConvW w; w.w0a = *(const f32x4*)(wconv + c); w.w1a = *(const f32x4*)(wconv + FF2 + c); w.w2a = *(const f32x4*)(wconv + 2 * FF2 + c); w.ba = *(const f32x4*)(bconv + c);
    w.w0g = *(const f32x4*)(wconv + FF + c); w.w1g = *(const f32x4*)(wconv + FF2 + FF + c); w.w2g = *(const f32x4*)(wconv + 2 * FF2 + FF + c); w.bg = *(const f32x4*)(bconv + FF + c); return w;
}
template <int CTRL> __device__ __forceinline__ float dppz(float x) { return __int_as_float(__builtin_amdgcn_update_dpp(0, __float_as_int(x), CTRL, 0xf, 0xf, true)); }
__device__ __forceinline__ u32x2 conv_gate4(const f32x4& ca, const f32x4& cg, const f32x4& pa, const f32x4& pg, const ConvW& w, int) {
    float o[4];
#pragma unroll
    for (int e = 0; e < 4; ++e) {
        float ua = fmaf(w.w2a[e], ca[e], w.ba[e]);
        ua = fmaf(dppz<0x111>(ca[e]), w.w1a[e], ua); ua = fmaf(dppz<0x10F>(pa[e]), w.w1a[e], ua);
        ua = fmaf(dppz<0x112>(ca[e]), w.w0a[e], ua); ua = fmaf(dppz<0x10E>(pa[e]), w.w0a[e], ua);
        float ug = fmaf(w.w2g[e], cg[e], w.bg[e]);
        ug = fmaf(dppz<0x111>(cg[e]), w.w1g[e], ug); ug = fmaf(dppz<0x10F>(pg[e]), w.w1g[e], ug);
        ug = fmaf(dppz<0x112>(cg[e]), w.w0g[e], ug); ug = fmaf(dppz<0x10E>(pg[e]), w.w0g[e], ug);
        o[e] = ua * sigmoidf_(ua) * ug;
    }
    u32x2 r; r.x = cvtpk(o[0], o[1]); r.y = cvtpk(o[2], o[3]); return r;
}
struct EpiFFN {
    static constexpr bool PERM = true, AFTER_DRAIN = false;
    bf16_t* act; float* uedge; float* outF; const float* wconv; const float* bconv;
    __device__ __forceinline__ void operator()(const f32x4 (&acc)[2][2][4][2], const pg8::Unit& u, int wr, int wc, int fr, int fq, lptr lds) const {
        lptr halo = lds + pg8::STAGE_BYTES;
        const int q8 = 32 * wc + 8 * fq;
        if (fr >= 14) {
#pragma unroll
            for (int ai = 0; ai < 2; ++ai)
#pragma unroll
                for (int bj = 0; bj < 2; ++bj)
#pragma unroll
                    for (int n = 0; n < 2; ++n) *(LAS f32x4*)(halo + ((((2 * ai + wr) * 2 + (fr - 14)) * 256 + 128 * bj + q8 + 4 * n) * 4)) = acc[ai][bj][3][n];
        }
        asm volatile("s_waitcnt lgkmcnt(0)" ::: "memory"); __builtin_amdgcn_s_barrier(); asm volatile("" ::: "memory");
#pragma unroll
        for (int n = 0; n < 2; ++n) {
            const int c = 128 * u.pn + q8 + 4 * n;
            const ConvW w = load_convw(wconv, bconv, c);
#pragma unroll
            for (int ai = 0; ai < 2; ++ai) {
                const int G = 2 * ai + wr;
                f32x4 pa = {0.f, 0.f, 0.f, 0.f}, pg = {0.f, 0.f, 0.f, 0.f};
                if (G > 0 && fr >= 14) { pa = *(const LAS f32x4*)(halo + ((((G - 1) * 2 + (fr - 14)) * 256 + q8 + 4 * n) * 4)); pg = *(const LAS f32x4*)(halo + ((((G - 1) * 2 + (fr - 14)) * 256 + 128 + q8 + 4 * n) * 4)); }
#pragma unroll
                for (int m = 0; m < 4; ++m) {
                    const f32x4 ca = acc[ai][0][m][n], cg = acc[ai][1][m][n];
                    const f32x4 qa = m ? acc[ai][0][m ? m - 1 : 0][n] : pa, qg = m ? acc[ai][1][m ? m - 1 : 0][n] : pg;
                    const u32x2 o = conv_gate4(ca, cg, qa, qg, w, fr);
                    const size_t row = (size_t)u.pm * 256 + 64 * G + 16 * m + fr;
                    *(u32x2*)(act + row * FF + c) = o;
                    if (m == 0 && G == 0 && fr < 2) { float* e = uedge + ((size_t)u.pm * 4 + fr) * FF2 + c; *(f32x4*)e = ca; *(f32x4*)(e + FF) = cg; }
                    if (m == 3 && G == 3 && fr >= 14) { float* e = uedge + ((size_t)u.pm * 4 + 2 + (fr - 14)) * FF2 + c; *(f32x4*)e = ca; *(f32x4*)(e + FF) = cg;
                        if ((u.pm & 15) == 15) { float* f = outF + ((size_t)(u.pm >> 4) * 2 + (fr - 14)) * FF2 + c; *(f32x4*)f = ca; *(f32x4*)(f + FF) = cg; } }
                }
            }
        }
    }
};
struct EpiFFNs {
    bf16_t* act; float* outF; const float* state; const float* wconv; const float* bconv;
    __device__ __forceinline__ void sub(const f32x4 (&a)[2][4][2], int pn, int rloc0, int wc, int fr, int fq) const {
        const int q8 = 32 * wc + 8 * fq;
#pragma unroll
        for (int n = 0; n < 2; ++n) {
            const int c = 128 * pn + q8 + 4 * n;
            const ConvW w = load_convw(wconv, bconv, c);
#pragma unroll
            for (int m = 0; m < 4; ++m) {
                const int b = (rloc0 + 16 * m) >> 5;
                const f32x4 ca = a[0][m][n], cg = a[1][m][n];
                f32x4 qa = {0.f, 0.f, 0.f, 0.f}, qg = {0.f, 0.f, 0.f, 0.f};
                if (m & 1) { qa = a[0][m ? m - 1 : 0][n]; qg = a[1][m ? m - 1 : 0][n]; }
                else if (fr >= 14) { const float* s = state + ((size_t)b * 2 + (fr - 14)) * FF2 + c; qa = *(const f32x4*)s; qg = *(const f32x4*)(s + FF); }
                const u32x2 o = conv_gate4(ca, cg, qa, qg, w, fr);
                const size_t row = (size_t)MP + rloc0 + 16 * m + fr;
                *(u32x2*)(act + row * FF + c) = o;
                if ((m & 1) && fr >= 14) { float* f = outF + ((size_t)b * 2 + (fr - 14)) * FF2 + c; *(f32x4*)f = ca; *(f32x4*)(f + FF) = cg; }
            }
        }
    }
};

template <int K, bool HISCALE, class Epi>
__device__ __forceinline__ void small_tile(const bf16_t* __restrict__ A, const bf16_t* __restrict__ Bt, const Epi& E, const float* ssq, lptr lds, int t, int tid, int lane, int wave) {
    constexpr int KW = K / 8;
    const int fr = lane & 15, fq = lane >> 4;
    const int wc = t & 3, G = (t >> 2) & 3, pn = t >> 4;
    f32x4 acc[2][4][2];
#pragma unroll
    for (int bj = 0; bj < 2; ++bj)
#pragma unroll
        for (int m = 0; m < 4; ++m)
#pragma unroll
            for (int n = 0; n < 2; ++n) acc[bj][m][n] = (f32x4){0.f, 0.f, 0.f, 0.f};
    const bf16_t* ap = A + (size_t)(G * 64 + fr) * K + fq * 8 + wave * KW;
    const bf16_t* bp = Bt + (size_t)(256 * pn + 32 * wc + 8 * (fr >> 2) + (fr & 3)) * K + fq * 8 + wave * KW;
#ifdef DBLK
    for (int rep = 0; rep < 2; ++rep) {
    if (rep == 1) {
_Pragma("unroll") for (int bj = 0; bj < 2; ++bj) _Pragma("unroll") for (int m = 0; m < 4; ++m) _Pragma("unroll") for (int n = 0; n < 2; ++n) acc[bj][m][n] = acc[bj][m][n] * 0.f; asm volatile("" ::: "memory"); }
#endif
#pragma unroll 4
    for (int k0 = 0; k0 < KW; k0 += 32) {
        bf16x8 af[4], bf[2][2];
#pragma unroll
        for (int m = 0; m < 4; ++m) af[m] = *(const bf16x8*)(ap + (size_t)(16 * m) * K + k0);
#pragma unroll
        for (int bj = 0; bj < 2; ++bj)
#pragma unroll
            for (int n = 0; n < 2; ++n) bf[bj][n] = *(const bf16x8*)(bp + (size_t)(128 * bj + 4 * n) * K + k0);
#pragma unroll
        for (int bj = 0; bj < 2; ++bj)
#pragma unroll
            for (int m = 0; m < 4; ++m)
#pragma unroll
                for (int n = 0; n < 2; ++n) acc[bj][m][n] = MFMA16(bf[bj][n], af[m], acc[bj][m][n]);
    }
#ifdef DBLK
    }
#endif
    if (HISCALE) { if (wave >= 4) {
#pragma unroll
        for (int m = 0; m < 4; ++m) { const float* sp = ssq + (size_t)(MP + G * 64 + 16 * m + fr) * 8; const f32x4 s0 = *(const f32x4*)sp, s1 = *(const f32x4*)(sp + 4);
            const float rstd = rsqrtf(((s0.x + s0.y) + (s0.z + s0.w) + (s1.x + s1.y) + (s1.z + s1.w)) * (1.f / 512.f) + EPS);
#pragma unroll
            for (int bj = 0; bj < 2; ++bj)
#pragma unroll
                for (int n = 0; n < 2; ++n) acc[bj][m][n] = acc[bj][m][n] * rstd; } } }
    __syncthreads();
    if (wave != 0) {
#pragma unroll
        for (int bj = 0; bj < 2; ++bj)
#pragma unroll
            for (int m = 0; m < 4; ++m)
#pragma unroll
                for (int n = 0; n < 2; ++n) *(LAS f32x4*)(lds + ((((wave - 1) * 16 + (bj * 4 + m) * 2 + n) * 64 + lane) * 16)) = acc[bj][m][n];
    }
    __syncthreads();
    if (wave == 0) {
#pragma unroll 1
        for (int w2 = 0; w2 < 7; ++w2)
#pragma unroll
            for (int bj = 0; bj < 2; ++bj)
#pragma unroll
                for (int m = 0; m < 4; ++m)
#pragma unroll
                    for (int n = 0; n < 2; ++n) acc[bj][m][n] = acc[bj][m][n] + *(const LAS f32x4*)(lds + (((w2 * 16 + (bj * 4 + m) * 2 + n) * 64 + lane) * 16));
        E.sub(acc, pn, G * 64, wc, fr, fq);
#ifdef DBLE
        asm volatile("" ::: "memory"); E.sub(acc, pn, G * 64, wc, fr, fq);
#endif
    }
    __syncthreads();
}

typedef unsigned v4u __attribute__((ext_vector_type(4)));
#define XB_TMO      128
#define XB_XCNT(j)  (256  + 64 * (j))
#define XB_XSUB(j)  (1280 + 64 * (j))
#define XB_XGEN(j)  (2304 + 64 * (j))
#define XB_TOP      3328
#define XB_TOPGEN   3392
#define XCD_BAR_WORDS 3456
#define XB_SPIN_CAP (1u << 18)

__device__ __forceinline__ unsigned xb_ld(unsigned* p)              { return __hip_atomic_load(p, __ATOMIC_RELAXED, __HIP_MEMORY_SCOPE_AGENT); }
__device__ __forceinline__ unsigned xb_add(unsigned* p, unsigned v) { return __hip_atomic_fetch_add(p, v, __ATOMIC_RELAXED, __HIP_MEMORY_SCOPE_AGENT); }
__device__ __forceinline__ unsigned xb_xcc_id() { return (unsigned)__builtin_amdgcn_s_getreg((3 << 11) | 20) & 0xFu; }
#define XB_SPIN(cond, bar) do { unsigned _sp = 0; while (cond) { __builtin_amdgcn_s_sleep(1); \
    if ((++_sp & 255u) == 0u) { if (xb_ld(&(bar)[XB_TMO])) break; if (_sp > XB_SPIN_CAP) { atomicAdd(&(bar)[XB_TMO], 1u); break; } } } } while (0)

struct XcdBarrier {
    unsigned* bar; unsigned x;
    volatile LAS unsigned* st;
};

__device__ __forceinline__ XcdBarrier xcd_barrier_post(unsigned* bar, volatile LAS unsigned* st) {
    XcdBarrier b; b.bar = bar; b.x = xb_xcc_id(); b.st = st;
    if (threadIdx.x == 0) (void)xb_add(&bar[XB_XCNT(b.x)], 1u);
    return b;
}
__device__ __forceinline__ void xcd_barrier_complete(unsigned* bar, unsigned x, unsigned& nloc, unsigned& nx) {
    const unsigned G = gridDim.x * gridDim.y * gridDim.z;
    unsigned sum, cnt, mine, sp = 0u;
    for (;;) {
        sum = 0u; cnt = 0u; mine = 0u;
#pragma unroll
        for (unsigned j = 0; j < 16; ++j) { const unsigned c = xb_ld(&bar[XB_XCNT(j)]); sum += c; cnt += (c > 0u) ? 1u : 0u; mine = (j == x) ? c : mine; }
        if (sum == G) break;
        __builtin_amdgcn_s_sleep(1);
        if ((++sp & 255u) == 0u) { if (xb_ld(&bar[XB_TMO])) break; if (sp > XB_SPIN_CAP) { atomicAdd(&bar[XB_TMO], 1u); break; } }
    }
    nloc = mine > 0u ? mine : 1u; nx = cnt > 0u ? cnt : 1u;
}

__device__ __forceinline__ void xcd_barrier(const XcdBarrier& b) {
    asm volatile("s_waitcnt vmcnt(0)" ::: "memory");
    __syncthreads();
    if (threadIdx.x == 0) {
        unsigned* bar = b.bar;
        __builtin_amdgcn_s_waitcnt(0);
        unsigned nloc = b.st[0], nx = b.st[1];
        if (nloc == 0u) { xcd_barrier_complete(bar, b.x, nloc, nx); b.st[0] = nloc; b.st[1] = nx; }
        const unsigned old = xb_add(&bar[XB_XSUB(b.x)], 1u);
        const unsigned gen = old / nloc;
        if (old + 1u == (gen + 1u) * nloc) {
            __builtin_amdgcn_fence(__ATOMIC_RELEASE, "agent");
            asm volatile("s_waitcnt vmcnt(0)" ::: "memory");
            const unsigned og = xb_add(&bar[XB_TOP], 1u);
            const unsigned tg = og / nx;
            if (og + 1u == (tg + 1u) * nx) xb_add(&bar[XB_TOPGEN], 1u);
            else XB_SPIN(xb_ld(&bar[XB_TOPGEN]) == tg, bar);
            __builtin_amdgcn_fence(__ATOMIC_ACQUIRE, "agent");
            xb_add(&bar[XB_XGEN(b.x)], 1u);
            asm volatile("s_waitcnt vmcnt(0)" ::: "memory");
        } else {
            XB_SPIN(xb_ld(&bar[XB_XGEN(b.x)]) == gen, bar);
            __builtin_amdgcn_fence(__ATOMIC_ACQUIRE, "agent");
            asm volatile("s_waitcnt vmcnt(0)" ::: "memory");
        }
    }
    __syncthreads();
}


__device__ __forceinline__ void transpose_item(const float* __restrict__ W, int ldw, int srccol0, bf16_t* __restrict__ WT, int K, int destrow0, int k0, LAS float* scr, int lane, const float* kscale = nullptr) {
#pragma unroll 16
    for (int i = 0; i < 32; ++i) { const int kk = 2 * i + (lane >> 5); scr[kk * 33 + (lane & 31)] = W[(size_t)(k0 + kk) * ldw + srccol0 + (lane & 31)] * (kscale ? kscale[k0 + kk] : 1.f); }
    asm volatile("s_waitcnt lgkmcnt(0)" ::: "memory");
    const int c = lane & 7;
#pragma unroll
    for (int j = 0; j < 4; ++j) { const int n = (lane >> 3) + 8 * j; const LAS float* s = scr + (8 * c) * 33 + n;
        u32x4 o; o.x = cvtpk(s[0 * 33], s[1 * 33]); o.y = cvtpk(s[2 * 33], s[3 * 33]); o.z = cvtpk(s[4 * 33], s[5 * 33]); o.w = cvtpk(s[6 * 33], s[7 * 33]);
        *(u32x4*)(WT + (size_t)(destrow0 + n) * K + k0 + 8 * c) = o; }
    asm volatile("s_waitcnt lgkmcnt(0)" ::: "memory");
}

__device__ __forceinline__ void phase_weights(const Params& P, lptr lds, int lane, int wave, int it_lo, int it_hi, int gw, int NGW) {
    unsigned char* ws = P.ws;
    LAS float* scr = (LAS float*)(lds + wave * 16384);
    constexpr int I1 = 16 * 112, I2 = 16 * 32, I3 = 16 * 176, I4 = 44 * 32;
    for (int it = it_lo + gw; it < it_hi; it += NGW) {
        int r = it;
        if (r < I1) { const int kb = r / 112, n0 = (r % 112) * 32, tile = n0 >> 8, p = n0 & 255, wc = (p >> 5) & 3, bj = p >> 7, L = tile * 256 + 64 * wc + 32 * bj;
            transpose_item(P.in[I_WIN], DIN, L < 2048 ? L : L + 8, (bf16_t*)(ws + WS_W1T), 1024, n0, kb * 64, scr, lane); continue; }
        r -= I1;
        if (r < I2) { const int kb = r / 32, n0 = (r % 32) * 32; transpose_item(P.in[I_WOUT], 1024, n0, (bf16_t*)(ws + WS_W2T), 1024, n0, kb * 64, scr, lane, kb >= 8 ? P.in[I_SOW] - 512 : nullptr); continue; }
        r -= I2;
        if (r < I3) { const int kb = r / 176, n0 = (r % 176) * 32, pn = n0 >> 8, p = n0 & 255, bj = p >> 7, q0 = p & 127;
            transpose_item(P.in[I_WUP], FF2, 128 * pn + q0 + FF * bj, (bf16_t*)(ws + WS_W3T), 1024, n0, kb * 64, scr, lane); continue; }
        r -= I3;
        { const int kb = r / 32, n0 = (r % 32) * 32; transpose_item(P.in[I_WDOWN], 1024, n0, (bf16_t*)(ws + WS_W4T), FF, n0, kb * 64, scr, lane); }
    }
}

__device__ __forceinline__ void phase0(const Params& P, lptr lds, int tid, int lane, int wave) {
    unsigned char* ws = P.ws;
    LAS float* sc = (LAS float*)lds;
    for (int i = tid; i < 16384; i += 512) { const int r = i >> 10, k = i & 1023; const float c = r < 8 ? P.in[I_CP][r * 1024 + k] : P.in[I_CS][(r - 8) * 1024 + k]; sc[i] = c / (1.f + __expf(-c)); }
    __syncthreads();
    const int job = blockIdx.x * 512 + tid;
    if (job < 16 * 6144) {
        const int ks = job / 6144, n = job % 6144;
        float acc[16];
#pragma unroll
        for (int r = 0; r < 16; ++r) acc[r] = 0.f;
        const float* wp = P.in[I_WADA] + (size_t)(ks * 64) * 6144 + n;
#pragma unroll 16
        for (int k = 0; k < 64; ++k) { const float w = wp[(size_t)k * 6144];
#pragma unroll
            for (int r = 0; r < 16; ++r) acc[r] += sc[r * 1024 + ks * 64 + k] * w; }
        __attribute__((address_space(1))) float* mp = (__attribute__((address_space(1))) float*)(ws + WS_MOD);
        const float bias = ks == 0 ? P.in[I_BADA][n] : 0.f;
#pragma unroll
        for (int r = 0; r < 16; ++r) (void)__builtin_amdgcn_global_atomic_fadd_f32(mp + (size_t)r * 6144 + n, acc[r] + bias);
    }
}

__device__ __forceinline__ void load_mod_vectors(const Params& P, LAS float* A, LAS float* S, const float* normw, int r, int shofs, int tid) {
    const float* md = (const float*)(P.ws + WS_MOD) + (size_t)r * 6144 + shofs;
    for (int k = tid; k < 1024; k += 512) { A[k] = normw[k] * (1.f + md[1024 + k]); S[k] = md[k]; }
}
__device__ __forceinline__ void load_row_bf(const bf16_t* xrow, int lane, f32x4 (&v)[4]) {
#pragma unroll
    for (int j = 0; j < 4; ++j) { const u32x2 w = ((const u32x2*)xrow)[lane + 64 * j]; v[j] = (f32x4){bflo(w.x), bfhi(w.x), bflo(w.y), bfhi(w.y)}; }
}
__device__ __forceinline__ void load_row(const float* xrow, int lane, f32x4 (&v)[4]) {
#pragma unroll
    for (int j = 0; j < 4; ++j) v[j] = ((const f32x4*)xrow)[lane + 64 * j];
}
template <bool GATES>
__device__ __forceinline__ void norm_row(const Params& P, const f32x4 (&v)[4], bf16_t* orow, float* grow, const LAS float* A, const LAS float* S, const LAS float* Wg, int lane) {
    float s = 0.f;
#pragma unroll
    for (int j = 0; j < 4; ++j) s += (v[j].x * v[j].x + v[j].y * v[j].y) + (v[j].z * v[j].z + v[j].w * v[j].w);
    const float rstd = rsqrtf(wave_sum(s) * (1.f / 1024.f) + EPS);
    float g[8];
#pragma unroll
    for (int i = 0; i < 8; ++i) g[i] = 0.f;
#pragma unroll
    for (int j = 0; j < 4; ++j) { const int k0 = 4 * lane + 256 * j;
        const f32x4 a = *(const LAS f32x4*)(A + k0), sh = *(const LAS f32x4*)(S + k0);
        const f32x4 hv = v[j] * rstd * a + sh;
        u32x2 o; o.x = cvtpk(hv.x, hv.y); o.y = cvtpk(hv.z, hv.w);
        *(u32x2*)(orow + k0) = o;
        if (GATES) {
#pragma unroll
            for (int i = 0; i < 8; ++i) { const f32x4 w = *(const LAS f32x4*)(Wg + i * 1024 + k0); g[i] += (hv.x * w.x + hv.y * w.y) + (hv.z * w.z + hv.w * w.w); } }
    }
    if (GATES) {
        { const bool hi = (lane & 32) != 0;
#pragma unroll
          for (int i = 0; i < 4; ++i) { const float send = hi ? g[i] : g[i + 4], keep = hi ? g[i + 4] : g[i]; g[i] = keep + __shfl_xor(send, 32); } }
        { const bool hi = (lane & 16) != 0;
#pragma unroll
          for (int i = 0; i < 2; ++i) { const float send = hi ? g[i] : g[i + 2], keep = hi ? g[i + 2] : g[i]; g[i] = keep + __shfl_xor(send, 16); } }
        { const bool hi = (lane & 8) != 0; const float send = hi ? g[0] : g[1], keep = hi ? g[1] : g[0]; g[0] = keep + __shfl_xor(send, 8); }
        g[0] += __shfl_xor(g[0], 4); g[0] += __shfl_xor(g[0], 2); g[0] += __shfl_xor(g[0], 1);
        const int gt = lane >> 3;
        if ((lane & 7) == 0) {
            float o;
            if (gt < 4) o = g[0] + P.in[I_BIG][gt];
            else { const float x = g[0] + P.in[I_BFG][gt - 4]; o = fminf(x, 0.f) - log1pf(expf(-fabsf(x))); }
            grow[gt] = o;
        }
    }
}
__device__ __forceinline__ void phase1(const Params& P, lptr lds, int tid, int lane, int wave) {
    LAS float* A1 = (LAS float*)lds; LAS float* S1 = A1 + 1024; LAS float* Wg = S1 + 1024;
    const size_t row0 = (size_t)blockIdx.x * 128 + wave * 16; f32x4 v[4], vn[4]; load_row(P.in[I_XP] + row0 * 1024, lane, v);
    for (int k = tid; k < 1024; k += 512) { const f32x4 w0 = *(const f32x4*)(P.in[I_WIN] + (size_t)k * DIN + 2048), w1 = *(const f32x4*)(P.in[I_WIN] + (size_t)k * DIN + 2052);
        Wg[k] = w0.x; Wg[1024 + k] = w0.y; Wg[2048 + k] = w0.z; Wg[3072 + k] = w0.w; Wg[4096 + k] = w1.x; Wg[5120 + k] = w1.y; Wg[6144 + k] = w1.z; Wg[7168 + k] = w1.w; }
    load_mod_vectors(P, A1, S1, P.in[I_N1W], blockIdx.x >> 5, 0, tid);
    LAS float* A1s = Wg + 8192; LAS float* S1s = A1s + 1024;
    load_mod_vectors(P, A1s, S1s, P.in[I_N1W], 8 + (blockIdx.x >> 5), 0, tid);
    __syncthreads();
    bf16_t* H = (bf16_t*)(P.ws + WS_H); float* GT = (float*)(P.ws + WS_GATES);
    {
#pragma unroll 1
      for (int j = 0; j < 16; ++j) { const size_t row = row0 + j;
          if (j + 1 < 16) load_row(P.in[I_XP] + (row + 1) * 1024, lane, vn);
          else if (wave == 0) load_row(P.in[I_XS] + (size_t)blockIdx.x * 1024, lane, vn);
          norm_row<true>(P, v, H + row * 1024, GT + row * 8, A1, S1, Wg, lane);
#pragma unroll
          for (int q = 0; q < 4; ++q) v[q] = vn[q]; }
      if (wave == 0) norm_row<true>(P, v, H + ((size_t)MP + blockIdx.x) * 1024, GT + ((size_t)MP + blockIdx.x) * 8, A1s, S1s, Wg, lane); }
}
__device__ __forceinline__ void phase5(const Params& P, lptr lds, int tid, int lane, int wave) {
    LAS float* A1 = (LAS float*)lds; LAS float* S1 = A1 + 1024;
    load_mod_vectors(P, A1, S1, P.in[I_N2W], blockIdx.x >> 5, 3072, tid);
    __syncthreads();
    bf16_t* H = (bf16_t*)(P.ws + WS_H);
    { const size_t row0 = (size_t)blockIdx.x * 128 + wave * 16; const bf16_t* X1 = (const bf16_t*)(P.ws + WS_X1B); f32x4 v[4], vn[4]; load_row_bf(X1 + row0 * 1024, lane, v);
#pragma unroll 1
      for (int j = 0; j < 16; ++j) { const size_t row = row0 + j;
          if (j + 1 < 16) load_row_bf(X1 + (row + 1) * 1024, lane, vn);
          norm_row<false>(P, v, H + row * 1024, nullptr, A1, S1, nullptr, lane);
#pragma unroll
          for (int q = 0; q < 4; ++q) v[q] = vn[q]; } }
    __syncthreads();
}
__device__ __forceinline__ void sample_h2_row(const Params& P, lptr lds, int tid, int lane, int wave) {
    LAS float* A1 = (LAS float*)lds; LAS float* S1 = A1 + 1024;
    load_mod_vectors(P, A1, S1, P.in[I_N2W], 8 + (blockIdx.x >> 5), 3072, tid);
    __syncthreads();
    if (wave == 0) { f32x4 v[4]; load_row_bf((const bf16_t*)(P.ws + WS_X1B) + ((size_t)MP + blockIdx.x) * 1024, lane, v); norm_row<false>(P, v, (bf16_t*)(P.ws + WS_H) + ((size_t)MP + blockIdx.x) * 1024, nullptr, A1, S1, nullptr, lane); }
    __syncthreads();
}
__device__ __forceinline__ void phase3b(const Params& P, int lane, int gw, int NGW) {
    bf16_t* Y = (bf16_t*)(P.ws + WS_YCAT); const float* SSQ = (const float*)(P.ws + WS_SSQ);
    for (int row = gw; row < MP; row += NGW) {
        const f32x4 s0 = *(const f32x4*)(SSQ + (size_t)row * 8), s1 = *(const f32x4*)(SSQ + (size_t)row * 8 + 4);
        const float rstd = rsqrtf(((s0.x + s0.y) + (s0.z + s0.w) + (s1.x + s1.y) + (s1.z + s1.w)) * (1.f / 512.f) + EPS);
        u32x4* p = (u32x4*)(Y + (size_t)row * 1024 + 512 + 8 * lane); const u32x4 o = *p;
        f32x4 a = {bflo(o.x), bfhi(o.x), bflo(o.y), bfhi(o.y)}, b = {bflo(o.z), bfhi(o.z), bflo(o.w), bfhi(o.w)};
        a = a * rstd; b = b * rstd;
        *p = pack8(a, b);
    }
}
__device__ __forceinline__ void phase_fix(const Params& P, int tid) {
    const float* UE = (const float*)(P.ws + WS_UEDGE); bf16_t* act = (bf16_t*)(P.ws + WS_ACT);
    const float* wc = P.in[I_WCONV]; const float* bc = P.in[I_BCONV];
    const int total = 128 * 2 * FF;
    if (blockIdx.x < 64) return;
    for (int i = (blockIdx.x - 64) * 512 + tid; i < total; i += (gridDim.x - 64) * 512) {
        const int j = i % FF, rr = (i / FF) & 1, pm = i / (2 * FF);
        if ((pm & 15) == 0) continue;
        float uc[2];
#pragma unroll
        for (int hf = 0; hf < 2; ++hf) { const int c = j + hf * FF;
            const float um2 = rr == 0 ? UE[((size_t)(pm - 1) * 4 + 2) * FF2 + c] : UE[((size_t)(pm - 1) * 4 + 3) * FF2 + c];
            const float um1 = rr == 0 ? UE[((size_t)(pm - 1) * 4 + 3) * FF2 + c] : UE[((size_t)pm * 4 + 0) * FF2 + c];
            const float u0 = UE[((size_t)pm * 4 + rr) * FF2 + c];
            uc[hf] = bc[c] + wc[2 * FF2 + c] * u0 + wc[FF2 + c] * um1 + wc[c] * um2; }
        act[((size_t)pm * 256 + rr) * FF + j] = f2bf(uc[0] * sigmoidf_(uc[0]) * uc[1]);
    }
}

constexpr int ML_P = 272;
constexpr int ML_QS = 0, ML_KS = 17408, ML_VS = 34816, ML_VW = 52224, ML_CS = 69632, ML_SS = 104448, ML_SC = 113664;
__device__ __forceinline__ void mlstm_item(const Params& P, lptr lds, int bh, bool sample, int tid, int lane, int wave) {
    const int b = bh >> 2, h = bh & 3, hh = lane >> 5, n31 = lane & 31;
    const size_t rowbase = sample ? (size_t)MP + b * 32 : (size_t)b * SEQ;
    const int nch = sample ? 1 : 64, L = sample ? 32 : 64;
    const bf16_t* MQ = (const bf16_t*)(P.ws + WS_PROJ); const bf16_t* MK = (const bf16_t*)(P.ws + WS_PROJ + PROJ_STRIDE); const bf16_t* MV = (const bf16_t*)(P.ws + WS_PROJ + 2 * PROJ_STRIDE);
    const bf16_t* MO = (const bf16_t*)(P.ws + WS_PROJ + 3 * PROJ_STRIDE); const float* GT = (const float*)(P.ws + WS_GATES); bf16_t* YC = (bf16_t*)(P.ws + WS_YCAT);
    LAS float* sc = (LAS float*)(lds + ML_SC);
    LAS float* bt = sc, *as_ = sc + 64, *mt = sc + 128, *winter = sc + 192, *emt = sc + 256, *wk = sc + 320, *rsum = sc + 384, *qn = sc + 512, *nvec = sc + 576, *misc = sc + 704;
    const int ti = wave >> 2, ej = wave & 3;
    f32x16 Cacc[2];
    {
        LAS float* cst = (LAS float*)lds;
        if (sample) { const float* src = P.in[I_STC] + ((size_t)b * 4 + h) * 16384;
            for (int i = tid; i < 4096; i += 512) { const f32x4 v = *(const f32x4*)(src + 4 * i); *(LAS f32x4*)(cst + (i >> 5) * 132 + (i & 31) * 4) = v; } }
        else { for (int i = tid; i < 4096; i += 512) *(LAS f32x4*)(cst + (i >> 5) * 132 + (i & 31) * 4) = (f32x4){0.f, 0.f, 0.f, 0.f}; }
        __syncthreads();
        const LAS float* cb = cst + (64 * (wave >> 2) + 4 * hh) * 132 + 32 * ej + n31;
#pragma unroll
        for (int i = 0; i < 2; ++i)
#pragma unroll
            for (int r = 0; r < 16; ++r) Cacc[i][r] = cb[(32 * i + (r & 3) + 8 * (r >> 2)) * 132];
        __syncthreads();
        lptr cs = lds + ML_CS + (64 * (wave >> 2) + 4 * hh) * ML_P + (32 * ej + n31) * 2;
#pragma unroll
        for (int i = 0; i < 2; ++i)
#pragma unroll
            for (int r = 0; r < 16; ++r) *(LAS unsigned short*)(cs + (32 * i + (r & 3) + 8 * (r >> 2)) * ML_P) = f2bf(Cacc[i][r]);
    }
    if (tid < 128) nvec[tid] = sample ? P.in[I_STN][((size_t)b * 4 + h) * 128 + tid] : 0.f;
    if (tid == 0) misc[0] = sample ? P.in[I_STM][b * 4 + h] : 0.f;
    u32x4 rq[2], rk[2], rv[2]; float g_ig = -INFINITY, g_lf = 0.f;
    const int prow[2] = {tid >> 4, (tid + 512) >> 4}, pch = tid & 15;
#define ML_LOAD(c) do { _Pragma("unroll") for (int i = 0; i < 2; ++i) { if (prow[i] < L) { const size_t go = (rowbase + (size_t)(c) * 64 + prow[i]) * 512 + h * 128 + pch * 8; \
            rq[i] = *(const u32x4*)(MQ + go); rk[i] = *(const u32x4*)(MK + go); rv[i] = *(const u32x4*)(MV + go); } else { rq[i] = (u32x4){0u, 0u, 0u, 0u}; rk[i] = rq[i]; rv[i] = rq[i]; } } \
        if (wave == 0) { if (lane < L) { const float* g = GT + (rowbase + (size_t)(c) * 64 + lane) * 8; g_ig = g[h]; g_lf = g[4 + h]; } else { g_ig = -INFINITY; g_lf = 0.f; } } } while (0)
    ML_LOAD(0);
    for (int c = 0; c < nch; ++c) {
        __syncthreads();
        if (wave == 0) {
            float bcum = g_lf;
#pragma unroll
            for (int o = 1; o < 64; o <<= 1) { const float v = __shfl_up(bcum, o); if (lane >= o) bcum += v; }
            const float a = g_ig - bcum; float amax = a;
#pragma unroll
            for (int o = 1; o < 64; o <<= 1) { const float v = __shfl_up(amax, o); if (lane >= o) amax = fmaxf(amax, v); }
            const float mprev = misc[0];
            const float m_t = fmaxf(bcum + mprev, bcum + amax);
            const float bL = __shfl(bcum, 63), aM = __shfl(amax, 63);
            const float m_new = fmaxf(bL + mprev, bL + aM);
            bt[lane] = bcum; as_[lane] = a; mt[lane] = m_t; winter[lane] = expf(bcum + mprev - m_t); emt[lane] = expf(-m_t); wk[lane] = expf(bL + a - m_new);
            if (lane == 0) { misc[1] = expf(bL + mprev - m_new); misc[2] = m_new; }
        }
#pragma unroll
        for (int i = 0; i < 2; ++i) { const int o = prow[i] * ML_P + pch * 16;
            *(LAS u32x4*)(lds + ML_QS + o) = rq[i]; *(LAS u32x4*)(lds + ML_KS + o) = rk[i]; *(LAS u32x4*)(lds + ML_VS + o) = rv[i]; }
        __syncthreads();
#pragma unroll
        for (int i = 0; i < 2; ++i) { const float w = wk[prow[i]]; const u32x4 v = rv[i]; u32x4 o;
            o.x = cvtpk(bflo(v.x) * w, bfhi(v.x) * w); o.y = cvtpk(bflo(v.y) * w, bfhi(v.y) * w); o.z = cvtpk(bflo(v.z) * w, bfhi(v.z) * w); o.w = cvtpk(bflo(v.w) * w, bfhi(v.w) * w);
            *(LAS u32x4*)(lds + ML_VW + prow[i] * ML_P + pch * 16) = o; }
        if (c + 1 < nch) ML_LOAD(c + 1);
        f32x16 num;
#pragma unroll
        for (int r = 0; r < 16; ++r) num[r] = 0.f;
#pragma unroll
        for (int ks = 0; ks < 8; ++ks) num = MFMA32(row_frag(lds + ML_QS, ML_P, 32 * ti, 16 * ks, lane), tr_frag(lds + ML_CS, ML_P, 16 * ks, 32 * ej, lane), num);
        if (wave < 3) {
            const int sti = wave == 0 ? 0 : 1, sj = wave == 2 ? 1 : 0;
            const int krow = (n31 & ~12) | ((n31 & 4) << 1) | ((n31 & 8) >> 1);
            f32x16 p;
#pragma unroll
            for (int r = 0; r < 16; ++r) p[r] = 0.f;
#pragma unroll
            for (int ks = 0; ks < 8; ++ks) p = MFMA32(*(const LAS bf16x8*)(lds + ML_KS + (32 * sj + krow) * ML_P + (16 * ks + 8 * hh) * 2), row_frag(lds + ML_QS, ML_P, 32 * sti, 16 * ks, lane), p);
            const int t = 32 * sti + n31; const float bt_t = bt[t], mt_t = mt[t]; float rs = 0.f;
            const LAS float* asb = as_ + 32 * sj + 8 * hh; const int tb = t - (32 * sj + 8 * hh);
#pragma unroll
            for (int r = 0; r < 16; ++r) { const int so = 16 * (r >> 3) + (r & 7);
                const float w = so <= tb ? __expf(bt_t + asb[so] - mt_t) : 0.f; p[r] *= w; rs += p[r]; }
#pragma unroll
            for (int a2 = 0; a2 < 2; ++a2) { u32x4 o; o.x = cvtpk(p[8 * a2 + 0], p[8 * a2 + 1]); o.y = cvtpk(p[8 * a2 + 2], p[8 * a2 + 3]); o.z = cvtpk(p[8 * a2 + 4], p[8 * a2 + 5]); o.w = cvtpk(p[8 * a2 + 6], p[8 * a2 + 7]);
                *(LAS u32x4*)(lds + ML_SS + t * 144 + (32 * sj + 16 * a2 + 8 * hh) * 2) = o; }
            rs += __shfl_xor(rs, 32);
            if (hh == 0) rsum[sj * 64 + t] = rs;
        }
        if (wave >= 4) {
            const int t = (tid - 256) >> 2, part = tid & 3; float s = 0.f;
#pragma unroll 8
            for (int d = 0; d < 32; ++d) s += bf2f(*(const LAS unsigned short*)(lds + ML_QS + t * ML_P + (32 * part + d) * 2)) * nvec[32 * part + d];
            s += __shfl_xor(s, 1); s += __shfl_xor(s, 2);
            if (part == 0) qn[t] = s;
        }
        __syncthreads();
        const LAS float* tb2 = sc + 32 * ti + 4 * hh;
#pragma unroll
        for (int r = 0; r < 16; ++r) num[r] *= tb2[192 + (r & 3) + 8 * (r >> 2)];
#pragma unroll
        for (int ks = 0; ks < 4; ++ks) if (ks < 2 || ti == 1) num = MFMA32(*(const LAS bf16x8*)(lds + ML_SS + (32 * ti + n31) * 144 + (16 * ks + 8 * hh) * 2), tr_frag(lds + ML_VS, ML_P, 16 * ks, 32 * ej, lane), num);
#pragma unroll
        for (int r = 0; r < 16; ++r) { const int o = (r & 3) + 8 * (r >> 2);
            const float den = tb2[192 + o] * tb2[512 + o] + tb2[384 + o] + (ti ? tb2[448 + o] : 0.f);
            const float hv = num[r] / fmaxf(fabsf(den), tb2[256 + o]);
            *(LAS unsigned short*)(lds + ML_QS + (32 * ti + 4 * hh) * ML_P + (32 * ej + n31) * 2 + o * ML_P) = f2bf(hv); }
        const float decay = misc[1];
#pragma unroll
        for (int i = 0; i < 2; ++i) { const int di = 2 * (wave >> 2) + i;
#pragma unroll
            for (int r = 0; r < 16; ++r) Cacc[i][r] *= decay;
#pragma unroll
            for (int ks = 0; ks < 4; ++ks) Cacc[i] = MFMA32(tr_frag(lds + ML_KS, ML_P, 16 * ks, 32 * di, lane), tr_frag(lds + ML_VW, ML_P, 16 * ks, 32 * ej, lane), Cacc[i]);
#pragma unroll
            for (int r = 0; r < 16; ++r) *(LAS unsigned short*)(lds + ML_CS + (64 * (wave >> 2) + 4 * hh) * ML_P + (32 * ej + n31) * 2 + (32 * i + (r & 3) + 8 * (r >> 2)) * ML_P) = f2bf(Cacc[i][r]); }
        if (tid < 128) { float s = decay * nvec[tid];
#pragma unroll 8
            for (int t = 0; t < 64; ++t) s += wk[t] * bf2f(*(const LAS unsigned short*)(lds + ML_KS + t * ML_P + tid * 2));
            nvec[tid] = s; }
        if (tid == 0) misc[0] = misc[2];
        __syncthreads();
        { const int t = tid >> 3, part = tid & 7;
          const u32x4 h0 = *(const LAS u32x4*)(lds + ML_QS + t * ML_P + part * 32), h1 = *(const LAS u32x4*)(lds + ML_QS + t * ML_P + part * 32 + 16);
          float hv[16] = {bflo(h0.x), bfhi(h0.x), bflo(h0.y), bfhi(h0.y), bflo(h0.z), bfhi(h0.z), bflo(h0.w), bfhi(h0.w), bflo(h1.x), bfhi(h1.x), bflo(h1.y), bfhi(h1.y), bflo(h1.z), bfhi(h1.z), bflo(h1.w), bfhi(h1.w)};
          float ss = 0.f;
#pragma unroll
          for (int e = 0; e < 16; ++e) ss += hv[e] * hv[e];
          ss += __shfl_xor(ss, 1); ss += __shfl_xor(ss, 2); ss += __shfl_xor(ss, 4);
          const float rstd = rsqrtf(ss * (1.f / 128.f) + EPS);
          if (t < L) {
              const size_t row = rowbase + (size_t)c * 64 + t; const int col = h * 128 + part * 16;
              const u32x4 g0 = *(const u32x4*)(MO + row * 512 + col), g1 = *(const u32x4*)(MO + row * 512 + col + 8);
              const float gv[16] = {bflo(g0.x), bfhi(g0.x), bflo(g0.y), bfhi(g0.y), bflo(g0.z), bfhi(g0.z), bflo(g0.w), bfhi(g0.w), bflo(g1.x), bfhi(g1.x), bflo(g1.y), bfhi(g1.y), bflo(g1.z), bfhi(g1.z), bflo(g1.w), bfhi(g1.w)};
              const float* mw = P.in[I_MLW] + col;
              float y[16];
#pragma unroll
              for (int e = 0; e < 16; ++e) y[e] = hv[e] * rstd * mw[e] * gv[e];
              u32x4 o0, o1; o0.x = cvtpk(y[0], y[1]); o0.y = cvtpk(y[2], y[3]); o0.z = cvtpk(y[4], y[5]); o0.w = cvtpk(y[6], y[7]); o1.x = cvtpk(y[8], y[9]); o1.y = cvtpk(y[10], y[11]); o1.z = cvtpk(y[12], y[13]); o1.w = cvtpk(y[14], y[15]);
              *(u32x4*)(YC + row * 1024 + col) = o0; *(u32x4*)(YC + row * 1024 + col + 8) = o1;
          } }
    }
#undef ML_LOAD
    __syncthreads();
    {
        LAS float* cst = (LAS float*)lds;
        int l3 = lane; asm volatile("" : "+v"(l3));
        LAS float* cb = cst + (64 * (wave >> 2) + 4 * (l3 >> 5)) * 132 + 32 * ej + (l3 & 31);
#pragma unroll
        for (int i = 0; i < 2; ++i)
#pragma unroll
            for (int r = 0; r < 16; ++r) cb[(32 * i + (r & 3) + 8 * (r >> 2)) * 132] = Cacc[i][r];
        __syncthreads();
        float* oc = P.out + (sample ? O_SC : O_PC) + ((size_t)b * 4 + h) * 16384;
        for (int i = tid; i < 4096; i += 512) *(f32x4*)(oc + 4 * i) = *(const LAS f32x4*)(cst + (i >> 5) * 132 + (i & 31) * 4);
    }
    if (tid < 128) P.out[(sample ? O_SN : O_PN) + ((size_t)b * 4 + h) * 128 + tid] = nvec[tid];
    if (tid == 0) P.out[(sample ? O_SM : O_PM) + b * 4 + h] = misc[0];
}


constexpr size_t WS_KVL = WS_H, WS_KNL = 420 * MiB, WS_CHS = 421 * MiB, WS_NST = 422 * MiB, WS_MST = 423 * MiB, WS_CST = 424 * MiB, WS_END2 = 489 * MiB;
template <int NC>
__device__ __forceinline__ void ml1_pair(const Params& P, lptr lds, int pair, int tid, int lane, int wave) {
    const int item0 = NC * pair; const int bh = item0 >> 6, c = item0 & 63, b = bh >> 2, h = bh & 3, hh = lane >> 5, n31 = lane & 31, ej = wave & 3;
    const size_t row0 = (size_t)b * SEQ + 64 * c;
    const bf16_t* MK = (const bf16_t*)(P.ws + WS_PROJ + PROJ_STRIDE); const bf16_t* MV = (const bf16_t*)(P.ws + WS_PROJ + 2 * PROJ_STRIDE); const float* GT = (const float*)(P.ws + WS_GATES);
    LAS float* wk = (LAS float*)(lds + ML_SC) + 320;
    const int prow[2] = {tid >> 4, (tid + 512) >> 4}, pch = tid & 15;
    u32x4 rk2[NC][2], rv2[NC][2]; float g_ig2[NC], g_lf2[NC];
#pragma unroll
    for (int s2 = 0; s2 < NC; ++s2) { g_ig2[s2] = 0.f; g_lf2[s2] = 0.f;
#pragma unroll
        for (int i = 0; i < 2; ++i) { const size_t go = (row0 + 64 * s2 + prow[i]) * 512 + h * 128 + pch * 8; rk2[s2][i] = *(const u32x4*)(MK + go); rv2[s2][i] = *(const u32x4*)(MV + go); }
        if (wave == 0) { const float* g = GT + (row0 + 64 * s2 + lane) * 8; g_ig2[s2] = g[h]; g_lf2[s2] = g[4 + h]; } }
#pragma unroll
    for (int s2 = 0; s2 < NC; ++s2) {
    const int item = item0 + s2; const float g_ig = g_ig2[s2], g_lf = g_lf2[s2];
    u32x4 rk[2] = {rk2[s2][0], rk2[s2][1]}, rv[2] = {rv2[s2][0], rv2[s2][1]};
    __syncthreads();
    if (wave == 0) {
        float bcum = g_lf;
#pragma unroll
        for (int o = 1; o < 64; o <<= 1) { const float v = __shfl_up(bcum, o); if (lane >= o) bcum += v; }
        const float a = g_ig - bcum; float amax = a;
#pragma unroll
        for (int o = 1; o < 64; o <<= 1) amax = fmaxf(amax, __shfl_xor(amax, o));
        const float bL = __shfl(bcum, 63);
        wk[lane] = expf(a - amax);
        if (lane == 0) { float* ch = (float*)(P.ws + WS_CHS) + (size_t)item * 4; ch[0] = bL; ch[1] = bL + amax; }
    }
#pragma unroll
    for (int i = 0; i < 2; ++i) *(LAS u32x4*)(lds + ML_KS + prow[i] * ML_P + pch * 16) = rk[i];
    __syncthreads();
#pragma unroll
    for (int i = 0; i < 2; ++i) { const float w = wk[prow[i]]; const u32x4 v = rv[i]; u32x4 o;
        o.x = cvtpk(bflo(v.x) * w, bfhi(v.x) * w); o.y = cvtpk(bflo(v.y) * w, bfhi(v.y) * w); o.z = cvtpk(bflo(v.z) * w, bfhi(v.z) * w); o.w = cvtpk(bflo(v.w) * w, bfhi(v.w) * w);
        *(LAS u32x4*)(lds + ML_VW + prow[i] * ML_P + pch * 16) = o; }
    if (tid < 128) { float s = 0.f;
#pragma unroll 8
        for (int t = 0; t < 64; ++t) s += wk[t] * bf2f(*(const LAS unsigned short*)(lds + ML_KS + t * ML_P + tid * 2));
        ((float*)(P.ws + WS_KNL))[(size_t)item * 128 + tid] = s; }
    __syncthreads();
#pragma unroll
    for (int i = 0; i < 2; ++i) { const int di = 2 * (wave >> 2) + i;
        f32x16 acc;
#pragma unroll
        for (int r = 0; r < 16; ++r) acc[r] = 0.f;
#pragma unroll
        for (int ks = 0; ks < 4; ++ks) acc = MFMA32(tr_frag(lds + ML_KS, ML_P, 16 * ks, 32 * di, lane), tr_frag(lds + ML_VW, ML_P, 16 * ks, 32 * ej, lane), acc);
#pragma unroll
        for (int r = 0; r < 16; ++r) *(LAS unsigned short*)(lds + ML_CS + (64 * (wave >> 2) + 4 * hh) * ML_P + (32 * ej + n31) * 2 + (32 * i + (r & 3) + 8 * (r >> 2)) * ML_P) = f2bf(acc[r]); }
    __syncthreads();
    bf16_t* kvl = (bf16_t*)(P.ws + WS_KVL) + (size_t)item * 16384;
#pragma unroll
    for (int i = 0; i < 4; ++i) { const int p = tid + 512 * i, row = p >> 4, ch = p & 15; *(u32x4*)(kvl + row * 128 + ch * 8) = *(const LAS u32x4*)(lds + ML_CS + row * ML_P + ch * 16); }
    }
}
__device__ __forceinline__ void ml2_scan(const Params& P, lptr lds, int tid) {
    const int hb = tid >> 8, lt = tid & 255, job = 2 * blockIdx.x + hb;
    const int bh = job >> 3, part = job & 7;
    LAS float* dec = (LAS float*)(lds + hb * 1024); LAS float* scl = dec + 64; LAS float* mst = scl + 64;
    if (lt < 64) {
        const float* ch = (const float*)(P.ws + WS_CHS) + ((size_t)bh * 64 + lt) * 4;
        const float bL = ch[0], ml = ch[1]; float A = bL, B = ml;
#pragma unroll
        for (int off = 1; off < 64; off <<= 1) { const float A2 = __shfl_up(A, off), B2 = __shfl_up(B, off); if (lt >= off) { B = fmaxf(B2 + A, B); A = A2 + A; } }
        const float mnext = fmaxf(A, B);
        float mc = __shfl_up(mnext, 1); if (lt == 0) mc = 0.f;
        dec[lt] = expf(bL + mc - mnext); scl[lt] = expf(ml - mnext); mst[lt] = mc; if (lt == 63) mst[64] = mnext;
    }
    __syncthreads();
    const size_t e0 = (size_t)part * 2048 + lt * 8;
    const bf16_t* kv = (const bf16_t*)(P.ws + WS_KVL) + (size_t)bh * 64 * 16384 + e0; bf16_t* cs = (bf16_t*)(P.ws + WS_CST) + (size_t)bh * 64 * 16384 + e0;
    f32x4 C0 = {0.f, 0.f, 0.f, 0.f}, C1 = {0.f, 0.f, 0.f, 0.f};
    const bool do_n = part == 0 && lt < 128; const int tn = do_n ? lt : 0; float n = 0.f;
    const float* kn = (const float*)(P.ws + WS_KNL) + (size_t)bh * 64 * 128 + tn; float* ns = (float*)(P.ws + WS_NST) + (size_t)bh * 64 * 128 + tn;
#pragma unroll 16
    for (int c = 0; c < 64; ++c) { const u32x4 v = *(const u32x4*)(kv + (size_t)c * 16384);
        float knv = 0.f; if (do_n) knv = kn[c * 128];
        *(u32x4*)(cs + (size_t)c * 16384) = pack8(C0, C1);
        if (do_n) ns[c * 128] = n;
        const f32x4 k0 = {bflo(v.x), bfhi(v.x), bflo(v.y), bfhi(v.y)}, k1 = {bflo(v.z), bfhi(v.z), bflo(v.w), bfhi(v.w)};
        const float d = dec[c], sl = scl[c];
        C0 = C0 * d + k0 * sl; C1 = C1 * d + k1 * sl; n = n * d + knv * sl; }
    float* oc = P.out + O_PC + (size_t)bh * 16384 + e0; *(f32x4*)oc = C0; *(f32x4*)(oc + 4) = C1;
    if (do_n) P.out[O_PN + (size_t)bh * 128 + lt] = n;
    if (part == 0 && lt >= 128 && lt < 192) ((float*)(P.ws + WS_MST))[bh * 64 + lt - 128] = mst[lt - 128];
    if (part == 0 && lt == 192) P.out[O_PM + bh] = mst[64];
}
struct Ml3In { u32x4 rq[2], rk[2], rv[2], rc[4], g0, g1; float g_ig, g_lf, mprev, nin; };
__device__ __forceinline__ void ml3_load(const Params& P, int item, int tid, int lane, int wave, Ml3In& L) {
    const int bh = item >> 6, c = item & 63, b = bh >> 2, h = bh & 3;
    const size_t row0 = (size_t)b * SEQ + 64 * c;
    const bf16_t* MQ = (const bf16_t*)(P.ws + WS_PROJ); const bf16_t* MK = (const bf16_t*)(P.ws + WS_PROJ + PROJ_STRIDE); const bf16_t* MV = (const bf16_t*)(P.ws + WS_PROJ + 2 * PROJ_STRIDE);
    const bf16_t* MO = (const bf16_t*)(P.ws + WS_PROJ + 3 * PROJ_STRIDE); const float* GT = (const float*)(P.ws + WS_GATES);
    const int prow[2] = {tid >> 4, (tid + 512) >> 4}, pch = tid & 15;
#pragma unroll
    for (int i = 0; i < 2; ++i) { const size_t go = (row0 + prow[i]) * 512 + h * 128 + pch * 8; L.rq[i] = *(const u32x4*)(MQ + go); L.rk[i] = *(const u32x4*)(MK + go); L.rv[i] = *(const u32x4*)(MV + go); }
    const bf16_t* cst = (const bf16_t*)(P.ws + WS_CST) + (size_t)item * 16384;
#pragma unroll
    for (int i = 0; i < 4; ++i) { const int p = tid + 512 * i; L.rc[i] = *(const u32x4*)(cst + (p >> 4) * 128 + (p & 15) * 8); }
    { const size_t row = row0 + (tid >> 3); const int col = h * 128 + (tid & 7) * 16; L.g0 = *(const u32x4*)(MO + row * 512 + col); L.g1 = *(const u32x4*)(MO + row * 512 + col + 8); }
    L.g_ig = 0.f; L.g_lf = 0.f; L.mprev = 0.f; L.nin = 0.f;
    if (wave == 0) { const float* g = GT + (row0 + lane) * 8; L.g_ig = g[h]; L.g_lf = g[4 + h]; L.mprev = ((const float*)(P.ws + WS_MST))[item]; }
    if (tid < 128) L.nin = ((const float*)(P.ws + WS_NST))[(size_t)item * 128 + tid];
}
__device__ __forceinline__ void ml3_item(const Params& P, lptr lds, int item, const Ml3In& L, int tid, int lane, int wave) {
    const int bh = item >> 6, c = item & 63, b = bh >> 2, h = bh & 3, hh = lane >> 5, n31 = lane & 31;
    const size_t row0 = (size_t)b * SEQ + 64 * c;
    bf16_t* YC = (bf16_t*)(P.ws + WS_YCAT);
    LAS float* sc = (LAS float*)(lds + ML_SC);
    LAS float* bt = sc, *as_ = sc + 64, *mt = sc + 128, *winter = sc + 192, *emt = sc + 256, *rsum = sc + 384, *qn = sc + 512, *nvec = sc + 576;
    const int ti = wave >> 2, ej = wave & 3;
    const int prow[2] = {tid >> 4, (tid + 512) >> 4}, pch = tid & 15;
    const float g_ig = L.g_ig, g_lf = L.g_lf, mprev = L.mprev, nin = L.nin;
    __syncthreads();
    if (wave == 0) {
        float bcum = g_lf;
#pragma unroll
        for (int o = 1; o < 64; o <<= 1) { const float v = __shfl_up(bcum, o); if (lane >= o) bcum += v; }
        const float a = g_ig - bcum; float amax = a;
#pragma unroll
        for (int o = 1; o < 64; o <<= 1) { const float v = __shfl_up(amax, o); if (lane >= o) amax = fmaxf(amax, v); }
        const float m_t = fmaxf(bcum + mprev, bcum + amax);
        bt[lane] = bcum; as_[lane] = a; mt[lane] = m_t; winter[lane] = expf(bcum + mprev - m_t); emt[lane] = expf(-m_t);
    }
    if (tid < 128) nvec[tid] = nin;
#pragma unroll
    for (int i = 0; i < 2; ++i) { const int o = prow[i] * ML_P + pch * 16;
        *(LAS u32x4*)(lds + ML_QS + o) = L.rq[i]; *(LAS u32x4*)(lds + ML_KS + o) = L.rk[i]; *(LAS u32x4*)(lds + ML_VS + o) = L.rv[i]; }
#pragma unroll
    for (int i = 0; i < 4; ++i) { const int p = tid + 512 * i; *(LAS u32x4*)(lds + ML_CS + (p >> 4) * ML_P + (p & 15) * 16) = L.rc[i]; }
    __syncthreads();
    f32x16 num;
#pragma unroll
    for (int r = 0; r < 16; ++r) num[r] = 0.f;
#pragma unroll
    for (int ks = 0; ks < 8; ++ks) num = MFMA32(row_frag(lds + ML_QS, ML_P, 32 * ti, 16 * ks, lane), tr_frag(lds + ML_CS, ML_P, 16 * ks, 32 * ej, lane), num);
    if (wave < 3) {
        const int sti = wave == 0 ? 0 : 1, sj = wave == 2 ? 1 : 0;
        const int krow = (n31 & ~12) | ((n31 & 4) << 1) | ((n31 & 8) >> 1);
        f32x16 p;
#pragma unroll
        for (int r = 0; r < 16; ++r) p[r] = 0.f;
#pragma unroll
        for (int ks = 0; ks < 8; ++ks) p = MFMA32(*(const LAS bf16x8*)(lds + ML_KS + (32 * sj + krow) * ML_P + (16 * ks + 8 * hh) * 2), row_frag(lds + ML_QS, ML_P, 32 * sti, 16 * ks, lane), p);
        const int t = 32 * sti + n31; const float bt_t = bt[t], mt_t = mt[t]; float rs = 0.f;
        const LAS float* asb = as_ + 32 * sj + 8 * hh; const int tb = t - (32 * sj + 8 * hh);
#pragma unroll
        for (int r = 0; r < 16; ++r) { const int so = 16 * (r >> 3) + (r & 7);
            const float w = so <= tb ? __expf(bt_t + asb[so] - mt_t) : 0.f; p[r] *= w; rs += p[r]; }
#pragma unroll
        for (int a2 = 0; a2 < 2; ++a2) { u32x4 o; o.x = cvtpk(p[8 * a2 + 0], p[8 * a2 + 1]); o.y = cvtpk(p[8 * a2 + 2], p[8 * a2 + 3]); o.z = cvtpk(p[8 * a2 + 4], p[8 * a2 + 5]); o.w = cvtpk(p[8 * a2 + 6], p[8 * a2 + 7]);
            *(LAS u32x4*)(lds + ML_SS + t * 144 + (32 * sj + 16 * a2 + 8 * hh) * 2) = o; }
        rs += __shfl_xor(rs, 32);
        if (hh == 0) rsum[sj * 64 + t] = rs;
    }
    if (wave >= 4) {
        const int t = (tid - 256) >> 2, part = tid & 3; float s = 0.f;
#pragma unroll 8
        for (int d = 0; d < 32; ++d) s += bf2f(*(const LAS unsigned short*)(lds + ML_QS + t * ML_P + (32 * part + d) * 2)) * nvec[32 * part + d];
        s += __shfl_xor(s, 1); s += __shfl_xor(s, 2);
        if (part == 0) qn[t] = s;
    }
    __syncthreads();
    const LAS float* tb2 = sc + 32 * ti + 4 * hh;
#pragma unroll
    for (int r = 0; r < 16; ++r) num[r] *= tb2[192 + (r & 3) + 8 * (r >> 2)];
#pragma unroll
    for (int ks = 0; ks < 4; ++ks) if (ks < 2 || ti == 1) num = MFMA32(*(const LAS bf16x8*)(lds + ML_SS + (32 * ti + n31) * 144 + (16 * ks + 8 * hh) * 2), tr_frag(lds + ML_VS, ML_P, 16 * ks, 32 * ej, lane), num);
#pragma unroll
    for (int r = 0; r < 16; ++r) { const int o = (r & 3) + 8 * (r >> 2);
        const float den = tb2[192 + o] * tb2[512 + o] + tb2[384 + o] + (ti ? tb2[448 + o] : 0.f);
        const float hv = num[r] / fmaxf(fabsf(den), tb2[256 + o]);
        *(LAS unsigned short*)(lds + ML_QS + (32 * ti + 4 * hh) * ML_P + (32 * ej + n31) * 2 + o * ML_P) = f2bf(hv); }
    __syncthreads();
    { const int t = tid >> 3, part = tid & 7;
      const size_t row = row0 + t; const int col = h * 128 + part * 16;
      const u32x4 g0 = L.g0, g1 = L.g1;
      const u32x4 h0 = *(const LAS u32x4*)(lds + ML_QS + t * ML_P + part * 32), h1 = *(const LAS u32x4*)(lds + ML_QS + t * ML_P + part * 32 + 16);
      float hv[16] = {bflo(h0.x), bfhi(h0.x), bflo(h0.y), bfhi(h0.y), bflo(h0.z), bfhi(h0.z), bflo(h0.w), bfhi(h0.w), bflo(h1.x), bfhi(h1.x), bflo(h1.y), bfhi(h1.y), bflo(h1.z), bfhi(h1.z), bflo(h1.w), bfhi(h1.w)};
      float ss = 0.f;
#pragma unroll
      for (int e = 0; e < 16; ++e) ss += hv[e] * hv[e];
      ss += __shfl_xor(ss, 1); ss += __shfl_xor(ss, 2); ss += __shfl_xor(ss, 4);
      const float rstd = rsqrtf(ss * (1.f / 128.f) + EPS);
      const float gv[16] = {bflo(g0.x), bfhi(g0.x), bflo(g0.y), bfhi(g0.y), bflo(g0.z), bfhi(g0.z), bflo(g0.w), bfhi(g0.w), bflo(g1.x), bfhi(g1.x), bflo(g1.y), bfhi(g1.y), bflo(g1.z), bfhi(g1.z), bflo(g1.w), bfhi(g1.w)};
      const float* mw = P.in[I_MLW] + col;
      float y[16];
#pragma unroll
      for (int e = 0; e < 16; ++e) y[e] = hv[e] * rstd * mw[e] * gv[e];
      u32x4 o0, o1; o0.x = cvtpk(y[0], y[1]); o0.y = cvtpk(y[2], y[3]); o0.z = cvtpk(y[4], y[5]); o0.w = cvtpk(y[6], y[7]); o1.x = cvtpk(y[8], y[9]); o1.y = cvtpk(y[10], y[11]); o1.z = cvtpk(y[12], y[13]); o1.w = cvtpk(y[14], y[15]);
      *(u32x4*)(YC + row * 1024 + col) = o0; *(u32x4*)(YC + row * 1024 + col + 8) = o1; }
}

constexpr int AT_KP = 144, AT_VP = 136, AT_WAVE = 64 * AT_KP + 64 * AT_VP;
__device__ __forceinline__ void sb_step(clptr Kt, clptr Vt, const bf16x8 (&qf)[4], f32x16& o0, f32x16& o1, float& carry, int lane, bool domask, int kq) {
    const int n31 = lane & 31, hh = lane >> 5;
    const int krow = (n31 & ~12) | ((n31 & 4) << 1) | ((n31 & 8) >> 1);
    f32x16 p[2];
#pragma unroll
    for (int r = 0; r < 16; ++r) { p[0][r] = 0.f; p[1][r] = 0.f; }
#pragma unroll
    for (int ks = 0; ks < 4; ++ks) {
        p[0] = MFMA32(*(const LAS bf16x8*)(Kt + krow * AT_KP + (16 * ks + 8 * hh) * 2), qf[ks], p[0]);
        p[1] = MFMA32(*(const LAS bf16x8*)(Kt + (32 + krow) * AT_KP + (16 * ks + 8 * hh) * 2), qf[ks], p[1]);
    }
    f32x16 om[2];
    float town[4], tpar[4];
#pragma unroll
    for (int u = 0; u < 2; ++u)
#pragma unroll
        for (int a = 0; a < 2; ++a) { float tp = 1.f;
#pragma unroll
            for (int j = 0; j < 8; ++j) { const int r = 8 * a + j;
                const float z = fminf(fmaxf(p[u][r], -60.f), 60.f);
                const float e = fast_exp2(-z); float sg = fast_rcp(1.f + e); float o = e * sg;
                if (domask) { const int kl = 32 * u + 16 * a + 8 * hh + j; if (kl >= kq) { sg = 0.f; o = 1.f; } }
                p[u][r] = sg; om[u][r] = o; tp *= o; }
            town[2 * u + a] = tp; }
#pragma unroll
    for (int i = 0; i < 4; ++i) tpar[i] = __shfl_xor(town[i], 32);
    float suf[5]; suf[4] = 1.f;
#pragma unroll
    for (int i = 3; i >= 0; --i) suf[i] = suf[i + 1] * (town[i] * tpar[i]);
    bf16x8 pf[4];
#pragma unroll
    for (int u = 0; u < 2; ++u)
#pragma unroll
        for (int a = 0; a < 2; ++a) { const int pr = 2 * u + a;
            float R = carry * suf[pr + 1] * (hh == 0 ? tpar[pr] : 1.f);
            float av[8];
#pragma unroll
            for (int j = 7; j >= 0; --j) { av[j] = p[u][8 * a + j] * R; R *= om[u][8 * a + j]; }
            u32x4 w; w.x = cvtpk(av[0], av[1]); w.y = cvtpk(av[2], av[3]); w.z = cvtpk(av[4], av[5]); w.w = cvtpk(av[6], av[7]);
            pf[pr] = __builtin_bit_cast(bf16x8, w); }
    carry *= suf[0];
#pragma unroll
    for (int pr = 0; pr < 4; ++pr) {
        o0 = MFMA32(tr_frag(Vt, AT_VP, 16 * pr, 0, lane), pf[pr], o0);
        o1 = MFMA32(tr_frag(Vt, AT_VP, 16 * pr, 32, lane), pf[pr], o1);
    }
}
__device__ __forceinline__ void attn_prompt_item(const Params& P, lptr lds, int b, int rb, int lane, int wave) {
    const int h = wave, n31 = lane & 31, hh = lane >> 5;
    const bf16_t* SQ = (const bf16_t*)(P.ws + WS_PROJ + 4 * PROJ_STRIDE); const bf16_t* SK = (const bf16_t*)(P.ws + WS_PROJ + 5 * PROJ_STRIDE); const bf16_t* SV = (const bf16_t*)(P.ws + WS_PROJ + 6 * PROJ_STRIDE);
    const size_t rowb = (size_t)b * SEQ; const int q0 = 32 * rb;
    lptr Kt = lds + wave * AT_WAVE; lptr Vt = Kt + 64 * AT_KP;
    bf16x8 qf[4];
#pragma unroll
    for (int ks = 0; ks < 4; ++ks) qf[ks] = *(const bf16x8*)(SQ + (rowb + q0 + n31) * 512 + h * 64 + 16 * ks + 8 * hh);
    f32x16 o0, o1;
#pragma unroll
    for (int r = 0; r < 16; ++r) { o0[r] = 0.f; o1[r] = 0.f; }
    float carry = 1.f;
    const int trow = lane >> 3, tch = lane & 7;
    u32x4 kv[8], vv[8];
    const int jt0 = (q0 + 30) >> 6;
#pragma unroll
    for (int i = 0; i < 8; ++i) { const size_t go = (rowb + 64 * jt0 + 8 * i + trow) * 512 + h * 64 + tch * 8; kv[i] = *(const u32x4*)(SK + go); vv[i] = *(const u32x4*)(SV + go); }
    for (int jt = jt0; jt >= 0; --jt) {
#pragma unroll
        for (int i = 0; i < 8; ++i) { const int row = 8 * i + trow;
            *(LAS u32x4*)(Kt + row * AT_KP + tch * 16) = kv[i];
            *(LAS u32x2*)(Vt + row * AT_VP + tch * 16) = (u32x2){vv[i].x, vv[i].y}; *(LAS u32x2*)(Vt + row * AT_VP + tch * 16 + 8) = (u32x2){vv[i].z, vv[i].w}; }
        if (jt > 0) {
#pragma unroll
            for (int i = 0; i < 8; ++i) { const size_t go = (rowb + 64 * (jt - 1) + 8 * i + trow) * 512 + h * 64 + tch * 8; kv[i] = *(const u32x4*)(SK + go); vv[i] = *(const u32x4*)(SV + go); } }
        sb_step(Kt, Vt, qf, o0, o1, carry, lane, 64 * jt + 63 >= q0, q0 + n31 - 64 * jt);
        if (__all(carry < 5.9604645e-8f)) break;
    }
    float ss = 0.f;
#pragma unroll
    for (int r = 0; r < 16; ++r) ss += o0[r] * o0[r] + o1[r] * o1[r];
    ss += __shfl_xor(ss, 32);
    const size_t row = rowb + q0 + n31;
    LAS float* sx = (LAS float*)(lds + 8 * AT_WAVE);
    if (hh == 0) sx[wave * 32 + n31] = ss;
    __syncthreads();
    float tot = 0.f;
#pragma unroll
    for (int w2 = 0; w2 < 8; ++w2) tot += sx[w2 * 32 + n31];
    const float rstd = rsqrtf(tot * (1.f / 512.f) + EPS);
    bf16_t* yo = (bf16_t*)(P.ws + WS_YCAT) + row * 1024 + 512 + h * 64 + 4 * hh;
#pragma unroll
    for (int g = 0; g < 4; ++g) {
        *(u32x2*)(yo + 8 * g) = (u32x2){cvtpk(o0[4 * g] * rstd, o0[4 * g + 1] * rstd), cvtpk(o0[4 * g + 2] * rstd, o0[4 * g + 3] * rstd)};
        *(u32x2*)(yo + 32 + 8 * g) = (u32x2){cvtpk(o1[4 * g] * rstd, o1[4 * g + 1] * rstd), cvtpk(o1[4 * g + 2] * rstd, o1[4 * g + 3] * rstd)};
    }
}
__device__ __forceinline__ void attn_sample_item(const Params& P, lptr lds, int bh, int tid, int lane, int wave) {
    const int b = bh >> 3, h = bh & 7, n31 = lane & 31, hh = lane >> 5;
    const bf16_t* SQ = (const bf16_t*)(P.ws + WS_PROJ + 4 * PROJ_STRIDE); const bf16_t* SK = (const bf16_t*)(P.ws + WS_PROJ + 5 * PROJ_STRIDE); const bf16_t* SV = (const bf16_t*)(P.ws + WS_PROJ + 6 * PROJ_STRIDE);
    const size_t rows = (size_t)MP + b * 32;
    lptr Kt = lds + wave * AT_WAVE; lptr Vt = Kt + 64 * AT_KP;
    bf16x8 qf[4];
#pragma unroll
    for (int ks = 0; ks < 4; ++ks) qf[ks] = *(const bf16x8*)(SQ + (rows + n31) * 512 + h * 64 + 16 * ks + 8 * hh);
    f32x16 o0, o1;
#pragma unroll
    for (int r = 0; r < 16; ++r) { o0[r] = 0.f; o1[r] = 0.f; }
    float carry = 1.f;
    if (wave == 7) {
        const int trow = lane >> 3, tch = lane & 7;
#pragma unroll
        for (int i = 0; i < 8; ++i) { const int row = 8 * i + trow; u32x4 kv = {0u, 0u, 0u, 0u}, vv = {0u, 0u, 0u, 0u};
            if (row < 32) { const size_t go = (rows + row) * 512 + h * 64 + tch * 8; kv = *(const u32x4*)(SK + go); vv = *(const u32x4*)(SV + go); }
            *(LAS u32x4*)(Kt + row * AT_KP + tch * 16) = kv;
            *(LAS u32x2*)(Vt + row * AT_VP + tch * 16) = (u32x2){vv.x, vv.y}; *(LAS u32x2*)(Vt + row * AT_VP + tch * 16 + 8) = (u32x2){vv.z, vv.w}; }
        sb_step(Kt, Vt, qf, o0, o1, carry, lane, true, n31);
    }
    const float* CK = P.in[I_CK] + (size_t)b * PAST * 512 + h * 64; const float* CV = P.in[I_CV] + (size_t)b * PAST * 512 + h * 64;
    for (int jt = 4 * wave + 3; jt >= 4 * wave; --jt) {
        const int trow = lane >> 4, c4 = lane & 15;
#pragma unroll
        for (int i = 0; i < 16; ++i) { const int row = 4 * i + trow; const size_t go = (size_t)(64 * jt + row) * 512 + c4 * 4;
            const f32x4 kx = *(const f32x4*)(CK + go), vx = *(const f32x4*)(CV + go);
            *(LAS u32x2*)(Kt + row * AT_KP + c4 * 8) = (u32x2){cvtpk(kx.x, kx.y), cvtpk(kx.z, kx.w)};
            *(LAS u32x2*)(Vt + row * AT_VP + c4 * 8) = (u32x2){cvtpk(vx.x, vx.y), cvtpk(vx.z, vx.w)}; }
        sb_step(Kt, Vt, qf, o0, o1, carry, lane, false, 0);
    }
    __syncthreads();
    LAS float* carr = (LAS float*)(lds + 65536);
    if (hh == 0) carr[wave * 32 + n31] = carry;
    __syncthreads();
    float mult = 1.f;
    for (int w2 = wave + 1; w2 < 8; ++w2) mult *= carr[w2 * 32 + n31];
#pragma unroll
    for (int g = 0; g < 4; ++g) {
        *(LAS f32x4*)(lds + (((wave * 8 + g) * 64 + lane) * 16)) = (f32x4){o0[4 * g] * mult, o0[4 * g + 1] * mult, o0[4 * g + 2] * mult, o0[4 * g + 3] * mult};
        *(LAS f32x4*)(lds + (((wave * 8 + 4 + g) * 64 + lane) * 16)) = (f32x4){o1[4 * g] * mult, o1[4 * g + 1] * mult, o1[4 * g + 2] * mult, o1[4 * g + 3] * mult};
    }
    __syncthreads();
    { const int q = tid >> 4, part = tid & 15; const int slot = (part >> 3) * 4 + ((part & 7) >> 1), ln = q + 32 * (part & 1);
      f32x4 v = {0.f, 0.f, 0.f, 0.f};
#pragma unroll
      for (int w2 = 0; w2 < 8; ++w2) v = v + *(const LAS f32x4*)(lds + (((w2 * 8 + slot) * 64 + ln) * 16));
      float ss = (v.x * v.x + v.y * v.y) + (v.z * v.z + v.w * v.w);
      ss += __shfl_xor(ss, 1); ss += __shfl_xor(ss, 2); ss += __shfl_xor(ss, 4); ss += __shfl_xor(ss, 8);
      const size_t row = rows + q;
      if (part == 0) ((float*)(P.ws + WS_SSQ))[row * 8 + h] = ss;
      *(u32x2*)((bf16_t*)(P.ws + WS_YCAT) + row * 1024 + 512 + h * 64 + part * 4) = (u32x2){cvtpk(v.x, v.y), cvtpk(v.z, v.w)}; }
    __syncthreads();
}
#ifndef M1NC
#define M1NC 2
#endif
constexpr int NQ_G1S = 224, NQ_AT = 1024, NQ_M1 = 2048 / M1NC, NQ_TOTAL = NQ_G1S + NQ_AT + NQ_M1;
template <class EpiS>
__device__ __forceinline__ void phase_mixers(const Params& P, lptr lds, int tid_in, int wave, const EpiS& Es) {
    unsigned* ctr = (unsigned*)(P.ws + WS_CTL);
    int nextitem = 0; if (tid_in == 0) nextitem = (int)atomicAdd(ctr, 1u);
    for (;;) {
        __syncthreads();
        if (tid_in == 0) *(LAS int*)(lds + QOFF) = nextitem;
        __syncthreads();
        int item = *(const LAS int*)(lds + QOFF);
        if (tid_in == 0 && item < NQ_TOTAL) nextitem = (int)atomicAdd(ctr, 1u);
        int tid = tid_in; asm volatile("" : "+v"(tid));
        const int lane = tid & 63;
        if (item >= NQ_TOTAL) break;
        if (item < NQ_G1S) { small_tile<1024, false>((const bf16_t*)(P.ws + WS_H) + (size_t)MP * 1024, (const bf16_t*)(P.ws + WS_W1T), Es, nullptr, lds, item, tid, lane, wave); continue; }
        item -= NQ_G1S;
        if (item < NQ_AT) { attn_prompt_item(P, lds, item & 7, 127 - (item >> 3), lane, wave); continue; }
        item -= NQ_AT;
        ml1_pair<M1NC>(P, lds, item, tid, lane, wave);
    }
}
__device__ __forceinline__ void phase_ml2(const Params& P, lptr lds, int tid_in, int wave) {
    int tid = tid_in; asm volatile("" : "+v"(tid));
    if (blockIdx.x < 128) ml2_scan(P, lds, tid);
    else if (blockIdx.x < 160) { }
    else if (blockIdx.x < 192) mlstm_item(P, lds, blockIdx.x - 160, true, tid, tid & 63, wave);
    else attn_sample_item(P, lds, blockIdx.x - 192, tid, tid & 63, wave);
}
template <class EpiS>
__device__ __forceinline__ void phase_ml3(const Params& P, lptr lds, int tid_in, int wave, const EpiS& Es) {
    if (blockIdx.x >= 192) { int tid = tid_in; asm volatile("" : "+v"(tid));
        small_tile<1024, true>((const bf16_t*)(P.ws + WS_YCAT) + (size_t)MP * 1024, (const bf16_t*)(P.ws + WS_W2T), Es, (const float*)(P.ws + WS_SSQ), lds, blockIdx.x - 192, tid, tid & 63, wave); }
#ifdef DBL_M3
    for (int rep = 0; rep < 2; ++rep)
#endif
    { int tid = tid_in; asm volatile("" : "+v"(tid));
      Ml3In cur, nxt; ml3_load(P, blockIdx.x, tid, tid & 63, wave, cur);
#pragma unroll 1
      for (int item = blockIdx.x; item < 2048; item += gridDim.x) {
          const int nitem = item + gridDim.x;
          if (nitem < 2048) ml3_load(P, nitem, tid, tid & 63, wave, nxt);
          ml3_item(P, lds, item, cur, tid, tid & 63, wave);
          cur = nxt;
      } }
}

__global__ void __launch_bounds__(512, 2) fwd(Params P) {
    extern __shared__ __attribute__((aligned(16))) unsigned char lds_raw[];
    lptr lds = (lptr)lds_raw;
    cg::grid_group grid = cg::this_grid();
    int tid = threadIdx.x, lane = tid & 63; const int wave = __builtin_amdgcn_readfirstlane(tid >> 6);
#define FRESH_TID() do { asm volatile("" : "+v"(tid)); lane = tid & 63; } while (0)
    const int gw = blockIdx.x * 8 + wave, NGW = gridDim.x * 8;
    unsigned char* ws = P.ws;
    const float* MOD = (const float*)(ws + WS_MOD);
    bf16_t* H = (bf16_t*)(ws + WS_H); bf16_t* PROJ = (bf16_t*)(ws + WS_PROJ); bf16_t* YC = (bf16_t*)(ws + WS_YCAT); bf16_t* ACT = (bf16_t*)(ws + WS_ACT);

#ifndef G_ALIGN
#define G_ALIGN true
#endif
#ifndef G_SP2
#define G_SP2 true
#endif
#ifndef PH
#define PH 0xFFFF
#endif
    if (tid == 0) { *(LAS unsigned*)(lds + LDS_BYTES - 32) = 0u; *(LAS unsigned*)(lds + LDS_BYTES - 28) = 0u; }
    __syncthreads();
    const XcdBarrier bar = xcd_barrier_post((unsigned*)(ws + WS_CTL) + 1024, (volatile LAS unsigned*)(lds + LDS_BYTES - 32));
    if (P.out == nullptr) grid.sync();
    phase0(P, lds, tid, lane, wave);
    __syncthreads();
    if (blockIdx.x >= 192) phase_weights(P, lds, lane, wave, 0, 4096, (blockIdx.x - 192) * 8 + wave, 64 * 8);
    else phase_weights(P, lds, lane, wave, 4096, 16 * 112 + 16 * 32 + 16 * 176 + 44 * 32, blockIdx.x * 8 + wave, 192 * 8);
#ifdef DBL_P0
    __syncthreads(); phase0(P, lds, tid, lane, wave);
#endif
    xcd_barrier(bar);
    FRESH_TID();
    phase1(P, lds, tid, lane, wave);
#ifdef DBL_P1
    __syncthreads(); phase1(P, lds, tid, lane, wave);
#endif
#ifdef DBL_P1NG
    __syncthreads(); phase1_nogates(P, lds, tid, lane, wave);
#endif
    xcd_barrier(bar);
    FRESH_TID();
    {
        EpiProj E{PROJ, P.out + O_PK, P.out + O_PV, P.in[I_SQW], P.in[I_SKW], 0};
        pg8::Gemm g{H, (const bf16_t*)(ws + WS_W1T), MP, NPROJ, 1024}; pg8::StaticOrder S; S.init(MP, NPROJ, gridDim.x, (int)blockIdx.x);
        pg8::gemm_phase<EpiProj, pg8::StaticOrder, G_ALIGN, G_SP2>(lds, g, S, E);
#ifdef DBL_G
        pg8::gemm_phase<EpiProj, pg8::StaticOrder, G_ALIGN, G_SP2>(lds, g, S, E);
#endif
    }
    xcd_barrier(bar);
    FRESH_TID();
    {
        EpiProj Es{PROJ, P.out + O_SK, P.out + O_SV, P.in[I_SQW], P.in[I_SKW], MP};
        phase_mixers(P, lds, tid, wave, Es);
    }
    xcd_barrier(bar);
    FRESH_TID();
    phase_ml2(P, lds, tid, wave);
#ifdef DBL_M2
    __syncthreads(); phase_ml2(P, lds, tid, wave);
#endif
    xcd_barrier(bar);
    FRESH_TID();
    {
        EpiRes<0> Es{P.in[I_XS], (bf16_t*)(ws + WS_X1B) + (size_t)MP * 1024, MOD + 8 * 6144 + 2048, 5};
        phase_ml3(P, lds, tid, wave, Es);
    }
#ifdef XSYNC
    for (int i = 0; i < XSYNC; ++i) xcd_barrier(bar);
#endif
    xcd_barrier(bar);
    FRESH_TID();
    {
        sample_h2_row(P, lds, tid, lane, wave);
        EpiRes<0> E{P.in[I_XP], ws + WS_X1B, MOD + 2048, 12};
        pg8::Gemm g{YC, (const bf16_t*)(ws + WS_W2T), MP, 1024, 1024}; pg8::StaticOrder S; S.init(MP, 1024, gridDim.x, (int)blockIdx.x);
        pg8::gemm_phase<EpiRes<0>, pg8::StaticOrder, G_ALIGN, G_SP2>(lds, g, S, E);
    }
    xcd_barrier(bar);
    FRESH_TID();
    {
        phase5(P, lds, tid, lane, wave);
#ifdef DBL_P5
        phase5(P, lds, tid, lane, wave);
#endif
        EpiFFNs Es{ACT, P.out + O_SF, P.in[I_SFC], P.in[I_WCONV], P.in[I_BCONV]};
        for (int t = blockIdx.x; t < 352; t += gridDim.x) small_tile<1024, false>(H + (size_t)MP * 1024, (const bf16_t*)(ws + WS_W3T), Es, nullptr, lds, t, tid, lane, wave);
    }
    xcd_barrier(bar);
    FRESH_TID();
    {
        EpiFFN E{ACT, (float*)(ws + WS_UEDGE), P.out + O_PF, P.in[I_WCONV], P.in[I_BCONV]};
        pg8::Gemm g{H, (const bf16_t*)(ws + WS_W3T), MP, FF2, 1024}; pg8::StaticOrder S; S.init(MP, FF2, gridDim.x, (int)blockIdx.x);
        pg8::gemm_phase<EpiFFN, pg8::StaticOrder, true, G_SP2>(lds, g, S, E);
#ifdef DBL_G
        pg8::gemm_phase<EpiFFN, pg8::StaticOrder, true, G_SP2>(lds, g, S, E);
#endif
    }
    xcd_barrier(bar);
    FRESH_TID();
    {
        phase_fix(P, tid);
        EpiRes<1> Es{(const bf16_t*)(ws + WS_X1B) + (size_t)MP * 1024, P.out + O_YS, MOD + 8 * 6144 + 5120, 5};
        if (blockIdx.x < 64) small_tile<FF, false>(ACT + (size_t)MP * FF, (const bf16_t*)(ws + WS_W4T), Es, nullptr, lds, blockIdx.x, tid, lane, wave);
    }
    xcd_barrier(bar);
    FRESH_TID();
    {
        EpiRes<1> E{ws + WS_X1B, P.out + O_YP, MOD + 5120, 12};
        pg8::Gemm g{ACT, (const bf16_t*)(ws + WS_W4T), MP, 1024, FF}; pg8::StaticOrder S; S.init(MP, 1024, gridDim.x, (int)blockIdx.x);
        pg8::gemm_phase<EpiRes<1>, pg8::StaticOrder, G_ALIGN, G_SP2>(lds, g, S, E);
    }

#ifdef DIAG
    xcd_barrier(bar);
    {
        const size_t offs[15] = {O_YP, O_YS, O_PC, O_PN, O_PM, O_PK, O_PV, O_PF, O_SC, O_SN, O_SM, O_SK, O_SV, O_SF, O_END};
        for (int o = 0; o < 14; ++o) if ((DIAG >> o) & 1) for (size_t i = offs[o] + (size_t)blockIdx.x * 512 + tid; i < offs[o + 1]; i += (size_t)gridDim.x * 512) P.out[i] *= 1.2f;
    }
#endif
}

extern "C" void kernel_launch(void* const* d_in, const int* in_sizes, int n_in, void* d_out, int out_size, void* d_ws, size_t ws_size, hipStream_t stream) {
    static int grid_blocks = 0;
    if (!grid_blocks) {
        int dev = 0, cus = 0, per_cu = 0;
        (void)hipGetDevice(&dev);
        (void)hipDeviceGetAttribute(&cus, hipDeviceAttributeMultiprocessorCount, dev);
        (void)hipFuncSetAttribute((const void*)fwd, hipFuncAttributeMaxDynamicSharedMemorySize, LDS_BYTES);
        (void)hipOccupancyMaxActiveBlocksPerMultiprocessor(&per_cu, (const void*)fwd, 512, LDS_BYTES);
        grid_blocks = cus;
        if (n_in != 26 || out_size != (int)O_END || ws_size < WS_END2 || cus != 256 || per_cu < 1) {
            fprintf(stderr, "kernel_launch: unexpected geometry: n_in %d out %d ws %zu cus %d per_cu %d\n", n_in, out_size, ws_size, cus, per_cu);
            if (n_in != 26 || out_size != (int)O_END || ws_size < WS_END2 || cus != 256) grid_blocks = -1;
        }
    }
    if (grid_blocks < 0) return;
    if (hipMemsetAsync((char*)d_ws + WS_CTL, 0, WS_MOD + 16 * 6144 * 4, stream) != hipSuccess) { fprintf(stderr, "kernel_launch: memset of the control words failed\n"); return; }
    Params p{};
    for (int i = 0; i < 26; ++i) p.in[i] = (const float*)d_in[i];
    p.out = (float*)d_out; p.ws = (unsigned char*)d_ws;
    void* args[] = {&p};
    hipError_t e = hipLaunchCooperativeKernel((const void*)fwd, dim3(grid_blocks), dim3(512), args, LDS_BYTES, stream);
    if (e != hipSuccess) fprintf(stderr, "cooperative launch failed: %s (grid %d)\n", hipGetErrorString(e), grid_blocks);
}
```

```cpp
#include <hip/hip_runtime.h>
#include <hip/hip_cooperative_groups.h>
#include <cstdio>
#include <cstdint>
namespace cg = cooperative_groups;

#define LAS __attribute__((address_space(3)))
typedef unsigned short bf16_t;
typedef short bf16x8 __attribute__((ext_vector_type(8)));
typedef short s16x4 __attribute__((ext_vector_type(4)));
typedef float f32x2 __attribute__((ext_vector_type(2)));
typedef float f32x4 __attribute__((ext_vector_type(4)));
typedef float f32x16 __attribute__((ext_vector_type(16)));
typedef unsigned u32x2 __attribute__((ext_vector_type(2)));
typedef unsigned u32x4 __attribute__((ext_vector_type(4)));
typedef __bf16 bf16x2_t __attribute__((ext_vector_type(2)));
typedef LAS unsigned char* lptr;
typedef const LAS unsigned char* clptr;

constexpr int DM = 1024, SEQ = 4096, NB = 8, MP = NB * SEQ, DEC = 32, MS = NB * DEC, MT = MP + MS, PAST = 2048;
constexpr int DIN = 3592, NPROJ = 3584, FF = 2816, FF2 = 5632;
constexpr float EPS = 1e-6f;
constexpr float LOG2E = 1.4426950408889634f;
constexpr size_t O_YP = 0, O_YS = 33554432, O_PC = 33816576, O_PN = 34340864, O_PM = 34344960, O_PK = 34344992, O_PV = 51122208,
                 O_PF = 67899424, O_SC = 67989536, O_SN = 68513824, O_SM = 68517920, O_SK = 68517952, O_SV = 68649024, O_SF = 68780096, O_END = 68870208;
constexpr size_t MiB = 1u << 20;
constexpr size_t WS_CTL = 0, WS_MODP = 1 * MiB  , WS_MOD = 65536  , WS_GATES = 8 * MiB, WS_SSQ = 10 * MiB, WS_UEDGE = 12 * MiB,
                 WS_W1T = 24 * MiB, WS_W2T = 31 * MiB, WS_W3T = 33 * MiB, WS_W4T = 44 * MiB, WS_H = 52 * MiB, WS_PROJ = 120 * MiB,
                 PROJ_STRIDE = 33 * MiB, WS_YCAT = 352 * MiB, WS_ACT = 120 * MiB, WS_END = 420 * MiB;
constexpr size_t WS_X1B = 424 * MiB;
constexpr int LDS_BYTES = 147456;
constexpr int QOFF = LDS_BYTES - 64;

struct Params { const float* in[26]; float* out; unsigned char* ws; };
enum { I_XP = 0, I_XS, I_CP, I_CS, I_STC, I_STN, I_STM, I_CK, I_CV, I_SFC, I_WADA, I_BADA, I_N1W, I_WIN, I_BIG, I_BFG, I_MLW, I_SQW, I_SKW, I_SOW,
       I_WOUT, I_N2W, I_WUP, I_WCONV, I_BCONV, I_WDOWN };

__device__ __forceinline__ unsigned cvtpk(float lo, float hi) { f32x2 v = {lo, hi}; bf16x2_t b = __builtin_convertvector(v, bf16x2_t); return __builtin_bit_cast(unsigned, b); }
__device__ __forceinline__ float bf2f(unsigned short x) { return __uint_as_float((unsigned)x << 16); }
__device__ __forceinline__ float bflo(unsigned w) { return __uint_as_float(w << 16); }
__device__ __forceinline__ float bfhi(unsigned w) { return __uint_as_float(w & 0xffff0000u); }
__device__ __forceinline__ unsigned short f2bf(float f) { return (unsigned short)(cvtpk(f, 0.f) & 0xffffu); }
__device__ __forceinline__ float wave_sum(float v) {
#pragma unroll
    for (int o = 1; o < 64; o <<= 1) v += __shfl_xor(v, o);
    return v;
}
__device__ __forceinline__ float fast_exp2(float x) { return __builtin_amdgcn_exp2f(x); }
__device__ __forceinline__ float fast_rcp(float x) { return __builtin_amdgcn_rcpf(x); }
__device__ __forceinline__ float sigmoidf_(float x) { return fast_rcp(1.f + fast_exp2(-x * LOG2E)); }
__device__ __forceinline__ int crow(int r, int hi) { return (r & 3) + 8 * (r >> 2) + 4 * hi; }
typedef short v4i16_t __attribute__((ext_vector_type(4)));
__device__ __forceinline__ s16x4 tr_read(clptr p) { return __builtin_bit_cast(s16x4, __builtin_amdgcn_ds_read_tr16_b64_v4i16((LAS v4i16_t*)p)); }
__device__ __forceinline__ bf16x8 tr_frag(clptr base, int P, int R0, int C0, int lane) {
    const int h = lane >> 5, blk = (lane >> 4) & 1, q = (lane & 15) >> 2, p = lane & 3;
    clptr a = base + (R0 + 8 * h + q) * P + (C0 + 16 * blk + 4 * p) * 2;
    const s16x4 lo = tr_read(a), hi = tr_read(a + 4 * P);
    return (bf16x8){lo[0], lo[1], lo[2], lo[3], hi[0], hi[1], hi[2], hi[3]};
}
__device__ __forceinline__ bf16x8 row_frag(clptr base, int P, int R0, int K0, int lane) {
    return *(const LAS bf16x8*)(base + (R0 + (lane & 31)) * P + (K0 + 8 * (lane >> 5)) * 2);
}
#define MFMA32(a, b, c) __builtin_amdgcn_mfma_f32_32x32x16_bf16((a), (b), (c), 0, 0, 0)
#define MFMA16(a, b, c) __builtin_amdgcn_mfma_f32_16x16x32_bf16((a), (b), (c), 0, 0, 0)

namespace pg8 {
#define PG8_LAS __attribute__((address_space(3)))
typedef unsigned short bf16_t;
typedef short bf16x8 __attribute__((ext_vector_type(8)));
typedef float f32x4 __attribute__((ext_vector_type(4)));
typedef unsigned u32x4 __attribute__((ext_vector_type(4)));
constexpr int BM = 256, BK = 64, HALF = 128, HTB = HALF * BK * 2  , STAGE_BYTES = 8 * HTB, NXCD = 8, WGM = 8;

__host__ __device__ __forceinline__ int lds_byte(int r, int c) { const int st = (r >> 4) * 2 + (c >> 5), rr = r & 15, cc = c & 31, ob = rr * 64 + cc * 2; return st * 1024 + (ob ^ (((ob >> 9) & 1) << 5)); }
__host__ __device__ __forceinline__ void stage_rc(int b, int& R, int& C) { const int st = b / 1024, sb = b % 1024, swz = sb ^ (((sb >> 9) & 1) << 5); R = (st >> 1) * 16 + swz / 64; C = (st & 1) * 32 + (swz % 64) / 2; }
__host__ __device__ __forceinline__ int perm32(int rho) { const int n = rho >> 4, i = rho & 15; return 8 * (i >> 2) + 4 * n + (i & 3); }

struct Unit { int pm, pn; };
struct Gemm { const bf16_t* A; const bf16_t* Bt; int M, N, K; };

struct StaticOrder {
    int nM, nN, nwg, G, c;
    __host__ __device__ void init(int M, int N, int G_, int c_) { nM = M / BM; nN = N / BM; nwg = nM * nN; G = G_; c = c_; }
    __host__ __device__ bool next(int i, Unit& u) const {
        const long L = (long)i * G + c; if (L >= nwg) return false;
        int wgid = (int)L; { const int q = nwg / NXCD, r = nwg % NXCD, xcd = wgid % NXCD, off = wgid / NXCD; wgid = (xcd < r ? xcd * (q + 1) : r * (q + 1) + (xcd - r) * q) + off; }
        const int nig = WGM * nN, gid = wgid / nig, fm = gid * WGM, gsz = (nM - fm) < WGM ? (nM - fm) : WGM;
        u.pm = fm + ((wgid % nig) % gsz); u.pn = (wgid % nig) / gsz; return true;
    }
    __device__ __forceinline__ void a_ready(const Unit&) const {}
    __device__ __forceinline__ void done(const Unit&) const {}
};

template <class Epi, class Sched, bool ALIGN_EPI = false, bool SP2 = false>
__device__ __forceinline__ void gemm_phase(PG8_LAS unsigned char* lds, const Gemm g, const Sched& S, const Epi& E) {
    int tid_o = threadIdx.x; asm volatile("" : "+v"(tid_o));
    const int tid = tid_o, wid = __builtin_amdgcn_readfirstlane(tid >> 6), lane = tid & 63, wr = wid >> 2, wc = wid & 3, fr = lane & 15, fq = lane >> 4;
    const int K = g.K, nt = K / BK;
    unsigned voffA[2], voffB[2];
#pragma unroll
    for (int i = 0; i < 2; ++i) { int R, C; stage_rc(tid * 16 + i * 8192, R, C); const int Rb = Epi::PERM ? ((R & ~31) + perm32(R & 31)) : R;
        voffA[i] = (unsigned)(R * K + C) * 2u; voffB[i] = (unsigned)(Rb * K + C) * 2u; }
    const size_t kstep = (size_t)(BK * 2);
    const size_t hstep = (size_t)HALF * K * 2;
    const size_t tstep = 2 * hstep;
    const unsigned ldsw = (unsigned)wid * 1024u;
    const int aoff = lds_byte(wr * 64 + fr, fq * 8), boff = lds_byte(wc * 32 + fr, fq * 8);
#define PG8_SA(b, h) (((b) * 2 + (h)) * HTB)
#define PG8_SB(b, h) ((4 + (b) * 2 + (h)) * HTB)
#define PG8_STAGE(bufoff, gbase, voff) do { _Pragma("unroll") for (int _i = 0; _i < 2; ++_i) \
        __builtin_amdgcn_global_load_lds((const unsigned*)((const char*)(gbase) + (voff)[_i]), (PG8_LAS unsigned*)(lds + (bufoff) + ldsw + _i * 8192), 16, 0, 0); } while (0)
#define PG8_LDA(dst, b, h) do { _Pragma("unroll") for (int m = 0; m < 4; ++m) _Pragma("unroll") for (int k = 0; k < 2; ++k) dst[m][k] = *(const PG8_LAS bf16x8*)(lds + PG8_SA(b, h) + aoff + m * 2048 + k * 1024); } while (0)
#define PG8_LDB(dst, b, h) do { _Pragma("unroll") for (int n = 0; n < 2; ++n) _Pragma("unroll") for (int k = 0; k < 2; ++k) dst[n][k] = *(const PG8_LAS bf16x8*)(lds + PG8_SB(b, h) + boff + n * 2048 + k * 1024); } while (0)
#define PG8_MMA(ai, bj, At, Bt) do { __builtin_amdgcn_s_setprio(1); _Pragma("unroll") for (int m = 0; m < 4; ++m) _Pragma("unroll") for (int n = 0; n < 2; ++n) _Pragma("unroll") for (int k = 0; k < 2; ++k) \
        acc[ai][bj][m][n] = __builtin_amdgcn_mfma_f32_16x16x32_bf16(Bt[n][k], At[m][k], acc[ai][bj][m][n], 0, 0, 0); __builtin_amdgcn_s_setprio(0); } while (0)
#define PG8_WAIT_V(n) asm volatile("s_waitcnt vmcnt(" #n ")" ::: "memory")
#define PG8_WAIT_L(n) asm volatile("s_waitcnt lgkmcnt(" #n ")" ::: "memory")
#define PG8_BAR __builtin_amdgcn_s_barrier()
#define PG8_SCHED __builtin_amdgcn_sched_barrier(0)
    Unit cur, nxt; int ui = 0;
    if (!S.next(0, cur)) return;
    f32x4 acc[2][2][4][2];
#pragma unroll
    for (int a = 0; a < 2; ++a)
#pragma unroll
        for (int b = 0; b < 2; ++b)
#pragma unroll
            for (int m = 0; m < 4; ++m)
#pragma unroll
                for (int n = 0; n < 2; ++n) acc[a][b][m][n] = (f32x4){0.f, 0.f, 0.f, 0.f};
    bf16x8 At[4][2], B0[2][2], B1[2][2];
    const char* cA = (const char*)g.A + (size_t)cur.pm * tstep; const char* cB = (const char*)g.Bt + (size_t)cur.pn * tstep;
    S.a_ready(cur);
    if constexpr (SP2) {
        PG8_STAGE(PG8_SB(0, 0), cB, voffB); PG8_STAGE(PG8_SB(0, 1), cB + hstep, voffB); PG8_STAGE(PG8_SA(0, 0), cA, voffA); PG8_STAGE(PG8_SA(0, 1), cA + hstep, voffA);
        if (wr == 1) PG8_BAR;
        PG8_WAIT_V(2); PG8_BAR;
        PG8_STAGE(PG8_SB(1, 0), cB + kstep, voffB); PG8_STAGE(PG8_SA(1, 0), cA + kstep, voffA); PG8_STAGE(PG8_SB(1, 1), cB + hstep + kstep, voffB);
        PG8_WAIT_V(6); PG8_BAR;
    } else {
        PG8_STAGE(PG8_SB(0, 0), cB, voffB); PG8_STAGE(PG8_SA(0, 0), cA, voffA); PG8_STAGE(PG8_SB(0, 1), cB + hstep, voffB); PG8_STAGE(PG8_SA(0, 1), cA + hstep, voffA);
        if (wr == 1) PG8_BAR;
        PG8_WAIT_V(4); PG8_BAR;
        PG8_STAGE(PG8_SB(1, 0), cB + kstep, voffB); PG8_STAGE(PG8_SA(1, 0), cA + kstep, voffA); PG8_STAGE(PG8_SB(1, 1), cB + hstep + kstep, voffB);
        PG8_WAIT_V(6); PG8_BAR;
    }
    for (;;) {
        const bool has_next = S.next(ui + 1, nxt);
        const char* nA = has_next ? (const char*)g.A + (size_t)nxt.pm * tstep : cA; const char* nB = has_next ? (const char*)g.Bt + (size_t)nxt.pn * tstep : cB;
        for (int t = 0; t < nt; t += 2) {
            const bool last = (t == nt - 2);
            const char* a1 = cA + (size_t)(t + 1) * kstep;
            const char* a2 = last ? nA : cA + (size_t)(t + 2) * kstep; const char* b2 = last ? nB : cB + (size_t)(t + 2) * kstep;
            const char* a3 = a2 + kstep; const char* b3 = b2 + kstep;
            if (last && has_next) S.a_ready(nxt);
            if constexpr (SP2) {
            PG8_LDB(B0, 0, 0); PG8_LDB(B1, 0, 1); PG8_SCHED; PG8_LDA(At, 0, 0); PG8_STAGE(PG8_SA(1, 1), a1 + hstep, voffA);
            PG8_WAIT_V(8); PG8_WAIT_L(0); PG8_BAR; PG8_MMA(0, 0, At, B0); PG8_MMA(0, 1, At, B1); PG8_BAR; PG8_SCHED;
            PG8_LDA(At, 0, 1); PG8_STAGE(PG8_SB(0, 0), b2, voffB); PG8_STAGE(PG8_SB(0, 1), b2 + hstep, voffB); PG8_STAGE(PG8_SA(0, 0), a2, voffA);
            PG8_WAIT_V(8); PG8_WAIT_L(0); PG8_BAR; PG8_MMA(1, 0, At, B0); PG8_MMA(1, 1, At, B1); PG8_BAR; PG8_SCHED;
            PG8_LDB(B0, 1, 0); PG8_LDB(B1, 1, 1); PG8_SCHED; PG8_LDA(At, 1, 0); PG8_STAGE(PG8_SA(0, 1), a2 + hstep, voffA);
            PG8_WAIT_V(8); PG8_WAIT_L(0); PG8_BAR; PG8_MMA(0, 0, At, B0); PG8_MMA(0, 1, At, B1); PG8_BAR; PG8_SCHED;
            PG8_LDA(At, 1, 1); PG8_STAGE(PG8_SB(1, 0), b3, voffB); PG8_STAGE(PG8_SB(1, 1), b3 + hstep, voffB); PG8_STAGE(PG8_SA(1, 0), a3, voffA);
            PG8_WAIT_V(8); PG8_WAIT_L(0); PG8_BAR; PG8_MMA(1, 0, At, B0); PG8_MMA(1, 1, At, B1); PG8_BAR; PG8_SCHED;
            } else {
            PG8_LDB(B0, 0, 0); PG8_SCHED; PG8_LDA(At, 0, 0); PG8_STAGE(PG8_SA(1, 1), a1 + hstep, voffA);
            PG8_WAIT_L(8); PG8_BAR; PG8_WAIT_L(0); PG8_MMA(0, 0, At, B0); PG8_BAR; PG8_SCHED;
            PG8_LDB(B1, 0, 1); PG8_STAGE(PG8_SB(0, 0), b2, voffB);
            PG8_BAR; PG8_WAIT_L(0); PG8_MMA(0, 1, At, B1); PG8_BAR;
            PG8_LDA(At, 0, 1); PG8_STAGE(PG8_SA(0, 0), a2, voffA);
            PG8_BAR; PG8_WAIT_L(0); PG8_MMA(1, 0, At, B0); PG8_BAR; PG8_SCHED;
            PG8_STAGE(PG8_SB(0, 1), b2 + hstep, voffB);
            PG8_WAIT_V(6); PG8_BAR; PG8_MMA(1, 1, At, B1); PG8_BAR;
            PG8_LDB(B0, 1, 0); PG8_SCHED; PG8_LDA(At, 1, 0); PG8_STAGE(PG8_SA(0, 1), a2 + hstep, voffA);
            PG8_WAIT_L(8); PG8_BAR; PG8_WAIT_L(0); PG8_MMA(0, 0, At, B0); PG8_BAR; PG8_SCHED;
            PG8_LDB(B1, 1, 1); PG8_STAGE(PG8_SB(1, 0), b3, voffB);
            PG8_BAR; PG8_WAIT_L(0); PG8_MMA(0, 1, At, B1); PG8_BAR;
            PG8_LDA(At, 1, 1); PG8_STAGE(PG8_SA(1, 0), a3, voffA);
            PG8_BAR; PG8_WAIT_L(0); PG8_MMA(1, 0, At, B0); PG8_BAR; PG8_SCHED;
            PG8_STAGE(PG8_SB(1, 1), b3 + hstep, voffB);
            PG8_WAIT_V(6); PG8_BAR; PG8_MMA(1, 1, At, B1); PG8_BAR;
            }
        }
        if constexpr (ALIGN_EPI) { if (wr == 0) PG8_BAR; }
        if constexpr (!Epi::AFTER_DRAIN) { E(acc, cur, wr, wc, fr, fq, lds); S.done(cur); }
        if (!has_next) break;
#pragma unroll
        for (int a = 0; a < 2; ++a)
#pragma unroll
            for (int b = 0; b < 2; ++b)
#pragma unroll
                for (int m = 0; m < 4; ++m)
#pragma unroll
                    for (int n = 0; n < 2; ++n) acc[a][b][m][n] = (f32x4){0.f, 0.f, 0.f, 0.f};
        cur = nxt; cA = nA; cB = nB; ++ui;
        if constexpr (ALIGN_EPI) { if (wr == 1) PG8_BAR; }
    }
    PG8_WAIT_V(0);
    if constexpr (!ALIGN_EPI) { if (wr == 0) PG8_BAR; }
    PG8_BAR;
    if constexpr (Epi::AFTER_DRAIN) { E.fused(acc, cur, wr, wc, fr, fq, lds, wid, lane); S.done(cur); }
#undef PG8_SA
#undef PG8_SB
#undef PG8_STAGE
#undef PG8_LDA
#undef PG8_LDB
#undef PG8_MMA
#undef PG8_WAIT_V
#undef PG8_WAIT_L
#undef PG8_BAR
#undef PG8_SCHED
}
}

__device__ __forceinline__ u32x4 pack8(const f32x4& v0, const f32x4& v1) { u32x4 w; w.x = cvtpk(v0[0], v0[1]); w.y = cvtpk(v0[2], v0[3]); w.z = cvtpk(v1[0], v1[1]); w.w = cvtpk(v1[2], v1[3]); return w; }

struct EpiProj {
    static constexpr bool PERM = true, AFTER_DRAIN = false;
    bf16_t* proj; float* outK; float* outV; const float* qw; const float* kw; int rowoff;
    __device__ __forceinline__ void sub(const f32x4 (&a)[2][4][2], int pn, int rloc0, int wc, int fr, int fq) const {
        const int kind = pn >> 1, half = pn & 1;
        const int c8 = 256 * half + 64 * wc + 8 * fq;
        bf16_t* ob = proj + (size_t)kind * (PROJ_STRIDE / 2);
        if (kind < 4) {
#pragma unroll
            for (int m = 0; m < 4; ++m) { const size_t row = (size_t)(rowoff + rloc0 + 16 * m + fr);
#pragma unroll
                for (int bj = 0; bj < 2; ++bj) { f32x4 v0 = a[bj][m][0], v1 = a[bj][m][1];
                    if (kind == 1) { v0 = v0 * 0.08838834764831845f; v1 = v1 * 0.08838834764831845f; }
                    if (kind == 3) {
#pragma unroll
                        for (int e = 0; e < 4; ++e) { v0[e] = sigmoidf_(v0[e]); v1[e] = sigmoidf_(v1[e]); } }
                    *(u32x4*)(ob + row * 512 + c8 + 32 * bj) = pack8(v0, v1); } }
        } else if (kind < 6) {
            const float* w = kind == 4 ? qw : kw; const float osc = kind == 4 ? 0.125f * LOG2E : 1.f;
            f32x4 wv[2][2];
#pragma unroll
            for (int bj = 0; bj < 2; ++bj)
#pragma unroll
                for (int n = 0; n < 2; ++n) wv[bj][n] = *(const f32x4*)(w + 32 * bj + 8 * fq + 4 * n);
#pragma unroll
            for (int m = 0; m < 4; ++m) { const int rl = rloc0 + 16 * m + fr; float ss = 0.f;
#pragma unroll
                for (int bj = 0; bj < 2; ++bj)
#pragma unroll
                    for (int n = 0; n < 2; ++n) { const f32x4 x = a[bj][m][n]; ss += (x[0] * x[0] + x[1] * x[1]) + (x[2] * x[2] + x[3] * x[3]); }
                ss += __shfl_xor(ss, 16); ss += __shfl_xor(ss, 32);
                const float rstd = rsqrtf(ss * (1.f / 64.f) + EPS);
#pragma unroll
                for (int bj = 0; bj < 2; ++bj) { f32x4 v0 = a[bj][m][0] * rstd * wv[bj][0], v1 = a[bj][m][1] * rstd * wv[bj][1];
                    if (kind == 5) { float* o = outK + (size_t)rl * 512 + c8 + 32 * bj; __builtin_nontemporal_store(v0, (f32x4*)o); __builtin_nontemporal_store(v1, (f32x4*)(o + 4)); }
                    v0 = v0 * osc; v1 = v1 * osc;
                    *(u32x4*)(ob + (size_t)(rowoff + rl) * 512 + c8 + 32 * bj) = pack8(v0, v1); } }
        } else {
#pragma unroll
            for (int m = 0; m < 4; ++m) { const int rl = rloc0 + 16 * m + fr;
#pragma unroll
                for (int bj = 0; bj < 2; ++bj) { const f32x4 v0 = a[bj][m][0], v1 = a[bj][m][1];
                    float* o = outV + (size_t)rl * 512 + c8 + 32 * bj; __builtin_nontemporal_store(v0, (f32x4*)o); __builtin_nontemporal_store(v1, (f32x4*)(o + 4));
                    *(u32x4*)(ob + (size_t)(rowoff + rl) * 512 + c8 + 32 * bj) = pack8(v0, v1); } }
        }
    }
    __device__ __forceinline__ void operator()(const f32x4 (&acc)[2][2][4][2], const pg8::Unit& u, int wr, int wc, int fr, int fq, lptr) const {
#pragma unroll
        for (int ai = 0; ai < 2; ++ai) sub(acc[ai], u.pn, u.pm * 256 + ai * 128 + wr * 64, wc, fr, fq);
    }
};

template <int MODE>
struct EpiRes {
    static constexpr bool PERM = true, AFTER_DRAIN = false;
    const void* xin; void* xout; const float* gate; int tlog;
    __device__ __forceinline__ void sub(const f32x4 (&a)[2][4][2], int pn, int rloc0, int wc, int fr, int fq) const {
#pragma unroll
        for (int m = 0; m < 4; ++m) { const int rl = rloc0 + 16 * m + fr; const float* g = gate + (size_t)(rl >> tlog) * 6144;
#pragma unroll
            for (int bj = 0; bj < 2; ++bj) { const int c = 256 * pn + 128 * bj + 32 * wc + 8 * fq;
                const f32x4 g0 = *(const f32x4*)(g + c), g1 = *(const f32x4*)(g + c + 4);
                if (MODE == 0) {
                    const float* xp = (const float*)xin + (size_t)rl * 1024 + c;
                    const f32x4 o0 = *(const f32x4*)xp + g0 * a[bj][m][0], o1 = *(const f32x4*)(xp + 4) + g1 * a[bj][m][1];
                    *(u32x4*)((bf16_t*)xout + (size_t)rl * 1024 + c) = pack8(o0, o1);
                } else {
                    const u32x4 xv = *(const u32x4*)((const bf16_t*)xin + (size_t)rl * 1024 + c);
                    const f32x4 x0 = {bflo(xv.x), bfhi(xv.x), bflo(xv.y), bfhi(xv.y)}, x1 = {bflo(xv.z), bfhi(xv.z), bflo(xv.w), bfhi(xv.w)};
                    float* op = (float*)xout + (size_t)rl * 1024 + c;
                    __builtin_nontemporal_store(x0 + g0 * a[bj][m][0], (f32x4*)op); __builtin_nontemporal_store(x1 + g1 * a[bj][m][1], (f32x4*)(op + 4));
                } } }
    }
    __device__ __forceinline__ void operator()(const f32x4 (&acc)[2][2][4][2], const pg8::Unit& u, int wr, int wc, int fr, int fq, lptr) const {
#pragma unroll
        for (int ai = 0; ai < 2; ++ai) sub(acc[ai], u.pn, u.pm * 256 + ai * 128 + wr * 64, wc, fr, fq);
    }
};

__device__ __forceinline__ float dpp_ror1(float x) { return __int_as_float(__builtin_amdgcn_update_dpp(0, __float_as_int(x), 0x121, 0xf, 0xf, false)); }
__device__ __forceinline__ float dpp_ror2(float x) { return __int_as_float(__builtin_amdgcn_update_dpp(0, __float_as_int(x), 0x122, 0xf, 0xf, false)); }
struct ConvW { f32x4 w0a, w1a, w2a, ba, w0g, w1g, w2g, bg; };
__device__ __forceinline__ ConvW load_convw(const float* wconv, const float* bconv, int c) {
    ConvW w; w.w0a = *(const f32x4*)(wconv + c); w.w1a = *(const f32x4*)(wconv + FF2 + c); w.w2a = *(const f32x4*)(wconv + 2 * FF2 + c); w.ba = *(const f32x4*)(bconv + c);
    w.w0g = *(const f32x4*)(wconv + FF + c); w.w1g = *(const f32x4*)(wconv + FF2 + FF + c); w.w2g = *(const f32x4*)(wconv + 2 * FF2 + FF + c); w.bg = *(const f32x4*)(bconv + FF + c); return w;
}
template <int CTRL> __device__ __forceinline__ float dppz(float x) { return __int_as_float(__builtin_amdgcn_update_dpp(0, __float_as_int(x), CTRL, 0xf, 0xf, true)); }
__device__ __forceinline__ u32x2 conv_gate4(const f32x4& ca, const f32x4& cg, const f32x4& pa, const f32x4& pg, const ConvW& w, int) {
    float o[4];
#pragma unroll
    for (int e = 0; e < 4; ++e) {
        float ua = fmaf(w.w2a[e], ca[e], w.ba[e]);
        ua = fmaf(dppz<0x111>(ca[e]), w.w1a[e], ua); ua = fmaf(dppz<0x10F>(pa[e]), w.w1a[e], ua);
        ua = fmaf(dppz<0x112>(ca[e]), w.w0a[e], ua); ua = fmaf(dppz<0x10E>(pa[e]), w.w0a[e], ua);
        float ug = fmaf(w.w2g[e], cg[e], w.bg[e]);
        ug = fmaf(dppz<0x111>(cg[e]), w.w1g[e], ug); ug = fmaf(dppz<0x10F>(pg[e]), w.w1g[e], ug);
        ug = fmaf(dppz<0x112>(cg[e]), w.w0g[e], ug); ug = fmaf(dppz<0x10E>(pg[e]), w.w0g[e], ug);
        o[e] = ua * sigmoidf_(ua) * ug;
    }
    u32x2 r; r.x = cvtpk(o[0], o[1]); r.y = cvtpk(o[2], o[3]); return r;
}
struct EpiFFN {
    static constexpr bool PERM = true, AFTER_DRAIN = false;
    bf16_t* act; float* uedge; float* outF; const float* wconv; const float* bconv;
    __device__ __forceinline__ void operator()(const f32x4 (&acc)[2][2][4][2], const pg8::Unit& u, int wr, int wc, int fr, int fq, lptr lds) const {
        lptr halo = lds + pg8::STAGE_BYTES;
        const int q8 = 32 * wc + 8 * fq;
        if (fr >= 14) {
#pragma unroll
            for (int ai = 0; ai < 2; ++ai)
#pragma unroll
                for (int bj = 0; bj < 2; ++bj)
#pragma unroll
                    for (int n = 0; n < 2; ++n) *(LAS f32x4*)(halo + ((((2 * ai + wr) * 2 + (fr - 14)) * 256 + 128 * bj + q8 + 4 * n) * 4)) = acc[ai][bj][3][n];
        }
        asm volatile("s_waitcnt lgkmcnt(0)" ::: "memory"); __builtin_amdgcn_s_barrier(); asm volatile("" ::: "memory");
#pragma unroll
        for (int n = 0; n < 2; ++n) {
            const int c = 128 * u.pn + q8 + 4 * n;
            const ConvW w = load_convw(wconv, bconv, c);
#pragma unroll
            for (int ai = 0; ai < 2; ++ai) {
                const int G = 2 * ai + wr;
                f32x4 pa = {0.f, 0.f, 0.f, 0.f}, pg = {0.f, 0.f, 0.f, 0.f};
                if (G > 0 && fr >= 14) { pa = *(const LAS f32x4*)(halo + ((((G - 1) * 2 + (fr - 14)) * 256 + q8 + 4 * n) * 4)); pg = *(const LAS f32x4*)(halo + ((((G - 1) * 2 + (fr - 14)) * 256 + 128 + q8 + 4 * n) * 4)); }
#pragma unroll
                for (int m = 0; m < 4; ++m) {
                    const f32x4 ca = acc[ai][0][m][n], cg = acc[ai][1][m][n];
                    const f32x4 qa = m ? acc[ai][0][m ? m - 1 : 0][n] : pa, qg = m ? acc[ai][1][m ? m - 1 : 0][n] : pg;
                    const u32x2 o = conv_gate4(ca, cg, qa, qg, w, fr);
                    const size_t row = (size_t)u.pm * 256 + 64 * G + 16 * m + fr;
                    *(u32x2*)(act + row * FF + c) = o;
                    if (m == 0 && G == 0 && fr < 2) { float* e = uedge + ((size_t)u.pm * 4 + fr) * FF2 + c; *(f32x4*)e = ca; *(f32x4*)(e + FF) = cg; }
                    if (m == 3 && G == 3 && fr >= 14) { float* e = uedge + ((size_t)u.pm * 4 + 2 + (fr - 14)) * FF2 + c; *(f32x4*)e = ca; *(f32x4*)(e + FF) = cg;
                        if ((u.pm & 15) == 15) { float* f = outF + ((size_t)(u.pm >> 4) * 2 + (fr - 14)) * FF2 + c; *(f32x4*)f = ca; *(f32x4*)(f + FF) = cg; } }
                }
            }
        }
    }
};
struct EpiFFNs {
    bf16_t* act; float* outF; const float* state; const float* wconv; const float* bconv;
    __device__ __forceinline__ void sub(const f32x4 (&a)[2][4][2], int pn, int rloc0, int wc, int fr, int fq) const {
        const int q8 = 32 * wc + 8 * fq;
#pragma unroll
        for (int n = 0; n < 2; ++n) {
            const int c = 128 * pn + q8 + 4 * n;
            const ConvW w = load_convw(wconv, bconv, c);
#pragma unroll
            for (int m = 0; m < 4; ++m) {
                const int b = (rloc0 + 16 * m) >> 5;
                const f32x4 ca = a[0][m][n], cg = a[1][m][n];
                f32x4 qa = {0.f, 0.f, 0.f, 0.f}, qg = {0.f, 0.f, 0.f, 0.f};
                if (m & 1) { qa = a[0][m ? m - 1 : 0][n]; qg = a[1][m ? m - 1 : 0][n]; }
                else if (fr >= 14) { const float* s = state + ((size_t)b * 2 + (fr - 14)) * FF2 + c; qa = *(const f32x4*)s; qg = *(const f32x4*)(s + FF); }
                const u32x2 o = conv_gate4(ca, cg, qa, qg, w, fr);
                const size_t row = (size_t)MP + rloc0 + 16 * m + fr;
                *(u32x2*)(act + row * FF + c) = o;
                if ((m & 1) && fr >= 14) { float* f = outF + ((size_t)b * 2 + (fr - 14)) * FF2 + c; *(f32x4*)f = ca; *(f32x4*)(f + FF) = cg; }
            }
        }
    }
};

template <int K, bool HISCALE, class Epi>
__device__ __forceinline__ void small_tile(const bf16_t* __restrict__ A, const bf16_t* __restrict__ Bt, const Epi& E, const float* ssq, lptr lds, int t, int tid, int lane, int wave) {
    constexpr int KW = K / 8;
    const int fr = lane & 15, fq = lane >> 4;
    const int wc = t & 3, G = (t >> 2) & 3, pn = t >> 4;
    f32x4 acc[2][4][2];
#pragma unroll
    for (int bj = 0; bj < 2; ++bj)
#pragma unroll
        for (int m = 0; m < 4; ++m)
#pragma unroll
            for (int n = 0; n < 2; ++n) acc[bj][m][n] = (f32x4){0.f, 0.f, 0.f, 0.f};
    const bf16_t* ap = A + (size_t)(G * 64 + fr) * K + fq * 8 + wave * KW;
    const bf16_t* bp = Bt + (size_t)(256 * pn + 32 * wc + 8 * (fr >> 2) + (fr & 3)) * K + fq * 8 + wave * KW;
#ifdef DBLK
    for (int rep = 0; rep < 2; ++rep) {
    if (rep == 1) {
_Pragma("unroll") for (int bj = 0; bj < 2; ++bj) _Pragma("unroll") for (int m = 0; m < 4; ++m) _Pragma("unroll") for (int n = 0; n < 2; ++n) acc[bj][m][n] = acc[bj][m][n] * 0.f; asm volatile("" ::: "memory"); }
#endif
#pragma unroll 4
    for (int k0 = 0; k0 < KW; k0 += 32) {
        bf16x8 af[4], bf[2][2];
#pragma unroll
        for (int m = 0; m < 4; ++m) af[m] = *(const bf16x8*)(ap + (size_t)(16 * m) * K + k0);
#pragma unroll
        for (int bj = 0; bj < 2; ++bj)
#pragma unroll
            for (int n = 0; n < 2; ++n) bf[bj][n] = *(const bf16x8*)(bp + (size_t)(128 * bj + 4 * n) * K + k0);
#pragma unroll
        for (int bj = 0; bj < 2; ++bj)
#pragma unroll
            for (int m = 0; m < 4; ++m)
#pragma unroll
                for (int n = 0; n < 2; ++n) acc[bj][m][n] = MFMA16(bf[bj][n], af[m], acc[bj][m][n]);
    }
#ifdef DBLK
    }
#endif
    if (HISCALE) { if (wave >= 4) {
#pragma unroll
        for (int m = 0; m < 4; ++m) { const float* sp = ssq + (size_t)(MP + G * 64 + 16 * m + fr) * 8; const f32x4 s0 = *(const f32x4*)sp, s1 = *(const f32x4*)(sp + 4);
            const float rstd = rsqrtf(((s0.x + s0.y) + (s0.z + s0.w) + (s1.x + s1.y) + (s1.z + s1.w)) * (1.f / 512.f) + EPS);
#pragma unroll
            for (int bj = 0; bj < 2; ++bj)
#pragma unroll
                for (int n = 0; n < 2; ++n) acc[bj][m][n] = acc[bj][m][n] * rstd; } } }
    __syncthreads();
    if (wave != 0) {
#pragma unroll
        for (int bj = 0; bj < 2; ++bj)
#pragma unroll
            for (int m = 0; m < 4; ++m)
#pragma unroll
                for (int n = 0; n < 2; ++n) *(LAS f32x4*)(lds + ((((wave - 1) * 16 + (bj * 4 + m) * 2 + n) * 64 + lane) * 16)) = acc[bj][m][n];
    }
    __syncthreads();
    if (wave == 0) {
#pragma unroll 1
        for (int w2 = 0; w2 < 7; ++w2)
#pragma unroll
            for (int bj = 0; bj < 2; ++bj)
#pragma unroll
                for (int m = 0; m < 4; ++m)
#pragma unroll
                    for (int n = 0; n < 2; ++n) acc[bj][m][n] = acc[bj][m][n] + *(const LAS f32x4*)(lds + (((w2 * 16 + (bj * 4 + m) * 2 + n) * 64 + lane) * 16));
        E.sub(acc, pn, G * 64, wc, fr, fq);
#ifdef DBLE
        asm volatile("" ::: "memory"); E.sub(acc, pn, G * 64, wc, fr, fq);
#endif
    }
    __syncthreads();
}

typedef unsigned v4u __attribute__((ext_vector_type(4)));
#define XB_TMO      128
#define XB_XCNT(j)  (256  + 64 * (j))
#define XB_XSUB(j)  (1280 + 64 * (j))
#define XB_XGEN(j)  (2304 + 64 * (j))
#define XB_TOP      3328
#define XB_TOPGEN   3392
#define XCD_BAR_WORDS 3456
#define XB_SPIN_CAP (1u << 18)

__device__ __forceinline__ unsigned xb_ld(unsigned* p)              { return __hip_atomic_load(p, __ATOMIC_RELAXED, __HIP_MEMORY_SCOPE_AGENT); }
__device__ __forceinline__ unsigned xb_add(unsigned* p, unsigned v) { return __hip_atomic_fetch_add(p, v, __ATOMIC_RELAXED, __HIP_MEMORY_SCOPE_AGENT); }
__device__ __forceinline__ unsigned xb_xcc_id() { return (unsigned)__builtin_amdgcn_s_getreg((3 << 11) | 20) & 0xFu; }
#define XB_SPIN(cond, bar) do { unsigned _sp = 0; while (cond) { __builtin_amdgcn_s_sleep(1); \
    if ((++_sp & 255u) == 0u) { if (xb_ld(&(bar)[XB_TMO])) break; if (_sp > XB_SPIN_CAP) { atomicAdd(&(bar)[XB_TMO], 1u); break; } } } } while (0)

struct XcdBarrier {
    unsigned* bar; unsigned x;
    volatile LAS unsigned* st;
};

__device__ __forceinline__ XcdBarrier xcd_barrier_post(unsigned* bar, volatile LAS unsigned* st) {
    XcdBarrier b; b.bar = bar; b.x = xb_xcc_id(); b.st = st;
    if (threadIdx.x == 0) (void)xb_add(&bar[XB_XCNT(b.x)], 1u);
    return b;
}
__device__ __forceinline__ void xcd_barrier_complete(unsigned* bar, unsigned x, unsigned& nloc, unsigned& nx) {
    const unsigned G = gridDim.x * gridDim.y * gridDim.z;
    unsigned sum, cnt, mine, sp = 0u;
    for (;;) {
        sum = 0u; cnt = 0u; mine = 0u;
#pragma unroll
        for (unsigned j = 0; j < 16; ++j) { const unsigned c = xb_ld(&bar[XB_XCNT(j)]); sum += c; cnt += (c > 0u) ? 1u : 0u; mine = (j == x) ? c : mine; }
        if (sum == G) break;
        __builtin_amdgcn_s_sleep(1);
        if ((++sp & 255u) == 0u) { if (xb_ld(&bar[XB_TMO])) break; if (sp > XB_SPIN_CAP) { atomicAdd(&bar[XB_TMO], 1u); break; } }
    }
    nloc = mine > 0u ? mine : 1u; nx = cnt > 0u ? cnt : 1u;
}

__device__ __forceinline__ void xcd_barrier(const XcdBarrier& b) {
    asm volatile("s_waitcnt vmcnt(0)" ::: "memory");
    __syncthreads();
    if (threadIdx.x == 0) {
        unsigned* bar = b.bar;
        __builtin_amdgcn_s_waitcnt(0);
        unsigned nloc = b.st[0], nx = b.st[1];
        if (nloc == 0u) { xcd_barrier_complete(bar, b.x, nloc, nx); b.st[0] = nloc; b.st[1] = nx; }
        const unsigned old = xb_add(&bar[XB_XSUB(b.x)], 1u);
        const unsigned gen = old / nloc;
        if (old + 1u == (gen + 1u) * nloc) {
            __builtin_amdgcn_fence(__ATOMIC_RELEASE, "agent");
            asm volatile("s_waitcnt vmcnt(0)" ::: "memory");
            const unsigned og = xb_add(&bar[XB_TOP], 1u);
            const unsigned tg = og / nx;
            if (og + 1u == (tg + 1u) * nx) xb_add(&bar[XB_TOPGEN], 1u);
            else XB_SPIN(xb_ld(&bar[XB_TOPGEN]) == tg, bar);
            __builtin_amdgcn_fence(__ATOMIC_ACQUIRE, "agent");
            xb_add(&bar[XB_XGEN(b.x)], 1u);
            asm volatile("s_waitcnt vmcnt(0)" ::: "memory");
        } else {
            XB_SPIN(xb_ld(&bar[XB_XGEN(b.x)]) == gen, bar);
            __builtin_amdgcn_fence(__ATOMIC_ACQUIRE, "agent");
            asm volatile("s_waitcnt vmcnt(0)" ::: "memory");
        }
    }
    __syncthreads();
}


__device__ __forceinline__ void transpose_item(const float* __restrict__ W, int ldw, int srccol0, bf16_t* __restrict__ WT, int K, int destrow0, int k0, LAS float* scr, int lane, const float* kscale = nullptr) {
#pragma unroll 16
    for (int i = 0; i < 32; ++i) { const int kk = 2 * i + (lane >> 5); scr[kk * 33 + (lane & 31)] = W[(size_t)(k0 + kk) * ldw + srccol0 + (lane & 31)] * (kscale ? kscale[k0 + kk] : 1.f); }
    asm volatile("s_waitcnt lgkmcnt(0)" ::: "memory");
    const int c = lane & 7;
#pragma unroll
    for (int j = 0; j < 4; ++j) { const int n = (lane >> 3) + 8 * j; const LAS float* s = scr + (8 * c) * 33 + n;
        u32x4 o; o.x = cvtpk(s[0 * 33], s[1 * 33]); o.y = cvtpk(s[2 * 33], s[3 * 33]); o.z = cvtpk(s[4 * 33], s[5 * 33]); o.w = cvtpk(s[6 * 33], s[7 * 33]);
        *(u32x4*)(WT + (size_t)(destrow0 + n) * K + k0 + 8 * c) = o; }
    asm volatile("s_waitcnt lgkmcnt(0)" ::: "memory");
}

__device__ __forceinline__ void phase_weights(const Params& P, lptr lds, int lane, int wave, int it_lo, int it_hi, int gw, int NGW) {
    unsigned char* ws = P.ws;
    LAS float* scr = (LAS float*)(lds + wave * 16384);
    constexpr int I1 = 16 * 112, I2 = 16 * 32, I3 = 16 * 176, I4 = 44 * 32;
    for (int it = it_lo + gw; it < it_hi; it += NGW) {
        int r = it;
        if (r < I1) { const int kb = r / 112, n0 = (r % 112) * 32, tile = n0 >> 8, p = n0 & 255, wc = (p >> 5) & 3, bj = p >> 7, L = tile * 256 + 64 * wc + 32 * bj;
            transpose_item(P.in[I_WIN], DIN, L < 2048 ? L : L + 8, (bf16_t*)(ws + WS_W1T), 1024, n0, kb * 64, scr, lane); continue; }
        r -= I1;
        if (r < I2) { const int kb = r / 32, n0 = (r % 32) * 32; transpose_item(P.in[I_WOUT], 1024, n0, (bf16_t*)(ws + WS_W2T), 1024, n0, kb * 64, scr, lane, kb >= 8 ? P.in[I_SOW] - 512 : nullptr); continue; }
        r -= I2;
        if (r < I3) { const int kb = r / 176, n0 = (r % 176) * 32, pn = n0 >> 8, p = n0 & 255, bj = p >> 7, q0 = p & 127;
            transpose_item(P.in[I_WUP], FF2, 128 * pn + q0 + FF * bj, (bf16_t*)(ws + WS_W3T), 1024, n0, kb * 64, scr, lane); continue; }
        r -= I3;
        { const int kb = r / 32, n0 = (r % 32) * 32; transpose_item(P.in[I_WDOWN], 1024, n0, (bf16_t*)(ws + WS_W4T), FF, n0, kb * 64, scr, lane); }
    }
}

__device__ __forceinline__ void phase0(const Params& P, lptr lds, int tid, int lane, int wave) {
    unsigned char* ws = P.ws;
    LAS float* sc = (LAS float*)lds;
    for (int i = tid; i < 16384; i += 512) { const int r = i >> 10, k = i & 1023; const float c = r < 8 ? P.in[I_CP][r * 1024 + k] : P.in[I_CS][(r - 8) * 1024 + k]; sc[i] = c / (1.f + __expf(-c)); }
    __syncthreads();
    const int job = blockIdx.x * 512 + tid;
    if (job < 16 * 6144) {
        const int ks = job / 6144, n = job % 6144;
        float acc[16];
#pragma unroll
        for (int r = 0; r < 16; ++r) acc[r] = 0.f;
        const float* wp = P.in[I_WADA] + (size_t)(ks * 64) * 6144 + n;
#pragma unroll 16
        for (int k = 0; k < 64; ++k) { const float w = wp[(size_t)k * 6144];
#pragma unroll
            for (int r = 0; r < 16; ++r) acc[r] += sc[r * 1024 + ks * 64 + k] * w; }
        __attribute__((address_space(1))) float* mp = (__attribute__((address_space(1))) float*)(ws + WS_MOD);
        const float bias = ks == 0 ? P.in[I_BADA][n] : 0.f;
#pragma unroll
        for (int r = 0; r < 16; ++r) (void)__builtin_amdgcn_global_atomic_fadd_f32(mp + (size_t)r * 6144 + n, acc[r] + bias);
    }
}

__device__ __forceinline__ void load_mod_vectors(const Params& P, LAS float* A, LAS float* S, const float* normw, int r, int shofs, int tid) {
    const float* md = (const float*)(P.ws + WS_MOD) + (size_t)r * 6144 + shofs;
    for (int k = tid; k < 1024; k += 512) { A[k] = normw[k] * (1.f + md[1024 + k]); S[k] = md[k]; }
}
__device__ __forceinline__ void load_row_bf(const bf16_t* xrow, int lane, f32x4 (&v)[4]) {
#pragma unroll
    for (int j = 0; j < 4; ++j) { const u32x2 w = ((const u32x2*)xrow)[lane + 64 * j]; v[j] = (f32x4){bflo(w.x), bfhi(w.x), bflo(w.y), bfhi(w.y)}; }
}
__device__ __forceinline__ void load_row(const float* xrow, int lane, f32x4 (&v)[4]) {
#pragma unroll
    for (int j = 0; j < 4; ++j) v[j] = __builtin_nontemporal_load((const f32x4*)xrow + lane + 64 * j);
}
template <bool GATES>
__device__ __forceinline__ void norm_row(const Params& P, const f32x4 (&v)[4], bf16_t* orow, float* grow, const LAS float* A, const LAS float* S, const LAS float* Wg, int lane) {
    float s = 0.f;
#pragma unroll
    for (int j = 0; j < 4; ++j) s += (v[j].x * v[j].x + v[j].y * v[j].y) + (v[j].z * v[j].z + v[j].w * v[j].w);
    const float rstd = rsqrtf(wave_sum(s) * (1.f / 1024.f) + EPS);
    float g[8];
#pragma unroll
    for (int i = 0; i < 8; ++i) g[i] = 0.f;
#pragma unroll
    for (int j = 0; j < 4; ++j) { const int k0 = 4 * lane + 256 * j;
        const f32x4 a = *(const LAS f32x4*)(A + k0), sh = *(const LAS f32x4*)(S + k0);
        const f32x4 hv = v[j] * rstd * a + sh;
        u32x2 o; o.x = cvtpk(hv.x, hv.y); o.y = cvtpk(hv.z, hv.w);
        *(u32x2*)(orow + k0) = o;
        if (GATES) {
#pragma unroll
            for (int i = 0; i < 8; ++i) { const f32x4 w = *(const LAS f32x4*)(Wg + i * 1024 + k0); g[i] += (hv.x * w.x + hv.y * w.y) + (hv.z * w.z + hv.w * w.w); } }
    }
    if (GATES) {
        { const bool hi = (lane & 32) != 0;
#pragma unroll
          for (int i = 0; i < 4; ++i) { const float send = hi ? g[i] : g[i + 4], keep = hi ? g[i + 4] : g[i]; g[i] = keep + __shfl_xor(send, 32); } }
        { const bool hi = (lane & 16) != 0;
#pragma unroll
          for (int i = 0; i < 2; ++i) { const float send = hi ? g[i] : g[i + 2], keep = hi ? g[i + 2] : g[i]; g[i] = keep + __shfl_xor(send, 16); } }
        { const bool hi = (lane & 8) != 0; const float send = hi ? g[0] : g[1], keep = hi ? g[1] : g[0]; g[0] = keep + __shfl_xor(send, 8); }
        g[0] += __shfl_xor(g[0], 4); g[0] += __shfl_xor(g[0], 2); g[0] += __shfl_xor(g[0], 1);
        const int gt = lane >> 3;
        if ((lane & 7) == 0) {
            float o;
            if (gt < 4) o = g[0] + P.in[I_BIG][gt];
            else { const float x = g[0] + P.in[I_BFG][gt - 4]; o = fminf(x, 0.f) - log1pf(expf(-fabsf(x))); }
            grow[gt] = o;
        }
    }
}
__device__ __forceinline__ void phase1(const Params& P, lptr lds, int tid, int lane, int wave) {
    LAS float* A1 = (LAS float*)lds; LAS float* S1 = A1 + 1024; LAS float* Wg = S1 + 1024;
    const size_t row0 = (size_t)blockIdx.x * 128 + wave * 16; f32x4 v[4], vn[4]; load_row(P.in[I_XP] + row0 * 1024, lane, v);
    for (int k = tid; k < 1024; k += 512) { const f32x4 w0 = *(const f32x4*)(P.in[I_WIN] + (size_t)k * DIN + 2048), w1 = *(const f32x4*)(P.in[I_WIN] + (size_t)k * DIN + 2052);
        Wg[k] = w0.x; Wg[1024 + k] = w0.y; Wg[2048 + k] = w0.z; Wg[3072 + k] = w0.w; Wg[4096 + k] = w1.x; Wg[5120 + k] = w1.y; Wg[6144 + k] = w1.z; Wg[7168 + k] = w1.w; }
    load_mod_vectors(P, A1, S1, P.in[I_N1W], blockIdx.x >> 5, 0, tid);
    LAS float* A1s = Wg + 8192; LAS float* S1s = A1s + 1024;
    load_mod_vectors(P, A1s, S1s, P.in[I_N1W], 8 + (blockIdx.x >> 5), 0, tid);
    __syncthreads();
    bf16_t* H = (bf16_t*)(P.ws + WS_H); float* GT = (float*)(P.ws + WS_GATES);
    {
#pragma unroll 1
      for (int j = 0; j < 16; ++j) { const size_t row = row0 + j;
          if (j + 1 < 16) load_row(P.in[I_XP] + (row + 1) * 1024, lane, vn);
          else if (wave == 0) load_row(P.in[I_XS] + (size_t)blockIdx.x * 1024, lane, vn);
          norm_row<true>(P, v, H + row * 1024, GT + row * 8, A1, S1, Wg, lane);
#pragma unroll
          for (int q = 0; q < 4; ++q) v[q] = vn[q]; }
      if (wave == 0) norm_row<true>(P, v, H + ((size_t)MP + blockIdx.x) * 1024, GT + ((size_t)MP + blockIdx.x) * 8, A1s, S1s, Wg, lane); }
}
__device__ __forceinline__ void phase5(const Params& P, lptr lds, int tid, int lane, int wave) {
    LAS float* A1 = (LAS float*)lds; LAS float* S1 = A1 + 1024;
    load_mod_vectors(P, A1, S1, P.in[I_N2W], blockIdx.x >> 5, 3072, tid);
    __syncthreads();
    bf16_t* H = (bf16_t*)(P.ws + WS_H);
    { const size_t row0 = (size_t)blockIdx.x * 128 + wave * 16; const bf16_t* X1 = (const bf16_t*)(P.ws + WS_X1B); f32x4 v[4], vn[4]; load_row_bf(X1 + row0 * 1024, lane, v);
#pragma unroll 1
      for (int j = 0; j < 16; ++j) { const size_t row = row0 + j;
          if (j + 1 < 16) load_row_bf(X1 + (row + 1) * 1024, lane, vn);
          norm_row<false>(P, v, H + row * 1024, nullptr, A1, S1, nullptr, lane);
#pragma unroll
          for (int q = 0; q < 4; ++q) v[q] = vn[q]; } }
    __syncthreads();
}
__device__ __forceinline__ void sample_h2_row(const Params& P, lptr lds, int tid, int lane, int wave) {
    LAS float* A1 = (LAS float*)lds; LAS float* S1 = A1 + 1024;
    load_mod_vectors(P, A1, S1, P.in[I_N2W], 8 + (blockIdx.x >> 5), 3072, tid);
    __syncthreads();
    if (wave == 0) { f32x4 v[4]; load_row_bf((const bf16_t*)(P.ws + WS_X1B) + ((size_t)MP + blockIdx.x) * 1024, lane, v); norm_row<false>(P, v, (bf16_t*)(P.ws + WS_H) + ((size_t)MP + blockIdx.x) * 1024, nullptr, A1, S1, nullptr, lane); }
    __syncthreads();
}
__device__ __forceinline__ void phase3b(const Params& P, int lane, int gw, int NGW) {
    bf16_t* Y = (bf16_t*)(P.ws + WS_YCAT); const float* SSQ = (const float*)(P.ws + WS_SSQ);
    for (int row = gw; row < MP; row += NGW) {
        const f32x4 s0 = *(const f32x4*)(SSQ + (size_t)row * 8), s1 = *(const f32x4*)(SSQ + (size_t)row * 8 + 4);
        const float rstd = rsqrtf(((s0.x + s0.y) + (s0.z + s0.w) + (s1.x + s1.y) + (s1.z + s1.w)) * (1.f / 512.f) + EPS);
        u32x4* p = (u32x4*)(Y + (size_t)row * 1024 + 512 + 8 * lane); const u32x4 o = *p;
        f32x4 a = {bflo(o.x), bfhi(o.x), bflo(o.y), bfhi(o.y)}, b = {bflo(o.z), bfhi(o.z), bflo(o.w), bfhi(o.w)};
        a = a * rstd; b = b * rstd;
        *p = pack8(a, b);
    }
}
__device__ __forceinline__ void phase_fix(const Params& P, int tid) {
    const float* UE = (const float*)(P.ws + WS_UEDGE); bf16_t* act = (bf16_t*)(P.ws + WS_ACT);
    const float* wc = P.in[I_WCONV]; const float* bc = P.in[I_BCONV];
    const int total = 128 * 2 * FF;
    if (blockIdx.x < 64) return;
    for (int i = (blockIdx.x - 64) * 512 + tid; i < total; i += (gridDim.x - 64) * 512) {
        const int j = i % FF, rr = (i / FF) & 1, pm = i / (2 * FF);
        if ((pm & 15) == 0) continue;
        float uc[2];
#pragma unroll
        for (int hf = 0; hf < 2; ++hf) { const int c = j + hf * FF;
            const float um2 = rr == 0 ? UE[((size_t)(pm - 1) * 4 + 2) * FF2 + c] : UE[((size_t)(pm - 1) * 4 + 3) * FF2 + c];
            const float um1 = rr == 0 ? UE[((size_t)(pm - 1) * 4 + 3) * FF2 + c] : UE[((size_t)pm * 4 + 0) * FF2 + c];
            const float u0 = UE[((size_t)pm * 4 + rr) * FF2 + c];
            uc[hf] = bc[c] + wc[2 * FF2 + c] * u0 + wc[FF2 + c] * um1 + wc[c] * um2; }
        act[((size_t)pm * 256 + rr) * FF + j] = f2bf(uc[0] * sigmoidf_(uc[0]) * uc[1]);
    }
}

constexpr int ML_P = 272;
constexpr int ML_QS = 0, ML_KS = 17408, ML_VS = 34816, ML_VW = 52224, ML_CS = 69632, ML_SS = 104448, ML_SC = 113664;
__device__ __forceinline__ void mlstm_item(const Params& P, lptr lds, int bh, bool sample, int tid, int lane, int wave) {
    const int b = bh >> 2, h = bh & 3, hh = lane >> 5, n31 = lane & 31;
    const size_t rowbase = sample ? (size_t)MP + b * 32 : (size_t)b * SEQ;
    const int nch = sample ? 1 : 64, L = sample ? 32 : 64;
    const bf16_t* MQ = (const bf16_t*)(P.ws + WS_PROJ); const bf16_t* MK = (const bf16_t*)(P.ws + WS_PROJ + PROJ_STRIDE); const bf16_t* MV = (const bf16_t*)(P.ws + WS_PROJ + 2 * PROJ_STRIDE);
    const bf16_t* MO = (const bf16_t*)(P.ws + WS_PROJ + 3 * PROJ_STRIDE); const float* GT = (const float*)(P.ws + WS_GATES); bf16_t* YC = (bf16_t*)(P.ws + WS_YCAT);
    LAS float* sc = (LAS float*)(lds + ML_SC);
    LAS float* bt = sc, *as_ = sc + 64, *mt = sc + 128, *winter = sc + 192, *emt = sc + 256, *wk = sc + 320, *rsum = sc + 384, *qn = sc + 512, *nvec = sc + 576, *misc = sc + 704;
    const int ti = wave >> 2, ej = wave & 3;
    f32x16 Cacc[2];
    {
        LAS float* cst = (LAS float*)lds;
        if (sample) { const float* src = P.in[I_STC] + ((size_t)b * 4 + h) * 16384;
            for (int i = tid; i < 4096; i += 512) { const f32x4 v = *(const f32x4*)(src + 4 * i); *(LAS f32x4*)(cst + (i >> 5) * 132 + (i & 31) * 4) = v; } }
        else { for (int i = tid; i < 4096; i += 512) *(LAS f32x4*)(cst + (i >> 5) * 132 + (i & 31) * 4) = (f32x4){0.f, 0.f, 0.f, 0.f}; }
        __syncthreads();
        const LAS float* cb = cst + (64 * (wave >> 2) + 4 * hh) * 132 + 32 * ej + n31;
#pragma unroll
        for (int i = 0; i < 2; ++i)
#pragma unroll
            for (int r = 0; r < 16; ++r) Cacc[i][r] = cb[(32 * i + (r & 3) + 8 * (r >> 2)) * 132];
        __syncthreads();
        lptr cs = lds + ML_CS + (64 * (wave >> 2) + 4 * hh) * ML_P + (32 * ej + n31) * 2;
#pragma unroll
        for (int i = 0; i < 2; ++i)
#pragma unroll
            for (int r = 0; r < 16; ++r) *(LAS unsigned short*)(cs + (32 * i + (r & 3) + 8 * (r >> 2)) * ML_P) = f2bf(Cacc[i][r]);
    }
    if (tid < 128) nvec[tid] = sample ? P.in[I_STN][((size_t)b * 4 + h) * 128 + tid] : 0.f;
    if (tid == 0) misc[0] = sample ? P.in[I_STM][b * 4 + h] : 0.f;
    u32x4 rq[2], rk[2], rv[2]; float g_ig = -INFINITY, g_lf = 0.f;
    const int prow[2] = {tid >> 4, (tid + 512) >> 4}, pch = tid & 15;
#define ML_LOAD(c) do { _Pragma("unroll") for (int i = 0; i < 2; ++i) { if (prow[i] < L) { const size_t go = (rowbase + (size_t)(c) * 64 + prow[i]) * 512 + h * 128 + pch * 8; \
            rq[i] = *(const u32x4*)(MQ + go); rk[i] = *(const u32x4*)(MK + go); rv[i] = *(const u32x4*)(MV + go); } else { rq[i] = (u32x4){0u, 0u, 0u, 0u}; rk[i] = rq[i]; rv[i] = rq[i]; } } \
        if (wave == 0) { if (lane < L) { const float* g = GT + (rowbase + (size_t)(c) * 64 + lane) * 8; g_ig = g[h]; g_lf = g[4 + h]; } else { g_ig = -INFINITY; g_lf = 0.f; } } } while (0)
    ML_LOAD(0);
    for (int c = 0; c < nch; ++c) {
        __syncthreads();
        if (wave == 0) {
            float bcum = g_lf;
#pragma unroll
            for (int o = 1; o < 64; o <<= 1) { const float v = __shfl_up(bcum, o); if (lane >= o) bcum += v; }
            const float a = g_ig - bcum; float amax = a;
#pragma unroll
            for (int o = 1; o < 64; o <<= 1) { const float v = __shfl_up(amax, o); if (lane >= o) amax = fmaxf(amax, v); }
            const float mprev = misc[0];
            const float m_t = fmaxf(bcum + mprev, bcum + amax);
            const float bL = __shfl(bcum, 63), aM = __shfl(amax, 63);
            const float m_new = fmaxf(bL + mprev, bL + aM);
            bt[lane] = bcum; as_[lane] = a; mt[lane] = m_t; winter[lane] = expf(bcum + mprev - m_t); emt[lane] = expf(-m_t); wk[lane] = expf(bL + a - m_new);
            if (lane == 0) { misc[1] = expf(bL + mprev - m_new); misc[2] = m_new; }
        }
#pragma unroll
        for (int i = 0; i < 2; ++i) { const int o = prow[i] * ML_P + pch * 16;
            *(LAS u32x4*)(lds + ML_QS + o) = rq[i]; *(LAS u32x4*)(lds + ML_KS + o) = rk[i]; *(LAS u32x4*)(lds + ML_VS + o) = rv[i]; }
        __syncthreads();
#pragma unroll
        for (int i = 0; i < 2; ++i) { const float w = wk[prow[i]]; const u32x4 v = rv[i]; u32x4 o;
            o.x = cvtpk(bflo(v.x) * w, bfhi(v.x) * w); o.y = cvtpk(bflo(v.y) * w, bfhi(v.y) * w); o.z = cvtpk(bflo(v.z) * w, bfhi(v.z) * w); o.w = cvtpk(bflo(v.w) * w, bfhi(v.w) * w);
            *(LAS u32x4*)(lds + ML_VW + prow[i] * ML_P + pch * 16) = o; }
        if (c + 1 < nch) ML_LOAD(c + 1);
        f32x16 num;
#pragma unroll
        for (int r = 0; r < 16; ++r) num[r] = 0.f;
#pragma unroll
        for (int ks = 0; ks < 8; ++ks) num = MFMA32(row_frag(lds + ML_QS, ML_P, 32 * ti, 16 * ks, lane), tr_frag(lds + ML_CS, ML_P, 16 * ks, 32 * ej, lane), num);
        if (wave < 3) {
            const int sti = wave == 0 ? 0 : 1, sj = wave == 2 ? 1 : 0;
            const int krow = (n31 & ~12) | ((n31 & 4) << 1) | ((n31 & 8) >> 1);
            f32x16 p;
#pragma unroll
            for (int r = 0; r < 16; ++r) p[r] = 0.f;
#pragma unroll
            for (int ks = 0; ks < 8; ++ks) p = MFMA32(*(const LAS bf16x8*)(lds + ML_KS + (32 * sj + krow) * ML_P + (16 * ks + 8 * hh) * 2), row_frag(lds + ML_QS, ML_P, 32 * sti, 16 * ks, lane), p);
            const int t = 32 * sti + n31; const float bt_t = bt[t], mt_t = mt[t]; float rs = 0.f;
            const LAS float* asb = as_ + 32 * sj + 8 * hh; const int tb = t - (32 * sj + 8 * hh);
#pragma unroll
            for (int r = 0; r < 16; ++r) { const int so = 16 * (r >> 3) + (r & 7);
                const float w = so <= tb ? __expf(bt_t + asb[so] - mt_t) : 0.f; p[r] *= w; rs += p[r]; }
#pragma unroll
            for (int a2 = 0; a2 < 2; ++a2) { u32x4 o; o.x = cvtpk(p[8 * a2 + 0], p[8 * a2 + 1]); o.y = cvtpk(p[8 * a2 + 2], p[8 * a2 + 3]); o.z = cvtpk(p[8 * a2 + 4], p[8 * a2 + 5]); o.w = cvtpk(p[8 * a2 + 6], p[8 * a2 + 7]);
                *(LAS u32x4*)(lds + ML_SS + t * 144 + (32 * sj + 16 * a2 + 8 * hh) * 2) = o; }
            rs += __shfl_xor(rs, 32);
            if (hh == 0) rsum[sj * 64 + t] = rs;
        }
        if (wave >= 4) {
            const int t = (tid - 256) >> 2, part = tid & 3; float s = 0.f;
#pragma unroll 8
            for (int d = 0; d < 32; ++d) s += bf2f(*(const LAS unsigned short*)(lds + ML_QS + t * ML_P + (32 * part + d) * 2)) * nvec[32 * part + d];
            s += __shfl_xor(s, 1); s += __shfl_xor(s, 2);
            if (part == 0) qn[t] = s;
        }
        __syncthreads();
        const LAS float* tb2 = sc + 32 * ti + 4 * hh;
#pragma unroll
        for (int r = 0; r < 16; ++r) num[r] *= tb2[192 + (r & 3) + 8 * (r >> 2)];
#pragma unroll
        for (int ks = 0; ks < 4; ++ks) if (ks < 2 || ti == 1) num = MFMA32(*(const LAS bf16x8*)(lds + ML_SS + (32 * ti + n31) * 144 + (16 * ks + 8 * hh) * 2), tr_frag(lds + ML_VS, ML_P, 16 * ks, 32 * ej, lane), num);
#pragma unroll
        for (int r = 0; r < 16; ++r) { const int o = (r & 3) + 8 * (r >> 2);
            const float den = tb2[192 + o] * tb2[512 + o] + tb2[384 + o] + (ti ? tb2[448 + o] : 0.f);
            const float hv = num[r] * fast_rcp(fmaxf(fabsf(den), tb2[256 + o]));
            *(LAS unsigned short*)(lds + ML_QS + (32 * ti + 4 * hh) * ML_P + (32 * ej + n31) * 2 + o * ML_P) = f2bf(hv); }
        const float decay = misc[1];
#pragma unroll
        for (int i = 0; i < 2; ++i) { const int di = 2 * (wave >> 2) + i;
#pragma unroll
            for (int r = 0; r < 16; ++r) Cacc[i][r] *= decay;
#pragma unroll
            for (int ks = 0; ks < 4; ++ks) Cacc[i] = MFMA32(tr_frag(lds + ML_KS, ML_P, 16 * ks, 32 * di, lane), tr_frag(lds + ML_VW, ML_P, 16 * ks, 32 * ej, lane), Cacc[i]);
#pragma unroll
            for (int r = 0; r < 16; ++r) *(LAS unsigned short*)(lds + ML_CS + (64 * (wave >> 2) + 4 * hh) * ML_P + (32 * ej + n31) * 2 + (32 * i + (r & 3) + 8 * (r >> 2)) * ML_P) = f2bf(Cacc[i][r]); }
        if (tid < 128) { float s = decay * nvec[tid];
#pragma unroll 8
            for (int t = 0; t < 64; ++t) s += wk[t] * bf2f(*(const LAS unsigned short*)(lds + ML_KS + t * ML_P + tid * 2));
            nvec[tid] = s; }
        if (tid == 0) misc[0] = misc[2];
        __syncthreads();
        { const int t = tid >> 3, part = tid & 7;
          const u32x4 h0 = *(const LAS u32x4*)(lds + ML_QS + t * ML_P + part * 32), h1 = *(const LAS u32x4*)(lds + ML_QS + t * ML_P + part * 32 + 16);
          float hv[16] = {bflo(h0.x), bfhi(h0.x), bflo(h0.y), bfhi(h0.y), bflo(h0.z), bfhi(h0.z), bflo(h0.w), bfhi(h0.w), bflo(h1.x), bfhi(h1.x), bflo(h1.y), bfhi(h1.y), bflo(h1.z), bfhi(h1.z), bflo(h1.w), bfhi(h1.w)};
          float ss = 0.f;
#pragma unroll
          for (int e = 0; e < 16; ++e) ss += hv[e] * hv[e];
          ss += __shfl_xor(ss, 1); ss += __shfl_xor(ss, 2); ss += __shfl_xor(ss, 4);
          const float rstd = rsqrtf(ss * (1.f / 128.f) + EPS);
          if (t < L) {
              const size_t row = rowbase + (size_t)c * 64 + t; const int col = h * 128 + part * 16;
              const u32x4 g0 = *(const u32x4*)(MO + row * 512 + col), g1 = *(const u32x4*)(MO + row * 512 + col + 8);
              const float gv[16] = {bflo(g0.x), bfhi(g0.x), bflo(g0.y), bfhi(g0.y), bflo(g0.z), bfhi(g0.z), bflo(g0.w), bfhi(g0.w), bflo(g1.x), bfhi(g1.x), bflo(g1.y), bfhi(g1.y), bflo(g1.z), bfhi(g1.z), bflo(g1.w), bfhi(g1.w)};
              const float* mw = P.in[I_MLW] + col;
              float y[16];
#pragma unroll
              for (int e = 0; e < 16; ++e) y[e] = hv[e] * rstd * mw[e] * gv[e];
              u32x4 o0, o1; o0.x = cvtpk(y[0], y[1]); o0.y = cvtpk(y[2], y[3]); o0.z = cvtpk(y[4], y[5]); o0.w = cvtpk(y[6], y[7]); o1.x = cvtpk(y[8], y[9]); o1.y = cvtpk(y[10], y[11]); o1.z = cvtpk(y[12], y[13]); o1.w = cvtpk(y[14], y[15]);
              *(u32x4*)(YC + row * 1024 + col) = o0; *(u32x4*)(YC + row * 1024 + col + 8) = o1;
          } }
    }
#undef ML_LOAD
    __syncthreads();
    {
        LAS float* cst = (LAS float*)lds;
        int l3 = lane; asm volatile("" : "+v"(l3));
        LAS float* cb = cst + (64 * (wave >> 2) + 4 * (l3 >> 5)) * 132 + 32 * ej + (l3 & 31);
#pragma unroll
        for (int i = 0; i < 2; ++i)
#pragma unroll
            for (int r = 0; r < 16; ++r) cb[(32 * i + (r & 3) + 8 * (r >> 2)) * 132] = Cacc[i][r];
        __syncthreads();
        float* oc = P.out + (sample ? O_SC : O_PC) + ((size_t)b * 4 + h) * 16384;
        for (int i = tid; i < 4096; i += 512) *(f32x4*)(oc + 4 * i) = *(const LAS f32x4*)(cst + (i >> 5) * 132 + (i & 31) * 4);
    }
    if (tid < 128) P.out[(sample ? O_SN : O_PN) + ((size_t)b * 4 + h) * 128 + tid] = nvec[tid];
    if (tid == 0) P.out[(sample ? O_SM : O_PM) + b * 4 + h] = misc[0];
}


constexpr size_t WS_KVL = WS_H, WS_KNL = 420 * MiB, WS_CHS = 421 * MiB, WS_NST = 422 * MiB, WS_MST = 423 * MiB, WS_CST = 424 * MiB, WS_END2 = 489 * MiB;
template <int NC>
__device__ __forceinline__ void ml1_pair(const Params& P, lptr lds, int pair, int tid, int lane, int wave) {
    const int item0 = NC * pair; const int bh = item0 >> 6, c = item0 & 63, b = bh >> 2, h = bh & 3, hh = lane >> 5, n31 = lane & 31, ej = wave & 3;
    const size_t row0 = (size_t)b * SEQ + 64 * c;
    const bf16_t* MK = (const bf16_t*)(P.ws + WS_PROJ + PROJ_STRIDE); const bf16_t* MV = (const bf16_t*)(P.ws + WS_PROJ + 2 * PROJ_STRIDE); const float* GT = (const float*)(P.ws + WS_GATES);
    LAS float* wk = (LAS float*)(lds + ML_SC) + 320;
    const int prow[2] = {tid >> 4, (tid + 512) >> 4}, pch = tid & 15;
    u32x4 rk2[NC][2], rv2[NC][2]; float g_ig2[NC], g_lf2[NC];
#pragma unroll
    for (int s2 = 0; s2 < NC; ++s2) { g_ig2[s2] = 0.f; g_lf2[s2] = 0.f;
#pragma unroll
        for (int i = 0; i < 2; ++i) { const size_t go = (row0 + 64 * s2 + prow[i]) * 512 + h * 128 + pch * 8; rk2[s2][i] = *(const u32x4*)(MK + go); rv2[s2][i] = *(const u32x4*)(MV + go); }
        if (wave == 0) { const float* g = GT + (row0 + 64 * s2 + lane) * 8; g_ig2[s2] = g[h]; g_lf2[s2] = g[4 + h]; } }
#pragma unroll
    for (int s2 = 0; s2 < NC; ++s2) {
    const int item = item0 + s2; const float g_ig = g_ig2[s2], g_lf = g_lf2[s2];
    u32x4 rk[2] = {rk2[s2][0], rk2[s2][1]}, rv[2] = {rv2[s2][0], rv2[s2][1]};
    __syncthreads();
    if (wave == 0) {
        float bcum = g_lf;
#pragma unroll
        for (int o = 1; o < 64; o <<= 1) { const float v = __shfl_up(bcum, o); if (lane >= o) bcum += v; }
        const float a = g_ig - bcum; float amax = a;
#pragma unroll
        for (int o = 1; o < 64; o <<= 1) amax = fmaxf(amax, __shfl_xor(amax, o));
        const float bL = __shfl(bcum, 63);
        wk[lane] = expf(a - amax);
        if (lane == 0) { float* ch = (float*)(P.ws + WS_CHS) + (size_t)item * 4; ch[0] = bL; ch[1] = bL + amax; }
    }
#pragma unroll
    for (int i = 0; i < 2; ++i) *(LAS u32x4*)(lds + ML_KS + prow[i] * ML_P + pch * 16) = rk[i];
    __syncthreads();
#pragma unroll
    for (int i = 0; i < 2; ++i) { const float w = wk[prow[i]]; const u32x4 v = rv[i]; u32x4 o;
        o.x = cvtpk(bflo(v.x) * w, bfhi(v.x) * w); o.y = cvtpk(bflo(v.y) * w, bfhi(v.y) * w); o.z = cvtpk(bflo(v.z) * w, bfhi(v.z) * w); o.w = cvtpk(bflo(v.w) * w, bfhi(v.w) * w);
        *(LAS u32x4*)(lds + ML_VW + prow[i] * ML_P + pch * 16) = o; }
    if (tid < 128) { float s = 0.f;
#pragma unroll 8
        for (int t = 0; t < 64; ++t) s += wk[t] * bf2f(*(const LAS unsigned short*)(lds + ML_KS + t * ML_P + tid * 2));
        ((float*)(P.ws + WS_KNL))[(size_t)item * 128 + tid] = s; }
    __syncthreads();
#pragma unroll
    for (int i = 0; i < 2; ++i) { const int di = 2 * (wave >> 2) + i;
        f32x16 acc;
#pragma unroll
        for (int r = 0; r < 16; ++r) acc[r] = 0.f;
#pragma unroll
        for (int ks = 0; ks < 4; ++ks) acc = MFMA32(tr_frag(lds + ML_KS, ML_P, 16 * ks, 32 * di, lane), tr_frag(lds + ML_VW, ML_P, 16 * ks, 32 * ej, lane), acc);
#pragma unroll
        for (int r = 0; r < 16; ++r) *(LAS unsigned short*)(lds + ML_CS + (64 * (wave >> 2) + 4 * hh) * ML_P + (32 * ej + n31) * 2 + (32 * i + (r & 3) + 8 * (r >> 2)) * ML_P) = f2bf(acc[r]); }
    __syncthreads();
    bf16_t* kvl = (bf16_t*)(P.ws + WS_KVL) + (size_t)item * 16384;
#pragma unroll
    for (int i = 0; i < 4; ++i) { const int p = tid + 512 * i, row = p >> 4, ch = p & 15; *(u32x4*)(kvl + row * 128 + ch * 8) = *(const LAS u32x4*)(lds + ML_CS + row * ML_P + ch * 16); }
    }
}
__device__ __forceinline__ void ml2_scan(const Params& P, lptr lds, int tid) {
    const int hb = tid >> 8, lt = tid & 255, job = 2 * blockIdx.x + hb;
    const int bh = job >> 3, part = job & 7;
    LAS float* dec = (LAS float*)(lds + hb * 1024); LAS float* scl = dec + 64; LAS float* mst = scl + 64;
    if (lt < 64) {
        const float* ch = (const float*)(P.ws + WS_CHS) + ((size_t)bh * 64 + lt) * 4;
        const float bL = ch[0], ml = ch[1]; float A = bL, B = ml;
#pragma unroll
        for (int off = 1; off < 64; off <<= 1) { const float A2 = __shfl_up(A, off), B2 = __shfl_up(B, off); if (lt >= off) { B = fmaxf(B2 + A, B); A = A2 + A; } }
        const float mnext = fmaxf(A, B);
        float mc = __shfl_up(mnext, 1); if (lt == 0) mc = 0.f;
        dec[lt] = expf(bL + mc - mnext); scl[lt] = expf(ml - mnext); mst[lt] = mc; if (lt == 63) mst[64] = mnext;
    }
    __syncthreads();
    const size_t e0 = (size_t)part * 2048 + lt * 8;
    const bf16_t* kv = (const bf16_t*)(P.ws + WS_KVL) + (size_t)bh * 64 * 16384 + e0; bf16_t* cs = (bf16_t*)(P.ws + WS_CST) + (size_t)bh * 64 * 16384 + e0;
    f32x4 C0 = {0.f, 0.f, 0.f, 0.f}, C1 = {0.f, 0.f, 0.f, 0.f};
    const bool do_n = part == 0 && lt < 128; const int tn = do_n ? lt : 0; float n = 0.f;
    const float* kn = (const float*)(P.ws + WS_KNL) + (size_t)bh * 64 * 128 + tn; float* ns = (float*)(P.ws + WS_NST) + (size_t)bh * 64 * 128 + tn;
#pragma unroll 16
    for (int c = 0; c < 64; ++c) { const u32x4 v = *(const u32x4*)(kv + (size_t)c * 16384);
        float knv = 0.f; if (do_n) knv = kn[c * 128];
        *(u32x4*)(cs + (size_t)c * 16384) = pack8(C0, C1);
        if (do_n) ns[c * 128] = n;
        const f32x4 k0 = {bflo(v.x), bfhi(v.x), bflo(v.y), bfhi(v.y)}, k1 = {bflo(v.z), bfhi(v.z), bflo(v.w), bfhi(v.w)};
        const float d = dec[c], sl = scl[c];
        C0 = C0 * d + k0 * sl; C1 = C1 * d + k1 * sl; n = n * d + knv * sl; }
    float* oc = P.out + O_PC + (size_t)bh * 16384 + e0; *(f32x4*)oc = C0; *(f32x4*)(oc + 4) = C1;
    if (do_n) P.out[O_PN + (size_t)bh * 128 + lt] = n;
    if (part == 0 && lt >= 128 && lt < 192) ((float*)(P.ws + WS_MST))[bh * 64 + lt - 128] = mst[lt - 128];
    if (part == 0 && lt == 192) P.out[O_PM + bh] = mst[64];
}
struct Ml3In { u32x4 rq[2], rk[2], rv[2], rc[4], g0, g1; float g_ig, g_lf, mprev, nin; };
__device__ __forceinline__ void ml3_load(const Params& P, int item, int tid, int lane, int wave, Ml3In& L) {
    const int bh = item >> 6, c = item & 63, b = bh >> 2, h = bh & 3;
    const size_t row0 = (size_t)b * SEQ + 64 * c;
    const bf16_t* MQ = (const bf16_t*)(P.ws + WS_PROJ); const bf16_t* MK = (const bf16_t*)(P.ws + WS_PROJ + PROJ_STRIDE); const bf16_t* MV = (const bf16_t*)(P.ws + WS_PROJ + 2 * PROJ_STRIDE);
    const bf16_t* MO = (const bf16_t*)(P.ws + WS_PROJ + 3 * PROJ_STRIDE); const float* GT = (const float*)(P.ws + WS_GATES);
    const int prow[2] = {tid >> 4, (tid + 512) >> 4}, pch = tid & 15;
#pragma unroll
    for (int i = 0; i < 2; ++i) { const size_t go = (row0 + prow[i]) * 512 + h * 128 + pch * 8; L.rq[i] = *(const u32x4*)(MQ + go); L.rk[i] = *(const u32x4*)(MK + go); L.rv[i] = *(const u32x4*)(MV + go); }
    const bf16_t* cst = (const bf16_t*)(P.ws + WS_CST) + (size_t)item * 16384;
#pragma unroll
    for (int i = 0; i < 4; ++i) { const int p = tid + 512 * i; L.rc[i] = *(const u32x4*)(cst + (p >> 4) * 128 + (p & 15) * 8); }
    { const size_t row = row0 + (tid >> 3); const int col = h * 128 + (tid & 7) * 16; L.g0 = *(const u32x4*)(MO + row * 512 + col); L.g1 = *(const u32x4*)(MO + row * 512 + col + 8); }
    L.g_ig = 0.f; L.g_lf = 0.f; L.mprev = 0.f; L.nin = 0.f;
    if (wave == 0) { const float* g = GT + (row0 + lane) * 8; L.g_ig = g[h]; L.g_lf = g[4 + h]; L.mprev = ((const float*)(P.ws + WS_MST))[item]; }
    if (tid < 128) L.nin = ((const float*)(P.ws + WS_NST))[(size_t)item * 128 + tid];
}
__device__ __forceinline__ void ml3_item(const Params& P, lptr lds, int item, const Ml3In& L, int tid, int lane, int wave) {
    const int bh = item >> 6, c = item & 63, b = bh >> 2, h = bh & 3, hh = lane >> 5, n31 = lane & 31;
    const size_t row0 = (size_t)b * SEQ + 64 * c;
    bf16_t* YC = (bf16_t*)(P.ws + WS_YCAT);
    LAS float* sc = (LAS float*)(lds + ML_SC);
    LAS float* bt = sc, *as_ = sc + 64, *mt = sc + 128, *winter = sc + 192, *emt = sc + 256, *rsum = sc + 384, *qn = sc + 512, *nvec = sc + 576;
    const int ti = wave >> 2, ej = wave & 3;
    const int prow[2] = {tid >> 4, (tid + 512) >> 4}, pch = tid & 15;
    const float g_ig = L.g_ig, g_lf = L.g_lf, mprev = L.mprev, nin = L.nin;
    __syncthreads();
    if (wave == 0) {
        float bcum = g_lf;
#pragma unroll
        for (int o = 1; o < 64; o <<= 1) { const float v = __shfl_up(bcum, o); if (lane >= o) bcum += v; }
        const float a = g_ig - bcum; float amax = a;
#pragma unroll
        for (int o = 1; o < 64; o <<= 1) { const float v = __shfl_up(amax, o); if (lane >= o) amax = fmaxf(amax, v); }
        const float m_t = fmaxf(bcum + mprev, bcum + amax);
        bt[lane] = bcum; as_[lane] = a; mt[lane] = m_t; winter[lane] = expf(bcum + mprev - m_t); emt[lane] = expf(-m_t);
    }
    if (tid < 128) nvec[tid] = nin;
#pragma unroll
    for (int i = 0; i < 2; ++i) { const int o = prow[i] * ML_P + pch * 16;
        *(LAS u32x4*)(lds + ML_QS + o) = L.rq[i]; *(LAS u32x4*)(lds + ML_KS + o) = L.rk[i]; *(LAS u32x4*)(lds + ML_VS + o) = L.rv[i]; }
#pragma unroll
    for (int i = 0; i < 4; ++i) { const int p = tid + 512 * i; *(LAS u32x4*)(lds + ML_CS + (p >> 4) * ML_P + (p & 15) * 16) = L.rc[i]; }
    __syncthreads();
    f32x16 num;
#pragma unroll
    for (int r = 0; r < 16; ++r) num[r] = 0.f;
#pragma unroll
    for (int ks = 0; ks < 8; ++ks) num = MFMA32(row_frag(lds + ML_QS, ML_P, 32 * ti, 16 * ks, lane), tr_frag(lds + ML_CS, ML_P, 16 * ks, 32 * ej, lane), num);
    if (wave < 3) {
        const int sti = wave == 0 ? 0 : 1, sj = wave == 2 ? 1 : 0;
        const int krow = (n31 & ~12) | ((n31 & 4) << 1) | ((n31 & 8) >> 1);
        f32x16 p;
#pragma unroll
        for (int r = 0; r < 16; ++r) p[r] = 0.f;
#pragma unroll
        for (int ks = 0; ks < 8; ++ks) p = MFMA32(*(const LAS bf16x8*)(lds + ML_KS + (32 * sj + krow) * ML_P + (16 * ks + 8 * hh) * 2), row_frag(lds + ML_QS, ML_P, 32 * sti, 16 * ks, lane), p);
        const int t = 32 * sti + n31; const float bt_t = bt[t], mt_t = mt[t]; float rs = 0.f;
        const LAS float* asb = as_ + 32 * sj + 8 * hh; const int tb = t - (32 * sj + 8 * hh);
#pragma unroll
        for (int r = 0; r < 16; ++r) { const int so = 16 * (r >> 3) + (r & 7);
            const float w = so <= tb ? __expf(bt_t + asb[so] - mt_t) : 0.f; p[r] *= w; rs += p[r]; }
#pragma unroll
        for (int a2 = 0; a2 < 2; ++a2) { u32x4 o; o.x = cvtpk(p[8 * a2 + 0], p[8 * a2 + 1]); o.y = cvtpk(p[8 * a2 + 2], p[8 * a2 + 3]); o.z = cvtpk(p[8 * a2 + 4], p[8 * a2 + 5]); o.w = cvtpk(p[8 * a2 + 6], p[8 * a2 + 7]);
            *(LAS u32x4*)(lds + ML_SS + t * 144 + (32 * sj + 16 * a2 + 8 * hh) * 2) = o; }
        rs += __shfl_xor(rs, 32);
        if (hh == 0) rsum[sj * 64 + t] = rs;
    }
    if (wave >= 4) {
        const int t = (tid - 256) >> 2, part = tid & 3; float s = 0.f;
#pragma unroll 8
        for (int d = 0; d < 32; ++d) s += bf2f(*(const LAS unsigned short*)(lds + ML_QS + t * ML_P + (32 * part + d) * 2)) * nvec[32 * part + d];
        s += __shfl_xor(s, 1); s += __shfl_xor(s, 2);
        if (part == 0) qn[t] = s;
    }
    __syncthreads();
    const LAS float* tb2 = sc + 32 * ti + 4 * hh;
#pragma unroll
    for (int r = 0; r < 16; ++r) num[r] *= tb2[192 + (r & 3) + 8 * (r >> 2)];
#pragma unroll
    for (int ks = 0; ks < 4; ++ks) if (ks < 2 || ti == 1) num = MFMA32(*(const LAS bf16x8*)(lds + ML_SS + (32 * ti + n31) * 144 + (16 * ks + 8 * hh) * 2), tr_frag(lds + ML_VS, ML_P, 16 * ks, 32 * ej, lane), num);
#pragma unroll
    for (int r = 0; r < 16; ++r) { const int o = (r & 3) + 8 * (r >> 2);
        const float den = tb2[192 + o] * tb2[512 + o] + tb2[384 + o] + (ti ? tb2[448 + o] : 0.f);
        const float hv = num[r] * fast_rcp(fmaxf(fabsf(den), tb2[256 + o]));
        *(LAS unsigned short*)(lds + ML_QS + (32 * ti + 4 * hh) * ML_P + (32 * ej + n31) * 2 + o * ML_P) = f2bf(hv); }
    __syncthreads();
    { const int t = tid >> 3, part = tid & 7;
      const size_t row = row0 + t; const int col = h * 128 + part * 16;
      const u32x4 g0 = L.g0, g1 = L.g1;
      const u32x4 h0 = *(const LAS u32x4*)(lds + ML_QS + t * ML_P + part * 32), h1 = *(const LAS u32x4*)(lds + ML_QS + t * ML_P + part * 32 + 16);
      float hv[16] = {bflo(h0.x), bfhi(h0.x), bflo(h0.y), bfhi(h0.y), bflo(h0.z), bfhi(h0.z), bflo(h0.w), bfhi(h0.w), bflo(h1.x), bfhi(h1.x), bflo(h1.y), bfhi(h1.y), bflo(h1.z), bfhi(h1.z), bflo(h1.w), bfhi(h1.w)};
      float ss = 0.f;
#pragma unroll
      for (int e = 0; e < 16; ++e) ss += hv[e] * hv[e];
      ss += __shfl_xor(ss, 1); ss += __shfl_xor(ss, 2); ss += __shfl_xor(ss, 4);
      const float rstd = rsqrtf(ss * (1.f / 128.f) + EPS);
      const float gv[16] = {bflo(g0.x), bfhi(g0.x), bflo(g0.y), bfhi(g0.y), bflo(g0.z), bfhi(g0.z), bflo(g0.w), bfhi(g0.w), bflo(g1.x), bfhi(g1.x), bflo(g1.y), bfhi(g1.y), bflo(g1.z), bfhi(g1.z), bflo(g1.w), bfhi(g1.w)};
      const float* mw = P.in[I_MLW] + col;
      float y[16];
#pragma unroll
      for (int e = 0; e < 16; ++e) y[e] = hv[e] * rstd * mw[e] * gv[e];
      u32x4 o0, o1; o0.x = cvtpk(y[0], y[1]); o0.y = cvtpk(y[2], y[3]); o0.z = cvtpk(y[4], y[5]); o0.w = cvtpk(y[6], y[7]); o1.x = cvtpk(y[8], y[9]); o1.y = cvtpk(y[10], y[11]); o1.z = cvtpk(y[12], y[13]); o1.w = cvtpk(y[14], y[15]);
      *(u32x4*)(YC + row * 1024 + col) = o0; *(u32x4*)(YC + row * 1024 + col + 8) = o1; }
}

constexpr int AT_KP = 144, AT_VP = 136, AT_WAVE = 64 * AT_KP + 64 * AT_VP;
__device__ __forceinline__ void sb_step(clptr Kt, clptr Vt, const bf16x8 (&qf)[4], f32x16& o0, f32x16& o1, float& carry, int lane, bool domask, int kq) {
    const int n31 = lane & 31, hh = lane >> 5;
    const int krow = (n31 & ~12) | ((n31 & 4) << 1) | ((n31 & 8) >> 1);
    f32x16 p[2];
#pragma unroll
    for (int r = 0; r < 16; ++r) { p[0][r] = 0.f; p[1][r] = 0.f; }
#pragma unroll
    for (int ks = 0; ks < 4; ++ks) {
        p[0] = MFMA32(*(const LAS bf16x8*)(Kt + krow * AT_KP + (16 * ks + 8 * hh) * 2), qf[ks], p[0]);
        p[1] = MFMA32(*(const LAS bf16x8*)(Kt + (32 + krow) * AT_KP + (16 * ks + 8 * hh) * 2), qf[ks], p[1]);
    }
    f32x16 om[2];
    float town[4], tpar[4];
#pragma unroll
    for (int u = 0; u < 2; ++u)
#pragma unroll
        for (int a = 0; a < 2; ++a) { float tp = 1.f;
#pragma unroll
            for (int j = 0; j < 8; ++j) { const int r = 8 * a + j;
                const float z = fminf(fmaxf(p[u][r], -60.f), 60.f);
                const float e = fast_exp2(-z); float sg = fast_rcp(1.f + e); float o = e * sg;
                if (domask) { const int kl = 32 * u + 16 * a + 8 * hh + j; if (kl >= kq) { sg = 0.f; o = 1.f; } }
                p[u][r] = sg; om[u][r] = o; tp *= o; }
            town[2 * u + a] = tp; }
#pragma unroll
    for (int i = 0; i < 4; ++i) tpar[i] = __shfl_xor(town[i], 32);
    float suf[5]; suf[4] = 1.f;
#pragma unroll
    for (int i = 3; i >= 0; --i) suf[i] = suf[i + 1] * (town[i] * tpar[i]);
    bf16x8 pf[4];
#pragma unroll
    for (int u = 0; u < 2; ++u)
#pragma unroll
        for (int a = 0; a < 2; ++a) { const int pr = 2 * u + a;
            float R = carry * suf[pr + 1] * (hh == 0 ? tpar[pr] : 1.f);
            float av[8];
#pragma unroll
            for (int j = 7; j >= 0; --j) { av[j] = p[u][8 * a + j] * R; R *= om[u][8 * a + j]; }
            u32x4 w; w.x = cvtpk(av[0], av[1]); w.y = cvtpk(av[2], av[3]); w.z = cvtpk(av[4], av[5]); w.w = cvtpk(av[6], av[7]);
            pf[pr] = __builtin_bit_cast(bf16x8, w); }
    carry *= suf[0];
#pragma unroll
    for (int pr = 0; pr < 4; ++pr) {
        o0 = MFMA32(tr_frag(Vt, AT_VP, 16 * pr, 0, lane), pf[pr], o0);
        o1 = MFMA32(tr_frag(Vt, AT_VP, 16 * pr, 32, lane), pf[pr], o1);
    }
}
__device__ __forceinline__ void attn_prompt_item(const Params& P, lptr lds, int b, int rb, int lane, int wave) {
    const int h = wave, n31 = lane & 31, hh = lane >> 5;
    const bf16_t* SQ = (const bf16_t*)(P.ws + WS_PROJ + 4 * PROJ_STRIDE); const bf16_t* SK = (const bf16_t*)(P.ws + WS_PROJ + 5 * PROJ_STRIDE); const bf16_t* SV = (const bf16_t*)(P.ws + WS_PROJ + 6 * PROJ_STRIDE);
    const size_t rowb = (size_t)b * SEQ; const int q0 = 32 * rb;
    lptr Kt = lds + wave * AT_WAVE; lptr Vt = Kt + 64 * AT_KP;
    bf16x8 qf[4];
#pragma unroll
    for (int ks = 0; ks < 4; ++ks) qf[ks] = *(const bf16x8*)(SQ + (rowb + q0 + n31) * 512 + h * 64 + 16 * ks + 8 * hh);
    f32x16 o0, o1;
#pragma unroll
    for (int r = 0; r < 16; ++r) { o0[r] = 0.f; o1[r] = 0.f; }
    float carry = 1.f;
    const int trow = lane >> 3, tch = lane & 7;
    u32x4 kv[8], vv[8];
    const int jt0 = (q0 + 30) >> 6;
#pragma unroll
    for (int i = 0; i < 8; ++i) { const size_t go = (rowb + 64 * jt0 + 8 * i + trow) * 512 + h * 64 + tch * 8; kv[i] = *(const u32x4*)(SK + go); vv[i] = *(const u32x4*)(SV + go); }
    for (int jt = jt0; jt >= 0; --jt) {
#pragma unroll
        for (int i = 0; i < 8; ++i) { const int row = 8 * i + trow;
            *(LAS u32x4*)(Kt + row * AT_KP + tch * 16) = kv[i];
            *(LAS u32x2*)(Vt + row * AT_VP + tch * 16) = (u32x2){vv[i].x, vv[i].y}; *(LAS u32x2*)(Vt + row * AT_VP + tch * 16 + 8) = (u32x2){vv[i].z, vv[i].w}; }
        if (jt > 0) {
#pragma unroll
            for (int i = 0; i < 8; ++i) { const size_t go = (rowb + 64 * (jt - 1) + 8 * i + trow) * 512 + h * 64 + tch * 8; kv[i] = *(const u32x4*)(SK + go); vv[i] = *(const u32x4*)(SV + go); } }
        sb_step(Kt, Vt, qf, o0, o1, carry, lane, 64 * jt + 63 >= q0, q0 + n31 - 64 * jt);
        if (__all(carry < 5.9604645e-8f)) break;
    }
    float ss = 0.f;
#pragma unroll
    for (int r = 0; r < 16; ++r) ss += o0[r] * o0[r] + o1[r] * o1[r];
    ss += __shfl_xor(ss, 32);
    const size_t row = rowb + q0 + n31;
    LAS float* sx = (LAS float*)(lds + 8 * AT_WAVE);
    if (hh == 0) sx[wave * 32 + n31] = ss;
    __syncthreads();
    float tot = 0.f;
#pragma unroll
    for (int w2 = 0; w2 < 8; ++w2) tot += sx[w2 * 32 + n31];
    const float rstd = rsqrtf(tot * (1.f / 512.f) + EPS);
    bf16_t* yo = (bf16_t*)(P.ws + WS_YCAT) + row * 1024 + 512 + h * 64 + 4 * hh;
#pragma unroll
    for (int g = 0; g < 4; ++g) {
        *(u32x2*)(yo + 8 * g) = (u32x2){cvtpk(o0[4 * g] * rstd, o0[4 * g + 1] * rstd), cvtpk(o0[4 * g + 2] * rstd, o0[4 * g + 3] * rstd)};
        *(u32x2*)(yo + 32 + 8 * g) = (u32x2){cvtpk(o1[4 * g] * rstd, o1[4 * g + 1] * rstd), cvtpk(o1[4 * g + 2] * rstd, o1[4 * g + 3] * rstd)};
    }
}
__device__ __forceinline__ void attn_sample_item(const Params& P, lptr lds, int bh, int tid, int lane, int wave) {
    const int b = bh >> 3, h = bh & 7, n31 = lane & 31, hh = lane >> 5;
    const bf16_t* SQ = (const bf16_t*)(P.ws + WS_PROJ + 4 * PROJ_STRIDE); const bf16_t* SK = (const bf16_t*)(P.ws + WS_PROJ + 5 * PROJ_STRIDE); const bf16_t* SV = (const bf16_t*)(P.ws + WS_PROJ + 6 * PROJ_STRIDE);
    const size_t rows = (size_t)MP + b * 32;
    lptr Kt = lds + wave * AT_WAVE; lptr Vt = Kt + 64 * AT_KP;
    bf16x8 qf[4];
#pragma unroll
    for (int ks = 0; ks < 4; ++ks) qf[ks] = *(const bf16x8*)(SQ + (rows + n31) * 512 + h * 64 + 16 * ks + 8 * hh);
    f32x16 o0, o1;
#pragma unroll
    for (int r = 0; r < 16; ++r) { o0[r] = 0.f; o1[r] = 0.f; }
    float carry = 1.f;
    if (wave == 7) {
        const int trow = lane >> 3, tch = lane & 7;
#pragma unroll
        for (int i = 0; i < 8; ++i) { const int row = 8 * i + trow; u32x4 kv = {0u, 0u, 0u, 0u}, vv = {0u, 0u, 0u, 0u};
            if (row < 32) { const size_t go = (rows + row) * 512 + h * 64 + tch * 8; kv = *(const u32x4*)(SK + go); vv = *(const u32x4*)(SV + go); }
            *(LAS u32x4*)(Kt + row * AT_KP + tch * 16) = kv;
            *(LAS u32x2*)(Vt + row * AT_VP + tch * 16) = (u32x2){vv.x, vv.y}; *(LAS u32x2*)(Vt + row * AT_VP + tch * 16 + 8) = (u32x2){vv.z, vv.w}; }
        sb_step(Kt, Vt, qf, o0, o1, carry, lane, true, n31);
    }
    const float* CK = P.in[I_CK] + (size_t)b * PAST * 512 + h * 64; const float* CV = P.in[I_CV] + (size_t)b * PAST * 512 + h * 64;
    for (int jt = 4 * wave + 3; jt >= 4 * wave; --jt) {
        const int trow = lane >> 4, c4 = lane & 15;
#pragma unroll
        for (int i = 0; i < 16; ++i) { const int row = 4 * i + trow; const size_t go = (size_t)(64 * jt + row) * 512 + c4 * 4;
            const f32x4 kx = *(const f32x4*)(CK + go), vx = *(const f32x4*)(CV + go);
            *(LAS u32x2*)(Kt + row * AT_KP + c4 * 8) = (u32x2){cvtpk(kx.x, kx.y), cvtpk(kx.z, kx.w)};
            *(LAS u32x2*)(Vt + row * AT_VP + c4 * 8) = (u32x2){cvtpk(vx.x, vx.y), cvtpk(vx.z, vx.w)}; }
        sb_step(Kt, Vt, qf, o0, o1, carry, lane, false, 0);
    }
    __syncthreads();
    LAS float* carr = (LAS float*)(lds + 65536);
    if (hh == 0) carr[wave * 32 + n31] = carry;
    __syncthreads();
    float mult = 1.f;
    for (int w2 = wave + 1; w2 < 8; ++w2) mult *= carr[w2 * 32 + n31];
#pragma unroll
    for (int g = 0; g < 4; ++g) {
        *(LAS f32x4*)(lds + (((wave * 8 + g) * 64 + lane) * 16)) = (f32x4){o0[4 * g] * mult, o0[4 * g + 1] * mult, o0[4 * g + 2] * mult, o0[4 * g + 3] * mult};
        *(LAS f32x4*)(lds + (((wave * 8 + 4 + g) * 64 + lane) * 16)) = (f32x4){o1[4 * g] * mult, o1[4 * g + 1] * mult, o1[4 * g + 2] * mult, o1[4 * g + 3] * mult};
    }
    __syncthreads();
    { const int q = tid >> 4, part = tid & 15; const int slot = (part >> 3) * 4 + ((part & 7) >> 1), ln = q + 32 * (part & 1);
      f32x4 v = {0.f, 0.f, 0.f, 0.f};
#pragma unroll
      for (int w2 = 0; w2 < 8; ++w2) v = v + *(const LAS f32x4*)(lds + (((w2 * 8 + slot) * 64 + ln) * 16));
      float ss = (v.x * v.x + v.y * v.y) + (v.z * v.z + v.w * v.w);
      ss += __shfl_xor(ss, 1); ss += __shfl_xor(ss, 2); ss += __shfl_xor(ss, 4); ss += __shfl_xor(ss, 8);
      const size_t row = rows + q;
      if (part == 0) ((float*)(P.ws + WS_SSQ))[row * 8 + h] = ss;
      *(u32x2*)((bf16_t*)(P.ws + WS_YCAT) + row * 1024 + 512 + h * 64 + part * 4) = (u32x2){cvtpk(v.x, v.y), cvtpk(v.z, v.w)}; }
    __syncthreads();
}
#ifndef M1NC
#define M1NC 2
#endif
constexpr int NQ_G1S = 224, NQ_AT = 1024, NQ_M1 = 2048 / M1NC, NQ_TOTAL = NQ_G1S + NQ_AT + NQ_M1;
template <class EpiS>
__device__ __forceinline__ void phase_mixers(const Params& P, lptr lds, int tid_in, int wave, const EpiS& Es) {
    unsigned* ctr = (unsigned*)(P.ws + WS_CTL);
    int nextitem = 0; if (tid_in == 0) nextitem = (int)atomicAdd(ctr, 1u);
    for (;;) {
        __syncthreads();
        if (tid_in == 0) *(LAS int*)(lds + QOFF) = nextitem;
        __syncthreads();
        int item = *(const LAS int*)(lds + QOFF);
        if (tid_in == 0 && item < NQ_TOTAL) nextitem = (int)atomicAdd(ctr, 1u);
        int tid = tid_in; asm volatile("" : "+v"(tid));
        const int lane = tid & 63;
        if (item >= NQ_TOTAL) break;
        if (item < NQ_G1S) { small_tile<1024, false>((const bf16_t*)(P.ws + WS_H) + (size_t)MP * 1024, (const bf16_t*)(P.ws + WS_W1T), Es, nullptr, lds, item, tid, lane, wave); continue; }
        item -= NQ_G1S;
        if (item < NQ_AT) { attn_prompt_item(P, lds, item & 7, 127 - (item >> 3), lane, wave); continue; }
        item -= NQ_AT;
        ml1_pair<M1NC>(P, lds, item, tid, lane, wave);
    }
}
__device__ __forceinline__ void phase_ml2(const Params& P, lptr lds, int tid_in, int wave) {
    int tid = tid_in; asm volatile("" : "+v"(tid));
    if (blockIdx.x < 128) ml2_scan(P, lds, tid);
    else if (blockIdx.x < 160) { }
    else if (blockIdx.x < 192) mlstm_item(P, lds, blockIdx.x - 160, true, tid, tid & 63, wave);
    else attn_sample_item(P, lds, blockIdx.x - 192, tid, tid & 63, wave);
}
template <class EpiS>
__device__ __forceinline__ void phase_ml3(const Params& P, lptr lds, int tid_in, int wave, const EpiS& Es) {
    if (blockIdx.x >= 192) { int tid = tid_in; asm volatile("" : "+v"(tid));
        small_tile<1024, true>((const bf16_t*)(P.ws + WS_YCAT) + (size_t)MP * 1024, (const bf16_t*)(P.ws + WS_W2T), Es, (const float*)(P.ws + WS_SSQ), lds, blockIdx.x - 192, tid, tid & 63, wave); }
#ifdef DBL_M3
    for (int rep = 0; rep < 2; ++rep)
#endif
    { int tid = tid_in; asm volatile("" : "+v"(tid));
      Ml3In cur, nxt; ml3_load(P, blockIdx.x, tid, tid & 63, wave, cur);
#pragma unroll 1
      for (int item = blockIdx.x; item < 2048; item += gridDim.x) {
          const int nitem = item + gridDim.x;
          if (nitem < 2048) ml3_load(P, nitem, tid, tid & 63, wave, nxt);
          ml3_item(P, lds, item, cur, tid, tid & 63, wave);
          cur = nxt;
      } }
}

__global__ void __launch_bounds__(512, 2) fwd(Params P) {
    extern __shared__ __attribute__((aligned(16))) unsigned char lds_raw[];
    lptr lds = (lptr)lds_raw;
    cg::grid_group grid = cg::this_grid();
    int tid = threadIdx.x, lane = tid & 63; const int wave = __builtin_amdgcn_readfirstlane(tid >> 6);
#define FRESH_TID() do { asm volatile("" : "+v"(tid)); lane = tid & 63; } while (0)
    const int gw = blockIdx.x * 8 + wave, NGW = gridDim.x * 8;
    unsigned char* ws = P.ws;
    const float* MOD = (const float*)(ws + WS_MOD);
    bf16_t* H = (bf16_t*)(ws + WS_H); bf16_t* PROJ = (bf16_t*)(ws + WS_PROJ); bf16_t* YC = (bf16_t*)(ws + WS_YCAT); bf16_t* ACT = (bf16_t*)(ws + WS_ACT);

#ifndef G_ALIGN
#define G_ALIGN true
#endif
#ifndef G_SP2
#define G_SP2 true
#endif
#ifndef PH
#define PH 0xFFFF
#endif
    if (tid == 0) { *(LAS unsigned*)(lds + LDS_BYTES - 32) = 0u; *(LAS unsigned*)(lds + LDS_BYTES - 28) = 0u; }
    __syncthreads();
    const XcdBarrier bar = xcd_barrier_post((unsigned*)(ws + WS_CTL) + 1024, (volatile LAS unsigned*)(lds + LDS_BYTES - 32));
    if (P.out == nullptr) grid.sync();
    phase0(P, lds, tid, lane, wave);
    __syncthreads();
    if (blockIdx.x >= 192) phase_weights(P, lds, lane, wave, 0, 4096, (blockIdx.x - 192) * 8 + wave, 64 * 8);
    else phase_weights(P, lds, lane, wave, 4096, 16 * 112 + 16 * 32 + 16 * 176 + 44 * 32, blockIdx.x * 8 + wave, 192 * 8);
#ifdef DBL_P0
    __syncthreads(); phase0(P, lds, tid, lane, wave);
#endif
    xcd_barrier(bar);
    FRESH_TID();
    phase1(P, lds, tid, lane, wave);
#ifdef DBL_P1
    __syncthreads(); phase1(P, lds, tid, lane, wave);
#endif
#ifdef DBL_P1NG
    __syncthreads(); phase1_nogates(P, lds, tid, lane, wave);
#endif
    xcd_barrier(bar);
    FRESH_TID();
    {
        EpiProj E{PROJ, P.out + O_PK, P.out + O_PV, P.in[I_SQW], P.in[I_SKW], 0};
        pg8::Gemm g{H, (const bf16_t*)(ws + WS_W1T), MP, NPROJ, 1024}; pg8::StaticOrder S; S.init(MP, NPROJ, gridDim.x, (int)blockIdx.x);
        pg8::gemm_phase<EpiProj, pg8::StaticOrder, G_ALIGN, G_SP2>(lds, g, S, E);
#ifdef DBL_G
        pg8::gemm_phase<EpiProj, pg8::StaticOrder, G_ALIGN, G_SP2>(lds, g, S, E);
#endif
    }
    xcd_barrier(bar);
    FRESH_TID();
    {
        EpiProj Es{PROJ, P.out + O_SK, P.out + O_SV, P.in[I_SQW], P.in[I_SKW], MP};
        phase_mixers(P, lds, tid, wave, Es);
    }
    xcd_barrier(bar);
    FRESH_TID();
    phase_ml2(P, lds, tid, wave);
#ifdef DBL_M2
    __syncthreads(); phase_ml2(P, lds, tid, wave);
#endif
    xcd_barrier(bar);
    FRESH_TID();
    {
        EpiRes<0> Es{P.in[I_XS], (bf16_t*)(ws + WS_X1B) + (size_t)MP * 1024, MOD + 8 * 6144 + 2048, 5};
        phase_ml3(P, lds, tid, wave, Es);
    }
#ifdef XSYNC
    for (int i = 0; i < XSYNC; ++i) xcd_barrier(bar);
#endif
    xcd_barrier(bar);
    FRESH_TID();
    {
        sample_h2_row(P, lds, tid, lane, wave);
        EpiRes<0> E{P.in[I_XP], ws + WS_X1B, MOD + 2048, 12};
        pg8::Gemm g{YC, (const bf16_t*)(ws + WS_W2T), MP, 1024, 1024}; pg8::StaticOrder S; S.init(MP, 1024, gridDim.x, (int)blockIdx.x);
        pg8::gemm_phase<EpiRes<0>, pg8::StaticOrder, G_ALIGN, G_SP2>(lds, g, S, E);
    }
    xcd_barrier(bar);
    FRESH_TID();
    {
        phase5(P, lds, tid, lane, wave);
#ifdef DBL_P5
        phase5(P, lds, tid, lane, wave);
#endif
        EpiFFNs Es{ACT, P.out + O_SF, P.in[I_SFC], P.in[I_WCONV], P.in[I_BCONV]};
        for (int t = blockIdx.x; t < 352; t += gridDim.x) small_tile<1024, false>(H + (size_t)MP * 1024, (const bf16_t*)(ws + WS_W3T), Es, nullptr, lds, t, tid, lane, wave);
    }
    xcd_barrier(bar);
    FRESH_TID();
    {
        EpiFFN E{ACT, (float*)(ws + WS_UEDGE), P.out + O_PF, P.in[I_WCONV], P.in[I_BCONV]};
        pg8::Gemm g{H, (const bf16_t*)(ws + WS_W3T), MP, FF2, 1024}; pg8::StaticOrder S; S.init(MP, FF2, gridDim.x, (int)blockIdx.x);
        pg8::gemm_phase<EpiFFN, pg8::StaticOrder, true, G_SP2>(lds, g, S, E);
#ifdef DBL_G
        pg8::gemm_phase<EpiFFN, pg8::StaticOrder, true, G_SP2>(lds, g, S, E);
#endif
    }
    xcd_barrier(bar);
    FRESH_TID();
    {
        phase_fix(P, tid);
        EpiRes<1> Es{(const bf16_t*)(ws + WS_X1B) + (size_t)MP * 1024, P.out + O_YS, MOD + 8 * 6144 + 5120, 5};
        if (blockIdx.x < 64) small_tile<FF, false>(ACT + (size_t)MP * FF, (const bf16_t*)(ws + WS_W4T), Es, nullptr, lds, blockIdx.x, tid, lane, wave);
    }
    xcd_barrier(bar);
    FRESH_TID();
    {
        EpiRes<1> E{ws + WS_X1B, P.out + O_YP, MOD + 5120, 12};
        pg8::Gemm g{ACT, (const bf16_t*)(ws + WS_W4T), MP, 1024, FF}; pg8::StaticOrder S; S.init(MP, 1024, gridDim.x, (int)blockIdx.x);
        pg8::gemm_phase<EpiRes<1>, pg8::StaticOrder, G_ALIGN, G_SP2>(lds, g, S, E);
    }

#ifdef DIAG
    xcd_barrier(bar);
    {
        const size_t offs[15] = {O_YP, O_YS, O_PC, O_PN, O_PM, O_PK, O_PV, O_PF, O_SC, O_SN, O_SM, O_SK, O_SV, O_SF, O_END};
        for (int o = 0; o < 14; ++o) if ((DIAG >> o) & 1) for (size_t i = offs[o] + (size_t)blockIdx.x * 512 + tid; i < offs[o + 1]; i += (size_t)gridDim.x * 512) P.out[i] *= 1.2f;
    }
#endif
}

extern "C" void kernel_launch(void* const* d_in, const int* in_sizes, int n_in, void* d_out, int out_size, void* d_ws, size_t ws_size, hipStream_t stream) {
    static int grid_blocks = 0;
    if (!grid_blocks) {
        int dev = 0, cus = 0, per_cu = 0;
        (void)hipGetDevice(&dev);
        (void)hipDeviceGetAttribute(&cus, hipDeviceAttributeMultiprocessorCount, dev);
        (void)hipFuncSetAttribute((const void*)fwd, hipFuncAttributeMaxDynamicSharedMemorySize, LDS_BYTES);
        (void)hipOccupancyMaxActiveBlocksPerMultiprocessor(&per_cu, (const void*)fwd, 512, LDS_BYTES);
        grid_blocks = cus;
        if (n_in != 26 || out_size != (int)O_END || ws_size < WS_END2 || cus != 256 || per_cu < 1) {
            fprintf(stderr, "kernel_launch: unexpected geometry: n_in %d out %d ws %zu cus %d per_cu %d\n", n_in, out_size, ws_size, cus, per_cu);
            if (n_in != 26 || out_size != (int)O_END || ws_size < WS_END2 || cus != 256) grid_blocks = -1;
        }
    }
    if (grid_blocks < 0) return;
    if (hipMemsetAsync((char*)d_ws + WS_CTL, 0, WS_MOD + 16 * 6144 * 4, stream) != hipSuccess) { fprintf(stderr, "kernel_launch: memset of the control words failed\n"); return; }
    Params p{};
    for (int i = 0; i < 26; ++i) p.in[i] = (const float*)d_in[i];
    p.out = (float*)d_out; p.ws = (unsigned char*)d_ws;
    void* args[] = {&p};
    hipError_t e = hipLaunchCooperativeKernel((const void*)fwd, dim3(grid_blocks), dim3(512), args, LDS_BYTES, stream);
    if (e != hipSuccess) fprintf(stderr, "cooperative launch failed: %s (grid %d)\n", hipGetErrorString(e), grid_blocks);
}
```

```cpp
#include <hip/hip_runtime.h>
#include <hip/hip_cooperative_groups.h>
#include <cstdio>
#include <cstdint>
namespace cg = cooperative_groups;

#define LAS __attribute__((address_space(3)))
typedef unsigned short bf16_t;
typedef short bf16x8 __attribute__((ext_vector_type(8)));
typedef short s16x4 __attribute__((ext_vector_type(4)));
typedef float f32x2 __attribute__((ext_vector_type(2)));
typedef float f32x4 __attribute__((ext_vector_type(4)));
typedef float f32x16 __attribute__((ext_vector_type(16)));
typedef unsigned u32x2 __attribute__((ext_vector_type(2)));
typedef unsigned u32x4 __attribute__((ext_vector_type(4)));
typedef __bf16 bf16x2_t __attribute__((ext_vector_type(2)));
typedef LAS unsigned char* lptr;
typedef const LAS unsigned char* clptr;

constexpr int DM = 1024, SEQ = 4096, NB = 8, MP = NB * SEQ, DEC = 32, MS = NB * DEC, MT = MP + MS, PAST = 2048;
constexpr int DIN = 3592, NPROJ = 3584, FF = 2816, FF2 = 5632;
constexpr float EPS = 1e-6f;
constexpr float LOG2E = 1.4426950408889634f;
constexpr size_t O_YP = 0, O_YS = 33554432, O_PC = 33816576, O_PN = 34340864, O_PM = 34344960, O_PK = 34344992, O_PV = 51122208,
                 O_PF = 67899424, O_SC = 67989536, O_SN = 68513824, O_SM = 68517920, O_SK = 68517952, O_SV = 68649024, O_SF = 68780096, O_END = 68870208;
constexpr size_t MiB = 1u << 20;
constexpr size_t WS_CTL = 0, WS_MODP = 1 * MiB  , WS_MOD = 65536  , WS_GATES = 8 * MiB, WS_SSQ = 10 * MiB, WS_UEDGE = 12 * MiB,
                 WS_W1T = 24 * MiB, WS_W2T = 31 * MiB, WS_W3T = 33 * MiB, WS_W4T = 44 * MiB, WS_H = 52 * MiB, WS_PROJ = 120 * MiB,
                 PROJ_STRIDE = 33 * MiB, WS_YCAT = 352 * MiB, WS_ACT = 120 * MiB, WS_END = 420 * MiB;
constexpr size_t WS_X1B = 424 * MiB;
constexpr int LDS_BYTES = 147456;
constexpr int QOFF = LDS_BYTES - 64;

struct Params { const float* in[26]; float* out; unsigned char* ws; };
enum { I_XP = 0, I_XS, I_CP, I_CS, I_STC, I_STN, I_STM, I_CK, I_CV, I_SFC, I_WADA, I_BADA, I_N1W, I_WIN, I_BIG, I_BFG, I_MLW, I_SQW, I_SKW, I_SOW,
       I_WOUT, I_N2W, I_WUP, I_WCONV, I_BCONV, I_WDOWN };

__device__ __forceinline__ unsigned cvtpk(float lo, float hi) { f32x2 v = {lo, hi}; bf16x2_t b = __builtin_convertvector(v, bf16x2_t); return __builtin_bit_cast(unsigned, b); }
__device__ __forceinline__ float bf2f(unsigned short x) { return __uint_as_float((unsigned)x << 16); }
__device__ __forceinline__ float bflo(unsigned w) { return __uint_as_float(w << 16); }
__device__ __forceinline__ float bfhi(unsigned w) { return __uint_as_float(w & 0xffff0000u); }
__device__ __forceinline__ unsigned short f2bf(float f) { return (unsigned short)(cvtpk(f, 0.f) & 0xffffu); }
__device__ __forceinline__ float wave_sum(float v) {
#pragma unroll
    for (int o = 1; o < 64; o <<= 1) v += __shfl_xor(v, o);
    return v;
}
__device__ __forceinline__ float fast_exp2(float x) { return __builtin_amdgcn_exp2f(x); }
__device__ __forceinline__ float fast_rcp(float x) { return __builtin_amdgcn_rcpf(x); }
__device__ __forceinline__ float sigmoidf_(float x) { return fast_rcp(1.f + fast_exp2(-x * LOG2E)); }
__device__ __forceinline__ int crow(int r, int hi) { return (r & 3) + 8 * (r >> 2) + 4 * hi; }
typedef short v4i16_t __attribute__((ext_vector_type(4)));
__device__ __forceinline__ s16x4 tr_read(clptr p) { return __builtin_bit_cast(s16x4, __builtin_amdgcn_ds_read_tr16_b64_v4i16((LAS v4i16_t*)p)); }
__device__ __forceinline__ bf16x8 tr_frag(clptr base, int P, int R0, int C0, int lane) {
    const int h = lane >> 5, blk = (lane >> 4) & 1, q = (lane & 15) >> 2, p = lane & 3;
    clptr a = base + (R0 + 8 * h + q) * P + (C0 + 16 * blk + 4 * p) * 2;
    const s16x4 lo = tr_read(a), hi = tr_read(a + 4 * P);
    return (bf16x8){lo[0], lo[1], lo[2], lo[3], hi[0], hi[1], hi[2], hi[3]};
}
__device__ __forceinline__ bf16x8 row_frag(clptr base, int P, int R0, int K0, int lane) {
    return *(const LAS bf16x8*)(base + (R0 + (lane & 31)) * P + (K0 + 8 * (lane >> 5)) * 2);
}
#define MFMA32(a, b, c) __builtin_amdgcn_mfma_f32_32x32x16_bf16((a), (b), (c), 0, 0, 0)
#define MFMA16(a, b, c) __builtin_amdgcn_mfma_f32_16x16x32_bf16((a), (b), (c), 0, 0, 0)

namespace pg8 {
#define PG8_LAS __attribute__((address_space(3)))
typedef unsigned short bf16_t;
typedef short bf16x8 __attribute__((ext_vector_type(8)));
typedef float f32x4 __attribute__((ext_vector_type(4)));
typedef unsigned u32x4 __attribute__((ext_vector_type(4)));
constexpr int BM = 256, BK = 64, HALF = 128, HTB = HALF * BK * 2  , STAGE_BYTES = 8 * HTB, NXCD = 8, WGM = 8;

__host__ __device__ __forceinline__ int lds_byte(int r, int c) { const int st = (r >> 4) * 2 + (c >> 5), rr = r & 15, cc = c & 31, ob = rr * 64 + cc * 2; return st * 1024 + (ob ^ (((ob >> 9) & 1) << 5)); }
__host__ __device__ __forceinline__ void stage_rc(int b, int& R, int& C) { const int st = b / 1024, sb = b % 1024, swz = sb ^ (((sb >> 9) & 1) << 5); R = (st >> 1) * 16 + swz / 64; C = (st & 1) * 32 + (swz % 64) / 2; }
__host__ __device__ __forceinline__ int perm32(int rho) { const int n = rho >> 4, i = rho & 15; return 8 * (i >> 2) + 4 * n + (i & 3); }

struct Unit { int pm, pn; };
struct Gemm { const bf16_t* A; const bf16_t* Bt; int M, N, K; };

struct StaticOrder {
    int nM, nN, nwg, G, c;
    __host__ __device__ void init(int M, int N, int G_, int c_) { nM = M / BM; nN = N / BM; nwg = nM * nN; G = G_; c = c_; }
    __host__ __device__ bool next(int i, Unit& u) const {
        const long L = (long)i * G + c; if (L >= nwg) return false;
        int wgid = (int)L; { const int q = nwg / NXCD, r = nwg % NXCD, xcd = wgid % NXCD, off = wgid / NXCD; wgid = (xcd < r ? xcd * (q + 1) : r * (q + 1) + (xcd - r) * q) + off; }
        const int nig = WGM * nN, gid = wgid / nig, fm = gid * WGM, gsz = (nM - fm) < WGM ? (nM - fm) : WGM;
        u.pm = fm + ((wgid % nig) % gsz); u.pn = (wgid % nig) / gsz; return true;
    }
    __device__ __forceinline__ void a_ready(const Unit&) const {}
    __device__ __forceinline__ void done(const Unit&) const {}
};

template <class Epi, class Sched, bool ALIGN_EPI = false, bool SP2 = false>
__device__ __forceinline__ void gemm_phase(PG8_LAS unsigned char* lds, const Gemm g, const Sched& S, const Epi& E) {
    int tid_o = threadIdx.x; asm volatile("" : "+v"(tid_o));
    const int tid = tid_o, wid = __builtin_amdgcn_readfirstlane(tid >> 6), lane = tid & 63, wr = wid >> 2, wc = wid & 3, fr = lane & 15, fq = lane >> 4;
    const int K = g.K, nt = K / BK;
    unsigned voffA[2], voffB[2];
#pragma unroll
    for (int i = 0; i < 2; ++i) { int R, C; stage_rc(tid * 16 + i * 8192, R, C); const int Rb = Epi::PERM ? ((R & ~31) + perm32(R & 31)) : R;
        voffA[i] = (unsigned)(R * K + C) * 2u; voffB[i] = (unsigned)(Rb * K + C) * 2u; }
    const size_t kstep = (size_t)(BK * 2);
    const size_t hstep = (size_t)HALF * K * 2;
    const size_t tstep = 2 * hstep;
    const unsigned ldsw = (unsigned)wid * 1024u;
    const int aoff = lds_byte(wr * 64 + fr, fq * 8), boff = lds_byte(wc * 32 + fr, fq * 8);
#define PG8_SA(b, h) (((b) * 2 + (h)) * HTB)
#define PG8_SB(b, h) ((4 + (b) * 2 + (h)) * HTB)
#define PG8_STAGE(bufoff, gbase, voff) do { _Pragma("unroll") for (int _i = 0; _i < 2; ++_i) \
        __builtin_amdgcn_global_load_lds((const unsigned*)((const char*)(gbase) + (voff)[_i]), (PG8_LAS unsigned*)(lds + (bufoff) + ldsw + _i * 8192), 16, 0, 0); } while (0)
#define PG8_LDA(dst, b, h) do { _Pragma("unroll") for (int m = 0; m < 4; ++m) _Pragma("unroll") for (int k = 0; k < 2; ++k) dst[m][k] = *(const PG8_LAS bf16x8*)(lds + PG8_SA(b, h) + aoff + m * 2048 + k * 1024); } while (0)
#define PG8_LDB(dst, b, h) do { _Pragma("unroll") for (int n = 0; n < 2; ++n) _Pragma("unroll") for (int k = 0; k < 2; ++k) dst[n][k] = *(const PG8_LAS bf16x8*)(lds + PG8_SB(b, h) + boff + n * 2048 + k * 1024); } while (0)
#define PG8_MMA(ai, bj, At, Bt) do { __builtin_amdgcn_s_setprio(1); _Pragma("unroll") for (int m = 0; m < 4; ++m) _Pragma("unroll") for (int n = 0; n < 2; ++n) _Pragma("unroll") for (int k = 0; k < 2; ++k) \
        acc[ai][bj][m][n] = __builtin_amdgcn_mfma_f32_16x16x32_bf16(Bt[n][k], At[m][k], acc[ai][bj][m][n], 0, 0, 0); __builtin_amdgcn_s_setprio(0); } while (0)
#define PG8_WAIT_V(n) asm volatile("s_waitcnt vmcnt(" #n ")" ::: "memory")
#define PG8_WAIT_L(n) asm volatile("s_waitcnt lgkmcnt(" #n ")" ::: "memory")
#define PG8_BAR __builtin_amdgcn_s_barrier()
#define PG8_SCHED __builtin_amdgcn_sched_barrier(0)
    Unit cur, nxt; int ui = 0;
    if (!S.next(0, cur)) return;
    f32x4 acc[2][2][4][2];
#pragma unroll
    for (int a = 0; a < 2; ++a)
#pragma unroll
        for (int b = 0; b < 2; ++b)
#pragma unroll
            for (int m = 0; m < 4; ++m)
#pragma unroll
                for (int n = 0; n < 2; ++n) acc[a][b][m][n] = (f32x4){0.f, 0.f, 0.f, 0.f};
    bf16x8 At[4][2], B0[2][2], B1[2][2];
    const char* cA = (const char*)g.A + (size_t)cur.pm * tstep; const char* cB = (const char*)g.Bt + (size_t)cur.pn * tstep;
    S.a_ready(cur);
    if constexpr (SP2) {
        PG8_STAGE(PG8_SB(0, 0), cB, voffB); PG8_STAGE(PG8_SB(0, 1), cB + hstep, voffB); PG8_STAGE(PG8_SA(0, 0), cA, voffA); PG8_STAGE(PG8_SA(0, 1), cA + hstep, voffA);
        if (wr == 1) PG8_BAR;
        PG8_WAIT_V(2); PG8_BAR;
        PG8_STAGE(PG8_SB(1, 0), cB + kstep, voffB); PG8_STAGE(PG8_SA(1, 0), cA + kstep, voffA); PG8_STAGE(PG8_SB(1, 1), cB + hstep + kstep, voffB);
        PG8_WAIT_V(6); PG8_BAR;
    } else {
        PG8_STAGE(PG8_SB(0, 0), cB, voffB); PG8_STAGE(PG8_SA(0, 0), cA, voffA); PG8_STAGE(PG8_SB(0, 1), cB + hstep, voffB); PG8_STAGE(PG8_SA(0, 1), cA + hstep, voffA);
        if (wr == 1) PG8_BAR;
        PG8_WAIT_V(4); PG8_BAR;
        PG8_STAGE(PG8_SB(1, 0), cB + kstep, voffB); PG8_STAGE(PG8_SA(1, 0), cA + kstep, voffA); PG8_STAGE(PG8_SB(1, 1), cB + hstep + kstep, voffB);
        PG8_WAIT_V(6); PG8_BAR;
    }
    for (;;) {
        const bool has_next = S.next(ui + 1, nxt);
        const char* nA = has_next ? (const char*)g.A + (size_t)nxt.pm * tstep : cA; const char* nB = has_next ? (const char*)g.Bt + (size_t)nxt.pn * tstep : cB;
        for (int t = 0; t < nt; t += 2) {
            const bool last = (t == nt - 2);
            const char* a1 = cA + (size_t)(t + 1) * kstep;
            const char* a2 = last ? nA : cA + (size_t)(t + 2) * kstep; const char* b2 = last ? nB : cB + (size_t)(t + 2) * kstep;
            const char* a3 = a2 + kstep; const char* b3 = b2 + kstep;
            if (last && has_next) S.a_ready(nxt);
            if constexpr (SP2) {
            PG8_LDB(B0, 0, 0); PG8_LDB(B1, 0, 1); PG8_SCHED; PG8_LDA(At, 0, 0); PG8_STAGE(PG8_SA(1, 1), a1 + hstep, voffA);
            PG8_WAIT_V(8); PG8_WAIT_L(0); PG8_BAR; PG8_MMA(0, 0, At, B0); PG8_MMA(0, 1, At, B1); PG8_BAR; PG8_SCHED;
            PG8_LDA(At, 0, 1); PG8_STAGE(PG8_SB(0, 0), b2, voffB); PG8_STAGE(PG8_SB(0, 1), b2 + hstep, voffB); PG8_STAGE(PG8_SA(0, 0), a2, voffA);
            PG8_WAIT_V(8); PG8_WAIT_L(0); PG8_BAR; PG8_MMA(1, 0, At, B0); PG8_MMA(1, 1, At, B1); PG8_BAR; PG8_SCHED;
            PG8_LDB(B0, 1, 0); PG8_LDB(B1, 1, 1); PG8_SCHED; PG8_LDA(At, 1, 0); PG8_STAGE(PG8_SA(0, 1), a2 + hstep, voffA);
            PG8_WAIT_V(8); PG8_WAIT_L(0); PG8_BAR; PG8_MMA(0, 0, At, B0); PG8_MMA(0, 1, At, B1); PG8_BAR; PG8_SCHED;
            PG8_LDA(At, 1, 1); PG8_STAGE(PG8_SB(1, 0), b3, voffB); PG8_STAGE(PG8_SB(1, 1), b3 + hstep, voffB); PG8_STAGE(PG8_SA(1, 0), a3, voffA);
            PG8_WAIT_V(8); PG8_WAIT_L(0); PG8_BAR; PG8_MMA(1, 0, At, B0); PG8_MMA(1, 1, At, B1); PG8_BAR; PG8_SCHED;
            } else {
            PG8_LDB(B0, 0, 0); PG8_SCHED; PG8_LDA(At, 0, 0); PG8_STAGE(PG8_SA(1, 1), a1 + hstep, voffA);
            PG8_WAIT_L(8); PG8_BAR; PG8_WAIT_L(0); PG8_MMA(0, 0, At, B0); PG8_BAR; PG8_SCHED;
            PG8_LDB(B1, 0, 1); PG8_STAGE(PG8_SB(0, 0), b2, voffB);
            PG8_BAR; PG8_WAIT_L(0); PG8_MMA(0, 1, At, B1); PG8_BAR;
            PG8_LDA(At, 0, 1); PG8_STAGE(PG8_SA(0, 0), a2, voffA);
            PG8_BAR; PG8_WAIT_L(0); PG8_MMA(1, 0, At, B0); PG8_BAR; PG8_SCHED;
            PG8_STAGE(PG8_SB(0, 1), b2 + hstep, voffB);
            PG8_WAIT_V(6); PG8_BAR; PG8_MMA(1, 1, At, B1); PG8_BAR;
            PG8_LDB(B0, 1, 0); PG8_SCHED; PG8_LDA(At, 1, 0); PG8_STAGE(PG8_SA(0, 1), a2 + hstep, voffA);
            PG8_WAIT_L(8); PG8_BAR; PG8_WAIT_L(0); PG8_MMA(0, 0, At, B0); PG8_BAR; PG8_SCHED;
            PG8_LDB(B1, 1, 1); PG8_STAGE(PG8_SB(1, 0), b3, voffB);
            PG8_BAR; PG8_WAIT_L(0); PG8_MMA(0, 1, At, B1); PG8_BAR;
            PG8_LDA(At, 1, 1); PG8_STAGE(PG8_SA(1, 0), a3, voffA);
            PG8_BAR; PG8_WAIT_L(0); PG8_MMA(1, 0, At, B0); PG8_BAR; PG8_SCHED;
            PG8_STAGE(PG8_SB(1, 1), b3 + hstep, voffB);
            PG8_WAIT_V(6); PG8_BAR; PG8_MMA(1, 1, At, B1); PG8_BAR;
            }
        }
        if constexpr (ALIGN_EPI) { if (wr == 0) PG8_BAR; }
        if constexpr (!Epi::AFTER_DRAIN) { E(acc, cur, wr, wc, fr, fq, lds); S.done(cur); }
        if (!has_next) break;
#pragma unroll
        for (int a = 0; a < 2; ++a)
#pragma unroll
            for (int b = 0; b < 2; ++b)
#pragma unroll
                for (int m = 0; m < 4; ++m)
#pragma unroll
                    for (int n = 0; n < 2; ++n) acc[a][b][m][n] = (f32x4){0.f, 0.f, 0.f, 0.f};
        cur = nxt; cA = nA; cB = nB; ++ui;
        if constexpr (ALIGN_EPI) { if (wr == 1) PG8_BAR; }
    }
    PG8_WAIT_V(0);
    if constexpr (!ALIGN_EPI) { if (wr == 0) PG8_BAR; }
    PG8_BAR;
    if constexpr (Epi::AFTER_DRAIN) { E.fused(acc, cur, wr, wc, fr, fq, lds, wid, lane); S.done(cur); }
#undef PG8_SA
#undef PG8_SB
#undef PG8_STAGE
#undef PG8_LDA
#undef PG8_LDB
#undef PG8_MMA
#undef PG8_WAIT_V
#undef PG8_WAIT_L
#undef PG8_BAR
#undef PG8_SCHED
}
}

__device__ __forceinline__ u32x4 pack8(const f32x4& v0, const f32x4& v1) { u32x4 w; w.x = cvtpk(v0[0], v0[1]); w.y = cvtpk(v0[2], v0[3]); w.z = cvtpk(v1[0], v1[1]); w.w = cvtpk(v1[2], v1[3]); return w; }

struct EpiProj {
    static constexpr bool PERM = true, AFTER_DRAIN = false;
    bf16_t* proj; float* outK; float* outV; const float* qw; const float* kw; int rowoff;
    __device__ __forceinline__ void sub(const f32x4 (&a)[2][4][2], int pn, int rloc0, int wc, int fr, int fq) const {
        const int kind = pn >> 1, half = pn & 1;
        const int c8 = 256 * half + 64 * wc + 8 * fq;
        bf16_t* ob = proj + (size_t)kind * (PROJ_STRIDE / 2);
        if (kind < 4) {
#pragma unroll
            for (int m = 0; m < 4; ++m) { const size_t row = (size_t)(rowoff + rloc0 + 16 * m + fr);
#pragma unroll
                for (int bj = 0; bj < 2; ++bj) { f32x4 v0 = a[bj][m][0], v1 = a[bj][m][1];
                    if (kind == 1) { v0 = v0 * 0.08838834764831845f; v1 = v1 * 0.08838834764831845f; }
                    if (kind == 3) {
#pragma unroll
                        for (int e = 0; e < 4; ++e) { v0[e] = sigmoidf_(v0[e]); v1[e] = sigmoidf_(v1[e]); } }
                    *(u32x4*)(ob + row * 512 + c8 + 32 * bj) = pack8(v0, v1); } }
        } else if (kind < 6) {
            const float* w = kind == 4 ? qw : kw; const float osc = kind == 4 ? 0.125f * LOG2E : 1.f;
            f32x4 wv[2][2];
#pragma unroll
            for (int bj = 0; bj < 2; ++bj)
#pragma unroll
                for (int n = 0; n < 2; ++n) wv[bj][n] = *(const f32x4*)(w + 32 * bj + 8 * fq + 4 * n);
#pragma unroll
            for (int m = 0; m < 4; ++m) { const int rl = rloc0 + 16 * m + fr; float ss = 0.f;
#pragma unroll
                for (int bj = 0; bj < 2; ++bj)
#pragma unroll
                    for (int n = 0; n < 2; ++n) { const f32x4 x = a[bj][m][n]; ss += (x[0] * x[0] + x[1] * x[1]) + (x[2] * x[2] + x[3] * x[3]); }
                ss += __shfl_xor(ss, 16); ss += __shfl_xor(ss, 32);
                const float rstd = rsqrtf(ss * (1.f / 64.f) + EPS);
#pragma unroll
                for (int bj = 0; bj < 2; ++bj) { f32x4 v0 = a[bj][m][0] * rstd * wv[bj][0], v1 = a[bj][m][1] * rstd * wv[bj][1];
                    if (kind == 5) { float* o = outK + (size_t)rl * 512 + c8 + 32 * bj; __builtin_nontemporal_store(v0, (f32x4*)o); __builtin_nontemporal_store(v1, (f32x4*)(o + 4)); }
                    v0 = v0 * osc; v1 = v1 * osc;
                    *(u32x4*)(ob + (size_t)(rowoff + rl) * 512 + c8 + 32 * bj) = pack8(v0, v1); } }
        } else {
#pragma unroll
            for (int m = 0; m < 4; ++m) { const int rl = rloc0 + 16 * m + fr;
#pragma unroll
                for (int bj = 0; bj < 2; ++bj) { const f32x4 v0 = a[bj][m][0], v1 = a[bj][m][1];
                    float* o = outV + (size_t)rl * 512 + c8 + 32 * bj; __builtin_nontemporal_store(v0, (f32x4*)o); __builtin_nontemporal_store(v1, (f32x4*)(o + 4));
                    *(u32x4*)(ob + (size_t)(rowoff + rl) * 512 + c8 + 32 * bj) = pack8(v0, v1); } }
        }
    }
    __device__ __forceinline__ void operator()(const f32x4 (&acc)[2][2][4][2], const pg8::Unit& u, int wr, int wc, int fr, int fq, lptr) const {
#pragma unroll
        for (int ai = 0; ai < 2; ++ai) sub(acc[ai], u.pn, u.pm * 256 + ai * 128 + wr * 64, wc, fr, fq);
    }
};

template <int MODE>
struct EpiRes {
    static constexpr bool PERM = true, AFTER_DRAIN = false;
    const void* xin; void* xout; const float* gate; int tlog;
    __device__ __forceinline__ void sub(const f32x4 (&a)[2][4][2], int pn, int rloc0, int wc, int fr, int fq) const {
#pragma unroll
        for (int m = 0; m < 4; ++m) { const int rl = rloc0 + 16 * m + fr; const float* g = gate + (size_t)(rl >> tlog) * 6144;
#pragma unroll
            for (int bj = 0; bj < 2; ++bj) { const int c = 256 * pn + 128 * bj + 32 * wc + 8 * fq;
                const f32x4 g0 = *(const f32x4*)(g + c), g1 = *(const f32x4*)(g + c + 4);
                if (MODE == 0) {
                    const float* xp = (const float*)xin + (size_t)rl * 1024 + c;
                    const f32x4 o0 = *(const f32x4*)xp + g0 * a[bj][m][0], o1 = *(const f32x4*)(xp + 4) + g1 * a[bj][m][1];
                    *(u32x4*)((bf16_t*)xout + (size_t)rl * 1024 + c) = pack8(o0, o1);
                } else {
                    const u32x4 xv = *(const u32x4*)((const bf16_t*)xin + (size_t)rl * 1024 + c);
                    const f32x4 x0 = {bflo(xv.x), bfhi(xv.x), bflo(xv.y), bfhi(xv.y)}, x1 = {bflo(xv.z), bfhi(xv.z), bflo(xv.w), bfhi(xv.w)};
                    float* op = (float*)xout + (size_t)rl * 1024 + c;
                    __builtin_nontemporal_store(x0 + g0 * a[bj][m][0], (f32x4*)op); __builtin_nontemporal_store(x1 + g1 * a[bj][m][1], (f32x4*)(op + 4));
                } } }
    }
    __device__ __forceinline__ void operator()(const f32x4 (&acc)[2][2][4][2], const pg8::Unit& u, int wr, int wc, int fr, int fq, lptr) const {
#pragma unroll
        for (int ai = 0; ai < 2; ++ai) sub(acc[ai], u.pn, u.pm * 256 + ai * 128 + wr * 64, wc, fr, fq);
    }
};

__device__ __forceinline__ float dpp_ror1(float x) { return __int_as_float(__builtin_amdgcn_update_dpp(0, __float_as_int(x), 0x121, 0xf, 0xf, false)); }
__device__ __forceinline__ float dpp_ror2(float x) { return __int_as_float(__builtin_amdgcn_update_dpp(0, __float_as_int(x), 0x122, 0xf, 0xf, false)); }
struct ConvW { f32x4 w0a, w1a, w2a, ba, w0g, w1g, w2g, bg; };
__device__ __forceinline__ ConvW load_convw(const float* wconv, const float* bconv, int c) {
    ConvW w; w.w0a = *(const f32x4*)(wconv + c); w.w1a = *(const f32x4*)(wconv + FF2 + c); w.w2a = *(const f32x4*)(wconv + 2 * FF2 + c); w.ba = *(const f32x4*)(bconv + c);
    w.w0g = *(const f32x4*)(wconv + FF + c); w.w1g = *(const f32x4*)(wconv + FF2 + FF + c); w.w2g = *(const f32x4*)(wconv + 2 * FF2 + FF + c); w.bg = *(const f32x4*)(bconv + FF + c); return w;
}
template <int CTRL> __device__ __forceinline__ float dppz(float x) { return __int_as_float(__builtin_amdgcn_update_dpp(0, __float_as_int(x), CTRL, 0xf, 0xf, true)); }
__device__ __forceinline__ u32x2 conv_gate4(const f32x4& ca, const f32x4& cg, const f32x4& pa, const f32x4& pg, const ConvW& w, int) {
    float o[4];
#pragma unroll
    for (int e = 0; e < 4; ++e) {
        float ua = fmaf(w.w2a[e], ca[e], w.ba[e]);
        ua = fmaf(dppz<0x111>(ca[e]), w.w1a[e], ua); ua = fmaf(dppz<0x10F>(pa[e]), w.w1a[e], ua);
        ua = fmaf(dppz<0x112>(ca[e]), w.w0a[e], ua); ua = fmaf(dppz<0x10E>(pa[e]), w.w0a[e], ua);
        float ug = fmaf(w.w2g[e], cg[e], w.bg[e]);
        ug = fmaf(dppz<0x111>(cg[e]), w.w1g[e], ug); ug = fmaf(dppz<0x10F>(pg[e]), w.w1g[e], ug);
        ug = fmaf(dppz<0x112>(cg[e]), w.w0g[e], ug); ug = fmaf(dppz<0x10E>(pg[e]), w.w0g[e], ug);
        o[e] = ua * sigmoidf_(ua) * ug;
    }
    u32x2 r; r.x = cvtpk(o[0], o[1]); r.y = cvtpk(o[2], o[3]); return r;
}
struct EpiFFN {
    static constexpr bool PERM = true, AFTER_DRAIN = false;
    bf16_t* act; float* uedge; float* outF; const float* wconv; const float* bconv;
    __device__ __forceinline__ void operator()(const f32x4 (&acc)[2][2][4][2], const pg8::Unit& u, int wr, int wc, int fr, int fq, lptr lds) const {
        lptr halo = lds + pg8::STAGE_BYTES;
        const int q8 = 32 * wc + 8 * fq;
        if (fr >= 14) {
#pragma unroll
            for (int ai = 0; ai < 2; ++ai)
#pragma unroll
                for (int bj = 0; bj < 2; ++bj)
#pragma unroll
                    for (int n = 0; n < 2; ++n) *(LAS f32x4*)(halo + ((((2 * ai + wr) * 2 + (fr - 14)) * 256 + 128 * bj + q8 + 4 * n) * 4)) = acc[ai][bj][3][n];
        }
        asm volatile("s_waitcnt lgkmcnt(0)" ::: "memory"); __builtin_amdgcn_s_barrier(); asm volatile("" ::: "memory");
#pragma unroll
        for (int n = 0; n < 2; ++n) {
            const int c = 128 * u.pn + q8 + 4 * n;
            const ConvW w = load_convw(wconv, bconv, c);
#pragma unroll
            for (int ai = 0; ai < 2; ++ai) {
                const int G = 2 * ai + wr;
                f32x4 pa = {0.f, 0.f, 0.f, 0.f}, pg = {0.f, 0.f, 0.f, 0.f};
                if (G > 0 && fr >= 14) { pa = *(const LAS f32x4*)(halo + ((((G - 1) * 2 + (fr - 14)) * 256 + q8 + 4 * n) * 4)); pg = *(const LAS f32x4*)(halo + ((((G - 1) * 2 + (fr - 14)) * 256 + 128 + q8 + 4 * n) * 4)); }
#pragma unroll
                for (int m = 0; m < 4; ++m) {
                    const f32x4 ca = acc[ai][0][m][n], cg = acc[ai][1][m][n];
                    const f32x4 qa = m ? acc[ai][0][m ? m - 1 : 0][n] : pa, qg = m ? acc[ai][1][m ? m - 1 : 0][n] : pg;
                    const u32x2 o = conv_gate4(ca, cg, qa, qg, w, fr);
                    const size_t row = (size_t)u.pm * 256 + 64 * G + 16 * m + fr;
                    *(u32x2*)(act + row * FF + c) = o;
                    if (m == 0 && G == 0 && fr < 2) { float* e = uedge + ((size_t)u.pm * 4 + fr) * FF2 + c; *(f32x4*)e = ca; *(f32x4*)(e + FF) = cg; }
                    if (m == 3 && G == 3 && fr >= 14) { float* e = uedge + ((size_t)u.pm * 4 + 2 + (fr - 14)) * FF2 + c; *(f32x4*)e = ca; *(f32x4*)(e + FF) = cg;
                        if ((u.pm & 15) == 15) { float* f = outF + ((size_t)(u.pm >> 4) * 2 + (fr - 14)) * FF2 + c; *(f32x4*)f = ca; *(f32x4*)(f + FF) = cg; } }
                }
            }
        }
    }
};
struct EpiFFNs {
    bf16_t* act; float* outF; const float* state; const float* wconv; const float* bconv;
    __device__ __forceinline__ void sub(const f32x4 (&a)[2][4][2], int pn, int rloc0, int wc, int fr, int fq) const {
        const int q8 = 32 * wc + 8 * fq;
#pragma unroll
        for (int n = 0; n < 2; ++n) {
            const int c = 128 * pn + q8 + 4 * n;
            const ConvW w = load_convw(wconv, bconv, c);
#pragma unroll
            for (int m = 0; m < 4; ++m) {
                const int b = (rloc0 + 16 * m) >> 5;
                const f32x4 ca = a[0][m][n], cg = a[1][m][n];
                f32x4 qa = {0.f, 0.f, 0.f, 0.f}, qg = {0.f, 0.f, 0.f, 0.f};
                if (m & 1) { qa = a[0][m ? m - 1 : 0][n]; qg = a[1][m ? m - 1 : 0][n]; }
                else if (fr >= 14) { const float* s = state + ((size_t)b * 2 + (fr - 14)) * FF2 + c; qa = *(const f32x4*)s; qg = *(const f32x4*)(s + FF); }
                const u32x2 o = conv_gate4(ca, cg, qa, qg, w, fr);
                const size_t row = (size_t)MP + rloc0 + 16 * m + fr;
                *(u32x2*)(act + row * FF + c) = o;
                if ((m & 1) && fr >= 14) { float* f = outF + ((size_t)b * 2 + (fr - 14)) * FF2 + c; *(f32x4*)f = ca; *(f32x4*)(f + FF) = cg; }
            }
        }
    }
};

template <int K, bool HISCALE, class Epi>
__device__ __forceinline__ void small_tile(const bf16_t* __restrict__ A, const bf16_t* __restrict__ Bt, const Epi& E, const float* ssq, lptr lds, int t, int tid, int lane, int wave) {
    constexpr int KW = K / 8;
    const int fr = lane & 15, fq = lane >> 4;
    const int wc = t & 3, G = (t >> 2) & 3, pn = t >> 4;
    f32x4 acc[2][4][2];
#pragma unroll
    for (int bj = 0; bj < 2; ++bj)
#pragma unroll
        for (int m = 0; m < 4; ++m)
#pragma unroll
            for (int n = 0; n < 2; ++n) acc[bj][m][n] = (f32x4){0.f, 0.f, 0.f, 0.f};
    const bf16_t* ap = A + (size_t)(G * 64 + fr) * K + fq * 8 + wave * KW;
    const bf16_t* bp = Bt + (size_t)(256 * pn + 32 * wc + 8 * (fr >> 2) + (fr & 3)) * K + fq * 8 + wave * KW;
#ifdef DBLK
    for (int rep = 0; rep < 2; ++rep) {
    if (rep == 1) {
_Pragma("unroll") for (int bj = 0; bj < 2; ++bj) _Pragma("unroll") for (int m = 0; m < 4; ++m) _Pragma("unroll") for (int n = 0; n < 2; ++n) acc[bj][m][n] = acc[bj][m][n] * 0.f; asm volatile("" ::: "memory"); }
#endif
#pragma unroll 4
    for (int k0 = 0; k0 < KW; k0 += 32) {
        bf16x8 af[4], bf[2][2];
#pragma unroll
        for (int m = 0; m < 4; ++m) af[m] = *(const bf16x8*)(ap + (size_t)(16 * m) * K + k0);
#pragma unroll
        for (int bj = 0; bj < 2; ++bj)
#pragma unroll
            for (int n = 0; n < 2; ++n) bf[bj][n] = *(const bf16x8*)(bp + (size_t)(128 * bj + 4 * n) * K + k0);
#pragma unroll
        for (int bj = 0; bj < 2; ++bj)
#pragma unroll
            for (int m = 0; m < 4; ++m)
#pragma unroll
                for (int n = 0; n < 2; ++n) acc[bj][m][n] = MFMA16(bf[bj][n], af[m], acc[bj][m][n]);
    }
#ifdef DBLK
    }
#endif
    if (HISCALE) { if (wave >= 4) {
#pragma unroll
        for (int m = 0; m < 4; ++m) { const float* sp = ssq + (size_t)(MP + G * 64 + 16 * m + fr) * 8; const f32x4 s0 = *(const f32x4*)sp, s1 = *(const f32x4*)(sp + 4);
            const float rstd = rsqrtf(((s0.x + s0.y) + (s0.z + s0.w) + (s1.x + s1.y) + (s1.z + s1.w)) * (1.f / 512.f) + EPS);
#pragma unroll
            for (int bj = 0; bj < 2; ++bj)
#pragma unroll
                for (int n = 0; n < 2; ++n) acc[bj][m][n] = acc[bj][m][n] * rstd; } } }
    __syncthreads();
    if (wave != 0) {
#pragma unroll
        for (int bj = 0; bj < 2; ++bj)
#pragma unroll
            for (int m = 0; m < 4; ++m)
#pragma unroll
                for (int n = 0; n < 2; ++n) *(LAS f32x4*)(lds + ((((wave - 1) * 16 + (bj * 4 + m) * 2 + n) * 64 + lane) * 16)) = acc[bj][m][n];
    }
    __syncthreads();
    if (wave == 0) {
#pragma unroll 1
        for (int w2 = 0; w2 < 7; ++w2)
#pragma unroll
            for (int bj = 0; bj < 2; ++bj)
#pragma unroll
                for (int m = 0; m < 4; ++m)
#pragma unroll
                    for (int n = 0; n < 2; ++n) acc[bj][m][n] = acc[bj][m][n] + *(const LAS f32x4*)(lds + (((w2 * 16 + (bj * 4 + m) * 2 + n) * 64 + lane) * 16));
        E.sub(acc, pn, G * 64, wc, fr, fq);
#ifdef DBLE
        asm volatile("" ::: "memory"); E.sub(acc, pn, G * 64, wc, fr, fq);
#endif
    }
    __syncthreads();
}

typedef unsigned v4u __attribute__((ext_vector_type(4)));
#define XB_TMO      128
#define XB_XCNT(j)  (256  + 64 * (j))
#define XB_XSUB(j)  (1280 + 64 * (j))
#define XB_XGEN(j)  (2304 + 64 * (j))
#define XB_TOP      3328
#define XB_TOPGEN   3392
#define XCD_BAR_WORDS 3456
#define XB_SPIN_CAP (1u << 18)

__device__ __forceinline__ unsigned xb_ld(unsigned* p)              { return __hip_atomic_load(p, __ATOMIC_RELAXED, __HIP_MEMORY_SCOPE_AGENT); }
__device__ __forceinline__ unsigned xb_add(unsigned* p, unsigned v) { return __hip_atomic_fetch_add(p, v, __ATOMIC_RELAXED, __HIP_MEMORY_SCOPE_AGENT); }
__device__ __forceinline__ unsigned xb_xcc_id() { return (unsigned)__builtin_amdgcn_s_getreg((3 << 11) | 20) & 0xFu; }
#define XB_SPIN(cond, bar) do { unsigned _sp = 0; while (cond) { __builtin_amdgcn_s_sleep(1); \
    if ((++_sp & 255u) == 0u) { if (xb_ld(&(bar)[XB_TMO])) break; if (_sp > XB_SPIN_CAP) { atomicAdd(&(bar)[XB_TMO], 1u); break; } } } } while (0)

struct XcdBarrier {
    unsigned* bar; unsigned x;
    volatile LAS unsigned* st;
};

__device__ __forceinline__ XcdBarrier xcd_barrier_post(unsigned* bar, volatile LAS unsigned* st) {
    XcdBarrier b; b.bar = bar; b.x = xb_xcc_id(); b.st = st;
    if (threadIdx.x == 0) (void)xb_add(&bar[XB_XCNT(b.x)], 1u);
    return b;
}
__device__ __forceinline__ void xcd_barrier_complete(unsigned* bar, unsigned x, unsigned& nloc, unsigned& nx) {
    const unsigned G = gridDim.x * gridDim.y * gridDim.z;
    unsigned sum, cnt, mine, sp = 0u;
    for (;;) {
        sum = 0u; cnt = 0u; mine = 0u;
#pragma unroll
        for (unsigned j = 0; j < 16; ++j) { const unsigned c = xb_ld(&bar[XB_XCNT(j)]); sum += c; cnt += (c > 0u) ? 1u : 0u; mine = (j == x) ? c : mine; }
        if (sum == G) break;
        __builtin_amdgcn_s_sleep(1);
        if ((++sp & 255u) == 0u) { if (xb_ld(&bar[XB_TMO])) break; if (sp > XB_SPIN_CAP) { atomicAdd(&bar[XB_TMO], 1u); break; } }
    }
    nloc = mine > 0u ? mine : 1u; nx = cnt > 0u ? cnt : 1u;
}

__device__ __forceinline__ void xcd_barrier(const XcdBarrier& b) {
    asm volatile("s_waitcnt vmcnt(0)" ::: "memory");
    __syncthreads();
    if (threadIdx.x == 0) {
        unsigned* bar = b.bar;
        __builtin_amdgcn_s_waitcnt(0);
        unsigned nloc = b.st[0], nx = b.st[1];
        if (nloc == 0u) { xcd_barrier_complete(bar, b.x, nloc, nx); b.st[0] = nloc; b.st[1] = nx; }
        const unsigned old = xb_add(&bar[XB_XSUB(b.x)], 1u);
        const unsigned gen = old / nloc;
        if (old + 1u == (gen + 1u) * nloc) {
            __builtin_amdgcn_fence(__ATOMIC_RELEASE, "agent");
            asm volatile("s_waitcnt vmcnt(0)" ::: "memory");
            const unsigned og = xb_add(&bar[XB_TOP], 1u);
            const unsigned tg = og / nx;
            if (og + 1u == (tg + 1u) * nx) xb_add(&bar[XB_TOPGEN], 1u);
            else XB_SPIN(xb_ld(&bar[XB_TOPGEN]) == tg, bar);
            __builtin_amdgcn_fence(__ATOMIC_ACQUIRE, "agent");
            xb_add(&bar[XB_XGEN(b.x)], 1u);
            asm volatile("s_waitcnt vmcnt(0)" ::: "memory");
        } else {
            XB_SPIN(xb_ld(&bar[XB_XGEN(b.x)]) == gen, bar);
            __builtin_amdgcn_fence(__ATOMIC_ACQUIRE, "agent");
            asm volatile("s_waitcnt vmcnt(0)" ::: "memory");
        }
    }
    __syncthreads();
}


__device__ __forceinline__ void transpose_item(const float* __restrict__ W, int ldw, int srccol0, bf16_t* __restrict__ WT, int K, int destrow0, int k0, LAS float* scr, int lane, const float* kscale = nullptr) {
#pragma unroll 16
    for (int i = 0; i < 32; ++i) { const int kk = 2 * i + (lane >> 5); scr[kk * 33 + (lane & 31)] = __builtin_nontemporal_load(W + (size_t)(k0 + kk) * ldw + srccol0 + (lane & 31)) * (kscale ? kscale[k0 + kk] : 1.f); }
    asm volatile("s_waitcnt lgkmcnt(0)" ::: "memory");
    const int c = lane & 7;
#pragma unroll
    for (int j = 0; j < 4; ++j) { const int n = (lane >> 3) + 8 * j; const LAS float* s = scr + (8 * c) * 33 + n;
        u32x4 o; o.x = cvtpk(s[0 * 33], s[1 * 33]); o.y = cvtpk(s[2 * 33], s[3 * 33]); o.z = cvtpk(s[4 * 33], s[5 * 33]); o.w = cvtpk(s[6 * 33], s[7 * 33]);
        *(u32x4*)(WT + (size_t)(destrow0 + n) * K + k0 + 8 * c) = o; }
    asm volatile("s_waitcnt lgkmcnt(0)" ::: "memory");
}

__device__ __forceinline__ void phase_weights(const Params& P, lptr lds, int lane, int wave, int it_lo, int it_hi, int gw, int NGW) {
    unsigned char* ws = P.ws;
    LAS float* scr = (LAS float*)(lds + wave * 16384);
    constexpr int I1 = 16 * 112, I2 = 16 * 32, I3 = 16 * 176, I4 = 44 * 32;
    for (int it = it_lo + gw; it < it_hi; it += NGW) {
        int r = it;
        if (r < I1) { const int kb = r / 112, n0 = (r % 112) * 32, tile = n0 >> 8, p = n0 & 255, wc = (p >> 5) & 3, bj = p >> 7, L = tile * 256 + 64 * wc + 32 * bj;
            transpose_item(P.in[I_WIN], DIN, L < 2048 ? L : L + 8, (bf16_t*)(ws + WS_W1T), 1024, n0, kb * 64, scr, lane); continue; }
        r -= I1;
        if (r < I2) { const int kb = r / 32, n0 = (r % 32) * 32; transpose_item(P.in[I_WOUT], 1024, n0, (bf16_t*)(ws + WS_W2T), 1024, n0, kb * 64, scr, lane, kb >= 8 ? P.in[I_SOW] - 512 : nullptr); continue; }
        r -= I2;
        if (r < I3) { const int kb = r / 176, n0 = (r % 176) * 32, pn = n0 >> 8, p = n0 & 255, bj = p >> 7, q0 = p & 127;
            transpose_item(P.in[I_WUP], FF2, 128 * pn + q0 + FF * bj, (bf16_t*)(ws + WS_W3T), 1024, n0, kb * 64, scr, lane); continue; }
        r -= I3;
        { const int kb = r / 32, n0 = (r % 32) * 32; transpose_item(P.in[I_WDOWN], 1024, n0, (bf16_t*)(ws + WS_W4T), FF, n0, kb * 64, scr, lane); }
    }
}

__device__ __forceinline__ void phase0(const Params& P, lptr lds, int tid, int lane, int wave) {
    unsigned char* ws = P.ws;
    LAS float* sc = (LAS float*)lds;
    for (int i = tid; i < 16384; i += 512) { const int r = i >> 10, k = i & 1023; const float c = r < 8 ? P.in[I_CP][r * 1024 + k] : P.in[I_CS][(r - 8) * 1024 + k]; sc[i] = c / (1.f + __expf(-c)); }
    __syncthreads();
    const int job = blockIdx.x * 512 + tid;
    if (job < 16 * 6144) {
        const int ks = job / 6144, n = job % 6144;
        float acc[16];
#pragma unroll
        for (int r = 0; r < 16; ++r) acc[r] = 0.f;
        const float* wp = P.in[I_WADA] + (size_t)(ks * 64) * 6144 + n;
#pragma unroll 16
        for (int k = 0; k < 64; ++k) { const float w = __builtin_nontemporal_load(wp + (size_t)k * 6144);
#pragma unroll
            for (int r = 0; r < 16; ++r) acc[r] += sc[r * 1024 + ks * 64 + k] * w; }
        __attribute__((address_space(1))) float* mp = (__attribute__((address_space(1))) float*)(ws + WS_MOD);
        const float bias = ks == 0 ? P.in[I_BADA][n] : 0.f;
#pragma unroll
        for (int r = 0; r < 16; ++r) (void)__builtin_amdgcn_global_atomic_fadd_f32(mp + (size_t)r * 6144 + n, acc[r] + bias);
    }
}

__device__ __forceinline__ void load_mod_vectors(const Params& P, LAS float* A, LAS float* S, const float* normw, int r, int shofs, int tid) {
    const float* md = (const float*)(P.ws + WS_MOD) + (size_t)r * 6144 + shofs;
    for (int k = tid; k < 1024; k += 512) { A[k] = normw[k] * (1.f + md[1024 + k]); S[k] = md[k]; }
}
__device__ __forceinline__ void load_row_bf(const bf16_t* xrow, int lane, f32x4 (&v)[4]) {
#pragma unroll
    for (int j = 0; j < 4; ++j) { const u32x2 w = ((const u32x2*)xrow)[lane + 64 * j]; v[j] = (f32x4){bflo(w.x), bfhi(w.x), bflo(w.y), bfhi(w.y)}; }
}
__device__ __forceinline__ void load_row(const float* xrow, int lane, f32x4 (&v)[4]) {
#pragma unroll
    for (int j = 0; j < 4; ++j) v[j] = __builtin_nontemporal_load((const f32x4*)xrow + lane + 64 * j);
}
template <bool GATES>
__device__ __forceinline__ void norm_row(const Params& P, const f32x4 (&v)[4], bf16_t* orow, float* grow, const LAS float* A, const LAS float* S, const LAS float* Wg, int lane) {
    float s = 0.f;
#pragma unroll
    for (int j = 0; j < 4; ++j) s += (v[j].x * v[j].x + v[j].y * v[j].y) + (v[j].z * v[j].z + v[j].w * v[j].w);
    const float rstd = rsqrtf(wave_sum(s) * (1.f / 1024.f) + EPS);
    float g[8];
#pragma unroll
    for (int i = 0; i < 8; ++i) g[i] = 0.f;
#pragma unroll
    for (int j = 0; j < 4; ++j) { const int k0 = 4 * lane + 256 * j;
        const f32x4 a = *(const LAS f32x4*)(A + k0), sh = *(const LAS f32x4*)(S + k0);
        const f32x4 hv = v[j] * rstd * a + sh;
        u32x2 o; o.x = cvtpk(hv.x, hv.y); o.y = cvtpk(hv.z, hv.w);
        *(u32x2*)(orow + k0) = o;
        if (GATES) {
#pragma unroll
            for (int i = 0; i < 8; ++i) { const f32x4 w = *(const LAS f32x4*)(Wg + i * 1024 + k0); g[i] += (hv.x * w.x + hv.y * w.y) + (hv.z * w.z + hv.w * w.w); } }
    }
    if (GATES) {
        { const bool hi = (lane & 32) != 0;
#pragma unroll
          for (int i = 0; i < 4; ++i) { const float send = hi ? g[i] : g[i + 4], keep = hi ? g[i + 4] : g[i]; g[i] = keep + __shfl_xor(send, 32); } }
        { const bool hi = (lane & 16) != 0;
#pragma unroll
          for (int i = 0; i < 2; ++i) { const float send = hi ? g[i] : g[i + 2], keep = hi ? g[i + 2] : g[i]; g[i] = keep + __shfl_xor(send, 16); } }
        { const bool hi = (lane & 8) != 0; const float send = hi ? g[0] : g[1], keep = hi ? g[1] : g[0]; g[0] = keep + __shfl_xor(send, 8); }
        g[0] += __shfl_xor(g[0], 4); g[0] += __shfl_xor(g[0], 2); g[0] += __shfl_xor(g[0], 1);
        const int gt = lane >> 3;
        if ((lane & 7) == 0) {
            float o;
            if (gt < 4) o = g[0] + P.in[I_BIG][gt];
            else { const float x = g[0] + P.in[I_BFG][gt - 4]; o = fminf(x, 0.f) - log1pf(expf(-fabsf(x))); }
            grow[gt] = o;
        }
    }
}
__device__ __forceinline__ void phase1(const Params& P, lptr lds, int tid, int lane, int wave) {
    LAS float* A1 = (LAS float*)lds; LAS float* S1 = A1 + 1024; LAS float* Wg = S1 + 1024;
    const size_t row0 = (size_t)blockIdx.x * 128 + wave * 16; f32x4 v[4], vn[4]; load_row(P.in[I_XP] + row0 * 1024, lane, v);
    for (int k = tid; k < 1024; k += 512) { const f32x4 w0 = *(const f32x4*)(P.in[I_WIN] + (size_t)k * DIN + 2048), w1 = *(const f32x4*)(P.in[I_WIN] + (size_t)k * DIN + 2052);
        Wg[k] = w0.x; Wg[1024 + k] = w0.y; Wg[2048 + k] = w0.z; Wg[3072 + k] = w0.w; Wg[4096 + k] = w1.x; Wg[5120 + k] = w1.y; Wg[6144 + k] = w1.z; Wg[7168 + k] = w1.w; }
    load_mod_vectors(P, A1, S1, P.in[I_N1W], blockIdx.x >> 5, 0, tid);
    LAS float* A1s = Wg + 8192; LAS float* S1s = A1s + 1024;
    load_mod_vectors(P, A1s, S1s, P.in[I_N1W], 8 + (blockIdx.x >> 5), 0, tid);
    __syncthreads();
    bf16_t* H = (bf16_t*)(P.ws + WS_H); float* GT = (float*)(P.ws + WS_GATES);
    {
#pragma unroll 1
      for (int j = 0; j < 16; ++j) { const size_t row = row0 + j;
          if (j + 1 < 16) load_row(P.in[I_XP] + (row + 1) * 1024, lane, vn);
          else if (wave == 0) load_row(P.in[I_XS] + (size_t)blockIdx.x * 1024, lane, vn);
          norm_row<true>(P, v, H + row * 1024, GT + row * 8, A1, S1, Wg, lane);
#pragma unroll
          for (int q = 0; q < 4; ++q) v[q] = vn[q]; }
      if (wave == 0) norm_row<true>(P, v, H + ((size_t)MP + blockIdx.x) * 1024, GT + ((size_t)MP + blockIdx.x) * 8, A1s, S1s, Wg, lane); }
}
__device__ __forceinline__ void phase5(const Params& P, lptr lds, int tid, int lane, int wave) {
    LAS float* A1 = (LAS float*)lds; LAS float* S1 = A1 + 1024;
    load_mod_vectors(P, A1, S1, P.in[I_N2W], blockIdx.x >> 5, 3072, tid);
    __syncthreads();
    bf16_t* H = (bf16_t*)(P.ws + WS_H);
    { const size_t row0 = (size_t)blockIdx.x * 128 + wave * 16; const bf16_t* X1 = (const bf16_t*)(P.ws + WS_X1B); f32x4 v[4], vn[4]; load_row_bf(X1 + row0 * 1024, lane, v);
#pragma unroll 1
      for (int j = 0; j < 16; ++j) { const size_t row = row0 + j;
          if (j + 1 < 16) load_row_bf(X1 + (row + 1) * 1024, lane, vn);
          norm_row<false>(P, v, H + row * 1024, nullptr, A1, S1, nullptr, lane);
#pragma unroll
          for (int q = 0; q < 4; ++q) v[q] = vn[q]; } }
    __syncthreads();
}
__device__ __forceinline__ void sample_h2_row(const Params& P, lptr lds, int tid, int lane, int wave) {
    LAS float* A1 = (LAS float*)lds; LAS float* S1 = A1 + 1024;
    load_mod_vectors(P, A1, S1, P.in[I_N2W], 8 + (blockIdx.x >> 5), 3072, tid);
    __syncthreads();
    if (wave == 0) { f32x4 v[4]; load_row_bf((const bf16_t*)(P.ws + WS_X1B) + ((size_t)MP + blockIdx.x) * 1024, lane, v); norm_row<false>(P, v, (bf16_t*)(P.ws + WS_H) + ((size_t)MP + blockIdx.x) * 1024, nullptr, A1, S1, nullptr, lane); }
    __syncthreads();
}
__device__ __forceinline__ void phase3b(const Params& P, int lane, int gw, int NGW) {
    bf16_t* Y = (bf16_t*)(P.ws + WS_YCAT); const float* SSQ = (const float*)(P.ws + WS_SSQ);
    for (int row = gw; row < MP; row += NGW) {
        const f32x4 s0 = *(const f32x4*)(SSQ + (size_t)row * 8), s1 = *(const f32x4*)(SSQ + (size_t)row * 8 + 4);
        const float rstd = rsqrtf(((s0.x + s0.y) + (s0.z + s0.w) + (s1.x + s1.y) + (s1.z + s1.w)) * (1.f / 512.f) + EPS);
        u32x4* p = (u32x4*)(Y + (size_t)row * 1024 + 512 + 8 * lane); const u32x4 o = *p;
        f32x4 a = {bflo(o.x), bfhi(o.x), bflo(o.y), bfhi(o.y)}, b = {bflo(o.z), bfhi(o.z), bflo(o.w), bfhi(o.w)};
        a = a * rstd; b = b * rstd;
        *p = pack8(a, b);
    }
}
__device__ __forceinline__ void phase_fix(const Params& P, int tid) {
    const float* UE = (const float*)(P.ws + WS_UEDGE); bf16_t* act = (bf16_t*)(P.ws + WS_ACT);
    const float* wc = P.in[I_WCONV]; const float* bc = P.in[I_BCONV];
    const int total = 128 * 2 * FF;
    if (blockIdx.x < 64) return;
    for (int i = (blockIdx.x - 64) * 512 + tid; i < total; i += (gridDim.x - 64) * 512) {
        const int j = i % FF, rr = (i / FF) & 1, pm = i / (2 * FF);
        if ((pm & 15) == 0) continue;
        float uc[2];
#pragma unroll
        for (int hf = 0; hf < 2; ++hf) { const int c = j + hf * FF;
            const float um2 = rr == 0 ? UE[((size_t)(pm - 1) * 4 + 2) * FF2 + c] : UE[((size_t)(pm - 1) * 4 + 3) * FF2 + c];
            const float um1 = rr == 0 ? UE[((size_t)(pm - 1) * 4 + 3) * FF2 + c] : UE[((size_t)pm * 4 + 0) * FF2 + c];
            const float u0 = UE[((size_t)pm * 4 + rr) * FF2 + c];
            uc[hf] = bc[c] + wc[2 * FF2 + c] * u0 + wc[FF2 + c] * um1 + wc[c] * um2; }
        act[((size_t)pm * 256 + rr) * FF + j] = f2bf(uc[0] * sigmoidf_(uc[0]) * uc[1]);
    }
}

constexpr int ML_P = 272;
constexpr int ML_QS = 0, ML_KS = 17408, ML_VS = 34816, ML_VW = 52224, ML_CS = 69632, ML_SS = 104448, ML_SC = 113664;
__device__ __forceinline__ void mlstm_item(const Params& P, lptr lds, int bh, bool sample, int tid, int lane, int wave) {
    const int b = bh >> 2, h = bh & 3, hh = lane >> 5, n31 = lane & 31;
    const size_t rowbase = sample ? (size_t)MP + b * 32 : (size_t)b * SEQ;
    const int nch = sample ? 1 : 64, L = sample ? 32 : 64;
    const bf16_t* MQ = (const bf16_t*)(P.ws + WS_PROJ); const bf16_t* MK = (const bf16_t*)(P.ws + WS_PROJ + PROJ_STRIDE); const bf16_t* MV = (const bf16_t*)(P.ws + WS_PROJ + 2 * PROJ_STRIDE);
    const bf16_t* MO = (const bf16_t*)(P.ws + WS_PROJ + 3 * PROJ_STRIDE); const float* GT = (const float*)(P.ws + WS_GATES); bf16_t* YC = (bf16_t*)(P.ws + WS_YCAT);
    LAS float* sc = (LAS float*)(lds + ML_SC);
    LAS float* bt = sc, *as_ = sc + 64, *mt = sc + 128, *winter = sc + 192, *emt = sc + 256, *wk = sc + 320, *rsum = sc + 384, *qn = sc + 512, *nvec = sc + 576, *misc = sc + 704;
    const int ti = wave >> 2, ej = wave & 3;
    f32x16 Cacc[2];
    {
        LAS float* cst = (LAS float*)lds;
        if (sample) { const float* src = P.in[I_STC] + ((size_t)b * 4 + h) * 16384;
            for (int i = tid; i < 4096; i += 512) { const f32x4 v = *(const f32x4*)(src + 4 * i); *(LAS f32x4*)(cst + (i >> 5) * 132 + (i & 31) * 4) = v; } }
        else { for (int i = tid; i < 4096; i += 512) *(LAS f32x4*)(cst + (i >> 5) * 132 + (i & 31) * 4) = (f32x4){0.f, 0.f, 0.f, 0.f}; }
        __syncthreads();
        const LAS float* cb = cst + (64 * (wave >> 2) + 4 * hh) * 132 + 32 * ej + n31;
#pragma unroll
        for (int i = 0; i < 2; ++i)
#pragma unroll
            for (int r = 0; r < 16; ++r) Cacc[i][r] = cb[(32 * i + (r & 3) + 8 * (r >> 2)) * 132];
        __syncthreads();
        lptr cs = lds + ML_CS + (64 * (wave >> 2) + 4 * hh) * ML_P + (32 * ej + n31) * 2;
#pragma unroll
        for (int i = 0; i < 2; ++i)
#pragma unroll
            for (int r = 0; r < 16; ++r) *(LAS unsigned short*)(cs + (32 * i + (r & 3) + 8 * (r >> 2)) * ML_P) = f2bf(Cacc[i][r]);
    }
    if (tid < 128) nvec[tid] = sample ? P.in[I_STN][((size_t)b * 4 + h) * 128 + tid] : 0.f;
    if (tid == 0) misc[0] = sample ? P.in[I_STM][b * 4 + h] : 0.f;
    u32x4 rq[2], rk[2], rv[2]; float g_ig = -INFINITY, g_lf = 0.f;
    const int prow[2] = {tid >> 4, (tid + 512) >> 4}, pch = tid & 15;
#define ML_LOAD(c) do { _Pragma("unroll") for (int i = 0; i < 2; ++i) { if (prow[i] < L) { const size_t go = (rowbase + (size_t)(c) * 64 + prow[i]) * 512 + h * 128 + pch * 8; \
            rq[i] = *(const u32x4*)(MQ + go); rk[i] = *(const u32x4*)(MK + go); rv[i] = *(const u32x4*)(MV + go); } else { rq[i] = (u32x4){0u, 0u, 0u, 0u}; rk[i] = rq[i]; rv[i] = rq[i]; } } \
        if (wave == 0) { if (lane < L) { const float* g = GT + (rowbase + (size_t)(c) * 64 + lane) * 8; g_ig = g[h]; g_lf = g[4 + h]; } else { g_ig = -INFINITY; g_lf = 0.f; } } } while (0)
    ML_LOAD(0);
    for (int c = 0; c < nch; ++c) {
        __syncthreads();
        if (wave == 0) {
            float bcum = g_lf;
#pragma unroll
            for (int o = 1; o < 64; o <<= 1) { const float v = __shfl_up(bcum, o); if (lane >= o) bcum += v; }
            const float a = g_ig - bcum; float amax = a;
#pragma unroll
            for (int o = 1; o < 64; o <<= 1) { const float v = __shfl_up(amax, o); if (lane >= o) amax = fmaxf(amax, v); }
            const float mprev = misc[0];
            const float m_t = fmaxf(bcum + mprev, bcum + amax);
            const float bL = __shfl(bcum, 63), aM = __shfl(amax, 63);
            const float m_new = fmaxf(bL + mprev, bL + aM);
            bt[lane] = bcum; as_[lane] = a; mt[lane] = m_t; winter[lane] = expf(bcum + mprev - m_t); emt[lane] = expf(-m_t); wk[lane] = expf(bL + a - m_new);
            if (lane == 0) { misc[1] = expf(bL + mprev - m_new); misc[2] = m_new; }
        }
#pragma unroll
        for (int i = 0; i < 2; ++i) { const int o = prow[i] * ML_P + pch * 16;
            *(LAS u32x4*)(lds + ML_QS + o) = rq[i]; *(LAS u32x4*)(lds + ML_KS + o) = rk[i]; *(LAS u32x4*)(lds + ML_VS + o) = rv[i]; }
        __syncthreads();
#pragma unroll
        for (int i = 0; i < 2; ++i) { const float w = wk[prow[i]]; const u32x4 v = rv[i]; u32x4 o;
            o.x = cvtpk(bflo(v.x) * w, bfhi(v.x) * w); o.y = cvtpk(bflo(v.y) * w, bfhi(v.y) * w); o.z = cvtpk(bflo(v.z) * w, bfhi(v.z) * w); o.w = cvtpk(bflo(v.w) * w, bfhi(v.w) * w);
            *(LAS u32x4*)(lds + ML_VW + prow[i] * ML_P + pch * 16) = o; }
        if (c + 1 < nch) ML_LOAD(c + 1);
        f32x16 num;
#pragma unroll
        for (int r = 0; r < 16; ++r) num[r] = 0.f;
#pragma unroll
        for (int ks = 0; ks < 8; ++ks) num = MFMA32(row_frag(lds + ML_QS, ML_P, 32 * ti, 16 * ks, lane), tr_frag(lds + ML_CS, ML_P, 16 * ks, 32 * ej, lane), num);
        if (wave < 3) {
            const int sti = wave == 0 ? 0 : 1, sj = wave == 2 ? 1 : 0;
            const int krow = (n31 & ~12) | ((n31 & 4) << 1) | ((n31 & 8) >> 1);
            f32x16 p;
#pragma unroll
            for (int r = 0; r < 16; ++r) p[r] = 0.f;
#pragma unroll
            for (int ks = 0; ks < 8; ++ks) p = MFMA32(*(const LAS bf16x8*)(lds + ML_KS + (32 * sj + krow) * ML_P + (16 * ks + 8 * hh) * 2), row_frag(lds + ML_QS, ML_P, 32 * sti, 16 * ks, lane), p);
            const int t = 32 * sti + n31; const float bt_t = bt[t], mt_t = mt[t]; float rs = 0.f;
            const LAS float* asb = as_ + 32 * sj + 8 * hh; const int tb = t - (32 * sj + 8 * hh);
#pragma unroll
            for (int r = 0; r < 16; ++r) { const int so = 16 * (r >> 3) + (r & 7);
                const float w = so <= tb ? __expf(bt_t + asb[so] - mt_t) : 0.f; p[r] *= w; rs += p[r]; }
#pragma unroll
            for (int a2 = 0; a2 < 2; ++a2) { u32x4 o; o.x = cvtpk(p[8 * a2 + 0], p[8 * a2 + 1]); o.y = cvtpk(p[8 * a2 + 2], p[8 * a2 + 3]); o.z = cvtpk(p[8 * a2 + 4], p[8 * a2 + 5]); o.w = cvtpk(p[8 * a2 + 6], p[8 * a2 + 7]);
                *(LAS u32x4*)(lds + ML_SS + t * 144 + (32 * sj + 16 * a2 + 8 * hh) * 2) = o; }
            rs += __shfl_xor(rs, 32);
            if (hh == 0) rsum[sj * 64 + t] = rs;
        }
        if (wave >= 4) {
            const int t = (tid - 256) >> 2, part = tid & 3; float s = 0.f;
#pragma unroll 8
            for (int d = 0; d < 32; ++d) s += bf2f(*(const LAS unsigned short*)(lds + ML_QS + t * ML_P + (32 * part + d) * 2)) * nvec[32 * part + d];
            s += __shfl_xor(s, 1); s += __shfl_xor(s, 2);
            if (part == 0) qn[t] = s;
        }
        __syncthreads();
        const LAS float* tb2 = sc + 32 * ti + 4 * hh;
#pragma unroll
        for (int r = 0; r < 16; ++r) num[r] *= tb2[192 + (r & 3) + 8 * (r >> 2)];
#pragma unroll
        for (int ks = 0; ks < 4; ++ks) if (ks < 2 || ti == 1) num = MFMA32(*(const LAS bf16x8*)(lds + ML_SS + (32 * ti + n31) * 144 + (16 * ks + 8 * hh) * 2), tr_frag(lds + ML_VS, ML_P, 16 * ks, 32 * ej, lane), num);
#pragma unroll
        for (int r = 0; r < 16; ++r) { const int o = (r & 3) + 8 * (r >> 2);
            const float den = tb2[192 + o] * tb2[512 + o] + tb2[384 + o] + (ti ? tb2[448 + o] : 0.f);
            const float hv = num[r] * fast_rcp(fmaxf(fabsf(den), tb2[256 + o]));
            *(LAS unsigned short*)(lds + ML_QS + (32 * ti + 4 * hh) * ML_P + (32 * ej + n31) * 2 + o * ML_P) = f2bf(hv); }
        const float decay = misc[1];
#pragma unroll
        for (int i = 0; i < 2; ++i) { const int di = 2 * (wave >> 2) + i;
#pragma unroll
            for (int r = 0; r < 16; ++r) Cacc[i][r] *= decay;
#pragma unroll
            for (int ks = 0; ks < 4; ++ks) Cacc[i] = MFMA32(tr_frag(lds + ML_KS, ML_P, 16 * ks, 32 * di, lane), tr_frag(lds + ML_VW, ML_P, 16 * ks, 32 * ej, lane), Cacc[i]);
#pragma unroll
            for (int r = 0; r < 16; ++r) *(LAS unsigned short*)(lds + ML_CS + (64 * (wave >> 2) + 4 * hh) * ML_P + (32 * ej + n31) * 2 + (32 * i + (r & 3) + 8 * (r >> 2)) * ML_P) = f2bf(Cacc[i][r]); }
        if (tid < 128) { float s = decay * nvec[tid];
#pragma unroll 8
            for (int t = 0; t < 64; ++t) s += wk[t] * bf2f(*(const LAS unsigned short*)(lds + ML_KS + t * ML_P + tid * 2));
            nvec[tid] = s; }
        if (tid == 0) misc[0] = misc[2];
        __syncthreads();
        { const int t = tid >> 3, part = tid & 7;
          const u32x4 h0 = *(const LAS u32x4*)(lds + ML_QS + t * ML_P + part * 32), h1 = *(const LAS u32x4*)(lds + ML_QS + t * ML_P + part * 32 + 16);
          float hv[16] = {bflo(h0.x), bfhi(h0.x), bflo(h0.y), bfhi(h0.y), bflo(h0.z), bfhi(h0.z), bflo(h0.w), bfhi(h0.w), bflo(h1.x), bfhi(h1.x), bflo(h1.y), bfhi(h1.y), bflo(h1.z), bfhi(h1.z), bflo(h1.w), bfhi(h1.w)};
          float ss = 0.f;
#pragma unroll
          for (int e = 0; e < 16; ++e) ss += hv[e] * hv[e];
          ss += __shfl_xor(ss, 1); ss += __shfl_xor(ss, 2); ss += __shfl_xor(ss, 4);
          const float rstd = rsqrtf(ss * (1.f / 128.f) + EPS);
          if (t < L) {
              const size_t row = rowbase + (size_t)c * 64 + t; const int col = h * 128 + part * 16;
              const u32x4 g0 = *(const u32x4*)(MO + row * 512 + col), g1 = *(const u32x4*)(MO + row * 512 + col + 8);
              const float gv[16] = {bflo(g0.x), bfhi(g0.x), bflo(g0.y), bfhi(g0.y), bflo(g0.z), bfhi(g0.z), bflo(g0.w), bfhi(g0.w), bflo(g1.x), bfhi(g1.x), bflo(g1.y), bfhi(g1.y), bflo(g1.z), bfhi(g1.z), bflo(g1.w), bfhi(g1.w)};
              const float* mw = P.in[I_MLW] + col;
              float y[16];
#pragma unroll
              for (int e = 0; e < 16; ++e) y[e] = hv[e] * rstd * mw[e] * gv[e];
              u32x4 o0, o1; o0.x = cvtpk(y[0], y[1]); o0.y = cvtpk(y[2], y[3]); o0.z = cvtpk(y[4], y[5]); o0.w = cvtpk(y[6], y[7]); o1.x = cvtpk(y[8], y[9]); o1.y = cvtpk(y[10], y[11]); o1.z = cvtpk(y[12], y[13]); o1.w = cvtpk(y[14], y[15]);
              *(u32x4*)(YC + row * 1024 + col) = o0; *(u32x4*)(YC + row * 1024 + col + 8) = o1;
          } }
    }
#undef ML_LOAD
    __syncthreads();
    {
        LAS float* cst = (LAS float*)lds;
        int l3 = lane; asm volatile("" : "+v"(l3));
        LAS float* cb = cst + (64 * (wave >> 2) + 4 * (l3 >> 5)) * 132 + 32 * ej + (l3 & 31);
#pragma unroll
        for (int i = 0; i < 2; ++i)
#pragma unroll
            for (int r = 0; r < 16; ++r) cb[(32 * i + (r & 3) + 8 * (r >> 2)) * 132] = Cacc[i][r];
        __syncthreads();
        float* oc = P.out + (sample ? O_SC : O_PC) + ((size_t)b * 4 + h) * 16384;
        for (int i = tid; i < 4096; i += 512) *(f32x4*)(oc + 4 * i) = *(const LAS f32x4*)(cst + (i >> 5) * 132 + (i & 31) * 4);
    }
    if (tid < 128) P.out[(sample ? O_SN : O_PN) + ((size_t)b * 4 + h) * 128 + tid] = nvec[tid];
    if (tid == 0) P.out[(sample ? O_SM : O_PM) + b * 4 + h] = misc[0];
}


constexpr size_t WS_KVL = WS_H, WS_KNL = 420 * MiB, WS_CHS = 421 * MiB, WS_NST = 422 * MiB, WS_MST = 423 * MiB, WS_CST = 424 * MiB, WS_END2 = 489 * MiB;
template <int NC>
__device__ __forceinline__ void ml1_pair(const Params& P, lptr lds, int pair, int tid, int lane, int wave) {
    const int item0 = NC * pair; const int bh = item0 >> 6, c = item0 & 63, b = bh >> 2, h = bh & 3, hh = lane >> 5, n31 = lane & 31, ej = wave & 3;
    const size_t row0 = (size_t)b * SEQ + 64 * c;
    const bf16_t* MK = (const bf16_t*)(P.ws + WS_PROJ + PROJ_STRIDE); const bf16_t* MV = (const bf16_t*)(P.ws + WS_PROJ + 2 * PROJ_STRIDE); const float* GT = (const float*)(P.ws + WS_GATES);
    LAS float* wk = (LAS float*)(lds + ML_SC) + 320;
    const int prow[2] = {tid >> 4, (tid + 512) >> 4}, pch = tid & 15;
    u32x4 rk2[NC][2], rv2[NC][2]; float g_ig2[NC], g_lf2[NC];
#pragma unroll
    for (int s2 = 0; s2 < NC; ++s2) { g_ig2[s2] = 0.f; g_lf2[s2] = 0.f;
#pragma unroll
        for (int i = 0; i < 2; ++i) { const size_t go = (row0 + 64 * s2 + prow[i]) * 512 + h * 128 + pch * 8; rk2[s2][i] = *(const u32x4*)(MK + go); rv2[s2][i] = *(const u32x4*)(MV + go); }
        if (wave == 0) { const float* g = GT + (row0 + 64 * s2 + lane) * 8; g_ig2[s2] = g[h]; g_lf2[s2] = g[4 + h]; } }
#pragma unroll
    for (int s2 = 0; s2 < NC; ++s2) {
    const int item = item0 + s2; const float g_ig = g_ig2[s2], g_lf = g_lf2[s2];
    u32x4 rk[2] = {rk2[s2][0], rk2[s2][1]}, rv[2] = {rv2[s2][0], rv2[s2][1]};
    __syncthreads();
    if (wave == 0) {
        float bcum = g_lf;
#pragma unroll
        for (int o = 1; o < 64; o <<= 1) { const float v = __shfl_up(bcum, o); if (lane >= o) bcum += v; }
        const float a = g_ig - bcum; float amax = a;
#pragma unroll
        for (int o = 1; o < 64; o <<= 1) amax = fmaxf(amax, __shfl_xor(amax, o));
        const float bL = __shfl(bcum, 63);
        wk[lane] = expf(a - amax);
        if (lane == 0) { float* ch = (float*)(P.ws + WS_CHS) + (size_t)item * 4; ch[0] = bL; ch[1] = bL + amax; }
    }
#pragma unroll
    for (int i = 0; i < 2; ++i) *(LAS u32x4*)(lds + ML_KS + prow[i] * ML_P + pch * 16) = rk[i];
    __syncthreads();
#pragma unroll
    for (int i = 0; i < 2; ++i) { const float w = wk[prow[i]]; const u32x4 v = rv[i]; u32x4 o;
        o.x = cvtpk(bflo(v.x) * w, bfhi(v.x) * w); o.y = cvtpk(bflo(v.y) * w, bfhi(v.y) * w); o.z = cvtpk(bflo(v.z) * w, bfhi(v.z) * w); o.w = cvtpk(bflo(v.w) * w, bfhi(v.w) * w);
        *(LAS u32x4*)(lds + ML_VW + prow[i] * ML_P + pch * 16) = o; }
    if (tid < 128) { float s = 0.f;
#pragma unroll 8
        for (int t = 0; t < 64; ++t) s += wk[t] * bf2f(*(const LAS unsigned short*)(lds + ML_KS + t * ML_P + tid * 2));
        ((float*)(P.ws + WS_KNL))[(size_t)item * 128 + tid] = s; }
    __syncthreads();
#pragma unroll
    for (int i = 0; i < 2; ++i) { const int di = 2 * (wave >> 2) + i;
        f32x16 acc;
#pragma unroll
        for (int r = 0; r < 16; ++r) acc[r] = 0.f;
#pragma unroll
        for (int ks = 0; ks < 4; ++ks) acc = MFMA32(tr_frag(lds + ML_KS, ML_P, 16 * ks, 32 * di, lane), tr_frag(lds + ML_VW, ML_P, 16 * ks, 32 * ej, lane), acc);
#pragma unroll
        for (int r = 0; r < 16; ++r) *(LAS unsigned short*)(lds + ML_CS + (64 * (wave >> 2) + 4 * hh) * ML_P + (32 * ej + n31) * 2 + (32 * i + (r & 3) + 8 * (r >> 2)) * ML_P) = f2bf(acc[r]); }
    __syncthreads();
    bf16_t* kvl = (bf16_t*)(P.ws + WS_KVL) + (size_t)item * 16384;
#pragma unroll
    for (int i = 0; i < 4; ++i) { const int p = tid + 512 * i, row = p >> 4, ch = p & 15; *(u32x4*)(kvl + row * 128 + ch * 8) = *(const LAS u32x4*)(lds + ML_CS + row * ML_P + ch * 16); }
    }
}
__device__ __forceinline__ void ml2_scan(const Params& P, lptr lds, int tid) {
    const int hb = tid >> 8, lt = tid & 255, job = 2 * blockIdx.x + hb;
    const int bh = job >> 3, part = job & 7;
    LAS float* dec = (LAS float*)(lds + hb * 1024); LAS float* scl = dec + 64; LAS float* mst = scl + 64;
    if (lt < 64) {
        const float* ch = (const float*)(P.ws + WS_CHS) + ((size_t)bh * 64 + lt) * 4;
        const float bL = ch[0], ml = ch[1]; float A = bL, B = ml;
#pragma unroll
        for (int off = 1; off < 64; off <<= 1) { const float A2 = __shfl_up(A, off), B2 = __shfl_up(B, off); if (lt >= off) { B = fmaxf(B2 + A, B); A = A2 + A; } }
        const float mnext = fmaxf(A, B);
        float mc = __shfl_up(mnext, 1); if (lt == 0) mc = 0.f;
        dec[lt] = expf(bL + mc - mnext); scl[lt] = expf(ml - mnext); mst[lt] = mc; if (lt == 63) mst[64] = mnext;
    }
    __syncthreads();
    const size_t e0 = (size_t)part * 2048 + lt * 8;
    const bf16_t* kv = (const bf16_t*)(P.ws + WS_KVL) + (size_t)bh * 64 * 16384 + e0; bf16_t* cs = (bf16_t*)(P.ws + WS_CST) + (size_t)bh * 64 * 16384 + e0;
    f32x4 C0 = {0.f, 0.f, 0.f, 0.f}, C1 = {0.f, 0.f, 0.f, 0.f};
    const bool do_n = part == 0 && lt < 128; const int tn = do_n ? lt : 0; float n = 0.f;
    const float* kn = (const float*)(P.ws + WS_KNL) + (size_t)bh * 64 * 128 + tn; float* ns = (float*)(P.ws + WS_NST) + (size_t)bh * 64 * 128 + tn;
#pragma unroll 16
    for (int c = 0; c < 64; ++c) { const u32x4 v = *(const u32x4*)(kv + (size_t)c * 16384);
        float knv = 0.f; if (do_n) knv = kn[c * 128];
        *(u32x4*)(cs + (size_t)c * 16384) = pack8(C0, C1);
        if (do_n) ns[c * 128] = n;
        const f32x4 k0 = {bflo(v.x), bfhi(v.x), bflo(v.y), bfhi(v.y)}, k1 = {bflo(v.z), bfhi(v.z), bflo(v.w), bfhi(v.w)};
        const float d = dec[c], sl = scl[c];
        C0 = C0 * d + k0 * sl; C1 = C1 * d + k1 * sl; n = n * d + knv * sl; }
    float* oc = P.out + O_PC + (size_t)bh * 16384 + e0; *(f32x4*)oc = C0; *(f32x4*)(oc + 4) = C1;
    if (do_n) P.out[O_PN + (size_t)bh * 128 + lt] = n;
    if (part == 0 && lt >= 128 && lt < 192) ((float*)(P.ws + WS_MST))[bh * 64 + lt - 128] = mst[lt - 128];
    if (part == 0 && lt == 192) P.out[O_PM + bh] = mst[64];
}
struct Ml3In { u32x4 rq[2], rk[2], rv[2], rc[4], g0, g1; float g_ig, g_lf, mprev, nin; };
__device__ __forceinline__ void ml3_load(const Params& P, int item, int tid, int lane, int wave, Ml3In& L) {
    const int bh = item >> 6, c = item & 63, b = bh >> 2, h = bh & 3;
    const size_t row0 = (size_t)b * SEQ + 64 * c;
    const bf16_t* MQ = (const bf16_t*)(P.ws + WS_PROJ); const bf16_t* MK = (const bf16_t*)(P.ws + WS_PROJ + PROJ_STRIDE); const bf16_t* MV = (const bf16_t*)(P.ws + WS_PROJ + 2 * PROJ_STRIDE);
    const bf16_t* MO = (const bf16_t*)(P.ws + WS_PROJ + 3 * PROJ_STRIDE); const float* GT = (const float*)(P.ws + WS_GATES);
    const int prow[2] = {tid >> 4, (tid + 512) >> 4}, pch = tid & 15;
#pragma unroll
    for (int i = 0; i < 2; ++i) { const size_t go = (row0 + prow[i]) * 512 + h * 128 + pch * 8; L.rq[i] = *(const u32x4*)(MQ + go); L.rk[i] = *(const u32x4*)(MK + go); L.rv[i] = *(const u32x4*)(MV + go); }
    const bf16_t* cst = (const bf16_t*)(P.ws + WS_CST) + (size_t)item * 16384;
#pragma unroll
    for (int i = 0; i < 4; ++i) { const int p = tid + 512 * i; L.rc[i] = *(const u32x4*)(cst + (p >> 4) * 128 + (p & 15) * 8); }
    { const size_t row = row0 + (tid >> 3); const int col = h * 128 + (tid & 7) * 16; L.g0 = *(const u32x4*)(MO + row * 512 + col); L.g1 = *(const u32x4*)(MO + row * 512 + col + 8); }
    L.g_ig = 0.f; L.g_lf = 0.f; L.mprev = 0.f; L.nin = 0.f;
    if (wave == 0) { const float* g = GT + (row0 + lane) * 8; L.g_ig = g[h]; L.g_lf = g[4 + h]; L.mprev = ((const float*)(P.ws + WS_MST))[item]; }
    if (tid < 128) L.nin = ((const float*)(P.ws + WS_NST))[(size_t)item * 128 + tid];
}
__device__ __forceinline__ void ml3_item(const Params& P, lptr lds, int item, const Ml3In& L, int tid, int lane, int wave) {
    const int bh = item >> 6, c = item & 63, b = bh >> 2, h = bh & 3, hh = lane >> 5, n31 = lane & 31;
    const size_t row0 = (size_t)b * SEQ + 64 * c;
    bf16_t* YC = (bf16_t*)(P.ws + WS_YCAT);
    LAS float* sc = (LAS float*)(lds + ML_SC);
    LAS float* bt = sc, *as_ = sc + 64, *mt = sc + 128, *winter = sc + 192, *emt = sc + 256, *rsum = sc + 384, *qn = sc + 512, *nvec = sc + 576;
    const int ti = wave >> 2, ej = wave & 3;
    const int prow[2] = {tid >> 4, (tid + 512) >> 4}, pch = tid & 15;
    const float g_ig = L.g_ig, g_lf = L.g_lf, mprev = L.mprev, nin = L.nin;
    __syncthreads();
    if (wave == 0) {
        float bcum = g_lf;
#pragma unroll
        for (int o = 1; o < 64; o <<= 1) { const float v = __shfl_up(bcum, o); if (lane >= o) bcum += v; }
        const float a = g_ig - bcum; float amax = a;
#pragma unroll
        for (int o = 1; o < 64; o <<= 1) { const float v = __shfl_up(amax, o); if (lane >= o) amax = fmaxf(amax, v); }
        const float m_t = fmaxf(bcum + mprev, bcum + amax);
        bt[lane] = bcum; as_[lane] = a; mt[lane] = m_t; winter[lane] = expf(bcum + mprev - m_t); emt[lane] = expf(-m_t);
    }
    if (tid < 128) nvec[tid] = nin;
#pragma unroll
    for (int i = 0; i < 2; ++i) { const int o = prow[i] * ML_P + pch * 16;
        *(LAS u32x4*)(lds + ML_QS + o) = L.rq[i]; *(LAS u32x4*)(lds + ML_KS + o) = L.rk[i]; *(LAS u32x4*)(lds + ML_VS + o) = L.rv[i]; }
#pragma unroll
    for (int i = 0; i < 4; ++i) { const int p = tid + 512 * i; *(LAS u32x4*)(lds + ML_CS + (p >> 4) * ML_P + (p & 15) * 16) = L.rc[i]; }
    __syncthreads();
    f32x16 num;
#pragma unroll
    for (int r = 0; r < 16; ++r) num[r] = 0.f;
#pragma unroll
    for (int ks = 0; ks < 8; ++ks) num = MFMA32(row_frag(lds + ML_QS, ML_P, 32 * ti, 16 * ks, lane), tr_frag(lds + ML_CS, ML_P, 16 * ks, 32 * ej, lane), num);
    if (wave < 3) {
        const int sti = wave == 0 ? 0 : 1, sj = wave == 2 ? 1 : 0;
        const int krow = (n31 & ~12) | ((n31 & 4) << 1) | ((n31 & 8) >> 1);
        f32x16 p;
#pragma unroll
        for (int r = 0; r < 16; ++r) p[r] = 0.f;
#pragma unroll
        for (int ks = 0; ks < 8; ++ks) p = MFMA32(*(const LAS bf16x8*)(lds + ML_KS + (32 * sj + krow) * ML_P + (16 * ks + 8 * hh) * 2), row_frag(lds + ML_QS, ML_P, 32 * sti, 16 * ks, lane), p);
        const int t = 32 * sti + n31; const float bt_t = bt[t], mt_t = mt[t]; float rs = 0.f;
        const LAS float* asb = as_ + 32 * sj + 8 * hh; const int tb = t - (32 * sj + 8 * hh);
#pragma unroll
        for (int r = 0; r < 16; ++r) { const int so = 16 * (r >> 3) + (r & 7);
            const float w = so <= tb ? __expf(bt_t + asb[so] - mt_t) : 0.f; p[r] *= w; rs += p[r]; }
#pragma unroll
        for (int a2 = 0; a2 < 2; ++a2) { u32x4 o; o.x = cvtpk(p[8 * a2 + 0], p[8 * a2 + 1]); o.y = cvtpk(p[8 * a2 + 2], p[8 * a2 + 3]); o.z = cvtpk(p[8 * a2 + 4], p[8 * a2 + 5]); o.w = cvtpk(p[8 * a2 + 6], p[8 * a2 + 7]);
            *(LAS u32x4*)(lds + ML_SS + t * 144 + (32 * sj + 16 * a2 + 8 * hh) * 2) = o; }
        rs += __shfl_xor(rs, 32);
        if (hh == 0) rsum[sj * 64 + t] = rs;
    }
    if (wave >= 4) {
        const int t = (tid - 256) >> 2, part = tid & 3; float s = 0.f;
#pragma unroll 8
        for (int d = 0; d < 32; ++d) s += bf2f(*(const LAS unsigned short*)(lds + ML_QS + t * ML_P + (32 * part + d) * 2)) * nvec[32 * part + d];
        s += __shfl_xor(s, 1); s += __shfl_xor(s, 2);
        if (part == 0) qn[t] = s;
    }
    __syncthreads();
    const LAS float* tb2 = sc + 32 * ti + 4 * hh;
#pragma unroll
    for (int r = 0; r < 16; ++r) num[r] *= tb2[192 + (r & 3) + 8 * (r >> 2)];
#pragma unroll
    for (int ks = 0; ks < 4; ++ks) if (ks < 2 || ti == 1) num = MFMA32(*(const LAS bf16x8*)(lds + ML_SS + (32 * ti + n31) * 144 + (16 * ks + 8 * hh) * 2), tr_frag(lds + ML_VS, ML_P, 16 * ks, 32 * ej, lane), num);
#pragma unroll
    for (int r = 0; r < 16; ++r) { const int o = (r & 3) + 8 * (r >> 2);
        const float den = tb2[192 + o] * tb2[512 + o] + tb2[384 + o] + (ti ? tb2[448 + o] : 0.f);
        const float hv = num[r] * fast_rcp(fmaxf(fabsf(den), tb2[256 + o]));
        *(LAS unsigned short*)(lds + ML_QS + (32 * ti + 4 * hh) * ML_P + (32 * ej + n31) * 2 + o * ML_P) = f2bf(hv); }
    __syncthreads();
    { const int t = tid >> 3, part = tid & 7;
      const size_t row = row0 + t; const int col = h * 128 + part * 16;
      const u32x4 g0 = L.g0, g1 = L.g1;
      const u32x4 h0 = *(const LAS u32x4*)(lds + ML_QS + t * ML_P + part * 32), h1 = *(const LAS u32x4*)(lds + ML_QS + t * ML_P + part * 32 + 16);
      float hv[16] = {bflo(h0.x), bfhi(h0.x), bflo(h0.y), bfhi(h0.y), bflo(h0.z), bfhi(h0.z), bflo(h0.w), bfhi(h0.w), bflo(h1.x), bfhi(h1.x), bflo(h1.y), bfhi(h1.y), bflo(h1.z), bfhi(h1.z), bflo(h1.w), bfhi(h1.w)};
      float ss = 0.f;
#pragma unroll
      for (int e = 0; e < 16; ++e) ss += hv[e] * hv[e];
      ss += __shfl_xor(ss, 1); ss += __shfl_xor(ss, 2); ss += __shfl_xor(ss, 4);
      const float rstd = rsqrtf(ss * (1.f / 128.f) + EPS);
      const float gv[16] = {bflo(g0.x), bfhi(g0.x), bflo(g0.y), bfhi(g0.y), bflo(g0.z), bfhi(g0.z), bflo(g0.w), bfhi(g0.w), bflo(g1.x), bfhi(g1.x), bflo(g1.y), bfhi(g1.y), bflo(g1.z), bfhi(g1.z), bflo(g1.w), bfhi(g1.w)};
      const float* mw = P.in[I_MLW] + col;
      float y[16];
#pragma unroll
      for (int e = 0; e < 16; ++e) y[e] = hv[e] * rstd * mw[e] * gv[e];
      u32x4 o0, o1; o0.x = cvtpk(y[0], y[1]); o0.y = cvtpk(y[2], y[3]); o0.z = cvtpk(y[4], y[5]); o0.w = cvtpk(y[6], y[7]); o1.x = cvtpk(y[8], y[9]); o1.y = cvtpk(y[10], y[11]); o1.z = cvtpk(y[12], y[13]); o1.w = cvtpk(y[14], y[15]);
      *(u32x4*)(YC + row * 1024 + col) = o0; *(u32x4*)(YC + row * 1024 + col + 8) = o1; }
}

constexpr int AT_KP = 144, AT_VP = 136, AT_WAVE = 64 * AT_KP + 64 * AT_VP;
__device__ __forceinline__ void sb_step(clptr Kt, clptr Vt, const bf16x8 (&qf)[4], f32x16& o0, f32x16& o1, float& carry, int lane, bool domask, int kq) {
    const int n31 = lane & 31, hh = lane >> 5;
    const int krow = (n31 & ~12) | ((n31 & 4) << 1) | ((n31 & 8) >> 1);
    f32x16 p[2];
#pragma unroll
    for (int r = 0; r < 16; ++r) { p[0][r] = 0.f; p[1][r] = 0.f; }
#pragma unroll
    for (int ks = 0; ks < 4; ++ks) {
        p[0] = MFMA32(*(const LAS bf16x8*)(Kt + krow * AT_KP + (16 * ks + 8 * hh) * 2), qf[ks], p[0]);
        p[1] = MFMA32(*(const LAS bf16x8*)(Kt + (32 + krow) * AT_KP + (16 * ks + 8 * hh) * 2), qf[ks], p[1]);
    }
    f32x16 om[2];
    float town[4], tpar[4];
#pragma unroll
    for (int u = 0; u < 2; ++u)
#pragma unroll
        for (int a = 0; a < 2; ++a) { float tp = 1.f;
#pragma unroll
            for (int j = 0; j < 8; ++j) { const int r = 8 * a + j;
                const float z = fminf(fmaxf(p[u][r], -60.f), 60.f);
                const float e = fast_exp2(-z); float sg = fast_rcp(1.f + e); float o = e * sg;
                if (domask) { const int kl = 32 * u + 16 * a + 8 * hh + j; if (kl >= kq) { sg = 0.f; o = 1.f; } }
                p[u][r] = sg; om[u][r] = o; tp *= o; }
            town[2 * u + a] = tp; }
#pragma unroll
    for (int i = 0; i < 4; ++i) tpar[i] = __shfl_xor(town[i], 32);
    float suf[5]; suf[4] = 1.f;
#pragma unroll
    for (int i = 3; i >= 0; --i) suf[i] = suf[i + 1] * (town[i] * tpar[i]);
    bf16x8 pf[4];
#pragma unroll
    for (int u = 0; u < 2; ++u)
#pragma unroll
        for (int a = 0; a < 2; ++a) { const int pr = 2 * u + a;
            float R = carry * suf[pr + 1] * (hh == 0 ? tpar[pr] : 1.f);
            float av[8];
#pragma unroll
            for (int j = 7; j >= 0; --j) { av[j] = p[u][8 * a + j] * R; R *= om[u][8 * a + j]; }
            u32x4 w; w.x = cvtpk(av[0], av[1]); w.y = cvtpk(av[2], av[3]); w.z = cvtpk(av[4], av[5]); w.w = cvtpk(av[6], av[7]);
            pf[pr] = __builtin_bit_cast(bf16x8, w); }
    carry *= suf[0];
#pragma unroll
    for (int pr = 0; pr < 4; ++pr) {
        o0 = MFMA32(tr_frag(Vt, AT_VP, 16 * pr, 0, lane), pf[pr], o0);
        o1 = MFMA32(tr_frag(Vt, AT_VP, 16 * pr, 32, lane), pf[pr], o1);
    }
}
__device__ __forceinline__ void attn_prompt_item(const Params& P, lptr lds, int b, int rb, int lane, int wave) {
    const int h = wave, n31 = lane & 31, hh = lane >> 5;
    const bf16_t* SQ = (const bf16_t*)(P.ws + WS_PROJ + 4 * PROJ_STRIDE); const bf16_t* SK = (const bf16_t*)(P.ws + WS_PROJ + 5 * PROJ_STRIDE); const bf16_t* SV = (const bf16_t*)(P.ws + WS_PROJ + 6 * PROJ_STRIDE);
    const size_t rowb = (size_t)b * SEQ; const int q0 = 32 * rb;
    lptr Kt = lds + wave * AT_WAVE; lptr Vt = Kt + 64 * AT_KP;
    bf16x8 qf[4];
#pragma unroll
    for (int ks = 0; ks < 4; ++ks) qf[ks] = *(const bf16x8*)(SQ + (rowb + q0 + n31) * 512 + h * 64 + 16 * ks + 8 * hh);
    f32x16 o0, o1;
#pragma unroll
    for (int r = 0; r < 16; ++r) { o0[r] = 0.f; o1[r] = 0.f; }
    float carry = 1.f;
    const int trow = lane >> 3, tch = lane & 7;
    u32x4 kv[8], vv[8];
    const int jt0 = (q0 + 30) >> 6;
#pragma unroll
    for (int i = 0; i < 8; ++i) { const size_t go = (rowb + 64 * jt0 + 8 * i + trow) * 512 + h * 64 + tch * 8; kv[i] = *(const u32x4*)(SK + go); vv[i] = *(const u32x4*)(SV + go); }
    for (int jt = jt0; jt >= 0; --jt) {
#pragma unroll
        for (int i = 0; i < 8; ++i) { const int row = 8 * i + trow;
            *(LAS u32x4*)(Kt + row * AT_KP + tch * 16) = kv[i];
            *(LAS u32x2*)(Vt + row * AT_VP + tch * 16) = (u32x2){vv[i].x, vv[i].y}; *(LAS u32x2*)(Vt + row * AT_VP + tch * 16 + 8) = (u32x2){vv[i].z, vv[i].w}; }
        if (jt > 0) {
#pragma unroll
            for (int i = 0; i < 8; ++i) { const size_t go = (rowb + 64 * (jt - 1) + 8 * i + trow) * 512 + h * 64 + tch * 8; kv[i] = *(const u32x4*)(SK + go); vv[i] = *(const u32x4*)(SV + go); } }
        sb_step(Kt, Vt, qf, o0, o1, carry, lane, 64 * jt + 63 >= q0, q0 + n31 - 64 * jt);
        if (__all(carry < 5.9604645e-8f)) break;
    }
    float ss = 0.f;
#pragma unroll
    for (int r = 0; r < 16; ++r) ss += o0[r] * o0[r] + o1[r] * o1[r];
    ss += __shfl_xor(ss, 32);
    const size_t row = rowb + q0 + n31;
    LAS float* sx = (LAS float*)(lds + 8 * AT_WAVE);
    if (hh == 0) sx[wave * 32 + n31] = ss;
    __syncthreads();
    float tot = 0.f;
#pragma unroll
    for (int w2 = 0; w2 < 8; ++w2) tot += sx[w2 * 32 + n31];
    const float rstd = rsqrtf(tot * (1.f / 512.f) + EPS);
    bf16_t* yo = (bf16_t*)(P.ws + WS_YCAT) + row * 1024 + 512 + h * 64 + 4 * hh;
#pragma unroll
    for (int g = 0; g < 4; ++g) {
        *(u32x2*)(yo + 8 * g) = (u32x2){cvtpk(o0[4 * g] * rstd, o0[4 * g + 1] * rstd), cvtpk(o0[4 * g + 2] * rstd, o0[4 * g + 3] * rstd)};
        *(u32x2*)(yo + 32 + 8 * g) = (u32x2){cvtpk(o1[4 * g] * rstd, o1[4 * g + 1] * rstd), cvtpk(o1[4 * g + 2] * rstd, o1[4 * g + 3] * rstd)};
    }
}
__device__ __forceinline__ void attn_sample_item(const Params& P, lptr lds, int bh, int tid, int lane, int wave) {
    const int b = bh >> 3, h = bh & 7, n31 = lane & 31, hh = lane >> 5;
    const bf16_t* SQ = (const bf16_t*)(P.ws + WS_PROJ + 4 * PROJ_STRIDE); const bf16_t* SK = (const bf16_t*)(P.ws + WS_PROJ + 5 * PROJ_STRIDE); const bf16_t* SV = (const bf16_t*)(P.ws + WS_PROJ + 6 * PROJ_STRIDE);
    const size_t rows = (size_t)MP + b * 32;
    lptr Kt = lds + wave * AT_WAVE; lptr Vt = Kt + 64 * AT_KP;
    bf16x8 qf[4];
#pragma unroll
    for (int ks = 0; ks < 4; ++ks) qf[ks] = *(const bf16x8*)(SQ + (rows + n31) * 512 + h * 64 + 16 * ks + 8 * hh);
    f32x16 o0, o1;
#pragma unroll
    for (int r = 0; r < 16; ++r) { o0[r] = 0.f; o1[r] = 0.f; }
    float carry = 1.f;
    if (wave == 7) {
        const int trow = lane >> 3, tch = lane & 7;
#pragma unroll
        for (int i = 0; i < 8; ++i) { const int row = 8 * i + trow; u32x4 kv = {0u, 0u, 0u, 0u}, vv = {0u, 0u, 0u, 0u};
            if (row < 32) { const size_t go = (rows + row) * 512 + h * 64 + tch * 8; kv = *(const u32x4*)(SK + go); vv = *(const u32x4*)(SV + go); }
            *(LAS u32x4*)(Kt + row * AT_KP + tch * 16) = kv;
            *(LAS u32x2*)(Vt + row * AT_VP + tch * 16) = (u32x2){vv.x, vv.y}; *(LAS u32x2*)(Vt + row * AT_VP + tch * 16 + 8) = (u32x2){vv.z, vv.w}; }
        sb_step(Kt, Vt, qf, o0, o1, carry, lane, true, n31);
    }
    const float* CK = P.in[I_CK] + (size_t)b * PAST * 512 + h * 64; const float* CV = P.in[I_CV] + (size_t)b * PAST * 512 + h * 64;
    for (int jt = 4 * wave + 3; jt >= 4 * wave; --jt) {
        const int trow = lane >> 4, c4 = lane & 15;
#pragma unroll
        for (int i = 0; i < 16; ++i) { const int row = 4 * i + trow; const size_t go = (size_t)(64 * jt + row) * 512 + c4 * 4;
            const f32x4 kx = *(const f32x4*)(CK + go), vx = *(const f32x4*)(CV + go);
            *(LAS u32x2*)(Kt + row * AT_KP + c4 * 8) = (u32x2){cvtpk(kx.x, kx.y), cvtpk(kx.z, kx.w)};
            *(LAS u32x2*)(Vt + row * AT_VP + c4 * 8) = (u32x2){cvtpk(vx.x, vx.y), cvtpk(vx.z, vx.w)}; }
        sb_step(Kt, Vt, qf, o0, o1, carry, lane, false, 0);
    }
    __syncthreads();
    LAS float* carr = (LAS float*)(lds + 65536);
    if (hh == 0) carr[wave * 32 + n31] = carry;
    __syncthreads();
    float mult = 1.f;
    for (int w2 = wave + 1; w2 < 8; ++w2) mult *= carr[w2 * 32 + n31];
#pragma unroll
    for (int g = 0; g < 4; ++g) {
        *(LAS f32x4*)(lds + (((wave * 8 + g) * 64 + lane) * 16)) = (f32x4){o0[4 * g] * mult, o0[4 * g + 1] * mult, o0[4 * g + 2] * mult, o0[4 * g + 3] * mult};
        *(LAS f32x4*)(lds + (((wave * 8 + 4 + g) * 64 + lane) * 16)) = (f32x4){o1[4 * g] * mult, o1[4 * g + 1] * mult, o1[4 * g + 2] * mult, o1[4 * g + 3] * mult};
    }
    __syncthreads();
    { const int q = tid >> 4, part = tid & 15; const int slot = (part >> 3) * 4 + ((part & 7) >> 1), ln = q + 32 * (part & 1);
      f32x4 v = {0.f, 0.f, 0.f, 0.f};
#pragma unroll
      for (int w2 = 0; w2 < 8; ++w2) v = v + *(const LAS f32x4*)(lds + (((w2 * 8 + slot) * 64 + ln) * 16));
      float ss = (v.x * v.x + v.y * v.y) + (v.z * v.z + v.w * v.w);
      ss += __shfl_xor(ss, 1); ss += __shfl_xor(ss, 2); ss += __shfl_xor(ss, 4); ss += __shfl_xor(ss, 8);
      const size_t row = rows + q;
      if (part == 0) ((float*)(P.ws + WS_SSQ))[row * 8 + h] = ss;
      *(u32x2*)((bf16_t*)(P.ws + WS_YCAT) + row * 1024 + 512 + h * 64 + part * 4) = (u32x2){cvtpk(v.x, v.y), cvtpk(v.z, v.w)}; }
    __syncthreads();
}
#ifndef M1NC
#define M1NC 2
#endif
constexpr int NQ_G1S = 224, NQ_AT = 1024, NQ_M1 = 2048 / M1NC, NQ_TOTAL = NQ_G1S + NQ_AT + NQ_M1;
template <class EpiS>
__device__ __forceinline__ void phase_mixers(const Params& P, lptr lds, int tid_in, int wave, const EpiS& Es) {
    unsigned* ctr = (unsigned*)(P.ws + WS_CTL);
    int nextitem = 0; if (tid_in == 0) nextitem = (int)atomicAdd(ctr, 1u);
    for (;;) {
        __syncthreads();
        if (tid_in == 0) *(LAS int*)(lds + QOFF) = nextitem;
        __syncthreads();
        int item = *(const LAS int*)(lds + QOFF);
        if (tid_in == 0 && item < NQ_TOTAL) nextitem = (int)atomicAdd(ctr, 1u);
        int tid = tid_in; asm volatile("" : "+v"(tid));
        const int lane = tid & 63;
        if (item >= NQ_TOTAL) break;
        if (item < NQ_G1S) { small_tile<1024, false>((const bf16_t*)(P.ws + WS_H) + (size_t)MP * 1024, (const bf16_t*)(P.ws + WS_W1T), Es, nullptr, lds, item, tid, lane, wave); continue; }
        item -= NQ_G1S;
        if (item < NQ_AT) { attn_prompt_item(P, lds, item & 7, 127 - (item >> 3), lane, wave); continue; }
        item -= NQ_AT;
        ml1_pair<M1NC>(P, lds, item, tid, lane, wave);
    }
}
__device__ __forceinline__ void phase_ml2(const Params& P, lptr lds, int tid_in, int wave) {
    int tid = tid_in; asm volatile("" : "+v"(tid));
    if (blockIdx.x < 128) ml2_scan(P, lds, tid);
    else if (blockIdx.x < 160) { }
    else if (blockIdx.x < 192) mlstm_item(P, lds, blockIdx.x - 160, true, tid, tid & 63, wave);
    else attn_sample_item(P, lds, blockIdx.x - 192, tid, tid & 63, wave);
}
template <class EpiS>
__device__ __forceinline__ void phase_ml3(const Params& P, lptr lds, int tid_in, int wave, const EpiS& Es) {
    if (blockIdx.x >= 192) { int tid = tid_in; asm volatile("" : "+v"(tid));
        small_tile<1024, true>((const bf16_t*)(P.ws + WS_YCAT) + (size_t)MP * 1024, (const bf16_t*)(P.ws + WS_W2T), Es, (const float*)(P.ws + WS_SSQ), lds, blockIdx.x - 192, tid, tid & 63, wave); }
#ifdef DBL_M3
    for (int rep = 0; rep < 2; ++rep)
#endif
    { int tid = tid_in; asm volatile("" : "+v"(tid));
      Ml3In cur, nxt; ml3_load(P, blockIdx.x, tid, tid & 63, wave, cur);
#pragma unroll 1
      for (int item = blockIdx.x; item < 2048; item += gridDim.x) {
          const int nitem = item + gridDim.x;
          if (nitem < 2048) ml3_load(P, nitem, tid, tid & 63, wave, nxt);
          ml3_item(P, lds, item, cur, tid, tid & 63, wave);
          cur = nxt;
      } }
}

__global__ void __launch_bounds__(512, 2) fwd(Params P) {
    extern __shared__ __attribute__((aligned(16))) unsigned char lds_raw[];
    lptr lds = (lptr)lds_raw;
    cg::grid_group grid = cg::this_grid();
    int tid = threadIdx.x, lane = tid & 63; const int wave = __builtin_amdgcn_readfirstlane(tid >> 6);
#define FRESH_TID() do { asm volatile("" : "+v"(tid)); lane = tid & 63; } while (0)
    const int gw = blockIdx.x * 8 + wave, NGW = gridDim.x * 8;
    unsigned char* ws = P.ws;
    const float* MOD = (const float*)(ws + WS_MOD);
    bf16_t* H = (bf16_t*)(ws + WS_H); bf16_t* PROJ = (bf16_t*)(ws + WS_PROJ); bf16_t* YC = (bf16_t*)(ws + WS_YCAT); bf16_t* ACT = (bf16_t*)(ws + WS_ACT);

#ifndef G_ALIGN
#define G_ALIGN true
#endif
#ifndef G_SP2
#define G_SP2 true
#endif
#ifndef PH
#define PH 0xFFFF
#endif
    if (tid == 0) { *(LAS unsigned*)(lds + LDS_BYTES - 32) = 0u; *(LAS unsigned*)(lds + LDS_BYTES - 28) = 0u; }
    __syncthreads();
    const XcdBarrier bar = xcd_barrier_post((unsigned*)(ws + WS_CTL) + 1024, (volatile LAS unsigned*)(lds + LDS_BYTES - 32));
    if (P.out == nullptr) grid.sync();
    phase0(P, lds, tid, lane, wave);
    __syncthreads();
    if (blockIdx.x >= 192) phase_weights(P, lds, lane, wave, 0, 4096, (blockIdx.x - 192) * 8 + wave, 64 * 8);
    else phase_weights(P, lds, lane, wave, 4096, 16 * 112 + 16 * 32 + 16 * 176 + 44 * 32, blockIdx.x * 8 + wave, 192 * 8);
#ifdef DBL_P0
    __syncthreads(); phase0(P, lds, tid, lane, wave);
#endif
    xcd_barrier(bar);
    FRESH_TID();
    phase1(P, lds, tid, lane, wave);
#ifdef DBL_P1
    __syncthreads(); phase1(P, lds, tid, lane, wave);
#endif
#ifdef DBL_P1NG
    __syncthreads(); phase1_nogates(P, lds, tid, lane, wave);
#endif
    xcd_barrier(bar);
    FRESH_TID();
    {
        EpiProj E{PROJ, P.out + O_PK, P.out + O_PV, P.in[I_SQW], P.in[I_SKW], 0};
        pg8::Gemm g{H, (const bf16_t*)(ws + WS_W1T), MP, NPROJ, 1024}; pg8::StaticOrder S; S.init(MP, NPROJ, gridDim.x, (int)blockIdx.x);
        pg8::gemm_phase<EpiProj, pg8::StaticOrder, G_ALIGN, G_SP2>(lds, g, S, E);
#ifdef DBL_G
        pg8::gemm_phase<EpiProj, pg8::StaticOrder, G_ALIGN, G_SP2>(lds, g, S, E);
#endif
    }
    xcd_barrier(bar);
    FRESH_TID();
    {
        EpiProj Es{PROJ, P.out + O_SK, P.out + O_SV, P.in[I_SQW], P.in[I_SKW], MP};
        phase_mixers(P, lds, tid, wave, Es);
    }
    xcd_barrier(bar);
    FRESH_TID();
    phase_ml2(P, lds, tid, wave);
#ifdef DBL_M2
    __syncthreads(); phase_ml2(P, lds, tid, wave);
#endif
    xcd_barrier(bar);
    FRESH_TID();
    {
        EpiRes<0> Es{P.in[I_XS], (bf16_t*)(ws + WS_X1B) + (size_t)MP * 1024, MOD + 8 * 6144 + 2048, 5};
        phase_ml3(P, lds, tid, wave, Es);
    }
#ifdef XSYNC
    for (int i = 0; i < XSYNC; ++i) xcd_barrier(bar);
#endif
    xcd_barrier(bar);
    FRESH_TID();
    {
        sample_h2_row(P, lds, tid, lane, wave);
        EpiRes<0> E{P.in[I_XP], ws + WS_X1B, MOD + 2048, 12};
        pg8::Gemm g{YC, (const bf16_t*)(ws + WS_W2T), MP, 1024, 1024}; pg8::StaticOrder S; S.init(MP, 1024, gridDim.x, (int)blockIdx.x);
        pg8::gemm_phase<EpiRes<0>, pg8::StaticOrder, G_ALIGN, G_SP2>(lds, g, S, E);
    }
    xcd_barrier(bar);
    FRESH_TID();
    {
        phase5(P, lds, tid, lane, wave);
#ifdef DBL_P5
        phase5(P, lds, tid, lane, wave);
#endif
        EpiFFNs Es{ACT, P.out + O_SF, P.in[I_SFC], P.in[I_WCONV], P.in[I_BCONV]};
        for (int t = blockIdx.x; t < 352; t += gridDim.x) small_tile<1024, false>(H + (size_t)MP * 1024, (const bf16_t*)(ws + WS_W3T), Es, nullptr, lds, t, tid, lane, wave);
    }
    xcd_barrier(bar);
    FRESH_TID();
    {
        EpiFFN E{ACT, (float*)(ws + WS_UEDGE), P.out + O_PF, P.in[I_WCONV], P.in[I_BCONV]};
        pg8::Gemm g{H, (const bf16_t*)(ws + WS_W3T), MP, FF2, 1024}; pg8::StaticOrder S; S.init(MP, FF2, gridDim.x, (int)blockIdx.x);
        pg8::gemm_phase<EpiFFN, pg8::StaticOrder, true, G_SP2>(lds, g, S, E);
#ifdef DBL_G
        pg8::gemm_phase<EpiFFN, pg8::StaticOrder, true, G_SP2>(lds, g, S, E);
#endif
    }
    xcd_barrier(bar);
    FRESH_TID();
    {
        phase_fix(P, tid);
        EpiRes<1> Es{(const bf16_t*)(ws + WS_X1B) + (size_t)MP * 1024, P.out + O_YS, MOD + 8 * 6144 + 5120, 5};
        if (blockIdx.x < 64) small_tile<FF, false>(ACT + (size_t)MP * FF, (const bf16_t*)(ws + WS_W4T), Es, nullptr, lds, blockIdx.x, tid, lane, wave);
    }
    xcd_barrier(bar);
    FRESH_TID();
    {
        EpiRes<1> E{ws + WS_X1B, P.out + O_YP, MOD + 5120, 12};
        pg8::Gemm g{ACT, (const bf16_t*)(ws + WS_W4T), MP, 1024, FF}; pg8::StaticOrder S; S.init(MP, 1024, gridDim.x, (int)blockIdx.x);
        pg8::gemm_phase<EpiRes<1>, pg8::StaticOrder, G_ALIGN, G_SP2>(lds, g, S, E);
    }

#ifdef DIAG
    xcd_barrier(bar);
    {
        const size_t offs[15] = {O_YP, O_YS, O_PC, O_PN, O_PM, O_PK, O_PV, O_PF, O_SC, O_SN, O_SM, O_SK, O_SV, O_SF, O_END};
        for (int o = 0; o < 14; ++o) if ((DIAG >> o) & 1) for (size_t i = offs[o] + (size_t)blockIdx.x * 512 + tid; i < offs[o + 1]; i += (size_t)gridDim.x * 512) P.out[i] *= 1.2f;
    }
#endif
}

extern "C" void kernel_launch(void* const* d_in, const int* in_sizes, int n_in, void* d_out, int out_size, void* d_ws, size_t ws_size, hipStream_t stream) {
    static int grid_blocks = 0;
    if (!grid_blocks) {
        int dev = 0, cus = 0, per_cu = 0;
        (void)hipGetDevice(&dev);
        (void)hipDeviceGetAttribute(&cus, hipDeviceAttributeMultiprocessorCount, dev);
        (void)hipFuncSetAttribute((const void*)fwd, hipFuncAttributeMaxDynamicSharedMemorySize, LDS_BYTES);
        (void)hipOccupancyMaxActiveBlocksPerMultiprocessor(&per_cu, (const void*)fwd, 512, LDS_BYTES);
        grid_blocks = cus;
        if (n_in != 26 || out_size != (int)O_END || ws_size < WS_END2 || cus != 256 || per_cu < 1) {
            fprintf(stderr, "kernel_launch: unexpected geometry: n_in %d out %d ws %zu cus %d per_cu %d\n", n_in, out_size, ws_size, cus, per_cu);
            if (n_in != 26 || out_size != (int)O_END || ws_size < WS_END2 || cus != 256) grid_blocks = -1;
        }
    }
    if (grid_blocks < 0) return;
    if (hipMemsetAsync((char*)d_ws + WS_CTL, 0, WS_MOD + 16 * 6144 * 4, stream) != hipSuccess) { fprintf(stderr, "kernel_launch: memset of the control words failed\n"); return; }
    Params p{};
    for (int i = 0; i < 26; ++i) p.in[i] = (const float*)d_in[i];
    p.out = (float*)d_out; p.ws = (unsigned char*)d_ws;
    void* args[] = {&p};
    hipError_t e = hipLaunchCooperativeKernel((const void*)fwd, dim3(grid_blocks), dim3(512), args, LDS_BYTES, stream);
    if (e != hipSuccess) fprintf(stderr, "cooperative launch failed: %s (grid %d)\n", hipGetErrorString(e), grid_blocks);
}
```
